# Optimizing an MI355X kernel written in HIP

```python
import math
import jax
import jax.numpy as jnp
from jax import lax
import numpy as np

D_MODEL = 1024
BATCH = 8
SEQ = 4096
DEPTH = 2

HEAD_DIM = 64
ROT_DIM = HEAD_DIM // 4
ROPE_THETA = 500000.0
NORM_EPS = 1e-6
Q_BLOCK = 128
NEG_INF = -1e30
FORCED = 1e9

NSA_HEADS = 4
NSA_CMP_LEN = 32
NSA_CMP_STRIDE = 16
NSA_CMP_HIDDEN = 256
NSA_SLC_LEN = 64
NSA_TOPK = 16
NSA_WINDOW = 512
NSA_W = NSA_HEADS * HEAD_DIM

S5_GROUPS = 16
S5_GROUP_CH = 16
S5_W = S5_GROUPS * S5_GROUP_CH
S5_STATE = 64

GDN_HEADS = 4
GDN_CONV = 4
GDN_CHUNK = 64
GDN_W = GDN_HEADS * HEAD_DIM

SB_HEADS = 4
SB_W = SB_HEADS * HEAD_DIM

N_BRANCH = 4
BRANCH_W = NSA_W
D_FF = 256 * math.ceil(8 * D_MODEL / (3 * 256))

IN_SPLITS = (NSA_W, 6 * HEAD_DIM, 3 * NSA_HEADS, S5_W, 3 * GDN_W, GDN_HEADS, GDN_HEADS, GDN_W, 3 * SB_W, N_BRANCH * D_MODEL)
D_IN = sum(IN_SPLITS)
IN_OFFSETS = tuple(int(v) for v in np.cumsum(IN_SPLITS)[:-1])

kernel_name = "hybrid_nsa_s5_gdn_stickbreaking_block"


def rms_norm(x, w):
    xf = x.astype(jnp.float32)
    y = xf * lax.rsqrt(jnp.mean(xf * xf, axis=-1, keepdims=True) + NORM_EPS)
    return (y * w.astype(jnp.float32)).astype(x.dtype)


def l2norm(x):
    return x * lax.rsqrt(jnp.sum(x * x, axis=-1, keepdims=True) + NORM_EPS)


def rope_tables(positions):
    half = ROT_DIM // 2
    inv_freq = ROPE_THETA ** (-jnp.arange(half, dtype=jnp.float32) / half)
    ang = positions.astype(jnp.float32)[..., None] * inv_freq
    return jnp.cos(ang), jnp.sin(ang)


def apply_rope(x, cos, sin):
    half = ROT_DIM // 2
    x1, x2, rest = x[..., :half], x[..., half:ROT_DIM], x[..., ROT_DIM:]
    return jnp.concatenate([x1 * cos - x2 * sin, x2 * cos + x1 * sin, rest], axis=-1).astype(x.dtype)


def masked_softmax(s, mask):
    s = jnp.where(mask, s, NEG_INF)
    m = jnp.max(s, axis=-1, keepdims=True)
    p = jnp.where(mask, jnp.exp(s - m), 0.0)
    return p / jnp.maximum(jnp.sum(p, axis=-1, keepdims=True), 1e-30)


def causal_depthwise_conv(x, w):
    k = w.shape[0]
    return lax.conv_general_dilated(x, w[:, None, :], window_strides=(1,), padding=[(k - 1, 0)],
                                    dimension_numbers=('NWC', 'WIO', 'NWC'), feature_group_count=x.shape[-1])


def nsa_mixer(q, kv, gate_logits, cos, sin, q_norm, k_norm, cmp_pos, ck_w1, ck_w2, cv_w1, cv_w2):
    B_, S_ = q.shape[:2]
    f32 = jnp.float32
    scale = HEAD_DIM ** -0.5
    q = rms_norm(q.reshape(B_, S_, NSA_HEADS, HEAD_DIM), q_norm)
    q_rot = apply_rope(q, cos[:, :, None], sin[:, :, None])
    k_c, v_c, k_s, v_s, k_w, v_w = jnp.split(kv, 6, axis=-1)
    n_cmp = (S_ - NSA_CMP_LEN) // NSA_CMP_STRIDE + 1
    cmp_start = jnp.arange(n_cmp) * NSA_CMP_STRIDE
    cmp_idx = cmp_start[:, None] + jnp.arange(NSA_CMP_LEN)[None, :]

    def compress(t, pos, w1, w2):
        blocks = (t[:, cmp_idx] + pos).reshape(B_, n_cmp, NSA_CMP_LEN * HEAD_DIM)
        return jax.nn.gelu(blocks @ w1) @ w2

    kc = rms_norm(compress(k_c, cmp_pos[0], ck_w1, ck_w2), k_norm[0])
    vc = compress(v_c, cmp_pos[1], cv_w1, cv_w2).astype(f32)
    cmp_end = cmp_start + NSA_CMP_LEN - 1
    n_slc = S_ // NSA_SLC_LEN
    top_n = min(NSA_TOPK, n_slc)
    slc_start = jnp.arange(n_slc) * NSA_SLC_LEN
    overlap = ((cmp_start[:, None] < slc_start[None, :] + NSA_SLC_LEN)
               & (cmp_start[:, None] + NSA_CMP_LEN > slc_start[None, :])).astype(f32)
    ks_blk = apply_rope(rms_norm(k_s, k_norm[1]), cos, sin).reshape(B_, n_slc, NSA_SLC_LEN, HEAD_DIM)
    vs_blk = v_s.reshape(B_, n_slc, NSA_SLC_LEN, HEAD_DIM)
    pad = ((0, 0), (NSA_WINDOW, 0), (0, 0))
    kw = jnp.pad(apply_rope(rms_norm(k_w, k_norm[2]), cos, sin), pad)
    vw = jnp.pad(v_w, pad)
    gates = jax.nn.sigmoid(gate_logits.astype(f32)).reshape(B_, S_, NSA_HEADS, 3)
    b_idx = jnp.arange(B_)[:, None, None]
    within = jnp.arange(NSA_SLC_LEN)

    def block(c):
        t0 = c * Q_BLOCK
        t = t0 + jnp.arange(Q_BLOCK)
        qb = lax.dynamic_slice_in_dim(q, t0, Q_BLOCK, axis=1)
        qrb = lax.dynamic_slice_in_dim(q_rot, t0, Q_BLOCK, axis=1)
        gb = lax.dynamic_slice_in_dim(gates, t0, Q_BLOCK, axis=1)
        s_c = jnp.einsum('bqhd,bnd->bhqn', qb, kc, preferred_element_type=f32) * scale
        p_c = masked_softmax(s_c, cmp_end[None, :] <= t[:, None])
        o_c = jnp.einsum('bhqn,bnd->bqhd', p_c, vc)
        imp = jnp.einsum('bhqn,nj->bqj', p_c, overlap)
        forced = (slc_start[None, :] == ((t // NSA_SLC_LEN) * NSA_SLC_LEN)[:, None]) | (slc_start[None, :] == 0)
        imp = jnp.where(forced, FORCED, jnp.where(slc_start[None, :] <= t[:, None], imp, NEG_INF))
        _, sel = lax.top_k(imp, top_n)
        kg = ks_blk[b_idx, sel].reshape(B_, Q_BLOCK, top_n * NSA_SLC_LEN, HEAD_DIM)
        vg = vs_blk[b_idx, sel].reshape(B_, Q_BLOCK, top_n * NSA_SLC_LEN, HEAD_DIM).astype(f32)
        kpos = (sel[..., None] * NSA_SLC_LEN + within).reshape(B_, Q_BLOCK, top_n * NSA_SLC_LEN)
        s_s = jnp.einsum('bqhd,bqkd->bhqk', qrb, kg, preferred_element_type=f32) * scale
        p_s = masked_softmax(s_s, (kpos <= t[None, :, None])[:, None])
        o_s = jnp.einsum('bhqk,bqkd->bqhd', p_s, vg)
        kwb = lax.dynamic_slice_in_dim(kw, t0, Q_BLOCK + NSA_WINDOW, axis=1)
        vwb = lax.dynamic_slice_in_dim(vw, t0, Q_BLOCK + NSA_WINDOW, axis=1).astype(f32)
        wpos = t0 - NSA_WINDOW + jnp.arange(Q_BLOCK + NSA_WINDOW)
        diff = t[:, None] - wpos[None, :]
        wmask = (diff >= 0) & (diff < NSA_WINDOW) & (wpos[None, :] >= 0)
        s_w = jnp.einsum('bqhd,bkd->bhqk', qrb, kwb, preferred_element_type=f32) * scale
        p_w = masked_softmax(s_w, wmask)
        o_w = jnp.einsum('bhqk,bkd->bqhd', p_w, vwb)
        return gb[..., 0:1] * o_c + gb[..., 1:2] * o_s + gb[..., 2:3] * o_w

    out = lax.map(block, jnp.arange(S_ // Q_BLOCK))
    return jnp.moveaxis(out, 0, 1).reshape(B_, S_, NSA_W).astype(q.dtype)


def s5_mixer(u, lam_re, lam_im, log_dt, b_re, b_im, c_re, c_im, d_skip, glu_w):
    B_, S_ = u.shape[:2]
    f32 = jnp.float32
    uf = u.astype(f32).reshape(B_, S_, S5_GROUPS, S5_GROUP_CH)
    dt = jnp.exp(log_dt.astype(f32))[:, None]
    lr, li = lam_re.astype(f32), lam_im.astype(f32)
    mag = jnp.exp(lr * dt)
    ab_re, ab_im = mag * jnp.cos(li * dt), mag * jnp.sin(li * dt)
    den = lr * lr + li * li
    f_re = ((ab_re - 1.0) * lr + ab_im * li) / den
    f_im = (ab_im * lr - (ab_re - 1.0) * li) / den
    br, bi = b_re.astype(f32), b_im.astype(f32)
    bb_re = f_re[..., None] * br - f_im[..., None] * bi
    bb_im = f_re[..., None] * bi + f_im[..., None] * br
    bu_re = jnp.einsum('bsgc,gpc->bsgp', uf, bb_re)
    bu_im = jnp.einsum('bsgc,gpc->bsgp', uf, bb_im)
    a_re = jnp.broadcast_to(ab_re, bu_re.shape)
    a_im = jnp.broadcast_to(ab_im, bu_im.shape)

    def combine(e1, e2):
        a1r, a1i, b1r, b1i = e1
        a2r, a2i, b2r, b2i = e2
        return (a2r * a1r - a2i * a1i, a2r * a1i + a2i * a1r,
                a2r * b1r - a2i * b1i + b2r, a2r * b1i + a2i * b1r + b2i)

    _, _, x_re, x_im = lax.associative_scan(combine, (a_re, a_im, bu_re, bu_im), axis=1)
    y = (jnp.einsum('gcp,bsgp->bsgc', c_re.astype(f32), x_re)
         - jnp.einsum('gcp,bsgp->bsgc', c_im.astype(f32), x_im)
         + d_skip.astype(f32).reshape(S5_GROUPS, S5_GROUP_CH) * uf)
    y = jax.nn.gelu(y.reshape(B_, S_, S5_W))
    z = y @ glu_w.astype(f32)
    return (z[..., :S5_W] * jax.nn.sigmoid(z[..., S5_W:])).astype(u.dtype)


def chunk_gated_delta_rule(q, k, v, g, beta):
    B_, S_, H, d = q.shape
    C = GDN_CHUNK
    N = S_ // C

    def to_chunks(t):
        return jnp.moveaxis(t.reshape((B_, N, C, H) + t.shape[3:]), 3, 2)

    q, k, v, g, beta = [to_chunks(t) for t in (q, k, v, g, beta)]
    G = jnp.cumsum(g, axis=-1)
    tril = jnp.tril(jnp.ones((C, C), dtype=bool))
    strict = jnp.tril(jnp.ones((C, C), dtype=bool), -1)
    decay = jnp.where(tril, jnp.exp(jnp.where(tril, G[..., :, None] - G[..., None, :], 0.0)), 0.0)
    kb = k * beta[..., None]
    vb = v * beta[..., None]
    L = jnp.where(strict, jnp.einsum('bnhid,bnhjd->bnhij', kb, k) * decay, 0.0)
    eye = jnp.eye(C, dtype=L.dtype)
    T = lax.linalg.triangular_solve(eye + L, jnp.broadcast_to(eye, L.shape), left_side=True,
                                    lower=True, unit_diagonal=True)
    u = jnp.einsum('bnhij,bnhjd->bnhid', T, vb)
    w = jnp.einsum('bnhij,bnhjd->bnhid', T, kb * jnp.exp(G)[..., None])
    a_intra = jnp.where(tril, jnp.einsum('bnhid,bnhjd->bnhij', q, k) * decay, 0.0)
    q_dec = q * jnp.exp(G)[..., None]
    k_dec = k * jnp.exp(G[..., -1:] - G)[..., None]
    g_last = jnp.exp(G[..., -1])

    def step(state, xs):
        u_i, w_i, a_i, qd_i, kd_i, gl_i = xs
        v_new = u_i - jnp.einsum('bhcd,bhde->bhce', w_i, state)
        o = jnp.einsum('bhcd,bhde->bhce', qd_i, state) + jnp.einsum('bhij,bhje->bhie', a_i, v_new)
        state = state * gl_i[..., None, None] + jnp.einsum('bhcd,bhce->bhde', kd_i, v_new)
        return state, o

    xs = tuple(jnp.moveaxis(t, 1, 0) for t in (u, w, a_intra, q_dec, k_dec, g_last))
    state0 = jnp.zeros((B_, H, d, v.shape[-1]), dtype=q.dtype)
    _, o = lax.scan(step, state0, xs)
    return o.transpose(1, 0, 3, 2, 4).reshape(B_, S_, H, v.shape[-1])


def gdn_mixer(qkv, a_in, b_in, z, conv_w, a_log, dt_bias, o_norm):
    B_, S_ = qkv.shape[:2]
    f32 = jnp.float32
    act = jax.nn.silu(causal_depthwise_conv(qkv, conv_w))
    q, k, v = [t.reshape(B_, S_, GDN_HEADS, HEAD_DIM).astype(f32) for t in jnp.split(act, 3, axis=-1)]
    q = l2norm(q) * HEAD_DIM ** -0.5
    k = l2norm(k)
    beta = jax.nn.sigmoid(b_in.astype(f32))
    g = -jnp.exp(a_log.astype(f32)) * jax.nn.softplus(a_in.astype(f32) + dt_bias.astype(f32))
    o = chunk_gated_delta_rule(q, k, v, g, beta)
    o = rms_norm(o, o_norm) * jax.nn.silu(z.astype(f32).reshape(B_, S_, GDN_HEADS, HEAD_DIM))
    return o.reshape(B_, S_, GDN_W).astype(qkv.dtype)


def stickbreaking_mixer(qkv):
    B_, S_ = qkv.shape[:2]
    f32 = jnp.float32
    q, k, v = [t.reshape(B_, S_, SB_HEADS, HEAD_DIM) for t in jnp.split(qkv, 3, axis=-1)]
    scale = HEAD_DIM ** -0.5
    outs = []
    for c in range(S_ // Q_BLOCK):
        t0 = c * Q_BLOCK
        n_k = t0 + Q_BLOCK
        z = jnp.einsum('bqhd,bkhd->bhqk', q[:, t0:n_k], k[:, :n_k], preferred_element_type=f32) * scale
        t = t0 + jnp.arange(Q_BLOCK)
        mask = jnp.arange(n_k)[None, :] < t[:, None]
        log_nb = jnp.where(mask, -jax.nn.softplus(z), 0.0)
        after = lax.cumsum(log_nb, axis=3, reverse=True) - log_nb
        weights = jnp.where(mask, jnp.exp(jax.nn.log_sigmoid(z) + after), 0.0)
        outs.append(jnp.einsum('bhqk,bkhd->bqhd', weights, v[:, :n_k].astype(f32)))
    return jnp.concatenate(outs, axis=1).reshape(B_, S_, SB_W).astype(qkv.dtype)


def swiglu_ffn(x, w_gate, w_up, w_down):
    return (jax.nn.silu(x @ w_gate) * (x @ w_up)) @ w_down


def setup_inputs(seed: int = 0) -> dict:
    key = jax.random.key(seed)
    keys = iter(jax.random.split(key, 40))
    f32 = jnp.float32
    L = DEPTH

    def nrm(shape, scale):
        return jax.random.normal(next(keys), shape, f32) * scale

    def gain(shape):
        return 1.0 + nrm(shape, 0.05)

    def unif(shape, lo, hi):
        return jax.random.uniform(next(keys), shape, f32, minval=lo, maxval=hi)

    x = nrm((BATCH, SEQ, D_MODEL), 1.0)
    positions = (jnp.arange(SEQ, dtype=jnp.int32)[None, :]
                 + jax.random.randint(next(keys), (BATCH, 1), 0, 1024, dtype=jnp.int32))
    dt_g = jnp.exp(unif((L, GDN_HEADS), math.log(1e-3), math.log(1e-1)))
    return {
        'x': x,
        'positions': positions,
        'attn_norm': gain((L, D_MODEL)),
        'w_in': nrm((L, D_MODEL, D_IN), D_MODEL ** -0.5),
        'nsa_q_norm': gain((L, HEAD_DIM)),
        'nsa_k_norm': gain((L, 3, HEAD_DIM)),
        'nsa_cmp_pos': nrm((L, 2, NSA_CMP_LEN, HEAD_DIM), 0.1),
        'nsa_cmp_k_w1': nrm((L, NSA_CMP_LEN * HEAD_DIM, NSA_CMP_HIDDEN), (NSA_CMP_LEN * HEAD_DIM) ** -0.5),
        'nsa_cmp_k_w2': nrm((L, NSA_CMP_HIDDEN, HEAD_DIM), NSA_CMP_HIDDEN ** -0.5),
        'nsa_cmp_v_w1': nrm((L, NSA_CMP_LEN * HEAD_DIM, NSA_CMP_HIDDEN), (NSA_CMP_LEN * HEAD_DIM) ** -0.5),
        'nsa_cmp_v_w2': nrm((L, NSA_CMP_HIDDEN, HEAD_DIM), NSA_CMP_HIDDEN ** -0.5),
        's5_lam_re': -0.5 + nrm((L, S5_GROUPS, S5_STATE), 0.01),
        's5_lam_im': math.pi * jnp.arange(S5_STATE, dtype=f32) + nrm((L, S5_GROUPS, S5_STATE), 0.01),
        's5_log_dt': unif((L, S5_GROUPS), math.log(1e-3), math.log(1e-1)),
        's5_b_re': nrm((L, S5_GROUPS, S5_STATE, S5_GROUP_CH), (2 * S5_GROUP_CH) ** -0.5),
        's5_b_im': nrm((L, S5_GROUPS, S5_STATE, S5_GROUP_CH), (2 * S5_GROUP_CH) ** -0.5),
        's5_c_re': nrm((L, S5_GROUPS, S5_GROUP_CH, S5_STATE), (2 * S5_STATE) ** -0.5),
        's5_c_im': nrm((L, S5_GROUPS, S5_GROUP_CH, S5_STATE), (2 * S5_STATE) ** -0.5),
        's5_d': nrm((L, S5_W), 1.0),
        's5_glu_w': nrm((L, S5_W, 2 * S5_W), S5_W ** -0.5),
        'gdn_conv_w': nrm((L, GDN_CONV, 3 * GDN_W), GDN_CONV ** -0.5),
        'gdn_a_log': jnp.log(unif((L, GDN_HEADS), 1.0, 16.0)),
        'gdn_dt_bias': dt_g + jnp.log(-jnp.expm1(-dt_g)),
        'gdn_o_norm': gain((L, HEAD_DIM)),
        'w_branch': nrm((L, N_BRANCH, BRANCH_W, D_MODEL), BRANCH_W ** -0.5),
        'w_out': nrm((L, D_MODEL, D_MODEL), D_MODEL ** -0.5),
        'ffn_norm': gain((L, D_MODEL)),
        'w_gate': nrm((L, D_MODEL, D_FF), D_MODEL ** -0.5),
        'w_up': nrm((L, D_MODEL, D_FF), D_MODEL ** -0.5),
        'w_down': nrm((L, D_FF, D_MODEL), D_FF ** -0.5),
    }


def reference(x, positions, attn_norm, w_in, nsa_q_norm, nsa_k_norm, nsa_cmp_pos, nsa_cmp_k_w1, nsa_cmp_k_w2,
              nsa_cmp_v_w1, nsa_cmp_v_w2, s5_lam_re, s5_lam_im, s5_log_dt, s5_b_re, s5_b_im, s5_c_re, s5_c_im,
              s5_d, s5_glu_w, gdn_conv_w, gdn_a_log, gdn_dt_bias, gdn_o_norm, w_branch, w_out, ffn_norm,
              w_gate, w_up, w_down):
    B_, S_, _ = x.shape
    cos, sin = rope_tables(positions)
    for l in range(DEPTH):
        h = rms_norm(x, attn_norm[l])
        proj = h @ w_in[l]
        (nsa_q, nsa_kv, nsa_g, s5_u, gdn_qkv, gdn_a, gdn_b, gdn_z, sb_qkv,
         merge_logits) = jnp.split(proj, IN_OFFSETS, axis=-1)
        o_nsa = nsa_mixer(nsa_q, nsa_kv, nsa_g, cos, sin, nsa_q_norm[l], nsa_k_norm[l], nsa_cmp_pos[l],
                          nsa_cmp_k_w1[l], nsa_cmp_k_w2[l], nsa_cmp_v_w1[l], nsa_cmp_v_w2[l])
        o_s5 = s5_mixer(s5_u, s5_lam_re[l], s5_lam_im[l], s5_log_dt[l], s5_b_re[l], s5_b_im[l],
                        s5_c_re[l], s5_c_im[l], s5_d[l], s5_glu_w[l])
        o_gdn = gdn_mixer(gdn_qkv, gdn_a, gdn_b, gdn_z, gdn_conv_w[l], gdn_a_log[l], gdn_dt_bias[l], gdn_o_norm[l])
        o_sb = stickbreaking_mixer(sb_qkv)
        gates = jax.nn.sigmoid(merge_logits.astype(jnp.float32)).reshape(B_, S_, N_BRANCH, D_MODEL).astype(x.dtype)
        merged = jnp.zeros_like(x)
        for m, o_m in enumerate((o_nsa, o_s5, o_gdn, o_sb)):
            merged = merged + gates[:, :, m] * (o_m @ w_branch[l, m])
        x = x + merged @ w_out[l]
        x = x + swiglu_ffn(rms_norm(x, ffn_norm[l]), w_gate[l], w_up[l], w_down[l])
    return x
```

```cpp
#include <hip/hip_runtime.h>
#include <hip/hip_cooperative_groups.h>
#include <cstdio>
namespace cg = cooperative_groups;

typedef unsigned short u16;
typedef unsigned long long u64;
typedef __attribute__((ext_vector_type(8))) short bf16x8;
typedef __attribute__((ext_vector_type(4))) short s16x4;
typedef __attribute__((ext_vector_type(4))) float f32x4;
#define DI __device__ __forceinline__

constexpr int NB = 8, SEQ = 4096, T_ = NB * SEQ, DM = 1024, DIN = 6804, PW = 2816, DFF = 2816;
constexpr int P_Q = 0, P_KV = 256, P_S5U = 640, P_GQKV = 896, P_GZ = 1664, P_SB = 1920, P_NG = 2688, P_GA = 2700, P_GB = 2704;
constexpr float EPS = 1e-6f;
constexpr size_t MiB = 1024ull * 1024ull;
constexpr size_t WS_H = 0, WS_PROJ = 64 * MiB, WS_OM = 240 * MiB, WS_MERGED = 304 * MiB,
                 WS_GQ = 304 * MiB, WS_GK = 320 * MiB, WS_GU = 336 * MiB, WS_GW = 352 * MiB, WS_GA = 368 * MiB,
                 WS_QR = 384 * MiB, WS_OC = 400 * MiB, WS_OW = 416 * MiB, WS_Y5 = 432 * MiB,
                 WS_GG = 448 * MiB, WS_SEL = 449 * MiB, WS_COS = 450 * MiB, WS_SIN = 451 * MiB,
                 WS_ENDS = 452 * MiB, WS_CARRY = 456 * MiB, WS_KC = 460 * MiB, WS_VC = 461 * MiB, WS_HID = 462 * MiB,
                 WS_CNT = 464 * MiB, WS_W = 465 * MiB, WS_CBIAS = 449 * MiB + 512 * 1024;
constexpr size_t WT_IN = 0, WT_G = WT_IN + 2816ull * 1024 * 2, WT_BR = WT_G + 4096ull * 1024 * 2, WT_OUT = WT_BR + 4096ull * 256 * 2,
                 WT_GU = WT_OUT + 1024ull * 1024 * 2, WT_D = WT_GU + 5632ull * 1024 * 2, WT_GLU = WT_D + 1024ull * 2816 * 2,
                 WT_C1 = WT_GLU + 512ull * 256 * 2, WT_C2 = WT_C1 + 512ull * 2048 * 2, WT_END = WT_C2 + 128ull * 256 * 2;
constexpr int NPHASE = 22;
#define XCD_STATIC_LOOP(NPER, BODY) { \
    unsigned c0_ = cnt[900], c1_ = cnt[901], c2_ = cnt[902], c3_ = cnt[903], c4_ = cnt[904], c5_ = cnt[905], c6_ = cnt[906], c7_ = cnt[907]; \
    const bool ok_ = c0_ && c1_ && c2_ && c3_ && c4_ && c5_ && c6_ && c7_; \
    const unsigned mine_ = xcd == 0 ? c0_ : xcd == 1 ? c1_ : xcd == 2 ? c2_ : xcd == 3 ? c3_ : xcd == 4 ? c4_ : xcd == 5 ? c5_ : xcd == 6 ? c6_ : c7_; \
    const int start_ = ok_ ? xcd * (NPER) + xrank : (int)blockIdx.x, end_ = ok_ ? (xcd + 1) * (NPER) : 8 * (NPER), step_ = ok_ ? (int)mine_ : (int)gridDim.x; \
    for (int it = start_; it < end_; it += step_) { BODY; } }
#ifndef PROBE_DUP
#define PROBE_DUP 0
#endif
#ifndef LB2
#define LB2 2
#endif
#ifndef PHASE_MASK
#define PHASE_MASK 0x7ff
#endif

struct Params {
  const float* in[30];
  float* out;
  unsigned char* ws;
  int ph_lo, ph_hi;
};


DI int TID() { int t = threadIdx.x; asm volatile("" : "+v"(t)); return t; }
DI unsigned char* WSP(const Params& P) { size_t z = 0; asm volatile("" : "+s"(z)); return P.ws + z; }
DI const float* PIN(const Params& P, int i) { asm volatile("" : "+s"(i)); return P.in[i]; }
DI u16 f2bf(float x) { unsigned u = __float_as_uint(x); u += 0x7fffu + ((u >> 16) & 1u); return (u16)(u >> 16); }
DI float bf2f(u16 h) { return __uint_as_float(((unsigned)h) << 16); }
DI unsigned pk2(float a, float b) { return (unsigned)f2bf(a) | ((unsigned)f2bf(b) << 16); }
DI float wave_sum(float v) {
#pragma unroll
  for (int o = 1; o < 64; o <<= 1) v += __shfl_xor(v, o);
  return v;
}
DI float sigmoidf_(float x) { return 1.f / (1.f + __expf(-x)); }
DI float siluf_(float x) { return x * sigmoidf_(x); }
DI float softplusf_(float x) { return fmaxf(x, 0.f) + log1pf(__expf(-fabsf(x))); }
DI float gelu_tanh(float x) {
  float u = 0.7978845608028654f * (x + 0.044715f * x * x * x);
  float t = 1.f - 2.f / (__expf(2.f * u) + 1.f);
  return 0.5f * x * (1.f + t);
}
DI void sincos_d(double x, double& s, double& c) {
  const double TWO_PI = 6.283185307179586476925287, INV = 0.15915494309189533576888;
  double n = rint(x * INV);
  double r = x - n * TWO_PI;
  double r2 = r * r, term = 1.0, cs = 1.0, ss = 1.0;
#pragma unroll
  for (int k = 1; k <= 14; ++k) { term *= r2 * (-1.0 / (double)((2 * k - 1) * (2 * k))); cs += term; }
  term = 1.0;
#pragma unroll
  for (int k = 1; k <= 14; ++k) { term *= r2 * (-1.0 / (double)((2 * k) * (2 * k + 1))); ss += term; }
  s = r * ss; c = cs;
}
DI int next_item(unsigned* cnt, int* s_item) {
  __syncthreads();
  if (TID() == 0) *s_item = (int)atomicAdd(cnt, 1u);
  __syncthreads();
  return *s_item;
}
DI int next_tile_xcd(unsigned* cnt8, int n_per_xcd, int xcd, int* s_item) {
  asm volatile("" : "+s"(xcd));
  __syncthreads();
  if (threadIdx.x == 0) {
    int res = -1;
    for (int a = 0; a < 8; ++a) {
      int qq = (xcd + a) & 7;
      unsigned v = atomicAdd(cnt8 + qq, 1u);
      if (v < (unsigned)n_per_xcd) { res = qq * n_per_xcd + (int)v; break; }
    }
    *s_item = res;
  }
  __syncthreads();
  return *s_item;
}
DI void tile_from_q(int it, int numN, int& mt, int& nt) {
  const int per = 32 * numN, q = it / per, i = it % per, g = i / (8 * numN), rem = i % (8 * numN);
  nt = rem >> 3; mt = 32 * q + 8 * g + (rem & 7);
}
DI int proj_src_col(int pc) {
  if (pc < 640) return pc;
  if (pc < 1664) return pc + 12;
  if (pc < 2688) return pc + 20;
  if (pc < 2700) return pc - 2688 + 640;
  if (pc < 2708) return pc - 2700 + 1676;
  return pc;
}

DI uint4 addpos8(uint4 v, const float* pp) {
  uint4 o;
  o.x = pk2(bf2f((u16)(v.x & 0xffff)) + pp[0], bf2f((u16)(v.x >> 16)) + pp[1]);
  o.y = pk2(bf2f((u16)(v.y & 0xffff)) + pp[2], bf2f((u16)(v.y >> 16)) + pp[3]);
  o.z = pk2(bf2f((u16)(v.z & 0xffff)) + pp[4], bf2f((u16)(v.z >> 16)) + pp[5]);
  o.w = pk2(bf2f((u16)(v.w & 0xffff)) + pp[6], bf2f((u16)(v.w >> 16)) + pp[7]);
  return o;
}
template <int NTW>
DI void gemm2(f32x4 (&acc)[4][NTW], const u16* __restrict__ arow, long a_kstep, const float* __restrict__ apos,
              const u16* __restrict__ brow, int K, u16* sA, u16* sB) {
  constexpr int BN = 32 * NTW, BV = BN / 32, LS = 80;
  const int tid = TID(), lane = tid & 63, w = tid >> 6, r16 = lane & 15, quad = lane >> 4;
  const int wm = w >> 1, wn = w & 1;
  u16* sa_st = sA + (tid >> 1) * LS + (tid & 1) * 32;
  u16* sb_st = (BN == 128) ? (sB + (tid >> 1) * LS + (tid & 1) * 32) : (sB + (tid >> 2) * LS + (tid & 3) * 16);
  uint4 pa0, pa1, pa2, pa3, pb0, pb1, pb2, pb3;
  uint4 qa0, qa1, qa2, qa3, qb0, qb1, qb2, qb3;
  pb2 = make_uint4(0, 0, 0, 0); pb3 = pb2; qb2 = pb2; qb3 = pb2;
#define G2_LOAD(KT, a0, a1, a2, a3, b0, b1, b2, b3) { const uint4* pa_ = (const uint4*)(arow + (long)(KT) * a_kstep); \
    a0 = pa_[0]; a1 = pa_[1]; a2 = pa_[2]; a3 = pa_[3]; \
    if (apos) { const float* pp_ = apos + (KT) * 64 + (tid & 1) * 32; \
      a0 = addpos8(a0, pp_); a1 = addpos8(a1, pp_ + 8); a2 = addpos8(a2, pp_ + 16); a3 = addpos8(a3, pp_ + 24); } \
    const uint4* pb_ = (const uint4*)(brow + (long)(KT) * 64); \
    b0 = pb_[0]; b1 = pb_[1]; if (BV == 4) { b2 = pb_[2]; b3 = pb_[3]; } }
#define G2_STORE(a0, a1, a2, a3, b0, b1, b2, b3) { \
    ((uint4*)sa_st)[0] = a0; ((uint4*)sa_st)[1] = a1; ((uint4*)sa_st)[2] = a2; ((uint4*)sa_st)[3] = a3; \
    ((uint4*)sb_st)[0] = b0; ((uint4*)sb_st)[1] = b1; if (BV == 4) { ((uint4*)sb_st)[2] = b2; ((uint4*)sb_st)[3] = b3; } }
#define G2_COMPUTE() { _Pragma("unroll") for (int ks = 0; ks < 2; ++ks) { \
      bf16x8 af[4], bg[NTW]; \
      _Pragma("unroll") for (int mi = 0; mi < 4; ++mi) af[mi] = *(const bf16x8*)(sA + (wm * 64 + 16 * mi + r16) * LS + ks * 32 + quad * 8); \
      _Pragma("unroll") for (int ni = 0; ni < NTW; ++ni) bg[ni] = *(const bf16x8*)(sB + (wn * (BN / 2) + 16 * ni + r16) * LS + ks * 32 + quad * 8); \
      _Pragma("unroll") for (int mi = 0; mi < 4; ++mi) \
        _Pragma("unroll") for (int ni = 0; ni < NTW; ++ni) acc[mi][ni] = __builtin_amdgcn_mfma_f32_16x16x32_bf16(af[mi], bg[ni], acc[mi][ni], 0, 0, 0); } }
#pragma unroll
  for (int mi = 0; mi < 4; ++mi)
#pragma unroll
    for (int ni = 0; ni < NTW; ++ni) acc[mi][ni] = (f32x4){0.f, 0.f, 0.f, 0.f};
  const int nk = K >> 6;
  G2_LOAD(0, pa0, pa1, pa2, pa3, pb0, pb1, pb2, pb3)
  G2_LOAD(1, qa0, qa1, qa2, qa3, qb0, qb1, qb2, qb3)
#pragma unroll 1
  for (int kt = 0; kt < nk; kt += 2) {
    __syncthreads();
    G2_STORE(pa0, pa1, pa2, pa3, pb0, pb1, pb2, pb3)
    __syncthreads();
    if (kt + 2 < nk) G2_LOAD(kt + 2, pa0, pa1, pa2, pa3, pb0, pb1, pb2, pb3)
    G2_COMPUTE()
    __syncthreads();
    G2_STORE(qa0, qa1, qa2, qa3, qb0, qb1, qb2, qb3)
    __syncthreads();
    if (kt + 3 < nk) G2_LOAD(kt + 3, qa0, qa1, qa2, qa3, qb0, qb1, qb2, qb3)
    G2_COMPUTE()
  }
#undef G2_LOAD
#undef G2_STORE
#undef G2_COMPUTE
}
DI void g3_rowpiece(int tid, int q, bool n64, int& row, int& pc) {
  const int w = tid >> 6, lane = tid & 63, chunk = n64 ? (2 * w + q) : (4 * w + q);
  row = 8 * chunk + (lane >> 3);
  pc = (lane & 7) ^ ((row >> 1) & 7);
}
DI const u16* g3_ptr(const u16* base, long ld, int tid, int q, bool n64) {
  int row, pc; g3_rowpiece(tid, q, n64, row, pc);
  return base + (long)row * ld + pc * 8;
}
template <int NTW, bool LEAN = false>
DI void gemm3(f32x4 (&acc)[4][NTW], const u16* ap0, const u16* ap1, const u16* ap2, const u16* ap3, long a_kstep,
              const u16* bp0, const u16* bp1, const u16* bp2, const u16* bp3, int K, u16* sbase, long a16 = 0, long b16 = 0) {
  constexpr int BN = 32 * NTW, STAGE = 16384;
  const int tid = TID(), lane = tid & 63, w = tid >> 6, r16 = lane & 15, quad = lane >> 4;
  const int wm = w >> 1, wn = w & 1;
  const int sz = (r16 >> 1) & 7;
  const int wu = __builtin_amdgcn_readfirstlane(w);
#define G3_GLDS(GP, LOFF) asm volatile("s_mov_b32 m0, %1\n\ts_nop 0\n\tglobal_load_lds_dwordx4 %0, off" :: "v"(GP), "s"(LOFF) : "memory", "m0")
  const unsigned lds0 = (unsigned)(size_t)sbase;
#define G3_ISSUE(KT) { const unsigned st_ = lds0 + (((KT) & 1) ? STAGE * 2 : 0); const long ka_ = (long)(KT) * a_kstep, kb_ = (long)(KT) * 64; \
    if (BN == 128) { \
      const unsigned la_ = __builtin_amdgcn_readfirstlane(st_ + wu * 4096u); \
      G3_GLDS(ap0 + ka_, la_); G3_GLDS(ap1 + ka_, la_ + 1024u); \
      if (a16) { G3_GLDS(ap0 + (ka_ + a16), la_ + 2048u); G3_GLDS(ap1 + (ka_ + a16), la_ + 3072u); } else { G3_GLDS(ap2 + ka_, la_ + 2048u); G3_GLDS(ap3 + ka_, la_ + 3072u); } \
      G3_GLDS(bp0 + kb_, la_ + 16384u); G3_GLDS(bp1 + kb_, la_ + 17408u); \
      if (b16) { G3_GLDS(bp0 + (kb_ + b16), la_ + 18432u); G3_GLDS(bp1 + (kb_ + b16), la_ + 19456u); } else { G3_GLDS(bp2 + kb_, la_ + 18432u); G3_GLDS(bp3 + kb_, la_ + 19456u); } \
    } else { \
      const unsigned la_ = __builtin_amdgcn_readfirstlane(st_ + wu * 4096u); \
      const unsigned lb_ = __builtin_amdgcn_readfirstlane(st_ + 16384u + wu * 2048u); \
      G3_GLDS(ap0 + ka_, la_); G3_GLDS(ap1 + ka_, la_ + 1024u); G3_GLDS(ap2 + ka_, la_ + 2048u); G3_GLDS(ap3 + ka_, la_ + 3072u); \
      G3_GLDS(bp0 + kb_, lb_); G3_GLDS(bp1 + kb_, lb_ + 1024u); \
    } }
#pragma unroll
  for (int mi = 0; mi < 4; ++mi)
#pragma unroll
    for (int ni = 0; ni < NTW; ++ni) acc[mi][ni] = (f32x4){0.f, 0.f, 0.f, 0.f};
  const int nk = K >> 6;
  __syncthreads();
  G3_ISSUE(0)
#pragma unroll 1
  for (int kt = 0; kt < nk; ++kt) {
    asm volatile("s_waitcnt vmcnt(0) lgkmcnt(0)" ::: "memory");
    __builtin_amdgcn_s_barrier();
    asm volatile("" ::: "memory");
    if (kt + 1 < nk) G3_ISSUE(kt + 1)
    const u16* sAs = sbase + (kt & 1) * STAGE;
    const u16* sBs = sAs + 8192;
#pragma unroll 1
    for (int ks = 0; ks < (LEAN ? 2 : 0); ++ks) {
      const int pcol = ((ks * 4 + quad) ^ sz) * 8;
      bf16x8 af[4];
#pragma unroll
      for (int mi = 0; mi < 4; ++mi) af[mi] = *(const bf16x8*)(sAs + (wm * 64 + 16 * mi + r16) * 64 + pcol);
#pragma unroll
      for (int ni = 0; ni < NTW; ++ni) {
        bf16x8 b1 = *(const bf16x8*)(sBs + (wn * (BN / 2) + 16 * ni + r16) * 64 + pcol);
#pragma unroll
        for (int mi = 0; mi < 4; ++mi) acc[mi][ni] = __builtin_amdgcn_mfma_f32_16x16x32_bf16(af[mi], b1, acc[mi][ni], 0, 0, 0);
      }
    }
#pragma unroll
    for (int ks = 0; ks < (LEAN ? 0 : 2); ++ks) {
      const int pcol = ((ks * 4 + quad) ^ sz) * 8;
      bf16x8 af[4], bg[NTW];
#pragma unroll
      for (int mi = 0; mi < 4; ++mi) af[mi] = *(const bf16x8*)(sAs + (wm * 64 + 16 * mi + r16) * 64 + pcol);
#pragma unroll
      for (int ni = 0; ni < NTW; ++ni) bg[ni] = *(const bf16x8*)(sBs + (wn * (BN / 2) + 16 * ni + r16) * 64 + pcol);
#pragma unroll
      for (int mi = 0; mi < 4; ++mi)
#pragma unroll
        for (int ni = 0; ni < NTW; ++ni) acc[mi][ni] = __builtin_amdgcn_mfma_f32_16x16x32_bf16(af[mi], bg[ni], acc[mi][ni], 0, 0, 0);
    }
  }
#undef G3_ISSUE
#undef G3_GLDS
}
DI int g5_sw(int row) { const int q = (row >> 2) & 3; return (q == 0) ? 0 : (q == 1) ? 2 : (q == 2) ? 3 : 1; }
DI void gemm5(f32x4 (&acc)[8][4], const u16* Abase, long lda, const u16* Bbase, long ldb, int K, u16* sbase) {
  const int tid = TID(), lane = tid & 63, w = tid >> 6, r16 = lane & 15, quad = lane >> 4;
  const int wm = w >> 1, wn = w & 1;
  const int lrow = lane >> 2, pcs = ((lane & 3) ^ g5_sw(lrow)) * 8;
  const u16* ap = Abase + (long)(64 * w + lrow) * lda + pcs;
  const u16* bp = Bbase + (long)(32 * w + lrow) * ldb + pcs;
  const long a16 = 16 * lda, b16 = 16 * ldb;
  const int pcol = (quad ^ g5_sw(r16)) * 8;
  const unsigned lds0 = (unsigned)(size_t)sbase;
  const unsigned la0 = __builtin_amdgcn_readfirstlane(lds0 + (unsigned)w * 4096u);
  const unsigned lb0 = __builtin_amdgcn_readfirstlane(lds0 + 16384u + (unsigned)w * 2048u);
#define G5_GLDS(GP, LOFF) asm volatile("s_mov_b32 m0, %1\n\ts_nop 0\n\tglobal_load_lds_dwordx4 %0, off" :: "v"(GP), "s"(LOFF) : "memory", "m0")
#define G5_ISSUE(KT) { const unsigned so_ = ((KT) & 1) ? 24576u : 0u; const long ko_ = (long)(KT) * 32; \
    G5_GLDS(ap + ko_, la0 + so_); G5_GLDS(ap + (ko_ + a16), la0 + so_ + 1024u); G5_GLDS(ap + (ko_ + 2 * a16), la0 + so_ + 2048u); G5_GLDS(ap + (ko_ + 3 * a16), la0 + so_ + 3072u); \
    G5_GLDS(bp + ko_, lb0 + so_); G5_GLDS(bp + (ko_ + b16), lb0 + so_ + 1024u); }
#pragma unroll
  for (int mi = 0; mi < 8; ++mi)
#pragma unroll
    for (int ni = 0; ni < 4; ++ni) acc[mi][ni] = (f32x4){0.f, 0.f, 0.f, 0.f};
  const int nk = K >> 5;
  __syncthreads();
  G5_ISSUE(0)
#pragma unroll 1
  for (int kt = 0; kt < nk; ++kt) {
    asm volatile("s_waitcnt vmcnt(0) lgkmcnt(0)" ::: "memory");
    __builtin_amdgcn_s_barrier();
    asm volatile("" ::: "memory");
    if (kt + 1 < nk) G5_ISSUE(kt + 1)
    const u16* sAs = sbase + (kt & 1) * 12288;
    const u16* sBs = sAs + 8192;
    bf16x8 bg[4];
#pragma unroll
    for (int ni = 0; ni < 4; ++ni) bg[ni] = *(const bf16x8*)(sBs + (wn * 64 + 16 * ni + r16) * 32 + pcol);
#pragma unroll
    for (int mi = 0; mi < 8; ++mi) {
      const bf16x8 af = *(const bf16x8*)(sAs + (wm * 128 + 16 * mi + r16) * 32 + pcol);
#pragma unroll
      for (int ni = 0; ni < 4; ++ni) acc[mi][ni] = __builtin_amdgcn_mfma_f32_16x16x32_bf16(af, bg[ni], acc[mi][ni], 0, 0, 0);
    }
  }
#undef G5_GLDS
#undef G5_ISSUE
}
DI void tile_from_q256(int it, int numN, int& mt, int& nt) {
  const int per = 16 * numN, q = it / per, i = it % per, g = i / (4 * numN), rem = i % (4 * numN);
  nt = rem >> 2; mt = 16 * q + 4 * g + (rem & 3);
}
template <int NCOLS>
DI void store_tile_bf16(const u16* sC, u16* gdst, long ld, int rows_valid) {
  constexpr int CPR = NCOLS / 8, LS = NCOLS + 8;
  const int tid = TID();
#pragma unroll
  for (int q = 0; q < (128 * CPR) / 256; ++q) {
    const int c = tid + 256 * q, row = c / CPR, ch = c % CPR;
    if (row < rows_valid) *(uint4*)(gdst + (long)row * ld + ch * 8) = *(const uint4*)(sC + row * LS + ch * 8);
  }
}
DI int pair_col(int np, int& which) {
  const int nt = np >> 7, c = np & 127, wn = c >> 6, ni = (c >> 4) & 3, r = c & 15;
  which = ni >> 1;
  return nt * 64 + wn * 32 + (ni & 1) * 16 + r;
}
DI const float* conv_colptr(const Params& P, int l, int mat, int np, long& ld) {
  int which;
  switch (mat) {
    case 0: ld = DIN; return PIN(P, 3) + (long)l * DM * DIN + proj_src_col(np);
    case 1: ld = DIN; return PIN(P, 3) + (long)l * DM * DIN + 2708 + np;
    case 2: ld = DM; return PIN(P, 24) + ((long)(l * 4 + (np >> 10)) * 256) * DM + (np & 1023);
    case 3: ld = DM; return PIN(P, 25) + (long)l * DM * DM + np;
    case 4: { int o = pair_col(np, which); ld = DFF; return (which ? PIN(P, 28) : PIN(P, 27)) + (long)l * DM * DFF + o; }
    case 5: ld = DM; return PIN(P, 29) + (long)l * DFF * DM + np;
    case 6: { int o = pair_col(np, which); ld = 512; return PIN(P, 19) + (long)l * 256 * 512 + which * 256 + o; }
    case 7: ld = 256; return PIN(P, (np >> 8) ? 9 : 7) + (long)l * 2048 * 256 + (np & 255);
    default: ld = 64; return PIN(P, (np >> 6) ? 10 : 8) + (long)l * 256 * 64 + (np & 63);
  }
}
DI void phase_convert(const Params& P, int l, float* lds) {
  const int tid = TID();
  if (blockIdx.x < 64) {
    const int kv = blockIdx.x >> 5, ks = blockIdx.x & 31;
    const float* pos = PIN(P, 6) + (long)(l * 2 + kv) * 2048 + ks * 64;
    const float* w1 = PIN(P, kv ? 9 : 7) + (long)l * 2048 * 256 + (long)ks * 64 * 256 + tid;
    float a = 0.f;
#pragma unroll 8
    for (int k = 0; k < 64; ++k) a += pos[k] * w1[(long)k * 256];
    ((float*)(WSP(P) + WS_CBIAS))[(kv * 32 + ks) * 256 + tid] = a;
  }
  const int NB_[9] = {44, 64, 64, 16, 88, 16, 8, 8, 2};
  const int KB_[9] = {16, 16, 4, 16, 16, 44, 4, 32, 4};
  const size_t OFF_[9] = {WT_IN, WT_G, WT_BR, WT_OUT, WT_GU, WT_D, WT_GLU, WT_C1, WT_C2};
  for (int it = blockIdx.x; it < 4648; it += gridDim.x) {
    int r = it, mat = 0, nbk = 0, kbk = 0; size_t off = 0;
#pragma unroll
    for (int q = 0; q < 9; ++q) { int n = NB_[q] * KB_[q]; if (r >= 0 && r < n) { mat = q; nbk = NB_[q]; kbk = KB_[q]; off = OFF_[q]; r -= 100000; } else if (r >= 0) r -= n; }
    r += 100000;
    const int nb = r / kbk, kb = r % kbk, K = kbk * 64;
    (void)nbk;
    __syncthreads();
    {
      const int n = tid & 63;
      long ld; const float* cp = conv_colptr(P, l, mat, nb * 64 + n, ld);
#pragma unroll 4
      for (int q = 0; q < 16; ++q) { int k = (tid >> 6) + 4 * q; lds[n * 65 + k] = cp[(long)(kb * 64 + k) * ld]; }
    }
    __syncthreads();
    u16* dst = (u16*)(WSP(P) + WS_W + off);
#pragma unroll
    for (int q = 0; q < 2; ++q) {
      int c = tid + 256 * q, n = c >> 3, k8 = (c & 7) * 8;
      const float* sp = lds + n * 65 + k8;
      uint4 v; v.x = pk2(sp[0], sp[1]); v.y = pk2(sp[2], sp[3]); v.z = pk2(sp[4], sp[5]); v.w = pk2(sp[6], sp[7]);
      *(uint4*)(dst + (long)(nb * 64 + n) * K + kb * 64 + k8) = v;
    }
  }
}

DI void st_mma(f32x4 (&st)[4], const u16* sK, const bf16x8 (&bq)[2], int lane) {
  const int r = lane & 15, quad = lane >> 4;
#pragma unroll
  for (int mt = 0; mt < 4; ++mt) {
    f32x4 a = {0.f, 0.f, 0.f, 0.f};
#pragma unroll
    for (int ks = 0; ks < 2; ++ks) {
      bf16x8 kf = *(const bf16x8*)(sK + (16 * mt + r) * 72 + ks * 32 + quad * 8);
      a = __builtin_amdgcn_mfma_f32_16x16x32_bf16(kf, bq[ks], a, 0, 0, 0);
    }
    st[mt] = a;
  }
}
DI void pv_mma(f32x4 (&ot)[4], const u16* sVt, const f32x4 (&p)[4], int lane) {
  const int r = lane & 15, quad = lane >> 4;
#pragma unroll
  for (int ks = 0; ks < 2; ++ks) {
    uint4 pu;
    pu.x = pk2(p[2 * ks][0], p[2 * ks][1]); pu.y = pk2(p[2 * ks][2], p[2 * ks][3]);
    pu.z = pk2(p[2 * ks + 1][0], p[2 * ks + 1][1]); pu.w = pk2(p[2 * ks + 1][2], p[2 * ks + 1][3]);
    bf16x8 pb = __builtin_bit_cast(bf16x8, pu);
#pragma unroll
    for (int dt = 0; dt < 4; ++dt) {
      const u16* vrow = sVt + (16 * dt + r) * 72;
      s16x4 lo = *(const s16x4*)(vrow + ((32 * ks + 4 * quad) ^ (16 * dt)));
      s16x4 hi = *(const s16x4*)(vrow + ((32 * ks + 16 + 4 * quad) ^ (16 * dt)));
      bf16x8 vf = __builtin_shufflevector(lo, hi, 0, 1, 2, 3, 4, 5, 6, 7);
      ot[dt] = __builtin_amdgcn_mfma_f32_16x16x32_bf16(vf, pb, ot[dt], 0, 0, 0);
    }
  }
}
DI void load_tile(u16* dst, const u16* src, long ld) {
  const int tid = TID();
#pragma unroll
  for (int i = 0; i < 2; ++i) {
    int c = tid + 256 * i, row = c >> 3, ch = c & 7;
    uint4 v = *(const uint4*)(src + (long)row * ld + ch * 8);
    *(uint4*)(dst + row * 72 + ch * 8) = v;
  }
}
DI void load_tile_T(u16* dst, const u16* src, long ld) {
  const int tid = TID();
#pragma unroll
  for (int i = 0; i < 2; ++i) {
    int c = tid + 256 * i, row = c >> 3, ch = c & 7;
    uint4 v = *(const uint4*)(src + (long)row * ld + ch * 8);
    const unsigned* vv = (const unsigned*)&v;
#pragma unroll
    for (int q = 0; q < 4; ++q) {
      dst[(ch * 8 + 2 * q) * 72 + row] = (u16)(vv[q] & 0xffff);
      dst[(ch * 8 + 2 * q + 1) * 72 + row] = (u16)(vv[q] >> 16);
    }
  }
}
DI void load_q_nsa(u16* dst, const u16* src, long ld) {
  const int tid = TID();
#pragma unroll
  for (int i = 0; i < 2; ++i) {
    int c = tid + 256 * i, row = c >> 3, ch = c & 7;
    uint4 v = *(const uint4*)(src + (long)(row & 15) * ld + (row >> 4) * 64 + ch * 8);
    *(uint4*)(dst + row * 72 + ch * 8) = v;
  }
}
DI void load_qfrag(bf16x8 (&bq)[2], const u16* sQ, int w, int lane) {
  const int r = lane & 15, quad = lane >> 4;
  bq[0] = *(const bf16x8*)(sQ + (16 * w + r) * 72 + quad * 8);
  bq[1] = *(const bf16x8*)(sQ + (16 * w + r) * 72 + 32 + quad * 8);
}
DI float quad_max(float v) { v = fmaxf(v, __shfl_xor(v, 16)); v = fmaxf(v, __shfl_xor(v, 32)); return v; }
DI float quad_sum(float v) { v += __shfl_xor(v, 16); v += __shfl_xor(v, 32); return v; }

DI void softmax_tile(f32x4 (&st)[4], const bool (&msk)[4][4], float& m, float& l, f32x4 (&ot)[4]) {
  float tm = -1e30f;
#pragma unroll
  for (int mt = 0; mt < 4; ++mt)
#pragma unroll
    for (int j = 0; j < 4; ++j) { float s = st[mt][j] * 0.125f; st[mt][j] = s; if (msk[mt][j]) tm = fmaxf(tm, s); }
  tm = quad_max(tm);
  float mn = fmaxf(m, tm);
  float alpha = __expf(m - mn);
  float ps = 0.f;
#pragma unroll
  for (int mt = 0; mt < 4; ++mt)
#pragma unroll
    for (int j = 0; j < 4; ++j) { float p = msk[mt][j] ? __expf(st[mt][j] - mn) : 0.f; st[mt][j] = p; ps += p; }
  l = l * alpha + ps;
  m = mn;
#pragma unroll
  for (int dt = 0; dt < 4; ++dt)
#pragma unroll
    for (int j = 0; j < 4; ++j) ot[dt][j] *= alpha;
}

DI void phase_rmsnorm(const float* __restrict__ x, const float* __restrict__ wgt, u16* __restrict__ H) {
  const int lane = TID() & 63, w = TID() >> 6;
  const int gw = blockIdx.x * 4 + w, nw = gridDim.x * 4;
  for (int row = gw; row < T_; row += nw) {
    const float4* xr = (const float4*)(x + (long)row * DM);
    float4 v[4]; float s = 0.f;
#pragma unroll
    for (int j = 0; j < 4; ++j) { v[j] = xr[lane + 64 * j]; s += v[j].x * v[j].x + v[j].y * v[j].y + v[j].z * v[j].z + v[j].w * v[j].w; }
    s = wave_sum(s);
    float r = rsqrtf(s * (1.f / DM) + EPS);
#pragma unroll
    for (int j = 0; j < 4; ++j) {
      float4 g = ((const float4*)wgt)[lane + 64 * j];
      uint2 o; o.x = pk2(v[j].x * r * g.x, v[j].y * r * g.y); o.y = pk2(v[j].z * r * g.z, v[j].w * r * g.w);
      *(uint2*)(H + (long)row * DM + (lane + 64 * j) * 4) = o;
    }
  }
}
DI void phase_rope_table(const int* __restrict__ positions, float* __restrict__ COS, float* __restrict__ SIN) {
  const float invf[8] = {1.0f, 0.1939227432012558f, 0.03760603070259094f, 0.007292664609849453f,
                         0.0014142135623842478f, 0.00027424818836152554f, 5.3182957344688475e-05f, 1.0313385246263351e-05f};
  for (int idx = blockIdx.x * 256 + TID(); idx < T_ * 8; idx += gridDim.x * 256) {
    int i = idx & 7;
    float f = invf[0];
#pragma unroll
    for (int q = 1; q < 8; ++q) f = (i == q) ? invf[q] : f;
    float ang = (float)positions[idx >> 3] * f;
    double s, c; sincos_d((double)ang, s, c);
    COS[idx] = (float)c; SIN[idx] = (float)s;
  }
}

struct S5Coef { float ar, ai; float bbr[16], bbi[16]; };
DI void s5_coef(const Params& P, int l, int g, int p, S5Coef& C) {
  float dt = expf(PIN(P, 13)[l * 16 + g]);
  float lr = PIN(P, 11)[(l * 16 + g) * 64 + p], li = PIN(P, 12)[(l * 16 + g) * 64 + p];
  float mag = expf(lr * dt);
  double s, c; sincos_d((double)(li * dt), s, c);
  C.ar = mag * (float)c; C.ai = mag * (float)s;
  float den = lr * lr + li * li;
  float fr = ((C.ar - 1.f) * lr + C.ai * li) / den;
  float fi = (C.ai * lr - (C.ar - 1.f) * li) / den;
  const float* br = PIN(P, 14) + ((long)(l * 16 + g) * 64 + p) * 16;
  const float* bi = PIN(P, 15) + ((long)(l * 16 + g) * 64 + p) * 16;
#pragma unroll
  for (int c2 = 0; c2 < 16; ++c2) {
    float b_r = br[c2], b_i = bi[c2];
    C.bbr[c2] = fr * b_r - fi * b_i;
    C.bbi[c2] = fr * b_i + fi * b_r;
  }
}
DI void s5_load_u(float* su, const u16* PROJ, int b, int chunk, int g, int lane) {
  const u16* src = PROJ + ((long)(b * SEQ + chunk * 64 + lane)) * PW + P_S5U + g * 16;
  uint4 v0 = ((const uint4*)src)[0], v1 = ((const uint4*)src)[1];
  const unsigned* a = (const unsigned*)&v0; const unsigned* c = (const unsigned*)&v1;
  float* d = su + lane * 16;
#pragma unroll
  for (int q = 0; q < 4; ++q) { d[2 * q] = bf2f((u16)(a[q] & 0xffff)); d[2 * q + 1] = bf2f((u16)(a[q] >> 16)); }
#pragma unroll
  for (int q = 0; q < 4; ++q) { d[8 + 2 * q] = bf2f((u16)(c[q] & 0xffff)); d[8 + 2 * q + 1] = bf2f((u16)(c[q] >> 16)); }
}

DI void s5_pass1_item(const Params& P, int l, int it, float* lds) {
  const int lane = TID() & 63, w = TID() >> 6;
  const int gq = it & 3, chunk = (it >> 2) & 63, b = it >> 8;
  const int g = gq * 4 + w;
  const u16* PROJ = (const u16*)(WSP(P) + WS_PROJ);
  float* su = lds + w * 1024;
  S5Coef C; s5_coef(P, l, g, lane, C);
  s5_load_u(su, PROJ, b, chunk, g, lane);
  __syncthreads();
  float xr = 0.f, xi = 0.f;
#pragma unroll 4
  for (int t = 0; t < 64; ++t) {
    const f32x4* up = (const f32x4*)(su + t * 16);
    float br = 0.f, bi = 0.f;
#pragma unroll
    for (int q = 0; q < 4; ++q) {
      f32x4 u = up[q];
#pragma unroll
      for (int e = 0; e < 4; ++e) { br += u[e] * C.bbr[4 * q + e]; bi += u[e] * C.bbi[4 * q + e]; }
    }
    float nr = C.ar * xr - C.ai * xi + br;
    float ni = C.ar * xi + C.ai * xr + bi;
    xr = nr; xi = ni;
  }
  float2* ENDS = (float2*)(WSP(P) + WS_ENDS);
  ENDS[((long)(b * 64 + chunk) * 16 + g) * 64 + lane] = make_float2(xr, xi);
}

DI void s5_carry_item(const Params& P, int l, int it) {
  const int idx = it * 256 + TID();
  const int b = idx >> 10, gp = idx & 1023, g = gp >> 6, p = gp & 63;
  float dt = expf(PIN(P, 13)[l * 16 + g]);
  float lr = PIN(P, 11)[(l * 16 + g) * 64 + p], li = PIN(P, 12)[(l * 16 + g) * 64 + p];
  float mag = expf(lr * dt * 64.f);
  double s, c; sincos_d((double)(li * dt) * 64.0, s, c);
  float ar = mag * (float)c, ai = mag * (float)s;
  const float2* ENDS = (const float2*)(WSP(P) + WS_ENDS);
  float2* CARRY = (float2*)(WSP(P) + WS_CARRY);
  float xr = 0.f, xi = 0.f;
  for (int ch = 0; ch < 64; ++ch) {
    long o = ((long)(b * 64 + ch) * 16 + g) * 64 + p;
    CARRY[o] = make_float2(xr, xi);
    float2 e = ENDS[o];
    float nr = ar * xr - ai * xi + e.x;
    float ni = ar * xi + ai * xr + e.y;
    xr = nr; xi = ni;
  }
}

DI void s5_pass2_item(const Params& P, int l, int it, float* lds) {
  const int lane = TID() & 63, w = TID() >> 6, r16 = lane & 15, quad = lane >> 4;
  const int gq = it & 3, chunk = (it >> 2) & 63, b = it >> 8;
  const int g = gq * 4 + w;
  const u16* PROJ = (const u16*)(WSP(P) + WS_PROJ);
  u16* Y5 = (u16*)(WSP(P) + WS_Y5);
  float* su = lds + w * 1024;
  u16* sX = (u16*)(lds + 4096) + w * (32 * 136);
  S5Coef C; s5_coef(P, l, g, lane, C);
  bf16x8 bfr[4];
#pragma unroll
  for (int ks = 0; ks < 4; ++ks) {
    const float* src = PIN(P, (ks < 2) ? 16 : 17) + ((long)(l * 16 + g) * 16 + r16) * 64 + (ks & 1) * 32 + quad * 8;
    const float4 v0 = ((const float4*)src)[0], v1 = ((const float4*)src)[1];
    const float sg = (ks < 2) ? 1.f : -1.f;
    uint4 pu; pu.x = pk2(sg * v0.x, sg * v0.y); pu.y = pk2(sg * v0.z, sg * v0.w); pu.z = pk2(sg * v1.x, sg * v1.y); pu.w = pk2(sg * v1.z, sg * v1.w);
    bfr[ks] = __builtin_bit_cast(bf16x8, pu);
  }
  const float dsk = PIN(P, 18)[l * 256 + g * 16 + r16];
  s5_load_u(su, PROJ, b, chunk, g, lane);
  __syncthreads();
  const float2 c0 = ((const float2*)(WSP(P) + WS_CARRY))[((long)(b * 64 + chunk) * 16 + g) * 64 + lane];
  float xr = c0.x, xi = c0.y;
  for (int half = 0; half < 2; ++half) {
#pragma unroll 4
    for (int tt = 0; tt < 32; ++tt) {
      const int t = half * 32 + tt;
      const f32x4* up = (const f32x4*)(su + t * 16);
      float br0 = 0.f, bi0 = 0.f, br1 = 0.f, bi1 = 0.f;
#pragma unroll
      for (int q = 0; q < 4; ++q) {
        f32x4 u = up[q];
        br0 += u[0] * C.bbr[4 * q + 0]; bi0 += u[0] * C.bbi[4 * q + 0];
        br1 += u[1] * C.bbr[4 * q + 1]; bi1 += u[1] * C.bbi[4 * q + 1];
        br0 += u[2] * C.bbr[4 * q + 2]; bi0 += u[2] * C.bbi[4 * q + 2];
        br1 += u[3] * C.bbr[4 * q + 3]; bi1 += u[3] * C.bbi[4 * q + 3];
      }
      const float nr = C.ar * xr - C.ai * xi + (br0 + br1);
      const float ni = C.ar * xi + C.ai * xr + (bi0 + bi1);
      xr = nr; xi = ni;
      sX[tt * 136 + lane] = f2bf(xr);
      sX[tt * 136 + 64 + lane] = f2bf(xi);
    }
    __syncthreads();
#pragma unroll
    for (int mt = 0; mt < 2; ++mt) {
      f32x4 acc = {0.f, 0.f, 0.f, 0.f};
#pragma unroll
      for (int ks = 0; ks < 4; ++ks) {
        const bf16x8 af = *(const bf16x8*)(sX + (16 * mt + r16) * 136 + ks * 32 + quad * 8);
        acc = __builtin_amdgcn_mfma_f32_16x16x32_bf16(af, bfr[ks], acc, 0, 0, 0);
      }
#pragma unroll
      for (int j = 0; j < 4; ++j) {
        const int t = half * 32 + 16 * mt + 4 * quad + j;
        const float y = acc[j] + dsk * su[t * 16 + r16];
        Y5[((long)(b * SEQ + chunk * 64 + t)) * 256 + g * 16 + r16] = f2bf(gelu_tanh(y));
      }
    }
    __syncthreads();
  }
}

DI void nsa_prep_item(const Params& P, int l, int it) {
  const int lane = TID() & 63, w = TID() >> 6;
  u16* PROJ = (u16*)(WSP(P) + WS_PROJ);
  u16* QR = (u16*)(WSP(P) + WS_QR);
  const float* COS = (const float*)(WSP(P) + WS_COS);
  const float* SIN = (const float*)(WSP(P) + WS_SIN);
  for (int tt = 0; tt < 4; ++tt) {
    const long t = (long)it * 16 + w * 4 + tt;
    const float cs = COS[t * 8 + (lane & 7)], sn = SIN[t * 8 + (lane & 7)];
#pragma unroll
    for (int g = 0; g < 6; ++g) {
      const int col = (g < 4) ? (P_Q + g * 64) : (g == 4 ? P_KV + 128 : P_KV + 256);
      const float wg = (g < 4) ? PIN(P, 4)[l * 64 + lane] : PIN(P, 5)[(l * 3 + (g - 3)) * 64 + lane];
      u16* ptr = PROJ + t * PW + col + lane;
      float v = bf2f(*ptr);
      float ss = wave_sum(v * v);
      float y = v * rsqrtf(ss * (1.f / 64.f) + EPS) * wg;
      float pr = __shfl_xor(y, 8);
      float rot = (lane < 8) ? (y * cs - pr * sn) : ((lane < 16) ? (y * cs + pr * sn) : y);
      if (g < 4) { *ptr = f2bf(y); QR[t * 256 + g * 64 + lane] = f2bf(rot); }
      else *ptr = f2bf(rot);
    }
  }
}

DI void cmp1_tile(const Params& P, int l, int ct, u16* sA, u16* sB) {
  const int tid = TID(), lane = tid & 63, w = tid >> 6, r16 = lane & 15, quad = lane >> 4, wm = w >> 1, wn = w & 1;
  const int kv = ct >> 5, mt = (ct >> 1) & 15, nt = ct & 1;
  const u16* PROJ = (const u16*)(WSP(P) + WS_PROJ);
  u16* HID = (u16*)(WSP(P) + WS_HID);
  const u16* apq[4];
#pragma unroll
  for (int q = 0; q < 4; ++q) {
    int row, pc; g3_rowpiece(tid, q, false, row, pc);
    int gr = mt * 128 + row; if (gr > 2039) gr = 2039;
    const int b = gr / 255, n = gr % 255;
    apq[q] = PROJ + ((long)(b * SEQ + 16 * n)) * PW + P_KV + kv * 64 + pc * 8;
  }
  const u16* Bb = (const u16*)(WSP(P) + WS_W + WT_C1) + ((long)(kv * 256 + nt * 128)) * 2048;
  f32x4 acc[4][4];
  gemm3<4>(acc, apq[0], apq[1], apq[2], apq[3], PW,
           g3_ptr(Bb, 2048, tid, 0, false), g3_ptr(Bb, 2048, tid, 1, false), g3_ptr(Bb, 2048, tid, 2, false), g3_ptr(Bb, 2048, tid, 3, false), 2048, sA);
  {
    const float* PART = (const float*)(WSP(P) + WS_CBIAS) + (long)kv * 32 * 256;
#pragma unroll
    for (int ni = 0; ni < 4; ++ni) {
      const int col = nt * 128 + wn * 64 + 16 * ni + r16;
      float bsum = 0.f;
      for (int sl = 0; sl < 32; ++sl) bsum += PART[sl * 256 + col];
#pragma unroll
      for (int mi = 0; mi < 4; ++mi)
#pragma unroll
        for (int j = 0; j < 4; ++j) acc[mi][ni][j] += bsum;
    }
  }
  __syncthreads();
#pragma unroll
  for (int mi = 0; mi < 4; ++mi)
#pragma unroll
    for (int ni = 0; ni < 4; ++ni)
#pragma unroll
      for (int j = 0; j < 4; ++j) sA[(wm * 64 + 16 * mi + 4 * quad + j) * 136 + wn * 64 + 16 * ni + r16] = f2bf(gelu_tanh(acc[mi][ni][j]));
  __syncthreads();
  store_tile_bf16<128>(sA, HID + ((long)kv * 2048 + mt * 128) * 256 + nt * 128, 256, 2040 - mt * 128);
}
DI void cmp2_tile(const Params& P, int l, int ct, u16* sA, u16* sB, float* sSS) {
  const int tid = TID(), lane = tid & 63, w = tid >> 6, r16 = lane & 15, quad = lane >> 4, wm = w >> 1, wn = w & 1;
  const int kv = ct >> 4, mt = ct & 15;
  const u16* HID = (const u16*)(WSP(P) + WS_HID);
  u16* OUT = (u16*)(WSP(P) + (kv ? WS_VC : WS_KC));
  const u16* Ab = HID + ((long)kv * 2048 + mt * 128) * 256;
  const u16* Bb = (const u16*)(WSP(P) + WS_W + WT_C2) + (long)kv * 64 * 256;
  f32x4 acc[4][2];
  gemm3<2>(acc, g3_ptr(Ab, 256, tid, 0, false), g3_ptr(Ab, 256, tid, 1, false), g3_ptr(Ab, 256, tid, 2, false), g3_ptr(Ab, 256, tid, 3, false), 64,
           g3_ptr(Bb, 256, tid, 0, true), g3_ptr(Bb, 256, tid, 1, true), nullptr, nullptr, 256, sA);
  __syncthreads();
  if (tid < 128) sSS[tid] = 0.f;
  __syncthreads();
#pragma unroll
  for (int mi = 0; mi < 4; ++mi)
#pragma unroll
    for (int j = 0; j < 4; ++j) {
      float ss = acc[mi][0][j] * acc[mi][0][j] + acc[mi][1][j] * acc[mi][1][j];
      ss += __shfl_xor(ss, 1); ss += __shfl_xor(ss, 2); ss += __shfl_xor(ss, 4); ss += __shfl_xor(ss, 8);
      if (r16 == 0) atomicAdd(&sSS[wm * 64 + 16 * mi + 4 * quad + j], ss);
    }
  __syncthreads();
#pragma unroll
  for (int mi = 0; mi < 4; ++mi)
#pragma unroll
    for (int j = 0; j < 4; ++j) {
      const int rl = wm * 64 + 16 * mi + 4 * quad + j, row = mt * 128 + rl;
      const float sc = (kv == 0) ? rsqrtf(sSS[rl] * (1.f / 64.f) + EPS) : 1.f;
      if (row < 2040) {
        int b = row / 255, n = row % 255;
#pragma unroll
        for (int ni = 0; ni < 2; ++ni) {
          int col = wn * 32 + 16 * ni + r16;
          float v = acc[mi][ni][j] * sc;
          if (kv == 0) v *= PIN(P, 5)[(l * 3 + 0) * 64 + col];
          OUT[((long)(b * 256 + n)) * 64 + col] = f2bf(v);
        }
      }
    }
}

DI void gdn_p1_item(const Params& P, int l, int it, float* lds) {
  const int tid = TID(), lane = tid & 63, w = tid >> 6, r16 = lane & 15, quad = lane >> 4;
  const int chunk = it & 63, h = (it >> 6) & 3, b = it >> 8;
  const long ci = it;
  const u16* PROJ = (const u16*)(WSP(P) + WS_PROJ);
  float* sq = lds;
  float* sk = lds + 64 * 65;
  float* sv = lds + 2 * 64 * 65;
  float* sG = lds + 3 * 64 * 65;
  float* sBeta = sG + 64;
  float* sg = sBeta + 64;
  u16* sQb = (u16*)(sg + 64);
  u16* sKb = sQb + 64 * 72;
  const float* cw = PIN(P, 20) + (long)l * 4 * 768;
  if (tid < 192) {
    const int cp = tid % 96, th = tid / 96;
    const int c0 = 2 * cp, which = c0 >> 6, d = c0 & 63, C = which * 256 + h * 64 + d;
    float w0[4], w1[4];
#pragma unroll
    for (int k = 0; k < 4; ++k) { w0[k] = cw[k * 768 + C]; w1[k] = cw[k * 768 + C + 1]; }
    unsigned v[35];
    const int s0 = chunk * 64 + th * 32 - 3;
    const u16* src = PROJ + ((long)(b * SEQ + s0)) * PW + P_GQKV + C;
#pragma unroll
    for (int k = 0; k < 35; ++k) v[k] = (s0 + k >= 0) ? *(const unsigned*)(src + (long)k * PW) : 0u;
    float* dst = lds + which * 64 * 65 + (th * 32) * 65 + d;
#pragma unroll
    for (int tt = 0; tt < 32; ++tt) {
      float a0 = 0.f, a1 = 0.f;
#pragma unroll
      for (int k = 0; k < 4; ++k) { a0 += w0[k] * bf2f((u16)(v[tt + k] & 0xffff)); a1 += w1[k] * bf2f((u16)(v[tt + k] >> 16)); }
      dst[tt * 65] = siluf_(a0); dst[tt * 65 + 1] = siluf_(a1);
    }
  }
  __syncthreads();
  if (tid < 128) {
    float* base = (tid < 64) ? sq : sk;
    u16* bb = (tid < 64) ? sQb : sKb;
    const int row = tid & 63;
    float ss = 0.f;
#pragma unroll 8
    for (int d = 0; d < 64; ++d) { float x = base[row * 65 + d]; ss += x * x; }
    const float sc = rsqrtf(ss + EPS) * ((tid < 64) ? 0.125f : 1.f);
#pragma unroll 8
    for (int d = 0; d < 64; d += 2) {
      const float x0 = base[row * 65 + d] * sc, x1 = base[row * 65 + d + 1] * sc;
      base[row * 65 + d] = x0; base[row * 65 + d + 1] = x1;
      *(unsigned*)(bb + row * 72 + d) = pk2(x0, x1);
    }
  } else if (tid < 192) {
    const int row = tid - 128;
    const long t = (long)(b * SEQ + chunk * 64 + row);
    const float bl = bf2f(PROJ[t * PW + P_GB + h]);
    const float al = bf2f(PROJ[t * PW + P_GA + h]);
    sBeta[row] = sigmoidf_(bl);
    sg[row] = -expf(PIN(P, 21)[l * 4 + h]) * softplusf_(al + PIN(P, 22)[l * 4 + h]);
  }
  __syncthreads();
  if (tid < 64) {
    float x = sg[tid];
#pragma unroll
    for (int o = 1; o < 64; o <<= 1) { float u = __shfl_up(x, o); if (tid >= o) x += u; }
    sG[tid] = x;
    ((float*)(WSP(P) + WS_GG))[ci * 64 + tid] = x;
  }
  __syncthreads();
  f32x4 lreg[4];
  {
    const f32x4 Gi4 = *(const f32x4*)(sG + 16 * w + 4 * quad);
    const f32x4 Bi4 = *(const f32x4*)(sBeta + 16 * w + 4 * quad);
    u16* GA = (u16*)(WSP(P) + WS_GA) + ci * 4096;
#pragma unroll
    for (int nt = 0; nt < 4; ++nt) {
      f32x4 aq = {0.f, 0.f, 0.f, 0.f}, ak = {0.f, 0.f, 0.f, 0.f};
#pragma unroll
      for (int ks = 0; ks < 2; ++ks) {
        const bf16x8 fq = *(const bf16x8*)(sQb + (16 * w + r16) * 72 + ks * 32 + quad * 8);
        const bf16x8 fk = *(const bf16x8*)(sKb + (16 * w + r16) * 72 + ks * 32 + quad * 8);
        const bf16x8 fb = *(const bf16x8*)(sKb + (16 * nt + r16) * 72 + ks * 32 + quad * 8);
        aq = __builtin_amdgcn_mfma_f32_16x16x32_bf16(fq, fb, aq, 0, 0, 0);
        ak = __builtin_amdgcn_mfma_f32_16x16x32_bf16(fk, fb, ak, 0, 0, 0);
      }
      const int j = 16 * nt + r16;
      const float Gj = sG[j];
#pragma unroll
      for (int jj = 0; jj < 4; ++jj) {
        const int i = 16 * w + 4 * quad + jj;
        const float dec = __expf(Gi4[jj] - Gj);
        GA[i * 64 + j] = f2bf((j <= i) ? aq[jj] * dec : 0.f);
        const float lv = (j < i) ? Bi4[jj] * ak[jj] * dec : 0.f;
        sq[i * 65 + j] = lv;
        lreg[nt][jj] = lv;
      }
    }
  }
  {
    u16* GQ = (u16*)(WSP(P) + WS_GQ) + ci * 4096;
#pragma unroll
    for (int q = 0; q < 2; ++q) { const int c = tid + 256 * q, row = c >> 3, ch = c & 7; *(uint4*)(GQ + row * 64 + ch * 8) = *(const uint4*)(sQb + row * 72 + ch * 8); }
    const int i = tid >> 2, j0 = (tid & 3) * 16;
    u16* GK = (u16*)(WSP(P) + WS_GK) + ci * 4096 + i * 64 + j0;
    unsigned ok[8];
#pragma unroll
    for (int q = 0; q < 8; ++q) ok[q] = pk2(sk[(j0 + 2 * q) * 65 + i], sk[(j0 + 2 * q + 1) * 65 + i]);
    ((uint4*)GK)[0] = make_uint4(ok[0], ok[1], ok[2], ok[3]); ((uint4*)GK)[1] = make_uint4(ok[4], ok[5], ok[6], ok[7]);
  }
  __syncthreads();
  u16* sLb = sQb;
  u16* sXT = sKb;
  {
    const int i = tid >> 2, j0 = (tid & 3) * 16;
    const float bi = sBeta[i], eg = __expf(sG[i]);
#pragma unroll
    for (int jj = 0; jj < 16; ++jj) { sv[i * 65 + j0 + jj] *= bi; sk[i * 65 + j0 + jj] *= bi * eg; }
#pragma unroll
    for (int nt = 0; nt < 4; ++nt)
#pragma unroll
      for (int jj = 0; jj < 4; ++jj) sLb[(16 * w + 4 * quad + jj) * 72 + 16 * nt + r16] = f2bf(lreg[nt][jj]);
  }
  __syncthreads();
#pragma unroll 1
  for (int bi = 0; bi < 4; ++bi) {
    if (tid < 128) {
      float* buf = (tid < 64) ? sv : sk;
      const int col = tid & 63;
      float x[16];
#pragma unroll
      for (int r = 0; r < 16; ++r) {
        float a0 = buf[(16 * bi + r) * 65 + col], a1 = 0.f;
#pragma unroll
        for (int j = 0; j + 1 < r; j += 2) { a0 -= sq[(16 * bi + r) * 65 + 16 * bi + j] * x[j]; a1 -= sq[(16 * bi + r) * 65 + 16 * bi + j + 1] * x[j + 1]; }
        if (r & 1) a0 -= sq[(16 * bi + r) * 65 + 16 * bi + r - 1] * x[r - 1];
        x[r] = a0 + a1;
        buf[(16 * bi + r) * 65 + col] = x[r];
      }
      uint4 p0, p1;
      p0.x = pk2(x[0], x[1]); p0.y = pk2(x[2], x[3]); p0.z = pk2(x[4], x[5]); p0.w = pk2(x[6], x[7]);
      p1.x = pk2(x[8], x[9]); p1.y = pk2(x[10], x[11]); p1.z = pk2(x[12], x[13]); p1.w = pk2(x[14], x[15]);
      *(uint4*)(sXT + tid * 24) = p0; *(uint4*)(sXT + tid * 24 + 8) = p1;
    }
    __syncthreads();
    if (bi < 3) {
#pragma unroll
      for (int q = 0; q < 2; ++q) {
        const int nt = 2 * w + q, colg = 16 * nt + r16;
        bf16x8 bx = *(const bf16x8*)(sXT + colg * 24 + (quad & 1) * 8);
        if (quad >= 2) bx = (bf16x8){0, 0, 0, 0, 0, 0, 0, 0};
        float* buf = (colg < 64) ? sv : sk;
        const int cc = colg & 63;
        for (int bk = bi + 1; bk < 4; ++bk) {
          const bf16x8 al = *(const bf16x8*)(sLb + (16 * bk + r16) * 72 + 16 * bi + quad * 8);
          f32x4 c = {0.f, 0.f, 0.f, 0.f};
          c = __builtin_amdgcn_mfma_f32_16x16x32_bf16(al, bx, c, 0, 0, 0);
#pragma unroll
          for (int jj = 0; jj < 4; ++jj) buf[(16 * bk + 4 * quad + jj) * 65 + cc] -= c[jj];
        }
      }
    }
    __syncthreads();
  }
  {
    const int i = tid >> 2, j0 = (tid & 3) * 16;
    u16* GU = (u16*)(WSP(P) + WS_GU) + ci * 4096 + i * 64 + j0;
    u16* GW = (u16*)(WSP(P) + WS_GW) + ci * 4096 + i * 64 + j0;
    unsigned ou[8], ow[8];
#pragma unroll
    for (int q = 0; q < 8; ++q) {
      ou[q] = pk2(sv[i * 65 + j0 + 2 * q], sv[i * 65 + j0 + 2 * q + 1]);
      ow[q] = pk2(sk[i * 65 + j0 + 2 * q], sk[i * 65 + j0 + 2 * q + 1]);
    }
    ((uint4*)GU)[0] = make_uint4(ou[0], ou[1], ou[2], ou[3]); ((uint4*)GU)[1] = make_uint4(ou[4], ou[5], ou[6], ou[7]);
    ((uint4*)GW)[0] = make_uint4(ow[0], ow[1], ow[2], ow[3]); ((uint4*)GW)[1] = make_uint4(ow[4], ow[5], ow[6], ow[7]);
  }
}

DI void unpack8(const u16* p, float (&o)[8]) {
  uint4 v = *(const uint4*)p;
  o[0] = bf2f((u16)(v.x & 0xffff)); o[1] = bf2f((u16)(v.x >> 16));
  o[2] = bf2f((u16)(v.y & 0xffff)); o[3] = bf2f((u16)(v.y >> 16));
  o[4] = bf2f((u16)(v.z & 0xffff)); o[5] = bf2f((u16)(v.z >> 16));
  o[6] = bf2f((u16)(v.w & 0xffff)); o[7] = bf2f((u16)(v.w >> 16));
}
DI void st_kt(u16* sKt, int c8, int row, uint4 k) {
  sKt[(c8 + 0) * 72 + row] = (u16)(k.x & 0xffff); sKt[(c8 + 1) * 72 + row] = (u16)(k.x >> 16);
  sKt[(c8 + 2) * 72 + row] = (u16)(k.y & 0xffff); sKt[(c8 + 3) * 72 + row] = (u16)(k.y >> 16);
  sKt[(c8 + 4) * 72 + row] = (u16)(k.z & 0xffff); sKt[(c8 + 5) * 72 + row] = (u16)(k.z >> 16);
  sKt[(c8 + 6) * 72 + row] = (u16)(k.w & 0xffff); sKt[(c8 + 7) * 72 + row] = (u16)(k.w >> 16);
}
DI uint2 pack4bf(const f32x4& v) { uint2 r; r.x = pk2(v[0], v[1]); r.y = pk2(v[2], v[3]); return r; }
DI void gdn_p2_item(const Params& P, int it, float* lds) {
  const int tid = TID(), lane = tid & 63, w = tid >> 6, r16 = lane & 15, quad = lane >> 4;
  const int es = it & 3, bh = it >> 2, b = bh >> 2, h = bh & 3;
  u16* sW = (u16*)lds;
  u16* sQ = sW + 64 * 72;
  u16* sAm = sQ + 64 * 72;
  u16* sKt = sAm + 64 * 72;
  u16* sSt = sKt + 64 * 72;
  u16* sVnT = sSt + 16 * 72;
  u16* sVdT = sVnT + 16 * 72;
  float* sG = (float*)(sVdT + 16 * 72);
  const u16* GQ = (const u16*)(WSP(P) + WS_GQ); const u16* GK = (const u16*)(WSP(P) + WS_GK);
  const u16* GU = (const u16*)(WSP(P) + WS_GU); const u16* GW = (const u16*)(WSP(P) + WS_GW);
  const u16* GA = (const u16*)(WSP(P) + WS_GA); const float* GG = (const float*)(WSP(P) + WS_GG);
  u16* ORAW = (u16*)(WSP(P) + WS_OM) + (long)2 * T_ * 256;
  f32x4 S = {0.f, 0.f, 0.f, 0.f};
  const int irow = 16 * w + 4 * quad;
  uint4 rw0, rw1, rq0, rq1, ra0, ra1, rk0, rk1; u16 ru0, ru1, ru2, ru3; float rg = 0.f;
  const int c0 = tid, c1 = tid + 256;
  const long off0 = (c0 >> 3) * 64 + (c0 & 7) * 8, off1 = (c1 >> 3) * 64 + (c1 & 7) * 8;
#define GDN_GLOAD(CH) { long ci_ = (long)bh * 64 + (CH); \
    rw0 = *(const uint4*)(GW + ci_ * 4096 + off0); rw1 = *(const uint4*)(GW + ci_ * 4096 + off1); \
    rq0 = *(const uint4*)(GQ + ci_ * 4096 + off0); rq1 = *(const uint4*)(GQ + ci_ * 4096 + off1); \
    ra0 = *(const uint4*)(GA + ci_ * 4096 + off0); ra1 = *(const uint4*)(GA + ci_ * 4096 + off1); \
    rk0 = *(const uint4*)(GK + ci_ * 4096 + off0); rk1 = *(const uint4*)(GK + ci_ * 4096 + off1); \
    const u16* up_ = GU + ci_ * 4096 + irow * 64 + es * 16 + r16; \
    ru0 = up_[0]; ru1 = up_[64]; ru2 = up_[128]; ru3 = up_[192]; \
    if (tid < 64) rg = GG[ci_ * 64 + tid]; }
  GDN_GLOAD(0)
  for (int ch = 0; ch < 64; ++ch) {
    __syncthreads();
    {
      const int row0 = c0 >> 3, c80 = (c0 & 7) * 8, row1 = c1 >> 3, c81 = (c1 & 7) * 8;
      *(uint4*)(sW + row0 * 72 + c80) = rw0; *(uint4*)(sW + row1 * 72 + c81) = rw1;
      *(uint4*)(sQ + row0 * 72 + c80) = rq0; *(uint4*)(sQ + row1 * 72 + c81) = rq1;
      *(uint4*)(sAm + row0 * 72 + c80) = ra0; *(uint4*)(sAm + row1 * 72 + c81) = ra1;
      *(uint4*)(sKt + row0 * 72 + c80) = rk0; *(uint4*)(sKt + row1 * 72 + c81) = rk1;
    }
    if (tid < 64) sG[tid] = rg;
    *(uint2*)(sSt + r16 * 72 + irow) = pack4bf(S);
    const f32x4 uc = {bf2f(ru0), bf2f(ru1), bf2f(ru2), bf2f(ru3)};
    __syncthreads();
    if (ch + 1 < 64) GDN_GLOAD(ch + 1)
    f32x4 ws = {0.f, 0.f, 0.f, 0.f}, qs = {0.f, 0.f, 0.f, 0.f};
#pragma unroll
    for (int ks = 0; ks < 2; ++ks) {
      const bf16x8 bS = *(const bf16x8*)(sSt + r16 * 72 + ks * 32 + quad * 8);
      const bf16x8 aW = *(const bf16x8*)(sW + (16 * w + r16) * 72 + ks * 32 + quad * 8);
      const bf16x8 aQ = *(const bf16x8*)(sQ + (16 * w + r16) * 72 + ks * 32 + quad * 8);
      ws = __builtin_amdgcn_mfma_f32_16x16x32_bf16(aW, bS, ws, 0, 0, 0);
      qs = __builtin_amdgcn_mfma_f32_16x16x32_bf16(aQ, bS, qs, 0, 0, 0);
    }
    const float Gl = sG[63];
    const f32x4 G4 = *(const f32x4*)(sG + irow);
    f32x4 vn, vd;
#pragma unroll
    for (int j = 0; j < 4; ++j) { vn[j] = uc[j] - ws[j]; vd[j] = vn[j] * __expf(Gl - G4[j]); }
    *(uint2*)(sVnT + r16 * 72 + irow) = pack4bf(vn);
    *(uint2*)(sVdT + r16 * 72 + irow) = pack4bf(vd);
    __syncthreads();
    f32x4 av = {0.f, 0.f, 0.f, 0.f}, kv = {0.f, 0.f, 0.f, 0.f};
#pragma unroll
    for (int ks = 0; ks < 2; ++ks) {
      const bf16x8 bVn = *(const bf16x8*)(sVnT + r16 * 72 + ks * 32 + quad * 8);
      const bf16x8 bVd = *(const bf16x8*)(sVdT + r16 * 72 + ks * 32 + quad * 8);
      const bf16x8 aA = *(const bf16x8*)(sAm + (16 * w + r16) * 72 + ks * 32 + quad * 8);
      const bf16x8 aK = *(const bf16x8*)(sKt + (16 * w + r16) * 72 + ks * 32 + quad * 8);
      av = __builtin_amdgcn_mfma_f32_16x16x32_bf16(aA, bVn, av, 0, 0, 0);
      kv = __builtin_amdgcn_mfma_f32_16x16x32_bf16(aK, bVd, kv, 0, 0, 0);
    }
    {
      u16* op = ORAW + ((long)(b * SEQ + ch * 64 + irow)) * 256 + h * 64 + es * 16 + r16;
#pragma unroll
      for (int j = 0; j < 4; ++j) op[j * 256] = f2bf(__expf(G4[j]) * qs[j] + av[j]);
    }
    const float gl = __expf(Gl);
#pragma unroll
    for (int j = 0; j < 4; ++j) S[j] = S[j] * gl + kv[j];
  }
#undef GDN_GLOAD
}
DI void gdn_post_item(const Params& P, int l, int it) {
  const int lane = TID() & 63, w = TID() >> 6;
  const u16* PROJ = (const u16*)(WSP(P) + WS_PROJ);
  u16* O = (u16*)(WSP(P) + WS_OM) + (long)2 * T_ * 256;
  const float wn = PIN(P, 23)[l * 64 + lane];
#pragma unroll 4
  for (int q = 0; q < 16; ++q) {
    long t = (long)it * 16 + w * 4 + (q >> 2); int h = q & 3;
    float o = bf2f(O[t * 256 + h * 64 + lane]);
    float ss = wave_sum(o * o);
    float y = o * rsqrtf(ss * (1.f / 64.f) + EPS) * wn;
    float z = bf2f(PROJ[t * PW + P_GZ + h * 64 + lane]);
    O[t * 256 + h * 64 + lane] = f2bf(y * siluf_(z));
  }
}

DI void kv_gload(uint4& k0, uint4& k1, uint4& v0, uint4& v1, const u16* ksrc, const u16* vsrc, long ld) {
  const int tid = TID(), r0 = tid >> 3, ch = tid & 7;
  k0 = *(const uint4*)(ksrc + (long)r0 * ld + ch * 8); k1 = *(const uint4*)(ksrc + (long)(r0 + 32) * ld + ch * 8);
  v0 = *(const uint4*)(vsrc + (long)r0 * ld + ch * 8); v1 = *(const uint4*)(vsrc + (long)(r0 + 32) * ld + ch * 8);
}
DI void k_gload(uint4& k0, uint4& k1, const u16* ksrc, long ld) {
  const int tid = TID(), r0 = tid >> 3, ch = tid & 7;
  k0 = *(const uint4*)(ksrc + (long)r0 * ld + ch * 8); k1 = *(const uint4*)(ksrc + (long)(r0 + 32) * ld + ch * 8);
}
DI void k_store(const uint4& k0, const uint4& k1, u16* sK) {
  const int tid = TID(), r0 = tid >> 3, ch = tid & 7;
  *(uint4*)(sK + r0 * 72 + ch * 8) = k0; *(uint4*)(sK + (r0 + 32) * 72 + ch * 8) = k1;
}
DI void kv_store(const uint4& k0, const uint4& k1, const uint4& v0, const uint4& v1, u16* sK, u16* sVt) {
  const int tid = TID(), r0 = tid >> 3, ch = tid & 7;
  *(uint4*)(sK + r0 * 72 + ch * 8) = k0; *(uint4*)(sK + (r0 + 32) * 72 + ch * 8) = k1;
  const int ksw = 16 * (ch >> 1);
  st_kt(sVt, ch * 8, r0 ^ ksw, v0); st_kt(sVt, ch * 8, (r0 + 32) ^ ksw, v1);
}
DI void sb_attn_item(const Params& P, int it, u16* sQ, u16* sK, u16* sVt) {
  const int tid = TID(), lane = tid & 63, w = tid >> 6, r16 = lane & 15, quad = lane >> 4;
  const int qb = 63 - (it >> 5), bh = it & 31, b = bh >> 2, h = bh & 3;
  const u16* PROJ = (const u16*)(WSP(P) + WS_PROJ);
  u16* OUT = (u16*)(WSP(P) + WS_OM) + (long)3 * T_ * 256;
  const long tb = (long)b * SEQ;
  load_tile(sQ, PROJ + (tb + qb * 64) * PW + P_SB + h * 64, PW);
  __syncthreads();
  bf16x8 bq[2]; load_qfrag(bq, sQ, w, lane);
  const int tq = qb * 64 + 16 * w + r16;
  f32x4 ot[4];
#pragma unroll
  for (int dt = 0; dt < 4; ++dt) ot[dt] = (f32x4){0.f, 0.f, 0.f, 0.f};
  float R = 0.f;
  uint4 pk0, pk1, pv0, pv1;
  kv_gload(pk0, pk1, pv0, pv1, PROJ + (tb + qb * 64) * PW + P_SB + 256 + h * 64, PROJ + (tb + qb * 64) * PW + P_SB + 512 + h * 64, PW);
  for (int kb = qb; kb >= 0; --kb) {
    if (__syncthreads_and(R < -104.f)) break;
    kv_store(pk0, pk1, pv0, pv1, sK, sVt);
    __syncthreads();
    if (kb > 0) kv_gload(pk0, pk1, pv0, pv1, PROJ + (tb + (kb - 1) * 64) * PW + P_SB + 256 + h * 64, PROJ + (tb + (kb - 1) * 64) * PW + P_SB + 512 + h * 64, PW);
    f32x4 st[4];
    st_mma(st, sK, bq, lane);
    float gs[4], zz[4][4], x[4][4];
#pragma unroll
    for (int mt = 0; mt < 4; ++mt) {
      float g = 0.f;
#pragma unroll
      for (int j = 0; j < 4; ++j) {
        int s = kb * 64 + 16 * mt + 4 * quad + j;
        float z = st[mt][j] * 0.125f;
        float sp = softplusf_(z);
        bool mk = s < tq;
        x[mt][j] = mk ? -sp : 0.f;
        zz[mt][j] = mk ? (z - sp) : -1e30f;
        g += x[mt][j];
      }
      gs[mt] = g;
    }
    float hm = 0.f, tot_all = 0.f;
    f32x4 pw[4];
#pragma unroll
    for (int mt = 3; mt >= 0; --mt) {
      float g = gs[mt];
      float v1 = __shfl_down(g, 16), v2 = __shfl_down(g, 32), v3 = __shfl_down(g, 48);
      float hq = (quad < 3 ? v1 : 0.f) + (quad < 2 ? v2 : 0.f) + (quad < 1 ? v3 : 0.f);
      float tot = quad_sum(g);
      float base = R + hm + hq;
      float e3 = 0.f, e2 = x[mt][3], e1 = e2 + x[mt][2], e0 = e1 + x[mt][1];
      pw[mt][0] = __expf(zz[mt][0] + base + e0);
      pw[mt][1] = __expf(zz[mt][1] + base + e1);
      pw[mt][2] = __expf(zz[mt][2] + base + e2);
      pw[mt][3] = __expf(zz[mt][3] + base + e3);
      hm += tot; tot_all += tot;
    }
    R += tot_all;
    pv_mma(ot, sVt, pw, lane);
  }
  const long t = tb + tq;
#pragma unroll
  for (int dt = 0; dt < 4; ++dt) {
    uint2 ov; ov.x = pk2(ot[dt][0], ot[dt][1]); ov.y = pk2(ot[dt][2], ot[dt][3]);
    *(uint2*)(OUT + t * 256 + h * 64 + 16 * dt + 4 * quad) = ov;
  }
}

DI void win_attn_item(const Params& P, int it, u16* sQ, u16* sKunused, u16* sVunused) {
  const int tid = TID(), lane = tid & 63, w = tid >> 6, r16 = lane & 15, quad = lane >> 4;
  const int tbk = 127 - (it >> 3), b = it & 7;
  u16* sK = sQ + 128 * 72;
  u16* sVt = sK + 64 * 72;
  (void)sKunused; (void)sVunused;
  const u16* PROJ = (const u16*)(WSP(P) + WS_PROJ);
  const u16* QR = (const u16*)(WSP(P) + WS_QR);
  u16* OW = (u16*)(WSP(P) + WS_OW);
  const long tb = (long)b * SEQ;
  const int t0 = tbk * 32;
#pragma unroll
  for (int i = 0; i < 4; ++i) {
    const int c = tid + 256 * i, row = c >> 3, ch = c & 7;
    *(uint4*)(sQ + row * 72 + ch * 8) = *(const uint4*)(QR + (tb + t0 + (row & 31)) * 256 + (row >> 5) * 64 + ch * 8);
  }
  __syncthreads();
  bf16x8 bq[2][2];
  int tq[2];
#pragma unroll
  for (int qt = 0; qt < 2; ++qt) {
    const int rowq = 32 * w + 16 * qt + r16;
    bq[qt][0] = *(const bf16x8*)(sQ + rowq * 72 + quad * 8);
    bq[qt][1] = *(const bf16x8*)(sQ + rowq * 72 + 32 + quad * 8);
    tq[qt] = t0 + 16 * qt + r16;
  }
  f32x4 ot[2][4];
#pragma unroll
  for (int qt = 0; qt < 2; ++qt)
#pragma unroll
    for (int dt = 0; dt < 4; ++dt) ot[qt][dt] = (f32x4){0.f, 0.f, 0.f, 0.f};
  float m[2] = {-1e30f, -1e30f}, lsum[2] = {0.f, 0.f};
  const int lo = (t0 - 511) > 0 ? (t0 - 511) : 0;
  const int kb_lo = lo >> 6, kb_hi = (t0 + 31) >> 6;
  uint4 pk0, pk1, pv0, pv1;
  kv_gload(pk0, pk1, pv0, pv1, PROJ + (tb + kb_lo * 64) * PW + P_KV + 256, PROJ + (tb + kb_lo * 64) * PW + P_KV + 320, PW);
  for (int kb = kb_lo; kb <= kb_hi; ++kb) {
    __syncthreads();
    kv_store(pk0, pk1, pv0, pv1, sK, sVt);
    __syncthreads();
    if (kb < kb_hi) kv_gload(pk0, pk1, pv0, pv1, PROJ + (tb + (kb + 1) * 64) * PW + P_KV + 256, PROJ + (tb + (kb + 1) * 64) * PW + P_KV + 320, PW);
#pragma unroll
    for (int qt = 0; qt < 2; ++qt) {
      f32x4 st[4];
      st_mma(st, sK, bq[qt], lane);
      bool msk[4][4];
#pragma unroll
      for (int mt = 0; mt < 4; ++mt)
#pragma unroll
        for (int j = 0; j < 4; ++j) { int s = kb * 64 + 16 * mt + 4 * quad + j; int df = tq[qt] - s; msk[mt][j] = (df >= 0) && (df < 512); }
      softmax_tile(st, msk, m[qt], lsum[qt], ot[qt]);
      pv_mma(ot[qt], sVt, st, lane);
    }
  }
#pragma unroll
  for (int qt = 0; qt < 2; ++qt) {
    const float ls = quad_sum(lsum[qt]);
    const float inv = 1.f / fmaxf(ls, 1e-30f);
    const long t = tb + tq[qt];
#pragma unroll
    for (int dt = 0; dt < 4; ++dt) {
      uint2 ov; ov.x = pk2(ot[qt][dt][0] * inv, ot[qt][dt][1] * inv); ov.y = pk2(ot[qt][dt][2] * inv, ot[qt][dt][3] * inv);
      *(uint2*)(OW + t * 256 + w * 64 + 16 * dt + 4 * quad) = ov;
    }
  }
}

DI void cmp_attn_item(const Params& P, int it, u16* sQ, u16* sK, u16* sVt, float* sImp) {
  const int tid = TID(), lane = tid & 63, w = tid >> 6, r16 = lane & 15, quad = lane >> 4;
  const int tbk = 255 - (it >> 3), b = it & 7;
  const u16* PROJ = (const u16*)(WSP(P) + WS_PROJ);
  const u16* KC = (const u16*)(WSP(P) + WS_KC) + (long)b * 256 * 64;
  const u16* VC = (const u16*)(WSP(P) + WS_VC) + (long)b * 256 * 64;
  u16* OC = (u16*)(WSP(P) + WS_OC);
  u64* SEL = (u64*)(WSP(P) + WS_SEL);
  const long tb = (long)b * SEQ;
  const int t0 = tbk * 16;
  load_q_nsa(sQ, PROJ + (tb + t0) * PW + P_Q, PW);
  for (int e = tid; e < 4 * 16 * 64; e += 256) sImp[e] = 0.f;
  __syncthreads();
  bf16x8 bq[2]; load_qfrag(bq, sQ, w, lane);
  const int tq = t0 + r16;
  const int nv = (tq >= 31) ? ((tq - 31) >> 4) + 1 : 0;
  const int nvmax = (t0 + 15 >= 31) ? ((t0 + 15 - 31) >> 4) + 1 : 0;
  const int ntile = (nvmax + 63) >> 6;
  float m = -1e30f, lsum = 0.f;
  uint4 pk0, pk1, pv0, pv1;
  if (ntile > 0) k_gload(pk0, pk1, KC, 64);
  for (int kt = 0; kt < ntile; ++kt) {
    __syncthreads();
    k_store(pk0, pk1, sK);
    __syncthreads();
    if (kt + 1 < ntile) k_gload(pk0, pk1, KC + (kt + 1) * 64 * 64, 64);
    f32x4 st[4];
    st_mma(st, sK, bq, lane);
    float tm = -1e30f;
#pragma unroll
    for (int mt = 0; mt < 4; ++mt)
#pragma unroll
      for (int j = 0; j < 4; ++j) { int n = kt * 64 + 16 * mt + 4 * quad + j; float s = st[mt][j] * 0.125f; st[mt][j] = s; if (n < nv) tm = fmaxf(tm, s); }
    tm = quad_max(tm);
    float mn = fmaxf(m, tm);
    float ps = 0.f;
#pragma unroll
    for (int mt = 0; mt < 4; ++mt)
#pragma unroll
      for (int j = 0; j < 4; ++j) { int n = kt * 64 + 16 * mt + 4 * quad + j; if (n < nv) ps += __expf(st[mt][j] - mn); }
    lsum = lsum * __expf(m - mn) + ps;
    m = mn;
  }
  lsum = quad_sum(lsum);
  const float inv = (lsum > 0.f) ? 1.f / lsum : 0.f;
  f32x4 ot[4];
#pragma unroll
  for (int dt = 0; dt < 4; ++dt) ot[dt] = (f32x4){0.f, 0.f, 0.f, 0.f};
  float carry = 0.f;
  if (ntile > 0) kv_gload(pk0, pk1, pv0, pv1, KC, VC, 64);
  for (int kt = 0; kt < ntile; ++kt) {
    __syncthreads();
    kv_store(pk0, pk1, pv0, pv1, sK, sVt);
    __syncthreads();
    if (kt + 1 < ntile) kv_gload(pk0, pk1, pv0, pv1, KC + (kt + 1) * 64 * 64, VC + (kt + 1) * 64 * 64, 64);
    f32x4 st[4];
    st_mma(st, sK, bq, lane);
#pragma unroll
    for (int mt = 0; mt < 4; ++mt)
#pragma unroll
      for (int j = 0; j < 4; ++j) { int n = kt * 64 + 16 * mt + 4 * quad + j; st[mt][j] = (n < nv) ? __expf(st[mt][j] * 0.125f - m) * inv : 0.f; }
    pv_mma(ot, sVt, st, lane);
    float prevlast = carry;
#pragma unroll
    for (int mt = 0; mt < 4; ++mt) {
      float pl = st[mt][3];
      float fd = __shfl_up(pl, 16);
      float pprev = (quad > 0) ? fd : prevlast;
      float v = st[mt][0] + st[mt][1] + st[mt][2] + st[mt][3] + pprev;
      sImp[(w * 16 + r16) * 64 + kt * 16 + mt * 4 + quad] = v;
      prevlast = __shfl_down(pl, 48);
    }
    carry = prevlast;
  }
  {
    const long t = tb + tq;
#pragma unroll
    for (int dt = 0; dt < 4; ++dt) {
      uint2 ov; ov.x = pk2(ot[dt][0], ot[dt][1]); ov.y = pk2(ot[dt][2], ot[dt][3]);
      *(uint2*)(OC + t * 256 + w * 64 + 16 * dt + 4 * quad) = ov;
    }
  }
  __syncthreads();
  for (int q = 0; q < 4; ++q) {
    const int tok = 4 * w + q, t = t0 + tok;
    float v = sImp[(0 * 16 + tok) * 64 + lane] + sImp[(1 * 16 + tok) * 64 + lane] + sImp[(2 * 16 + tok) * 64 + lane] + sImp[(3 * 16 + tok) * 64 + lane];
    const int cur = t >> 6;
    if (lane == 0 || lane == cur) v = 1e9f;
    else if (lane * 64 > t) v = -1e30f;
    int cnt = 0;
#pragma unroll
    for (int i2 = 0; i2 < 64; ++i2) {
      float vi = __builtin_bit_cast(float, __builtin_amdgcn_readlane(__builtin_bit_cast(int, v), i2));
      cnt += (vi > v || (vi == v && i2 < lane)) ? 1 : 0;
    }
    u64 mask = __ballot(cnt < 16);
    if (lane == 0) SEL[tb + t] = mask;
  }
}

DI void sel_attn_item(const Params& P, int it, u16* sQ, u16* sKunused, u16* sVunused) {
  const int tid = TID(), lane = tid & 63, w = tid >> 6, r16 = lane & 15, quad = lane >> 4;
  const int tbk = 127 - (it >> 3), b = it & 7;
  u16* sK = sQ + 128 * 72;
  u16* sVt = sK + 64 * 72;
  (void)sKunused; (void)sVunused;
  const u16* PROJ = (const u16*)(WSP(P) + WS_PROJ);
  const u16* QR = (const u16*)(WSP(P) + WS_QR);
  const u16* OC = (const u16*)(WSP(P) + WS_OC);
  const u16* OW = (const u16*)(WSP(P) + WS_OW);
  const u64* SEL = (const u64*)(WSP(P) + WS_SEL);
  u16* OUT = (u16*)(WSP(P) + WS_OM);
  const long tb = (long)b * SEQ;
  const int t0 = tbk * 32;
#pragma unroll
  for (int i = 0; i < 4; ++i) {
    const int c = tid + 256 * i, row = c >> 3, ch = c & 7;
    *(uint4*)(sQ + row * 72 + ch * 8) = *(const uint4*)(QR + (tb + t0 + (row & 31)) * 256 + (row >> 5) * 64 + ch * 8);
  }
  __syncthreads();
  bf16x8 bq[2][2];
  int tq[2]; u64 mysel[2];
#pragma unroll
  for (int qt = 0; qt < 2; ++qt) {
    const int rowq = 32 * w + 16 * qt + r16;
    bq[qt][0] = *(const bf16x8*)(sQ + rowq * 72 + quad * 8);
    bq[qt][1] = *(const bf16x8*)(sQ + rowq * 72 + 32 + quad * 8);
    tq[qt] = t0 + 16 * qt + r16;
    mysel[qt] = SEL[tb + tq[qt]];
  }
  u64 uni = 0;
#pragma unroll
  for (int q = 0; q < 32; ++q) uni |= SEL[tb + t0 + q];
  const int cur = t0 >> 6;
  uni &= (cur == 63) ? ~0ull : ((1ull << (cur + 1)) - 1ull);
  f32x4 ot[2][4];
#pragma unroll
  for (int qt = 0; qt < 2; ++qt)
#pragma unroll
    for (int dt = 0; dt < 4; ++dt) ot[qt][dt] = (f32x4){0.f, 0.f, 0.f, 0.f};
  float m[2] = {-1e30f, -1e30f}, lsum[2] = {0.f, 0.f};
  uint4 pk0, pk1, pv0, pv1;
  int kb = uni ? (__ffsll((long long)uni) - 1) : -1;
  uni &= uni - 1;
  if (kb >= 0) kv_gload(pk0, pk1, pv0, pv1, PROJ + (tb + kb * 64) * PW + P_KV + 128, PROJ + (tb + kb * 64) * PW + P_KV + 192, PW);
  for (int nkb = -1; kb >= 0; kb = nkb) {
    __syncthreads();
    kv_store(pk0, pk1, pv0, pv1, sK, sVt);
    __syncthreads();
    nkb = uni ? (__ffsll((long long)uni) - 1) : -1;
    uni &= uni - 1;
    if (nkb >= 0) kv_gload(pk0, pk1, pv0, pv1, PROJ + (tb + nkb * 64) * PW + P_KV + 128, PROJ + (tb + nkb * 64) * PW + P_KV + 192, PW);
#pragma unroll
    for (int qt = 0; qt < 2; ++qt) {
      f32x4 st[4];
      st_mma(st, sK, bq[qt], lane);
      const bool selq = (mysel[qt] >> kb) & 1ull;
      bool msk[4][4];
#pragma unroll
      for (int mt = 0; mt < 4; ++mt)
#pragma unroll
        for (int j = 0; j < 4; ++j) { int s = kb * 64 + 16 * mt + 4 * quad + j; msk[mt][j] = selq && (s <= tq[qt]); }
      softmax_tile(st, msk, m[qt], lsum[qt], ot[qt]);
      pv_mma(ot[qt], sVt, st, lane);
    }
  }
#pragma unroll
  for (int qt = 0; qt < 2; ++qt) {
    const float ls = quad_sum(lsum[qt]);
    const float inv = 1.f / fmaxf(ls, 1e-30f);
    const long t = tb + tq[qt];
    const float gc = sigmoidf_(bf2f(PROJ[t * PW + P_NG + w * 3 + 0]));
    const float gsl = sigmoidf_(bf2f(PROJ[t * PW + P_NG + w * 3 + 1]));
    const float gw = sigmoidf_(bf2f(PROJ[t * PW + P_NG + w * 3 + 2]));
#pragma unroll
    for (int dt = 0; dt < 4; ++dt) {
      const long o = t * 256 + w * 64 + 16 * dt + 4 * quad;
      uint2 c = *(const uint2*)(OC + o), ww = *(const uint2*)(OW + o);
      float r0 = gc * bf2f((u16)(c.x & 0xffff)) + gsl * ot[qt][dt][0] * inv + gw * bf2f((u16)(ww.x & 0xffff));
      float r1 = gc * bf2f((u16)(c.x >> 16)) + gsl * ot[qt][dt][1] * inv + gw * bf2f((u16)(ww.x >> 16));
      float r2 = gc * bf2f((u16)(c.y & 0xffff)) + gsl * ot[qt][dt][2] * inv + gw * bf2f((u16)(ww.y & 0xffff));
      float r3 = gc * bf2f((u16)(c.y >> 16)) + gsl * ot[qt][dt][3] * inv + gw * bf2f((u16)(ww.y >> 16));
      uint2 ov; ov.x = pk2(r0, r1); ov.y = pk2(r2, r3);
      *(uint2*)(OUT + o) = ov;
    }
  }
}

DI void inproj_tile(const Params& P, int l, int it, u16* sA, u16* sB) {
  const int tid = TID(), lane = tid & 63, w = tid >> 6, r16 = lane & 15, quad = lane >> 4, wm = w >> 1, wn = w & 1;
  int mt, nt; tile_from_q256(it, 22, mt, nt);
  const u16* H = (const u16*)(WSP(P) + WS_H);
  u16* PROJ = (u16*)(WSP(P) + WS_PROJ);
  f32x4 acc[8][4];
  gemm5(acc, H + (long)mt * 256 * DM, DM, (const u16*)(WSP(P) + WS_W + WT_IN) + (long)nt * 128 * DM, DM, DM, sA);
#pragma unroll 1
  for (int h = 0; h < 2; ++h) {
    __syncthreads();
    if (wm == h) {
#pragma unroll
      for (int mi = 0; mi < 8; ++mi)
#pragma unroll
        for (int ni = 0; ni < 4; ++ni)
#pragma unroll
          for (int j = 0; j < 4; ++j) sA[(16 * mi + 4 * quad + j) * 136 + wn * 64 + 16 * ni + r16] = f2bf(acc[mi][ni][j]);
    }
    __syncthreads();
    store_tile_bf16<128>(sA, PROJ + ((long)mt * 256 + h * 128) * PW + nt * 128, PW, 128);
  }
}
DI void glu_tile(const Params& P, int l, int it, u16* sA, u16* sB) {
  const int tid = TID(), lane = tid & 63, w = tid >> 6, r16 = lane & 15, quad = lane >> 4, wm = w >> 1, wn = w & 1;
  const int mt = it >> 2, nt = it & 3;
  const u16* Y5 = (const u16*)(WSP(P) + WS_Y5);
  u16* OUT = (u16*)(WSP(P) + WS_OM) + (long)1 * T_ * 256;
  const u16* Ab = Y5 + (long)mt * 128 * 256;
  const u16* Bb = (const u16*)(WSP(P) + WS_W + WT_GLU) + (long)nt * 128 * 256;
  f32x4 acc[4][4];
  gemm3<4>(acc, g3_ptr(Ab, 256, tid, 0, false), g3_ptr(Ab, 256, tid, 1, false), nullptr, nullptr, 64,
           g3_ptr(Bb, 256, tid, 0, false), g3_ptr(Bb, 256, tid, 1, false), nullptr, nullptr, 256, sA, 16L * 256, 16L * 256);
  __syncthreads();
#pragma unroll
  for (int mi = 0; mi < 4; ++mi)
#pragma unroll
    for (int ni = 0; ni < 2; ++ni)
#pragma unroll
      for (int j = 0; j < 4; ++j)
        sA[(wm * 64 + 16 * mi + 4 * quad + j) * 72 + wn * 32 + 16 * ni + r16] = f2bf(acc[mi][ni][j] * sigmoidf_(acc[mi][ni + 2][j]));
  __syncthreads();
  store_tile_bf16<64>(sA, OUT + (long)mt * 128 * 256 + nt * 64, 256, 128);
}
DI void merge_tile(const Params& P, int l, int it, u16* sA, u16* sB) {
  const int tid = TID(), lane = tid & 63, w = tid >> 6, r16 = lane & 15, quad = lane >> 4, wm = w >> 1, wn = w & 1;
  int mt, nt; tile_from_q(it, 8, mt, nt);
  const u16* H = (const u16*)(WSP(P) + WS_H);
  const u16* OM = (const u16*)(WSP(P) + WS_OM);
  u16* MERGED = (u16*)(WSP(P) + WS_MERGED);
  uint2 outp[4][4];
#pragma unroll
  for (int mi = 0; mi < 4; ++mi)
#pragma unroll
    for (int ni = 0; ni < 4; ++ni) outp[mi][ni] = make_uint2(0u, 0u);
#pragma unroll 1
  for (int m = 0; m < 4; ++m) {
    uint2 gp[4][4];
    {
      f32x4 ag[4][4];
      const u16* Ab = H + (long)mt * 128 * DM;
      const u16* Bb = (const u16*)(WSP(P) + WS_W + WT_G) + ((long)(m * 1024 + nt * 128)) * DM;
      gemm3<4, true>(ag, g3_ptr(Ab, DM, tid, 0, false), g3_ptr(Ab, DM, tid, 1, false), nullptr, nullptr, 64,
               g3_ptr(Bb, DM, tid, 0, false), g3_ptr(Bb, DM, tid, 1, false), nullptr, nullptr, DM, sA, 16L * DM, 16L * DM);
#pragma unroll
      for (int mi = 0; mi < 4; ++mi)
#pragma unroll
        for (int ni = 0; ni < 4; ++ni) {
          gp[mi][ni].x = pk2(sigmoidf_(ag[mi][ni][0]), sigmoidf_(ag[mi][ni][1]));
          gp[mi][ni].y = pk2(sigmoidf_(ag[mi][ni][2]), sigmoidf_(ag[mi][ni][3]));
        }
    }
    {
      f32x4 av[4][4];
      const u16* Ab = OM + ((long)m * T_ + (long)mt * 128) * 256;
      const u16* Bb = (const u16*)(WSP(P) + WS_W + WT_BR) + ((long)(m * 1024 + nt * 128)) * 256;
      gemm3<4, true>(av, g3_ptr(Ab, 256, tid, 0, false), g3_ptr(Ab, 256, tid, 1, false), nullptr, nullptr, 64,
               g3_ptr(Bb, 256, tid, 0, false), g3_ptr(Bb, 256, tid, 1, false), nullptr, nullptr, 256, sA, 16L * 256, 16L * 256);
#pragma unroll
      for (int mi = 0; mi < 4; ++mi)
#pragma unroll
        for (int ni = 0; ni < 4; ++ni) {
          const float o0 = bf2f((u16)(outp[mi][ni].x & 0xffff)) + av[mi][ni][0] * bf2f((u16)(gp[mi][ni].x & 0xffff));
          const float o1 = bf2f((u16)(outp[mi][ni].x >> 16)) + av[mi][ni][1] * bf2f((u16)(gp[mi][ni].x >> 16));
          const float o2 = bf2f((u16)(outp[mi][ni].y & 0xffff)) + av[mi][ni][2] * bf2f((u16)(gp[mi][ni].y & 0xffff));
          const float o3 = bf2f((u16)(outp[mi][ni].y >> 16)) + av[mi][ni][3] * bf2f((u16)(gp[mi][ni].y >> 16));
          outp[mi][ni].x = pk2(o0, o1); outp[mi][ni].y = pk2(o2, o3);
        }
    }
  }
  __syncthreads();
#pragma unroll
  for (int mi = 0; mi < 4; ++mi)
#pragma unroll
    for (int ni = 0; ni < 4; ++ni)
#pragma unroll
      for (int j = 0; j < 4; ++j) {
        const unsigned wv = (j < 2) ? outp[mi][ni].x : outp[mi][ni].y;
        sA[(wm * 64 + 16 * mi + 4 * quad + j) * 136 + wn * 64 + 16 * ni + r16] = (u16)((j & 1) ? (wv >> 16) : (wv & 0xffff));
      }
  __syncthreads();
  store_tile_bf16<128>(sA, MERGED + (long)mt * 128 * DM + nt * 128, DM, 128);
}
DI void resid_tile(const u16* A, int K, const u16* Bt, const float* resid, float* out, int it, u16* sA, u16* sB) {
  const int tid = TID(), lane = tid & 63, w = tid >> 6, r16 = lane & 15, quad = lane >> 4, wm = w >> 1, wn = w & 1;
  int mt, nt; tile_from_q256(it, 8, mt, nt);
  f32x4 acc[8][4];
  gemm5(acc, A + (long)mt * 256 * K, K, Bt + (long)nt * 128 * K, K, K, sA);
  float* sC = (float*)sA + w * (32 * 68);
#pragma unroll
  for (int hp = 0; hp < 4; ++hp) {
    __syncthreads();
#pragma unroll
    for (int mi2 = 0; mi2 < 2; ++mi2)
#pragma unroll
      for (int ni = 0; ni < 4; ++ni)
#pragma unroll
        for (int j = 0; j < 4; ++j) sC[(16 * mi2 + 4 * quad + j) * 68 + 16 * ni + r16] = acc[2 * hp + mi2][ni][j];
    __syncthreads();
#pragma unroll
    for (int q = 0; q < 8; ++q) {
      const int c = lane + 64 * q, row = c >> 4, c4 = (c & 15) * 4;
      const long o = ((long)mt * 256 + wm * 128 + 32 * hp + row) * DM + nt * 128 + wn * 64 + c4;
      const float4 rv = *(const float4*)(resid + o);
      const f32x4 cv = *(const f32x4*)(sC + row * 68 + c4);
      *(float4*)(out + o) = make_float4(rv.x + cv[0], rv.y + cv[1], rv.z + cv[2], rv.w + cv[3]);
    }
  }
}
DI void ffn1_tile(const Params& P, int l, int it, u16* sA, u16* sB) {
  const int tid = TID(), lane = tid & 63, w = tid >> 6, r16 = lane & 15, quad = lane >> 4, wm = w >> 1, wn = w & 1;
  int mt, nt; tile_from_q256(it, 44, mt, nt);
  const u16* H = (const u16*)(WSP(P) + WS_H);
  u16* ACT = (u16*)(WSP(P) + WS_PROJ);
  f32x4 acc[8][4];
  gemm5(acc, H + (long)mt * 256 * DM, DM, (const u16*)(WSP(P) + WS_W + WT_GU) + (long)nt * 128 * DM, DM, DM, sA);
#pragma unroll 1
  for (int h = 0; h < 2; ++h) {
    __syncthreads();
    if (wm == h) {
#pragma unroll
      for (int mi = 0; mi < 8; ++mi)
#pragma unroll
        for (int ni = 0; ni < 2; ++ni)
#pragma unroll
          for (int j = 0; j < 4; ++j)
            sA[(16 * mi + 4 * quad + j) * 72 + wn * 32 + 16 * ni + r16] = f2bf(siluf_(acc[mi][ni][j]) * acc[mi][ni + 2][j]);
    }
    __syncthreads();
    store_tile_bf16<64>(sA, ACT + ((long)mt * 256 + h * 128) * DFF + nt * 64, DFF, 128);
  }
}

__global__ void __launch_bounds__(256, LB2) fwd_megakernel(Params P) {
  cg::grid_group grid = cg::this_grid();
  __shared__ __attribute__((aligned(16))) float lds[17920];
  __shared__ int s_item;
  unsigned* cnt = (unsigned*)(WSP(P) + WS_CNT);
  const int xcd = (int)(__builtin_amdgcn_s_getreg((3 << 11) | 20) & 0xF) & 7;
  __shared__ int s_rank;
  if (threadIdx.x == 0) s_rank = (int)atomicAdd(cnt + 900 + xcd, 1u);
  __syncthreads();
  const int xrank = __builtin_amdgcn_readfirstlane(s_rank);
  u16* sA = (u16*)lds;
  u16* sB = sA + 128 * 80;
  u16* aQ = (u16*)lds;
  u16* aK = aQ + 64 * 72;
  u16* aV = aK + 64 * 72;
  float* aImp = (float*)(aV + 64 * 72);
  for (int ph = P.ph_lo; ph < P.ph_hi; ++ph) {
    const int l = ph / 11, sp = ph % 11;
    const float* xin = (l == 0) ? PIN(P, 0) : P.out;
    const int nrep = (PROBE_DUP != 0 && l == 0 && ((PROBE_DUP >> sp) & 1)) ? 2 : 1;
    for (int rep = 0; rep < nrep; ++rep) {
    unsigned* pc = cnt + (ph + 32 * rep) * 8;
    switch (sp) {
      case 0: if (PHASE_MASK & (1 << 0)) {
        phase_rmsnorm(xin, PIN(P, 2) + l * DM, (u16*)(WSP(P) + WS_H));
        phase_convert(P, l, lds);
        if (l == 0) phase_rope_table((const int*)PIN(P, 1), (float*)(WSP(P) + WS_COS), (float*)(WSP(P) + WS_SIN));
      } break;
      case 1: if (PHASE_MASK & (1 << 1)) {
        XCD_STATIC_LOOP(16 * 22, inproj_tile(P, l, it, sA, sB))
      } break;
      case 2: if (PHASE_MASK & (1 << 2)) {
        for (;;) {
          int it = next_item(pc, &s_item); if (it >= 64 + 3 * 2048) break;
          if (it < 64) cmp1_tile(P, l, it, sA, sB);
          else if (it < 64 + 2048) gdn_p1_item(P, l, it - 64, lds);
          else if (it < 64 + 4096) s5_pass1_item(P, l, it - 64 - 2048, lds);
          else nsa_prep_item(P, l, it - 64 - 4096);
        }
      } break;
      case 3: if (PHASE_MASK & (1 << 3)) {
        for (;;) {
          int it = next_item(pc, &s_item); if (it >= 128 + 3072 + 64) break;
          if (it < 128) gdn_p2_item(P, it, lds);
          else if (it < 128 + 2048) sb_attn_item(P, it - 128, aQ, aK, aV);
          else if (it < 128 + 3072) win_attn_item(P, it - 128 - 2048, aQ, aK, aV);
          else if (it < 128 + 3072 + 32) s5_carry_item(P, l, it - 128 - 3072);
          else cmp2_tile(P, l, it - 128 - 3072 - 32, sA, sB, lds + 17000);
        }
      } break;
      case 4: if (PHASE_MASK & (1 << 4)) {
        for (;;) {
          int it = next_item(pc, &s_item); if (it >= 3 * 2048) break;
          if (it < 2048) cmp_attn_item(P, it, aQ, aK, aV, aImp);
          else if (it < 4096) s5_pass2_item(P, l, it - 2048, lds);
          else gdn_post_item(P, l, it - 4096);
        }
      } break;
      case 5: if (PHASE_MASK & (1 << 5)) {
        for (;;) {
          int it = next_item(pc, &s_item); if (it >= 1024 + 1024) break;
          if (it < 1024) sel_attn_item(P, it, aQ, aK, aV);
          else glu_tile(P, l, it - 1024, sA, sB);
        }
      } break;
      case 6: if (PHASE_MASK & (1 << 6)) {
        XCD_STATIC_LOOP(32 * 8, merge_tile(P, l, it, sA, sB))
      } break;
      case 7: if (PHASE_MASK & (1 << 7)) {
        XCD_STATIC_LOOP(16 * 8, resid_tile((const u16*)(WSP(P) + WS_MERGED), DM, (const u16*)(WSP(P) + WS_W + WT_OUT), xin, P.out, it, sA, sB))
      } break;
      case 8: if (PHASE_MASK & (1 << 8)) {
        phase_rmsnorm(P.out, PIN(P, 26) + l * DM, (u16*)(WSP(P) + WS_H));
      } break;
      case 9: if (PHASE_MASK & (1 << 9)) {
        XCD_STATIC_LOOP(16 * 44, ffn1_tile(P, l, it, sA, sB))
      } break;
      case 10: if (PHASE_MASK & (1 << 10)) {
        XCD_STATIC_LOOP(16 * 8, resid_tile((const u16*)(WSP(P) + WS_PROJ), DFF, (const u16*)(WSP(P) + WS_W + WT_D), P.out, P.out, it, sA, sB))
      } break;
    }
    if (rep + 1 < nrep) grid.sync();
    }
    if (ph + 1 < P.ph_hi) grid.sync();
  }
}

extern "C" void kernel_launch(void* const* d_in, const int* in_sizes, int n_in, void* d_out, int out_size, void* d_ws, size_t ws_size,
                              hipStream_t stream) {
  static int grid_blocks = 0;
  if (!grid_blocks) {
    int dev = 0, cus = 0, per_cu = 0;
    hipGetDevice(&dev);
    hipDeviceGetAttribute(&cus, hipDeviceAttributeMultiprocessorCount, dev);
    hipOccupancyMaxActiveBlocksPerMultiprocessor(&per_cu, fwd_megakernel, 256, 0);
    if (per_cu < 1) per_cu = 1;
    if (per_cu > 2) per_cu = 2;
    grid_blocks = cus * per_cu;
    if (ws_size < WS_W + WT_END) fprintf(stderr, "kernel_launch: workspace too small: %zu\n", ws_size);
  }
  hipMemsetAsync((char*)d_ws + WS_CNT, 0, 4096, stream);
  Params p{};
  for (int i = 0; i < 30; ++i) p.in[i] = (const float*)d_in[i];
  p.out = (float*)d_out;
  p.ws = (unsigned char*)d_ws;
  p.ph_lo = 0; p.ph_hi = NPHASE;
  void* args[] = {&p};
  hipError_t e = hipLaunchCooperativeKernel((void*)fwd_megakernel, dim3(grid_blocks), dim3(256), args, 0, stream);
  if (e != hipSuccess) fprintf(stderr, "cooperative launch failed: %s (grid %d)\n", hipGetErrorString(e), grid_blocks);
}
```

```cpp
#include <hip/hip_runtime.h>
#include <hip/hip_cooperative_groups.h>
#include <cstdio>
namespace cg = cooperative_groups;

typedef unsigned short u16;
typedef unsigned long long u64;
typedef __attribute__((ext_vector_type(8))) short bf16x8;
typedef __attribute__((ext_vector_type(4))) short s16x4;
typedef __attribute__((ext_vector_type(4))) float f32x4;
#define DI __device__ __forceinline__

constexpr int NB = 8, SEQ = 4096, T_ = NB * SEQ, DM = 1024, DIN = 6804, PW = 2816, DFF = 2816;
constexpr int P_Q = 0, P_KV = 256, P_S5U = 640, P_GQKV = 896, P_GZ = 1664, P_SB = 1920, P_NG = 2688, P_GA = 2700, P_GB = 2704;
constexpr float EPS = 1e-6f;
constexpr size_t MiB = 1024ull * 1024ull;
constexpr size_t WS_H = 0, WS_PROJ = 64 * MiB, WS_OM = 240 * MiB, WS_MERGED = 304 * MiB,
                 WS_GQ = 304 * MiB, WS_GK = 320 * MiB, WS_GU = 336 * MiB, WS_GW = 352 * MiB, WS_GA = 368 * MiB,
                 WS_QR = 384 * MiB, WS_OC = 400 * MiB, WS_OW = 416 * MiB, WS_Y5 = 432 * MiB,
                 WS_GG = 448 * MiB, WS_SEL = 449 * MiB, WS_COS = 450 * MiB, WS_SIN = 451 * MiB,
                 WS_ENDS = 452 * MiB, WS_CARRY = 456 * MiB, WS_KC = 460 * MiB, WS_VC = 461 * MiB, WS_HID = 462 * MiB,
                 WS_CNT = 464 * MiB, WS_W = 465 * MiB, WS_CBIAS = 449 * MiB + 512 * 1024;
constexpr size_t WT_IN = 0, WT_G = WT_IN + 2816ull * 1024 * 2, WT_BR = WT_G + 4096ull * 1024 * 2, WT_OUT = WT_BR + 4096ull * 256 * 2,
                 WT_GU = WT_OUT + 1024ull * 1024 * 2, WT_D = WT_GU + 5632ull * 1024 * 2, WT_GLU = WT_D + 1024ull * 2816 * 2,
                 WT_C1 = WT_GLU + 512ull * 256 * 2, WT_C2 = WT_C1 + 512ull * 2048 * 2, WT_END = WT_C2 + 128ull * 256 * 2;
constexpr int NPHASE = 22;
#define XCD_STATIC_LOOP(NPER, BODY) { \
    unsigned c0_ = cnt[900], c1_ = cnt[901], c2_ = cnt[902], c3_ = cnt[903], c4_ = cnt[904], c5_ = cnt[905], c6_ = cnt[906], c7_ = cnt[907]; \
    const bool ok_ = c0_ && c1_ && c2_ && c3_ && c4_ && c5_ && c6_ && c7_; \
    const unsigned mine_ = xcd == 0 ? c0_ : xcd == 1 ? c1_ : xcd == 2 ? c2_ : xcd == 3 ? c3_ : xcd == 4 ? c4_ : xcd == 5 ? c5_ : xcd == 6 ? c6_ : c7_; \
    const int start_ = ok_ ? xcd * (NPER) + xrank : (int)blockIdx.x, end_ = ok_ ? (xcd + 1) * (NPER) : 8 * (NPER), step_ = ok_ ? (int)mine_ : (int)gridDim.x; \
    for (int it = start_; it < end_; it += step_) { BODY; } }
#ifndef PROBE_DUP
#define PROBE_DUP 0
#endif
#ifndef LB2
#define LB2 2
#endif
#ifndef PHASE_MASK
#define PHASE_MASK 0x7ff
#endif

struct Params {
  const float* in[30];
  float* out;
  unsigned char* ws;
  int ph_lo, ph_hi;
};


DI int TID() { int t = threadIdx.x; asm volatile("" : "+v"(t)); return t; }
DI unsigned char* WSP(const Params& P) { size_t z = 0; asm volatile("" : "+s"(z)); return P.ws + z; }
DI u16 f2bf(float x) { unsigned u = __float_as_uint(x); u += 0x7fffu + ((u >> 16) & 1u); return (u16)(u >> 16); }
DI float bf2f(u16 h) { return __uint_as_float(((unsigned)h) << 16); }
DI unsigned pk2(float a, float b) { return (unsigned)f2bf(a) | ((unsigned)f2bf(b) << 16); }
DI float wave_sum(float v) {
#pragma unroll
  for (int o = 1; o < 64; o <<= 1) v += __shfl_xor(v, o);
  return v;
}
DI float sigmoidf_(float x) { return 1.f / (1.f + __expf(-x)); }
DI float siluf_(float x) { return x * sigmoidf_(x); }
DI float softplusf_(float x) { return fmaxf(x, 0.f) + log1pf(__expf(-fabsf(x))); }
DI float gelu_tanh(float x) {
  float u = 0.7978845608028654f * (x + 0.044715f * x * x * x);
  float t = 1.f - 2.f / (__expf(2.f * u) + 1.f);
  return 0.5f * x * (1.f + t);
}
DI void sincos_d(double x, double& s, double& c) {
  const double TWO_PI = 6.283185307179586476925287, INV = 0.15915494309189533576888;
  double n = rint(x * INV);
  double r = x - n * TWO_PI;
  double r2 = r * r, term = 1.0, cs = 1.0, ss = 1.0;
#pragma unroll
  for (int k = 1; k <= 14; ++k) { term *= r2 * (-1.0 / (double)((2 * k - 1) * (2 * k))); cs += term; }
  term = 1.0;
#pragma unroll
  for (int k = 1; k <= 14; ++k) { term *= r2 * (-1.0 / (double)((2 * k) * (2 * k + 1))); ss += term; }
  s = r * ss; c = cs;
}
DI int next_item(unsigned* cnt, int* s_item) {
  __syncthreads();
  if (TID() == 0) *s_item = (int)atomicAdd(cnt, 1u);
  __syncthreads();
  return *s_item;
}
DI int next_tile_xcd(unsigned* cnt8, int n_per_xcd, int xcd, int* s_item) {
  asm volatile("" : "+s"(xcd));
  __syncthreads();
  if (threadIdx.x == 0) {
    int res = -1;
    for (int a = 0; a < 8; ++a) {
      int qq = (xcd + a) & 7;
      unsigned v = atomicAdd(cnt8 + qq, 1u);
      if (v < (unsigned)n_per_xcd) { res = qq * n_per_xcd + (int)v; break; }
    }
    *s_item = res;
  }
  __syncthreads();
  return *s_item;
}
DI void tile_from_q(int it, int numN, int& mt, int& nt) {
  const int per = 32 * numN, q = it / per, i = it % per, g = i / (8 * numN), rem = i % (8 * numN);
  nt = rem >> 3; mt = 32 * q + 8 * g + (rem & 7);
}
DI int proj_src_col(int pc) {
  if (pc < 640) return pc;
  if (pc < 1664) return pc + 12;
  if (pc < 2688) return pc + 20;
  if (pc < 2700) return pc - 2688 + 640;
  if (pc < 2708) return pc - 2700 + 1676;
  return pc;
}

DI uint4 addpos8(uint4 v, const float* pp) {
  uint4 o;
  o.x = pk2(bf2f((u16)(v.x & 0xffff)) + pp[0], bf2f((u16)(v.x >> 16)) + pp[1]);
  o.y = pk2(bf2f((u16)(v.y & 0xffff)) + pp[2], bf2f((u16)(v.y >> 16)) + pp[3]);
  o.z = pk2(bf2f((u16)(v.z & 0xffff)) + pp[4], bf2f((u16)(v.z >> 16)) + pp[5]);
  o.w = pk2(bf2f((u16)(v.w & 0xffff)) + pp[6], bf2f((u16)(v.w >> 16)) + pp[7]);
  return o;
}
template <int NTW>
DI void gemm2(f32x4 (&acc)[4][NTW], const u16* __restrict__ arow, long a_kstep, const float* __restrict__ apos,
              const u16* __restrict__ brow, int K, u16* sA, u16* sB) {
  constexpr int BN = 32 * NTW, BV = BN / 32, LS = 80;
  const int tid = TID(), lane = tid & 63, w = tid >> 6, r16 = lane & 15, quad = lane >> 4;
  const int wm = w >> 1, wn = w & 1;
  u16* sa_st = sA + (tid >> 1) * LS + (tid & 1) * 32;
  u16* sb_st = (BN == 128) ? (sB + (tid >> 1) * LS + (tid & 1) * 32) : (sB + (tid >> 2) * LS + (tid & 3) * 16);
  uint4 pa0, pa1, pa2, pa3, pb0, pb1, pb2, pb3;
  uint4 qa0, qa1, qa2, qa3, qb0, qb1, qb2, qb3;
  pb2 = make_uint4(0, 0, 0, 0); pb3 = pb2; qb2 = pb2; qb3 = pb2;
#define G2_LOAD(KT, a0, a1, a2, a3, b0, b1, b2, b3) { const uint4* pa_ = (const uint4*)(arow + (long)(KT) * a_kstep); \
    a0 = pa_[0]; a1 = pa_[1]; a2 = pa_[2]; a3 = pa_[3]; \
    if (apos) { const float* pp_ = apos + (KT) * 64 + (tid & 1) * 32; \
      a0 = addpos8(a0, pp_); a1 = addpos8(a1, pp_ + 8); a2 = addpos8(a2, pp_ + 16); a3 = addpos8(a3, pp_ + 24); } \
    const uint4* pb_ = (const uint4*)(brow + (long)(KT) * 64); \
    b0 = pb_[0]; b1 = pb_[1]; if (BV == 4) { b2 = pb_[2]; b3 = pb_[3]; } }
#define G2_STORE(a0, a1, a2, a3, b0, b1, b2, b3) { \
    ((uint4*)sa_st)[0] = a0; ((uint4*)sa_st)[1] = a1; ((uint4*)sa_st)[2] = a2; ((uint4*)sa_st)[3] = a3; \
    ((uint4*)sb_st)[0] = b0; ((uint4*)sb_st)[1] = b1; if (BV == 4) { ((uint4*)sb_st)[2] = b2; ((uint4*)sb_st)[3] = b3; } }
#define G2_COMPUTE() { _Pragma("unroll") for (int ks = 0; ks < 2; ++ks) { \
      bf16x8 af[4], bg[NTW]; \
      _Pragma("unroll") for (int mi = 0; mi < 4; ++mi) af[mi] = *(const bf16x8*)(sA + (wm * 64 + 16 * mi + r16) * LS + ks * 32 + quad * 8); \
      _Pragma("unroll") for (int ni = 0; ni < NTW; ++ni) bg[ni] = *(const bf16x8*)(sB + (wn * (BN / 2) + 16 * ni + r16) * LS + ks * 32 + quad * 8); \
      _Pragma("unroll") for (int mi = 0; mi < 4; ++mi) \
        _Pragma("unroll") for (int ni = 0; ni < NTW; ++ni) acc[mi][ni] = __builtin_amdgcn_mfma_f32_16x16x32_bf16(af[mi], bg[ni], acc[mi][ni], 0, 0, 0); } }
#pragma unroll
  for (int mi = 0; mi < 4; ++mi)
#pragma unroll
    for (int ni = 0; ni < NTW; ++ni) acc[mi][ni] = (f32x4){0.f, 0.f, 0.f, 0.f};
  const int nk = K >> 6;
  G2_LOAD(0, pa0, pa1, pa2, pa3, pb0, pb1, pb2, pb3)
  G2_LOAD(1, qa0, qa1, qa2, qa3, qb0, qb1, qb2, qb3)
#pragma unroll 1
  for (int kt = 0; kt < nk; kt += 2) {
    __syncthreads();
    G2_STORE(pa0, pa1, pa2, pa3, pb0, pb1, pb2, pb3)
    __syncthreads();
    if (kt + 2 < nk) G2_LOAD(kt + 2, pa0, pa1, pa2, pa3, pb0, pb1, pb2, pb3)
    G2_COMPUTE()
    __syncthreads();
    G2_STORE(qa0, qa1, qa2, qa3, qb0, qb1, qb2, qb3)
    __syncthreads();
    if (kt + 3 < nk) G2_LOAD(kt + 3, qa0, qa1, qa2, qa3, qb0, qb1, qb2, qb3)
    G2_COMPUTE()
  }
#undef G2_LOAD
#undef G2_STORE
#undef G2_COMPUTE
}
DI void g3_rowpiece(int tid, int q, bool n64, int& row, int& pc) {
  const int w = tid >> 6, lane = tid & 63, chunk = n64 ? (2 * w + q) : (4 * w + q);
  row = 8 * chunk + (lane >> 3);
  pc = (lane & 7) ^ ((row >> 1) & 7);
}
DI const u16* g3_ptr(const u16* base, long ld, int tid, int q, bool n64) {
  int row, pc; g3_rowpiece(tid, q, n64, row, pc);
  return base + (long)row * ld + pc * 8;
}
template <int NTW, bool LEAN = false>
DI void gemm3(f32x4 (&acc)[4][NTW], const u16* ap0, const u16* ap1, const u16* ap2, const u16* ap3, long a_kstep,
              const u16* bp0, const u16* bp1, const u16* bp2, const u16* bp3, int K, u16* sbase, long a16 = 0, long b16 = 0) {
  constexpr int BN = 32 * NTW, STAGE = 16384;
  const int tid = TID(), lane = tid & 63, w = tid >> 6, r16 = lane & 15, quad = lane >> 4;
  const int wm = w >> 1, wn = w & 1;
  const int sz = (r16 >> 1) & 7;
  const int wu = __builtin_amdgcn_readfirstlane(w);
#define G3_GLDS(GP, LOFF) asm volatile("s_mov_b32 m0, %1\n\ts_nop 0\n\tglobal_load_lds_dwordx4 %0, off" :: "v"(GP), "s"(LOFF) : "memory", "m0")
  const unsigned lds0 = (unsigned)(size_t)sbase;
#define G3_ISSUE(KT) { const unsigned st_ = lds0 + (((KT) & 1) ? STAGE * 2 : 0); const long ka_ = (long)(KT) * a_kstep, kb_ = (long)(KT) * 64; \
    if (BN == 128) { \
      const unsigned la_ = __builtin_amdgcn_readfirstlane(st_ + wu * 4096u); \
      G3_GLDS(ap0 + ka_, la_); G3_GLDS(ap1 + ka_, la_ + 1024u); \
      if (a16) { G3_GLDS(ap0 + (ka_ + a16), la_ + 2048u); G3_GLDS(ap1 + (ka_ + a16), la_ + 3072u); } else { G3_GLDS(ap2 + ka_, la_ + 2048u); G3_GLDS(ap3 + ka_, la_ + 3072u); } \
      G3_GLDS(bp0 + kb_, la_ + 16384u); G3_GLDS(bp1 + kb_, la_ + 17408u); \
      if (b16) { G3_GLDS(bp0 + (kb_ + b16), la_ + 18432u); G3_GLDS(bp1 + (kb_ + b16), la_ + 19456u); } else { G3_GLDS(bp2 + kb_, la_ + 18432u); G3_GLDS(bp3 + kb_, la_ + 19456u); } \
    } else { \
      const unsigned la_ = __builtin_amdgcn_readfirstlane(st_ + wu * 4096u); \
      const unsigned lb_ = __builtin_amdgcn_readfirstlane(st_ + 16384u + wu * 2048u); \
      G3_GLDS(ap0 + ka_, la_); G3_GLDS(ap1 + ka_, la_ + 1024u); G3_GLDS(ap2 + ka_, la_ + 2048u); G3_GLDS(ap3 + ka_, la_ + 3072u); \
      G3_GLDS(bp0 + kb_, lb_); G3_GLDS(bp1 + kb_, lb_ + 1024u); \
    } }
#pragma unroll
  for (int mi = 0; mi < 4; ++mi)
#pragma unroll
    for (int ni = 0; ni < NTW; ++ni) acc[mi][ni] = (f32x4){0.f, 0.f, 0.f, 0.f};
  const int nk = K >> 6;
  __syncthreads();
  G3_ISSUE(0)
  if (!LEAN && BN == 128) {
#define G3_PIECE(I, KT) { const unsigned st_ = lds0 + (((KT) & 1) ? STAGE * 2 : 0); const long ka_ = (long)(KT) * a_kstep, kb_ = (long)(KT) * 64; \
      const unsigned la_ = __builtin_amdgcn_readfirstlane(st_ + wu * 4096u); \
      if ((I) == 0) G3_GLDS(ap0 + ka_, la_); else if ((I) == 1) G3_GLDS(ap1 + ka_, la_ + 1024u); \
      else if ((I) == 2) G3_GLDS((a16 ? ap0 + a16 : ap2) + ka_, la_ + 2048u); else if ((I) == 3) G3_GLDS((a16 ? ap1 + a16 : ap3) + ka_, la_ + 3072u); \
      else if ((I) == 4) G3_GLDS(bp0 + kb_, la_ + 16384u); else if ((I) == 5) G3_GLDS(bp1 + kb_, la_ + 17408u); \
      else if ((I) == 6) G3_GLDS((b16 ? bp0 + b16 : bp2) + kb_, la_ + 18432u); else G3_GLDS((b16 ? bp1 + b16 : bp3) + kb_, la_ + 19456u); }
#define G3_STEP(KT, DOISSUE) { const u16* sAs = sbase + ((KT) & 1) * STAGE; const u16* sBs = sAs + 8192; \
      _Pragma("unroll") for (int ks = 0; ks < 2; ++ks) { \
        const int pcol = ((ks * 4 + quad) ^ sz) * 8; \
        bf16x8 af[4], bg[NTW]; \
        _Pragma("unroll") for (int mi = 0; mi < 4; ++mi) af[mi] = *(const bf16x8*)(sAs + (wm * 64 + 16 * mi + r16) * 64 + pcol); \
        _Pragma("unroll") for (int ni = 0; ni < NTW; ++ni) bg[ni] = *(const bf16x8*)(sBs + (wn * (BN / 2) + 16 * ni + r16) * 64 + pcol); \
        _Pragma("unroll") for (int mi = 0; mi < 4; ++mi) { \
          _Pragma("unroll") for (int ni = 0; ni < NTW; ++ni) acc[mi][ni] = __builtin_amdgcn_mfma_f32_16x16x32_bf16(af[mi], bg[ni], acc[mi][ni], 0, 0, 0); \
          if (DOISSUE) G3_PIECE(ks * 4 + mi, (KT) + 1) \
          __builtin_amdgcn_sched_barrier(0); } } }
#pragma unroll 1
    for (int kt = 0; kt < nk - 1; ++kt) {
      asm volatile("s_waitcnt vmcnt(0) lgkmcnt(0)" ::: "memory");
      __builtin_amdgcn_s_barrier();
      asm volatile("" ::: "memory");
      G3_STEP(kt, true)
    }
    asm volatile("s_waitcnt vmcnt(0) lgkmcnt(0)" ::: "memory");
    __builtin_amdgcn_s_barrier();
    asm volatile("" ::: "memory");
    G3_STEP(nk - 1, false)
#undef G3_PIECE
#undef G3_STEP
  } else
#pragma unroll 1
  for (int kt = 0; kt < nk; ++kt) {
    asm volatile("s_waitcnt vmcnt(0) lgkmcnt(0)" ::: "memory");
    __builtin_amdgcn_s_barrier();
    asm volatile("" ::: "memory");
    if (kt + 1 < nk) G3_ISSUE(kt + 1)
    const u16* sAs = sbase + (kt & 1) * STAGE;
    const u16* sBs = sAs + 8192;
#pragma unroll 1
    for (int ks = 0; ks < (LEAN ? 2 : 0); ++ks) {
      const int pcol = ((ks * 4 + quad) ^ sz) * 8;
      bf16x8 af[4];
#pragma unroll
      for (int mi = 0; mi < 4; ++mi) af[mi] = *(const bf16x8*)(sAs + (wm * 64 + 16 * mi + r16) * 64 + pcol);
#pragma unroll
      for (int ni = 0; ni < NTW; ++ni) {
        bf16x8 b1 = *(const bf16x8*)(sBs + (wn * (BN / 2) + 16 * ni + r16) * 64 + pcol);
#pragma unroll
        for (int mi = 0; mi < 4; ++mi) acc[mi][ni] = __builtin_amdgcn_mfma_f32_16x16x32_bf16(af[mi], b1, acc[mi][ni], 0, 0, 0);
      }
    }
#pragma unroll
    for (int ks = 0; ks < (LEAN ? 0 : 2); ++ks) {
      const int pcol = ((ks * 4 + quad) ^ sz) * 8;
      bf16x8 af[4], bg[NTW];
#pragma unroll
      for (int mi = 0; mi < 4; ++mi) af[mi] = *(const bf16x8*)(sAs + (wm * 64 + 16 * mi + r16) * 64 + pcol);
#pragma unroll
      for (int ni = 0; ni < NTW; ++ni) bg[ni] = *(const bf16x8*)(sBs + (wn * (BN / 2) + 16 * ni + r16) * 64 + pcol);
#pragma unroll
      for (int mi = 0; mi < 4; ++mi)
#pragma unroll
        for (int ni = 0; ni < NTW; ++ni) acc[mi][ni] = __builtin_amdgcn_mfma_f32_16x16x32_bf16(af[mi], bg[ni], acc[mi][ni], 0, 0, 0);
    }
  }
#undef G3_ISSUE
#undef G3_GLDS
}
template <int NCOLS>
DI void store_tile_bf16(const u16* sC, u16* gdst, long ld, int rows_valid) {
  constexpr int CPR = NCOLS / 8, LS = NCOLS + 8;
  const int tid = TID();
#pragma unroll
  for (int q = 0; q < (128 * CPR) / 256; ++q) {
    const int c = tid + 256 * q, row = c / CPR, ch = c % CPR;
    if (row < rows_valid) *(uint4*)(gdst + (long)row * ld + ch * 8) = *(const uint4*)(sC + row * LS + ch * 8);
  }
}
DI int pair_col(int np, int& which) {
  const int nt = np >> 7, c = np & 127, wn = c >> 6, ni = (c >> 4) & 3, r = c & 15;
  which = ni >> 1;
  return nt * 64 + wn * 32 + (ni & 1) * 16 + r;
}
DI const float* conv_colptr(const Params& P, int l, int mat, int np, long& ld) {
  int which;
  switch (mat) {
    case 0: ld = DIN; return P.in[3] + (long)l * DM * DIN + proj_src_col(np);
    case 1: ld = DIN; return P.in[3] + (long)l * DM * DIN + 2708 + np;
    case 2: ld = DM; return P.in[24] + ((long)(l * 4 + (np >> 10)) * 256) * DM + (np & 1023);
    case 3: ld = DM; return P.in[25] + (long)l * DM * DM + np;
    case 4: { int o = pair_col(np, which); ld = DFF; return (which ? P.in[28] : P.in[27]) + (long)l * DM * DFF + o; }
    case 5: ld = DM; return P.in[29] + (long)l * DFF * DM + np;
    case 6: { int o = pair_col(np, which); ld = 512; return P.in[19] + (long)l * 256 * 512 + which * 256 + o; }
    case 7: ld = 256; return P.in[(np >> 8) ? 9 : 7] + (long)l * 2048 * 256 + (np & 255);
    default: ld = 64; return P.in[(np >> 6) ? 10 : 8] + (long)l * 256 * 64 + (np & 63);
  }
}
DI void phase_convert(const Params& P, int l, float* lds) {
  const int tid = TID();
  if (blockIdx.x < 64) {
    const int kv = blockIdx.x >> 5, ks = blockIdx.x & 31;
    const float* pos = P.in[6] + (long)(l * 2 + kv) * 2048 + ks * 64;
    const float* w1 = P.in[kv ? 9 : 7] + (long)l * 2048 * 256 + (long)ks * 64 * 256 + tid;
    float a = 0.f;
#pragma unroll 8
    for (int k = 0; k < 64; ++k) a += pos[k] * w1[(long)k * 256];
    ((float*)(WSP(P) + WS_CBIAS))[(kv * 32 + ks) * 256 + tid] = a;
  }
  const int NB_[9] = {44, 64, 64, 16, 88, 16, 8, 8, 2};
  const int KB_[9] = {16, 16, 4, 16, 16, 44, 4, 32, 4};
  const size_t OFF_[9] = {WT_IN, WT_G, WT_BR, WT_OUT, WT_GU, WT_D, WT_GLU, WT_C1, WT_C2};
  for (int it = blockIdx.x; it < 4648; it += gridDim.x) {
    int r = it, mat = 0, nbk = 0, kbk = 0; size_t off = 0;
#pragma unroll
    for (int q = 0; q < 9; ++q) { int n = NB_[q] * KB_[q]; if (r >= 0 && r < n) { mat = q; nbk = NB_[q]; kbk = KB_[q]; off = OFF_[q]; r -= 100000; } else if (r >= 0) r -= n; }
    r += 100000;
    const int nb = r / kbk, kb = r % kbk, K = kbk * 64;
    (void)nbk;
    __syncthreads();
    {
      const int n = tid & 63;
      long ld; const float* cp = conv_colptr(P, l, mat, nb * 64 + n, ld);
#pragma unroll 4
      for (int q = 0; q < 16; ++q) { int k = (tid >> 6) + 4 * q; lds[n * 65 + k] = cp[(long)(kb * 64 + k) * ld]; }
    }
    __syncthreads();
    u16* dst = (u16*)(WSP(P) + WS_W + off);
#pragma unroll
    for (int q = 0; q < 2; ++q) {
      int c = tid + 256 * q, n = c >> 3, k8 = (c & 7) * 8;
      const float* sp = lds + n * 65 + k8;
      uint4 v; v.x = pk2(sp[0], sp[1]); v.y = pk2(sp[2], sp[3]); v.z = pk2(sp[4], sp[5]); v.w = pk2(sp[6], sp[7]);
      *(uint4*)(dst + (long)(nb * 64 + n) * K + kb * 64 + k8) = v;
    }
  }
}

DI void st_mma(f32x4 (&st)[4], const u16* sK, const bf16x8 (&bq)[2], int lane) {
  const int r = lane & 15, quad = lane >> 4;
#pragma unroll
  for (int mt = 0; mt < 4; ++mt) {
    f32x4 a = {0.f, 0.f, 0.f, 0.f};
#pragma unroll
    for (int ks = 0; ks < 2; ++ks) {
      bf16x8 kf = *(const bf16x8*)(sK + (16 * mt + r) * 72 + ks * 32 + quad * 8);
      a = __builtin_amdgcn_mfma_f32_16x16x32_bf16(kf, bq[ks], a, 0, 0, 0);
    }
    st[mt] = a;
  }
}
DI void pv_mma(f32x4 (&ot)[4], const u16* sVt, const f32x4 (&p)[4], int lane) {
  const int r = lane & 15, quad = lane >> 4;
#pragma unroll
  for (int ks = 0; ks < 2; ++ks) {
    uint4 pu;
    pu.x = pk2(p[2 * ks][0], p[2 * ks][1]); pu.y = pk2(p[2 * ks][2], p[2 * ks][3]);
    pu.z = pk2(p[2 * ks + 1][0], p[2 * ks + 1][1]); pu.w = pk2(p[2 * ks + 1][2], p[2 * ks + 1][3]);
    bf16x8 pb = __builtin_bit_cast(bf16x8, pu);
#pragma unroll
    for (int dt = 0; dt < 4; ++dt) {
      const u16* vrow = sVt + (16 * dt + r) * 72;
      s16x4 lo = *(const s16x4*)(vrow + ((32 * ks + 4 * quad) ^ (16 * dt)));
      s16x4 hi = *(const s16x4*)(vrow + ((32 * ks + 16 + 4 * quad) ^ (16 * dt)));
      bf16x8 vf = __builtin_shufflevector(lo, hi, 0, 1, 2, 3, 4, 5, 6, 7);
      ot[dt] = __builtin_amdgcn_mfma_f32_16x16x32_bf16(vf, pb, ot[dt], 0, 0, 0);
    }
  }
}
DI void load_tile(u16* dst, const u16* src, long ld) {
  const int tid = TID();
#pragma unroll
  for (int i = 0; i < 2; ++i) {
    int c = tid + 256 * i, row = c >> 3, ch = c & 7;
    uint4 v = *(const uint4*)(src + (long)row * ld + ch * 8);
    *(uint4*)(dst + row * 72 + ch * 8) = v;
  }
}
DI void load_tile_T(u16* dst, const u16* src, long ld) {
  const int tid = TID();
#pragma unroll
  for (int i = 0; i < 2; ++i) {
    int c = tid + 256 * i, row = c >> 3, ch = c & 7;
    uint4 v = *(const uint4*)(src + (long)row * ld + ch * 8);
    const unsigned* vv = (const unsigned*)&v;
#pragma unroll
    for (int q = 0; q < 4; ++q) {
      dst[(ch * 8 + 2 * q) * 72 + row] = (u16)(vv[q] & 0xffff);
      dst[(ch * 8 + 2 * q + 1) * 72 + row] = (u16)(vv[q] >> 16);
    }
  }
}
DI void load_q_nsa(u16* dst, const u16* src, long ld) {
  const int tid = TID();
#pragma unroll
  for (int i = 0; i < 2; ++i) {
    int c = tid + 256 * i, row = c >> 3, ch = c & 7;
    uint4 v = *(const uint4*)(src + (long)(row & 15) * ld + (row >> 4) * 64 + ch * 8);
    *(uint4*)(dst + row * 72 + ch * 8) = v;
  }
}
DI void load_qfrag(bf16x8 (&bq)[2], const u16* sQ, int w, int lane) {
  const int r = lane & 15, quad = lane >> 4;
  bq[0] = *(const bf16x8*)(sQ + (16 * w + r) * 72 + quad * 8);
  bq[1] = *(const bf16x8*)(sQ + (16 * w + r) * 72 + 32 + quad * 8);
}
DI float quad_max(float v) { v = fmaxf(v, __shfl_xor(v, 16)); v = fmaxf(v, __shfl_xor(v, 32)); return v; }
DI float quad_sum(float v) { v += __shfl_xor(v, 16); v += __shfl_xor(v, 32); return v; }

DI void softmax_tile(f32x4 (&st)[4], const bool (&msk)[4][4], float& m, float& l, f32x4 (&ot)[4]) {
  float tm = -1e30f;
#pragma unroll
  for (int mt = 0; mt < 4; ++mt)
#pragma unroll
    for (int j = 0; j < 4; ++j) { float s = st[mt][j] * 0.125f; st[mt][j] = s; if (msk[mt][j]) tm = fmaxf(tm, s); }
  tm = quad_max(tm);
  float mn = fmaxf(m, tm);
  float alpha = __expf(m - mn);
  float ps = 0.f;
#pragma unroll
  for (int mt = 0; mt < 4; ++mt)
#pragma unroll
    for (int j = 0; j < 4; ++j) { float p = msk[mt][j] ? __expf(st[mt][j] - mn) : 0.f; st[mt][j] = p; ps += p; }
  l = l * alpha + ps;
  m = mn;
#pragma unroll
  for (int dt = 0; dt < 4; ++dt)
#pragma unroll
    for (int j = 0; j < 4; ++j) ot[dt][j] *= alpha;
}

DI void phase_rmsnorm(const float* __restrict__ x, const float* __restrict__ wgt, u16* __restrict__ H) {
  const int lane = TID() & 63, w = TID() >> 6;
  const int gw = blockIdx.x * 4 + w, nw = gridDim.x * 4;
  for (int row = gw; row < T_; row += nw) {
    const float4* xr = (const float4*)(x + (long)row * DM);
    float4 v[4]; float s = 0.f;
#pragma unroll
    for (int j = 0; j < 4; ++j) { v[j] = xr[lane + 64 * j]; s += v[j].x * v[j].x + v[j].y * v[j].y + v[j].z * v[j].z + v[j].w * v[j].w; }
    s = wave_sum(s);
    float r = rsqrtf(s * (1.f / DM) + EPS);
#pragma unroll
    for (int j = 0; j < 4; ++j) {
      float4 g = ((const float4*)wgt)[lane + 64 * j];
      uint2 o; o.x = pk2(v[j].x * r * g.x, v[j].y * r * g.y); o.y = pk2(v[j].z * r * g.z, v[j].w * r * g.w);
      *(uint2*)(H + (long)row * DM + (lane + 64 * j) * 4) = o;
    }
  }
}
DI void phase_rope_table(const int* __restrict__ positions, float* __restrict__ COS, float* __restrict__ SIN) {
  const float invf[8] = {1.0f, 0.1939227432012558f, 0.03760603070259094f, 0.007292664609849453f,
                         0.0014142135623842478f, 0.00027424818836152554f, 5.3182957344688475e-05f, 1.0313385246263351e-05f};
  for (int idx = blockIdx.x * 256 + TID(); idx < T_ * 8; idx += gridDim.x * 256) {
    int i = idx & 7;
    float f = invf[0];
#pragma unroll
    for (int q = 1; q < 8; ++q) f = (i == q) ? invf[q] : f;
    float ang = (float)positions[idx >> 3] * f;
    double s, c; sincos_d((double)ang, s, c);
    COS[idx] = (float)c; SIN[idx] = (float)s;
  }
}

struct S5Coef { float ar, ai; float bbr[16], bbi[16]; };
DI void s5_coef(const Params& P, int l, int g, int p, S5Coef& C) {
  float dt = expf(P.in[13][l * 16 + g]);
  float lr = P.in[11][(l * 16 + g) * 64 + p], li = P.in[12][(l * 16 + g) * 64 + p];
  float mag = expf(lr * dt);
  double s, c; sincos_d((double)(li * dt), s, c);
  C.ar = mag * (float)c; C.ai = mag * (float)s;
  float den = lr * lr + li * li;
  float fr = ((C.ar - 1.f) * lr + C.ai * li) / den;
  float fi = (C.ai * lr - (C.ar - 1.f) * li) / den;
  const float* br = P.in[14] + ((long)(l * 16 + g) * 64 + p) * 16;
  const float* bi = P.in[15] + ((long)(l * 16 + g) * 64 + p) * 16;
#pragma unroll
  for (int c2 = 0; c2 < 16; ++c2) {
    float b_r = br[c2], b_i = bi[c2];
    C.bbr[c2] = fr * b_r - fi * b_i;
    C.bbi[c2] = fr * b_i + fi * b_r;
  }
}
DI void s5_load_u(float* su, const u16* PROJ, int b, int chunk, int g, int lane) {
  const u16* src = PROJ + ((long)(b * SEQ + chunk * 64 + lane)) * PW + P_S5U + g * 16;
  uint4 v0 = ((const uint4*)src)[0], v1 = ((const uint4*)src)[1];
  const unsigned* a = (const unsigned*)&v0; const unsigned* c = (const unsigned*)&v1;
  float* d = su + lane * 16;
#pragma unroll
  for (int q = 0; q < 4; ++q) { d[2 * q] = bf2f((u16)(a[q] & 0xffff)); d[2 * q + 1] = bf2f((u16)(a[q] >> 16)); }
#pragma unroll
  for (int q = 0; q < 4; ++q) { d[8 + 2 * q] = bf2f((u16)(c[q] & 0xffff)); d[8 + 2 * q + 1] = bf2f((u16)(c[q] >> 16)); }
}

DI void s5_pass1_item(const Params& P, int l, int it, float* lds) {
  const int lane = TID() & 63, w = TID() >> 6;
  const int gq = it & 3, chunk = (it >> 2) & 63, b = it >> 8;
  const int g = gq * 4 + w;
  const u16* PROJ = (const u16*)(WSP(P) + WS_PROJ);
  float* su = lds + w * 1024;
  S5Coef C; s5_coef(P, l, g, lane, C);
  s5_load_u(su, PROJ, b, chunk, g, lane);
  __syncthreads();
  float xr = 0.f, xi = 0.f;
#pragma unroll 4
  for (int t = 0; t < 64; ++t) {
    const f32x4* up = (const f32x4*)(su + t * 16);
    float br = 0.f, bi = 0.f;
#pragma unroll
    for (int q = 0; q < 4; ++q) {
      f32x4 u = up[q];
#pragma unroll
      for (int e = 0; e < 4; ++e) { br += u[e] * C.bbr[4 * q + e]; bi += u[e] * C.bbi[4 * q + e]; }
    }
    float nr = C.ar * xr - C.ai * xi + br;
    float ni = C.ar * xi + C.ai * xr + bi;
    xr = nr; xi = ni;
  }
  float2* ENDS = (float2*)(WSP(P) + WS_ENDS);
  ENDS[((long)(b * 64 + chunk) * 16 + g) * 64 + lane] = make_float2(xr, xi);
}

DI void s5_carry_item(const Params& P, int l, int it) {
  const int idx = it * 256 + TID();
  const int b = idx >> 10, gp = idx & 1023, g = gp >> 6, p = gp & 63;
  float dt = expf(P.in[13][l * 16 + g]);
  float lr = P.in[11][(l * 16 + g) * 64 + p], li = P.in[12][(l * 16 + g) * 64 + p];
  float mag = expf(lr * dt * 64.f);
  double s, c; sincos_d((double)(li * dt) * 64.0, s, c);
  float ar = mag * (float)c, ai = mag * (float)s;
  const float2* ENDS = (const float2*)(WSP(P) + WS_ENDS);
  float2* CARRY = (float2*)(WSP(P) + WS_CARRY);
  float xr = 0.f, xi = 0.f;
  for (int ch = 0; ch < 64; ++ch) {
    long o = ((long)(b * 64 + ch) * 16 + g) * 64 + p;
    CARRY[o] = make_float2(xr, xi);
    float2 e = ENDS[o];
    float nr = ar * xr - ai * xi + e.x;
    float ni = ar * xi + ai * xr + e.y;
    xr = nr; xi = ni;
  }
}

DI void s5_pass2_item(const Params& P, int l, int it, float* lds) {
  const int lane = TID() & 63, w = TID() >> 6, r16 = lane & 15, quad = lane >> 4;
  const int gq = it & 3, chunk = (it >> 2) & 63, b = it >> 8;
  const int g = gq * 4 + w;
  const u16* PROJ = (const u16*)(WSP(P) + WS_PROJ);
  u16* Y5 = (u16*)(WSP(P) + WS_Y5);
  float* su = lds + w * 1024;
  u16* sX = (u16*)(lds + 4096) + w * (32 * 136);
  S5Coef C; s5_coef(P, l, g, lane, C);
  bf16x8 bfr[4];
#pragma unroll
  for (int ks = 0; ks < 4; ++ks) {
    const float* src = P.in[(ks < 2) ? 16 : 17] + ((long)(l * 16 + g) * 16 + r16) * 64 + (ks & 1) * 32 + quad * 8;
    const float4 v0 = ((const float4*)src)[0], v1 = ((const float4*)src)[1];
    const float sg = (ks < 2) ? 1.f : -1.f;
    uint4 pu; pu.x = pk2(sg * v0.x, sg * v0.y); pu.y = pk2(sg * v0.z, sg * v0.w); pu.z = pk2(sg * v1.x, sg * v1.y); pu.w = pk2(sg * v1.z, sg * v1.w);
    bfr[ks] = __builtin_bit_cast(bf16x8, pu);
  }
  const float dsk = P.in[18][l * 256 + g * 16 + r16];
  s5_load_u(su, PROJ, b, chunk, g, lane);
  __syncthreads();
  const float2 c0 = ((const float2*)(WSP(P) + WS_CARRY))[((long)(b * 64 + chunk) * 16 + g) * 64 + lane];
  float xr = c0.x, xi = c0.y;
  for (int half = 0; half < 2; ++half) {
#pragma unroll 4
    for (int tt = 0; tt < 32; ++tt) {
      const int t = half * 32 + tt;
      const f32x4* up = (const f32x4*)(su + t * 16);
      float br0 = 0.f, bi0 = 0.f, br1 = 0.f, bi1 = 0.f;
#pragma unroll
      for (int q = 0; q < 4; ++q) {
        f32x4 u = up[q];
        br0 += u[0] * C.bbr[4 * q + 0]; bi0 += u[0] * C.bbi[4 * q + 0];
        br1 += u[1] * C.bbr[4 * q + 1]; bi1 += u[1] * C.bbi[4 * q + 1];
        br0 += u[2] * C.bbr[4 * q + 2]; bi0 += u[2] * C.bbi[4 * q + 2];
        br1 += u[3] * C.bbr[4 * q + 3]; bi1 += u[3] * C.bbi[4 * q + 3];
      }
      const float nr = C.ar * xr - C.ai * xi + (br0 + br1);
      const float ni = C.ar * xi + C.ai * xr + (bi0 + bi1);
      xr = nr; xi = ni;
      sX[tt * 136 + lane] = f2bf(xr);
      sX[tt * 136 + 64 + lane] = f2bf(xi);
    }
    __syncthreads();
#pragma unroll
    for (int mt = 0; mt < 2; ++mt) {
      f32x4 acc = {0.f, 0.f, 0.f, 0.f};
#pragma unroll
      for (int ks = 0; ks < 4; ++ks) {
        const bf16x8 af = *(const bf16x8*)(sX + (16 * mt + r16) * 136 + ks * 32 + quad * 8);
        acc = __builtin_amdgcn_mfma_f32_16x16x32_bf16(af, bfr[ks], acc, 0, 0, 0);
      }
#pragma unroll
      for (int j = 0; j < 4; ++j) {
        const int t = half * 32 + 16 * mt + 4 * quad + j;
        const float y = acc[j] + dsk * su[t * 16 + r16];
        Y5[((long)(b * SEQ + chunk * 64 + t)) * 256 + g * 16 + r16] = f2bf(gelu_tanh(y));
      }
    }
    __syncthreads();
  }
}

DI void nsa_prep_item(const Params& P, int l, int it) {
  const int lane = TID() & 63, w = TID() >> 6;
  u16* PROJ = (u16*)(WSP(P) + WS_PROJ);
  u16* QR = (u16*)(WSP(P) + WS_QR);
  const float* COS = (const float*)(WSP(P) + WS_COS);
  const float* SIN = (const float*)(WSP(P) + WS_SIN);
  for (int tt = 0; tt < 4; ++tt) {
    const long t = (long)it * 16 + w * 4 + tt;
    const float cs = COS[t * 8 + (lane & 7)], sn = SIN[t * 8 + (lane & 7)];
#pragma unroll
    for (int g = 0; g < 6; ++g) {
      const int col = (g < 4) ? (P_Q + g * 64) : (g == 4 ? P_KV + 128 : P_KV + 256);
      const float wg = (g < 4) ? P.in[4][l * 64 + lane] : P.in[5][(l * 3 + (g - 3)) * 64 + lane];
      u16* ptr = PROJ + t * PW + col + lane;
      float v = bf2f(*ptr);
      float ss = wave_sum(v * v);
      float y = v * rsqrtf(ss * (1.f / 64.f) + EPS) * wg;
      float pr = __shfl_xor(y, 8);
      float rot = (lane < 8) ? (y * cs - pr * sn) : ((lane < 16) ? (y * cs + pr * sn) : y);
      if (g < 4) { *ptr = f2bf(y); QR[t * 256 + g * 64 + lane] = f2bf(rot); }
      else *ptr = f2bf(rot);
    }
  }
}

DI void cmp1_tile(const Params& P, int l, int ct, u16* sA, u16* sB) {
  const int tid = TID(), lane = tid & 63, w = tid >> 6, r16 = lane & 15, quad = lane >> 4, wm = w >> 1, wn = w & 1;
  const int kv = ct >> 5, mt = (ct >> 1) & 15, nt = ct & 1;
  const u16* PROJ = (const u16*)(WSP(P) + WS_PROJ);
  u16* HID = (u16*)(WSP(P) + WS_HID);
  const u16* apq[4];
#pragma unroll
  for (int q = 0; q < 4; ++q) {
    int row, pc; g3_rowpiece(tid, q, false, row, pc);
    int gr = mt * 128 + row; if (gr > 2039) gr = 2039;
    const int b = gr / 255, n = gr % 255;
    apq[q] = PROJ + ((long)(b * SEQ + 16 * n)) * PW + P_KV + kv * 64 + pc * 8;
  }
  const u16* Bb = (const u16*)(WSP(P) + WS_W + WT_C1) + ((long)(kv * 256 + nt * 128)) * 2048;
  f32x4 acc[4][4];
  gemm3<4>(acc, apq[0], apq[1], apq[2], apq[3], PW,
           g3_ptr(Bb, 2048, tid, 0, false), g3_ptr(Bb, 2048, tid, 1, false), g3_ptr(Bb, 2048, tid, 2, false), g3_ptr(Bb, 2048, tid, 3, false), 2048, sA);
  {
    const float* PART = (const float*)(WSP(P) + WS_CBIAS) + (long)kv * 32 * 256;
#pragma unroll
    for (int ni = 0; ni < 4; ++ni) {
      const int col = nt * 128 + wn * 64 + 16 * ni + r16;
      float bsum = 0.f;
      for (int sl = 0; sl < 32; ++sl) bsum += PART[sl * 256 + col];
#pragma unroll
      for (int mi = 0; mi < 4; ++mi)
#pragma unroll
        for (int j = 0; j < 4; ++j) acc[mi][ni][j] += bsum;
    }
  }
  __syncthreads();
#pragma unroll
  for (int mi = 0; mi < 4; ++mi)
#pragma unroll
    for (int ni = 0; ni < 4; ++ni)
#pragma unroll
      for (int j = 0; j < 4; ++j) sA[(wm * 64 + 16 * mi + 4 * quad + j) * 136 + wn * 64 + 16 * ni + r16] = f2bf(gelu_tanh(acc[mi][ni][j]));
  __syncthreads();
  store_tile_bf16<128>(sA, HID + ((long)kv * 2048 + mt * 128) * 256 + nt * 128, 256, 2040 - mt * 128);
}
DI void cmp2_tile(const Params& P, int l, int ct, u16* sA, u16* sB, float* sSS) {
  const int tid = TID(), lane = tid & 63, w = tid >> 6, r16 = lane & 15, quad = lane >> 4, wm = w >> 1, wn = w & 1;
  const int kv = ct >> 4, mt = ct & 15;
  const u16* HID = (const u16*)(WSP(P) + WS_HID);
  u16* OUT = (u16*)(WSP(P) + (kv ? WS_VC : WS_KC));
  const u16* Ab = HID + ((long)kv * 2048 + mt * 128) * 256;
  const u16* Bb = (const u16*)(WSP(P) + WS_W + WT_C2) + (long)kv * 64 * 256;
  f32x4 acc[4][2];
  gemm3<2>(acc, g3_ptr(Ab, 256, tid, 0, false), g3_ptr(Ab, 256, tid, 1, false), g3_ptr(Ab, 256, tid, 2, false), g3_ptr(Ab, 256, tid, 3, false), 64,
           g3_ptr(Bb, 256, tid, 0, true), g3_ptr(Bb, 256, tid, 1, true), nullptr, nullptr, 256, sA);
  __syncthreads();
  if (tid < 128) sSS[tid] = 0.f;
  __syncthreads();
#pragma unroll
  for (int mi = 0; mi < 4; ++mi)
#pragma unroll
    for (int j = 0; j < 4; ++j) {
      float ss = acc[mi][0][j] * acc[mi][0][j] + acc[mi][1][j] * acc[mi][1][j];
      ss += __shfl_xor(ss, 1); ss += __shfl_xor(ss, 2); ss += __shfl_xor(ss, 4); ss += __shfl_xor(ss, 8);
      if (r16 == 0) atomicAdd(&sSS[wm * 64 + 16 * mi + 4 * quad + j], ss);
    }
  __syncthreads();
#pragma unroll
  for (int mi = 0; mi < 4; ++mi)
#pragma unroll
    for (int j = 0; j < 4; ++j) {
      const int rl = wm * 64 + 16 * mi + 4 * quad + j, row = mt * 128 + rl;
      const float sc = (kv == 0) ? rsqrtf(sSS[rl] * (1.f / 64.f) + EPS) : 1.f;
      if (row < 2040) {
        int b = row / 255, n = row % 255;
#pragma unroll
        for (int ni = 0; ni < 2; ++ni) {
          int col = wn * 32 + 16 * ni + r16;
          float v = acc[mi][ni][j] * sc;
          if (kv == 0) v *= P.in[5][(l * 3 + 0) * 64 + col];
          OUT[((long)(b * 256 + n)) * 64 + col] = f2bf(v);
        }
      }
    }
}

DI void gdn_p1_item(const Params& P, int l, int it, float* lds) {
  const int tid = TID(), lane = tid & 63, w = tid >> 6, r16 = lane & 15, quad = lane >> 4;
  const int chunk = it & 63, h = (it >> 6) & 3, b = it >> 8;
  const long ci = it;
  const u16* PROJ = (const u16*)(WSP(P) + WS_PROJ);
  float* sq = lds;
  float* sk = lds + 64 * 65;
  float* sv = lds + 2 * 64 * 65;
  float* sG = lds + 3 * 64 * 65;
  float* sBeta = sG + 64;
  float* sg = sBeta + 64;
  u16* sQb = (u16*)(sg + 64);
  u16* sKb = sQb + 64 * 72;
  const float* cw = P.in[20] + (long)l * 4 * 768;
  if (tid < 192) {
    const int cp = tid % 96, th = tid / 96;
    const int c0 = 2 * cp, which = c0 >> 6, d = c0 & 63, C = which * 256 + h * 64 + d;
    float w0[4], w1[4];
#pragma unroll
    for (int k = 0; k < 4; ++k) { w0[k] = cw[k * 768 + C]; w1[k] = cw[k * 768 + C + 1]; }
    unsigned v[35];
    const int s0 = chunk * 64 + th * 32 - 3;
    const u16* src = PROJ + ((long)(b * SEQ + s0)) * PW + P_GQKV + C;
#pragma unroll
    for (int k = 0; k < 35; ++k) v[k] = (s0 + k >= 0) ? *(const unsigned*)(src + (long)k * PW) : 0u;
    float* dst = lds + which * 64 * 65 + (th * 32) * 65 + d;
#pragma unroll
    for (int tt = 0; tt < 32; ++tt) {
      float a0 = 0.f, a1 = 0.f;
#pragma unroll
      for (int k = 0; k < 4; ++k) { a0 += w0[k] * bf2f((u16)(v[tt + k] & 0xffff)); a1 += w1[k] * bf2f((u16)(v[tt + k] >> 16)); }
      dst[tt * 65] = siluf_(a0); dst[tt * 65 + 1] = siluf_(a1);
    }
  }
  __syncthreads();
  if (tid < 128) {
    float* base = (tid < 64) ? sq : sk;
    u16* bb = (tid < 64) ? sQb : sKb;
    const int row = tid & 63;
    float ss = 0.f;
#pragma unroll 8
    for (int d = 0; d < 64; ++d) { float x = base[row * 65 + d]; ss += x * x; }
    const float sc = rsqrtf(ss + EPS) * ((tid < 64) ? 0.125f : 1.f);
#pragma unroll 8
    for (int d = 0; d < 64; d += 2) {
      const float x0 = base[row * 65 + d] * sc, x1 = base[row * 65 + d + 1] * sc;
      base[row * 65 + d] = x0; base[row * 65 + d + 1] = x1;
      *(unsigned*)(bb + row * 72 + d) = pk2(x0, x1);
    }
  } else if (tid < 192) {
    const int row = tid - 128;
    const long t = (long)(b * SEQ + chunk * 64 + row);
    const float bl = bf2f(PROJ[t * PW + P_GB + h]);
    const float al = bf2f(PROJ[t * PW + P_GA + h]);
    sBeta[row] = sigmoidf_(bl);
    sg[row] = -expf(P.in[21][l * 4 + h]) * softplusf_(al + P.in[22][l * 4 + h]);
  }
  __syncthreads();
  if (tid < 64) {
    float x = sg[tid];
#pragma unroll
    for (int o = 1; o < 64; o <<= 1) { float u = __shfl_up(x, o); if (tid >= o) x += u; }
    sG[tid] = x;
    ((float*)(WSP(P) + WS_GG))[ci * 64 + tid] = x;
  }
  __syncthreads();
  f32x4 lreg[4];
  {
    const f32x4 Gi4 = *(const f32x4*)(sG + 16 * w + 4 * quad);
    const f32x4 Bi4 = *(const f32x4*)(sBeta + 16 * w + 4 * quad);
    u16* GA = (u16*)(WSP(P) + WS_GA) + ci * 4096;
#pragma unroll
    for (int nt = 0; nt < 4; ++nt) {
      f32x4 aq = {0.f, 0.f, 0.f, 0.f}, ak = {0.f, 0.f, 0.f, 0.f};
#pragma unroll
      for (int ks = 0; ks < 2; ++ks) {
        const bf16x8 fq = *(const bf16x8*)(sQb + (16 * w + r16) * 72 + ks * 32 + quad * 8);
        const bf16x8 fk = *(const bf16x8*)(sKb + (16 * w + r16) * 72 + ks * 32 + quad * 8);
        const bf16x8 fb = *(const bf16x8*)(sKb + (16 * nt + r16) * 72 + ks * 32 + quad * 8);
        aq = __builtin_amdgcn_mfma_f32_16x16x32_bf16(fq, fb, aq, 0, 0, 0);
        ak = __builtin_amdgcn_mfma_f32_16x16x32_bf16(fk, fb, ak, 0, 0, 0);
      }
      const int j = 16 * nt + r16;
      const float Gj = sG[j];
#pragma unroll
      for (int jj = 0; jj < 4; ++jj) {
        const int i = 16 * w + 4 * quad + jj;
        const float dec = __expf(Gi4[jj] - Gj);
        GA[i * 64 + j] = f2bf((j <= i) ? aq[jj] * dec : 0.f);
        const float lv = (j < i) ? Bi4[jj] * ak[jj] * dec : 0.f;
        sq[i * 65 + j] = lv;
        lreg[nt][jj] = lv;
      }
    }
  }
  {
    u16* GQ = (u16*)(WSP(P) + WS_GQ) + ci * 4096;
#pragma unroll
    for (int q = 0; q < 2; ++q) { const int c = tid + 256 * q, row = c >> 3, ch = c & 7; *(uint4*)(GQ + row * 64 + ch * 8) = *(const uint4*)(sQb + row * 72 + ch * 8); }
    const int i = tid >> 2, j0 = (tid & 3) * 16;
    u16* GK = (u16*)(WSP(P) + WS_GK) + ci * 4096 + i * 64 + j0;
    unsigned ok[8];
#pragma unroll
    for (int q = 0; q < 8; ++q) ok[q] = pk2(sk[(j0 + 2 * q) * 65 + i], sk[(j0 + 2 * q + 1) * 65 + i]);
    ((uint4*)GK)[0] = make_uint4(ok[0], ok[1], ok[2], ok[3]); ((uint4*)GK)[1] = make_uint4(ok[4], ok[5], ok[6], ok[7]);
  }
  __syncthreads();
  u16* sLb = sQb;
  u16* sXT = sKb;
  {
    const int i = tid >> 2, j0 = (tid & 3) * 16;
    const float bi = sBeta[i], eg = __expf(sG[i]);
#pragma unroll
    for (int jj = 0; jj < 16; ++jj) { sv[i * 65 + j0 + jj] *= bi; sk[i * 65 + j0 + jj] *= bi * eg; }
#pragma unroll
    for (int nt = 0; nt < 4; ++nt)
#pragma unroll
      for (int jj = 0; jj < 4; ++jj) sLb[(16 * w + 4 * quad + jj) * 72 + 16 * nt + r16] = f2bf(lreg[nt][jj]);
  }
  __syncthreads();
#pragma unroll 1
  for (int bi = 0; bi < 4; ++bi) {
    if (tid < 128) {
      float* buf = (tid < 64) ? sv : sk;
      const int col = tid & 63;
      float x[16];
#pragma unroll
      for (int r = 0; r < 16; ++r) {
        float a0 = buf[(16 * bi + r) * 65 + col], a1 = 0.f;
#pragma unroll
        for (int j = 0; j + 1 < r; j += 2) { a0 -= sq[(16 * bi + r) * 65 + 16 * bi + j] * x[j]; a1 -= sq[(16 * bi + r) * 65 + 16 * bi + j + 1] * x[j + 1]; }
        if (r & 1) a0 -= sq[(16 * bi + r) * 65 + 16 * bi + r - 1] * x[r - 1];
        x[r] = a0 + a1;
        buf[(16 * bi + r) * 65 + col] = x[r];
      }
      uint4 p0, p1;
      p0.x = pk2(x[0], x[1]); p0.y = pk2(x[2], x[3]); p0.z = pk2(x[4], x[5]); p0.w = pk2(x[6], x[7]);
      p1.x = pk2(x[8], x[9]); p1.y = pk2(x[10], x[11]); p1.z = pk2(x[12], x[13]); p1.w = pk2(x[14], x[15]);
      *(uint4*)(sXT + tid * 24) = p0; *(uint4*)(sXT + tid * 24 + 8) = p1;
    }
    __syncthreads();
    if (bi < 3) {
#pragma unroll
      for (int q = 0; q < 2; ++q) {
        const int nt = 2 * w + q, colg = 16 * nt + r16;
        bf16x8 bx = *(const bf16x8*)(sXT + colg * 24 + (quad & 1) * 8);
        if (quad >= 2) bx = (bf16x8){0, 0, 0, 0, 0, 0, 0, 0};
        float* buf = (colg < 64) ? sv : sk;
        const int cc = colg & 63;
        for (int bk = bi + 1; bk < 4; ++bk) {
          const bf16x8 al = *(const bf16x8*)(sLb + (16 * bk + r16) * 72 + 16 * bi + quad * 8);
          f32x4 c = {0.f, 0.f, 0.f, 0.f};
          c = __builtin_amdgcn_mfma_f32_16x16x32_bf16(al, bx, c, 0, 0, 0);
#pragma unroll
          for (int jj = 0; jj < 4; ++jj) buf[(16 * bk + 4 * quad + jj) * 65 + cc] -= c[jj];
        }
      }
    }
    __syncthreads();
  }
  {
    const int i = tid >> 2, j0 = (tid & 3) * 16;
    u16* GU = (u16*)(WSP(P) + WS_GU) + ci * 4096 + i * 64 + j0;
    u16* GW = (u16*)(WSP(P) + WS_GW) + ci * 4096 + i * 64 + j0;
    unsigned ou[8], ow[8];
#pragma unroll
    for (int q = 0; q < 8; ++q) {
      ou[q] = pk2(sv[i * 65 + j0 + 2 * q], sv[i * 65 + j0 + 2 * q + 1]);
      ow[q] = pk2(sk[i * 65 + j0 + 2 * q], sk[i * 65 + j0 + 2 * q + 1]);
    }
    ((uint4*)GU)[0] = make_uint4(ou[0], ou[1], ou[2], ou[3]); ((uint4*)GU)[1] = make_uint4(ou[4], ou[5], ou[6], ou[7]);
    ((uint4*)GW)[0] = make_uint4(ow[0], ow[1], ow[2], ow[3]); ((uint4*)GW)[1] = make_uint4(ow[4], ow[5], ow[6], ow[7]);
  }
}

DI void unpack8(const u16* p, float (&o)[8]) {
  uint4 v = *(const uint4*)p;
  o[0] = bf2f((u16)(v.x & 0xffff)); o[1] = bf2f((u16)(v.x >> 16));
  o[2] = bf2f((u16)(v.y & 0xffff)); o[3] = bf2f((u16)(v.y >> 16));
  o[4] = bf2f((u16)(v.z & 0xffff)); o[5] = bf2f((u16)(v.z >> 16));
  o[6] = bf2f((u16)(v.w & 0xffff)); o[7] = bf2f((u16)(v.w >> 16));
}
DI void st_kt(u16* sKt, int c8, int row, uint4 k) {
  sKt[(c8 + 0) * 72 + row] = (u16)(k.x & 0xffff); sKt[(c8 + 1) * 72 + row] = (u16)(k.x >> 16);
  sKt[(c8 + 2) * 72 + row] = (u16)(k.y & 0xffff); sKt[(c8 + 3) * 72 + row] = (u16)(k.y >> 16);
  sKt[(c8 + 4) * 72 + row] = (u16)(k.z & 0xffff); sKt[(c8 + 5) * 72 + row] = (u16)(k.z >> 16);
  sKt[(c8 + 6) * 72 + row] = (u16)(k.w & 0xffff); sKt[(c8 + 7) * 72 + row] = (u16)(k.w >> 16);
}
DI uint2 pack4bf(const f32x4& v) { uint2 r; r.x = pk2(v[0], v[1]); r.y = pk2(v[2], v[3]); return r; }
DI void gdn_p2_item(const Params& P, int it, float* lds) {
  const int tid = TID(), lane = tid & 63, w = tid >> 6, r16 = lane & 15, quad = lane >> 4;
  const int es = it & 3, bh = it >> 2, b = bh >> 2, h = bh & 3;
  u16* sW = (u16*)lds;
  u16* sQ = sW + 64 * 72;
  u16* sAm = sQ + 64 * 72;
  u16* sKt = sAm + 64 * 72;
  u16* sSt = sKt + 64 * 72;
  u16* sVnT = sSt + 16 * 72;
  u16* sVdT = sVnT + 16 * 72;
  float* sG = (float*)(sVdT + 16 * 72);
  const u16* GQ = (const u16*)(WSP(P) + WS_GQ); const u16* GK = (const u16*)(WSP(P) + WS_GK);
  const u16* GU = (const u16*)(WSP(P) + WS_GU); const u16* GW = (const u16*)(WSP(P) + WS_GW);
  const u16* GA = (const u16*)(WSP(P) + WS_GA); const float* GG = (const float*)(WSP(P) + WS_GG);
  u16* ORAW = (u16*)(WSP(P) + WS_OM) + (long)2 * T_ * 256;
  f32x4 S = {0.f, 0.f, 0.f, 0.f};
  const int irow = 16 * w + 4 * quad;
  uint4 rw0, rw1, rq0, rq1, ra0, ra1, rk0, rk1; u16 ru0, ru1, ru2, ru3; float rg = 0.f;
  const int c0 = tid, c1 = tid + 256;
  const long off0 = (c0 >> 3) * 64 + (c0 & 7) * 8, off1 = (c1 >> 3) * 64 + (c1 & 7) * 8;
#define GDN_GLOAD(CH) { long ci_ = (long)bh * 64 + (CH); \
    rw0 = *(const uint4*)(GW + ci_ * 4096 + off0); rw1 = *(const uint4*)(GW + ci_ * 4096 + off1); \
    rq0 = *(const uint4*)(GQ + ci_ * 4096 + off0); rq1 = *(const uint4*)(GQ + ci_ * 4096 + off1); \
    ra0 = *(const uint4*)(GA + ci_ * 4096 + off0); ra1 = *(const uint4*)(GA + ci_ * 4096 + off1); \
    rk0 = *(const uint4*)(GK + ci_ * 4096 + off0); rk1 = *(const uint4*)(GK + ci_ * 4096 + off1); \
    const u16* up_ = GU + ci_ * 4096 + irow * 64 + es * 16 + r16; \
    ru0 = up_[0]; ru1 = up_[64]; ru2 = up_[128]; ru3 = up_[192]; \
    if (tid < 64) rg = GG[ci_ * 64 + tid]; }
  GDN_GLOAD(0)
  for (int ch = 0; ch < 64; ++ch) {
    __syncthreads();
    {
      const int row0 = c0 >> 3, c80 = (c0 & 7) * 8, row1 = c1 >> 3, c81 = (c1 & 7) * 8;
      *(uint4*)(sW + row0 * 72 + c80) = rw0; *(uint4*)(sW + row1 * 72 + c81) = rw1;
      *(uint4*)(sQ + row0 * 72 + c80) = rq0; *(uint4*)(sQ + row1 * 72 + c81) = rq1;
      *(uint4*)(sAm + row0 * 72 + c80) = ra0; *(uint4*)(sAm + row1 * 72 + c81) = ra1;
      *(uint4*)(sKt + row0 * 72 + c80) = rk0; *(uint4*)(sKt + row1 * 72 + c81) = rk1;
    }
    if (tid < 64) sG[tid] = rg;
    *(uint2*)(sSt + r16 * 72 + irow) = pack4bf(S);
    const f32x4 uc = {bf2f(ru0), bf2f(ru1), bf2f(ru2), bf2f(ru3)};
    __syncthreads();
    if (ch + 1 < 64) GDN_GLOAD(ch + 1)
    f32x4 ws = {0.f, 0.f, 0.f, 0.f}, qs = {0.f, 0.f, 0.f, 0.f};
#pragma unroll
    for (int ks = 0; ks < 2; ++ks) {
      const bf16x8 bS = *(const bf16x8*)(sSt + r16 * 72 + ks * 32 + quad * 8);
      const bf16x8 aW = *(const bf16x8*)(sW + (16 * w + r16) * 72 + ks * 32 + quad * 8);
      const bf16x8 aQ = *(const bf16x8*)(sQ + (16 * w + r16) * 72 + ks * 32 + quad * 8);
      ws = __builtin_amdgcn_mfma_f32_16x16x32_bf16(aW, bS, ws, 0, 0, 0);
      qs = __builtin_amdgcn_mfma_f32_16x16x32_bf16(aQ, bS, qs, 0, 0, 0);
    }
    const float Gl = sG[63];
    const f32x4 G4 = *(const f32x4*)(sG + irow);
    f32x4 vn, vd;
#pragma unroll
    for (int j = 0; j < 4; ++j) { vn[j] = uc[j] - ws[j]; vd[j] = vn[j] * __expf(Gl - G4[j]); }
    *(uint2*)(sVnT + r16 * 72 + irow) = pack4bf(vn);
    *(uint2*)(sVdT + r16 * 72 + irow) = pack4bf(vd);
    __syncthreads();
    f32x4 av = {0.f, 0.f, 0.f, 0.f}, kv = {0.f, 0.f, 0.f, 0.f};
#pragma unroll
    for (int ks = 0; ks < 2; ++ks) {
      const bf16x8 bVn = *(const bf16x8*)(sVnT + r16 * 72 + ks * 32 + quad * 8);
      const bf16x8 bVd = *(const bf16x8*)(sVdT + r16 * 72 + ks * 32 + quad * 8);
      const bf16x8 aA = *(const bf16x8*)(sAm + (16 * w + r16) * 72 + ks * 32 + quad * 8);
      const bf16x8 aK = *(const bf16x8*)(sKt + (16 * w + r16) * 72 + ks * 32 + quad * 8);
      av = __builtin_amdgcn_mfma_f32_16x16x32_bf16(aA, bVn, av, 0, 0, 0);
      kv = __builtin_amdgcn_mfma_f32_16x16x32_bf16(aK, bVd, kv, 0, 0, 0);
    }
    {
      u16* op = ORAW + ((long)(b * SEQ + ch * 64 + irow)) * 256 + h * 64 + es * 16 + r16;
#pragma unroll
      for (int j = 0; j < 4; ++j) op[j * 256] = f2bf(__expf(G4[j]) * qs[j] + av[j]);
    }
    const float gl = __expf(Gl);
#pragma unroll
    for (int j = 0; j < 4; ++j) S[j] = S[j] * gl + kv[j];
  }
#undef GDN_GLOAD
}
DI void gdn_post_item(const Params& P, int l, int it) {
  const int lane = TID() & 63, w = TID() >> 6;
  const u16* PROJ = (const u16*)(WSP(P) + WS_PROJ);
  u16* O = (u16*)(WSP(P) + WS_OM) + (long)2 * T_ * 256;
  const float wn = P.in[23][l * 64 + lane];
#pragma unroll 4
  for (int q = 0; q < 16; ++q) {
    long t = (long)it * 16 + w * 4 + (q >> 2); int h = q & 3;
    float o = bf2f(O[t * 256 + h * 64 + lane]);
    float ss = wave_sum(o * o);
    float y = o * rsqrtf(ss * (1.f / 64.f) + EPS) * wn;
    float z = bf2f(PROJ[t * PW + P_GZ + h * 64 + lane]);
    O[t * 256 + h * 64 + lane] = f2bf(y * siluf_(z));
  }
}

DI void kv_gload(uint4& k0, uint4& k1, uint4& v0, uint4& v1, const u16* ksrc, const u16* vsrc, long ld) {
  const int tid = TID(), r0 = tid >> 3, ch = tid & 7;
  k0 = *(const uint4*)(ksrc + (long)r0 * ld + ch * 8); k1 = *(const uint4*)(ksrc + (long)(r0 + 32) * ld + ch * 8);
  v0 = *(const uint4*)(vsrc + (long)r0 * ld + ch * 8); v1 = *(const uint4*)(vsrc + (long)(r0 + 32) * ld + ch * 8);
}
DI void k_gload(uint4& k0, uint4& k1, const u16* ksrc, long ld) {
  const int tid = TID(), r0 = tid >> 3, ch = tid & 7;
  k0 = *(const uint4*)(ksrc + (long)r0 * ld + ch * 8); k1 = *(const uint4*)(ksrc + (long)(r0 + 32) * ld + ch * 8);
}
DI void k_store(const uint4& k0, const uint4& k1, u16* sK) {
  const int tid = TID(), r0 = tid >> 3, ch = tid & 7;
  *(uint4*)(sK + r0 * 72 + ch * 8) = k0; *(uint4*)(sK + (r0 + 32) * 72 + ch * 8) = k1;
}
DI void kv_store(const uint4& k0, const uint4& k1, const uint4& v0, const uint4& v1, u16* sK, u16* sVt) {
  const int tid = TID(), r0 = tid >> 3, ch = tid & 7;
  *(uint4*)(sK + r0 * 72 + ch * 8) = k0; *(uint4*)(sK + (r0 + 32) * 72 + ch * 8) = k1;
  const int ksw = 16 * (ch >> 1);
  st_kt(sVt, ch * 8, r0 ^ ksw, v0); st_kt(sVt, ch * 8, (r0 + 32) ^ ksw, v1);
}
DI void sb_attn_item(const Params& P, int it, u16* sQ, u16* sK, u16* sVt) {
  const int tid = TID(), lane = tid & 63, w = tid >> 6, r16 = lane & 15, quad = lane >> 4;
  const int qb = 63 - (it >> 5), bh = it & 31, b = bh >> 2, h = bh & 3;
  const u16* PROJ = (const u16*)(WSP(P) + WS_PROJ);
  u16* OUT = (u16*)(WSP(P) + WS_OM) + (long)3 * T_ * 256;
  const long tb = (long)b * SEQ;
  load_tile(sQ, PROJ + (tb + qb * 64) * PW + P_SB + h * 64, PW);
  __syncthreads();
  bf16x8 bq[2]; load_qfrag(bq, sQ, w, lane);
  const int tq = qb * 64 + 16 * w + r16;
  f32x4 ot[4];
#pragma unroll
  for (int dt = 0; dt < 4; ++dt) ot[dt] = (f32x4){0.f, 0.f, 0.f, 0.f};
  float R = 0.f;
  uint4 pk0, pk1, pv0, pv1;
  kv_gload(pk0, pk1, pv0, pv1, PROJ + (tb + qb * 64) * PW + P_SB + 256 + h * 64, PROJ + (tb + qb * 64) * PW + P_SB + 512 + h * 64, PW);
  for (int kb = qb; kb >= 0; --kb) {
    if (__syncthreads_and(R < -104.f)) break;
    kv_store(pk0, pk1, pv0, pv1, sK, sVt);
    __syncthreads();
    if (kb > 0) kv_gload(pk0, pk1, pv0, pv1, PROJ + (tb + (kb - 1) * 64) * PW + P_SB + 256 + h * 64, PROJ + (tb + (kb - 1) * 64) * PW + P_SB + 512 + h * 64, PW);
    f32x4 st[4];
    st_mma(st, sK, bq, lane);
    float gs[4], zz[4][4], x[4][4];
#pragma unroll
    for (int mt = 0; mt < 4; ++mt) {
      float g = 0.f;
#pragma unroll
      for (int j = 0; j < 4; ++j) {
        int s = kb * 64 + 16 * mt + 4 * quad + j;
        float z = st[mt][j] * 0.125f;
        float sp = softplusf_(z);
        bool mk = s < tq;
        x[mt][j] = mk ? -sp : 0.f;
        zz[mt][j] = mk ? (z - sp) : -1e30f;
        g += x[mt][j];
      }
      gs[mt] = g;
    }
    float hm = 0.f, tot_all = 0.f;
    f32x4 pw[4];
#pragma unroll
    for (int mt = 3; mt >= 0; --mt) {
      float g = gs[mt];
      float v1 = __shfl_down(g, 16), v2 = __shfl_down(g, 32), v3 = __shfl_down(g, 48);
      float hq = (quad < 3 ? v1 : 0.f) + (quad < 2 ? v2 : 0.f) + (quad < 1 ? v3 : 0.f);
      float tot = quad_sum(g);
      float base = R + hm + hq;
      float e3 = 0.f, e2 = x[mt][3], e1 = e2 + x[mt][2], e0 = e1 + x[mt][1];
      pw[mt][0] = __expf(zz[mt][0] + base + e0);
      pw[mt][1] = __expf(zz[mt][1] + base + e1);
      pw[mt][2] = __expf(zz[mt][2] + base + e2);
      pw[mt][3] = __expf(zz[mt][3] + base + e3);
      hm += tot; tot_all += tot;
    }
    R += tot_all;
    pv_mma(ot, sVt, pw, lane);
  }
  const long t = tb + tq;
#pragma unroll
  for (int dt = 0; dt < 4; ++dt) {
    uint2 ov; ov.x = pk2(ot[dt][0], ot[dt][1]); ov.y = pk2(ot[dt][2], ot[dt][3]);
    *(uint2*)(OUT + t * 256 + h * 64 + 16 * dt + 4 * quad) = ov;
  }
}

DI void win_attn_item(const Params& P, int it, u16* sQ, u16* sKunused, u16* sVunused) {
  const int tid = TID(), lane = tid & 63, w = tid >> 6, r16 = lane & 15, quad = lane >> 4;
  const int tbk = 127 - (it >> 3), b = it & 7;
  u16* sK = sQ + 128 * 72;
  u16* sVt = sK + 64 * 72;
  (void)sKunused; (void)sVunused;
  const u16* PROJ = (const u16*)(WSP(P) + WS_PROJ);
  const u16* QR = (const u16*)(WSP(P) + WS_QR);
  u16* OW = (u16*)(WSP(P) + WS_OW);
  const long tb = (long)b * SEQ;
  const int t0 = tbk * 32;
#pragma unroll
  for (int i = 0; i < 4; ++i) {
    const int c = tid + 256 * i, row = c >> 3, ch = c & 7;
    *(uint4*)(sQ + row * 72 + ch * 8) = *(const uint4*)(QR + (tb + t0 + (row & 31)) * 256 + (row >> 5) * 64 + ch * 8);
  }
  __syncthreads();
  bf16x8 bq[2][2];
  int tq[2];
#pragma unroll
  for (int qt = 0; qt < 2; ++qt) {
    const int rowq = 32 * w + 16 * qt + r16;
    bq[qt][0] = *(const bf16x8*)(sQ + rowq * 72 + quad * 8);
    bq[qt][1] = *(const bf16x8*)(sQ + rowq * 72 + 32 + quad * 8);
    tq[qt] = t0 + 16 * qt + r16;
  }
  f32x4 ot[2][4];
#pragma unroll
  for (int qt = 0; qt < 2; ++qt)
#pragma unroll
    for (int dt = 0; dt < 4; ++dt) ot[qt][dt] = (f32x4){0.f, 0.f, 0.f, 0.f};
  float m[2] = {-1e30f, -1e30f}, lsum[2] = {0.f, 0.f};
  const int lo = (t0 - 511) > 0 ? (t0 - 511) : 0;
  const int kb_lo = lo >> 6, kb_hi = (t0 + 31) >> 6;
  uint4 pk0, pk1, pv0, pv1;
  kv_gload(pk0, pk1, pv0, pv1, PROJ + (tb + kb_lo * 64) * PW + P_KV + 256, PROJ + (tb + kb_lo * 64) * PW + P_KV + 320, PW);
  for (int kb = kb_lo; kb <= kb_hi; ++kb) {
    __syncthreads();
    kv_store(pk0, pk1, pv0, pv1, sK, sVt);
    __syncthreads();
    if (kb < kb_hi) kv_gload(pk0, pk1, pv0, pv1, PROJ + (tb + (kb + 1) * 64) * PW + P_KV + 256, PROJ + (tb + (kb + 1) * 64) * PW + P_KV + 320, PW);
#pragma unroll
    for (int qt = 0; qt < 2; ++qt) {
      f32x4 st[4];
      st_mma(st, sK, bq[qt], lane);
      bool msk[4][4];
#pragma unroll
      for (int mt = 0; mt < 4; ++mt)
#pragma unroll
        for (int j = 0; j < 4; ++j) { int s = kb * 64 + 16 * mt + 4 * quad + j; int df = tq[qt] - s; msk[mt][j] = (df >= 0) && (df < 512); }
      softmax_tile(st, msk, m[qt], lsum[qt], ot[qt]);
      pv_mma(ot[qt], sVt, st, lane);
    }
  }
#pragma unroll
  for (int qt = 0; qt < 2; ++qt) {
    const float ls = quad_sum(lsum[qt]);
    const float inv = 1.f / fmaxf(ls, 1e-30f);
    const long t = tb + tq[qt];
#pragma unroll
    for (int dt = 0; dt < 4; ++dt) {
      uint2 ov; ov.x = pk2(ot[qt][dt][0] * inv, ot[qt][dt][1] * inv); ov.y = pk2(ot[qt][dt][2] * inv, ot[qt][dt][3] * inv);
      *(uint2*)(OW + t * 256 + w * 64 + 16 * dt + 4 * quad) = ov;
    }
  }
}

DI void cmp_attn_item(const Params& P, int it, u16* sQ, u16* sK, u16* sVt, float* sImp) {
  const int tid = TID(), lane = tid & 63, w = tid >> 6, r16 = lane & 15, quad = lane >> 4;
  const int tbk = 255 - (it >> 3), b = it & 7;
  const u16* PROJ = (const u16*)(WSP(P) + WS_PROJ);
  const u16* KC = (const u16*)(WSP(P) + WS_KC) + (long)b * 256 * 64;
  const u16* VC = (const u16*)(WSP(P) + WS_VC) + (long)b * 256 * 64;
  u16* OC = (u16*)(WSP(P) + WS_OC);
  u64* SEL = (u64*)(WSP(P) + WS_SEL);
  const long tb = (long)b * SEQ;
  const int t0 = tbk * 16;
  load_q_nsa(sQ, PROJ + (tb + t0) * PW + P_Q, PW);
  for (int e = tid; e < 4 * 16 * 64; e += 256) sImp[e] = 0.f;
  __syncthreads();
  bf16x8 bq[2]; load_qfrag(bq, sQ, w, lane);
  const int tq = t0 + r16;
  const int nv = (tq >= 31) ? ((tq - 31) >> 4) + 1 : 0;
  const int nvmax = (t0 + 15 >= 31) ? ((t0 + 15 - 31) >> 4) + 1 : 0;
  const int ntile = (nvmax + 63) >> 6;
  float m = -1e30f, lsum = 0.f;
  uint4 pk0, pk1, pv0, pv1;
  if (ntile > 0) k_gload(pk0, pk1, KC, 64);
  for (int kt = 0; kt < ntile; ++kt) {
    __syncthreads();
    k_store(pk0, pk1, sK);
    __syncthreads();
    if (kt + 1 < ntile) k_gload(pk0, pk1, KC + (kt + 1) * 64 * 64, 64);
    f32x4 st[4];
    st_mma(st, sK, bq, lane);
    float tm = -1e30f;
#pragma unroll
    for (int mt = 0; mt < 4; ++mt)
#pragma unroll
      for (int j = 0; j < 4; ++j) { int n = kt * 64 + 16 * mt + 4 * quad + j; float s = st[mt][j] * 0.125f; st[mt][j] = s; if (n < nv) tm = fmaxf(tm, s); }
    tm = quad_max(tm);
    float mn = fmaxf(m, tm);
    float ps = 0.f;
#pragma unroll
    for (int mt = 0; mt < 4; ++mt)
#pragma unroll
      for (int j = 0; j < 4; ++j) { int n = kt * 64 + 16 * mt + 4 * quad + j; if (n < nv) ps += __expf(st[mt][j] - mn); }
    lsum = lsum * __expf(m - mn) + ps;
    m = mn;
  }
  lsum = quad_sum(lsum);
  const float inv = (lsum > 0.f) ? 1.f / lsum : 0.f;
  f32x4 ot[4];
#pragma unroll
  for (int dt = 0; dt < 4; ++dt) ot[dt] = (f32x4){0.f, 0.f, 0.f, 0.f};
  float carry = 0.f;
  if (ntile > 0) kv_gload(pk0, pk1, pv0, pv1, KC, VC, 64);
  for (int kt = 0; kt < ntile; ++kt) {
    __syncthreads();
    kv_store(pk0, pk1, pv0, pv1, sK, sVt);
    __syncthreads();
    if (kt + 1 < ntile) kv_gload(pk0, pk1, pv0, pv1, KC + (kt + 1) * 64 * 64, VC + (kt + 1) * 64 * 64, 64);
    f32x4 st[4];
    st_mma(st, sK, bq, lane);
#pragma unroll
    for (int mt = 0; mt < 4; ++mt)
#pragma unroll
      for (int j = 0; j < 4; ++j) { int n = kt * 64 + 16 * mt + 4 * quad + j; st[mt][j] = (n < nv) ? __expf(st[mt][j] * 0.125f - m) * inv : 0.f; }
    pv_mma(ot, sVt, st, lane);
    float prevlast = carry;
#pragma unroll
    for (int mt = 0; mt < 4; ++mt) {
      float pl = st[mt][3];
      float fd = __shfl_up(pl, 16);
      float pprev = (quad > 0) ? fd : prevlast;
      float v = st[mt][0] + st[mt][1] + st[mt][2] + st[mt][3] + pprev;
      sImp[(w * 16 + r16) * 64 + kt * 16 + mt * 4 + quad] = v;
      prevlast = __shfl_down(pl, 48);
    }
    carry = prevlast;
  }
  {
    const long t = tb + tq;
#pragma unroll
    for (int dt = 0; dt < 4; ++dt) {
      uint2 ov; ov.x = pk2(ot[dt][0], ot[dt][1]); ov.y = pk2(ot[dt][2], ot[dt][3]);
      *(uint2*)(OC + t * 256 + w * 64 + 16 * dt + 4 * quad) = ov;
    }
  }
  __syncthreads();
  for (int q = 0; q < 4; ++q) {
    const int tok = 4 * w + q, t = t0 + tok;
    float v = sImp[(0 * 16 + tok) * 64 + lane] + sImp[(1 * 16 + tok) * 64 + lane] + sImp[(2 * 16 + tok) * 64 + lane] + sImp[(3 * 16 + tok) * 64 + lane];
    const int cur = t >> 6;
    if (lane == 0 || lane == cur) v = 1e9f;
    else if (lane * 64 > t) v = -1e30f;
    int cnt = 0;
#pragma unroll
    for (int i2 = 0; i2 < 64; ++i2) {
      float vi = __builtin_bit_cast(float, __builtin_amdgcn_readlane(__builtin_bit_cast(int, v), i2));
      cnt += (vi > v || (vi == v && i2 < lane)) ? 1 : 0;
    }
    u64 mask = __ballot(cnt < 16);
    if (lane == 0) SEL[tb + t] = mask;
  }
}

DI void sel_attn_item(const Params& P, int it, u16* sQ, u16* sKunused, u16* sVunused) {
  const int tid = TID(), lane = tid & 63, w = tid >> 6, r16 = lane & 15, quad = lane >> 4;
  const int tbk = 127 - (it >> 3), b = it & 7;
  u16* sK = sQ + 128 * 72;
  u16* sVt = sK + 64 * 72;
  (void)sKunused; (void)sVunused;
  const u16* PROJ = (const u16*)(WSP(P) + WS_PROJ);
  const u16* QR = (const u16*)(WSP(P) + WS_QR);
  const u16* OC = (const u16*)(WSP(P) + WS_OC);
  const u16* OW = (const u16*)(WSP(P) + WS_OW);
  const u64* SEL = (const u64*)(WSP(P) + WS_SEL);
  u16* OUT = (u16*)(WSP(P) + WS_OM);
  const long tb = (long)b * SEQ;
  const int t0 = tbk * 32;
#pragma unroll
  for (int i = 0; i < 4; ++i) {
    const int c = tid + 256 * i, row = c >> 3, ch = c & 7;
    *(uint4*)(sQ + row * 72 + ch * 8) = *(const uint4*)(QR + (tb + t0 + (row & 31)) * 256 + (row >> 5) * 64 + ch * 8);
  }
  __syncthreads();
  bf16x8 bq[2][2];
  int tq[2]; u64 mysel[2];
#pragma unroll
  for (int qt = 0; qt < 2; ++qt) {
    const int rowq = 32 * w + 16 * qt + r16;
    bq[qt][0] = *(const bf16x8*)(sQ + rowq * 72 + quad * 8);
    bq[qt][1] = *(const bf16x8*)(sQ + rowq * 72 + 32 + quad * 8);
    tq[qt] = t0 + 16 * qt + r16;
    mysel[qt] = SEL[tb + tq[qt]];
  }
  u64 uni = 0;
#pragma unroll
  for (int q = 0; q < 32; ++q) uni |= SEL[tb + t0 + q];
  const int cur = t0 >> 6;
  uni &= (cur == 63) ? ~0ull : ((1ull << (cur + 1)) - 1ull);
  f32x4 ot[2][4];
#pragma unroll
  for (int qt = 0; qt < 2; ++qt)
#pragma unroll
    for (int dt = 0; dt < 4; ++dt) ot[qt][dt] = (f32x4){0.f, 0.f, 0.f, 0.f};
  float m[2] = {-1e30f, -1e30f}, lsum[2] = {0.f, 0.f};
  uint4 pk0, pk1, pv0, pv1;
  int kb = uni ? (__ffsll((long long)uni) - 1) : -1;
  uni &= uni - 1;
  if (kb >= 0) kv_gload(pk0, pk1, pv0, pv1, PROJ + (tb + kb * 64) * PW + P_KV + 128, PROJ + (tb + kb * 64) * PW + P_KV + 192, PW);
  for (int nkb = -1; kb >= 0; kb = nkb) {
    __syncthreads();
    kv_store(pk0, pk1, pv0, pv1, sK, sVt);
    __syncthreads();
    nkb = uni ? (__ffsll((long long)uni) - 1) : -1;
    uni &= uni - 1;
    if (nkb >= 0) kv_gload(pk0, pk1, pv0, pv1, PROJ + (tb + nkb * 64) * PW + P_KV + 128, PROJ + (tb + nkb * 64) * PW + P_KV + 192, PW);
#pragma unroll
    for (int qt = 0; qt < 2; ++qt) {
      f32x4 st[4];
      st_mma(st, sK, bq[qt], lane);
      const bool selq = (mysel[qt] >> kb) & 1ull;
      bool msk[4][4];
#pragma unroll
      for (int mt = 0; mt < 4; ++mt)
#pragma unroll
        for (int j = 0; j < 4; ++j) { int s = kb * 64 + 16 * mt + 4 * quad + j; msk[mt][j] = selq && (s <= tq[qt]); }
      softmax_tile(st, msk, m[qt], lsum[qt], ot[qt]);
      pv_mma(ot[qt], sVt, st, lane);
    }
  }
#pragma unroll
  for (int qt = 0; qt < 2; ++qt) {
    const float ls = quad_sum(lsum[qt]);
    const float inv = 1.f / fmaxf(ls, 1e-30f);
    const long t = tb + tq[qt];
    const float gc = sigmoidf_(bf2f(PROJ[t * PW + P_NG + w * 3 + 0]));
    const float gsl = sigmoidf_(bf2f(PROJ[t * PW + P_NG + w * 3 + 1]));
    const float gw = sigmoidf_(bf2f(PROJ[t * PW + P_NG + w * 3 + 2]));
#pragma unroll
    for (int dt = 0; dt < 4; ++dt) {
      const long o = t * 256 + w * 64 + 16 * dt + 4 * quad;
      uint2 c = *(const uint2*)(OC + o), ww = *(const uint2*)(OW + o);
      float r0 = gc * bf2f((u16)(c.x & 0xffff)) + gsl * ot[qt][dt][0] * inv + gw * bf2f((u16)(ww.x & 0xffff));
      float r1 = gc * bf2f((u16)(c.x >> 16)) + gsl * ot[qt][dt][1] * inv + gw * bf2f((u16)(ww.x >> 16));
      float r2 = gc * bf2f((u16)(c.y & 0xffff)) + gsl * ot[qt][dt][2] * inv + gw * bf2f((u16)(ww.y & 0xffff));
      float r3 = gc * bf2f((u16)(c.y >> 16)) + gsl * ot[qt][dt][3] * inv + gw * bf2f((u16)(ww.y >> 16));
      uint2 ov; ov.x = pk2(r0, r1); ov.y = pk2(r2, r3);
      *(uint2*)(OUT + o) = ov;
    }
  }
}

DI void inproj_tile(const Params& P, int l, int it, u16* sA, u16* sB) {
  const int tid = TID(), lane = tid & 63, w = tid >> 6, r16 = lane & 15, quad = lane >> 4, wm = w >> 1, wn = w & 1;
  int mt, nt; tile_from_q(it, 22, mt, nt);
  const u16* H = (const u16*)(WSP(P) + WS_H);
  u16* PROJ = (u16*)(WSP(P) + WS_PROJ);
  const u16* Ab = H + (long)mt * 128 * DM;
  const u16* Bb = (const u16*)(WSP(P) + WS_W + WT_IN) + (long)nt * 128 * DM;
  f32x4 acc[4][4];
  gemm3<4>(acc, g3_ptr(Ab, DM, tid, 0, false), g3_ptr(Ab, DM, tid, 1, false), nullptr, nullptr, 64,
           g3_ptr(Bb, DM, tid, 0, false), g3_ptr(Bb, DM, tid, 1, false), nullptr, nullptr, DM, sA, 16L * DM, 16L * DM);
  __syncthreads();
#pragma unroll
  for (int mi = 0; mi < 4; ++mi)
#pragma unroll
    for (int ni = 0; ni < 4; ++ni)
#pragma unroll
      for (int j = 0; j < 4; ++j) sA[(wm * 64 + 16 * mi + 4 * quad + j) * 136 + wn * 64 + 16 * ni + r16] = f2bf(acc[mi][ni][j]);
  __syncthreads();
  store_tile_bf16<128>(sA, PROJ + (long)mt * 128 * PW + nt * 128, PW, 128);
}
DI void glu_tile(const Params& P, int l, int it, u16* sA, u16* sB) {
  const int tid = TID(), lane = tid & 63, w = tid >> 6, r16 = lane & 15, quad = lane >> 4, wm = w >> 1, wn = w & 1;
  const int mt = it >> 2, nt = it & 3;
  const u16* Y5 = (const u16*)(WSP(P) + WS_Y5);
  u16* OUT = (u16*)(WSP(P) + WS_OM) + (long)1 * T_ * 256;
  const u16* Ab = Y5 + (long)mt * 128 * 256;
  const u16* Bb = (const u16*)(WSP(P) + WS_W + WT_GLU) + (long)nt * 128 * 256;
  f32x4 acc[4][4];
  gemm3<4>(acc, g3_ptr(Ab, 256, tid, 0, false), g3_ptr(Ab, 256, tid, 1, false), nullptr, nullptr, 64,
           g3_ptr(Bb, 256, tid, 0, false), g3_ptr(Bb, 256, tid, 1, false), nullptr, nullptr, 256, sA, 16L * 256, 16L * 256);
  __syncthreads();
#pragma unroll
  for (int mi = 0; mi < 4; ++mi)
#pragma unroll
    for (int ni = 0; ni < 2; ++ni)
#pragma unroll
      for (int j = 0; j < 4; ++j)
        sA[(wm * 64 + 16 * mi + 4 * quad + j) * 72 + wn * 32 + 16 * ni + r16] = f2bf(acc[mi][ni][j] * sigmoidf_(acc[mi][ni + 2][j]));
  __syncthreads();
  store_tile_bf16<64>(sA, OUT + (long)mt * 128 * 256 + nt * 64, 256, 128);
}
DI void merge_tile(const Params& P, int l, int it, u16* sA, u16* sB) {
  const int tid = TID(), lane = tid & 63, w = tid >> 6, r16 = lane & 15, quad = lane >> 4, wm = w >> 1, wn = w & 1;
  int mt, nt; tile_from_q(it, 8, mt, nt);
  const u16* H = (const u16*)(WSP(P) + WS_H);
  const u16* OM = (const u16*)(WSP(P) + WS_OM);
  u16* MERGED = (u16*)(WSP(P) + WS_MERGED);
  uint2 outp[4][4];
#pragma unroll
  for (int mi = 0; mi < 4; ++mi)
#pragma unroll
    for (int ni = 0; ni < 4; ++ni) outp[mi][ni] = make_uint2(0u, 0u);
#pragma unroll 1
  for (int m = 0; m < 4; ++m) {
    uint2 gp[4][4];
    {
      f32x4 ag[4][4];
      const u16* Ab = H + (long)mt * 128 * DM;
      const u16* Bb = (const u16*)(WSP(P) + WS_W + WT_G) + ((long)(m * 1024 + nt * 128)) * DM;
      gemm3<4, true>(ag, g3_ptr(Ab, DM, tid, 0, false), g3_ptr(Ab, DM, tid, 1, false), nullptr, nullptr, 64,
               g3_ptr(Bb, DM, tid, 0, false), g3_ptr(Bb, DM, tid, 1, false), nullptr, nullptr, DM, sA, 16L * DM, 16L * DM);
#pragma unroll
      for (int mi = 0; mi < 4; ++mi)
#pragma unroll
        for (int ni = 0; ni < 4; ++ni) {
          gp[mi][ni].x = pk2(sigmoidf_(ag[mi][ni][0]), sigmoidf_(ag[mi][ni][1]));
          gp[mi][ni].y = pk2(sigmoidf_(ag[mi][ni][2]), sigmoidf_(ag[mi][ni][3]));
        }
    }
    {
      f32x4 av[4][4];
      const u16* Ab = OM + ((long)m * T_ + (long)mt * 128) * 256;
      const u16* Bb = (const u16*)(WSP(P) + WS_W + WT_BR) + ((long)(m * 1024 + nt * 128)) * 256;
      gemm3<4, true>(av, g3_ptr(Ab, 256, tid, 0, false), g3_ptr(Ab, 256, tid, 1, false), nullptr, nullptr, 64,
               g3_ptr(Bb, 256, tid, 0, false), g3_ptr(Bb, 256, tid, 1, false), nullptr, nullptr, 256, sA, 16L * 256, 16L * 256);
#pragma unroll
      for (int mi = 0; mi < 4; ++mi)
#pragma unroll
        for (int ni = 0; ni < 4; ++ni) {
          const float o0 = bf2f((u16)(outp[mi][ni].x & 0xffff)) + av[mi][ni][0] * bf2f((u16)(gp[mi][ni].x & 0xffff));
          const float o1 = bf2f((u16)(outp[mi][ni].x >> 16)) + av[mi][ni][1] * bf2f((u16)(gp[mi][ni].x >> 16));
          const float o2 = bf2f((u16)(outp[mi][ni].y & 0xffff)) + av[mi][ni][2] * bf2f((u16)(gp[mi][ni].y & 0xffff));
          const float o3 = bf2f((u16)(outp[mi][ni].y >> 16)) + av[mi][ni][3] * bf2f((u16)(gp[mi][ni].y >> 16));
          outp[mi][ni].x = pk2(o0, o1); outp[mi][ni].y = pk2(o2, o3);
        }
    }
  }
  __syncthreads();
#pragma unroll
  for (int mi = 0; mi < 4; ++mi)
#pragma unroll
    for (int ni = 0; ni < 4; ++ni)
#pragma unroll
      for (int j = 0; j < 4; ++j) {
        const unsigned wv = (j < 2) ? outp[mi][ni].x : outp[mi][ni].y;
        sA[(wm * 64 + 16 * mi + 4 * quad + j) * 136 + wn * 64 + 16 * ni + r16] = (u16)((j & 1) ? (wv >> 16) : (wv & 0xffff));
      }
  __syncthreads();
  store_tile_bf16<128>(sA, MERGED + (long)mt * 128 * DM + nt * 128, DM, 128);
}
DI void resid_tile(const u16* A, int K, const u16* Bt, const float* resid, float* out, int it, u16* sA, u16* sB) {
  const int tid = TID(), lane = tid & 63, w = tid >> 6, r16 = lane & 15, quad = lane >> 4, wm = w >> 1, wn = w & 1;
  int mt, nt; tile_from_q(it, 8, mt, nt);
  const u16* Ab = A + (long)mt * 128 * K;
  const u16* Bb = Bt + (long)nt * 128 * K;
  f32x4 acc[4][4];
  gemm3<4>(acc, g3_ptr(Ab, K, tid, 0, false), g3_ptr(Ab, K, tid, 1, false), nullptr, nullptr, 64,
           g3_ptr(Bb, K, tid, 0, false), g3_ptr(Bb, K, tid, 1, false), nullptr, nullptr, K, sA, 16L * K, 16L * K);
  float* sC = (float*)sA + w * (32 * 68);
#pragma unroll
  for (int hp = 0; hp < 2; ++hp) {
    __syncthreads();
#pragma unroll
    for (int mi2 = 0; mi2 < 2; ++mi2)
#pragma unroll
      for (int ni = 0; ni < 4; ++ni)
#pragma unroll
        for (int j = 0; j < 4; ++j) sC[(16 * mi2 + 4 * quad + j) * 68 + 16 * ni + r16] = acc[2 * hp + mi2][ni][j];
    __syncthreads();
#pragma unroll
    for (int q = 0; q < 8; ++q) {
      const int c = lane + 64 * q, row = c >> 4, c4 = (c & 15) * 4;
      const long o = ((long)mt * 128 + wm * 64 + 32 * hp + row) * DM + nt * 128 + wn * 64 + c4;
      const float4 rv = *(const float4*)(resid + o);
      const f32x4 cv = *(const f32x4*)(sC + row * 68 + c4);
      *(float4*)(out + o) = make_float4(rv.x + cv[0], rv.y + cv[1], rv.z + cv[2], rv.w + cv[3]);
    }
  }
}
DI void ffn1_tile(const Params& P, int l, int it, u16* sA, u16* sB) {
  const int tid = TID(), lane = tid & 63, w = tid >> 6, r16 = lane & 15, quad = lane >> 4, wm = w >> 1, wn = w & 1;
  int mt, nt; tile_from_q(it, 44, mt, nt);
  const u16* H = (const u16*)(WSP(P) + WS_H);
  u16* ACT = (u16*)(WSP(P) + WS_PROJ);
  const u16* Ab = H + (long)mt * 128 * DM;
  const u16* Bb = (const u16*)(WSP(P) + WS_W + WT_GU) + (long)nt * 128 * DM;
  f32x4 acc[4][4];
  gemm3<4>(acc, g3_ptr(Ab, DM, tid, 0, false), g3_ptr(Ab, DM, tid, 1, false), nullptr, nullptr, 64,
           g3_ptr(Bb, DM, tid, 0, false), g3_ptr(Bb, DM, tid, 1, false), nullptr, nullptr, DM, sA, 16L * DM, 16L * DM);
  __syncthreads();
#pragma unroll
  for (int mi = 0; mi < 4; ++mi)
#pragma unroll
    for (int ni = 0; ni < 2; ++ni)
#pragma unroll
      for (int j = 0; j < 4; ++j)
        sA[(wm * 64 + 16 * mi + 4 * quad + j) * 72 + wn * 32 + 16 * ni + r16] = f2bf(siluf_(acc[mi][ni][j]) * acc[mi][ni + 2][j]);
  __syncthreads();
  store_tile_bf16<64>(sA, ACT + (long)mt * 128 * DFF + nt * 64, DFF, 128);
}

__global__ void __launch_bounds__(256, LB2) fwd_megakernel(Params P) {
  cg::grid_group grid = cg::this_grid();
  __shared__ __attribute__((aligned(16))) float lds[17920];
  __shared__ int s_item;
  unsigned* cnt = (unsigned*)(WSP(P) + WS_CNT);
  const int xcd = (int)(__builtin_amdgcn_s_getreg((3 << 11) | 20) & 0xF) & 7;
  __shared__ int s_rank;
  if (threadIdx.x == 0) s_rank = (int)atomicAdd(cnt + 900 + xcd, 1u);
  __syncthreads();
  const int xrank = s_rank;
  u16* sA = (u16*)lds;
  u16* sB = sA + 128 * 80;
  u16* aQ = (u16*)lds;
  u16* aK = aQ + 64 * 72;
  u16* aV = aK + 64 * 72;
  float* aImp = (float*)(aV + 64 * 72);
  for (int ph = P.ph_lo; ph < P.ph_hi; ++ph) {
    const int l = ph / 11, sp = ph % 11;
    const float* xin = (l == 0) ? P.in[0] : P.out;
    const int nrep = (PROBE_DUP != 0 && l == 0 && ((PROBE_DUP >> sp) & 1)) ? 2 : 1;
    for (int rep = 0; rep < nrep; ++rep) {
    unsigned* pc = cnt + (ph + 32 * rep) * 8;
    switch (sp) {
      case 0: if (PHASE_MASK & (1 << 0)) {
        phase_rmsnorm(xin, P.in[2] + l * DM, (u16*)(WSP(P) + WS_H));
        phase_convert(P, l, lds);
        if (l == 0) phase_rope_table((const int*)P.in[1], (float*)(WSP(P) + WS_COS), (float*)(WSP(P) + WS_SIN));
      } break;
      case 1: if (PHASE_MASK & (1 << 1)) {
        XCD_STATIC_LOOP(32 * 22, inproj_tile(P, l, it, sA, sB))
      } break;
      case 2: if (PHASE_MASK & (1 << 2)) {
        for (;;) {
          int it = next_item(pc, &s_item); if (it >= 64 + 3 * 2048) break;
          if (it < 64) cmp1_tile(P, l, it, sA, sB);
          else if (it < 64 + 2048) gdn_p1_item(P, l, it - 64, lds);
          else if (it < 64 + 4096) s5_pass1_item(P, l, it - 64 - 2048, lds);
          else nsa_prep_item(P, l, it - 64 - 4096);
        }
      } break;
      case 3: if (PHASE_MASK & (1 << 3)) {
        for (;;) {
          int it = next_item(pc, &s_item); if (it >= 128 + 3072 + 64) break;
          if (it < 128) gdn_p2_item(P, it, lds);
          else if (it < 128 + 2048) sb_attn_item(P, it - 128, aQ, aK, aV);
          else if (it < 128 + 3072) win_attn_item(P, it - 128 - 2048, aQ, aK, aV);
          else if (it < 128 + 3072 + 32) s5_carry_item(P, l, it - 128 - 3072);
          else cmp2_tile(P, l, it - 128 - 3072 - 32, sA, sB, lds + 17000);
        }
      } break;
      case 4: if (PHASE_MASK & (1 << 4)) {
        for (;;) {
          int it = next_item(pc, &s_item); if (it >= 3 * 2048) break;
          if (it < 2048) cmp_attn_item(P, it, aQ, aK, aV, aImp);
          else if (it < 4096) s5_pass2_item(P, l, it - 2048, lds);
          else gdn_post_item(P, l, it - 4096);
        }
      } break;
      case 5: if (PHASE_MASK & (1 << 5)) {
        for (;;) {
          int it = next_item(pc, &s_item); if (it >= 1024 + 1024) break;
          if (it < 1024) sel_attn_item(P, it, aQ, aK, aV);
          else glu_tile(P, l, it - 1024, sA, sB);
        }
      } break;
      case 6: if (PHASE_MASK & (1 << 6)) {
        XCD_STATIC_LOOP(32 * 8, merge_tile(P, l, it, sA, sB))
      } break;
      case 7: if (PHASE_MASK & (1 << 7)) {
        XCD_STATIC_LOOP(32 * 8, resid_tile((const u16*)(WSP(P) + WS_MERGED), DM, (const u16*)(WSP(P) + WS_W + WT_OUT), xin, P.out, it, sA, sB))
      } break;
      case 8: if (PHASE_MASK & (1 << 8)) {
        phase_rmsnorm(P.out, P.in[26] + l * DM, (u16*)(WSP(P) + WS_H));
      } break;
      case 9: if (PHASE_MASK & (1 << 9)) {
        XCD_STATIC_LOOP(32 * 44, ffn1_tile(P, l, it, sA, sB))
      } break;
      case 10: if (PHASE_MASK & (1 << 10)) {
        XCD_STATIC_LOOP(32 * 8, resid_tile((const u16*)(WSP(P) + WS_PROJ), DFF, (const u16*)(WSP(P) + WS_W + WT_D), P.out, P.out, it, sA, sB))
      } break;
    }
    if (rep + 1 < nrep) grid.sync();
    }
    if (ph + 1 < P.ph_hi) grid.sync();
  }
}

extern "C" void kernel_launch(void* const* d_in, const int* in_sizes, int n_in, void* d_out, int out_size, void* d_ws, size_t ws_size,
                              hipStream_t stream) {
  static int grid_blocks = 0;
  if (!grid_blocks) {
    int dev = 0, cus = 0, per_cu = 0;
    hipGetDevice(&dev);
    hipDeviceGetAttribute(&cus, hipDeviceAttributeMultiprocessorCount, dev);
    hipOccupancyMaxActiveBlocksPerMultiprocessor(&per_cu, fwd_megakernel, 256, 0);
    if (per_cu < 1) per_cu = 1;
    if (per_cu > 2) per_cu = 2;
    grid_blocks = cus * per_cu;
    if (ws_size < WS_W + WT_END) fprintf(stderr, "kernel_launch: workspace too small: %zu\n", ws_size);
  }
  hipMemsetAsync((char*)d_ws + WS_CNT, 0, 4096, stream);
  Params p{};
  for (int i = 0; i < 30; ++i) p.in[i] = (const float*)d_in[i];
  p.out = (float*)d_out;
  p.ws = (unsigned char*)d_ws;
  p.ph_lo = 0; p.ph_hi = NPHASE;
  void* args[] = {&p};
  hipError_t e = hipLaunchCooperativeKernel((void*)fwd_megakernel, dim3(grid_blocks), dim3(256), args, 0, stream);
  if (e != hipSuccess) fprintf(stderr, "cooperative launch failed: %s (grid %d)\n", hipGetErrorString(e), grid_blocks);
}
```

```cpp
#include <hip/hip_runtime.h>
#include <hip/hip_cooperative_groups.h>
#include <cstdio>
namespace cg = cooperative_groups;

typedef unsigned short u16;
typedef unsigned long long u64;
typedef __attribute__((ext_vector_type(8))) short bf16x8;
typedef __attribute__((ext_vector_type(4))) short s16x4;
typedef __attribute__((ext_vector_type(4))) float f32x4;
#define DI __device__ __forceinline__

constexpr int NB = 8, SEQ = 4096, T_ = NB * SEQ, DM = 1024, DIN = 6804, PW = 2816, DFF = 2816;
constexpr int P_Q = 0, P_KV = 256, P_S5U = 640, P_GQKV = 896, P_GZ = 1664, P_SB = 1920, P_NG = 2688, P_GA = 2700, P_GB = 2704;
constexpr float EPS = 1e-6f;
constexpr size_t MiB = 1024ull * 1024ull;
constexpr size_t WS_H = 0, WS_PROJ = 64 * MiB, WS_OM = 240 * MiB, WS_MERGED = 304 * MiB,
                 WS_GQ = 304 * MiB, WS_GK = 320 * MiB, WS_GU = 336 * MiB, WS_GW = 352 * MiB, WS_GA = 368 * MiB,
                 WS_QR = 384 * MiB, WS_OC = 400 * MiB, WS_OW = 416 * MiB, WS_Y5 = 432 * MiB,
                 WS_GG = 448 * MiB, WS_SEL = 449 * MiB, WS_COS = 450 * MiB, WS_SIN = 451 * MiB,
                 WS_ENDS = 452 * MiB, WS_CARRY = 456 * MiB, WS_KC = 460 * MiB, WS_VC = 461 * MiB, WS_HID = 462 * MiB,
                 WS_CNT = 464 * MiB, WS_W = 465 * MiB, WS_CBIAS = 449 * MiB + 512 * 1024;
constexpr size_t WT_IN = 0, WT_G = WT_IN + 2816ull * 1024 * 2, WT_BR = WT_G + 4096ull * 1024 * 2, WT_OUT = WT_BR + 4096ull * 256 * 2,
                 WT_GU = WT_OUT + 1024ull * 1024 * 2, WT_D = WT_GU + 5632ull * 1024 * 2, WT_GLU = WT_D + 1024ull * 2816 * 2,
                 WT_C1 = WT_GLU + 512ull * 256 * 2, WT_C2 = WT_C1 + 512ull * 2048 * 2, WT_END = WT_C2 + 128ull * 256 * 2;
constexpr int NPHASE = 22;
#define XCD_STATIC_LOOP(NPER, BODY) { \
    unsigned c0_ = cnt[900], c1_ = cnt[901], c2_ = cnt[902], c3_ = cnt[903], c4_ = cnt[904], c5_ = cnt[905], c6_ = cnt[906], c7_ = cnt[907]; \
    const bool ok_ = c0_ && c1_ && c2_ && c3_ && c4_ && c5_ && c6_ && c7_; \
    const unsigned mine_ = xcd == 0 ? c0_ : xcd == 1 ? c1_ : xcd == 2 ? c2_ : xcd == 3 ? c3_ : xcd == 4 ? c4_ : xcd == 5 ? c5_ : xcd == 6 ? c6_ : c7_; \
    const int start_ = ok_ ? xcd * (NPER) + xrank : (int)blockIdx.x, end_ = ok_ ? (xcd + 1) * (NPER) : 8 * (NPER), step_ = ok_ ? (int)mine_ : (int)gridDim.x; \
    for (int it = start_; it < end_; it += step_) { BODY; } }
#ifndef PROBE_DUP
#define PROBE_DUP 0
#endif
#ifndef LB2
#define LB2 2
#endif
#ifndef PHASE_MASK
#define PHASE_MASK 0x7ff
#endif

struct Params {
  const float* in[30];
  float* out;
  unsigned char* ws;
  int ph_lo, ph_hi;
};


DI int TID() { int t = threadIdx.x; asm volatile("" : "+v"(t)); return t; }
DI unsigned char* WSP(const Params& P) { size_t z = 0; asm volatile("" : "+s"(z)); return P.ws + z; }
DI u16 f2bf(float x) { unsigned u = __float_as_uint(x); u += 0x7fffu + ((u >> 16) & 1u); return (u16)(u >> 16); }
DI float bf2f(u16 h) { return __uint_as_float(((unsigned)h) << 16); }
DI unsigned pk2(float a, float b) { return (unsigned)f2bf(a) | ((unsigned)f2bf(b) << 16); }
DI float wave_sum(float v) {
#pragma unroll
  for (int o = 1; o < 64; o <<= 1) v += __shfl_xor(v, o);
  return v;
}
DI float sigmoidf_(float x) { return 1.f / (1.f + __expf(-x)); }
DI float siluf_(float x) { return x * sigmoidf_(x); }
DI float softplusf_(float x) { return fmaxf(x, 0.f) + log1pf(__expf(-fabsf(x))); }
DI float gelu_tanh(float x) {
  float u = 0.7978845608028654f * (x + 0.044715f * x * x * x);
  float t = 1.f - 2.f / (__expf(2.f * u) + 1.f);
  return 0.5f * x * (1.f + t);
}
DI void sincos_d(double x, double& s, double& c) {
  const double TWO_PI = 6.283185307179586476925287, INV = 0.15915494309189533576888;
  double n = rint(x * INV);
  double r = x - n * TWO_PI;
  double r2 = r * r, term = 1.0, cs = 1.0, ss = 1.0;
#pragma unroll
  for (int k = 1; k <= 14; ++k) { term *= r2 * (-1.0 / (double)((2 * k - 1) * (2 * k))); cs += term; }
  term = 1.0;
#pragma unroll
  for (int k = 1; k <= 14; ++k) { term *= r2 * (-1.0 / (double)((2 * k) * (2 * k + 1))); ss += term; }
  s = r * ss; c = cs;
}
DI int next_item(unsigned* cnt, int* s_item) {
  __syncthreads();
  if (TID() == 0) *s_item = (int)atomicAdd(cnt, 1u);
  __syncthreads();
  return *s_item;
}
DI int next_tile_xcd(unsigned* cnt8, int n_per_xcd, int xcd, int* s_item) {
  asm volatile("" : "+s"(xcd));
  __syncthreads();
  if (threadIdx.x == 0) {
    int res = -1;
    for (int a = 0; a < 8; ++a) {
      int qq = (xcd + a) & 7;
      unsigned v = atomicAdd(cnt8 + qq, 1u);
      if (v < (unsigned)n_per_xcd) { res = qq * n_per_xcd + (int)v; break; }
    }
    *s_item = res;
  }
  __syncthreads();
  return *s_item;
}
DI void tile_from_q(int it, int numN, int& mt, int& nt) {
  const int per = 32 * numN, q = it / per, i = it % per, g = i / (8 * numN), rem = i % (8 * numN);
  nt = rem >> 3; mt = 32 * q + 8 * g + (rem & 7);
}
DI int proj_src_col(int pc) {
  if (pc < 640) return pc;
  if (pc < 1664) return pc + 12;
  if (pc < 2688) return pc + 20;
  if (pc < 2700) return pc - 2688 + 640;
  if (pc < 2708) return pc - 2700 + 1676;
  return pc;
}

DI uint4 addpos8(uint4 v, const float* pp) {
  uint4 o;
  o.x = pk2(bf2f((u16)(v.x & 0xffff)) + pp[0], bf2f((u16)(v.x >> 16)) + pp[1]);
  o.y = pk2(bf2f((u16)(v.y & 0xffff)) + pp[2], bf2f((u16)(v.y >> 16)) + pp[3]);
  o.z = pk2(bf2f((u16)(v.z & 0xffff)) + pp[4], bf2f((u16)(v.z >> 16)) + pp[5]);
  o.w = pk2(bf2f((u16)(v.w & 0xffff)) + pp[6], bf2f((u16)(v.w >> 16)) + pp[7]);
  return o;
}
template <int NTW>
DI void gemm2(f32x4 (&acc)[4][NTW], const u16* __restrict__ arow, long a_kstep, const float* __restrict__ apos,
              const u16* __restrict__ brow, int K, u16* sA, u16* sB) {
  constexpr int BN = 32 * NTW, BV = BN / 32, LS = 80;
  const int tid = TID(), lane = tid & 63, w = tid >> 6, r16 = lane & 15, quad = lane >> 4;
  const int wm = w >> 1, wn = w & 1;
  u16* sa_st = sA + (tid >> 1) * LS + (tid & 1) * 32;
  u16* sb_st = (BN == 128) ? (sB + (tid >> 1) * LS + (tid & 1) * 32) : (sB + (tid >> 2) * LS + (tid & 3) * 16);
  uint4 pa0, pa1, pa2, pa3, pb0, pb1, pb2, pb3;
  uint4 qa0, qa1, qa2, qa3, qb0, qb1, qb2, qb3;
  pb2 = make_uint4(0, 0, 0, 0); pb3 = pb2; qb2 = pb2; qb3 = pb2;
#define G2_LOAD(KT, a0, a1, a2, a3, b0, b1, b2, b3) { const uint4* pa_ = (const uint4*)(arow + (long)(KT) * a_kstep); \
    a0 = pa_[0]; a1 = pa_[1]; a2 = pa_[2]; a3 = pa_[3]; \
    if (apos) { const float* pp_ = apos + (KT) * 64 + (tid & 1) * 32; \
      a0 = addpos8(a0, pp_); a1 = addpos8(a1, pp_ + 8); a2 = addpos8(a2, pp_ + 16); a3 = addpos8(a3, pp_ + 24); } \
    const uint4* pb_ = (const uint4*)(brow + (long)(KT) * 64); \
    b0 = pb_[0]; b1 = pb_[1]; if (BV == 4) { b2 = pb_[2]; b3 = pb_[3]; } }
#define G2_STORE(a0, a1, a2, a3, b0, b1, b2, b3) { \
    ((uint4*)sa_st)[0] = a0; ((uint4*)sa_st)[1] = a1; ((uint4*)sa_st)[2] = a2; ((uint4*)sa_st)[3] = a3; \
    ((uint4*)sb_st)[0] = b0; ((uint4*)sb_st)[1] = b1; if (BV == 4) { ((uint4*)sb_st)[2] = b2; ((uint4*)sb_st)[3] = b3; } }
#define G2_COMPUTE() { _Pragma("unroll") for (int ks = 0; ks < 2; ++ks) { \
      bf16x8 af[4], bg[NTW]; \
      _Pragma("unroll") for (int mi = 0; mi < 4; ++mi) af[mi] = *(const bf16x8*)(sA + (wm * 64 + 16 * mi + r16) * LS + ks * 32 + quad * 8); \
      _Pragma("unroll") for (int ni = 0; ni < NTW; ++ni) bg[ni] = *(const bf16x8*)(sB + (wn * (BN / 2) + 16 * ni + r16) * LS + ks * 32 + quad * 8); \
      _Pragma("unroll") for (int mi = 0; mi < 4; ++mi) \
        _Pragma("unroll") for (int ni = 0; ni < NTW; ++ni) acc[mi][ni] = __builtin_amdgcn_mfma_f32_16x16x32_bf16(af[mi], bg[ni], acc[mi][ni], 0, 0, 0); } }
#pragma unroll
  for (int mi = 0; mi < 4; ++mi)
#pragma unroll
    for (int ni = 0; ni < NTW; ++ni) acc[mi][ni] = (f32x4){0.f, 0.f, 0.f, 0.f};
  const int nk = K >> 6;
  G2_LOAD(0, pa0, pa1, pa2, pa3, pb0, pb1, pb2, pb3)
  G2_LOAD(1, qa0, qa1, qa2, qa3, qb0, qb1, qb2, qb3)
#pragma unroll 1
  for (int kt = 0; kt < nk; kt += 2) {
    __syncthreads();
    G2_STORE(pa0, pa1, pa2, pa3, pb0, pb1, pb2, pb3)
    __syncthreads();
    if (kt + 2 < nk) G2_LOAD(kt + 2, pa0, pa1, pa2, pa3, pb0, pb1, pb2, pb3)
    G2_COMPUTE()
    __syncthreads();
    G2_STORE(qa0, qa1, qa2, qa3, qb0, qb1, qb2, qb3)
    __syncthreads();
    if (kt + 3 < nk) G2_LOAD(kt + 3, qa0, qa1, qa2, qa3, qb0, qb1, qb2, qb3)
    G2_COMPUTE()
  }
#undef G2_LOAD
#undef G2_STORE
#undef G2_COMPUTE
}
DI void g3_rowpiece(int tid, int q, bool n64, int& row, int& pc) {
  const int w = tid >> 6, lane = tid & 63, chunk = n64 ? (2 * w + q) : (4 * w + q);
  row = 8 * chunk + (lane >> 3);
  pc = (lane & 7) ^ ((row >> 1) & 7);
}
DI const u16* g3_ptr(const u16* base, long ld, int tid, int q, bool n64) {
  int row, pc; g3_rowpiece(tid, q, n64, row, pc);
  return base + (long)row * ld + pc * 8;
}
template <int NTW, bool LEAN = false>
DI void gemm3(f32x4 (&acc)[4][NTW], const u16* ap0, const u16* ap1, const u16* ap2, const u16* ap3, long a_kstep,
              const u16* bp0, const u16* bp1, const u16* bp2, const u16* bp3, int K, u16* sbase, long a16 = 0, long b16 = 0) {
  constexpr int BN = 32 * NTW, STAGE = 16384;
  const int tid = TID(), lane = tid & 63, w = tid >> 6, r16 = lane & 15, quad = lane >> 4;
  const int wm = w >> 1, wn = w & 1;
  const int sz = (r16 >> 1) & 7;
  const int wu = __builtin_amdgcn_readfirstlane(w);
#define G3_GLDS(GP, LOFF) asm volatile("s_mov_b32 m0, %1\n\ts_nop 0\n\tglobal_load_lds_dwordx4 %0, off" :: "v"(GP), "s"(LOFF) : "memory", "m0")
  const unsigned lds0 = (unsigned)(size_t)sbase;
#define G3_ISSUE(KT) { const unsigned st_ = lds0 + (((KT) & 1) ? STAGE * 2 : 0); const long ka_ = (long)(KT) * a_kstep, kb_ = (long)(KT) * 64; \
    if (BN == 128) { \
      const unsigned la_ = __builtin_amdgcn_readfirstlane(st_ + wu * 4096u); \
      G3_GLDS(ap0 + ka_, la_); G3_GLDS(ap1 + ka_, la_ + 1024u); \
      if (a16) { G3_GLDS(ap0 + (ka_ + a16), la_ + 2048u); G3_GLDS(ap1 + (ka_ + a16), la_ + 3072u); } else { G3_GLDS(ap2 + ka_, la_ + 2048u); G3_GLDS(ap3 + ka_, la_ + 3072u); } \
      G3_GLDS(bp0 + kb_, la_ + 16384u); G3_GLDS(bp1 + kb_, la_ + 17408u); \
      if (b16) { G3_GLDS(bp0 + (kb_ + b16), la_ + 18432u); G3_GLDS(bp1 + (kb_ + b16), la_ + 19456u); } else { G3_GLDS(bp2 + kb_, la_ + 18432u); G3_GLDS(bp3 + kb_, la_ + 19456u); } \
    } else { \
      const unsigned la_ = __builtin_amdgcn_readfirstlane(st_ + wu * 4096u); \
      const unsigned lb_ = __builtin_amdgcn_readfirstlane(st_ + 16384u + wu * 2048u); \
      G3_GLDS(ap0 + ka_, la_); G3_GLDS(ap1 + ka_, la_ + 1024u); G3_GLDS(ap2 + ka_, la_ + 2048u); G3_GLDS(ap3 + ka_, la_ + 3072u); \
      G3_GLDS(bp0 + kb_, lb_); G3_GLDS(bp1 + kb_, lb_ + 1024u); \
    } }
#pragma unroll
  for (int mi = 0; mi < 4; ++mi)
#pragma unroll
    for (int ni = 0; ni < NTW; ++ni) acc[mi][ni] = (f32x4){0.f, 0.f, 0.f, 0.f};
  const int nk = K >> 6;
  __syncthreads();
  G3_ISSUE(0)
  if (!LEAN && BN == 128) {
#define G3_PIECE(I, KT) { const unsigned st_ = lds0 + (((KT) & 1) ? STAGE * 2 : 0); const long ka_ = (long)(KT) * a_kstep, kb_ = (long)(KT) * 64; \
      const unsigned la_ = __builtin_amdgcn_readfirstlane(st_ + wu * 4096u); \
      if ((I) == 0) G3_GLDS(ap0 + ka_, la_); else if ((I) == 1) G3_GLDS(ap1 + ka_, la_ + 1024u); \
      else if ((I) == 2) G3_GLDS((a16 ? ap0 + a16 : ap2) + ka_, la_ + 2048u); else if ((I) == 3) G3_GLDS((a16 ? ap1 + a16 : ap3) + ka_, la_ + 3072u); \
      else if ((I) == 4) G3_GLDS(bp0 + kb_, la_ + 16384u); else if ((I) == 5) G3_GLDS(bp1 + kb_, la_ + 17408u); \
      else if ((I) == 6) G3_GLDS((b16 ? bp0 + b16 : bp2) + kb_, la_ + 18432u); else G3_GLDS((b16 ? bp1 + b16 : bp3) + kb_, la_ + 19456u); }
#define G3_STEP(KT, DOISSUE) { const u16* sAs = sbase + ((KT) & 1) * STAGE; const u16* sBs = sAs + 8192; \
      _Pragma("unroll") for (int ks = 0; ks < 2; ++ks) { \
        const int pcol = ((ks * 4 + quad) ^ sz) * 8; \
        bf16x8 af[4], bg[NTW]; \
        _Pragma("unroll") for (int mi = 0; mi < 4; ++mi) af[mi] = *(const bf16x8*)(sAs + (wm * 64 + 16 * mi + r16) * 64 + pcol); \
        _Pragma("unroll") for (int ni = 0; ni < NTW; ++ni) bg[ni] = *(const bf16x8*)(sBs + (wn * (BN / 2) + 16 * ni + r16) * 64 + pcol); \
        _Pragma("unroll") for (int mi = 0; mi < 4; ++mi) { \
          if (ks == 0) {   \
            acc[mi][0] = __builtin_amdgcn_mfma_f32_16x16x32_bf16(af[mi], bg[0], acc[mi][0], 0, 0, 0); \
            acc[mi][1] = __builtin_amdgcn_mfma_f32_16x16x32_bf16(af[mi], bg[1], acc[mi][1], 0, 0, 0); \
            if (DOISSUE) G3_PIECE(2 * mi, (KT) + 1) \
            __builtin_amdgcn_sched_barrier(0); \
            acc[mi][2] = __builtin_amdgcn_mfma_f32_16x16x32_bf16(af[mi], bg[2], acc[mi][2], 0, 0, 0); \
            acc[mi][3] = __builtin_amdgcn_mfma_f32_16x16x32_bf16(af[mi], bg[3], acc[mi][3], 0, 0, 0); \
            if (DOISSUE) G3_PIECE(2 * mi + 1, (KT) + 1) \
            __builtin_amdgcn_sched_barrier(0); \
          } else { \
            _Pragma("unroll") for (int ni = 0; ni < NTW; ++ni) acc[mi][ni] = __builtin_amdgcn_mfma_f32_16x16x32_bf16(af[mi], bg[ni], acc[mi][ni], 0, 0, 0); \
          } } } }
#pragma unroll 1
    for (int kt = 0; kt < nk - 1; ++kt) {
      asm volatile("s_waitcnt vmcnt(0) lgkmcnt(0)" ::: "memory");
      __builtin_amdgcn_s_barrier();
      asm volatile("" ::: "memory");
      G3_STEP(kt, true)
    }
    asm volatile("s_waitcnt vmcnt(0) lgkmcnt(0)" ::: "memory");
    __builtin_amdgcn_s_barrier();
    asm volatile("" ::: "memory");
    G3_STEP(nk - 1, false)
#undef G3_PIECE
#undef G3_STEP
  } else
#pragma unroll 1
  for (int kt = 0; kt < nk; ++kt) {
    asm volatile("s_waitcnt vmcnt(0) lgkmcnt(0)" ::: "memory");
    __builtin_amdgcn_s_barrier();
    asm volatile("" ::: "memory");
    if (kt + 1 < nk) G3_ISSUE(kt + 1)
    const u16* sAs = sbase + (kt & 1) * STAGE;
    const u16* sBs = sAs + 8192;
#pragma unroll 1
    for (int ks = 0; ks < (LEAN ? 2 : 0); ++ks) {
      const int pcol = ((ks * 4 + quad) ^ sz) * 8;
      bf16x8 af[4];
#pragma unroll
      for (int mi = 0; mi < 4; ++mi) af[mi] = *(const bf16x8*)(sAs + (wm * 64 + 16 * mi + r16) * 64 + pcol);
#pragma unroll
      for (int ni = 0; ni < NTW; ++ni) {
        bf16x8 b1 = *(const bf16x8*)(sBs + (wn * (BN / 2) + 16 * ni + r16) * 64 + pcol);
#pragma unroll
        for (int mi = 0; mi < 4; ++mi) acc[mi][ni] = __builtin_amdgcn_mfma_f32_16x16x32_bf16(af[mi], b1, acc[mi][ni], 0, 0, 0);
      }
    }
#pragma unroll
    for (int ks = 0; ks < (LEAN ? 0 : 2); ++ks) {
      const int pcol = ((ks * 4 + quad) ^ sz) * 8;
      bf16x8 af[4], bg[NTW];
#pragma unroll
      for (int mi = 0; mi < 4; ++mi) af[mi] = *(const bf16x8*)(sAs + (wm * 64 + 16 * mi + r16) * 64 + pcol);
#pragma unroll
      for (int ni = 0; ni < NTW; ++ni) bg[ni] = *(const bf16x8*)(sBs + (wn * (BN / 2) + 16 * ni + r16) * 64 + pcol);
#pragma unroll
      for (int mi = 0; mi < 4; ++mi)
#pragma unroll
        for (int ni = 0; ni < NTW; ++ni) acc[mi][ni] = __builtin_amdgcn_mfma_f32_16x16x32_bf16(af[mi], bg[ni], acc[mi][ni], 0, 0, 0);
    }
  }
#undef G3_ISSUE
#undef G3_GLDS
}
template <int NCOLS>
DI void store_tile_bf16(const u16* sC, u16* gdst, long ld, int rows_valid) {
  constexpr int CPR = NCOLS / 8, LS = NCOLS + 8;
  const int tid = TID();
#pragma unroll
  for (int q = 0; q < (128 * CPR) / 256; ++q) {
    const int c = tid + 256 * q, row = c / CPR, ch = c % CPR;
    if (row < rows_valid) *(uint4*)(gdst + (long)row * ld + ch * 8) = *(const uint4*)(sC + row * LS + ch * 8);
  }
}
DI int pair_col(int np, int& which) {
  const int nt = np >> 7, c = np & 127, wn = c >> 6, ni = (c >> 4) & 3, r = c & 15;
  which = ni >> 1;
  return nt * 64 + wn * 32 + (ni & 1) * 16 + r;
}
DI const float* conv_colptr(const Params& P, int l, int mat, int np, long& ld) {
  int which;
  switch (mat) {
    case 0: ld = DIN; return P.in[3] + (long)l * DM * DIN + proj_src_col(np);
    case 1: ld = DIN; return P.in[3] + (long)l * DM * DIN + 2708 + np;
    case 2: ld = DM; return P.in[24] + ((long)(l * 4 + (np >> 10)) * 256) * DM + (np & 1023);
    case 3: ld = DM; return P.in[25] + (long)l * DM * DM + np;
    case 4: { int o = pair_col(np, which); ld = DFF; return (which ? P.in[28] : P.in[27]) + (long)l * DM * DFF + o; }
    case 5: ld = DM; return P.in[29] + (long)l * DFF * DM + np;
    case 6: { int o = pair_col(np, which); ld = 512; return P.in[19] + (long)l * 256 * 512 + which * 256 + o; }
    case 7: ld = 256; return P.in[(np >> 8) ? 9 : 7] + (long)l * 2048 * 256 + (np & 255);
    default: ld = 64; return P.in[(np >> 6) ? 10 : 8] + (long)l * 256 * 64 + (np & 63);
  }
}
DI void phase_convert(const Params& P, int l, float* lds) {
  const int tid = TID();
  if (blockIdx.x < 64) {
    const int kv = blockIdx.x >> 5, ks = blockIdx.x & 31;
    const float* pos = P.in[6] + (long)(l * 2 + kv) * 2048 + ks * 64;
    const float* w1 = P.in[kv ? 9 : 7] + (long)l * 2048 * 256 + (long)ks * 64 * 256 + tid;
    float a = 0.f;
#pragma unroll 8
    for (int k = 0; k < 64; ++k) a += pos[k] * w1[(long)k * 256];
    ((float*)(WSP(P) + WS_CBIAS))[(kv * 32 + ks) * 256 + tid] = a;
  }
  const int NB_[9] = {44, 64, 64, 16, 88, 16, 8, 8, 2};
  const int KB_[9] = {16, 16, 4, 16, 16, 44, 4, 32, 4};
  const size_t OFF_[9] = {WT_IN, WT_G, WT_BR, WT_OUT, WT_GU, WT_D, WT_GLU, WT_C1, WT_C2};
  for (int it = blockIdx.x; it < 4648; it += gridDim.x) {
    int r = it, mat = 0, nbk = 0, kbk = 0; size_t off = 0;
#pragma unroll
    for (int q = 0; q < 9; ++q) { int n = NB_[q] * KB_[q]; if (r >= 0 && r < n) { mat = q; nbk = NB_[q]; kbk = KB_[q]; off = OFF_[q]; r -= 100000; } else if (r >= 0) r -= n; }
    r += 100000;
    const int nb = r / kbk, kb = r % kbk, K = kbk * 64;
    (void)nbk;
    __syncthreads();
    {
      const int n = tid & 63;
      long ld; const float* cp = conv_colptr(P, l, mat, nb * 64 + n, ld);
#pragma unroll 4
      for (int q = 0; q < 16; ++q) { int k = (tid >> 6) + 4 * q; lds[n * 65 + k] = cp[(long)(kb * 64 + k) * ld]; }
    }
    __syncthreads();
    u16* dst = (u16*)(WSP(P) + WS_W + off);
#pragma unroll
    for (int q = 0; q < 2; ++q) {
      int c = tid + 256 * q, n = c >> 3, k8 = (c & 7) * 8;
      const float* sp = lds + n * 65 + k8;
      uint4 v; v.x = pk2(sp[0], sp[1]); v.y = pk2(sp[2], sp[3]); v.z = pk2(sp[4], sp[5]); v.w = pk2(sp[6], sp[7]);
      *(uint4*)(dst + (long)(nb * 64 + n) * K + kb * 64 + k8) = v;
    }
  }
}

DI void st_mma(f32x4 (&st)[4], const u16* sK, const bf16x8 (&bq)[2], int lane) {
  const int r = lane & 15, quad = lane >> 4;
#pragma unroll
  for (int mt = 0; mt < 4; ++mt) {
    f32x4 a = {0.f, 0.f, 0.f, 0.f};
#pragma unroll
    for (int ks = 0; ks < 2; ++ks) {
      bf16x8 kf = *(const bf16x8*)(sK + (16 * mt + r) * 72 + ks * 32 + quad * 8);
      a = __builtin_amdgcn_mfma_f32_16x16x32_bf16(kf, bq[ks], a, 0, 0, 0);
    }
    st[mt] = a;
  }
}
DI void pv_mma(f32x4 (&ot)[4], const u16* sVt, const f32x4 (&p)[4], int lane) {
  const int r = lane & 15, quad = lane >> 4;
#pragma unroll
  for (int ks = 0; ks < 2; ++ks) {
    uint4 pu;
    pu.x = pk2(p[2 * ks][0], p[2 * ks][1]); pu.y = pk2(p[2 * ks][2], p[2 * ks][3]);
    pu.z = pk2(p[2 * ks + 1][0], p[2 * ks + 1][1]); pu.w = pk2(p[2 * ks + 1][2], p[2 * ks + 1][3]);
    bf16x8 pb = __builtin_bit_cast(bf16x8, pu);
#pragma unroll
    for (int dt = 0; dt < 4; ++dt) {
      const u16* vrow = sVt + (16 * dt + r) * 72;
      s16x4 lo = *(const s16x4*)(vrow + ((32 * ks + 4 * quad) ^ (16 * dt)));
      s16x4 hi = *(const s16x4*)(vrow + ((32 * ks + 16 + 4 * quad) ^ (16 * dt)));
      bf16x8 vf = __builtin_shufflevector(lo, hi, 0, 1, 2, 3, 4, 5, 6, 7);
      ot[dt] = __builtin_amdgcn_mfma_f32_16x16x32_bf16(vf, pb, ot[dt], 0, 0, 0);
    }
  }
}
DI void load_tile(u16* dst, const u16* src, long ld) {
  const int tid = TID();
#pragma unroll
  for (int i = 0; i < 2; ++i) {
    int c = tid + 256 * i, row = c >> 3, ch = c & 7;
    uint4 v = *(const uint4*)(src + (long)row * ld + ch * 8);
    *(uint4*)(dst + row * 72 + ch * 8) = v;
  }
}
DI void load_tile_T(u16* dst, const u16* src, long ld) {
  const int tid = TID();
#pragma unroll
  for (int i = 0; i < 2; ++i) {
    int c = tid + 256 * i, row = c >> 3, ch = c & 7;
    uint4 v = *(const uint4*)(src + (long)row * ld + ch * 8);
    const unsigned* vv = (const unsigned*)&v;
#pragma unroll
    for (int q = 0; q < 4; ++q) {
      dst[(ch * 8 + 2 * q) * 72 + row] = (u16)(vv[q] & 0xffff);
      dst[(ch * 8 + 2 * q + 1) * 72 + row] = (u16)(vv[q] >> 16);
    }
  }
}
DI void load_q_nsa(u16* dst, const u16* src, long ld) {
  const int tid = TID();
#pragma unroll
  for (int i = 0; i < 2; ++i) {
    int c = tid + 256 * i, row = c >> 3, ch = c & 7;
    uint4 v = *(const uint4*)(src + (long)(row & 15) * ld + (row >> 4) * 64 + ch * 8);
    *(uint4*)(dst + row * 72 + ch * 8) = v;
  }
}
DI void load_qfrag(bf16x8 (&bq)[2], const u16* sQ, int w, int lane) {
  const int r = lane & 15, quad = lane >> 4;
  bq[0] = *(const bf16x8*)(sQ + (16 * w + r) * 72 + quad * 8);
  bq[1] = *(const bf16x8*)(sQ + (16 * w + r) * 72 + 32 + quad * 8);
}
DI float quad_max(float v) { v = fmaxf(v, __shfl_xor(v, 16)); v = fmaxf(v, __shfl_xor(v, 32)); return v; }
DI float quad_sum(float v) { v += __shfl_xor(v, 16); v += __shfl_xor(v, 32); return v; }

DI void softmax_tile(f32x4 (&st)[4], const bool (&msk)[4][4], float& m, float& l, f32x4 (&ot)[4]) {
  float tm = -1e30f;
#pragma unroll
  for (int mt = 0; mt < 4; ++mt)
#pragma unroll
    for (int j = 0; j < 4; ++j) { float s = st[mt][j] * 0.125f; st[mt][j] = s; if (msk[mt][j]) tm = fmaxf(tm, s); }
  tm = quad_max(tm);
  float mn = fmaxf(m, tm);
  float alpha = __expf(m - mn);
  float ps = 0.f;
#pragma unroll
  for (int mt = 0; mt < 4; ++mt)
#pragma unroll
    for (int j = 0; j < 4; ++j) { float p = msk[mt][j] ? __expf(st[mt][j] - mn) : 0.f; st[mt][j] = p; ps += p; }
  l = l * alpha + ps;
  m = mn;
#pragma unroll
  for (int dt = 0; dt < 4; ++dt)
#pragma unroll
    for (int j = 0; j < 4; ++j) ot[dt][j] *= alpha;
}

DI void phase_rmsnorm(const float* __restrict__ x, const float* __restrict__ wgt, u16* __restrict__ H) {
  const int lane = TID() & 63, w = TID() >> 6;
  const int gw = blockIdx.x * 4 + w, nw = gridDim.x * 4;
  for (int row = gw; row < T_; row += nw) {
    const float4* xr = (const float4*)(x + (long)row * DM);
    float4 v[4]; float s = 0.f;
#pragma unroll
    for (int j = 0; j < 4; ++j) { v[j] = xr[lane + 64 * j]; s += v[j].x * v[j].x + v[j].y * v[j].y + v[j].z * v[j].z + v[j].w * v[j].w; }
    s = wave_sum(s);
    float r = rsqrtf(s * (1.f / DM) + EPS);
#pragma unroll
    for (int j = 0; j < 4; ++j) {
      float4 g = ((const float4*)wgt)[lane + 64 * j];
      uint2 o; o.x = pk2(v[j].x * r * g.x, v[j].y * r * g.y); o.y = pk2(v[j].z * r * g.z, v[j].w * r * g.w);
      *(uint2*)(H + (long)row * DM + (lane + 64 * j) * 4) = o;
    }
  }
}
DI void phase_rope_table(const int* __restrict__ positions, float* __restrict__ COS, float* __restrict__ SIN) {
  const float invf[8] = {1.0f, 0.1939227432012558f, 0.03760603070259094f, 0.007292664609849453f,
                         0.0014142135623842478f, 0.00027424818836152554f, 5.3182957344688475e-05f, 1.0313385246263351e-05f};
  for (int idx = blockIdx.x * 256 + TID(); idx < T_ * 8; idx += gridDim.x * 256) {
    int i = idx & 7;
    float f = invf[0];
#pragma unroll
    for (int q = 1; q < 8; ++q) f = (i == q) ? invf[q] : f;
    float ang = (float)positions[idx >> 3] * f;
    double s, c; sincos_d((double)ang, s, c);
    COS[idx] = (float)c; SIN[idx] = (float)s;
  }
}

struct S5Coef { float ar, ai; float bbr[16], bbi[16]; };
DI void s5_coef(const Params& P, int l, int g, int p, S5Coef& C) {
  float dt = expf(P.in[13][l * 16 + g]);
  float lr = P.in[11][(l * 16 + g) * 64 + p], li = P.in[12][(l * 16 + g) * 64 + p];
  float mag = expf(lr * dt);
  double s, c; sincos_d((double)(li * dt), s, c);
  C.ar = mag * (float)c; C.ai = mag * (float)s;
  float den = lr * lr + li * li;
  float fr = ((C.ar - 1.f) * lr + C.ai * li) / den;
  float fi = (C.ai * lr - (C.ar - 1.f) * li) / den;
  const float* br = P.in[14] + ((long)(l * 16 + g) * 64 + p) * 16;
  const float* bi = P.in[15] + ((long)(l * 16 + g) * 64 + p) * 16;
#pragma unroll
  for (int c2 = 0; c2 < 16; ++c2) {
    float b_r = br[c2], b_i = bi[c2];
    C.bbr[c2] = fr * b_r - fi * b_i;
    C.bbi[c2] = fr * b_i + fi * b_r;
  }
}
DI void s5_load_u(float* su, const u16* PROJ, int b, int chunk, int g, int lane) {
  const u16* src = PROJ + ((long)(b * SEQ + chunk * 64 + lane)) * PW + P_S5U + g * 16;
  uint4 v0 = ((const uint4*)src)[0], v1 = ((const uint4*)src)[1];
  const unsigned* a = (const unsigned*)&v0; const unsigned* c = (const unsigned*)&v1;
  float* d = su + lane * 16;
#pragma unroll
  for (int q = 0; q < 4; ++q) { d[2 * q] = bf2f((u16)(a[q] & 0xffff)); d[2 * q + 1] = bf2f((u16)(a[q] >> 16)); }
#pragma unroll
  for (int q = 0; q < 4; ++q) { d[8 + 2 * q] = bf2f((u16)(c[q] & 0xffff)); d[8 + 2 * q + 1] = bf2f((u16)(c[q] >> 16)); }
}

DI void s5_pass1_item(const Params& P, int l, int it, float* lds) {
  const int lane = TID() & 63, w = TID() >> 6;
  const int gq = it & 3, chunk = (it >> 2) & 63, b = it >> 8;
  const int g = gq * 4 + w;
  const u16* PROJ = (const u16*)(WSP(P) + WS_PROJ);
  float* su = lds + w * 1024;
  S5Coef C; s5_coef(P, l, g, lane, C);
  s5_load_u(su, PROJ, b, chunk, g, lane);
  __syncthreads();
  float xr = 0.f, xi = 0.f;
#pragma unroll 4
  for (int t = 0; t < 64; ++t) {
    const f32x4* up = (const f32x4*)(su + t * 16);
    float br = 0.f, bi = 0.f;
#pragma unroll
    for (int q = 0; q < 4; ++q) {
      f32x4 u = up[q];
#pragma unroll
      for (int e = 0; e < 4; ++e) { br += u[e] * C.bbr[4 * q + e]; bi += u[e] * C.bbi[4 * q + e]; }
    }
    float nr = C.ar * xr - C.ai * xi + br;
    float ni = C.ar * xi + C.ai * xr + bi;
    xr = nr; xi = ni;
  }
  float2* ENDS = (float2*)(WSP(P) + WS_ENDS);
  ENDS[((long)(b * 64 + chunk) * 16 + g) * 64 + lane] = make_float2(xr, xi);
}

DI void s5_carry_item(const Params& P, int l, int it) {
  const int idx = it * 256 + TID();
  const int b = idx >> 10, gp = idx & 1023, g = gp >> 6, p = gp & 63;
  float dt = expf(P.in[13][l * 16 + g]);
  float lr = P.in[11][(l * 16 + g) * 64 + p], li = P.in[12][(l * 16 + g) * 64 + p];
  float mag = expf(lr * dt * 64.f);
  double s, c; sincos_d((double)(li * dt) * 64.0, s, c);
  float ar = mag * (float)c, ai = mag * (float)s;
  const float2* ENDS = (const float2*)(WSP(P) + WS_ENDS);
  float2* CARRY = (float2*)(WSP(P) + WS_CARRY);
  float xr = 0.f, xi = 0.f;
  for (int ch = 0; ch < 64; ++ch) {
    long o = ((long)(b * 64 + ch) * 16 + g) * 64 + p;
    CARRY[o] = make_float2(xr, xi);
    float2 e = ENDS[o];
    float nr = ar * xr - ai * xi + e.x;
    float ni = ar * xi + ai * xr + e.y;
    xr = nr; xi = ni;
  }
}

DI void s5_pass2_item(const Params& P, int l, int it, float* lds) {
  const int lane = TID() & 63, w = TID() >> 6, r16 = lane & 15, quad = lane >> 4;
  const int gq = it & 3, chunk = (it >> 2) & 63, b = it >> 8;
  const int g = gq * 4 + w;
  const u16* PROJ = (const u16*)(WSP(P) + WS_PROJ);
  u16* Y5 = (u16*)(WSP(P) + WS_Y5);
  float* su = lds + w * 1024;
  u16* sX = (u16*)(lds + 4096) + w * (32 * 136);
  S5Coef C; s5_coef(P, l, g, lane, C);
  bf16x8 bfr[4];
#pragma unroll
  for (int ks = 0; ks < 4; ++ks) {
    const float* src = P.in[(ks < 2) ? 16 : 17] + ((long)(l * 16 + g) * 16 + r16) * 64 + (ks & 1) * 32 + quad * 8;
    const float4 v0 = ((const float4*)src)[0], v1 = ((const float4*)src)[1];
    const float sg = (ks < 2) ? 1.f : -1.f;
    uint4 pu; pu.x = pk2(sg * v0.x, sg * v0.y); pu.y = pk2(sg * v0.z, sg * v0.w); pu.z = pk2(sg * v1.x, sg * v1.y); pu.w = pk2(sg * v1.z, sg * v1.w);
    bfr[ks] = __builtin_bit_cast(bf16x8, pu);
  }
  const float dsk = P.in[18][l * 256 + g * 16 + r16];
  s5_load_u(su, PROJ, b, chunk, g, lane);
  __syncthreads();
  const float2 c0 = ((const float2*)(WSP(P) + WS_CARRY))[((long)(b * 64 + chunk) * 16 + g) * 64 + lane];
  float xr = c0.x, xi = c0.y;
  for (int half = 0; half < 2; ++half) {
#pragma unroll 4
    for (int tt = 0; tt < 32; ++tt) {
      const int t = half * 32 + tt;
      const f32x4* up = (const f32x4*)(su + t * 16);
      float br0 = 0.f, bi0 = 0.f, br1 = 0.f, bi1 = 0.f;
#pragma unroll
      for (int q = 0; q < 4; ++q) {
        f32x4 u = up[q];
        br0 += u[0] * C.bbr[4 * q + 0]; bi0 += u[0] * C.bbi[4 * q + 0];
        br1 += u[1] * C.bbr[4 * q + 1]; bi1 += u[1] * C.bbi[4 * q + 1];
        br0 += u[2] * C.bbr[4 * q + 2]; bi0 += u[2] * C.bbi[4 * q + 2];
        br1 += u[3] * C.bbr[4 * q + 3]; bi1 += u[3] * C.bbi[4 * q + 3];
      }
      const float nr = C.ar * xr - C.ai * xi + (br0 + br1);
      const float ni = C.ar * xi + C.ai * xr + (bi0 + bi1);
      xr = nr; xi = ni;
      sX[tt * 136 + lane] = f2bf(xr);
      sX[tt * 136 + 64 + lane] = f2bf(xi);
    }
    __syncthreads();
#pragma unroll
    for (int mt = 0; mt < 2; ++mt) {
      f32x4 acc = {0.f, 0.f, 0.f, 0.f};
#pragma unroll
      for (int ks = 0; ks < 4; ++ks) {
        const bf16x8 af = *(const bf16x8*)(sX + (16 * mt + r16) * 136 + ks * 32 + quad * 8);
        acc = __builtin_amdgcn_mfma_f32_16x16x32_bf16(af, bfr[ks], acc, 0, 0, 0);
      }
#pragma unroll
      for (int j = 0; j < 4; ++j) {
        const int t = half * 32 + 16 * mt + 4 * quad + j;
        const float y = acc[j] + dsk * su[t * 16 + r16];
        Y5[((long)(b * SEQ + chunk * 64 + t)) * 256 + g * 16 + r16] = f2bf(gelu_tanh(y));
      }
    }
    __syncthreads();
  }
}

DI void nsa_prep_item(const Params& P, int l, int it) {
  const int lane = TID() & 63, w = TID() >> 6;
  u16* PROJ = (u16*)(WSP(P) + WS_PROJ);
  u16* QR = (u16*)(WSP(P) + WS_QR);
  const float* COS = (const float*)(WSP(P) + WS_COS);
  const float* SIN = (const float*)(WSP(P) + WS_SIN);
  for (int tt = 0; tt < 4; ++tt) {
    const long t = (long)it * 16 + w * 4 + tt;
    const float cs = COS[t * 8 + (lane & 7)], sn = SIN[t * 8 + (lane & 7)];
#pragma unroll
    for (int g = 0; g < 6; ++g) {
      const int col = (g < 4) ? (P_Q + g * 64) : (g == 4 ? P_KV + 128 : P_KV + 256);
      const float wg = (g < 4) ? P.in[4][l * 64 + lane] : P.in[5][(l * 3 + (g - 3)) * 64 + lane];
      u16* ptr = PROJ + t * PW + col + lane;
      float v = bf2f(*ptr);
      float ss = wave_sum(v * v);
      float y = v * rsqrtf(ss * (1.f / 64.f) + EPS) * wg;
      float pr = __shfl_xor(y, 8);
      float rot = (lane < 8) ? (y * cs - pr * sn) : ((lane < 16) ? (y * cs + pr * sn) : y);
      if (g < 4) { *ptr = f2bf(y); QR[t * 256 + g * 64 + lane] = f2bf(rot); }
      else *ptr = f2bf(rot);
    }
  }
}

DI void cmp1_tile(const Params& P, int l, int ct, u16* sA, u16* sB) {
  const int tid = TID(), lane = tid & 63, w = tid >> 6, r16 = lane & 15, quad = lane >> 4, wm = w >> 1, wn = w & 1;
  const int kv = ct >> 5, mt = (ct >> 1) & 15, nt = ct & 1;
  const u16* PROJ = (const u16*)(WSP(P) + WS_PROJ);
  u16* HID = (u16*)(WSP(P) + WS_HID);
  const u16* apq[4];
#pragma unroll
  for (int q = 0; q < 4; ++q) {
    int row, pc; g3_rowpiece(tid, q, false, row, pc);
    int gr = mt * 128 + row; if (gr > 2039) gr = 2039;
    const int b = gr / 255, n = gr % 255;
    apq[q] = PROJ + ((long)(b * SEQ + 16 * n)) * PW + P_KV + kv * 64 + pc * 8;
  }
  const u16* Bb = (const u16*)(WSP(P) + WS_W + WT_C1) + ((long)(kv * 256 + nt * 128)) * 2048;
  f32x4 acc[4][4];
  gemm3<4>(acc, apq[0], apq[1], apq[2], apq[3], PW,
           g3_ptr(Bb, 2048, tid, 0, false), g3_ptr(Bb, 2048, tid, 1, false), g3_ptr(Bb, 2048, tid, 2, false), g3_ptr(Bb, 2048, tid, 3, false), 2048, sA);
  {
    const float* PART = (const float*)(WSP(P) + WS_CBIAS) + (long)kv * 32 * 256;
#pragma unroll
    for (int ni = 0; ni < 4; ++ni) {
      const int col = nt * 128 + wn * 64 + 16 * ni + r16;
      float bsum = 0.f;
      for (int sl = 0; sl < 32; ++sl) bsum += PART[sl * 256 + col];
#pragma unroll
      for (int mi = 0; mi < 4; ++mi)
#pragma unroll
        for (int j = 0; j < 4; ++j) acc[mi][ni][j] += bsum;
    }
  }
  __syncthreads();
#pragma unroll
  for (int mi = 0; mi < 4; ++mi)
#pragma unroll
    for (int ni = 0; ni < 4; ++ni)
#pragma unroll
      for (int j = 0; j < 4; ++j) sA[(wm * 64 + 16 * mi + 4 * quad + j) * 136 + wn * 64 + 16 * ni + r16] = f2bf(gelu_tanh(acc[mi][ni][j]));
  __syncthreads();
  store_tile_bf16<128>(sA, HID + ((long)kv * 2048 + mt * 128) * 256 + nt * 128, 256, 2040 - mt * 128);
}
DI void cmp2_tile(const Params& P, int l, int ct, u16* sA, u16* sB, float* sSS) {
  const int tid = TID(), lane = tid & 63, w = tid >> 6, r16 = lane & 15, quad = lane >> 4, wm = w >> 1, wn = w & 1;
  const int kv = ct >> 4, mt = ct & 15;
  const u16* HID = (const u16*)(WSP(P) + WS_HID);
  u16* OUT = (u16*)(WSP(P) + (kv ? WS_VC : WS_KC));
  const u16* Ab = HID + ((long)kv * 2048 + mt * 128) * 256;
  const u16* Bb = (const u16*)(WSP(P) + WS_W + WT_C2) + (long)kv * 64 * 256;
  f32x4 acc[4][2];
  gemm3<2>(acc, g3_ptr(Ab, 256, tid, 0, false), g3_ptr(Ab, 256, tid, 1, false), g3_ptr(Ab, 256, tid, 2, false), g3_ptr(Ab, 256, tid, 3, false), 64,
           g3_ptr(Bb, 256, tid, 0, true), g3_ptr(Bb, 256, tid, 1, true), nullptr, nullptr, 256, sA);
  __syncthreads();
  if (tid < 128) sSS[tid] = 0.f;
  __syncthreads();
#pragma unroll
  for (int mi = 0; mi < 4; ++mi)
#pragma unroll
    for (int j = 0; j < 4; ++j) {
      float ss = acc[mi][0][j] * acc[mi][0][j] + acc[mi][1][j] * acc[mi][1][j];
      ss += __shfl_xor(ss, 1); ss += __shfl_xor(ss, 2); ss += __shfl_xor(ss, 4); ss += __shfl_xor(ss, 8);
      if (r16 == 0) atomicAdd(&sSS[wm * 64 + 16 * mi + 4 * quad + j], ss);
    }
  __syncthreads();
#pragma unroll
  for (int mi = 0; mi < 4; ++mi)
#pragma unroll
    for (int j = 0; j < 4; ++j) {
      const int rl = wm * 64 + 16 * mi + 4 * quad + j, row = mt * 128 + rl;
      const float sc = (kv == 0) ? rsqrtf(sSS[rl] * (1.f / 64.f) + EPS) : 1.f;
      if (row < 2040) {
        int b = row / 255, n = row % 255;
#pragma unroll
        for (int ni = 0; ni < 2; ++ni) {
          int col = wn * 32 + 16 * ni + r16;
          float v = acc[mi][ni][j] * sc;
          if (kv == 0) v *= P.in[5][(l * 3 + 0) * 64 + col];
          OUT[((long)(b * 256 + n)) * 64 + col] = f2bf(v);
        }
      }
    }
}

DI void gdn_p1_item(const Params& P, int l, int it, float* lds) {
  const int tid = TID(), lane = tid & 63, w = tid >> 6, r16 = lane & 15, quad = lane >> 4;
  const int chunk = it & 63, h = (it >> 6) & 3, b = it >> 8;
  const long ci = it;
  const u16* PROJ = (const u16*)(WSP(P) + WS_PROJ);
  float* sq = lds;
  float* sk = lds + 64 * 65;
  float* sv = lds + 2 * 64 * 65;
  float* sG = lds + 3 * 64 * 65;
  float* sBeta = sG + 64;
  float* sg = sBeta + 64;
  u16* sQb = (u16*)(sg + 64);
  u16* sKb = sQb + 64 * 72;
  const float* cw = P.in[20] + (long)l * 4 * 768;
  if (tid < 192) {
    const int cp = tid % 96, th = tid / 96;
    const int c0 = 2 * cp, which = c0 >> 6, d = c0 & 63, C = which * 256 + h * 64 + d;
    float w0[4], w1[4];
#pragma unroll
    for (int k = 0; k < 4; ++k) { w0[k] = cw[k * 768 + C]; w1[k] = cw[k * 768 + C + 1]; }
    unsigned v[35];
    const int s0 = chunk * 64 + th * 32 - 3;
    const u16* src = PROJ + ((long)(b * SEQ + s0)) * PW + P_GQKV + C;
#pragma unroll
    for (int k = 0; k < 35; ++k) v[k] = (s0 + k >= 0) ? *(const unsigned*)(src + (long)k * PW) : 0u;
    float* dst = lds + which * 64 * 65 + (th * 32) * 65 + d;
#pragma unroll
    for (int tt = 0; tt < 32; ++tt) {
      float a0 = 0.f, a1 = 0.f;
#pragma unroll
      for (int k = 0; k < 4; ++k) { a0 += w0[k] * bf2f((u16)(v[tt + k] & 0xffff)); a1 += w1[k] * bf2f((u16)(v[tt + k] >> 16)); }
      dst[tt * 65] = siluf_(a0); dst[tt * 65 + 1] = siluf_(a1);
    }
  }
  __syncthreads();
  if (tid < 128) {
    float* base = (tid < 64) ? sq : sk;
    u16* bb = (tid < 64) ? sQb : sKb;
    const int row = tid & 63;
    float ss = 0.f;
#pragma unroll 8
    for (int d = 0; d < 64; ++d) { float x = base[row * 65 + d]; ss += x * x; }
    const float sc = rsqrtf(ss + EPS) * ((tid < 64) ? 0.125f : 1.f);
#pragma unroll 8
    for (int d = 0; d < 64; d += 2) {
      const float x0 = base[row * 65 + d] * sc, x1 = base[row * 65 + d + 1] * sc;
      base[row * 65 + d] = x0; base[row * 65 + d + 1] = x1;
      *(unsigned*)(bb + row * 72 + d) = pk2(x0, x1);
    }
  } else if (tid < 192) {
    const int row = tid - 128;
    const long t = (long)(b * SEQ + chunk * 64 + row);
    const float bl = bf2f(PROJ[t * PW + P_GB + h]);
    const float al = bf2f(PROJ[t * PW + P_GA + h]);
    sBeta[row] = sigmoidf_(bl);
    sg[row] = -expf(P.in[21][l * 4 + h]) * softplusf_(al + P.in[22][l * 4 + h]);
  }
  __syncthreads();
  if (tid < 64) {
    float x = sg[tid];
#pragma unroll
    for (int o = 1; o < 64; o <<= 1) { float u = __shfl_up(x, o); if (tid >= o) x += u; }
    sG[tid] = x;
    ((float*)(WSP(P) + WS_GG))[ci * 64 + tid] = x;
  }
  __syncthreads();
  f32x4 lreg[4];
  {
    const f32x4 Gi4 = *(const f32x4*)(sG + 16 * w + 4 * quad);
    const f32x4 Bi4 = *(const f32x4*)(sBeta + 16 * w + 4 * quad);
    u16* GA = (u16*)(WSP(P) + WS_GA) + ci * 4096;
#pragma unroll
    for (int nt = 0; nt < 4; ++nt) {
      f32x4 aq = {0.f, 0.f, 0.f, 0.f}, ak = {0.f, 0.f, 0.f, 0.f};
#pragma unroll
      for (int ks = 0; ks < 2; ++ks) {
        const bf16x8 fq = *(const bf16x8*)(sQb + (16 * w + r16) * 72 + ks * 32 + quad * 8);
        const bf16x8 fk = *(const bf16x8*)(sKb + (16 * w + r16) * 72 + ks * 32 + quad * 8);
        const bf16x8 fb = *(const bf16x8*)(sKb + (16 * nt + r16) * 72 + ks * 32 + quad * 8);
        aq = __builtin_amdgcn_mfma_f32_16x16x32_bf16(fq, fb, aq, 0, 0, 0);
        ak = __builtin_amdgcn_mfma_f32_16x16x32_bf16(fk, fb, ak, 0, 0, 0);
      }
      const int j = 16 * nt + r16;
      const float Gj = sG[j];
#pragma unroll
      for (int jj = 0; jj < 4; ++jj) {
        const int i = 16 * w + 4 * quad + jj;
        const float dec = __expf(Gi4[jj] - Gj);
        GA[i * 64 + j] = f2bf((j <= i) ? aq[jj] * dec : 0.f);
        const float lv = (j < i) ? Bi4[jj] * ak[jj] * dec : 0.f;
        sq[i * 65 + j] = lv;
        lreg[nt][jj] = lv;
      }
    }
  }
  {
    u16* GQ = (u16*)(WSP(P) + WS_GQ) + ci * 4096;
#pragma unroll
    for (int q = 0; q < 2; ++q) { const int c = tid + 256 * q, row = c >> 3, ch = c & 7; *(uint4*)(GQ + row * 64 + ch * 8) = *(const uint4*)(sQb + row * 72 + ch * 8); }
    const int i = tid >> 2, j0 = (tid & 3) * 16;
    u16* GK = (u16*)(WSP(P) + WS_GK) + ci * 4096 + i * 64 + j0;
    unsigned ok[8];
#pragma unroll
    for (int q = 0; q < 8; ++q) ok[q] = pk2(sk[(j0 + 2 * q) * 65 + i], sk[(j0 + 2 * q + 1) * 65 + i]);
    ((uint4*)GK)[0] = make_uint4(ok[0], ok[1], ok[2], ok[3]); ((uint4*)GK)[1] = make_uint4(ok[4], ok[5], ok[6], ok[7]);
  }
  __syncthreads();
  u16* sLb = sQb;
  u16* sXT = sKb;
  {
    const int i = tid >> 2, j0 = (tid & 3) * 16;
    const float bi = sBeta[i], eg = __expf(sG[i]);
#pragma unroll
    for (int jj = 0; jj < 16; ++jj) { sv[i * 65 + j0 + jj] *= bi; sk[i * 65 + j0 + jj] *= bi * eg; }
#pragma unroll
    for (int nt = 0; nt < 4; ++nt)
#pragma unroll
      for (int jj = 0; jj < 4; ++jj) sLb[(16 * w + 4 * quad + jj) * 72 + 16 * nt + r16] = f2bf(lreg[nt][jj]);
  }
  __syncthreads();
#pragma unroll 1
  for (int bi = 0; bi < 4; ++bi) {
    if (tid < 128) {
      float* buf = (tid < 64) ? sv : sk;
      const int col = tid & 63;
      float x[16];
#pragma unroll
      for (int r = 0; r < 16; ++r) {
        float a0 = buf[(16 * bi + r) * 65 + col], a1 = 0.f;
#pragma unroll
        for (int j = 0; j + 1 < r; j += 2) { a0 -= sq[(16 * bi + r) * 65 + 16 * bi + j] * x[j]; a1 -= sq[(16 * bi + r) * 65 + 16 * bi + j + 1] * x[j + 1]; }
        if (r & 1) a0 -= sq[(16 * bi + r) * 65 + 16 * bi + r - 1] * x[r - 1];
        x[r] = a0 + a1;
        buf[(16 * bi + r) * 65 + col] = x[r];
      }
      uint4 p0, p1;
      p0.x = pk2(x[0], x[1]); p0.y = pk2(x[2], x[3]); p0.z = pk2(x[4], x[5]); p0.w = pk2(x[6], x[7]);
      p1.x = pk2(x[8], x[9]); p1.y = pk2(x[10], x[11]); p1.z = pk2(x[12], x[13]); p1.w = pk2(x[14], x[15]);
      *(uint4*)(sXT + tid * 24) = p0; *(uint4*)(sXT + tid * 24 + 8) = p1;
    }
    __syncthreads();
    if (bi < 3) {
#pragma unroll
      for (int q = 0; q < 2; ++q) {
        const int nt = 2 * w + q, colg = 16 * nt + r16;
        bf16x8 bx = *(const bf16x8*)(sXT + colg * 24 + (quad & 1) * 8);
        if (quad >= 2) bx = (bf16x8){0, 0, 0, 0, 0, 0, 0, 0};
        float* buf = (colg < 64) ? sv : sk;
        const int cc = colg & 63;
        for (int bk = bi + 1; bk < 4; ++bk) {
          const bf16x8 al = *(const bf16x8*)(sLb + (16 * bk + r16) * 72 + 16 * bi + quad * 8);
          f32x4 c = {0.f, 0.f, 0.f, 0.f};
          c = __builtin_amdgcn_mfma_f32_16x16x32_bf16(al, bx, c, 0, 0, 0);
#pragma unroll
          for (int jj = 0; jj < 4; ++jj) buf[(16 * bk + 4 * quad + jj) * 65 + cc] -= c[jj];
        }
      }
    }
    __syncthreads();
  }
  {
    const int i = tid >> 2, j0 = (tid & 3) * 16;
    u16* GU = (u16*)(WSP(P) + WS_GU) + ci * 4096 + i * 64 + j0;
    u16* GW = (u16*)(WSP(P) + WS_GW) + ci * 4096 + i * 64 + j0;
    unsigned ou[8], ow[8];
#pragma unroll
    for (int q = 0; q < 8; ++q) {
      ou[q] = pk2(sv[i * 65 + j0 + 2 * q], sv[i * 65 + j0 + 2 * q + 1]);
      ow[q] = pk2(sk[i * 65 + j0 + 2 * q], sk[i * 65 + j0 + 2 * q + 1]);
    }
    ((uint4*)GU)[0] = make_uint4(ou[0], ou[1], ou[2], ou[3]); ((uint4*)GU)[1] = make_uint4(ou[4], ou[5], ou[6], ou[7]);
    ((uint4*)GW)[0] = make_uint4(ow[0], ow[1], ow[2], ow[3]); ((uint4*)GW)[1] = make_uint4(ow[4], ow[5], ow[6], ow[7]);
  }
}

DI void unpack8(const u16* p, float (&o)[8]) {
  uint4 v = *(const uint4*)p;
  o[0] = bf2f((u16)(v.x & 0xffff)); o[1] = bf2f((u16)(v.x >> 16));
  o[2] = bf2f((u16)(v.y & 0xffff)); o[3] = bf2f((u16)(v.y >> 16));
  o[4] = bf2f((u16)(v.z & 0xffff)); o[5] = bf2f((u16)(v.z >> 16));
  o[6] = bf2f((u16)(v.w & 0xffff)); o[7] = bf2f((u16)(v.w >> 16));
}
DI void st_kt(u16* sKt, int c8, int row, uint4 k) {
  sKt[(c8 + 0) * 72 + row] = (u16)(k.x & 0xffff); sKt[(c8 + 1) * 72 + row] = (u16)(k.x >> 16);
  sKt[(c8 + 2) * 72 + row] = (u16)(k.y & 0xffff); sKt[(c8 + 3) * 72 + row] = (u16)(k.y >> 16);
  sKt[(c8 + 4) * 72 + row] = (u16)(k.z & 0xffff); sKt[(c8 + 5) * 72 + row] = (u16)(k.z >> 16);
  sKt[(c8 + 6) * 72 + row] = (u16)(k.w & 0xffff); sKt[(c8 + 7) * 72 + row] = (u16)(k.w >> 16);
}
DI uint2 pack4bf(const f32x4& v) { uint2 r; r.x = pk2(v[0], v[1]); r.y = pk2(v[2], v[3]); return r; }
DI void gdn_p2_item(const Params& P, int it, float* lds) {
  const int tid = TID(), lane = tid & 63, w = tid >> 6, r16 = lane & 15, quad = lane >> 4;
  const int es = it & 3, bh = it >> 2, b = bh >> 2, h = bh & 3;
  u16* sW = (u16*)lds;
  u16* sQ = sW + 64 * 72;
  u16* sAm = sQ + 64 * 72;
  u16* sKt = sAm + 64 * 72;
  u16* sSt = sKt + 64 * 72;
  u16* sVnT = sSt + 16 * 72;
  u16* sVdT = sVnT + 16 * 72;
  float* sG = (float*)(sVdT + 16 * 72);
  const u16* GQ = (const u16*)(WSP(P) + WS_GQ); const u16* GK = (const u16*)(WSP(P) + WS_GK);
  const u16* GU = (const u16*)(WSP(P) + WS_GU); const u16* GW = (const u16*)(WSP(P) + WS_GW);
  const u16* GA = (const u16*)(WSP(P) + WS_GA); const float* GG = (const float*)(WSP(P) + WS_GG);
  u16* ORAW = (u16*)(WSP(P) + WS_OM) + (long)2 * T_ * 256;
  f32x4 S = {0.f, 0.f, 0.f, 0.f};
  const int irow = 16 * w + 4 * quad;
  uint4 rw0, rw1, rq0, rq1, ra0, ra1, rk0, rk1; u16 ru0, ru1, ru2, ru3; float rg = 0.f;
  const int c0 = tid, c1 = tid + 256;
  const long off0 = (c0 >> 3) * 64 + (c0 & 7) * 8, off1 = (c1 >> 3) * 64 + (c1 & 7) * 8;
#define GDN_GLOAD(CH) { long ci_ = (long)bh * 64 + (CH); \
    rw0 = *(const uint4*)(GW + ci_ * 4096 + off0); rw1 = *(const uint4*)(GW + ci_ * 4096 + off1); \
    rq0 = *(const uint4*)(GQ + ci_ * 4096 + off0); rq1 = *(const uint4*)(GQ + ci_ * 4096 + off1); \
    ra0 = *(const uint4*)(GA + ci_ * 4096 + off0); ra1 = *(const uint4*)(GA + ci_ * 4096 + off1); \
    rk0 = *(const uint4*)(GK + ci_ * 4096 + off0); rk1 = *(const uint4*)(GK + ci_ * 4096 + off1); \
    const u16* up_ = GU + ci_ * 4096 + irow * 64 + es * 16 + r16; \
    ru0 = up_[0]; ru1 = up_[64]; ru2 = up_[128]; ru3 = up_[192]; \
    if (tid < 64) rg = GG[ci_ * 64 + tid]; }
  GDN_GLOAD(0)
  for (int ch = 0; ch < 64; ++ch) {
    __syncthreads();
    {
      const int row0 = c0 >> 3, c80 = (c0 & 7) * 8, row1 = c1 >> 3, c81 = (c1 & 7) * 8;
      *(uint4*)(sW + row0 * 72 + c80) = rw0; *(uint4*)(sW + row1 * 72 + c81) = rw1;
      *(uint4*)(sQ + row0 * 72 + c80) = rq0; *(uint4*)(sQ + row1 * 72 + c81) = rq1;
      *(uint4*)(sAm + row0 * 72 + c80) = ra0; *(uint4*)(sAm + row1 * 72 + c81) = ra1;
      *(uint4*)(sKt + row0 * 72 + c80) = rk0; *(uint4*)(sKt + row1 * 72 + c81) = rk1;
    }
    if (tid < 64) sG[tid] = rg;
    *(uint2*)(sSt + r16 * 72 + irow) = pack4bf(S);
    const f32x4 uc = {bf2f(ru0), bf2f(ru1), bf2f(ru2), bf2f(ru3)};
    __syncthreads();
    if (ch + 1 < 64) GDN_GLOAD(ch + 1)
    f32x4 ws = {0.f, 0.f, 0.f, 0.f}, qs = {0.f, 0.f, 0.f, 0.f};
#pragma unroll
    for (int ks = 0; ks < 2; ++ks) {
      const bf16x8 bS = *(const bf16x8*)(sSt + r16 * 72 + ks * 32 + quad * 8);
      const bf16x8 aW = *(const bf16x8*)(sW + (16 * w + r16) * 72 + ks * 32 + quad * 8);
      const bf16x8 aQ = *(const bf16x8*)(sQ + (16 * w + r16) * 72 + ks * 32 + quad * 8);
      ws = __builtin_amdgcn_mfma_f32_16x16x32_bf16(aW, bS, ws, 0, 0, 0);
      qs = __builtin_amdgcn_mfma_f32_16x16x32_bf16(aQ, bS, qs, 0, 0, 0);
    }
    const float Gl = sG[63];
    const f32x4 G4 = *(const f32x4*)(sG + irow);
    f32x4 vn, vd;
#pragma unroll
    for (int j = 0; j < 4; ++j) { vn[j] = uc[j] - ws[j]; vd[j] = vn[j] * __expf(Gl - G4[j]); }
    *(uint2*)(sVnT + r16 * 72 + irow) = pack4bf(vn);
    *(uint2*)(sVdT + r16 * 72 + irow) = pack4bf(vd);
    __syncthreads();
    f32x4 av = {0.f, 0.f, 0.f, 0.f}, kv = {0.f, 0.f, 0.f, 0.f};
#pragma unroll
    for (int ks = 0; ks < 2; ++ks) {
      const bf16x8 bVn = *(const bf16x8*)(sVnT + r16 * 72 + ks * 32 + quad * 8);
      const bf16x8 bVd = *(const bf16x8*)(sVdT + r16 * 72 + ks * 32 + quad * 8);
      const bf16x8 aA = *(const bf16x8*)(sAm + (16 * w + r16) * 72 + ks * 32 + quad * 8);
      const bf16x8 aK = *(const bf16x8*)(sKt + (16 * w + r16) * 72 + ks * 32 + quad * 8);
      av = __builtin_amdgcn_mfma_f32_16x16x32_bf16(aA, bVn, av, 0, 0, 0);
      kv = __builtin_amdgcn_mfma_f32_16x16x32_bf16(aK, bVd, kv, 0, 0, 0);
    }
    {
      u16* op = ORAW + ((long)(b * SEQ + ch * 64 + irow)) * 256 + h * 64 + es * 16 + r16;
#pragma unroll
      for (int j = 0; j < 4; ++j) op[j * 256] = f2bf(__expf(G4[j]) * qs[j] + av[j]);
    }
    const float gl = __expf(Gl);
#pragma unroll
    for (int j = 0; j < 4; ++j) S[j] = S[j] * gl + kv[j];
  }
#undef GDN_GLOAD
}
DI void gdn_post_item(const Params& P, int l, int it) {
  const int lane = TID() & 63, w = TID() >> 6;
  const u16* PROJ = (const u16*)(WSP(P) + WS_PROJ);
  u16* O = (u16*)(WSP(P) + WS_OM) + (long)2 * T_ * 256;
  const float wn = P.in[23][l * 64 + lane];
#pragma unroll 4
  for (int q = 0; q < 16; ++q) {
    long t = (long)it * 16 + w * 4 + (q >> 2); int h = q & 3;
    float o = bf2f(O[t * 256 + h * 64 + lane]);
    float ss = wave_sum(o * o);
    float y = o * rsqrtf(ss * (1.f / 64.f) + EPS) * wn;
    float z = bf2f(PROJ[t * PW + P_GZ + h * 64 + lane]);
    O[t * 256 + h * 64 + lane] = f2bf(y * siluf_(z));
  }
}

DI void kv_gload(uint4& k0, uint4& k1, uint4& v0, uint4& v1, const u16* ksrc, const u16* vsrc, long ld) {
  const int tid = TID(), r0 = tid >> 3, ch = tid & 7;
  k0 = *(const uint4*)(ksrc + (long)r0 * ld + ch * 8); k1 = *(const uint4*)(ksrc + (long)(r0 + 32) * ld + ch * 8);
  v0 = *(const uint4*)(vsrc + (long)r0 * ld + ch * 8); v1 = *(const uint4*)(vsrc + (long)(r0 + 32) * ld + ch * 8);
}
DI void k_gload(uint4& k0, uint4& k1, const u16* ksrc, long ld) {
  const int tid = TID(), r0 = tid >> 3, ch = tid & 7;
  k0 = *(const uint4*)(ksrc + (long)r0 * ld + ch * 8); k1 = *(const uint4*)(ksrc + (long)(r0 + 32) * ld + ch * 8);
}
DI void k_store(const uint4& k0, const uint4& k1, u16* sK) {
  const int tid = TID(), r0 = tid >> 3, ch = tid & 7;
  *(uint4*)(sK + r0 * 72 + ch * 8) = k0; *(uint4*)(sK + (r0 + 32) * 72 + ch * 8) = k1;
}
DI void kv_store(const uint4& k0, const uint4& k1, const uint4& v0, const uint4& v1, u16* sK, u16* sVt) {
  const int tid = TID(), r0 = tid >> 3, ch = tid & 7;
  *(uint4*)(sK + r0 * 72 + ch * 8) = k0; *(uint4*)(sK + (r0 + 32) * 72 + ch * 8) = k1;
  const int ksw = 16 * (ch >> 1);
  st_kt(sVt, ch * 8, r0 ^ ksw, v0); st_kt(sVt, ch * 8, (r0 + 32) ^ ksw, v1);
}
DI void sb_attn_item(const Params& P, int it, u16* sQ, u16* sK, u16* sVt) {
  const int tid = TID(), lane = tid & 63, w = tid >> 6, r16 = lane & 15, quad = lane >> 4;
  const int qb = 63 - (it >> 5), bh = it & 31, b = bh >> 2, h = bh & 3;
  const u16* PROJ = (const u16*)(WSP(P) + WS_PROJ);
  u16* OUT = (u16*)(WSP(P) + WS_OM) + (long)3 * T_ * 256;
  const long tb = (long)b * SEQ;
  load_tile(sQ, PROJ + (tb + qb * 64) * PW + P_SB + h * 64, PW);
  __syncthreads();
  bf16x8 bq[2]; load_qfrag(bq, sQ, w, lane);
  const int tq = qb * 64 + 16 * w + r16;
  f32x4 ot[4];
#pragma unroll
  for (int dt = 0; dt < 4; ++dt) ot[dt] = (f32x4){0.f, 0.f, 0.f, 0.f};
  float R = 0.f;
  uint4 pk0, pk1, pv0, pv1;
  kv_gload(pk0, pk1, pv0, pv1, PROJ + (tb + qb * 64) * PW + P_SB + 256 + h * 64, PROJ + (tb + qb * 64) * PW + P_SB + 512 + h * 64, PW);
  for (int kb = qb; kb >= 0; --kb) {
    if (__syncthreads_and(R < -104.f)) break;
    kv_store(pk0, pk1, pv0, pv1, sK, sVt);
    __syncthreads();
    if (kb > 0) kv_gload(pk0, pk1, pv0, pv1, PROJ + (tb + (kb - 1) * 64) * PW + P_SB + 256 + h * 64, PROJ + (tb + (kb - 1) * 64) * PW + P_SB + 512 + h * 64, PW);
    f32x4 st[4];
    st_mma(st, sK, bq, lane);
    float gs[4], zz[4][4], x[4][4];
#pragma unroll
    for (int mt = 0; mt < 4; ++mt) {
      float g = 0.f;
#pragma unroll
      for (int j = 0; j < 4; ++j) {
        int s = kb * 64 + 16 * mt + 4 * quad + j;
        float z = st[mt][j] * 0.125f;
        float sp = softplusf_(z);
        bool mk = s < tq;
        x[mt][j] = mk ? -sp : 0.f;
        zz[mt][j] = mk ? (z - sp) : -1e30f;
        g += x[mt][j];
      }
      gs[mt] = g;
    }
    float hm = 0.f, tot_all = 0.f;
    f32x4 pw[4];
#pragma unroll
    for (int mt = 3; mt >= 0; --mt) {
      float g = gs[mt];
      float v1 = __shfl_down(g, 16), v2 = __shfl_down(g, 32), v3 = __shfl_down(g, 48);
      float hq = (quad < 3 ? v1 : 0.f) + (quad < 2 ? v2 : 0.f) + (quad < 1 ? v3 : 0.f);
      float tot = quad_sum(g);
      float base = R + hm + hq;
      float e3 = 0.f, e2 = x[mt][3], e1 = e2 + x[mt][2], e0 = e1 + x[mt][1];
      pw[mt][0] = __expf(zz[mt][0] + base + e0);
      pw[mt][1] = __expf(zz[mt][1] + base + e1);
      pw[mt][2] = __expf(zz[mt][2] + base + e2);
      pw[mt][3] = __expf(zz[mt][3] + base + e3);
      hm += tot; tot_all += tot;
    }
    R += tot_all;
    pv_mma(ot, sVt, pw, lane);
  }
  const long t = tb + tq;
#pragma unroll
  for (int dt = 0; dt < 4; ++dt) {
    uint2 ov; ov.x = pk2(ot[dt][0], ot[dt][1]); ov.y = pk2(ot[dt][2], ot[dt][3]);
    *(uint2*)(OUT + t * 256 + h * 64 + 16 * dt + 4 * quad) = ov;
  }
}

DI void win_attn_item(const Params& P, int it, u16* sQ, u16* sKunused, u16* sVunused) {
  const int tid = TID(), lane = tid & 63, w = tid >> 6, r16 = lane & 15, quad = lane >> 4;
  const int tbk = 127 - (it >> 3), b = it & 7;
  u16* sK = sQ + 128 * 72;
  u16* sVt = sK + 64 * 72;
  (void)sKunused; (void)sVunused;
  const u16* PROJ = (const u16*)(WSP(P) + WS_PROJ);
  const u16* QR = (const u16*)(WSP(P) + WS_QR);
  u16* OW = (u16*)(WSP(P) + WS_OW);
  const long tb = (long)b * SEQ;
  const int t0 = tbk * 32;
#pragma unroll
  for (int i = 0; i < 4; ++i) {
    const int c = tid + 256 * i, row = c >> 3, ch = c & 7;
    *(uint4*)(sQ + row * 72 + ch * 8) = *(const uint4*)(QR + (tb + t0 + (row & 31)) * 256 + (row >> 5) * 64 + ch * 8);
  }
  __syncthreads();
  bf16x8 bq[2][2];
  int tq[2];
#pragma unroll
  for (int qt = 0; qt < 2; ++qt) {
    const int rowq = 32 * w + 16 * qt + r16;
    bq[qt][0] = *(const bf16x8*)(sQ + rowq * 72 + quad * 8);
    bq[qt][1] = *(const bf16x8*)(sQ + rowq * 72 + 32 + quad * 8);
    tq[qt] = t0 + 16 * qt + r16;
  }
  f32x4 ot[2][4];
#pragma unroll
  for (int qt = 0; qt < 2; ++qt)
#pragma unroll
    for (int dt = 0; dt < 4; ++dt) ot[qt][dt] = (f32x4){0.f, 0.f, 0.f, 0.f};
  float m[2] = {-1e30f, -1e30f}, lsum[2] = {0.f, 0.f};
  const int lo = (t0 - 511) > 0 ? (t0 - 511) : 0;
  const int kb_lo = lo >> 6, kb_hi = (t0 + 31) >> 6;
  uint4 pk0, pk1, pv0, pv1;
  kv_gload(pk0, pk1, pv0, pv1, PROJ + (tb + kb_lo * 64) * PW + P_KV + 256, PROJ + (tb + kb_lo * 64) * PW + P_KV + 320, PW);
  for (int kb = kb_lo; kb <= kb_hi; ++kb) {
    __syncthreads();
    kv_store(pk0, pk1, pv0, pv1, sK, sVt);
    __syncthreads();
    if (kb < kb_hi) kv_gload(pk0, pk1, pv0, pv1, PROJ + (tb + (kb + 1) * 64) * PW + P_KV + 256, PROJ + (tb + (kb + 1) * 64) * PW + P_KV + 320, PW);
#pragma unroll
    for (int qt = 0; qt < 2; ++qt) {
      f32x4 st[4];
      st_mma(st, sK, bq[qt], lane);
      bool msk[4][4];
#pragma unroll
      for (int mt = 0; mt < 4; ++mt)
#pragma unroll
        for (int j = 0; j < 4; ++j) { int s = kb * 64 + 16 * mt + 4 * quad + j; int df = tq[qt] - s; msk[mt][j] = (df >= 0) && (df < 512); }
      softmax_tile(st, msk, m[qt], lsum[qt], ot[qt]);
      pv_mma(ot[qt], sVt, st, lane);
    }
  }
#pragma unroll
  for (int qt = 0; qt < 2; ++qt) {
    const float ls = quad_sum(lsum[qt]);
    const float inv = 1.f / fmaxf(ls, 1e-30f);
    const long t = tb + tq[qt];
#pragma unroll
    for (int dt = 0; dt < 4; ++dt) {
      uint2 ov; ov.x = pk2(ot[qt][dt][0] * inv, ot[qt][dt][1] * inv); ov.y = pk2(ot[qt][dt][2] * inv, ot[qt][dt][3] * inv);
      *(uint2*)(OW + t * 256 + w * 64 + 16 * dt + 4 * quad) = ov;
    }
  }
}

DI void cmp_attn_item(const Params& P, int it, u16* sQ, u16* sK, u16* sVt, float* sImp) {
  const int tid = TID(), lane = tid & 63, w = tid >> 6, r16 = lane & 15, quad = lane >> 4;
  const int tbk = 255 - (it >> 3), b = it & 7;
  const u16* PROJ = (const u16*)(WSP(P) + WS_PROJ);
  const u16* KC = (const u16*)(WSP(P) + WS_KC) + (long)b * 256 * 64;
  const u16* VC = (const u16*)(WSP(P) + WS_VC) + (long)b * 256 * 64;
  u16* OC = (u16*)(WSP(P) + WS_OC);
  u64* SEL = (u64*)(WSP(P) + WS_SEL);
  const long tb = (long)b * SEQ;
  const int t0 = tbk * 16;
  load_q_nsa(sQ, PROJ + (tb + t0) * PW + P_Q, PW);
  for (int e = tid; e < 4 * 16 * 64; e += 256) sImp[e] = 0.f;
  __syncthreads();
  bf16x8 bq[2]; load_qfrag(bq, sQ, w, lane);
  const int tq = t0 + r16;
  const int nv = (tq >= 31) ? ((tq - 31) >> 4) + 1 : 0;
  const int nvmax = (t0 + 15 >= 31) ? ((t0 + 15 - 31) >> 4) + 1 : 0;
  const int ntile = (nvmax + 63) >> 6;
  float m = -1e30f, lsum = 0.f;
  uint4 pk0, pk1, pv0, pv1;
  if (ntile > 0) k_gload(pk0, pk1, KC, 64);
  for (int kt = 0; kt < ntile; ++kt) {
    __syncthreads();
    k_store(pk0, pk1, sK);
    __syncthreads();
    if (kt + 1 < ntile) k_gload(pk0, pk1, KC + (kt + 1) * 64 * 64, 64);
    f32x4 st[4];
    st_mma(st, sK, bq, lane);
    float tm = -1e30f;
#pragma unroll
    for (int mt = 0; mt < 4; ++mt)
#pragma unroll
      for (int j = 0; j < 4; ++j) { int n = kt * 64 + 16 * mt + 4 * quad + j; float s = st[mt][j] * 0.125f; st[mt][j] = s; if (n < nv) tm = fmaxf(tm, s); }
    tm = quad_max(tm);
    float mn = fmaxf(m, tm);
    float ps = 0.f;
#pragma unroll
    for (int mt = 0; mt < 4; ++mt)
#pragma unroll
      for (int j = 0; j < 4; ++j) { int n = kt * 64 + 16 * mt + 4 * quad + j; if (n < nv) ps += __expf(st[mt][j] - mn); }
    lsum = lsum * __expf(m - mn) + ps;
    m = mn;
  }
  lsum = quad_sum(lsum);
  const float inv = (lsum > 0.f) ? 1.f / lsum : 0.f;
  f32x4 ot[4];
#pragma unroll
  for (int dt = 0; dt < 4; ++dt) ot[dt] = (f32x4){0.f, 0.f, 0.f, 0.f};
  float carry = 0.f;
  if (ntile > 0) kv_gload(pk0, pk1, pv0, pv1, KC, VC, 64);
  for (int kt = 0; kt < ntile; ++kt) {
    __syncthreads();
    kv_store(pk0, pk1, pv0, pv1, sK, sVt);
    __syncthreads();
    if (kt + 1 < ntile) kv_gload(pk0, pk1, pv0, pv1, KC + (kt + 1) * 64 * 64, VC + (kt + 1) * 64 * 64, 64);
    f32x4 st[4];
    st_mma(st, sK, bq, lane);
#pragma unroll
    for (int mt = 0; mt < 4; ++mt)
#pragma unroll
      for (int j = 0; j < 4; ++j) { int n = kt * 64 + 16 * mt + 4 * quad + j; st[mt][j] = (n < nv) ? __expf(st[mt][j] * 0.125f - m) * inv : 0.f; }
    pv_mma(ot, sVt, st, lane);
    float prevlast = carry;
#pragma unroll
    for (int mt = 0; mt < 4; ++mt) {
      float pl = st[mt][3];
      float fd = __shfl_up(pl, 16);
      float pprev = (quad > 0) ? fd : prevlast;
      float v = st[mt][0] + st[mt][1] + st[mt][2] + st[mt][3] + pprev;
      sImp[(w * 16 + r16) * 64 + kt * 16 + mt * 4 + quad] = v;
      prevlast = __shfl_down(pl, 48);
    }
    carry = prevlast;
  }
  {
    const long t = tb + tq;
#pragma unroll
    for (int dt = 0; dt < 4; ++dt) {
      uint2 ov; ov.x = pk2(ot[dt][0], ot[dt][1]); ov.y = pk2(ot[dt][2], ot[dt][3]);
      *(uint2*)(OC + t * 256 + w * 64 + 16 * dt + 4 * quad) = ov;
    }
  }
  __syncthreads();
  for (int q = 0; q < 4; ++q) {
    const int tok = 4 * w + q, t = t0 + tok;
    float v = sImp[(0 * 16 + tok) * 64 + lane] + sImp[(1 * 16 + tok) * 64 + lane] + sImp[(2 * 16 + tok) * 64 + lane] + sImp[(3 * 16 + tok) * 64 + lane];
    const int cur = t >> 6;
    if (lane == 0 || lane == cur) v = 1e9f;
    else if (lane * 64 > t) v = -1e30f;
    int cnt = 0;
#pragma unroll
    for (int i2 = 0; i2 < 64; ++i2) {
      float vi = __builtin_bit_cast(float, __builtin_amdgcn_readlane(__builtin_bit_cast(int, v), i2));
      cnt += (vi > v || (vi == v && i2 < lane)) ? 1 : 0;
    }
    u64 mask = __ballot(cnt < 16);
    if (lane == 0) SEL[tb + t] = mask;
  }
}

DI void sel_attn_item(const Params& P, int it, u16* sQ, u16* sKunused, u16* sVunused) {
  const int tid = TID(), lane = tid & 63, w = tid >> 6, r16 = lane & 15, quad = lane >> 4;
  const int tbk = 127 - (it >> 3), b = it & 7;
  u16* sK = sQ + 128 * 72;
  u16* sVt = sK + 64 * 72;
  (void)sKunused; (void)sVunused;
  const u16* PROJ = (const u16*)(WSP(P) + WS_PROJ);
  const u16* QR = (const u16*)(WSP(P) + WS_QR);
  const u16* OC = (const u16*)(WSP(P) + WS_OC);
  const u16* OW = (const u16*)(WSP(P) + WS_OW);
  const u64* SEL = (const u64*)(WSP(P) + WS_SEL);
  u16* OUT = (u16*)(WSP(P) + WS_OM);
  const long tb = (long)b * SEQ;
  const int t0 = tbk * 32;
#pragma unroll
  for (int i = 0; i < 4; ++i) {
    const int c = tid + 256 * i, row = c >> 3, ch = c & 7;
    *(uint4*)(sQ + row * 72 + ch * 8) = *(const uint4*)(QR + (tb + t0 + (row & 31)) * 256 + (row >> 5) * 64 + ch * 8);
  }
  __syncthreads();
  bf16x8 bq[2][2];
  int tq[2]; u64 mysel[2];
#pragma unroll
  for (int qt = 0; qt < 2; ++qt) {
    const int rowq = 32 * w + 16 * qt + r16;
    bq[qt][0] = *(const bf16x8*)(sQ + rowq * 72 + quad * 8);
    bq[qt][1] = *(const bf16x8*)(sQ + rowq * 72 + 32 + quad * 8);
    tq[qt] = t0 + 16 * qt + r16;
    mysel[qt] = SEL[tb + tq[qt]];
  }
  u64 uni = 0;
#pragma unroll
  for (int q = 0; q < 32; ++q) uni |= SEL[tb + t0 + q];
  const int cur = t0 >> 6;
  uni &= (cur == 63) ? ~0ull : ((1ull << (cur + 1)) - 1ull);
  f32x4 ot[2][4];
#pragma unroll
  for (int qt = 0; qt < 2; ++qt)
#pragma unroll
    for (int dt = 0; dt < 4; ++dt) ot[qt][dt] = (f32x4){0.f, 0.f, 0.f, 0.f};
  float m[2] = {-1e30f, -1e30f}, lsum[2] = {0.f, 0.f};
  uint4 pk0, pk1, pv0, pv1;
  int kb = uni ? (__ffsll((long long)uni) - 1) : -1;
  uni &= uni - 1;
  if (kb >= 0) kv_gload(pk0, pk1, pv0, pv1, PROJ + (tb + kb * 64) * PW + P_KV + 128, PROJ + (tb + kb * 64) * PW + P_KV + 192, PW);
  for (int nkb = -1; kb >= 0; kb = nkb) {
    __syncthreads();
    kv_store(pk0, pk1, pv0, pv1, sK, sVt);
    __syncthreads();
    nkb = uni ? (__ffsll((long long)uni) - 1) : -1;
    uni &= uni - 1;
    if (nkb >= 0) kv_gload(pk0, pk1, pv0, pv1, PROJ + (tb + nkb * 64) * PW + P_KV + 128, PROJ + (tb + nkb * 64) * PW + P_KV + 192, PW);
#pragma unroll
    for (int qt = 0; qt < 2; ++qt) {
      f32x4 st[4];
      st_mma(st, sK, bq[qt], lane);
      const bool selq = (mysel[qt] >> kb) & 1ull;
      bool msk[4][4];
#pragma unroll
      for (int mt = 0; mt < 4; ++mt)
#pragma unroll
        for (int j = 0; j < 4; ++j) { int s = kb * 64 + 16 * mt + 4 * quad + j; msk[mt][j] = selq && (s <= tq[qt]); }
      softmax_tile(st, msk, m[qt], lsum[qt], ot[qt]);
      pv_mma(ot[qt], sVt, st, lane);
    }
  }
#pragma unroll
  for (int qt = 0; qt < 2; ++qt) {
    const float ls = quad_sum(lsum[qt]);
    const float inv = 1.f / fmaxf(ls, 1e-30f);
    const long t = tb + tq[qt];
    const float gc = sigmoidf_(bf2f(PROJ[t * PW + P_NG + w * 3 + 0]));
    const float gsl = sigmoidf_(bf2f(PROJ[t * PW + P_NG + w * 3 + 1]));
    const float gw = sigmoidf_(bf2f(PROJ[t * PW + P_NG + w * 3 + 2]));
#pragma unroll
    for (int dt = 0; dt < 4; ++dt) {
      const long o = t * 256 + w * 64 + 16 * dt + 4 * quad;
      uint2 c = *(const uint2*)(OC + o), ww = *(const uint2*)(OW + o);
      float r0 = gc * bf2f((u16)(c.x & 0xffff)) + gsl * ot[qt][dt][0] * inv + gw * bf2f((u16)(ww.x & 0xffff));
      float r1 = gc * bf2f((u16)(c.x >> 16)) + gsl * ot[qt][dt][1] * inv + gw * bf2f((u16)(ww.x >> 16));
      float r2 = gc * bf2f((u16)(c.y & 0xffff)) + gsl * ot[qt][dt][2] * inv + gw * bf2f((u16)(ww.y & 0xffff));
      float r3 = gc * bf2f((u16)(c.y >> 16)) + gsl * ot[qt][dt][3] * inv + gw * bf2f((u16)(ww.y >> 16));
      uint2 ov; ov.x = pk2(r0, r1); ov.y = pk2(r2, r3);
      *(uint2*)(OUT + o) = ov;
    }
  }
}

DI void inproj_tile(const Params& P, int l, int it, u16* sA, u16* sB) {
  const int tid = TID(), lane = tid & 63, w = tid >> 6, r16 = lane & 15, quad = lane >> 4, wm = w >> 1, wn = w & 1;
  int mt, nt; tile_from_q(it, 22, mt, nt);
  const u16* H = (const u16*)(WSP(P) + WS_H);
  u16* PROJ = (u16*)(WSP(P) + WS_PROJ);
  const u16* Ab = H + (long)mt * 128 * DM;
  const u16* Bb = (const u16*)(WSP(P) + WS_W + WT_IN) + (long)nt * 128 * DM;
  f32x4 acc[4][4];
  gemm3<4>(acc, g3_ptr(Ab, DM, tid, 0, false), g3_ptr(Ab, DM, tid, 1, false), nullptr, nullptr, 64,
           g3_ptr(Bb, DM, tid, 0, false), g3_ptr(Bb, DM, tid, 1, false), nullptr, nullptr, DM, sA, 16L * DM, 16L * DM);
  __syncthreads();
#pragma unroll
  for (int mi = 0; mi < 4; ++mi)
#pragma unroll
    for (int ni = 0; ni < 4; ++ni)
#pragma unroll
      for (int j = 0; j < 4; ++j) sA[(wm * 64 + 16 * mi + 4 * quad + j) * 136 + wn * 64 + 16 * ni + r16] = f2bf(acc[mi][ni][j]);
  __syncthreads();
  store_tile_bf16<128>(sA, PROJ + (long)mt * 128 * PW + nt * 128, PW, 128);
}
DI void glu_tile(const Params& P, int l, int it, u16* sA, u16* sB) {
  const int tid = TID(), lane = tid & 63, w = tid >> 6, r16 = lane & 15, quad = lane >> 4, wm = w >> 1, wn = w & 1;
  const int mt = it >> 2, nt = it & 3;
  const u16* Y5 = (const u16*)(WSP(P) + WS_Y5);
  u16* OUT = (u16*)(WSP(P) + WS_OM) + (long)1 * T_ * 256;
  const u16* Ab = Y5 + (long)mt * 128 * 256;
  const u16* Bb = (const u16*)(WSP(P) + WS_W + WT_GLU) + (long)nt * 128 * 256;
  f32x4 acc[4][4];
  gemm3<4>(acc, g3_ptr(Ab, 256, tid, 0, false), g3_ptr(Ab, 256, tid, 1, false), nullptr, nullptr, 64,
           g3_ptr(Bb, 256, tid, 0, false), g3_ptr(Bb, 256, tid, 1, false), nullptr, nullptr, 256, sA, 16L * 256, 16L * 256);
  __syncthreads();
#pragma unroll
  for (int mi = 0; mi < 4; ++mi)
#pragma unroll
    for (int ni = 0; ni < 2; ++ni)
#pragma unroll
      for (int j = 0; j < 4; ++j)
        sA[(wm * 64 + 16 * mi + 4 * quad + j) * 72 + wn * 32 + 16 * ni + r16] = f2bf(acc[mi][ni][j] * sigmoidf_(acc[mi][ni + 2][j]));
  __syncthreads();
  store_tile_bf16<64>(sA, OUT + (long)mt * 128 * 256 + nt * 64, 256, 128);
}
DI void merge_tile(const Params& P, int l, int it, u16* sA, u16* sB) {
  const int tid = TID(), lane = tid & 63, w = tid >> 6, r16 = lane & 15, quad = lane >> 4, wm = w >> 1, wn = w & 1;
  int mt, nt; tile_from_q(it, 8, mt, nt);
  const u16* H = (const u16*)(WSP(P) + WS_H);
  const u16* OM = (const u16*)(WSP(P) + WS_OM);
  u16* MERGED = (u16*)(WSP(P) + WS_MERGED);
  uint2 outp[4][4];
#pragma unroll
  for (int mi = 0; mi < 4; ++mi)
#pragma unroll
    for (int ni = 0; ni < 4; ++ni) outp[mi][ni] = make_uint2(0u, 0u);
#pragma unroll 1
  for (int m = 0; m < 4; ++m) {
    uint2 gp[4][4];
    {
      f32x4 ag[4][4];
      const u16* Ab = H + (long)mt * 128 * DM;
      const u16* Bb = (const u16*)(WSP(P) + WS_W + WT_G) + ((long)(m * 1024 + nt * 128)) * DM;
      gemm3<4, true>(ag, g3_ptr(Ab, DM, tid, 0, false), g3_ptr(Ab, DM, tid, 1, false), nullptr, nullptr, 64,
               g3_ptr(Bb, DM, tid, 0, false), g3_ptr(Bb, DM, tid, 1, false), nullptr, nullptr, DM, sA, 16L * DM, 16L * DM);
#pragma unroll
      for (int mi = 0; mi < 4; ++mi)
#pragma unroll
        for (int ni = 0; ni < 4; ++ni) {
          gp[mi][ni].x = pk2(sigmoidf_(ag[mi][ni][0]), sigmoidf_(ag[mi][ni][1]));
          gp[mi][ni].y = pk2(sigmoidf_(ag[mi][ni][2]), sigmoidf_(ag[mi][ni][3]));
        }
    }
    {
      f32x4 av[4][4];
      const u16* Ab = OM + ((long)m * T_ + (long)mt * 128) * 256;
      const u16* Bb = (const u16*)(WSP(P) + WS_W + WT_BR) + ((long)(m * 1024 + nt * 128)) * 256;
      gemm3<4, true>(av, g3_ptr(Ab, 256, tid, 0, false), g3_ptr(Ab, 256, tid, 1, false), nullptr, nullptr, 64,
               g3_ptr(Bb, 256, tid, 0, false), g3_ptr(Bb, 256, tid, 1, false), nullptr, nullptr, 256, sA, 16L * 256, 16L * 256);
#pragma unroll
      for (int mi = 0; mi < 4; ++mi)
#pragma unroll
        for (int ni = 0; ni < 4; ++ni) {
          const float o0 = bf2f((u16)(outp[mi][ni].x & 0xffff)) + av[mi][ni][0] * bf2f((u16)(gp[mi][ni].x & 0xffff));
          const float o1 = bf2f((u16)(outp[mi][ni].x >> 16)) + av[mi][ni][1] * bf2f((u16)(gp[mi][ni].x >> 16));
          const float o2 = bf2f((u16)(outp[mi][ni].y & 0xffff)) + av[mi][ni][2] * bf2f((u16)(gp[mi][ni].y & 0xffff));
          const float o3 = bf2f((u16)(outp[mi][ni].y >> 16)) + av[mi][ni][3] * bf2f((u16)(gp[mi][ni].y >> 16));
          outp[mi][ni].x = pk2(o0, o1); outp[mi][ni].y = pk2(o2, o3);
        }
    }
  }
  __syncthreads();
#pragma unroll
  for (int mi = 0; mi < 4; ++mi)
#pragma unroll
    for (int ni = 0; ni < 4; ++ni)
#pragma unroll
      for (int j = 0; j < 4; ++j) {
        const unsigned wv = (j < 2) ? outp[mi][ni].x : outp[mi][ni].y;
        sA[(wm * 64 + 16 * mi + 4 * quad + j) * 136 + wn * 64 + 16 * ni + r16] = (u16)((j & 1) ? (wv >> 16) : (wv & 0xffff));
      }
  __syncthreads();
  store_tile_bf16<128>(sA, MERGED + (long)mt * 128 * DM + nt * 128, DM, 128);
}
DI void resid_tile(const u16* A, int K, const u16* Bt, const float* resid, float* out, int it, u16* sA, u16* sB) {
  const int tid = TID(), lane = tid & 63, w = tid >> 6, r16 = lane & 15, quad = lane >> 4, wm = w >> 1, wn = w & 1;
  int mt, nt; tile_from_q(it, 8, mt, nt);
  const u16* Ab = A + (long)mt * 128 * K;
  const u16* Bb = Bt + (long)nt * 128 * K;
  f32x4 acc[4][4];
  gemm3<4>(acc, g3_ptr(Ab, K, tid, 0, false), g3_ptr(Ab, K, tid, 1, false), nullptr, nullptr, 64,
           g3_ptr(Bb, K, tid, 0, false), g3_ptr(Bb, K, tid, 1, false), nullptr, nullptr, K, sA, 16L * K, 16L * K);
  float* sC = (float*)sA + w * (32 * 68);
#pragma unroll
  for (int hp = 0; hp < 2; ++hp) {
    __syncthreads();
#pragma unroll
    for (int mi2 = 0; mi2 < 2; ++mi2)
#pragma unroll
      for (int ni = 0; ni < 4; ++ni)
#pragma unroll
        for (int j = 0; j < 4; ++j) sC[(16 * mi2 + 4 * quad + j) * 68 + 16 * ni + r16] = acc[2 * hp + mi2][ni][j];
    __syncthreads();
#pragma unroll
    for (int q = 0; q < 8; ++q) {
      const int c = lane + 64 * q, row = c >> 4, c4 = (c & 15) * 4;
      const long o = ((long)mt * 128 + wm * 64 + 32 * hp + row) * DM + nt * 128 + wn * 64 + c4;
      const float4 rv = *(const float4*)(resid + o);
      const f32x4 cv = *(const f32x4*)(sC + row * 68 + c4);
      *(float4*)(out + o) = make_float4(rv.x + cv[0], rv.y + cv[1], rv.z + cv[2], rv.w + cv[3]);
    }
  }
}
DI void ffn1_tile(const Params& P, int l, int it, u16* sA, u16* sB) {
  const int tid = TID(), lane = tid & 63, w = tid >> 6, r16 = lane & 15, quad = lane >> 4, wm = w >> 1, wn = w & 1;
  int mt, nt; tile_from_q(it, 44, mt, nt);
  const u16* H = (const u16*)(WSP(P) + WS_H);
  u16* ACT = (u16*)(WSP(P) + WS_PROJ);
  const u16* Ab = H + (long)mt * 128 * DM;
  const u16* Bb = (const u16*)(WSP(P) + WS_W + WT_GU) + (long)nt * 128 * DM;
  f32x4 acc[4][4];
  gemm3<4>(acc, g3_ptr(Ab, DM, tid, 0, false), g3_ptr(Ab, DM, tid, 1, false), nullptr, nullptr, 64,
           g3_ptr(Bb, DM, tid, 0, false), g3_ptr(Bb, DM, tid, 1, false), nullptr, nullptr, DM, sA, 16L * DM, 16L * DM);
  __syncthreads();
#pragma unroll
  for (int mi = 0; mi < 4; ++mi)
#pragma unroll
    for (int ni = 0; ni < 2; ++ni)
#pragma unroll
      for (int j = 0; j < 4; ++j)
        sA[(wm * 64 + 16 * mi + 4 * quad + j) * 72 + wn * 32 + 16 * ni + r16] = f2bf(siluf_(acc[mi][ni][j]) * acc[mi][ni + 2][j]);
  __syncthreads();
  store_tile_bf16<64>(sA, ACT + (long)mt * 128 * DFF + nt * 64, DFF, 128);
}

__global__ void __launch_bounds__(256, LB2) fwd_megakernel(Params P) {
  cg::grid_group grid = cg::this_grid();
  __shared__ __attribute__((aligned(16))) float lds[17920];
  __shared__ int s_item;
  unsigned* cnt = (unsigned*)(WSP(P) + WS_CNT);
  const int xcd = (int)(__builtin_amdgcn_s_getreg((3 << 11) | 20) & 0xF) & 7;
  __shared__ int s_rank;
  if (threadIdx.x == 0) s_rank = (int)atomicAdd(cnt + 900 + xcd, 1u);
  __syncthreads();
  const int xrank = s_rank;
  u16* sA = (u16*)lds;
  u16* sB = sA + 128 * 80;
  u16* aQ = (u16*)lds;
  u16* aK = aQ + 64 * 72;
  u16* aV = aK + 64 * 72;
  float* aImp = (float*)(aV + 64 * 72);
  for (int ph = P.ph_lo; ph < P.ph_hi; ++ph) {
    const int l = ph / 11, sp = ph % 11;
    const float* xin = (l == 0) ? P.in[0] : P.out;
    const int nrep = (PROBE_DUP != 0 && l == 0 && ((PROBE_DUP >> sp) & 1)) ? 2 : 1;
    for (int rep = 0; rep < nrep; ++rep) {
    unsigned* pc = cnt + (ph + 32 * rep) * 8;
    switch (sp) {
      case 0: if (PHASE_MASK & (1 << 0)) {
        phase_rmsnorm(xin, P.in[2] + l * DM, (u16*)(WSP(P) + WS_H));
        phase_convert(P, l, lds);
        if (l == 0) phase_rope_table((const int*)P.in[1], (float*)(WSP(P) + WS_COS), (float*)(WSP(P) + WS_SIN));
      } break;
      case 1: if (PHASE_MASK & (1 << 1)) {
        XCD_STATIC_LOOP(32 * 22, inproj_tile(P, l, it, sA, sB))
      } break;
      case 2: if (PHASE_MASK & (1 << 2)) {
        for (;;) {
          int it = next_item(pc, &s_item); if (it >= 64 + 3 * 2048) break;
          if (it < 64) cmp1_tile(P, l, it, sA, sB);
          else if (it < 64 + 2048) gdn_p1_item(P, l, it - 64, lds);
          else if (it < 64 + 4096) s5_pass1_item(P, l, it - 64 - 2048, lds);
          else nsa_prep_item(P, l, it - 64 - 4096);
        }
      } break;
      case 3: if (PHASE_MASK & (1 << 3)) {
        for (;;) {
          int it = next_item(pc, &s_item); if (it >= 128 + 3072 + 64) break;
          if (it < 128) gdn_p2_item(P, it, lds);
          else if (it < 128 + 2048) sb_attn_item(P, it - 128, aQ, aK, aV);
          else if (it < 128 + 3072) win_attn_item(P, it - 128 - 2048, aQ, aK, aV);
          else if (it < 128 + 3072 + 32) s5_carry_item(P, l, it - 128 - 3072);
          else cmp2_tile(P, l, it - 128 - 3072 - 32, sA, sB, lds + 17000);
        }
      } break;
      case 4: if (PHASE_MASK & (1 << 4)) {
        for (;;) {
          int it = next_item(pc, &s_item); if (it >= 3 * 2048) break;
          if (it < 2048) cmp_attn_item(P, it, aQ, aK, aV, aImp);
          else if (it < 4096) s5_pass2_item(P, l, it - 2048, lds);
          else gdn_post_item(P, l, it - 4096);
        }
      } break;
      case 5: if (PHASE_MASK & (1 << 5)) {
        for (;;) {
          int it = next_item(pc, &s_item); if (it >= 1024 + 1024) break;
          if (it < 1024) sel_attn_item(P, it, aQ, aK, aV);
          else glu_tile(P, l, it - 1024, sA, sB);
        }
      } break;
      case 6: if (PHASE_MASK & (1 << 6)) {
        XCD_STATIC_LOOP(32 * 8, merge_tile(P, l, it, sA, sB))
      } break;
      case 7: if (PHASE_MASK & (1 << 7)) {
        XCD_STATIC_LOOP(32 * 8, resid_tile((const u16*)(WSP(P) + WS_MERGED), DM, (const u16*)(WSP(P) + WS_W + WT_OUT), xin, P.out, it, sA, sB))
      } break;
      case 8: if (PHASE_MASK & (1 << 8)) {
        phase_rmsnorm(P.out, P.in[26] + l * DM, (u16*)(WSP(P) + WS_H));
      } break;
      case 9: if (PHASE_MASK & (1 << 9)) {
        XCD_STATIC_LOOP(32 * 44, ffn1_tile(P, l, it, sA, sB))
      } break;
      case 10: if (PHASE_MASK & (1 << 10)) {
        XCD_STATIC_LOOP(32 * 8, resid_tile((const u16*)(WSP(P) + WS_PROJ), DFF, (const u16*)(WSP(P) + WS_W + WT_D), P.out, P.out, it, sA, sB))
      } break;
    }
    if (rep + 1 < nrep) grid.sync();
    }
    if (ph + 1 < P.ph_hi) grid.sync();
  }
}

extern "C" void kernel_launch(void* const* d_in, const int* in_sizes, int n_in, void* d_out, int out_size, void* d_ws, size_t ws_size,
                              hipStream_t stream) {
  static int grid_blocks = 0;
  if (!grid_blocks) {
    int dev = 0, cus = 0, per_cu = 0;
    hipGetDevice(&dev);
    hipDeviceGetAttribute(&cus, hipDeviceAttributeMultiprocessorCount, dev);
    hipOccupancyMaxActiveBlocksPerMultiprocessor(&per_cu, fwd_megakernel, 256, 0);
    if (per_cu < 1) per_cu = 1;
    if (per_cu > 2) per_cu = 2;
    grid_blocks = cus * per_cu;
    if (ws_size < WS_W + WT_END) fprintf(stderr, "kernel_launch: workspace too small: %zu\n", ws_size);
  }
  hipMemsetAsync((char*)d_ws + WS_CNT, 0, 4096, stream);
  Params p{};
  for (int i = 0; i < 30; ++i) p.in[i] = (const float*)d_in[i];
  p.out = (float*)d_out;
  p.ws = (unsigned char*)d_ws;
  p.ph_lo = 0; p.ph_hi = NPHASE;
  void* args[] = {&p};
  hipError_t e = hipLaunchCooperativeKernel((void*)fwd_megakernel, dim3(grid_blocks), dim3(256), args, 0, stream);
  if (e != hipSuccess) fprintf(stderr, "cooperative launch failed: %s (grid %d)\n", hipGetErrorString(e), grid_blocks);
}
```

```cpp
#include <hip/hip_runtime.h>
#include <hip/hip_cooperative_groups.h>
#include <cstdio>
namespace cg = cooperative_groups;

typedef unsigned short u16;
typedef unsigned long long u64;
typedef __attribute__((ext_vector_type(8))) short bf16x8;
typedef __attribute__((ext_vector_type(4))) short s16x4;
typedef __attribute__((ext_vector_type(4))) float f32x4;
#define DI __device__ __forceinline__

constexpr int NB = 8, SEQ = 4096, T_ = NB * SEQ, DM = 1024, DIN = 6804, PW = 2816, DFF = 2816;
constexpr int P_Q = 0, P_KV = 256, P_S5U = 640, P_GQKV = 896, P_GZ = 1664, P_SB = 1920, P_NG = 2688, P_GA = 2700, P_GB = 2704;
constexpr float EPS = 1e-6f;
constexpr size_t MiB = 1024ull * 1024ull;
constexpr size_t WS_H = 0, WS_PROJ = 64 * MiB, WS_OM = 240 * MiB, WS_MERGED = 304 * MiB,
                 WS_GQ = 304 * MiB, WS_GK = 320 * MiB, WS_GU = 336 * MiB, WS_GW = 352 * MiB, WS_GA = 368 * MiB,
                 WS_QR = 384 * MiB, WS_OC = 400 * MiB, WS_OW = 416 * MiB, WS_Y5 = 432 * MiB,
                 WS_GG = 448 * MiB, WS_SEL = 449 * MiB, WS_COS = 450 * MiB, WS_SIN = 451 * MiB,
                 WS_ENDS = 452 * MiB, WS_CARRY = 456 * MiB, WS_KC = 460 * MiB, WS_VC = 461 * MiB, WS_HID = 462 * MiB,
                 WS_CNT = 464 * MiB, WS_W = 465 * MiB, WS_CBIAS = 449 * MiB + 512 * 1024;
constexpr size_t WT_IN = 0, WT_G = WT_IN + 2816ull * 1024 * 2, WT_BR = WT_G + 4096ull * 1024 * 2, WT_OUT = WT_BR + 4096ull * 256 * 2,
                 WT_GU = WT_OUT + 1024ull * 1024 * 2, WT_D = WT_GU + 5632ull * 1024 * 2, WT_GLU = WT_D + 1024ull * 2816 * 2,
                 WT_C1 = WT_GLU + 512ull * 256 * 2, WT_C2 = WT_C1 + 512ull * 2048 * 2, WT_END = WT_C2 + 128ull * 256 * 2;
constexpr int NPHASE = 22;
#define XCD_STATIC_LOOP(NPER, BODY) { \
    unsigned c0_ = cnt[900], c1_ = cnt[901], c2_ = cnt[902], c3_ = cnt[903], c4_ = cnt[904], c5_ = cnt[905], c6_ = cnt[906], c7_ = cnt[907]; \
    const bool ok_ = c0_ && c1_ && c2_ && c3_ && c4_ && c5_ && c6_ && c7_; \
    const unsigned mine_ = xcd == 0 ? c0_ : xcd == 1 ? c1_ : xcd == 2 ? c2_ : xcd == 3 ? c3_ : xcd == 4 ? c4_ : xcd == 5 ? c5_ : xcd == 6 ? c6_ : c7_; \
    const int start_ = ok_ ? xcd * (NPER) + xrank : (int)blockIdx.x, end_ = ok_ ? (xcd + 1) * (NPER) : 8 * (NPER), step_ = ok_ ? (int)mine_ : (int)gridDim.x; \
    for (int it = start_; it < end_; it += step_) { BODY; } }
#ifndef PROBE_DUP
#define PROBE_DUP 0
#endif
#ifndef LB2
#define LB2 2
#endif
#ifndef PHASE_MASK
#define PHASE_MASK 0x7ff
#endif

struct Params {
  const float* in[30];
  float* out;
  unsigned char* ws;
  int ph_lo, ph_hi;
};


DI int TID() { int t = threadIdx.x; asm volatile("" : "+v"(t)); return t; }
DI unsigned char* WSP(const Params& P) { size_t z = 0; asm volatile("" : "+s"(z)); return P.ws + z; }
DI u16 f2bf(float x) { unsigned u = __float_as_uint(x); u += 0x7fffu + ((u >> 16) & 1u); return (u16)(u >> 16); }
DI float bf2f(u16 h) { return __uint_as_float(((unsigned)h) << 16); }
DI unsigned pk2(float a, float b) { return (unsigned)f2bf(a) | ((unsigned)f2bf(b) << 16); }
DI float wave_sum(float v) {
#pragma unroll
  for (int o = 1; o < 64; o <<= 1) v += __shfl_xor(v, o);
  return v;
}
DI float sigmoidf_(float x) { return 1.f / (1.f + __expf(-x)); }
DI float siluf_(float x) { return x * sigmoidf_(x); }
DI float softplusf_(float x) { return fmaxf(x, 0.f) + log1pf(__expf(-fabsf(x))); }
DI float gelu_tanh(float x) {
  float u = 0.7978845608028654f * (x + 0.044715f * x * x * x);
  float t = 1.f - 2.f / (__expf(2.f * u) + 1.f);
  return 0.5f * x * (1.f + t);
}
DI void sincos_d(double x, double& s, double& c) {
  const double TWO_PI = 6.283185307179586476925287, INV = 0.15915494309189533576888;
  double n = rint(x * INV);
  double r = x - n * TWO_PI;
  double r2 = r * r, term = 1.0, cs = 1.0, ss = 1.0;
#pragma unroll
  for (int k = 1; k <= 14; ++k) { term *= r2 * (-1.0 / (double)((2 * k - 1) * (2 * k))); cs += term; }
  term = 1.0;
#pragma unroll
  for (int k = 1; k <= 14; ++k) { term *= r2 * (-1.0 / (double)((2 * k) * (2 * k + 1))); ss += term; }
  s = r * ss; c = cs;
}
DI int next_item(unsigned* cnt, int* s_item) {
  __syncthreads();
  if (TID() == 0) *s_item = (int)atomicAdd(cnt, 1u);
  __syncthreads();
  return *s_item;
}
DI int next_tile_xcd(unsigned* cnt8, int n_per_xcd, int xcd, int* s_item) {
  asm volatile("" : "+s"(xcd));
  __syncthreads();
  if (threadIdx.x == 0) {
    int res = -1;
    for (int a = 0; a < 8; ++a) {
      int qq = (xcd + a) & 7;
      unsigned v = atomicAdd(cnt8 + qq, 1u);
      if (v < (unsigned)n_per_xcd) { res = qq * n_per_xcd + (int)v; break; }
    }
    *s_item = res;
  }
  __syncthreads();
  return *s_item;
}
DI void tile_from_q(int it, int numN, int& mt, int& nt) {
  const int per = 32 * numN, q = it / per, i = it % per, g = i / (8 * numN), rem = i % (8 * numN);
  nt = rem >> 3; mt = 32 * q + 8 * g + (rem & 7);
}
DI int proj_src_col(int pc) {
  if (pc < 640) return pc;
  if (pc < 1664) return pc + 12;
  if (pc < 2688) return pc + 20;
  if (pc < 2700) return pc - 2688 + 640;
  if (pc < 2708) return pc - 2700 + 1676;
  return pc;
}

DI uint4 addpos8(uint4 v, const float* pp) {
  uint4 o;
  o.x = pk2(bf2f((u16)(v.x & 0xffff)) + pp[0], bf2f((u16)(v.x >> 16)) + pp[1]);
  o.y = pk2(bf2f((u16)(v.y & 0xffff)) + pp[2], bf2f((u16)(v.y >> 16)) + pp[3]);
  o.z = pk2(bf2f((u16)(v.z & 0xffff)) + pp[4], bf2f((u16)(v.z >> 16)) + pp[5]);
  o.w = pk2(bf2f((u16)(v.w & 0xffff)) + pp[6], bf2f((u16)(v.w >> 16)) + pp[7]);
  return o;
}
template <int NTW>
DI void gemm2(f32x4 (&acc)[4][NTW], const u16* __restrict__ arow, long a_kstep, const float* __restrict__ apos,
              const u16* __restrict__ brow, int K, u16* sA, u16* sB) {
  constexpr int BN = 32 * NTW, BV = BN / 32, LS = 80;
  const int tid = TID(), lane = tid & 63, w = tid >> 6, r16 = lane & 15, quad = lane >> 4;
  const int wm = w >> 1, wn = w & 1;
  u16* sa_st = sA + (tid >> 1) * LS + (tid & 1) * 32;
  u16* sb_st = (BN == 128) ? (sB + (tid >> 1) * LS + (tid & 1) * 32) : (sB + (tid >> 2) * LS + (tid & 3) * 16);
  uint4 pa0, pa1, pa2, pa3, pb0, pb1, pb2, pb3;
  uint4 qa0, qa1, qa2, qa3, qb0, qb1, qb2, qb3;
  pb2 = make_uint4(0, 0, 0, 0); pb3 = pb2; qb2 = pb2; qb3 = pb2;
#define G2_LOAD(KT, a0, a1, a2, a3, b0, b1, b2, b3) { const uint4* pa_ = (const uint4*)(arow + (long)(KT) * a_kstep); \
    a0 = pa_[0]; a1 = pa_[1]; a2 = pa_[2]; a3 = pa_[3]; \
    if (apos) { const float* pp_ = apos + (KT) * 64 + (tid & 1) * 32; \
      a0 = addpos8(a0, pp_); a1 = addpos8(a1, pp_ + 8); a2 = addpos8(a2, pp_ + 16); a3 = addpos8(a3, pp_ + 24); } \
    const uint4* pb_ = (const uint4*)(brow + (long)(KT) * 64); \
    b0 = pb_[0]; b1 = pb_[1]; if (BV == 4) { b2 = pb_[2]; b3 = pb_[3]; } }
#define G2_STORE(a0, a1, a2, a3, b0, b1, b2, b3) { \
    ((uint4*)sa_st)[0] = a0; ((uint4*)sa_st)[1] = a1; ((uint4*)sa_st)[2] = a2; ((uint4*)sa_st)[3] = a3; \
    ((uint4*)sb_st)[0] = b0; ((uint4*)sb_st)[1] = b1; if (BV == 4) { ((uint4*)sb_st)[2] = b2; ((uint4*)sb_st)[3] = b3; } }
#define G2_COMPUTE() { _Pragma("unroll") for (int ks = 0; ks < 2; ++ks) { \
      bf16x8 af[4], bg[NTW]; \
      _Pragma("unroll") for (int mi = 0; mi < 4; ++mi) af[mi] = *(const bf16x8*)(sA + (wm * 64 + 16 * mi + r16) * LS + ks * 32 + quad * 8); \
      _Pragma("unroll") for (int ni = 0; ni < NTW; ++ni) bg[ni] = *(const bf16x8*)(sB + (wn * (BN / 2) + 16 * ni + r16) * LS + ks * 32 + quad * 8); \
      _Pragma("unroll") for (int mi = 0; mi < 4; ++mi) \
        _Pragma("unroll") for (int ni = 0; ni < NTW; ++ni) acc[mi][ni] = __builtin_amdgcn_mfma_f32_16x16x32_bf16(af[mi], bg[ni], acc[mi][ni], 0, 0, 0); } }
#pragma unroll
  for (int mi = 0; mi < 4; ++mi)
#pragma unroll
    for (int ni = 0; ni < NTW; ++ni) acc[mi][ni] = (f32x4){0.f, 0.f, 0.f, 0.f};
  const int nk = K >> 6;
  G2_LOAD(0, pa0, pa1, pa2, pa3, pb0, pb1, pb2, pb3)
  G2_LOAD(1, qa0, qa1, qa2, qa3, qb0, qb1, qb2, qb3)
#pragma unroll 1
  for (int kt = 0; kt < nk; kt += 2) {
    __syncthreads();
    G2_STORE(pa0, pa1, pa2, pa3, pb0, pb1, pb2, pb3)
    __syncthreads();
    if (kt + 2 < nk) G2_LOAD(kt + 2, pa0, pa1, pa2, pa3, pb0, pb1, pb2, pb3)
    G2_COMPUTE()
    __syncthreads();
    G2_STORE(qa0, qa1, qa2, qa3, qb0, qb1, qb2, qb3)
    __syncthreads();
    if (kt + 3 < nk) G2_LOAD(kt + 3, qa0, qa1, qa2, qa3, qb0, qb1, qb2, qb3)
    G2_COMPUTE()
  }
#undef G2_LOAD
#undef G2_STORE
#undef G2_COMPUTE
}
DI void g3_rowpiece(int tid, int q, bool n64, int& row, int& pc) {
  const int w = tid >> 6, lane = tid & 63, chunk = n64 ? (2 * w + q) : (4 * w + q);
  row = 8 * chunk + (lane >> 3);
  pc = (lane & 7) ^ ((row >> 1) & 7);
}
DI const u16* g3_ptr(const u16* base, long ld, int tid, int q, bool n64) {
  int row, pc; g3_rowpiece(tid, q, n64, row, pc);
  return base + (long)row * ld + pc * 8;
}
template <int NTW, bool LEAN = false>
DI void gemm3(f32x4 (&acc)[4][NTW], const u16* ap0, const u16* ap1, const u16* ap2, const u16* ap3, long a_kstep,
              const u16* bp0, const u16* bp1, const u16* bp2, const u16* bp3, int K, u16* sbase, long a16 = 0, long b16 = 0) {
  constexpr int BN = 32 * NTW, STAGE = 16384;
  const int tid = TID(), lane = tid & 63, w = tid >> 6, r16 = lane & 15, quad = lane >> 4;
  const int wm = w >> 1, wn = w & 1;
  const int sz = (r16 >> 1) & 7;
  const int wu = __builtin_amdgcn_readfirstlane(w);
#define G3_GLDS(GP, LOFF) asm volatile("s_mov_b32 m0, %1\n\ts_nop 0\n\tglobal_load_lds_dwordx4 %0, off" :: "v"(GP), "s"(LOFF) : "memory", "m0")
  const unsigned lds0 = (unsigned)(size_t)sbase;
#define G3_ISSUE(KT) { const unsigned st_ = lds0 + (((KT) & 1) ? STAGE * 2 : 0); const long ka_ = (long)(KT) * a_kstep, kb_ = (long)(KT) * 64; \
    if (BN == 128) { \
      const unsigned la_ = __builtin_amdgcn_readfirstlane(st_ + wu * 4096u); \
      G3_GLDS(ap0 + ka_, la_); G3_GLDS(ap1 + ka_, la_ + 1024u); \
      if (a16) { G3_GLDS(ap0 + (ka_ + a16), la_ + 2048u); G3_GLDS(ap1 + (ka_ + a16), la_ + 3072u); } else { G3_GLDS(ap2 + ka_, la_ + 2048u); G3_GLDS(ap3 + ka_, la_ + 3072u); } \
      G3_GLDS(bp0 + kb_, la_ + 16384u); G3_GLDS(bp1 + kb_, la_ + 17408u); \
      if (b16) { G3_GLDS(bp0 + (kb_ + b16), la_ + 18432u); G3_GLDS(bp1 + (kb_ + b16), la_ + 19456u); } else { G3_GLDS(bp2 + kb_, la_ + 18432u); G3_GLDS(bp3 + kb_, la_ + 19456u); } \
    } else { \
      const unsigned la_ = __builtin_amdgcn_readfirstlane(st_ + wu * 4096u); \
      const unsigned lb_ = __builtin_amdgcn_readfirstlane(st_ + 16384u + wu * 2048u); \
      G3_GLDS(ap0 + ka_, la_); G3_GLDS(ap1 + ka_, la_ + 1024u); G3_GLDS(ap2 + ka_, la_ + 2048u); G3_GLDS(ap3 + ka_, la_ + 3072u); \
      G3_GLDS(bp0 + kb_, lb_); G3_GLDS(bp1 + kb_, lb_ + 1024u); \
    } }
#pragma unroll
  for (int mi = 0; mi < 4; ++mi)
#pragma unroll
    for (int ni = 0; ni < NTW; ++ni) acc[mi][ni] = (f32x4){0.f, 0.f, 0.f, 0.f};
  const int nk = K >> 6;
  __syncthreads();
  G3_ISSUE(0)
  if (!LEAN && BN == 128) {
#define G3_PIECE(I, KT) { const unsigned st_ = lds0 + (((KT) & 1) ? STAGE * 2 : 0); const long ka_ = (long)(KT) * a_kstep, kb_ = (long)(KT) * 64; \
      const unsigned la_ = __builtin_amdgcn_readfirstlane(st_ + wu * 4096u); \
      if ((I) == 0) G3_GLDS(ap0 + ka_, la_); else if ((I) == 1) G3_GLDS(ap1 + ka_, la_ + 1024u); \
      else if ((I) == 2) G3_GLDS((a16 ? ap0 + a16 : ap2) + ka_, la_ + 2048u); else if ((I) == 3) G3_GLDS((a16 ? ap1 + a16 : ap3) + ka_, la_ + 3072u); \
      else if ((I) == 4) G3_GLDS(bp0 + kb_, la_ + 16384u); else if ((I) == 5) G3_GLDS(bp1 + kb_, la_ + 17408u); \
      else if ((I) == 6) G3_GLDS((b16 ? bp0 + b16 : bp2) + kb_, la_ + 18432u); else G3_GLDS((b16 ? bp1 + b16 : bp3) + kb_, la_ + 19456u); }
#define G3_STEP(KT, DOISSUE) { const u16* sAs = sbase + ((KT) & 1) * STAGE; const u16* sBs = sAs + 8192; \
      bf16x8 af[2][4], bg[2][NTW];     \
      _Pragma("unroll") for (int ks = 0; ks < 2; ++ks) { \
        const int pcol = ((ks * 4 + quad) ^ sz) * 8; \
        _Pragma("unroll") for (int mi = 0; mi < 4; ++mi) af[ks][mi] = *(const bf16x8*)(sAs + (wm * 64 + 16 * mi + r16) * 64 + pcol); \
        _Pragma("unroll") for (int ni = 0; ni < NTW; ++ni) bg[ks][ni] = *(const bf16x8*)(sBs + (wn * (BN / 2) + 16 * ni + r16) * 64 + pcol); } \
      _Pragma("unroll") for (int mi = 0; mi < 4; ++mi) {   \
        acc[mi][0] = __builtin_amdgcn_mfma_f32_16x16x32_bf16(af[0][mi], bg[0][0], acc[mi][0], 0, 0, 0); \
        acc[mi][1] = __builtin_amdgcn_mfma_f32_16x16x32_bf16(af[0][mi], bg[0][1], acc[mi][1], 0, 0, 0); \
        if (DOISSUE) G3_PIECE(2 * mi, (KT) + 1) \
        __builtin_amdgcn_sched_barrier(0); \
        acc[mi][2] = __builtin_amdgcn_mfma_f32_16x16x32_bf16(af[0][mi], bg[0][2], acc[mi][2], 0, 0, 0); \
        acc[mi][3] = __builtin_amdgcn_mfma_f32_16x16x32_bf16(af[0][mi], bg[0][3], acc[mi][3], 0, 0, 0); \
        if (DOISSUE) G3_PIECE(2 * mi + 1, (KT) + 1) \
        __builtin_amdgcn_sched_barrier(0); } \
      _Pragma("unroll") for (int mi = 0; mi < 4; ++mi) \
        _Pragma("unroll") for (int ni = 0; ni < NTW; ++ni) acc[mi][ni] = __builtin_amdgcn_mfma_f32_16x16x32_bf16(af[1][mi], bg[1][ni], acc[mi][ni], 0, 0, 0); }
#pragma unroll 1
    for (int kt = 0; kt < nk - 1; ++kt) {
      asm volatile("s_waitcnt vmcnt(0) lgkmcnt(0)" ::: "memory");
      __builtin_amdgcn_s_barrier();
      asm volatile("" ::: "memory");
      G3_STEP(kt, true)
    }
    asm volatile("s_waitcnt vmcnt(0) lgkmcnt(0)" ::: "memory");
    __builtin_amdgcn_s_barrier();
    asm volatile("" ::: "memory");
    G3_STEP(nk - 1, false)
#undef G3_PIECE
#undef G3_STEP
  } else
#pragma unroll 1
  for (int kt = 0; kt < nk; ++kt) {
    asm volatile("s_waitcnt vmcnt(0) lgkmcnt(0)" ::: "memory");
    __builtin_amdgcn_s_barrier();
    asm volatile("" ::: "memory");
    if (kt + 1 < nk) G3_ISSUE(kt + 1)
    const u16* sAs = sbase + (kt & 1) * STAGE;
    const u16* sBs = sAs + 8192;
#pragma unroll 1
    for (int ks = 0; ks < (LEAN ? 2 : 0); ++ks) {
      const int pcol = ((ks * 4 + quad) ^ sz) * 8;
      bf16x8 af[4];
#pragma unroll
      for (int mi = 0; mi < 4; ++mi) af[mi] = *(const bf16x8*)(sAs + (wm * 64 + 16 * mi + r16) * 64 + pcol);
#pragma unroll
      for (int ni = 0; ni < NTW; ++ni) {
        bf16x8 b1 = *(const bf16x8*)(sBs + (wn * (BN / 2) + 16 * ni + r16) * 64 + pcol);
#pragma unroll
        for (int mi = 0; mi < 4; ++mi) acc[mi][ni] = __builtin_amdgcn_mfma_f32_16x16x32_bf16(af[mi], b1, acc[mi][ni], 0, 0, 0);
      }
    }
#pragma unroll
    for (int ks = 0; ks < (LEAN ? 0 : 2); ++ks) {
      const int pcol = ((ks * 4 + quad) ^ sz) * 8;
      bf16x8 af[4], bg[NTW];
#pragma unroll
      for (int mi = 0; mi < 4; ++mi) af[mi] = *(const bf16x8*)(sAs + (wm * 64 + 16 * mi + r16) * 64 + pcol);
#pragma unroll
      for (int ni = 0; ni < NTW; ++ni) bg[ni] = *(const bf16x8*)(sBs + (wn * (BN / 2) + 16 * ni + r16) * 64 + pcol);
#pragma unroll
      for (int mi = 0; mi < 4; ++mi)
#pragma unroll
        for (int ni = 0; ni < NTW; ++ni) acc[mi][ni] = __builtin_amdgcn_mfma_f32_16x16x32_bf16(af[mi], bg[ni], acc[mi][ni], 0, 0, 0);
    }
  }
#undef G3_ISSUE
#undef G3_GLDS
}
template <int NCOLS>
DI void store_tile_bf16(const u16* sC, u16* gdst, long ld, int rows_valid) {
  constexpr int CPR = NCOLS / 8, LS = NCOLS + 8;
  const int tid = TID();
#pragma unroll
  for (int q = 0; q < (128 * CPR) / 256; ++q) {
    const int c = tid + 256 * q, row = c / CPR, ch = c % CPR;
    if (row < rows_valid) *(uint4*)(gdst + (long)row * ld + ch * 8) = *(const uint4*)(sC + row * LS + ch * 8);
  }
}
DI int pair_col(int np, int& which) {
  const int nt = np >> 7, c = np & 127, wn = c >> 6, ni = (c >> 4) & 3, r = c & 15;
  which = ni >> 1;
  return nt * 64 + wn * 32 + (ni & 1) * 16 + r;
}
DI const float* conv_colptr(const Params& P, int l, int mat, int np, long& ld) {
  int which;
  switch (mat) {
    case 0: ld = DIN; return P.in[3] + (long)l * DM * DIN + proj_src_col(np);
    case 1: ld = DIN; return P.in[3] + (long)l * DM * DIN + 2708 + np;
    case 2: ld = DM; return P.in[24] + ((long)(l * 4 + (np >> 10)) * 256) * DM + (np & 1023);
    case 3: ld = DM; return P.in[25] + (long)l * DM * DM + np;
    case 4: { int o = pair_col(np, which); ld = DFF; return (which ? P.in[28] : P.in[27]) + (long)l * DM * DFF + o; }
    case 5: ld = DM; return P.in[29] + (long)l * DFF * DM + np;
    case 6: { int o = pair_col(np, which); ld = 512; return P.in[19] + (long)l * 256 * 512 + which * 256 + o; }
    case 7: ld = 256; return P.in[(np >> 8) ? 9 : 7] + (long)l * 2048 * 256 + (np & 255);
    default: ld = 64; return P.in[(np >> 6) ? 10 : 8] + (long)l * 256 * 64 + (np & 63);
  }
}
DI void phase_convert(const Params& P, int l, float* lds) {
  const int tid = TID();
  if (blockIdx.x < 64) {
    const int kv = blockIdx.x >> 5, ks = blockIdx.x & 31;
    const float* pos = P.in[6] + (long)(l * 2 + kv) * 2048 + ks * 64;
    const float* w1 = P.in[kv ? 9 : 7] + (long)l * 2048 * 256 + (long)ks * 64 * 256 + tid;
    float a = 0.f;
#pragma unroll 8
    for (int k = 0; k < 64; ++k) a += pos[k] * w1[(long)k * 256];
    ((float*)(WSP(P) + WS_CBIAS))[(kv * 32 + ks) * 256 + tid] = a;
  }
  const int NB_[9] = {44, 64, 64, 16, 88, 16, 8, 8, 2};
  const int KB_[9] = {16, 16, 4, 16, 16, 44, 4, 32, 4};
  const size_t OFF_[9] = {WT_IN, WT_G, WT_BR, WT_OUT, WT_GU, WT_D, WT_GLU, WT_C1, WT_C2};
  for (int it = blockIdx.x; it < 4648; it += gridDim.x) {
    int r = it, mat = 0, nbk = 0, kbk = 0; size_t off = 0;
#pragma unroll
    for (int q = 0; q < 9; ++q) { int n = NB_[q] * KB_[q]; if (r >= 0 && r < n) { mat = q; nbk = NB_[q]; kbk = KB_[q]; off = OFF_[q]; r -= 100000; } else if (r >= 0) r -= n; }
    r += 100000;
    const int nb = r / kbk, kb = r % kbk, K = kbk * 64;
    (void)nbk;
    __syncthreads();
    {
      const int n = tid & 63;
      long ld; const float* cp = conv_colptr(P, l, mat, nb * 64 + n, ld);
#pragma unroll 4
      for (int q = 0; q < 16; ++q) { int k = (tid >> 6) + 4 * q; lds[n * 65 + k] = cp[(long)(kb * 64 + k) * ld]; }
    }
    __syncthreads();
    u16* dst = (u16*)(WSP(P) + WS_W + off);
#pragma unroll
    for (int q = 0; q < 2; ++q) {
      int c = tid + 256 * q, n = c >> 3, k8 = (c & 7) * 8;
      const float* sp = lds + n * 65 + k8;
      uint4 v; v.x = pk2(sp[0], sp[1]); v.y = pk2(sp[2], sp[3]); v.z = pk2(sp[4], sp[5]); v.w = pk2(sp[6], sp[7]);
      *(uint4*)(dst + (long)(nb * 64 + n) * K + kb * 64 + k8) = v;
    }
  }
}

DI void st_mma(f32x4 (&st)[4], const u16* sK, const bf16x8 (&bq)[2], int lane) {
  const int r = lane & 15, quad = lane >> 4;
#pragma unroll
  for (int mt = 0; mt < 4; ++mt) {
    f32x4 a = {0.f, 0.f, 0.f, 0.f};
#pragma unroll
    for (int ks = 0; ks < 2; ++ks) {
      bf16x8 kf = *(const bf16x8*)(sK + (16 * mt + r) * 72 + ks * 32 + quad * 8);
      a = __builtin_amdgcn_mfma_f32_16x16x32_bf16(kf, bq[ks], a, 0, 0, 0);
    }
    st[mt] = a;
  }
}
DI void pv_mma(f32x4 (&ot)[4], const u16* sVt, const f32x4 (&p)[4], int lane) {
  const int r = lane & 15, quad = lane >> 4;
#pragma unroll
  for (int ks = 0; ks < 2; ++ks) {
    uint4 pu;
    pu.x = pk2(p[2 * ks][0], p[2 * ks][1]); pu.y = pk2(p[2 * ks][2], p[2 * ks][3]);
    pu.z = pk2(p[2 * ks + 1][0], p[2 * ks + 1][1]); pu.w = pk2(p[2 * ks + 1][2], p[2 * ks + 1][3]);
    bf16x8 pb = __builtin_bit_cast(bf16x8, pu);
#pragma unroll
    for (int dt = 0; dt < 4; ++dt) {
      const u16* vrow = sVt + (16 * dt + r) * 72;
      s16x4 lo = *(const s16x4*)(vrow + ((32 * ks + 4 * quad) ^ (16 * dt)));
      s16x4 hi = *(const s16x4*)(vrow + ((32 * ks + 16 + 4 * quad) ^ (16 * dt)));
      bf16x8 vf = __builtin_shufflevector(lo, hi, 0, 1, 2, 3, 4, 5, 6, 7);
      ot[dt] = __builtin_amdgcn_mfma_f32_16x16x32_bf16(vf, pb, ot[dt], 0, 0, 0);
    }
  }
}
DI void load_tile(u16* dst, const u16* src, long ld) {
  const int tid = TID();
#pragma unroll
  for (int i = 0; i < 2; ++i) {
    int c = tid + 256 * i, row = c >> 3, ch = c & 7;
    uint4 v = *(const uint4*)(src + (long)row * ld + ch * 8);
    *(uint4*)(dst + row * 72 + ch * 8) = v;
  }
}
DI void load_tile_T(u16* dst, const u16* src, long ld) {
  const int tid = TID();
#pragma unroll
  for (int i = 0; i < 2; ++i) {
    int c = tid + 256 * i, row = c >> 3, ch = c & 7;
    uint4 v = *(const uint4*)(src + (long)row * ld + ch * 8);
    const unsigned* vv = (const unsigned*)&v;
#pragma unroll
    for (int q = 0; q < 4; ++q) {
      dst[(ch * 8 + 2 * q) * 72 + row] = (u16)(vv[q] & 0xffff);
      dst[(ch * 8 + 2 * q + 1) * 72 + row] = (u16)(vv[q] >> 16);
    }
  }
}
DI void load_q_nsa(u16* dst, const u16* src, long ld) {
  const int tid = TID();
#pragma unroll
  for (int i = 0; i < 2; ++i) {
    int c = tid + 256 * i, row = c >> 3, ch = c & 7;
    uint4 v = *(const uint4*)(src + (long)(row & 15) * ld + (row >> 4) * 64 + ch * 8);
    *(uint4*)(dst + row * 72 + ch * 8) = v;
  }
}
DI void load_qfrag(bf16x8 (&bq)[2], const u16* sQ, int w, int lane) {
  const int r = lane & 15, quad = lane >> 4;
  bq[0] = *(const bf16x8*)(sQ + (16 * w + r) * 72 + quad * 8);
  bq[1] = *(const bf16x8*)(sQ + (16 * w + r) * 72 + 32 + quad * 8);
}
DI float quad_max(float v) { v = fmaxf(v, __shfl_xor(v, 16)); v = fmaxf(v, __shfl_xor(v, 32)); return v; }
DI float quad_sum(float v) { v += __shfl_xor(v, 16); v += __shfl_xor(v, 32); return v; }

DI void softmax_tile(f32x4 (&st)[4], const bool (&msk)[4][4], float& m, float& l, f32x4 (&ot)[4]) {
  float tm = -1e30f;
#pragma unroll
  for (int mt = 0; mt < 4; ++mt)
#pragma unroll
    for (int j = 0; j < 4; ++j) { float s = st[mt][j] * 0.125f; st[mt][j] = s; if (msk[mt][j]) tm = fmaxf(tm, s); }
  tm = quad_max(tm);
  float mn = fmaxf(m, tm);
  float alpha = __expf(m - mn);
  float ps = 0.f;
#pragma unroll
  for (int mt = 0; mt < 4; ++mt)
#pragma unroll
    for (int j = 0; j < 4; ++j) { float p = msk[mt][j] ? __expf(st[mt][j] - mn) : 0.f; st[mt][j] = p; ps += p; }
  l = l * alpha + ps;
  m = mn;
#pragma unroll
  for (int dt = 0; dt < 4; ++dt)
#pragma unroll
    for (int j = 0; j < 4; ++j) ot[dt][j] *= alpha;
}

DI void phase_rmsnorm(const float* __restrict__ x, const float* __restrict__ wgt, u16* __restrict__ H) {
  const int lane = TID() & 63, w = TID() >> 6;
  const int gw = blockIdx.x * 4 + w, nw = gridDim.x * 4;
  for (int row = gw; row < T_; row += nw) {
    const float4* xr = (const float4*)(x + (long)row * DM);
    float4 v[4]; float s = 0.f;
#pragma unroll
    for (int j = 0; j < 4; ++j) { v[j] = xr[lane + 64 * j]; s += v[j].x * v[j].x + v[j].y * v[j].y + v[j].z * v[j].z + v[j].w * v[j].w; }
    s = wave_sum(s);
    float r = rsqrtf(s * (1.f / DM) + EPS);
#pragma unroll
    for (int j = 0; j < 4; ++j) {
      float4 g = ((const float4*)wgt)[lane + 64 * j];
      uint2 o; o.x = pk2(v[j].x * r * g.x, v[j].y * r * g.y); o.y = pk2(v[j].z * r * g.z, v[j].w * r * g.w);
      *(uint2*)(H + (long)row * DM + (lane + 64 * j) * 4) = o;
    }
  }
}
DI void phase_rope_table(const int* __restrict__ positions, float* __restrict__ COS, float* __restrict__ SIN) {
  const float invf[8] = {1.0f, 0.1939227432012558f, 0.03760603070259094f, 0.007292664609849453f,
                         0.0014142135623842478f, 0.00027424818836152554f, 5.3182957344688475e-05f, 1.0313385246263351e-05f};
  for (int idx = blockIdx.x * 256 + TID(); idx < T_ * 8; idx += gridDim.x * 256) {
    int i = idx & 7;
    float f = invf[0];
#pragma unroll
    for (int q = 1; q < 8; ++q) f = (i == q) ? invf[q] : f;
    float ang = (float)positions[idx >> 3] * f;
    double s, c; sincos_d((double)ang, s, c);
    COS[idx] = (float)c; SIN[idx] = (float)s;
  }
}

struct S5Coef { float ar, ai; float bbr[16], bbi[16]; };
DI void s5_coef(const Params& P, int l, int g, int p, S5Coef& C) {
  float dt = expf(P.in[13][l * 16 + g]);
  float lr = P.in[11][(l * 16 + g) * 64 + p], li = P.in[12][(l * 16 + g) * 64 + p];
  float mag = expf(lr * dt);
  double s, c; sincos_d((double)(li * dt), s, c);
  C.ar = mag * (float)c; C.ai = mag * (float)s;
  float den = lr * lr + li * li;
  float fr = ((C.ar - 1.f) * lr + C.ai * li) / den;
  float fi = (C.ai * lr - (C.ar - 1.f) * li) / den;
  const float* br = P.in[14] + ((long)(l * 16 + g) * 64 + p) * 16;
  const float* bi = P.in[15] + ((long)(l * 16 + g) * 64 + p) * 16;
#pragma unroll
  for (int c2 = 0; c2 < 16; ++c2) {
    float b_r = br[c2], b_i = bi[c2];
    C.bbr[c2] = fr * b_r - fi * b_i;
    C.bbi[c2] = fr * b_i + fi * b_r;
  }
}
DI void s5_load_u(float* su, const u16* PROJ, int b, int chunk, int g, int lane) {
  const u16* src = PROJ + ((long)(b * SEQ + chunk * 64 + lane)) * PW + P_S5U + g * 16;
  uint4 v0 = ((const uint4*)src)[0], v1 = ((const uint4*)src)[1];
  const unsigned* a = (const unsigned*)&v0; const unsigned* c = (const unsigned*)&v1;
  float* d = su + lane * 16;
#pragma unroll
  for (int q = 0; q < 4; ++q) { d[2 * q] = bf2f((u16)(a[q] & 0xffff)); d[2 * q + 1] = bf2f((u16)(a[q] >> 16)); }
#pragma unroll
  for (int q = 0; q < 4; ++q) { d[8 + 2 * q] = bf2f((u16)(c[q] & 0xffff)); d[8 + 2 * q + 1] = bf2f((u16)(c[q] >> 16)); }
}

DI void s5_pass1_item(const Params& P, int l, int it, float* lds) {
  const int lane = TID() & 63, w = TID() >> 6;
  const int gq = it & 3, chunk = (it >> 2) & 63, b = it >> 8;
  const int g = gq * 4 + w;
  const u16* PROJ = (const u16*)(WSP(P) + WS_PROJ);
  float* su = lds + w * 1024;
  S5Coef C; s5_coef(P, l, g, lane, C);
  s5_load_u(su, PROJ, b, chunk, g, lane);
  __syncthreads();
  float xr = 0.f, xi = 0.f;
#pragma unroll 4
  for (int t = 0; t < 64; ++t) {
    const f32x4* up = (const f32x4*)(su + t * 16);
    float br = 0.f, bi = 0.f;
#pragma unroll
    for (int q = 0; q < 4; ++q) {
      f32x4 u = up[q];
#pragma unroll
      for (int e = 0; e < 4; ++e) { br += u[e] * C.bbr[4 * q + e]; bi += u[e] * C.bbi[4 * q + e]; }
    }
    float nr = C.ar * xr - C.ai * xi + br;
    float ni = C.ar * xi + C.ai * xr + bi;
    xr = nr; xi = ni;
  }
  float2* ENDS = (float2*)(WSP(P) + WS_ENDS);
  ENDS[((long)(b * 64 + chunk) * 16 + g) * 64 + lane] = make_float2(xr, xi);
}

DI void s5_carry_item(const Params& P, int l, int it) {
  const int idx = it * 256 + TID();
  const int b = idx >> 10, gp = idx & 1023, g = gp >> 6, p = gp & 63;
  float dt = expf(P.in[13][l * 16 + g]);
  float lr = P.in[11][(l * 16 + g) * 64 + p], li = P.in[12][(l * 16 + g) * 64 + p];
  float mag = expf(lr * dt * 64.f);
  double s, c; sincos_d((double)(li * dt) * 64.0, s, c);
  float ar = mag * (float)c, ai = mag * (float)s;
  const float2* ENDS = (const float2*)(WSP(P) + WS_ENDS);
  float2* CARRY = (float2*)(WSP(P) + WS_CARRY);
  float xr = 0.f, xi = 0.f;
  for (int ch = 0; ch < 64; ++ch) {
    long o = ((long)(b * 64 + ch) * 16 + g) * 64 + p;
    CARRY[o] = make_float2(xr, xi);
    float2 e = ENDS[o];
    float nr = ar * xr - ai * xi + e.x;
    float ni = ar * xi + ai * xr + e.y;
    xr = nr; xi = ni;
  }
}

DI void s5_pass2_item(const Params& P, int l, int it, float* lds) {
  const int lane = TID() & 63, w = TID() >> 6, r16 = lane & 15, quad = lane >> 4;
  const int gq = it & 3, chunk = (it >> 2) & 63, b = it >> 8;
  const int g = gq * 4 + w;
  const u16* PROJ = (const u16*)(WSP(P) + WS_PROJ);
  u16* Y5 = (u16*)(WSP(P) + WS_Y5);
  float* su = lds + w * 1024;
  u16* sX = (u16*)(lds + 4096) + w * (32 * 136);
  S5Coef C; s5_coef(P, l, g, lane, C);
  bf16x8 bfr[4];
#pragma unroll
  for (int ks = 0; ks < 4; ++ks) {
    const float* src = P.in[(ks < 2) ? 16 : 17] + ((long)(l * 16 + g) * 16 + r16) * 64 + (ks & 1) * 32 + quad * 8;
    const float4 v0 = ((const float4*)src)[0], v1 = ((const float4*)src)[1];
    const float sg = (ks < 2) ? 1.f : -1.f;
    uint4 pu; pu.x = pk2(sg * v0.x, sg * v0.y); pu.y = pk2(sg * v0.z, sg * v0.w); pu.z = pk2(sg * v1.x, sg * v1.y); pu.w = pk2(sg * v1.z, sg * v1.w);
    bfr[ks] = __builtin_bit_cast(bf16x8, pu);
  }
  const float dsk = P.in[18][l * 256 + g * 16 + r16];
  s5_load_u(su, PROJ, b, chunk, g, lane);
  __syncthreads();
  const float2 c0 = ((const float2*)(WSP(P) + WS_CARRY))[((long)(b * 64 + chunk) * 16 + g) * 64 + lane];
  float xr = c0.x, xi = c0.y;
  for (int half = 0; half < 2; ++half) {
#pragma unroll 4
    for (int tt = 0; tt < 32; ++tt) {
      const int t = half * 32 + tt;
      const f32x4* up = (const f32x4*)(su + t * 16);
      float br0 = 0.f, bi0 = 0.f, br1 = 0.f, bi1 = 0.f;
#pragma unroll
      for (int q = 0; q < 4; ++q) {
        f32x4 u = up[q];
        br0 += u[0] * C.bbr[4 * q + 0]; bi0 += u[0] * C.bbi[4 * q + 0];
        br1 += u[1] * C.bbr[4 * q + 1]; bi1 += u[1] * C.bbi[4 * q + 1];
        br0 += u[2] * C.bbr[4 * q + 2]; bi0 += u[2] * C.bbi[4 * q + 2];
        br1 += u[3] * C.bbr[4 * q + 3]; bi1 += u[3] * C.bbi[4 * q + 3];
      }
      const float nr = C.ar * xr - C.ai * xi + (br0 + br1);
      const float ni = C.ar * xi + C.ai * xr + (bi0 + bi1);
      xr = nr; xi = ni;
      sX[tt * 136 + lane] = f2bf(xr);
      sX[tt * 136 + 64 + lane] = f2bf(xi);
    }
    __syncthreads();
#pragma unroll
    for (int mt = 0; mt < 2; ++mt) {
      f32x4 acc = {0.f, 0.f, 0.f, 0.f};
#pragma unroll
      for (int ks = 0; ks < 4; ++ks) {
        const bf16x8 af = *(const bf16x8*)(sX + (16 * mt + r16) * 136 + ks * 32 + quad * 8);
        acc = __builtin_amdgcn_mfma_f32_16x16x32_bf16(af, bfr[ks], acc, 0, 0, 0);
      }
#pragma unroll
      for (int j = 0; j < 4; ++j) {
        const int t = half * 32 + 16 * mt + 4 * quad + j;
        const float y = acc[j] + dsk * su[t * 16 + r16];
        Y5[((long)(b * SEQ + chunk * 64 + t)) * 256 + g * 16 + r16] = f2bf(gelu_tanh(y));
      }
    }
    __syncthreads();
  }
}

DI void nsa_prep_item(const Params& P, int l, int it) {
  const int lane = TID() & 63, w = TID() >> 6;
  u16* PROJ = (u16*)(WSP(P) + WS_PROJ);
  u16* QR = (u16*)(WSP(P) + WS_QR);
  const float* COS = (const float*)(WSP(P) + WS_COS);
  const float* SIN = (const float*)(WSP(P) + WS_SIN);
  for (int tt = 0; tt < 4; ++tt) {
    const long t = (long)it * 16 + w * 4 + tt;
    const float cs = COS[t * 8 + (lane & 7)], sn = SIN[t * 8 + (lane & 7)];
#pragma unroll
    for (int g = 0; g < 6; ++g) {
      const int col = (g < 4) ? (P_Q + g * 64) : (g == 4 ? P_KV + 128 : P_KV + 256);
      const float wg = (g < 4) ? P.in[4][l * 64 + lane] : P.in[5][(l * 3 + (g - 3)) * 64 + lane];
      u16* ptr = PROJ + t * PW + col + lane;
      float v = bf2f(*ptr);
      float ss = wave_sum(v * v);
      float y = v * rsqrtf(ss * (1.f / 64.f) + EPS) * wg;
      float pr = __shfl_xor(y, 8);
      float rot = (lane < 8) ? (y * cs - pr * sn) : ((lane < 16) ? (y * cs + pr * sn) : y);
      if (g < 4) { *ptr = f2bf(y); QR[t * 256 + g * 64 + lane] = f2bf(rot); }
      else *ptr = f2bf(rot);
    }
  }
}

DI void cmp1_tile(const Params& P, int l, int ct, u16* sA, u16* sB) {
  const int tid = TID(), lane = tid & 63, w = tid >> 6, r16 = lane & 15, quad = lane >> 4, wm = w >> 1, wn = w & 1;
  const int kv = ct >> 5, mt = (ct >> 1) & 15, nt = ct & 1;
  const u16* PROJ = (const u16*)(WSP(P) + WS_PROJ);
  u16* HID = (u16*)(WSP(P) + WS_HID);
  const u16* apq[4];
#pragma unroll
  for (int q = 0; q < 4; ++q) {
    int row, pc; g3_rowpiece(tid, q, false, row, pc);
    int gr = mt * 128 + row; if (gr > 2039) gr = 2039;
    const int b = gr / 255, n = gr % 255;
    apq[q] = PROJ + ((long)(b * SEQ + 16 * n)) * PW + P_KV + kv * 64 + pc * 8;
  }
  const u16* Bb = (const u16*)(WSP(P) + WS_W + WT_C1) + ((long)(kv * 256 + nt * 128)) * 2048;
  f32x4 acc[4][4];
  gemm3<4>(acc, apq[0], apq[1], apq[2], apq[3], PW,
           g3_ptr(Bb, 2048, tid, 0, false), g3_ptr(Bb, 2048, tid, 1, false), g3_ptr(Bb, 2048, tid, 2, false), g3_ptr(Bb, 2048, tid, 3, false), 2048, sA);
  {
    const float* PART = (const float*)(WSP(P) + WS_CBIAS) + (long)kv * 32 * 256;
#pragma unroll
    for (int ni = 0; ni < 4; ++ni) {
      const int col = nt * 128 + wn * 64 + 16 * ni + r16;
      float bsum = 0.f;
      for (int sl = 0; sl < 32; ++sl) bsum += PART[sl * 256 + col];
#pragma unroll
      for (int mi = 0; mi < 4; ++mi)
#pragma unroll
        for (int j = 0; j < 4; ++j) acc[mi][ni][j] += bsum;
    }
  }
  __syncthreads();
#pragma unroll
  for (int mi = 0; mi < 4; ++mi)
#pragma unroll
    for (int ni = 0; ni < 4; ++ni)
#pragma unroll
      for (int j = 0; j < 4; ++j) sA[(wm * 64 + 16 * mi + 4 * quad + j) * 136 + wn * 64 + 16 * ni + r16] = f2bf(gelu_tanh(acc[mi][ni][j]));
  __syncthreads();
  store_tile_bf16<128>(sA, HID + ((long)kv * 2048 + mt * 128) * 256 + nt * 128, 256, 2040 - mt * 128);
}
DI void cmp2_tile(const Params& P, int l, int ct, u16* sA, u16* sB, float* sSS) {
  const int tid = TID(), lane = tid & 63, w = tid >> 6, r16 = lane & 15, quad = lane >> 4, wm = w >> 1, wn = w & 1;
  const int kv = ct >> 4, mt = ct & 15;
  const u16* HID = (const u16*)(WSP(P) + WS_HID);
  u16* OUT = (u16*)(WSP(P) + (kv ? WS_VC : WS_KC));
  const u16* Ab = HID + ((long)kv * 2048 + mt * 128) * 256;
  const u16* Bb = (const u16*)(WSP(P) + WS_W + WT_C2) + (long)kv * 64 * 256;
  f32x4 acc[4][2];
  gemm3<2>(acc, g3_ptr(Ab, 256, tid, 0, false), g3_ptr(Ab, 256, tid, 1, false), g3_ptr(Ab, 256, tid, 2, false), g3_ptr(Ab, 256, tid, 3, false), 64,
           g3_ptr(Bb, 256, tid, 0, true), g3_ptr(Bb, 256, tid, 1, true), nullptr, nullptr, 256, sA);
  __syncthreads();
  if (tid < 128) sSS[tid] = 0.f;
  __syncthreads();
#pragma unroll
  for (int mi = 0; mi < 4; ++mi)
#pragma unroll
    for (int j = 0; j < 4; ++j) {
      float ss = acc[mi][0][j] * acc[mi][0][j] + acc[mi][1][j] * acc[mi][1][j];
      ss += __shfl_xor(ss, 1); ss += __shfl_xor(ss, 2); ss += __shfl_xor(ss, 4); ss += __shfl_xor(ss, 8);
      if (r16 == 0) atomicAdd(&sSS[wm * 64 + 16 * mi + 4 * quad + j], ss);
    }
  __syncthreads();
#pragma unroll
  for (int mi = 0; mi < 4; ++mi)
#pragma unroll
    for (int j = 0; j < 4; ++j) {
      const int rl = wm * 64 + 16 * mi + 4 * quad + j, row = mt * 128 + rl;
      const float sc = (kv == 0) ? rsqrtf(sSS[rl] * (1.f / 64.f) + EPS) : 1.f;
      if (row < 2040) {
        int b = row / 255, n = row % 255;
#pragma unroll
        for (int ni = 0; ni < 2; ++ni) {
          int col = wn * 32 + 16 * ni + r16;
          float v = acc[mi][ni][j] * sc;
          if (kv == 0) v *= P.in[5][(l * 3 + 0) * 64 + col];
          OUT[((long)(b * 256 + n)) * 64 + col] = f2bf(v);
        }
      }
    }
}

DI void gdn_p1_item(const Params& P, int l, int it, float* lds) {
  const int tid = TID(), lane = tid & 63, w = tid >> 6, r16 = lane & 15, quad = lane >> 4;
  const int chunk = it & 63, h = (it >> 6) & 3, b = it >> 8;
  const long ci = it;
  const u16* PROJ = (const u16*)(WSP(P) + WS_PROJ);
  float* sq = lds;
  float* sk = lds + 64 * 65;
  float* sv = lds + 2 * 64 * 65;
  float* sG = lds + 3 * 64 * 65;
  float* sBeta = sG + 64;
  float* sg = sBeta + 64;
  u16* sQb = (u16*)(sg + 64);
  u16* sKb = sQb + 64 * 72;
  const float* cw = P.in[20] + (long)l * 4 * 768;
  if (tid < 192) {
    const int cp = tid % 96, th = tid / 96;
    const int c0 = 2 * cp, which = c0 >> 6, d = c0 & 63, C = which * 256 + h * 64 + d;
    float w0[4], w1[4];
#pragma unroll
    for (int k = 0; k < 4; ++k) { w0[k] = cw[k * 768 + C]; w1[k] = cw[k * 768 + C + 1]; }
    unsigned v[35];
    const int s0 = chunk * 64 + th * 32 - 3;
    const u16* src = PROJ + ((long)(b * SEQ + s0)) * PW + P_GQKV + C;
#pragma unroll
    for (int k = 0; k < 35; ++k) v[k] = (s0 + k >= 0) ? *(const unsigned*)(src + (long)k * PW) : 0u;
    float* dst = lds + which * 64 * 65 + (th * 32) * 65 + d;
#pragma unroll
    for (int tt = 0; tt < 32; ++tt) {
      float a0 = 0.f, a1 = 0.f;
#pragma unroll
      for (int k = 0; k < 4; ++k) { a0 += w0[k] * bf2f((u16)(v[tt + k] & 0xffff)); a1 += w1[k] * bf2f((u16)(v[tt + k] >> 16)); }
      dst[tt * 65] = siluf_(a0); dst[tt * 65 + 1] = siluf_(a1);
    }
  }
  __syncthreads();
  if (tid < 128) {
    float* base = (tid < 64) ? sq : sk;
    u16* bb = (tid < 64) ? sQb : sKb;
    const int row = tid & 63;
    float ss = 0.f;
#pragma unroll 8
    for (int d = 0; d < 64; ++d) { float x = base[row * 65 + d]; ss += x * x; }
    const float sc = rsqrtf(ss + EPS) * ((tid < 64) ? 0.125f : 1.f);
#pragma unroll 8
    for (int d = 0; d < 64; d += 2) {
      const float x0 = base[row * 65 + d] * sc, x1 = base[row * 65 + d + 1] * sc;
      base[row * 65 + d] = x0; base[row * 65 + d + 1] = x1;
      *(unsigned*)(bb + row * 72 + d) = pk2(x0, x1);
    }
  } else if (tid < 192) {
    const int row = tid - 128;
    const long t = (long)(b * SEQ + chunk * 64 + row);
    const float bl = bf2f(PROJ[t * PW + P_GB + h]);
    const float al = bf2f(PROJ[t * PW + P_GA + h]);
    sBeta[row] = sigmoidf_(bl);
    sg[row] = -expf(P.in[21][l * 4 + h]) * softplusf_(al + P.in[22][l * 4 + h]);
  }
  __syncthreads();
  if (tid < 64) {
    float x = sg[tid];
#pragma unroll
    for (int o = 1; o < 64; o <<= 1) { float u = __shfl_up(x, o); if (tid >= o) x += u; }
    sG[tid] = x;
    ((float*)(WSP(P) + WS_GG))[ci * 64 + tid] = x;
  }
  __syncthreads();
  f32x4 lreg[4];
  {
    const f32x4 Gi4 = *(const f32x4*)(sG + 16 * w + 4 * quad);
    const f32x4 Bi4 = *(const f32x4*)(sBeta + 16 * w + 4 * quad);
    u16* GA = (u16*)(WSP(P) + WS_GA) + ci * 4096;
#pragma unroll
    for (int nt = 0; nt < 4; ++nt) {
      f32x4 aq = {0.f, 0.f, 0.f, 0.f}, ak = {0.f, 0.f, 0.f, 0.f};
#pragma unroll
      for (int ks = 0; ks < 2; ++ks) {
        const bf16x8 fq = *(const bf16x8*)(sQb + (16 * w + r16) * 72 + ks * 32 + quad * 8);
        const bf16x8 fk = *(const bf16x8*)(sKb + (16 * w + r16) * 72 + ks * 32 + quad * 8);
        const bf16x8 fb = *(const bf16x8*)(sKb + (16 * nt + r16) * 72 + ks * 32 + quad * 8);
        aq = __builtin_amdgcn_mfma_f32_16x16x32_bf16(fq, fb, aq, 0, 0, 0);
        ak = __builtin_amdgcn_mfma_f32_16x16x32_bf16(fk, fb, ak, 0, 0, 0);
      }
      const int j = 16 * nt + r16;
      const float Gj = sG[j];
#pragma unroll
      for (int jj = 0; jj < 4; ++jj) {
        const int i = 16 * w + 4 * quad + jj;
        const float dec = __expf(Gi4[jj] - Gj);
        GA[i * 64 + j] = f2bf((j <= i) ? aq[jj] * dec : 0.f);
        const float lv = (j < i) ? Bi4[jj] * ak[jj] * dec : 0.f;
        sq[i * 65 + j] = lv;
        lreg[nt][jj] = lv;
      }
    }
  }
  {
    u16* GQ = (u16*)(WSP(P) + WS_GQ) + ci * 4096;
#pragma unroll
    for (int q = 0; q < 2; ++q) { const int c = tid + 256 * q, row = c >> 3, ch = c & 7; *(uint4*)(GQ + row * 64 + ch * 8) = *(const uint4*)(sQb + row * 72 + ch * 8); }
    const int i = tid >> 2, j0 = (tid & 3) * 16;
    u16* GK = (u16*)(WSP(P) + WS_GK) + ci * 4096 + i * 64 + j0;
    unsigned ok[8];
#pragma unroll
    for (int q = 0; q < 8; ++q) ok[q] = pk2(sk[(j0 + 2 * q) * 65 + i], sk[(j0 + 2 * q + 1) * 65 + i]);
    ((uint4*)GK)[0] = make_uint4(ok[0], ok[1], ok[2], ok[3]); ((uint4*)GK)[1] = make_uint4(ok[4], ok[5], ok[6], ok[7]);
  }
  __syncthreads();
  u16* sLb = sQb;
  u16* sXT = sKb;
  {
    const int i = tid >> 2, j0 = (tid & 3) * 16;
    const float bi = sBeta[i], eg = __expf(sG[i]);
#pragma unroll
    for (int jj = 0; jj < 16; ++jj) { sv[i * 65 + j0 + jj] *= bi; sk[i * 65 + j0 + jj] *= bi * eg; }
#pragma unroll
    for (int nt = 0; nt < 4; ++nt)
#pragma unroll
      for (int jj = 0; jj < 4; ++jj) sLb[(16 * w + 4 * quad + jj) * 72 + 16 * nt + r16] = f2bf(lreg[nt][jj]);
  }
  __syncthreads();
#pragma unroll 1
  for (int bi = 0; bi < 4; ++bi) {
    if (tid < 128) {
      float* buf = (tid < 64) ? sv : sk;
      const int col = tid & 63;
      float x[16];
#pragma unroll
      for (int r = 0; r < 16; ++r) {
        float a0 = buf[(16 * bi + r) * 65 + col], a1 = 0.f;
#pragma unroll
        for (int j = 0; j + 1 < r; j += 2) { a0 -= sq[(16 * bi + r) * 65 + 16 * bi + j] * x[j]; a1 -= sq[(16 * bi + r) * 65 + 16 * bi + j + 1] * x[j + 1]; }
        if (r & 1) a0 -= sq[(16 * bi + r) * 65 + 16 * bi + r - 1] * x[r - 1];
        x[r] = a0 + a1;
        buf[(16 * bi + r) * 65 + col] = x[r];
      }
      uint4 p0, p1;
      p0.x = pk2(x[0], x[1]); p0.y = pk2(x[2], x[3]); p0.z = pk2(x[4], x[5]); p0.w = pk2(x[6], x[7]);
      p1.x = pk2(x[8], x[9]); p1.y = pk2(x[10], x[11]); p1.z = pk2(x[12], x[13]); p1.w = pk2(x[14], x[15]);
      *(uint4*)(sXT + tid * 24) = p0; *(uint4*)(sXT + tid * 24 + 8) = p1;
    }
    __syncthreads();
    if (bi < 3) {
#pragma unroll
      for (int q = 0; q < 2; ++q) {
        const int nt = 2 * w + q, colg = 16 * nt + r16;
        bf16x8 bx = *(const bf16x8*)(sXT + colg * 24 + (quad & 1) * 8);
        if (quad >= 2) bx = (bf16x8){0, 0, 0, 0, 0, 0, 0, 0};
        float* buf = (colg < 64) ? sv : sk;
        const int cc = colg & 63;
        for (int bk = bi + 1; bk < 4; ++bk) {
          const bf16x8 al = *(const bf16x8*)(sLb + (16 * bk + r16) * 72 + 16 * bi + quad * 8);
          f32x4 c = {0.f, 0.f, 0.f, 0.f};
          c = __builtin_amdgcn_mfma_f32_16x16x32_bf16(al, bx, c, 0, 0, 0);
#pragma unroll
          for (int jj = 0; jj < 4; ++jj) buf[(16 * bk + 4 * quad + jj) * 65 + cc] -= c[jj];
        }
      }
    }
    __syncthreads();
  }
  {
    const int i = tid >> 2, j0 = (tid & 3) * 16;
    u16* GU = (u16*)(WSP(P) + WS_GU) + ci * 4096 + i * 64 + j0;
    u16* GW = (u16*)(WSP(P) + WS_GW) + ci * 4096 + i * 64 + j0;
    unsigned ou[8], ow[8];
#pragma unroll
    for (int q = 0; q < 8; ++q) {
      ou[q] = pk2(sv[i * 65 + j0 + 2 * q], sv[i * 65 + j0 + 2 * q + 1]);
      ow[q] = pk2(sk[i * 65 + j0 + 2 * q], sk[i * 65 + j0 + 2 * q + 1]);
    }
    ((uint4*)GU)[0] = make_uint4(ou[0], ou[1], ou[2], ou[3]); ((uint4*)GU)[1] = make_uint4(ou[4], ou[5], ou[6], ou[7]);
    ((uint4*)GW)[0] = make_uint4(ow[0], ow[1], ow[2], ow[3]); ((uint4*)GW)[1] = make_uint4(ow[4], ow[5], ow[6], ow[7]);
  }
}

DI void unpack8(const u16* p, float (&o)[8]) {
  uint4 v = *(const uint4*)p;
  o[0] = bf2f((u16)(v.x & 0xffff)); o[1] = bf2f((u16)(v.x >> 16));
  o[2] = bf2f((u16)(v.y & 0xffff)); o[3] = bf2f((u16)(v.y >> 16));
  o[4] = bf2f((u16)(v.z & 0xffff)); o[5] = bf2f((u16)(v.z >> 16));
  o[6] = bf2f((u16)(v.w & 0xffff)); o[7] = bf2f((u16)(v.w >> 16));
}
DI void st_kt(u16* sKt, int c8, int row, uint4 k) {
  sKt[(c8 + 0) * 72 + row] = (u16)(k.x & 0xffff); sKt[(c8 + 1) * 72 + row] = (u16)(k.x >> 16);
  sKt[(c8 + 2) * 72 + row] = (u16)(k.y & 0xffff); sKt[(c8 + 3) * 72 + row] = (u16)(k.y >> 16);
  sKt[(c8 + 4) * 72 + row] = (u16)(k.z & 0xffff); sKt[(c8 + 5) * 72 + row] = (u16)(k.z >> 16);
  sKt[(c8 + 6) * 72 + row] = (u16)(k.w & 0xffff); sKt[(c8 + 7) * 72 + row] = (u16)(k.w >> 16);
}
DI uint2 pack4bf(const f32x4& v) { uint2 r; r.x = pk2(v[0], v[1]); r.y = pk2(v[2], v[3]); return r; }
DI void gdn_p2_item(const Params& P, int it, float* lds) {
  const int tid = TID(), lane = tid & 63, w = tid >> 6, r16 = lane & 15, quad = lane >> 4;
  const int es = it & 3, bh = it >> 2, b = bh >> 2, h = bh & 3;
  u16* sW = (u16*)lds;
  u16* sQ = sW + 64 * 72;
  u16* sAm = sQ + 64 * 72;
  u16* sKt = sAm + 64 * 72;
  u16* sSt = sKt + 64 * 72;
  u16* sVnT = sSt + 16 * 72;
  u16* sVdT = sVnT + 16 * 72;
  float* sG = (float*)(sVdT + 16 * 72);
  const u16* GQ = (const u16*)(WSP(P) + WS_GQ); const u16* GK = (const u16*)(WSP(P) + WS_GK);
  const u16* GU = (const u16*)(WSP(P) + WS_GU); const u16* GW = (const u16*)(WSP(P) + WS_GW);
  const u16* GA = (const u16*)(WSP(P) + WS_GA); const float* GG = (const float*)(WSP(P) + WS_GG);
  u16* ORAW = (u16*)(WSP(P) + WS_OM) + (long)2 * T_ * 256;
  f32x4 S = {0.f, 0.f, 0.f, 0.f};
  const int irow = 16 * w + 4 * quad;
  uint4 rw0, rw1, rq0, rq1, ra0, ra1, rk0, rk1; u16 ru0, ru1, ru2, ru3; float rg = 0.f;
  const int c0 = tid, c1 = tid + 256;
  const long off0 = (c0 >> 3) * 64 + (c0 & 7) * 8, off1 = (c1 >> 3) * 64 + (c1 & 7) * 8;
#define GDN_GLOAD(CH) { long ci_ = (long)bh * 64 + (CH); \
    rw0 = *(const uint4*)(GW + ci_ * 4096 + off0); rw1 = *(const uint4*)(GW + ci_ * 4096 + off1); \
    rq0 = *(const uint4*)(GQ + ci_ * 4096 + off0); rq1 = *(const uint4*)(GQ + ci_ * 4096 + off1); \
    ra0 = *(const uint4*)(GA + ci_ * 4096 + off0); ra1 = *(const uint4*)(GA + ci_ * 4096 + off1); \
    rk0 = *(const uint4*)(GK + ci_ * 4096 + off0); rk1 = *(const uint4*)(GK + ci_ * 4096 + off1); \
    const u16* up_ = GU + ci_ * 4096 + irow * 64 + es * 16 + r16; \
    ru0 = up_[0]; ru1 = up_[64]; ru2 = up_[128]; ru3 = up_[192]; \
    if (tid < 64) rg = GG[ci_ * 64 + tid]; }
  GDN_GLOAD(0)
  for (int ch = 0; ch < 64; ++ch) {
    __syncthreads();
    {
      const int row0 = c0 >> 3, c80 = (c0 & 7) * 8, row1 = c1 >> 3, c81 = (c1 & 7) * 8;
      *(uint4*)(sW + row0 * 72 + c80) = rw0; *(uint4*)(sW + row1 * 72 + c81) = rw1;
      *(uint4*)(sQ + row0 * 72 + c80) = rq0; *(uint4*)(sQ + row1 * 72 + c81) = rq1;
      *(uint4*)(sAm + row0 * 72 + c80) = ra0; *(uint4*)(sAm + row1 * 72 + c81) = ra1;
      *(uint4*)(sKt + row0 * 72 + c80) = rk0; *(uint4*)(sKt + row1 * 72 + c81) = rk1;
    }
    if (tid < 64) sG[tid] = rg;
    *(uint2*)(sSt + r16 * 72 + irow) = pack4bf(S);
    const f32x4 uc = {bf2f(ru0), bf2f(ru1), bf2f(ru2), bf2f(ru3)};
    __syncthreads();
    if (ch + 1 < 64) GDN_GLOAD(ch + 1)
    f32x4 ws = {0.f, 0.f, 0.f, 0.f}, qs = {0.f, 0.f, 0.f, 0.f};
#pragma unroll
    for (int ks = 0; ks < 2; ++ks) {
      const bf16x8 bS = *(const bf16x8*)(sSt + r16 * 72 + ks * 32 + quad * 8);
      const bf16x8 aW = *(const bf16x8*)(sW + (16 * w + r16) * 72 + ks * 32 + quad * 8);
      const bf16x8 aQ = *(const bf16x8*)(sQ + (16 * w + r16) * 72 + ks * 32 + quad * 8);
      ws = __builtin_amdgcn_mfma_f32_16x16x32_bf16(aW, bS, ws, 0, 0, 0);
      qs = __builtin_amdgcn_mfma_f32_16x16x32_bf16(aQ, bS, qs, 0, 0, 0);
    }
    const float Gl = sG[63];
    const f32x4 G4 = *(const f32x4*)(sG + irow);
    f32x4 vn, vd;
#pragma unroll
    for (int j = 0; j < 4; ++j) { vn[j] = uc[j] - ws[j]; vd[j] = vn[j] * __expf(Gl - G4[j]); }
    *(uint2*)(sVnT + r16 * 72 + irow) = pack4bf(vn);
    *(uint2*)(sVdT + r16 * 72 + irow) = pack4bf(vd);
    __syncthreads();
    f32x4 av = {0.f, 0.f, 0.f, 0.f}, kv = {0.f, 0.f, 0.f, 0.f};
#pragma unroll
    for (int ks = 0; ks < 2; ++ks) {
      const bf16x8 bVn = *(const bf16x8*)(sVnT + r16 * 72 + ks * 32 + quad * 8);
      const bf16x8 bVd = *(const bf16x8*)(sVdT + r16 * 72 + ks * 32 + quad * 8);
      const bf16x8 aA = *(const bf16x8*)(sAm + (16 * w + r16) * 72 + ks * 32 + quad * 8);
      const bf16x8 aK = *(const bf16x8*)(sKt + (16 * w + r16) * 72 + ks * 32 + quad * 8);
      av = __builtin_amdgcn_mfma_f32_16x16x32_bf16(aA, bVn, av, 0, 0, 0);
      kv = __builtin_amdgcn_mfma_f32_16x16x32_bf16(aK, bVd, kv, 0, 0, 0);
    }
    {
      u16* op = ORAW + ((long)(b * SEQ + ch * 64 + irow)) * 256 + h * 64 + es * 16 + r16;
#pragma unroll
      for (int j = 0; j < 4; ++j) op[j * 256] = f2bf(__expf(G4[j]) * qs[j] + av[j]);
    }
    const float gl = __expf(Gl);
#pragma unroll
    for (int j = 0; j < 4; ++j) S[j] = S[j] * gl + kv[j];
  }
#undef GDN_GLOAD
}
DI void gdn_post_item(const Params& P, int l, int it) {
  const int lane = TID() & 63, w = TID() >> 6;
  const u16* PROJ = (const u16*)(WSP(P) + WS_PROJ);
  u16* O = (u16*)(WSP(P) + WS_OM) + (long)2 * T_ * 256;
  const float wn = P.in[23][l * 64 + lane];
#pragma unroll 4
  for (int q = 0; q < 16; ++q) {
    long t = (long)it * 16 + w * 4 + (q >> 2); int h = q & 3;
    float o = bf2f(O[t * 256 + h * 64 + lane]);
    float ss = wave_sum(o * o);
    float y = o * rsqrtf(ss * (1.f / 64.f) + EPS) * wn;
    float z = bf2f(PROJ[t * PW + P_GZ + h * 64 + lane]);
    O[t * 256 + h * 64 + lane] = f2bf(y * siluf_(z));
  }
}

DI void kv_gload(uint4& k0, uint4& k1, uint4& v0, uint4& v1, const u16* ksrc, const u16* vsrc, long ld) {
  const int tid = TID(), r0 = tid >> 3, ch = tid & 7;
  k0 = *(const uint4*)(ksrc + (long)r0 * ld + ch * 8); k1 = *(const uint4*)(ksrc + (long)(r0 + 32) * ld + ch * 8);
  v0 = *(const uint4*)(vsrc + (long)r0 * ld + ch * 8); v1 = *(const uint4*)(vsrc + (long)(r0 + 32) * ld + ch * 8);
}
DI void k_gload(uint4& k0, uint4& k1, const u16* ksrc, long ld) {
  const int tid = TID(), r0 = tid >> 3, ch = tid & 7;
  k0 = *(const uint4*)(ksrc + (long)r0 * ld + ch * 8); k1 = *(const uint4*)(ksrc + (long)(r0 + 32) * ld + ch * 8);
}
DI void k_store(const uint4& k0, const uint4& k1, u16* sK) {
  const int tid = TID(), r0 = tid >> 3, ch = tid & 7;
  *(uint4*)(sK + r0 * 72 + ch * 8) = k0; *(uint4*)(sK + (r0 + 32) * 72 + ch * 8) = k1;
}
DI void kv_store(const uint4& k0, const uint4& k1, const uint4& v0, const uint4& v1, u16* sK, u16* sVt) {
  const int tid = TID(), r0 = tid >> 3, ch = tid & 7;
  *(uint4*)(sK + r0 * 72 + ch * 8) = k0; *(uint4*)(sK + (r0 + 32) * 72 + ch * 8) = k1;
  const int ksw = 16 * (ch >> 1);
  st_kt(sVt, ch * 8, r0 ^ ksw, v0); st_kt(sVt, ch * 8, (r0 + 32) ^ ksw, v1);
}
DI void sb_attn_item(const Params& P, int it, u16* sQ, u16* sK, u16* sVt) {
  const int tid = TID(), lane = tid & 63, w = tid >> 6, r16 = lane & 15, quad = lane >> 4;
  const int qb = 63 - (it >> 5), bh = it & 31, b = bh >> 2, h = bh & 3;
  const u16* PROJ = (const u16*)(WSP(P) + WS_PROJ);
  u16* OUT = (u16*)(WSP(P) + WS_OM) + (long)3 * T_ * 256;
  const long tb = (long)b * SEQ;
  load_tile(sQ, PROJ + (tb + qb * 64) * PW + P_SB + h * 64, PW);
  __syncthreads();
  bf16x8 bq[2]; load_qfrag(bq, sQ, w, lane);
  const int tq = qb * 64 + 16 * w + r16;
  f32x4 ot[4];
#pragma unroll
  for (int dt = 0; dt < 4; ++dt) ot[dt] = (f32x4){0.f, 0.f, 0.f, 0.f};
  float R = 0.f;
  uint4 pk0, pk1, pv0, pv1;
  kv_gload(pk0, pk1, pv0, pv1, PROJ + (tb + qb * 64) * PW + P_SB + 256 + h * 64, PROJ + (tb + qb * 64) * PW + P_SB + 512 + h * 64, PW);
  for (int kb = qb; kb >= 0; --kb) {
    if (__syncthreads_and(R < -104.f)) break;
    kv_store(pk0, pk1, pv0, pv1, sK, sVt);
    __syncthreads();
    if (kb > 0) kv_gload(pk0, pk1, pv0, pv1, PROJ + (tb + (kb - 1) * 64) * PW + P_SB + 256 + h * 64, PROJ + (tb + (kb - 1) * 64) * PW + P_SB + 512 + h * 64, PW);
    f32x4 st[4];
    st_mma(st, sK, bq, lane);
    float gs[4], zz[4][4], x[4][4];
#pragma unroll
    for (int mt = 0; mt < 4; ++mt) {
      float g = 0.f;
#pragma unroll
      for (int j = 0; j < 4; ++j) {
        int s = kb * 64 + 16 * mt + 4 * quad + j;
        float z = st[mt][j] * 0.125f;
        float sp = softplusf_(z);
        bool mk = s < tq;
        x[mt][j] = mk ? -sp : 0.f;
        zz[mt][j] = mk ? (z - sp) : -1e30f;
        g += x[mt][j];
      }
      gs[mt] = g;
    }
    float hm = 0.f, tot_all = 0.f;
    f32x4 pw[4];
#pragma unroll
    for (int mt = 3; mt >= 0; --mt) {
      float g = gs[mt];
      float v1 = __shfl_down(g, 16), v2 = __shfl_down(g, 32), v3 = __shfl_down(g, 48);
      float hq = (quad < 3 ? v1 : 0.f) + (quad < 2 ? v2 : 0.f) + (quad < 1 ? v3 : 0.f);
      float tot = quad_sum(g);
      float base = R + hm + hq;
      float e3 = 0.f, e2 = x[mt][3], e1 = e2 + x[mt][2], e0 = e1 + x[mt][1];
      pw[mt][0] = __expf(zz[mt][0] + base + e0);
      pw[mt][1] = __expf(zz[mt][1] + base + e1);
      pw[mt][2] = __expf(zz[mt][2] + base + e2);
      pw[mt][3] = __expf(zz[mt][3] + base + e3);
      hm += tot; tot_all += tot;
    }
    R += tot_all;
    pv_mma(ot, sVt, pw, lane);
  }
  const long t = tb + tq;
#pragma unroll
  for (int dt = 0; dt < 4; ++dt) {
    uint2 ov; ov.x = pk2(ot[dt][0], ot[dt][1]); ov.y = pk2(ot[dt][2], ot[dt][3]);
    *(uint2*)(OUT + t * 256 + h * 64 + 16 * dt + 4 * quad) = ov;
  }
}

DI void win_attn_item(const Params& P, int it, u16* sQ, u16* sKunused, u16* sVunused) {
  const int tid = TID(), lane = tid & 63, w = tid >> 6, r16 = lane & 15, quad = lane >> 4;
  const int tbk = 127 - (it >> 3), b = it & 7;
  u16* sK = sQ + 128 * 72;
  u16* sVt = sK + 64 * 72;
  (void)sKunused; (void)sVunused;
  const u16* PROJ = (const u16*)(WSP(P) + WS_PROJ);
  const u16* QR = (const u16*)(WSP(P) + WS_QR);
  u16* OW = (u16*)(WSP(P) + WS_OW);
  const long tb = (long)b * SEQ;
  const int t0 = tbk * 32;
#pragma unroll
  for (int i = 0; i < 4; ++i) {
    const int c = tid + 256 * i, row = c >> 3, ch = c & 7;
    *(uint4*)(sQ + row * 72 + ch * 8) = *(const uint4*)(QR + (tb + t0 + (row & 31)) * 256 + (row >> 5) * 64 + ch * 8);
  }
  __syncthreads();
  bf16x8 bq[2][2];
  int tq[2];
#pragma unroll
  for (int qt = 0; qt < 2; ++qt) {
    const int rowq = 32 * w + 16 * qt + r16;
    bq[qt][0] = *(const bf16x8*)(sQ + rowq * 72 + quad * 8);
    bq[qt][1] = *(const bf16x8*)(sQ + rowq * 72 + 32 + quad * 8);
    tq[qt] = t0 + 16 * qt + r16;
  }
  f32x4 ot[2][4];
#pragma unroll
  for (int qt = 0; qt < 2; ++qt)
#pragma unroll
    for (int dt = 0; dt < 4; ++dt) ot[qt][dt] = (f32x4){0.f, 0.f, 0.f, 0.f};
  float m[2] = {-1e30f, -1e30f}, lsum[2] = {0.f, 0.f};
  const int lo = (t0 - 511) > 0 ? (t0 - 511) : 0;
  const int kb_lo = lo >> 6, kb_hi = (t0 + 31) >> 6;
  uint4 pk0, pk1, pv0, pv1;
  kv_gload(pk0, pk1, pv0, pv1, PROJ + (tb + kb_lo * 64) * PW + P_KV + 256, PROJ + (tb + kb_lo * 64) * PW + P_KV + 320, PW);
  for (int kb = kb_lo; kb <= kb_hi; ++kb) {
    __syncthreads();
    kv_store(pk0, pk1, pv0, pv1, sK, sVt);
    __syncthreads();
    if (kb < kb_hi) kv_gload(pk0, pk1, pv0, pv1, PROJ + (tb + (kb + 1) * 64) * PW + P_KV + 256, PROJ + (tb + (kb + 1) * 64) * PW + P_KV + 320, PW);
#pragma unroll
    for (int qt = 0; qt < 2; ++qt) {
      f32x4 st[4];
      st_mma(st, sK, bq[qt], lane);
      bool msk[4][4];
#pragma unroll
      for (int mt = 0; mt < 4; ++mt)
#pragma unroll
        for (int j = 0; j < 4; ++j) { int s = kb * 64 + 16 * mt + 4 * quad + j; int df = tq[qt] - s; msk[mt][j] = (df >= 0) && (df < 512); }
      softmax_tile(st, msk, m[qt], lsum[qt], ot[qt]);
      pv_mma(ot[qt], sVt, st, lane);
    }
  }
#pragma unroll
  for (int qt = 0; qt < 2; ++qt) {
    const float ls = quad_sum(lsum[qt]);
    const float inv = 1.f / fmaxf(ls, 1e-30f);
    const long t = tb + tq[qt];
#pragma unroll
    for (int dt = 0; dt < 4; ++dt) {
      uint2 ov; ov.x = pk2(ot[qt][dt][0] * inv, ot[qt][dt][1] * inv); ov.y = pk2(ot[qt][dt][2] * inv, ot[qt][dt][3] * inv);
      *(uint2*)(OW + t * 256 + w * 64 + 16 * dt + 4 * quad) = ov;
    }
  }
}

DI void cmp_attn_item(const Params& P, int it, u16* sQ, u16* sK, u16* sVt, float* sImp) {
  const int tid = TID(), lane = tid & 63, w = tid >> 6, r16 = lane & 15, quad = lane >> 4;
  const int tbk = 255 - (it >> 3), b = it & 7;
  const u16* PROJ = (const u16*)(WSP(P) + WS_PROJ);
  const u16* KC = (const u16*)(WSP(P) + WS_KC) + (long)b * 256 * 64;
  const u16* VC = (const u16*)(WSP(P) + WS_VC) + (long)b * 256 * 64;
  u16* OC = (u16*)(WSP(P) + WS_OC);
  u64* SEL = (u64*)(WSP(P) + WS_SEL);
  const long tb = (long)b * SEQ;
  const int t0 = tbk * 16;
  load_q_nsa(sQ, PROJ + (tb + t0) * PW + P_Q, PW);
  for (int e = tid; e < 4 * 16 * 64; e += 256) sImp[e] = 0.f;
  __syncthreads();
  bf16x8 bq[2]; load_qfrag(bq, sQ, w, lane);
  const int tq = t0 + r16;
  const int nv = (tq >= 31) ? ((tq - 31) >> 4) + 1 : 0;
  const int nvmax = (t0 + 15 >= 31) ? ((t0 + 15 - 31) >> 4) + 1 : 0;
  const int ntile = (nvmax + 63) >> 6;
  float m = -1e30f, lsum = 0.f;
  uint4 pk0, pk1, pv0, pv1;
  if (ntile > 0) k_gload(pk0, pk1, KC, 64);
  for (int kt = 0; kt < ntile; ++kt) {
    __syncthreads();
    k_store(pk0, pk1, sK);
    __syncthreads();
    if (kt + 1 < ntile) k_gload(pk0, pk1, KC + (kt + 1) * 64 * 64, 64);
    f32x4 st[4];
    st_mma(st, sK, bq, lane);
    float tm = -1e30f;
#pragma unroll
    for (int mt = 0; mt < 4; ++mt)
#pragma unroll
      for (int j = 0; j < 4; ++j) { int n = kt * 64 + 16 * mt + 4 * quad + j; float s = st[mt][j] * 0.125f; st[mt][j] = s; if (n < nv) tm = fmaxf(tm, s); }
    tm = quad_max(tm);
    float mn = fmaxf(m, tm);
    float ps = 0.f;
#pragma unroll
    for (int mt = 0; mt < 4; ++mt)
#pragma unroll
      for (int j = 0; j < 4; ++j) { int n = kt * 64 + 16 * mt + 4 * quad + j; if (n < nv) ps += __expf(st[mt][j] - mn); }
    lsum = lsum * __expf(m - mn) + ps;
    m = mn;
  }
  lsum = quad_sum(lsum);
  const float inv = (lsum > 0.f) ? 1.f / lsum : 0.f;
  f32x4 ot[4];
#pragma unroll
  for (int dt = 0; dt < 4; ++dt) ot[dt] = (f32x4){0.f, 0.f, 0.f, 0.f};
  float carry = 0.f;
  if (ntile > 0) kv_gload(pk0, pk1, pv0, pv1, KC, VC, 64);
  for (int kt = 0; kt < ntile; ++kt) {
    __syncthreads();
    kv_store(pk0, pk1, pv0, pv1, sK, sVt);
    __syncthreads();
    if (kt + 1 < ntile) kv_gload(pk0, pk1, pv0, pv1, KC + (kt + 1) * 64 * 64, VC + (kt + 1) * 64 * 64, 64);
    f32x4 st[4];
    st_mma(st, sK, bq, lane);
#pragma unroll
    for (int mt = 0; mt < 4; ++mt)
#pragma unroll
      for (int j = 0; j < 4; ++j) { int n = kt * 64 + 16 * mt + 4 * quad + j; st[mt][j] = (n < nv) ? __expf(st[mt][j] * 0.125f - m) * inv : 0.f; }
    pv_mma(ot, sVt, st, lane);
    float prevlast = carry;
#pragma unroll
    for (int mt = 0; mt < 4; ++mt) {
      float pl = st[mt][3];
      float fd = __shfl_up(pl, 16);
      float pprev = (quad > 0) ? fd : prevlast;
      float v = st[mt][0] + st[mt][1] + st[mt][2] + st[mt][3] + pprev;
      sImp[(w * 16 + r16) * 64 + kt * 16 + mt * 4 + quad] = v;
      prevlast = __shfl_down(pl, 48);
    }
    carry = prevlast;
  }
  {
    const long t = tb + tq;
#pragma unroll
    for (int dt = 0; dt < 4; ++dt) {
      uint2 ov; ov.x = pk2(ot[dt][0], ot[dt][1]); ov.y = pk2(ot[dt][2], ot[dt][3]);
      *(uint2*)(OC + t * 256 + w * 64 + 16 * dt + 4 * quad) = ov;
    }
  }
  __syncthreads();
  for (int q = 0; q < 4; ++q) {
    const int tok = 4 * w + q, t = t0 + tok;
    float v = sImp[(0 * 16 + tok) * 64 + lane] + sImp[(1 * 16 + tok) * 64 + lane] + sImp[(2 * 16 + tok) * 64 + lane] + sImp[(3 * 16 + tok) * 64 + lane];
    const int cur = t >> 6;
    if (lane == 0 || lane == cur) v = 1e9f;
    else if (lane * 64 > t) v = -1e30f;
    int cnt = 0;
#pragma unroll
    for (int i2 = 0; i2 < 64; ++i2) {
      float vi = __builtin_bit_cast(float, __builtin_amdgcn_readlane(__builtin_bit_cast(int, v), i2));
      cnt += (vi > v || (vi == v && i2 < lane)) ? 1 : 0;
    }
    u64 mask = __ballot(cnt < 16);
    if (lane == 0) SEL[tb + t] = mask;
  }
}

DI void sel_attn_item(const Params& P, int it, u16* sQ, u16* sKunused, u16* sVunused) {
  const int tid = TID(), lane = tid & 63, w = tid >> 6, r16 = lane & 15, quad = lane >> 4;
  const int tbk = 127 - (it >> 3), b = it & 7;
  u16* sK = sQ + 128 * 72;
  u16* sVt = sK + 64 * 72;
  (void)sKunused; (void)sVunused;
  const u16* PROJ = (const u16*)(WSP(P) + WS_PROJ);
  const u16* QR = (const u16*)(WSP(P) + WS_QR);
  const u16* OC = (const u16*)(WSP(P) + WS_OC);
  const u16* OW = (const u16*)(WSP(P) + WS_OW);
  const u64* SEL = (const u64*)(WSP(P) + WS_SEL);
  u16* OUT = (u16*)(WSP(P) + WS_OM);
  const long tb = (long)b * SEQ;
  const int t0 = tbk * 32;
#pragma unroll
  for (int i = 0; i < 4; ++i) {
    const int c = tid + 256 * i, row = c >> 3, ch = c & 7;
    *(uint4*)(sQ + row * 72 + ch * 8) = *(const uint4*)(QR + (tb + t0 + (row & 31)) * 256 + (row >> 5) * 64 + ch * 8);
  }
  __syncthreads();
  bf16x8 bq[2][2];
  int tq[2]; u64 mysel[2];
#pragma unroll
  for (int qt = 0; qt < 2; ++qt) {
    const int rowq = 32 * w + 16 * qt + r16;
    bq[qt][0] = *(const bf16x8*)(sQ + rowq * 72 + quad * 8);
    bq[qt][1] = *(const bf16x8*)(sQ + rowq * 72 + 32 + quad * 8);
    tq[qt] = t0 + 16 * qt + r16;
    mysel[qt] = SEL[tb + tq[qt]];
  }
  u64 uni = 0;
#pragma unroll
  for (int q = 0; q < 32; ++q) uni |= SEL[tb + t0 + q];
  const int cur = t0 >> 6;
  uni &= (cur == 63) ? ~0ull : ((1ull << (cur + 1)) - 1ull);
  f32x4 ot[2][4];
#pragma unroll
  for (int qt = 0; qt < 2; ++qt)
#pragma unroll
    for (int dt = 0; dt < 4; ++dt) ot[qt][dt] = (f32x4){0.f, 0.f, 0.f, 0.f};
  float m[2] = {-1e30f, -1e30f}, lsum[2] = {0.f, 0.f};
  uint4 pk0, pk1, pv0, pv1;
  int kb = uni ? (__ffsll((long long)uni) - 1) : -1;
  uni &= uni - 1;
  if (kb >= 0) kv_gload(pk0, pk1, pv0, pv1, PROJ + (tb + kb * 64) * PW + P_KV + 128, PROJ + (tb + kb * 64) * PW + P_KV + 192, PW);
  for (int nkb = -1; kb >= 0; kb = nkb) {
    __syncthreads();
    kv_store(pk0, pk1, pv0, pv1, sK, sVt);
    __syncthreads();
    nkb = uni ? (__ffsll((long long)uni) - 1) : -1;
    uni &= uni - 1;
    if (nkb >= 0) kv_gload(pk0, pk1, pv0, pv1, PROJ + (tb + nkb * 64) * PW + P_KV + 128, PROJ + (tb + nkb * 64) * PW + P_KV + 192, PW);
#pragma unroll
    for (int qt = 0; qt < 2; ++qt) {
      f32x4 st[4];
      st_mma(st, sK, bq[qt], lane);
      const bool selq = (mysel[qt] >> kb) & 1ull;
      bool msk[4][4];
#pragma unroll
      for (int mt = 0; mt < 4; ++mt)
#pragma unroll
        for (int j = 0; j < 4; ++j) { int s = kb * 64 + 16 * mt + 4 * quad + j; msk[mt][j] = selq && (s <= tq[qt]); }
      softmax_tile(st, msk, m[qt], lsum[qt], ot[qt]);
      pv_mma(ot[qt], sVt, st, lane);
    }
  }
#pragma unroll
  for (int qt = 0; qt < 2; ++qt) {
    const float ls = quad_sum(lsum[qt]);
    const float inv = 1.f / fmaxf(ls, 1e-30f);
    const long t = tb + tq[qt];
    const float gc = sigmoidf_(bf2f(PROJ[t * PW + P_NG + w * 3 + 0]));
    const float gsl = sigmoidf_(bf2f(PROJ[t * PW + P_NG + w * 3 + 1]));
    const float gw = sigmoidf_(bf2f(PROJ[t * PW + P_NG + w * 3 + 2]));
#pragma unroll
    for (int dt = 0; dt < 4; ++dt) {
      const long o = t * 256 + w * 64 + 16 * dt + 4 * quad;
      uint2 c = *(const uint2*)(OC + o), ww = *(const uint2*)(OW + o);
      float r0 = gc * bf2f((u16)(c.x & 0xffff)) + gsl * ot[qt][dt][0] * inv + gw * bf2f((u16)(ww.x & 0xffff));
      float r1 = gc * bf2f((u16)(c.x >> 16)) + gsl * ot[qt][dt][1] * inv + gw * bf2f((u16)(ww.x >> 16));
      float r2 = gc * bf2f((u16)(c.y & 0xffff)) + gsl * ot[qt][dt][2] * inv + gw * bf2f((u16)(ww.y & 0xffff));
      float r3 = gc * bf2f((u16)(c.y >> 16)) + gsl * ot[qt][dt][3] * inv + gw * bf2f((u16)(ww.y >> 16));
      uint2 ov; ov.x = pk2(r0, r1); ov.y = pk2(r2, r3);
      *(uint2*)(OUT + o) = ov;
    }
  }
}

DI void inproj_tile(const Params& P, int l, int it, u16* sA, u16* sB) {
  const int tid = TID(), lane = tid & 63, w = tid >> 6, r16 = lane & 15, quad = lane >> 4, wm = w >> 1, wn = w & 1;
  int mt, nt; tile_from_q(it, 22, mt, nt);
  const u16* H = (const u16*)(WSP(P) + WS_H);
  u16* PROJ = (u16*)(WSP(P) + WS_PROJ);
  const u16* Ab = H + (long)mt * 128 * DM;
  const u16* Bb = (const u16*)(WSP(P) + WS_W + WT_IN) + (long)nt * 128 * DM;
  f32x4 acc[4][4];
  gemm3<4>(acc, g3_ptr(Ab, DM, tid, 0, false), g3_ptr(Ab, DM, tid, 1, false), nullptr, nullptr, 64,
           g3_ptr(Bb, DM, tid, 0, false), g3_ptr(Bb, DM, tid, 1, false), nullptr, nullptr, DM, sA, 16L * DM, 16L * DM);
  __syncthreads();
#pragma unroll
  for (int mi = 0; mi < 4; ++mi)
#pragma unroll
    for (int ni = 0; ni < 4; ++ni)
#pragma unroll
      for (int j = 0; j < 4; ++j) sA[(wm * 64 + 16 * mi + 4 * quad + j) * 136 + wn * 64 + 16 * ni + r16] = f2bf(acc[mi][ni][j]);
  __syncthreads();
  store_tile_bf16<128>(sA, PROJ + (long)mt * 128 * PW + nt * 128, PW, 128);
}
DI void glu_tile(const Params& P, int l, int it, u16* sA, u16* sB) {
  const int tid = TID(), lane = tid & 63, w = tid >> 6, r16 = lane & 15, quad = lane >> 4, wm = w >> 1, wn = w & 1;
  const int mt = it >> 2, nt = it & 3;
  const u16* Y5 = (const u16*)(WSP(P) + WS_Y5);
  u16* OUT = (u16*)(WSP(P) + WS_OM) + (long)1 * T_ * 256;
  const u16* Ab = Y5 + (long)mt * 128 * 256;
  const u16* Bb = (const u16*)(WSP(P) + WS_W + WT_GLU) + (long)nt * 128 * 256;
  f32x4 acc[4][4];
  gemm3<4>(acc, g3_ptr(Ab, 256, tid, 0, false), g3_ptr(Ab, 256, tid, 1, false), nullptr, nullptr, 64,
           g3_ptr(Bb, 256, tid, 0, false), g3_ptr(Bb, 256, tid, 1, false), nullptr, nullptr, 256, sA, 16L * 256, 16L * 256);
  __syncthreads();
#pragma unroll
  for (int mi = 0; mi < 4; ++mi)
#pragma unroll
    for (int ni = 0; ni < 2; ++ni)
#pragma unroll
      for (int j = 0; j < 4; ++j)
        sA[(wm * 64 + 16 * mi + 4 * quad + j) * 72 + wn * 32 + 16 * ni + r16] = f2bf(acc[mi][ni][j] * sigmoidf_(acc[mi][ni + 2][j]));
  __syncthreads();
  store_tile_bf16<64>(sA, OUT + (long)mt * 128 * 256 + nt * 64, 256, 128);
}
DI void merge_tile(const Params& P, int l, int it, u16* sA, u16* sB) {
  const int tid = TID(), lane = tid & 63, w = tid >> 6, r16 = lane & 15, quad = lane >> 4, wm = w >> 1, wn = w & 1;
  int mt, nt; tile_from_q(it, 8, mt, nt);
  const u16* H = (const u16*)(WSP(P) + WS_H);
  const u16* OM = (const u16*)(WSP(P) + WS_OM);
  u16* MERGED = (u16*)(WSP(P) + WS_MERGED);
  uint2 outp[4][4];
#pragma unroll
  for (int mi = 0; mi < 4; ++mi)
#pragma unroll
    for (int ni = 0; ni < 4; ++ni) outp[mi][ni] = make_uint2(0u, 0u);
#pragma unroll 1
  for (int m = 0; m < 4; ++m) {
    uint2 gp[4][4];
    {
      f32x4 ag[4][4];
      const u16* Ab = H + (long)mt * 128 * DM;
      const u16* Bb = (const u16*)(WSP(P) + WS_W + WT_G) + ((long)(m * 1024 + nt * 128)) * DM;
      gemm3<4, true>(ag, g3_ptr(Ab, DM, tid, 0, false), g3_ptr(Ab, DM, tid, 1, false), nullptr, nullptr, 64,
               g3_ptr(Bb, DM, tid, 0, false), g3_ptr(Bb, DM, tid, 1, false), nullptr, nullptr, DM, sA, 16L * DM, 16L * DM);
#pragma unroll
      for (int mi = 0; mi < 4; ++mi)
#pragma unroll
        for (int ni = 0; ni < 4; ++ni) {
          gp[mi][ni].x = pk2(sigmoidf_(ag[mi][ni][0]), sigmoidf_(ag[mi][ni][1]));
          gp[mi][ni].y = pk2(sigmoidf_(ag[mi][ni][2]), sigmoidf_(ag[mi][ni][3]));
        }
    }
    {
      f32x4 av[4][4];
      const u16* Ab = OM + ((long)m * T_ + (long)mt * 128) * 256;
      const u16* Bb = (const u16*)(WSP(P) + WS_W + WT_BR) + ((long)(m * 1024 + nt * 128)) * 256;
      gemm3<4, true>(av, g3_ptr(Ab, 256, tid, 0, false), g3_ptr(Ab, 256, tid, 1, false), nullptr, nullptr, 64,
               g3_ptr(Bb, 256, tid, 0, false), g3_ptr(Bb, 256, tid, 1, false), nullptr, nullptr, 256, sA, 16L * 256, 16L * 256);
#pragma unroll
      for (int mi = 0; mi < 4; ++mi)
#pragma unroll
        for (int ni = 0; ni < 4; ++ni) {
          const float o0 = bf2f((u16)(outp[mi][ni].x & 0xffff)) + av[mi][ni][0] * bf2f((u16)(gp[mi][ni].x & 0xffff));
          const float o1 = bf2f((u16)(outp[mi][ni].x >> 16)) + av[mi][ni][1] * bf2f((u16)(gp[mi][ni].x >> 16));
          const float o2 = bf2f((u16)(outp[mi][ni].y & 0xffff)) + av[mi][ni][2] * bf2f((u16)(gp[mi][ni].y & 0xffff));
          const float o3 = bf2f((u16)(outp[mi][ni].y >> 16)) + av[mi][ni][3] * bf2f((u16)(gp[mi][ni].y >> 16));
          outp[mi][ni].x = pk2(o0, o1); outp[mi][ni].y = pk2(o2, o3);
        }
    }
  }
  __syncthreads();
#pragma unroll
  for (int mi = 0; mi < 4; ++mi)
#pragma unroll
    for (int ni = 0; ni < 4; ++ni)
#pragma unroll
      for (int j = 0; j < 4; ++j) {
        const unsigned wv = (j < 2) ? outp[mi][ni].x : outp[mi][ni].y;
        sA[(wm * 64 + 16 * mi + 4 * quad + j) * 136 + wn * 64 + 16 * ni + r16] = (u16)((j & 1) ? (wv >> 16) : (wv & 0xffff));
      }
  __syncthreads();
  store_tile_bf16<128>(sA, MERGED + (long)mt * 128 * DM + nt * 128, DM, 128);
}
DI void resid_tile(const u16* A, int K, const u16* Bt, const float* resid, float* out, int it, u16* sA, u16* sB) {
  const int tid = TID(), lane = tid & 63, w = tid >> 6, r16 = lane & 15, quad = lane >> 4, wm = w >> 1, wn = w & 1;
  int mt, nt; tile_from_q(it, 8, mt, nt);
  const u16* Ab = A + (long)mt * 128 * K;
  const u16* Bb = Bt + (long)nt * 128 * K;
  f32x4 acc[4][4];
  gemm3<4>(acc, g3_ptr(Ab, K, tid, 0, false), g3_ptr(Ab, K, tid, 1, false), nullptr, nullptr, 64,
           g3_ptr(Bb, K, tid, 0, false), g3_ptr(Bb, K, tid, 1, false), nullptr, nullptr, K, sA, 16L * K, 16L * K);
  float* sC = (float*)sA + w * (32 * 68);
#pragma unroll
  for (int hp = 0; hp < 2; ++hp) {
    __syncthreads();
#pragma unroll
    for (int mi2 = 0; mi2 < 2; ++mi2)
#pragma unroll
      for (int ni = 0; ni < 4; ++ni)
#pragma unroll
        for (int j = 0; j < 4; ++j) sC[(16 * mi2 + 4 * quad + j) * 68 + 16 * ni + r16] = acc[2 * hp + mi2][ni][j];
    __syncthreads();
#pragma unroll
    for (int q = 0; q < 8; ++q) {
      const int c = lane + 64 * q, row = c >> 4, c4 = (c & 15) * 4;
      const long o = ((long)mt * 128 + wm * 64 + 32 * hp + row) * DM + nt * 128 + wn * 64 + c4;
      const float4 rv = *(const float4*)(resid + o);
      const f32x4 cv = *(const f32x4*)(sC + row * 68 + c4);
      *(float4*)(out + o) = make_float4(rv.x + cv[0], rv.y + cv[1], rv.z + cv[2], rv.w + cv[3]);
    }
  }
}
DI void ffn1_tile(const Params& P, int l, int it, u16* sA, u16* sB) {
  const int tid = TID(), lane = tid & 63, w = tid >> 6, r16 = lane & 15, quad = lane >> 4, wm = w >> 1, wn = w & 1;
  int mt, nt; tile_from_q(it, 44, mt, nt);
  const u16* H = (const u16*)(WSP(P) + WS_H);
  u16* ACT = (u16*)(WSP(P) + WS_PROJ);
  const u16* Ab = H + (long)mt * 128 * DM;
  const u16* Bb = (const u16*)(WSP(P) + WS_W + WT_GU) + (long)nt * 128 * DM;
  f32x4 acc[4][4];
  gemm3<4>(acc, g3_ptr(Ab, DM, tid, 0, false), g3_ptr(Ab, DM, tid, 1, false), nullptr, nullptr, 64,
           g3_ptr(Bb, DM, tid, 0, false), g3_ptr(Bb, DM, tid, 1, false), nullptr, nullptr, DM, sA, 16L * DM, 16L * DM);
  __syncthreads();
#pragma unroll
  for (int mi = 0; mi < 4; ++mi)
#pragma unroll
    for (int ni = 0; ni < 2; ++ni)
#pragma unroll
      for (int j = 0; j < 4; ++j)
        sA[(wm * 64 + 16 * mi + 4 * quad + j) * 72 + wn * 32 + 16 * ni + r16] = f2bf(siluf_(acc[mi][ni][j]) * acc[mi][ni + 2][j]);
  __syncthreads();
  store_tile_bf16<64>(sA, ACT + (long)mt * 128 * DFF + nt * 64, DFF, 128);
}

__global__ void __launch_bounds__(256, LB2) fwd_megakernel(Params P) {
  cg::grid_group grid = cg::this_grid();
  __shared__ __attribute__((aligned(16))) float lds[17920];
  __shared__ int s_item;
  unsigned* cnt = (unsigned*)(WSP(P) + WS_CNT);
  const int xcd = (int)(__builtin_amdgcn_s_getreg((3 << 11) | 20) & 0xF) & 7;
  __shared__ int s_rank;
  if (threadIdx.x == 0) s_rank = (int)atomicAdd(cnt + 900 + xcd, 1u);
  __syncthreads();
  const int xrank = s_rank;
  u16* sA = (u16*)lds;
  u16* sB = sA + 128 * 80;
  u16* aQ = (u16*)lds;
  u16* aK = aQ + 64 * 72;
  u16* aV = aK + 64 * 72;
  float* aImp = (float*)(aV + 64 * 72);
  for (int ph = P.ph_lo; ph < P.ph_hi; ++ph) {
    const int l = ph / 11, sp = ph % 11;
    const float* xin = (l == 0) ? P.in[0] : P.out;
    const int nrep = (PROBE_DUP != 0 && l == 0 && ((PROBE_DUP >> sp) & 1)) ? 2 : 1;
    for (int rep = 0; rep < nrep; ++rep) {
    unsigned* pc = cnt + (ph + 32 * rep) * 8;
    switch (sp) {
      case 0: if (PHASE_MASK & (1 << 0)) {
        phase_rmsnorm(xin, P.in[2] + l * DM, (u16*)(WSP(P) + WS_H));
        phase_convert(P, l, lds);
        if (l == 0) phase_rope_table((const int*)P.in[1], (float*)(WSP(P) + WS_COS), (float*)(WSP(P) + WS_SIN));
      } break;
      case 1: if (PHASE_MASK & (1 << 1)) {
        XCD_STATIC_LOOP(32 * 22, inproj_tile(P, l, it, sA, sB))
      } break;
      case 2: if (PHASE_MASK & (1 << 2)) {
        for (;;) {
          int it = next_item(pc, &s_item); if (it >= 64 + 3 * 2048) break;
          if (it < 64) cmp1_tile(P, l, it, sA, sB);
          else if (it < 64 + 2048) gdn_p1_item(P, l, it - 64, lds);
          else if (it < 64 + 4096) s5_pass1_item(P, l, it - 64 - 2048, lds);
          else nsa_prep_item(P, l, it - 64 - 4096);
        }
      } break;
      case 3: if (PHASE_MASK & (1 << 3)) {
        for (;;) {
          int it = next_item(pc, &s_item); if (it >= 128 + 3072 + 64) break;
          if (it < 128) gdn_p2_item(P, it, lds);
          else if (it < 128 + 2048) sb_attn_item(P, it - 128, aQ, aK, aV);
          else if (it < 128 + 3072) win_attn_item(P, it - 128 - 2048, aQ, aK, aV);
          else if (it < 128 + 3072 + 32) s5_carry_item(P, l, it - 128 - 3072);
          else cmp2_tile(P, l, it - 128 - 3072 - 32, sA, sB, lds + 17000);
        }
      } break;
      case 4: if (PHASE_MASK & (1 << 4)) {
        for (;;) {
          int it = next_item(pc, &s_item); if (it >= 3 * 2048) break;
          if (it < 2048) cmp_attn_item(P, it, aQ, aK, aV, aImp);
          else if (it < 4096) s5_pass2_item(P, l, it - 2048, lds);
          else gdn_post_item(P, l, it - 4096);
        }
      } break;
      case 5: if (PHASE_MASK & (1 << 5)) {
        for (;;) {
          int it = next_item(pc, &s_item); if (it >= 1024 + 1024) break;
          if (it < 1024) sel_attn_item(P, it, aQ, aK, aV);
          else glu_tile(P, l, it - 1024, sA, sB);
        }
      } break;
      case 6: if (PHASE_MASK & (1 << 6)) {
        XCD_STATIC_LOOP(32 * 8, merge_tile(P, l, it, sA, sB))
      } break;
      case 7: if (PHASE_MASK & (1 << 7)) {
        XCD_STATIC_LOOP(32 * 8, resid_tile((const u16*)(WSP(P) + WS_MERGED), DM, (const u16*)(WSP(P) + WS_W + WT_OUT), xin, P.out, it, sA, sB))
      } break;
      case 8: if (PHASE_MASK & (1 << 8)) {
        phase_rmsnorm(P.out, P.in[26] + l * DM, (u16*)(WSP(P) + WS_H));
      } break;
      case 9: if (PHASE_MASK & (1 << 9)) {
        XCD_STATIC_LOOP(32 * 44, ffn1_tile(P, l, it, sA, sB))
      } break;
      case 10: if (PHASE_MASK & (1 << 10)) {
        XCD_STATIC_LOOP(32 * 8, resid_tile((const u16*)(WSP(P) + WS_PROJ), DFF, (const u16*)(WSP(P) + WS_W + WT_D), P.out, P.out, it, sA, sB))
      } break;
    }
    if (rep + 1 < nrep) grid.sync();
    }
    if (ph + 1 < P.ph_hi) grid.sync();
  }
}

extern "C" void kernel_launch(void* const* d_in, const int* in_sizes, int n_in, void* d_out, int out_size, void* d_ws, size_t ws_size,
                              hipStream_t stream) {
  static int grid_blocks = 0;
  if (!grid_blocks) {
    int dev = 0, cus = 0, per_cu = 0;
    hipGetDevice(&dev);
    hipDeviceGetAttribute(&cus, hipDeviceAttributeMultiprocessorCount, dev);
    hipOccupancyMaxActiveBlocksPerMultiprocessor(&per_cu, fwd_megakernel, 256, 0);
    if (per_cu < 1) per_cu = 1;
    if (per_cu > 2) per_cu = 2;
    grid_blocks = cus * per_cu;
    if (ws_size < WS_W + WT_END) fprintf(stderr, "kernel_launch: workspace too small: %zu\n", ws_size);
  }
  hipMemsetAsync((char*)d_ws + WS_CNT, 0, 4096, stream);
  Params p{};
  for (int i = 0; i < 30; ++i) p.in[i] = (const float*)d_in[i];
  p.out = (float*)d_out;
  p.ws = (unsigned char*)d_ws;
  p.ph_lo = 0; p.ph_hi = NPHASE;
  void* args[] = {&p};
  hipError_t e = hipLaunchCooperativeKernel((void*)fwd_megakernel, dim3(grid_blocks), dim3(256), args, 0, stream);
  if (e != hipSuccess) fprintf(stderr, "cooperative launch failed: %s (grid %d)\n", hipGetErrorString(e), grid_blocks);
}
```

```cpp
#include <hip/hip_runtime.h>
#include <hip/hip_cooperative_groups.h>
#include <cstdio>
namespace cg = cooperative_groups;

typedef unsigned short u16;
typedef unsigned long long u64;
typedef __attribute__((ext_vector_type(8))) short bf16x8;
typedef __attribute__((ext_vector_type(4))) short s16x4;
typedef __attribute__((ext_vector_type(4))) float f32x4;
#define DI __device__ __forceinline__

constexpr int NB = 8, SEQ = 4096, T_ = NB * SEQ, DM = 1024, DIN = 6804, PW = 2816, DFF = 2816;
constexpr int P_Q = 0, P_KV = 256, P_S5U = 640, P_GQKV = 896, P_GZ = 1664, P_SB = 1920, P_NG = 2688, P_GA = 2700, P_GB = 2704;
constexpr float EPS = 1e-6f;
constexpr size_t MiB = 1024ull * 1024ull;
constexpr size_t WS_H = 0, WS_PROJ = 64 * MiB, WS_OM = 240 * MiB, WS_MERGED = 304 * MiB,
                 WS_GQ = 304 * MiB, WS_GK = 320 * MiB, WS_GU = 336 * MiB, WS_GW = 352 * MiB, WS_GA = 368 * MiB,
                 WS_QR = 384 * MiB, WS_OC = 400 * MiB, WS_OW = 416 * MiB, WS_Y5 = 432 * MiB,
                 WS_GG = 448 * MiB, WS_SEL = 449 * MiB, WS_COS = 450 * MiB, WS_SIN = 451 * MiB,
                 WS_ENDS = 452 * MiB, WS_CARRY = 456 * MiB, WS_KC = 460 * MiB, WS_VC = 461 * MiB, WS_HID = 462 * MiB,
                 WS_CNT = 464 * MiB, WS_W = 465 * MiB, WS_CBIAS = 449 * MiB + 512 * 1024;
constexpr size_t WT_IN = 0, WT_G = WT_IN + 2816ull * 1024 * 2, WT_BR = WT_G + 4096ull * 1024 * 2, WT_OUT = WT_BR + 4096ull * 256 * 2,
                 WT_GU = WT_OUT + 1024ull * 1024 * 2, WT_D = WT_GU + 5632ull * 1024 * 2, WT_GLU = WT_D + 1024ull * 2816 * 2,
                 WT_C1 = WT_GLU + 512ull * 256 * 2, WT_C2 = WT_C1 + 512ull * 2048 * 2, WT_END = WT_C2 + 128ull * 256 * 2;
constexpr int NPHASE = 22;
#define XCD_STATIC_LOOP(NPER, BODY) { \
    unsigned c0_ = cnt[900], c1_ = cnt[901], c2_ = cnt[902], c3_ = cnt[903], c4_ = cnt[904], c5_ = cnt[905], c6_ = cnt[906], c7_ = cnt[907]; \
    const bool ok_ = c0_ && c1_ && c2_ && c3_ && c4_ && c5_ && c6_ && c7_; \
    const unsigned mine_ = xcd == 0 ? c0_ : xcd == 1 ? c1_ : xcd == 2 ? c2_ : xcd == 3 ? c3_ : xcd == 4 ? c4_ : xcd == 5 ? c5_ : xcd == 6 ? c6_ : c7_; \
    const int start_ = ok_ ? xcd * (NPER) + xrank : (int)blockIdx.x, end_ = ok_ ? (xcd + 1) * (NPER) : 8 * (NPER), step_ = ok_ ? (int)mine_ : (int)gridDim.x; \
    for (int it = start_; it < end_; it += step_) { BODY; } }
#ifndef PROBE_DUP
#define PROBE_DUP 0
#endif
#ifndef LB2
#define LB2 2
#endif
#ifndef PHASE_MASK
#define PHASE_MASK 0x7ff
#endif

struct Params {
  const float* in[30];
  float* out;
  unsigned char* ws;
  int ph_lo, ph_hi;
};


DI int TID() { int t = threadIdx.x; asm volatile("" : "+v"(t)); return t; }
DI unsigned char* WSP(const Params& P) { size_t z = 0; asm volatile("" : "+s"(z)); return P.ws + z; }
DI u16 f2bf(float x) { unsigned u = __float_as_uint(x); u += 0x7fffu + ((u >> 16) & 1u); return (u16)(u >> 16); }
DI float bf2f(u16 h) { return __uint_as_float(((unsigned)h) << 16); }
DI unsigned pk2(float a, float b) { return (unsigned)f2bf(a) | ((unsigned)f2bf(b) << 16); }
DI float wave_sum(float v) {
#pragma unroll
  for (int o = 1; o < 64; o <<= 1) v += __shfl_xor(v, o);
  return v;
}
DI float sigmoidf_(float x) { return 1.f / (1.f + __expf(-x)); }
DI float siluf_(float x) { return x * sigmoidf_(x); }
DI float softplusf_(float x) { return fmaxf(x, 0.f) + log1pf(__expf(-fabsf(x))); }
DI float gelu_tanh(float x) {
  float u = 0.7978845608028654f * (x + 0.044715f * x * x * x);
  float t = 1.f - 2.f / (__expf(2.f * u) + 1.f);
  return 0.5f * x * (1.f + t);
}
DI void sincos_d(double x, double& s, double& c) {
  const double TWO_PI = 6.283185307179586476925287, INV = 0.15915494309189533576888;
  double n = rint(x * INV);
  double r = x - n * TWO_PI;
  double r2 = r * r, term = 1.0, cs = 1.0, ss = 1.0;
#pragma unroll
  for (int k = 1; k <= 14; ++k) { term *= r2 * (-1.0 / (double)((2 * k - 1) * (2 * k))); cs += term; }
  term = 1.0;
#pragma unroll
  for (int k = 1; k <= 14; ++k) { term *= r2 * (-1.0 / (double)((2 * k) * (2 * k + 1))); ss += term; }
  s = r * ss; c = cs;
}
DI int next_item(unsigned* cnt, int* s_item) {
  __syncthreads();
  if (TID() == 0) *s_item = (int)atomicAdd(cnt, 1u);
  __syncthreads();
  return *s_item;
}
DI int next_tile_xcd(unsigned* cnt8, int n_per_xcd, int xcd, int* s_item) {
  asm volatile("" : "+s"(xcd));
  __syncthreads();
  if (threadIdx.x == 0) {
    int res = -1;
    for (int a = 0; a < 8; ++a) {
      int qq = (xcd + a) & 7;
      unsigned v = atomicAdd(cnt8 + qq, 1u);
      if (v < (unsigned)n_per_xcd) { res = qq * n_per_xcd + (int)v; break; }
    }
    *s_item = res;
  }
  __syncthreads();
  return *s_item;
}
DI void tile_from_q(int it, int numN, int& mt, int& nt) {
  const int per = 32 * numN, q = it / per, i = it % per, g = i / (8 * numN), rem = i % (8 * numN);
  nt = rem >> 3; mt = 32 * q + 8 * g + (rem & 7);
}
DI int proj_src_col(int pc) {
  if (pc < 640) return pc;
  if (pc < 1664) return pc + 12;
  if (pc < 2688) return pc + 20;
  if (pc < 2700) return pc - 2688 + 640;
  if (pc < 2708) return pc - 2700 + 1676;
  return pc;
}

DI uint4 addpos8(uint4 v, const float* pp) {
  uint4 o;
  o.x = pk2(bf2f((u16)(v.x & 0xffff)) + pp[0], bf2f((u16)(v.x >> 16)) + pp[1]);
  o.y = pk2(bf2f((u16)(v.y & 0xffff)) + pp[2], bf2f((u16)(v.y >> 16)) + pp[3]);
  o.z = pk2(bf2f((u16)(v.z & 0xffff)) + pp[4], bf2f((u16)(v.z >> 16)) + pp[5]);
  o.w = pk2(bf2f((u16)(v.w & 0xffff)) + pp[6], bf2f((u16)(v.w >> 16)) + pp[7]);
  return o;
}
template <int NTW>
DI void gemm2(f32x4 (&acc)[4][NTW], const u16* __restrict__ arow, long a_kstep, const float* __restrict__ apos,
              const u16* __restrict__ brow, int K, u16* sA, u16* sB) {
  constexpr int BN = 32 * NTW, BV = BN / 32, LS = 80;
  const int tid = TID(), lane = tid & 63, w = tid >> 6, r16 = lane & 15, quad = lane >> 4;
  const int wm = w >> 1, wn = w & 1;
  u16* sa_st = sA + (tid >> 1) * LS + (tid & 1) * 32;
  u16* sb_st = (BN == 128) ? (sB + (tid >> 1) * LS + (tid & 1) * 32) : (sB + (tid >> 2) * LS + (tid & 3) * 16);
  uint4 pa0, pa1, pa2, pa3, pb0, pb1, pb2, pb3;
  uint4 qa0, qa1, qa2, qa3, qb0, qb1, qb2, qb3;
  pb2 = make_uint4(0, 0, 0, 0); pb3 = pb2; qb2 = pb2; qb3 = pb2;
#define G2_LOAD(KT, a0, a1, a2, a3, b0, b1, b2, b3) { const uint4* pa_ = (const uint4*)(arow + (long)(KT) * a_kstep); \
    a0 = pa_[0]; a1 = pa_[1]; a2 = pa_[2]; a3 = pa_[3]; \
    if (apos) { const float* pp_ = apos + (KT) * 64 + (tid & 1) * 32; \
      a0 = addpos8(a0, pp_); a1 = addpos8(a1, pp_ + 8); a2 = addpos8(a2, pp_ + 16); a3 = addpos8(a3, pp_ + 24); } \
    const uint4* pb_ = (const uint4*)(brow + (long)(KT) * 64); \
    b0 = pb_[0]; b1 = pb_[1]; if (BV == 4) { b2 = pb_[2]; b3 = pb_[3]; } }
#define G2_STORE(a0, a1, a2, a3, b0, b1, b2, b3) { \
    ((uint4*)sa_st)[0] = a0; ((uint4*)sa_st)[1] = a1; ((uint4*)sa_st)[2] = a2; ((uint4*)sa_st)[3] = a3; \
    ((uint4*)sb_st)[0] = b0; ((uint4*)sb_st)[1] = b1; if (BV == 4) { ((uint4*)sb_st)[2] = b2; ((uint4*)sb_st)[3] = b3; } }
#define G2_COMPUTE() { _Pragma("unroll") for (int ks = 0; ks < 2; ++ks) { \
      bf16x8 af[4], bg[NTW]; \
      _Pragma("unroll") for (int mi = 0; mi < 4; ++mi) af[mi] = *(const bf16x8*)(sA + (wm * 64 + 16 * mi + r16) * LS + ks * 32 + quad * 8); \
      _Pragma("unroll") for (int ni = 0; ni < NTW; ++ni) bg[ni] = *(const bf16x8*)(sB + (wn * (BN / 2) + 16 * ni + r16) * LS + ks * 32 + quad * 8); \
      _Pragma("unroll") for (int mi = 0; mi < 4; ++mi) \
        _Pragma("unroll") for (int ni = 0; ni < NTW; ++ni) acc[mi][ni] = __builtin_amdgcn_mfma_f32_16x16x32_bf16(af[mi], bg[ni], acc[mi][ni], 0, 0, 0); } }
#pragma unroll
  for (int mi = 0; mi < 4; ++mi)
#pragma unroll
    for (int ni = 0; ni < NTW; ++ni) acc[mi][ni] = (f32x4){0.f, 0.f, 0.f, 0.f};
  const int nk = K >> 6;
  G2_LOAD(0, pa0, pa1, pa2, pa3, pb0, pb1, pb2, pb3)
  G2_LOAD(1, qa0, qa1, qa2, qa3, qb0, qb1, qb2, qb3)
#pragma unroll 1
  for (int kt = 0; kt < nk; kt += 2) {
    __syncthreads();
    G2_STORE(pa0, pa1, pa2, pa3, pb0, pb1, pb2, pb3)
    __syncthreads();
    if (kt + 2 < nk) G2_LOAD(kt + 2, pa0, pa1, pa2, pa3, pb0, pb1, pb2, pb3)
    G2_COMPUTE()
    __syncthreads();
    G2_STORE(qa0, qa1, qa2, qa3, qb0, qb1, qb2, qb3)
    __syncthreads();
    if (kt + 3 < nk) G2_LOAD(kt + 3, qa0, qa1, qa2, qa3, qb0, qb1, qb2, qb3)
    G2_COMPUTE()
  }
#undef G2_LOAD
#undef G2_STORE
#undef G2_COMPUTE
}
DI void g3_rowpiece(int tid, int q, bool n64, int& row, int& pc) {
  const int w = tid >> 6, lane = tid & 63, chunk = n64 ? (2 * w + q) : (4 * w + q);
  row = 8 * chunk + (lane >> 3);
  pc = (lane & 7) ^ ((row >> 1) & 7);
}
DI const u16* g3_ptr(const u16* base, long ld, int tid, int q, bool n64) {
  int row, pc; g3_rowpiece(tid, q, n64, row, pc);
  return base + (long)row * ld + pc * 8;
}
template <int NTW, bool LEAN = false>
DI void gemm3(f32x4 (&acc)[4][NTW], const u16* ap0, const u16* ap1, const u16* ap2, const u16* ap3, long a_kstep,
              const u16* bp0, const u16* bp1, const u16* bp2, const u16* bp3, int K, u16* sbase, long a16 = 0, long b16 = 0) {
  constexpr int BN = 32 * NTW, STAGE = 16384;
  const int tid = TID(), lane = tid & 63, w = tid >> 6, r16 = lane & 15, quad = lane >> 4;
  const int wm = w >> 1, wn = w & 1;
  const int sz = (r16 >> 1) & 7;
  const int wu = __builtin_amdgcn_readfirstlane(w);
#define G3_GLDS(GP, LOFF) asm volatile("s_mov_b32 m0, %1\n\ts_nop 0\n\tglobal_load_lds_dwordx4 %0, off" :: "v"(GP), "s"(LOFF) : "memory", "m0")
  const unsigned lds0 = (unsigned)(size_t)sbase;
#define G3_ISSUE(KT) { const unsigned st_ = lds0 + (((KT) & 1) ? STAGE * 2 : 0); const long ka_ = (long)(KT) * a_kstep, kb_ = (long)(KT) * 64; \
    if (BN == 128) { \
      const unsigned la_ = __builtin_amdgcn_readfirstlane(st_ + wu * 4096u); \
      G3_GLDS(ap0 + ka_, la_); G3_GLDS(ap1 + ka_, la_ + 1024u); \
      if (a16) { G3_GLDS(ap0 + (ka_ + a16), la_ + 2048u); G3_GLDS(ap1 + (ka_ + a16), la_ + 3072u); } else { G3_GLDS(ap2 + ka_, la_ + 2048u); G3_GLDS(ap3 + ka_, la_ + 3072u); } \
      G3_GLDS(bp0 + kb_, la_ + 16384u); G3_GLDS(bp1 + kb_, la_ + 17408u); \
      if (b16) { G3_GLDS(bp0 + (kb_ + b16), la_ + 18432u); G3_GLDS(bp1 + (kb_ + b16), la_ + 19456u); } else { G3_GLDS(bp2 + kb_, la_ + 18432u); G3_GLDS(bp3 + kb_, la_ + 19456u); } \
    } else { \
      const unsigned la_ = __builtin_amdgcn_readfirstlane(st_ + wu * 4096u); \
      const unsigned lb_ = __builtin_amdgcn_readfirstlane(st_ + 16384u + wu * 2048u); \
      G3_GLDS(ap0 + ka_, la_); G3_GLDS(ap1 + ka_, la_ + 1024u); G3_GLDS(ap2 + ka_, la_ + 2048u); G3_GLDS(ap3 + ka_, la_ + 3072u); \
      G3_GLDS(bp0 + kb_, lb_); G3_GLDS(bp1 + kb_, lb_ + 1024u); \
    } }
#pragma unroll
  for (int mi = 0; mi < 4; ++mi)
#pragma unroll
    for (int ni = 0; ni < NTW; ++ni) acc[mi][ni] = (f32x4){0.f, 0.f, 0.f, 0.f};
  const int nk = K >> 6;
  __syncthreads();
  G3_ISSUE(0)
  if (!LEAN && BN == 128) {
#define G3_PIECE(I, KT) { const unsigned st_ = lds0 + (((KT) & 1) ? STAGE * 2 : 0); const long ka_ = (long)(KT) * a_kstep, kb_ = (long)(KT) * 64; \
      const unsigned la_ = __builtin_amdgcn_readfirstlane(st_ + wu * 4096u); \
      if ((I) == 0) G3_GLDS(ap0 + ka_, la_); else if ((I) == 1) G3_GLDS(ap1 + ka_, la_ + 1024u); \
      else if ((I) == 2) G3_GLDS((a16 ? ap0 + a16 : ap2) + ka_, la_ + 2048u); else if ((I) == 3) G3_GLDS((a16 ? ap1 + a16 : ap3) + ka_, la_ + 3072u); \
      else if ((I) == 4) G3_GLDS(bp0 + kb_, la_ + 16384u); else if ((I) == 5) G3_GLDS(bp1 + kb_, la_ + 17408u); \
      else if ((I) == 6) G3_GLDS((b16 ? bp0 + b16 : bp2) + kb_, la_ + 18432u); else G3_GLDS((b16 ? bp1 + b16 : bp3) + kb_, la_ + 19456u); }
#define G3_STEP(KT, DOISSUE) { const u16* sAs = sbase + ((KT) & 1) * STAGE; const u16* sBs = sAs + 8192; \
      bf16x8 af[2][4], bg[2][NTW];     \
      _Pragma("unroll") for (int ks = 0; ks < 2; ++ks) { \
        const int pcol = ((ks * 4 + quad) ^ sz) * 8; \
        _Pragma("unroll") for (int mi = 0; mi < 4; ++mi) af[ks][mi] = *(const bf16x8*)(sAs + (wm * 64 + 16 * mi + r16) * 64 + pcol); \
        _Pragma("unroll") for (int ni = 0; ni < NTW; ++ni) bg[ks][ni] = *(const bf16x8*)(sBs + (wn * (BN / 2) + 16 * ni + r16) * 64 + pcol); } \
      __builtin_amdgcn_s_setprio(1);     \
      _Pragma("unroll") for (int mi = 0; mi < 4; ++mi) {   \
        acc[mi][0] = __builtin_amdgcn_mfma_f32_16x16x32_bf16(af[0][mi], bg[0][0], acc[mi][0], 0, 0, 0); \
        acc[mi][1] = __builtin_amdgcn_mfma_f32_16x16x32_bf16(af[0][mi], bg[0][1], acc[mi][1], 0, 0, 0); \
        if (DOISSUE) G3_PIECE(2 * mi, (KT) + 1) \
        __builtin_amdgcn_sched_barrier(0); \
        acc[mi][2] = __builtin_amdgcn_mfma_f32_16x16x32_bf16(af[0][mi], bg[0][2], acc[mi][2], 0, 0, 0); \
        acc[mi][3] = __builtin_amdgcn_mfma_f32_16x16x32_bf16(af[0][mi], bg[0][3], acc[mi][3], 0, 0, 0); \
        if (DOISSUE) G3_PIECE(2 * mi + 1, (KT) + 1) \
        __builtin_amdgcn_sched_barrier(0); } \
      _Pragma("unroll") for (int mi = 0; mi < 4; ++mi) \
        _Pragma("unroll") for (int ni = 0; ni < NTW; ++ni) acc[mi][ni] = __builtin_amdgcn_mfma_f32_16x16x32_bf16(af[1][mi], bg[1][ni], acc[mi][ni], 0, 0, 0); \
      __builtin_amdgcn_s_setprio(0); }
#pragma unroll 1
    for (int kt = 0; kt < nk - 1; ++kt) {
      asm volatile("s_waitcnt vmcnt(0) lgkmcnt(0)" ::: "memory");
      __builtin_amdgcn_s_barrier();
      asm volatile("" ::: "memory");
      G3_STEP(kt, true)
    }
    asm volatile("s_waitcnt vmcnt(0) lgkmcnt(0)" ::: "memory");
    __builtin_amdgcn_s_barrier();
    asm volatile("" ::: "memory");
    G3_STEP(nk - 1, false)
#undef G3_PIECE
#undef G3_STEP
  } else
#pragma unroll 1
  for (int kt = 0; kt < nk; ++kt) {
    asm volatile("s_waitcnt vmcnt(0) lgkmcnt(0)" ::: "memory");
    __builtin_amdgcn_s_barrier();
    asm volatile("" ::: "memory");
    if (kt + 1 < nk) G3_ISSUE(kt + 1)
    const u16* sAs = sbase + (kt & 1) * STAGE;
    const u16* sBs = sAs + 8192;
#pragma unroll 1
    for (int ks = 0; ks < (LEAN ? 2 : 0); ++ks) {
      const int pcol = ((ks * 4 + quad) ^ sz) * 8;
      bf16x8 af[4];
#pragma unroll
      for (int mi = 0; mi < 4; ++mi) af[mi] = *(const bf16x8*)(sAs + (wm * 64 + 16 * mi + r16) * 64 + pcol);
#pragma unroll
      for (int ni = 0; ni < NTW; ++ni) {
        bf16x8 b1 = *(const bf16x8*)(sBs + (wn * (BN / 2) + 16 * ni + r16) * 64 + pcol);
#pragma unroll
        for (int mi = 0; mi < 4; ++mi) acc[mi][ni] = __builtin_amdgcn_mfma_f32_16x16x32_bf16(af[mi], b1, acc[mi][ni], 0, 0, 0);
      }
    }
#pragma unroll
    for (int ks = 0; ks < (LEAN ? 0 : 2); ++ks) {
      const int pcol = ((ks * 4 + quad) ^ sz) * 8;
      bf16x8 af[4], bg[NTW];
#pragma unroll
      for (int mi = 0; mi < 4; ++mi) af[mi] = *(const bf16x8*)(sAs + (wm * 64 + 16 * mi + r16) * 64 + pcol);
#pragma unroll
      for (int ni = 0; ni < NTW; ++ni) bg[ni] = *(const bf16x8*)(sBs + (wn * (BN / 2) + 16 * ni + r16) * 64 + pcol);
#pragma unroll
      for (int mi = 0; mi < 4; ++mi)
#pragma unroll
        for (int ni = 0; ni < NTW; ++ni) acc[mi][ni] = __builtin_amdgcn_mfma_f32_16x16x32_bf16(af[mi], bg[ni], acc[mi][ni], 0, 0, 0);
    }
  }
#undef G3_ISSUE
#undef G3_GLDS
}
template <int NCOLS>
DI void store_tile_bf16(const u16* sC, u16* gdst, long ld, int rows_valid) {
  constexpr int CPR = NCOLS / 8, LS = NCOLS + 8;
  const int tid = TID();
#pragma unroll
  for (int q = 0; q < (128 * CPR) / 256; ++q) {
    const int c = tid + 256 * q, row = c / CPR, ch = c % CPR;
    if (row < rows_valid) *(uint4*)(gdst + (long)row * ld + ch * 8) = *(const uint4*)(sC + row * LS + ch * 8);
  }
}
DI int pair_col(int np, int& which) {
  const int nt = np >> 7, c = np & 127, wn = c >> 6, ni = (c >> 4) & 3, r = c & 15;
  which = ni >> 1;
  return nt * 64 + wn * 32 + (ni & 1) * 16 + r;
}
DI const float* conv_colptr(const Params& P, int l, int mat, int np, long& ld) {
  int which;
  switch (mat) {
    case 0: ld = DIN; return P.in[3] + (long)l * DM * DIN + proj_src_col(np);
    case 1: ld = DIN; return P.in[3] + (long)l * DM * DIN + 2708 + np;
    case 2: ld = DM; return P.in[24] + ((long)(l * 4 + (np >> 10)) * 256) * DM + (np & 1023);
    case 3: ld = DM; return P.in[25] + (long)l * DM * DM + np;
    case 4: { int o = pair_col(np, which); ld = DFF; return (which ? P.in[28] : P.in[27]) + (long)l * DM * DFF + o; }
    case 5: ld = DM; return P.in[29] + (long)l * DFF * DM + np;
    case 6: { int o = pair_col(np, which); ld = 512; return P.in[19] + (long)l * 256 * 512 + which * 256 + o; }
    case 7: ld = 256; return P.in[(np >> 8) ? 9 : 7] + (long)l * 2048 * 256 + (np & 255);
    default: ld = 64; return P.in[(np >> 6) ? 10 : 8] + (long)l * 256 * 64 + (np & 63);
  }
}
DI void phase_convert(const Params& P, int l, float* lds) {
  const int tid = TID();
  if (blockIdx.x < 64) {
    const int kv = blockIdx.x >> 5, ks = blockIdx.x & 31;
    const float* pos = P.in[6] + (long)(l * 2 + kv) * 2048 + ks * 64;
    const float* w1 = P.in[kv ? 9 : 7] + (long)l * 2048 * 256 + (long)ks * 64 * 256 + tid;
    float a = 0.f;
#pragma unroll 8
    for (int k = 0; k < 64; ++k) a += pos[k] * w1[(long)k * 256];
    ((float*)(WSP(P) + WS_CBIAS))[(kv * 32 + ks) * 256 + tid] = a;
  }
  const int NB_[9] = {44, 64, 64, 16, 88, 16, 8, 8, 2};
  const int KB_[9] = {16, 16, 4, 16, 16, 44, 4, 32, 4};
  const size_t OFF_[9] = {WT_IN, WT_G, WT_BR, WT_OUT, WT_GU, WT_D, WT_GLU, WT_C1, WT_C2};
  for (int it = blockIdx.x; it < 4648; it += gridDim.x) {
    int r = it, mat = 0, nbk = 0, kbk = 0; size_t off = 0;
#pragma unroll
    for (int q = 0; q < 9; ++q) { int n = NB_[q] * KB_[q]; if (r >= 0 && r < n) { mat = q; nbk = NB_[q]; kbk = KB_[q]; off = OFF_[q]; r -= 100000; } else if (r >= 0) r -= n; }
    r += 100000;
    const int nb = r / kbk, kb = r % kbk, K = kbk * 64;
    (void)nbk;
    __syncthreads();
    {
      const int n = tid & 63;
      long ld; const float* cp = conv_colptr(P, l, mat, nb * 64 + n, ld);
#pragma unroll 4
      for (int q = 0; q < 16; ++q) { int k = (tid >> 6) + 4 * q; lds[n * 65 + k] = cp[(long)(kb * 64 + k) * ld]; }
    }
    __syncthreads();
    u16* dst = (u16*)(WSP(P) + WS_W + off);
#pragma unroll
    for (int q = 0; q < 2; ++q) {
      int c = tid + 256 * q, n = c >> 3, k8 = (c & 7) * 8;
      const float* sp = lds + n * 65 + k8;
      uint4 v; v.x = pk2(sp[0], sp[1]); v.y = pk2(sp[2], sp[3]); v.z = pk2(sp[4], sp[5]); v.w = pk2(sp[6], sp[7]);
      *(uint4*)(dst + (long)(nb * 64 + n) * K + kb * 64 + k8) = v;
    }
  }
}

DI void st_mma(f32x4 (&st)[4], const u16* sK, const bf16x8 (&bq)[2], int lane) {
  const int r = lane & 15, quad = lane >> 4;
#pragma unroll
  for (int mt = 0; mt < 4; ++mt) {
    f32x4 a = {0.f, 0.f, 0.f, 0.f};
#pragma unroll
    for (int ks = 0; ks < 2; ++ks) {
      bf16x8 kf = *(const bf16x8*)(sK + (16 * mt + r) * 72 + ks * 32 + quad * 8);
      a = __builtin_amdgcn_mfma_f32_16x16x32_bf16(kf, bq[ks], a, 0, 0, 0);
    }
    st[mt] = a;
  }
}
DI void pv_mma(f32x4 (&ot)[4], const u16* sVt, const f32x4 (&p)[4], int lane) {
  const int r = lane & 15, quad = lane >> 4;
#pragma unroll
  for (int ks = 0; ks < 2; ++ks) {
    uint4 pu;
    pu.x = pk2(p[2 * ks][0], p[2 * ks][1]); pu.y = pk2(p[2 * ks][2], p[2 * ks][3]);
    pu.z = pk2(p[2 * ks + 1][0], p[2 * ks + 1][1]); pu.w = pk2(p[2 * ks + 1][2], p[2 * ks + 1][3]);
    bf16x8 pb = __builtin_bit_cast(bf16x8, pu);
#pragma unroll
    for (int dt = 0; dt < 4; ++dt) {
      const u16* vrow = sVt + (16 * dt + r) * 72;
      s16x4 lo = *(const s16x4*)(vrow + ((32 * ks + 4 * quad) ^ (16 * dt)));
      s16x4 hi = *(const s16x4*)(vrow + ((32 * ks + 16 + 4 * quad) ^ (16 * dt)));
      bf16x8 vf = __builtin_shufflevector(lo, hi, 0, 1, 2, 3, 4, 5, 6, 7);
      ot[dt] = __builtin_amdgcn_mfma_f32_16x16x32_bf16(vf, pb, ot[dt], 0, 0, 0);
    }
  }
}
DI void load_tile(u16* dst, const u16* src, long ld) {
  const int tid = TID();
#pragma unroll
  for (int i = 0; i < 2; ++i) {
    int c = tid + 256 * i, row = c >> 3, ch = c & 7;
    uint4 v = *(const uint4*)(src + (long)row * ld + ch * 8);
    *(uint4*)(dst + row * 72 + ch * 8) = v;
  }
}
DI void load_tile_T(u16* dst, const u16* src, long ld) {
  const int tid = TID();
#pragma unroll
  for (int i = 0; i < 2; ++i) {
    int c = tid + 256 * i, row = c >> 3, ch = c & 7;
    uint4 v = *(const uint4*)(src + (long)row * ld + ch * 8);
    const unsigned* vv = (const unsigned*)&v;
#pragma unroll
    for (int q = 0; q < 4; ++q) {
      dst[(ch * 8 + 2 * q) * 72 + row] = (u16)(vv[q] & 0xffff);
      dst[(ch * 8 + 2 * q + 1) * 72 + row] = (u16)(vv[q] >> 16);
    }
  }
}
DI void load_q_nsa(u16* dst, const u16* src, long ld) {
  const int tid = TID();
#pragma unroll
  for (int i = 0; i < 2; ++i) {
    int c = tid + 256 * i, row = c >> 3, ch = c & 7;
    uint4 v = *(const uint4*)(src + (long)(row & 15) * ld + (row >> 4) * 64 + ch * 8);
    *(uint4*)(dst + row * 72 + ch * 8) = v;
  }
}
DI void load_qfrag(bf16x8 (&bq)[2], const u16* sQ, int w, int lane) {
  const int r = lane & 15, quad = lane >> 4;
  bq[0] = *(const bf16x8*)(sQ + (16 * w + r) * 72 + quad * 8);
  bq[1] = *(const bf16x8*)(sQ + (16 * w + r) * 72 + 32 + quad * 8);
}
DI float quad_max(float v) { v = fmaxf(v, __shfl_xor(v, 16)); v = fmaxf(v, __shfl_xor(v, 32)); return v; }
DI float quad_sum(float v) { v += __shfl_xor(v, 16); v += __shfl_xor(v, 32); return v; }

DI void softmax_tile(f32x4 (&st)[4], const bool (&msk)[4][4], float& m, float& l, f32x4 (&ot)[4]) {
  float tm = -1e30f;
#pragma unroll
  for (int mt = 0; mt < 4; ++mt)
#pragma unroll
    for (int j = 0; j < 4; ++j) { float s = st[mt][j] * 0.125f; st[mt][j] = s; if (msk[mt][j]) tm = fmaxf(tm, s); }
  tm = quad_max(tm);
  float mn = fmaxf(m, tm);
  float alpha = __expf(m - mn);
  float ps = 0.f;
#pragma unroll
  for (int mt = 0; mt < 4; ++mt)
#pragma unroll
    for (int j = 0; j < 4; ++j) { float p = msk[mt][j] ? __expf(st[mt][j] - mn) : 0.f; st[mt][j] = p; ps += p; }
  l = l * alpha + ps;
  m = mn;
#pragma unroll
  for (int dt = 0; dt < 4; ++dt)
#pragma unroll
    for (int j = 0; j < 4; ++j) ot[dt][j] *= alpha;
}

DI void phase_rmsnorm(const float* __restrict__ x, const float* __restrict__ wgt, u16* __restrict__ H) {
  const int lane = TID() & 63, w = TID() >> 6;
  const int gw = blockIdx.x * 4 + w, nw = gridDim.x * 4;
  for (int row = gw; row < T_; row += nw) {
    const float4* xr = (const float4*)(x + (long)row * DM);
    float4 v[4]; float s = 0.f;
#pragma unroll
    for (int j = 0; j < 4; ++j) { v[j] = xr[lane + 64 * j]; s += v[j].x * v[j].x + v[j].y * v[j].y + v[j].z * v[j].z + v[j].w * v[j].w; }
    s = wave_sum(s);
    float r = rsqrtf(s * (1.f / DM) + EPS);
#pragma unroll
    for (int j = 0; j < 4; ++j) {
      float4 g = ((const float4*)wgt)[lane + 64 * j];
      uint2 o; o.x = pk2(v[j].x * r * g.x, v[j].y * r * g.y); o.y = pk2(v[j].z * r * g.z, v[j].w * r * g.w);
      *(uint2*)(H + (long)row * DM + (lane + 64 * j) * 4) = o;
    }
  }
}
DI void phase_rope_table(const int* __restrict__ positions, float* __restrict__ COS, float* __restrict__ SIN) {
  const float invf[8] = {1.0f, 0.1939227432012558f, 0.03760603070259094f, 0.007292664609849453f,
                         0.0014142135623842478f, 0.00027424818836152554f, 5.3182957344688475e-05f, 1.0313385246263351e-05f};
  for (int idx = blockIdx.x * 256 + TID(); idx < T_ * 8; idx += gridDim.x * 256) {
    int i = idx & 7;
    float f = invf[0];
#pragma unroll
    for (int q = 1; q < 8; ++q) f = (i == q) ? invf[q] : f;
    float ang = (float)positions[idx >> 3] * f;
    double s, c; sincos_d((double)ang, s, c);
    COS[idx] = (float)c; SIN[idx] = (float)s;
  }
}

struct S5Coef { float ar, ai; float bbr[16], bbi[16]; };
DI void s5_coef(const Params& P, int l, int g, int p, S5Coef& C) {
  float dt = expf(P.in[13][l * 16 + g]);
  float lr = P.in[11][(l * 16 + g) * 64 + p], li = P.in[12][(l * 16 + g) * 64 + p];
  float mag = expf(lr * dt);
  double s, c; sincos_d((double)(li * dt), s, c);
  C.ar = mag * (float)c; C.ai = mag * (float)s;
  float den = lr * lr + li * li;
  float fr = ((C.ar - 1.f) * lr + C.ai * li) / den;
  float fi = (C.ai * lr - (C.ar - 1.f) * li) / den;
  const float* br = P.in[14] + ((long)(l * 16 + g) * 64 + p) * 16;
  const float* bi = P.in[15] + ((long)(l * 16 + g) * 64 + p) * 16;
#pragma unroll
  for (int c2 = 0; c2 < 16; ++c2) {
    float b_r = br[c2], b_i = bi[c2];
    C.bbr[c2] = fr * b_r - fi * b_i;
    C.bbi[c2] = fr * b_i + fi * b_r;
  }
}
DI void s5_load_u(float* su, const u16* PROJ, int b, int chunk, int g, int lane) {
  const u16* src = PROJ + ((long)(b * SEQ + chunk * 64 + lane)) * PW + P_S5U + g * 16;
  uint4 v0 = ((const uint4*)src)[0], v1 = ((const uint4*)src)[1];
  const unsigned* a = (const unsigned*)&v0; const unsigned* c = (const unsigned*)&v1;
  float* d = su + lane * 16;
#pragma unroll
  for (int q = 0; q < 4; ++q) { d[2 * q] = bf2f((u16)(a[q] & 0xffff)); d[2 * q + 1] = bf2f((u16)(a[q] >> 16)); }
#pragma unroll
  for (int q = 0; q < 4; ++q) { d[8 + 2 * q] = bf2f((u16)(c[q] & 0xffff)); d[8 + 2 * q + 1] = bf2f((u16)(c[q] >> 16)); }
}

DI void s5_pass1_item(const Params& P, int l, int it, float* lds) {
  const int lane = TID() & 63, w = TID() >> 6;
  const int gq = it & 3, chunk = (it >> 2) & 63, b = it >> 8;
  const int g = gq * 4 + w;
  const u16* PROJ = (const u16*)(WSP(P) + WS_PROJ);
  float* su = lds + w * 1024;
  S5Coef C; s5_coef(P, l, g, lane, C);
  s5_load_u(su, PROJ, b, chunk, g, lane);
  __syncthreads();
  float xr = 0.f, xi = 0.f;
#pragma unroll 4
  for (int t = 0; t < 64; ++t) {
    const f32x4* up = (const f32x4*)(su + t * 16);
    float br = 0.f, bi = 0.f;
#pragma unroll
    for (int q = 0; q < 4; ++q) {
      f32x4 u = up[q];
#pragma unroll
      for (int e = 0; e < 4; ++e) { br += u[e] * C.bbr[4 * q + e]; bi += u[e] * C.bbi[4 * q + e]; }
    }
    float nr = C.ar * xr - C.ai * xi + br;
    float ni = C.ar * xi + C.ai * xr + bi;
    xr = nr; xi = ni;
  }
  float2* ENDS = (float2*)(WSP(P) + WS_ENDS);
  ENDS[((long)(b * 64 + chunk) * 16 + g) * 64 + lane] = make_float2(xr, xi);
}

DI void s5_carry_item(const Params& P, int l, int it) {
  const int idx = it * 256 + TID();
  const int b = idx >> 10, gp = idx & 1023, g = gp >> 6, p = gp & 63;
  float dt = expf(P.in[13][l * 16 + g]);
  float lr = P.in[11][(l * 16 + g) * 64 + p], li = P.in[12][(l * 16 + g) * 64 + p];
  float mag = expf(lr * dt * 64.f);
  double s, c; sincos_d((double)(li * dt) * 64.0, s, c);
  float ar = mag * (float)c, ai = mag * (float)s;
  const float2* ENDS = (const float2*)(WSP(P) + WS_ENDS);
  float2* CARRY = (float2*)(WSP(P) + WS_CARRY);
  float xr = 0.f, xi = 0.f;
  for (int ch = 0; ch < 64; ++ch) {
    long o = ((long)(b * 64 + ch) * 16 + g) * 64 + p;
    CARRY[o] = make_float2(xr, xi);
    float2 e = ENDS[o];
    float nr = ar * xr - ai * xi + e.x;
    float ni = ar * xi + ai * xr + e.y;
    xr = nr; xi = ni;
  }
}

DI void s5_pass2_item(const Params& P, int l, int it, float* lds) {
  const int lane = TID() & 63, w = TID() >> 6, r16 = lane & 15, quad = lane >> 4;
  const int gq = it & 3, chunk = (it >> 2) & 63, b = it >> 8;
  const int g = gq * 4 + w;
  const u16* PROJ = (const u16*)(WSP(P) + WS_PROJ);
  u16* Y5 = (u16*)(WSP(P) + WS_Y5);
  float* su = lds + w * 1024;
  u16* sX = (u16*)(lds + 4096) + w * (32 * 136);
  S5Coef C; s5_coef(P, l, g, lane, C);
  bf16x8 bfr[4];
#pragma unroll
  for (int ks = 0; ks < 4; ++ks) {
    const float* src = P.in[(ks < 2) ? 16 : 17] + ((long)(l * 16 + g) * 16 + r16) * 64 + (ks & 1) * 32 + quad * 8;
    const float4 v0 = ((const float4*)src)[0], v1 = ((const float4*)src)[1];
    const float sg = (ks < 2) ? 1.f : -1.f;
    uint4 pu; pu.x = pk2(sg * v0.x, sg * v0.y); pu.y = pk2(sg * v0.z, sg * v0.w); pu.z = pk2(sg * v1.x, sg * v1.y); pu.w = pk2(sg * v1.z, sg * v1.w);
    bfr[ks] = __builtin_bit_cast(bf16x8, pu);
  }
  const float dsk = P.in[18][l * 256 + g * 16 + r16];
  s5_load_u(su, PROJ, b, chunk, g, lane);
  __syncthreads();
  const float2 c0 = ((const float2*)(WSP(P) + WS_CARRY))[((long)(b * 64 + chunk) * 16 + g) * 64 + lane];
  float xr = c0.x, xi = c0.y;
  for (int half = 0; half < 2; ++half) {
#pragma unroll 4
    for (int tt = 0; tt < 32; ++tt) {
      const int t = half * 32 + tt;
      const f32x4* up = (const f32x4*)(su + t * 16);
      float br0 = 0.f, bi0 = 0.f, br1 = 0.f, bi1 = 0.f;
#pragma unroll
      for (int q = 0; q < 4; ++q) {
        f32x4 u = up[q];
        br0 += u[0] * C.bbr[4 * q + 0]; bi0 += u[0] * C.bbi[4 * q + 0];
        br1 += u[1] * C.bbr[4 * q + 1]; bi1 += u[1] * C.bbi[4 * q + 1];
        br0 += u[2] * C.bbr[4 * q + 2]; bi0 += u[2] * C.bbi[4 * q + 2];
        br1 += u[3] * C.bbr[4 * q + 3]; bi1 += u[3] * C.bbi[4 * q + 3];
      }
      const float nr = C.ar * xr - C.ai * xi + (br0 + br1);
      const float ni = C.ar * xi + C.ai * xr + (bi0 + bi1);
      xr = nr; xi = ni;
      sX[tt * 136 + lane] = f2bf(xr);
      sX[tt * 136 + 64 + lane] = f2bf(xi);
    }
    __syncthreads();
#pragma unroll
    for (int mt = 0; mt < 2; ++mt) {
      f32x4 acc = {0.f, 0.f, 0.f, 0.f};
#pragma unroll
      for (int ks = 0; ks < 4; ++ks) {
        const bf16x8 af = *(const bf16x8*)(sX + (16 * mt + r16) * 136 + ks * 32 + quad * 8);
        acc = __builtin_amdgcn_mfma_f32_16x16x32_bf16(af, bfr[ks], acc, 0, 0, 0);
      }
#pragma unroll
      for (int j = 0; j < 4; ++j) {
        const int t = half * 32 + 16 * mt + 4 * quad + j;
        const float y = acc[j] + dsk * su[t * 16 + r16];
        Y5[((long)(b * SEQ + chunk * 64 + t)) * 256 + g * 16 + r16] = f2bf(gelu_tanh(y));
      }
    }
    __syncthreads();
  }
}

DI void nsa_prep_item(const Params& P, int l, int it) {
  const int lane = TID() & 63, w = TID() >> 6;
  u16* PROJ = (u16*)(WSP(P) + WS_PROJ);
  u16* QR = (u16*)(WSP(P) + WS_QR);
  const float* COS = (const float*)(WSP(P) + WS_COS);
  const float* SIN = (const float*)(WSP(P) + WS_SIN);
  for (int tt = 0; tt < 4; ++tt) {
    const long t = (long)it * 16 + w * 4 + tt;
    const float cs = COS[t * 8 + (lane & 7)], sn = SIN[t * 8 + (lane & 7)];
#pragma unroll
    for (int g = 0; g < 6; ++g) {
      const int col = (g < 4) ? (P_Q + g * 64) : (g == 4 ? P_KV + 128 : P_KV + 256);
      const float wg = (g < 4) ? P.in[4][l * 64 + lane] : P.in[5][(l * 3 + (g - 3)) * 64 + lane];
      u16* ptr = PROJ + t * PW + col + lane;
      float v = bf2f(*ptr);
      float ss = wave_sum(v * v);
      float y = v * rsqrtf(ss * (1.f / 64.f) + EPS) * wg;
      float pr = __shfl_xor(y, 8);
      float rot = (lane < 8) ? (y * cs - pr * sn) : ((lane < 16) ? (y * cs + pr * sn) : y);
      if (g < 4) { *ptr = f2bf(y); QR[t * 256 + g * 64 + lane] = f2bf(rot); }
      else *ptr = f2bf(rot);
    }
  }
}

DI void cmp1_tile(const Params& P, int l, int ct, u16* sA, u16* sB) {
  const int tid = TID(), lane = tid & 63, w = tid >> 6, r16 = lane & 15, quad = lane >> 4, wm = w >> 1, wn = w & 1;
  const int kv = ct >> 5, mt = (ct >> 1) & 15, nt = ct & 1;
  const u16* PROJ = (const u16*)(WSP(P) + WS_PROJ);
  u16* HID = (u16*)(WSP(P) + WS_HID);
  const u16* apq[4];
#pragma unroll
  for (int q = 0; q < 4; ++q) {
    int row, pc; g3_rowpiece(tid, q, false, row, pc);
    int gr = mt * 128 + row; if (gr > 2039) gr = 2039;
    const int b = gr / 255, n = gr % 255;
    apq[q] = PROJ + ((long)(b * SEQ + 16 * n)) * PW + P_KV + kv * 64 + pc * 8;
  }
  const u16* Bb = (const u16*)(WSP(P) + WS_W + WT_C1) + ((long)(kv * 256 + nt * 128)) * 2048;
  f32x4 acc[4][4];
  gemm3<4>(acc, apq[0], apq[1], apq[2], apq[3], PW,
           g3_ptr(Bb, 2048, tid, 0, false), g3_ptr(Bb, 2048, tid, 1, false), g3_ptr(Bb, 2048, tid, 2, false), g3_ptr(Bb, 2048, tid, 3, false), 2048, sA);
  {
    const float* PART = (const float*)(WSP(P) + WS_CBIAS) + (long)kv * 32 * 256;
#pragma unroll
    for (int ni = 0; ni < 4; ++ni) {
      const int col = nt * 128 + wn * 64 + 16 * ni + r16;
      float bsum = 0.f;
      for (int sl = 0; sl < 32; ++sl) bsum += PART[sl * 256 + col];
#pragma unroll
      for (int mi = 0; mi < 4; ++mi)
#pragma unroll
        for (int j = 0; j < 4; ++j) acc[mi][ni][j] += bsum;
    }
  }
  __syncthreads();
#pragma unroll
  for (int mi = 0; mi < 4; ++mi)
#pragma unroll
    for (int ni = 0; ni < 4; ++ni)
#pragma unroll
      for (int j = 0; j < 4; ++j) sA[(wm * 64 + 16 * mi + 4 * quad + j) * 136 + wn * 64 + 16 * ni + r16] = f2bf(gelu_tanh(acc[mi][ni][j]));
  __syncthreads();
  store_tile_bf16<128>(sA, HID + ((long)kv * 2048 + mt * 128) * 256 + nt * 128, 256, 2040 - mt * 128);
}
DI void cmp2_tile(const Params& P, int l, int ct, u16* sA, u16* sB, float* sSS) {
  const int tid = TID(), lane = tid & 63, w = tid >> 6, r16 = lane & 15, quad = lane >> 4, wm = w >> 1, wn = w & 1;
  const int kv = ct >> 4, mt = ct & 15;
  const u16* HID = (const u16*)(WSP(P) + WS_HID);
  u16* OUT = (u16*)(WSP(P) + (kv ? WS_VC : WS_KC));
  const u16* Ab = HID + ((long)kv * 2048 + mt * 128) * 256;
  const u16* Bb = (const u16*)(WSP(P) + WS_W + WT_C2) + (long)kv * 64 * 256;
  f32x4 acc[4][2];
  gemm3<2>(acc, g3_ptr(Ab, 256, tid, 0, false), g3_ptr(Ab, 256, tid, 1, false), g3_ptr(Ab, 256, tid, 2, false), g3_ptr(Ab, 256, tid, 3, false), 64,
           g3_ptr(Bb, 256, tid, 0, true), g3_ptr(Bb, 256, tid, 1, true), nullptr, nullptr, 256, sA);
  __syncthreads();
  if (tid < 128) sSS[tid] = 0.f;
  __syncthreads();
#pragma unroll
  for (int mi = 0; mi < 4; ++mi)
#pragma unroll
    for (int j = 0; j < 4; ++j) {
      float ss = acc[mi][0][j] * acc[mi][0][j] + acc[mi][1][j] * acc[mi][1][j];
      ss += __shfl_xor(ss, 1); ss += __shfl_xor(ss, 2); ss += __shfl_xor(ss, 4); ss += __shfl_xor(ss, 8);
      if (r16 == 0) atomicAdd(&sSS[wm * 64 + 16 * mi + 4 * quad + j], ss);
    }
  __syncthreads();
#pragma unroll
  for (int mi = 0; mi < 4; ++mi)
#pragma unroll
    for (int j = 0; j < 4; ++j) {
      const int rl = wm * 64 + 16 * mi + 4 * quad + j, row = mt * 128 + rl;
      const float sc = (kv == 0) ? rsqrtf(sSS[rl] * (1.f / 64.f) + EPS) : 1.f;
      if (row < 2040) {
        int b = row / 255, n = row % 255;
#pragma unroll
        for (int ni = 0; ni < 2; ++ni) {
          int col = wn * 32 + 16 * ni + r16;
          float v = acc[mi][ni][j] * sc;
          if (kv == 0) v *= P.in[5][(l * 3 + 0) * 64 + col];
          OUT[((long)(b * 256 + n)) * 64 + col] = f2bf(v);
        }
      }
    }
}

DI void gdn_p1_item(const Params& P, int l, int it, float* lds) {
  const int tid = TID(), lane = tid & 63, w = tid >> 6, r16 = lane & 15, quad = lane >> 4;
  const int chunk = it & 63, h = (it >> 6) & 3, b = it >> 8;
  const long ci = it;
  const u16* PROJ = (const u16*)(WSP(P) + WS_PROJ);
  float* sq = lds;
  float* sk = lds + 64 * 65;
  float* sv = lds + 2 * 64 * 65;
  float* sG = lds + 3 * 64 * 65;
  float* sBeta = sG + 64;
  float* sg = sBeta + 64;
  u16* sQb = (u16*)(sg + 64);
  u16* sKb = sQb + 64 * 72;
  const float* cw = P.in[20] + (long)l * 4 * 768;
  if (tid < 192) {
    const int cp = tid % 96, th = tid / 96;
    const int c0 = 2 * cp, which = c0 >> 6, d = c0 & 63, C = which * 256 + h * 64 + d;
    float w0[4], w1[4];
#pragma unroll
    for (int k = 0; k < 4; ++k) { w0[k] = cw[k * 768 + C]; w1[k] = cw[k * 768 + C + 1]; }
    unsigned v[35];
    const int s0 = chunk * 64 + th * 32 - 3;
    const u16* src = PROJ + ((long)(b * SEQ + s0)) * PW + P_GQKV + C;
#pragma unroll
    for (int k = 0; k < 35; ++k) v[k] = (s0 + k >= 0) ? *(const unsigned*)(src + (long)k * PW) : 0u;
    float* dst = lds + which * 64 * 65 + (th * 32) * 65 + d;
#pragma unroll
    for (int tt = 0; tt < 32; ++tt) {
      float a0 = 0.f, a1 = 0.f;
#pragma unroll
      for (int k = 0; k < 4; ++k) { a0 += w0[k] * bf2f((u16)(v[tt + k] & 0xffff)); a1 += w1[k] * bf2f((u16)(v[tt + k] >> 16)); }
      dst[tt * 65] = siluf_(a0); dst[tt * 65 + 1] = siluf_(a1);
    }
  }
  __syncthreads();
  if (tid < 128) {
    float* base = (tid < 64) ? sq : sk;
    u16* bb = (tid < 64) ? sQb : sKb;
    const int row = tid & 63;
    float ss = 0.f;
#pragma unroll 8
    for (int d = 0; d < 64; ++d) { float x = base[row * 65 + d]; ss += x * x; }
    const float sc = rsqrtf(ss + EPS) * ((tid < 64) ? 0.125f : 1.f);
#pragma unroll 8
    for (int d = 0; d < 64; d += 2) {
      const float x0 = base[row * 65 + d] * sc, x1 = base[row * 65 + d + 1] * sc;
      base[row * 65 + d] = x0; base[row * 65 + d + 1] = x1;
      *(unsigned*)(bb + row * 72 + d) = pk2(x0, x1);
    }
  } else if (tid < 192) {
    const int row = tid - 128;
    const long t = (long)(b * SEQ + chunk * 64 + row);
    const float bl = bf2f(PROJ[t * PW + P_GB + h]);
    const float al = bf2f(PROJ[t * PW + P_GA + h]);
    sBeta[row] = sigmoidf_(bl);
    sg[row] = -expf(P.in[21][l * 4 + h]) * softplusf_(al + P.in[22][l * 4 + h]);
  }
  __syncthreads();
  if (tid < 64) {
    float x = sg[tid];
#pragma unroll
    for (int o = 1; o < 64; o <<= 1) { float u = __shfl_up(x, o); if (tid >= o) x += u; }
    sG[tid] = x;
    ((float*)(WSP(P) + WS_GG))[ci * 64 + tid] = x;
  }
  __syncthreads();
  f32x4 lreg[4];
  {
    const f32x4 Gi4 = *(const f32x4*)(sG + 16 * w + 4 * quad);
    const f32x4 Bi4 = *(const f32x4*)(sBeta + 16 * w + 4 * quad);
    u16* GA = (u16*)(WSP(P) + WS_GA) + ci * 4096;
#pragma unroll
    for (int nt = 0; nt < 4; ++nt) {
      f32x4 aq = {0.f, 0.f, 0.f, 0.f}, ak = {0.f, 0.f, 0.f, 0.f};
#pragma unroll
      for (int ks = 0; ks < 2; ++ks) {
        const bf16x8 fq = *(const bf16x8*)(sQb + (16 * w + r16) * 72 + ks * 32 + quad * 8);
        const bf16x8 fk = *(const bf16x8*)(sKb + (16 * w + r16) * 72 + ks * 32 + quad * 8);
        const bf16x8 fb = *(const bf16x8*)(sKb + (16 * nt + r16) * 72 + ks * 32 + quad * 8);
        aq = __builtin_amdgcn_mfma_f32_16x16x32_bf16(fq, fb, aq, 0, 0, 0);
        ak = __builtin_amdgcn_mfma_f32_16x16x32_bf16(fk, fb, ak, 0, 0, 0);
      }
      const int j = 16 * nt + r16;
      const float Gj = sG[j];
#pragma unroll
      for (int jj = 0; jj < 4; ++jj) {
        const int i = 16 * w + 4 * quad + jj;
        const float dec = __expf(Gi4[jj] - Gj);
        GA[i * 64 + j] = f2bf((j <= i) ? aq[jj] * dec : 0.f);
        const float lv = (j < i) ? Bi4[jj] * ak[jj] * dec : 0.f;
        sq[i * 65 + j] = lv;
        lreg[nt][jj] = lv;
      }
    }
  }
  {
    u16* GQ = (u16*)(WSP(P) + WS_GQ) + ci * 4096;
#pragma unroll
    for (int q = 0; q < 2; ++q) { const int c = tid + 256 * q, row = c >> 3, ch = c & 7; *(uint4*)(GQ + row * 64 + ch * 8) = *(const uint4*)(sQb + row * 72 + ch * 8); }
    const int i = tid >> 2, j0 = (tid & 3) * 16;
    u16* GK = (u16*)(WSP(P) + WS_GK) + ci * 4096 + i * 64 + j0;
    unsigned ok[8];
#pragma unroll
    for (int q = 0; q < 8; ++q) ok[q] = pk2(sk[(j0 + 2 * q) * 65 + i], sk[(j0 + 2 * q + 1) * 65 + i]);
    ((uint4*)GK)[0] = make_uint4(ok[0], ok[1], ok[2], ok[3]); ((uint4*)GK)[1] = make_uint4(ok[4], ok[5], ok[6], ok[7]);
  }
  __syncthreads();
  u16* sLb = sQb;
  u16* sXT = sKb;
  {
    const int i = tid >> 2, j0 = (tid & 3) * 16;
    const float bi = sBeta[i], eg = __expf(sG[i]);
#pragma unroll
    for (int jj = 0; jj < 16; ++jj) { sv[i * 65 + j0 + jj] *= bi; sk[i * 65 + j0 + jj] *= bi * eg; }
#pragma unroll
    for (int nt = 0; nt < 4; ++nt)
#pragma unroll
      for (int jj = 0; jj < 4; ++jj) sLb[(16 * w + 4 * quad + jj) * 72 + 16 * nt + r16] = f2bf(lreg[nt][jj]);
  }
  __syncthreads();
#pragma unroll 1
  for (int bi = 0; bi < 4; ++bi) {
    if (tid < 128) {
      float* buf = (tid < 64) ? sv : sk;
      const int col = tid & 63;
      float x[16];
#pragma unroll
      for (int r = 0; r < 16; ++r) {
        float a0 = buf[(16 * bi + r) * 65 + col], a1 = 0.f;
#pragma unroll
        for (int j = 0; j + 1 < r; j += 2) { a0 -= sq[(16 * bi + r) * 65 + 16 * bi + j] * x[j]; a1 -= sq[(16 * bi + r) * 65 + 16 * bi + j + 1] * x[j + 1]; }
        if (r & 1) a0 -= sq[(16 * bi + r) * 65 + 16 * bi + r - 1] * x[r - 1];
        x[r] = a0 + a1;
        buf[(16 * bi + r) * 65 + col] = x[r];
      }
      uint4 p0, p1;
      p0.x = pk2(x[0], x[1]); p0.y = pk2(x[2], x[3]); p0.z = pk2(x[4], x[5]); p0.w = pk2(x[6], x[7]);
      p1.x = pk2(x[8], x[9]); p1.y = pk2(x[10], x[11]); p1.z = pk2(x[12], x[13]); p1.w = pk2(x[14], x[15]);
      *(uint4*)(sXT + tid * 24) = p0; *(uint4*)(sXT + tid * 24 + 8) = p1;
    }
    __syncthreads();
    if (bi < 3) {
#pragma unroll
      for (int q = 0; q < 2; ++q) {
        const int nt = 2 * w + q, colg = 16 * nt + r16;
        bf16x8 bx = *(const bf16x8*)(sXT + colg * 24 + (quad & 1) * 8);
        if (quad >= 2) bx = (bf16x8){0, 0, 0, 0, 0, 0, 0, 0};
        float* buf = (colg < 64) ? sv : sk;
        const int cc = colg & 63;
        for (int bk = bi + 1; bk < 4; ++bk) {
          const bf16x8 al = *(const bf16x8*)(sLb + (16 * bk + r16) * 72 + 16 * bi + quad * 8);
          f32x4 c = {0.f, 0.f, 0.f, 0.f};
          c = __builtin_amdgcn_mfma_f32_16x16x32_bf16(al, bx, c, 0, 0, 0);
#pragma unroll
          for (int jj = 0; jj < 4; ++jj) buf[(16 * bk + 4 * quad + jj) * 65 + cc] -= c[jj];
        }
      }
    }
    __syncthreads();
  }
  {
    const int i = tid >> 2, j0 = (tid & 3) * 16;
    u16* GU = (u16*)(WSP(P) + WS_GU) + ci * 4096 + i * 64 + j0;
    u16* GW = (u16*)(WSP(P) + WS_GW) + ci * 4096 + i * 64 + j0;
    unsigned ou[8], ow[8];
#pragma unroll
    for (int q = 0; q < 8; ++q) {
      ou[q] = pk2(sv[i * 65 + j0 + 2 * q], sv[i * 65 + j0 + 2 * q + 1]);
      ow[q] = pk2(sk[i * 65 + j0 + 2 * q], sk[i * 65 + j0 + 2 * q + 1]);
    }
    ((uint4*)GU)[0] = make_uint4(ou[0], ou[1], ou[2], ou[3]); ((uint4*)GU)[1] = make_uint4(ou[4], ou[5], ou[6], ou[7]);
    ((uint4*)GW)[0] = make_uint4(ow[0], ow[1], ow[2], ow[3]); ((uint4*)GW)[1] = make_uint4(ow[4], ow[5], ow[6], ow[7]);
  }
}

DI void unpack8(const u16* p, float (&o)[8]) {
  uint4 v = *(const uint4*)p;
  o[0] = bf2f((u16)(v.x & 0xffff)); o[1] = bf2f((u16)(v.x >> 16));
  o[2] = bf2f((u16)(v.y & 0xffff)); o[3] = bf2f((u16)(v.y >> 16));
  o[4] = bf2f((u16)(v.z & 0xffff)); o[5] = bf2f((u16)(v.z >> 16));
  o[6] = bf2f((u16)(v.w & 0xffff)); o[7] = bf2f((u16)(v.w >> 16));
}
DI void st_kt(u16* sKt, int c8, int row, uint4 k) {
  sKt[(c8 + 0) * 72 + row] = (u16)(k.x & 0xffff); sKt[(c8 + 1) * 72 + row] = (u16)(k.x >> 16);
  sKt[(c8 + 2) * 72 + row] = (u16)(k.y & 0xffff); sKt[(c8 + 3) * 72 + row] = (u16)(k.y >> 16);
  sKt[(c8 + 4) * 72 + row] = (u16)(k.z & 0xffff); sKt[(c8 + 5) * 72 + row] = (u16)(k.z >> 16);
  sKt[(c8 + 6) * 72 + row] = (u16)(k.w & 0xffff); sKt[(c8 + 7) * 72 + row] = (u16)(k.w >> 16);
}
DI uint2 pack4bf(const f32x4& v) { uint2 r; r.x = pk2(v[0], v[1]); r.y = pk2(v[2], v[3]); return r; }
DI void gdn_p2_item(const Params& P, int it, float* lds) {
  const int tid = TID(), lane = tid & 63, w = tid >> 6, r16 = lane & 15, quad = lane >> 4;
  const int es = it & 3, bh = it >> 2, b = bh >> 2, h = bh & 3;
  u16* sW = (u16*)lds;
  u16* sQ = sW + 64 * 72;
  u16* sAm = sQ + 64 * 72;
  u16* sKt = sAm + 64 * 72;
  u16* sSt = sKt + 64 * 72;
  u16* sVnT = sSt + 16 * 72;
  u16* sVdT = sVnT + 16 * 72;
  float* sG = (float*)(sVdT + 16 * 72);
  const u16* GQ = (const u16*)(WSP(P) + WS_GQ); const u16* GK = (const u16*)(WSP(P) + WS_GK);
  const u16* GU = (const u16*)(WSP(P) + WS_GU); const u16* GW = (const u16*)(WSP(P) + WS_GW);
  const u16* GA = (const u16*)(WSP(P) + WS_GA); const float* GG = (const float*)(WSP(P) + WS_GG);
  u16* ORAW = (u16*)(WSP(P) + WS_OM) + (long)2 * T_ * 256;
  f32x4 S = {0.f, 0.f, 0.f, 0.f};
  const int irow = 16 * w + 4 * quad;
  uint4 rw0, rw1, rq0, rq1, ra0, ra1, rk0, rk1; u16 ru0, ru1, ru2, ru3; float rg = 0.f;
  const int c0 = tid, c1 = tid + 256;
  const long off0 = (c0 >> 3) * 64 + (c0 & 7) * 8, off1 = (c1 >> 3) * 64 + (c1 & 7) * 8;
#define GDN_GLOAD(CH) { long ci_ = (long)bh * 64 + (CH); \
    rw0 = *(const uint4*)(GW + ci_ * 4096 + off0); rw1 = *(const uint4*)(GW + ci_ * 4096 + off1); \
    rq0 = *(const uint4*)(GQ + ci_ * 4096 + off0); rq1 = *(const uint4*)(GQ + ci_ * 4096 + off1); \
    ra0 = *(const uint4*)(GA + ci_ * 4096 + off0); ra1 = *(const uint4*)(GA + ci_ * 4096 + off1); \
    rk0 = *(const uint4*)(GK + ci_ * 4096 + off0); rk1 = *(const uint4*)(GK + ci_ * 4096 + off1); \
    const u16* up_ = GU + ci_ * 4096 + irow * 64 + es * 16 + r16; \
    ru0 = up_[0]; ru1 = up_[64]; ru2 = up_[128]; ru3 = up_[192]; \
    if (tid < 64) rg = GG[ci_ * 64 + tid]; }
  GDN_GLOAD(0)
  for (int ch = 0; ch < 64; ++ch) {
    __syncthreads();
    {
      const int row0 = c0 >> 3, c80 = (c0 & 7) * 8, row1 = c1 >> 3, c81 = (c1 & 7) * 8;
      *(uint4*)(sW + row0 * 72 + c80) = rw0; *(uint4*)(sW + row1 * 72 + c81) = rw1;
      *(uint4*)(sQ + row0 * 72 + c80) = rq0; *(uint4*)(sQ + row1 * 72 + c81) = rq1;
      *(uint4*)(sAm + row0 * 72 + c80) = ra0; *(uint4*)(sAm + row1 * 72 + c81) = ra1;
      *(uint4*)(sKt + row0 * 72 + c80) = rk0; *(uint4*)(sKt + row1 * 72 + c81) = rk1;
    }
    if (tid < 64) sG[tid] = rg;
    *(uint2*)(sSt + r16 * 72 + irow) = pack4bf(S);
    const f32x4 uc = {bf2f(ru0), bf2f(ru1), bf2f(ru2), bf2f(ru3)};
    __syncthreads();
    if (ch + 1 < 64) GDN_GLOAD(ch + 1)
    f32x4 ws = {0.f, 0.f, 0.f, 0.f}, qs = {0.f, 0.f, 0.f, 0.f};
#pragma unroll
    for (int ks = 0; ks < 2; ++ks) {
      const bf16x8 bS = *(const bf16x8*)(sSt + r16 * 72 + ks * 32 + quad * 8);
      const bf16x8 aW = *(const bf16x8*)(sW + (16 * w + r16) * 72 + ks * 32 + quad * 8);
      const bf16x8 aQ = *(const bf16x8*)(sQ + (16 * w + r16) * 72 + ks * 32 + quad * 8);
      ws = __builtin_amdgcn_mfma_f32_16x16x32_bf16(aW, bS, ws, 0, 0, 0);
      qs = __builtin_amdgcn_mfma_f32_16x16x32_bf16(aQ, bS, qs, 0, 0, 0);
    }
    const float Gl = sG[63];
    const f32x4 G4 = *(const f32x4*)(sG + irow);
    f32x4 vn, vd;
#pragma unroll
    for (int j = 0; j < 4; ++j) { vn[j] = uc[j] - ws[j]; vd[j] = vn[j] * __expf(Gl - G4[j]); }
    *(uint2*)(sVnT + r16 * 72 + irow) = pack4bf(vn);
    *(uint2*)(sVdT + r16 * 72 + irow) = pack4bf(vd);
    __syncthreads();
    f32x4 av = {0.f, 0.f, 0.f, 0.f}, kv = {0.f, 0.f, 0.f, 0.f};
#pragma unroll
    for (int ks = 0; ks < 2; ++ks) {
      const bf16x8 bVn = *(const bf16x8*)(sVnT + r16 * 72 + ks * 32 + quad * 8);
      const bf16x8 bVd = *(const bf16x8*)(sVdT + r16 * 72 + ks * 32 + quad * 8);
      const bf16x8 aA = *(const bf16x8*)(sAm + (16 * w + r16) * 72 + ks * 32 + quad * 8);
      const bf16x8 aK = *(const bf16x8*)(sKt + (16 * w + r16) * 72 + ks * 32 + quad * 8);
      av = __builtin_amdgcn_mfma_f32_16x16x32_bf16(aA, bVn, av, 0, 0, 0);
      kv = __builtin_amdgcn_mfma_f32_16x16x32_bf16(aK, bVd, kv, 0, 0, 0);
    }
    {
      u16* op = ORAW + ((long)(b * SEQ + ch * 64 + irow)) * 256 + h * 64 + es * 16 + r16;
#pragma unroll
      for (int j = 0; j < 4; ++j) op[j * 256] = f2bf(__expf(G4[j]) * qs[j] + av[j]);
    }
    const float gl = __expf(Gl);
#pragma unroll
    for (int j = 0; j < 4; ++j) S[j] = S[j] * gl + kv[j];
  }
#undef GDN_GLOAD
}
DI void gdn_post_item(const Params& P, int l, int it) {
  const int lane = TID() & 63, w = TID() >> 6;
  const u16* PROJ = (const u16*)(WSP(P) + WS_PROJ);
  u16* O = (u16*)(WSP(P) + WS_OM) + (long)2 * T_ * 256;
  const float wn = P.in[23][l * 64 + lane];
#pragma unroll 4
  for (int q = 0; q < 16; ++q) {
    long t = (long)it * 16 + w * 4 + (q >> 2); int h = q & 3;
    float o = bf2f(O[t * 256 + h * 64 + lane]);
    float ss = wave_sum(o * o);
    float y = o * rsqrtf(ss * (1.f / 64.f) + EPS) * wn;
    float z = bf2f(PROJ[t * PW + P_GZ + h * 64 + lane]);
    O[t * 256 + h * 64 + lane] = f2bf(y * siluf_(z));
  }
}

DI void kv_gload(uint4& k0, uint4& k1, uint4& v0, uint4& v1, const u16* ksrc, const u16* vsrc, long ld) {
  const int tid = TID(), r0 = tid >> 3, ch = tid & 7;
  k0 = *(const uint4*)(ksrc + (long)r0 * ld + ch * 8); k1 = *(const uint4*)(ksrc + (long)(r0 + 32) * ld + ch * 8);
  v0 = *(const uint4*)(vsrc + (long)r0 * ld + ch * 8); v1 = *(const uint4*)(vsrc + (long)(r0 + 32) * ld + ch * 8);
}
DI void k_gload(uint4& k0, uint4& k1, const u16* ksrc, long ld) {
  const int tid = TID(), r0 = tid >> 3, ch = tid & 7;
  k0 = *(const uint4*)(ksrc + (long)r0 * ld + ch * 8); k1 = *(const uint4*)(ksrc + (long)(r0 + 32) * ld + ch * 8);
}
DI void k_store(const uint4& k0, const uint4& k1, u16* sK) {
  const int tid = TID(), r0 = tid >> 3, ch = tid & 7;
  *(uint4*)(sK + r0 * 72 + ch * 8) = k0; *(uint4*)(sK + (r0 + 32) * 72 + ch * 8) = k1;
}
DI void kv_store(const uint4& k0, const uint4& k1, const uint4& v0, const uint4& v1, u16* sK, u16* sVt) {
  const int tid = TID(), r0 = tid >> 3, ch = tid & 7;
  *(uint4*)(sK + r0 * 72 + ch * 8) = k0; *(uint4*)(sK + (r0 + 32) * 72 + ch * 8) = k1;
  const int ksw = 16 * (ch >> 1);
  st_kt(sVt, ch * 8, r0 ^ ksw, v0); st_kt(sVt, ch * 8, (r0 + 32) ^ ksw, v1);
}
DI void sb_attn_item(const Params& P, int it, u16* sQ, u16* sK, u16* sVt) {
  const int tid = TID(), lane = tid & 63, w = tid >> 6, r16 = lane & 15, quad = lane >> 4;
  const int qb = 63 - (it >> 5), bh = it & 31, b = bh >> 2, h = bh & 3;
  const u16* PROJ = (const u16*)(WSP(P) + WS_PROJ);
  u16* OUT = (u16*)(WSP(P) + WS_OM) + (long)3 * T_ * 256;
  const long tb = (long)b * SEQ;
  load_tile(sQ, PROJ + (tb + qb * 64) * PW + P_SB + h * 64, PW);
  __syncthreads();
  bf16x8 bq[2]; load_qfrag(bq, sQ, w, lane);
  const int tq = qb * 64 + 16 * w + r16;
  f32x4 ot[4];
#pragma unroll
  for (int dt = 0; dt < 4; ++dt) ot[dt] = (f32x4){0.f, 0.f, 0.f, 0.f};
  float R = 0.f;
  uint4 pk0, pk1, pv0, pv1;
  kv_gload(pk0, pk1, pv0, pv1, PROJ + (tb + qb * 64) * PW + P_SB + 256 + h * 64, PROJ + (tb + qb * 64) * PW + P_SB + 512 + h * 64, PW);
  for (int kb = qb; kb >= 0; --kb) {
    if (__syncthreads_and(R < -104.f)) break;
    kv_store(pk0, pk1, pv0, pv1, sK, sVt);
    __syncthreads();
    if (kb > 0) kv_gload(pk0, pk1, pv0, pv1, PROJ + (tb + (kb - 1) * 64) * PW + P_SB + 256 + h * 64, PROJ + (tb + (kb - 1) * 64) * PW + P_SB + 512 + h * 64, PW);
    f32x4 st[4];
    st_mma(st, sK, bq, lane);
    float gs[4], zz[4][4], x[4][4];
#pragma unroll
    for (int mt = 0; mt < 4; ++mt) {
      float g = 0.f;
#pragma unroll
      for (int j = 0; j < 4; ++j) {
        int s = kb * 64 + 16 * mt + 4 * quad + j;
        float z = st[mt][j] * 0.125f;
        float sp = softplusf_(z);
        bool mk = s < tq;
        x[mt][j] = mk ? -sp : 0.f;
        zz[mt][j] = mk ? (z - sp) : -1e30f;
        g += x[mt][j];
      }
      gs[mt] = g;
    }
    float hm = 0.f, tot_all = 0.f;
    f32x4 pw[4];
#pragma unroll
    for (int mt = 3; mt >= 0; --mt) {
      float g = gs[mt];
      float v1 = __shfl_down(g, 16), v2 = __shfl_down(g, 32), v3 = __shfl_down(g, 48);
      float hq = (quad < 3 ? v1 : 0.f) + (quad < 2 ? v2 : 0.f) + (quad < 1 ? v3 : 0.f);
      float tot = quad_sum(g);
      float base = R + hm + hq;
      float e3 = 0.f, e2 = x[mt][3], e1 = e2 + x[mt][2], e0 = e1 + x[mt][1];
      pw[mt][0] = __expf(zz[mt][0] + base + e0);
      pw[mt][1] = __expf(zz[mt][1] + base + e1);
      pw[mt][2] = __expf(zz[mt][2] + base + e2);
      pw[mt][3] = __expf(zz[mt][3] + base + e3);
      hm += tot; tot_all += tot;
    }
    R += tot_all;
    pv_mma(ot, sVt, pw, lane);
  }
  const long t = tb + tq;
#pragma unroll
  for (int dt = 0; dt < 4; ++dt) {
    uint2 ov; ov.x = pk2(ot[dt][0], ot[dt][1]); ov.y = pk2(ot[dt][2], ot[dt][3]);
    *(uint2*)(OUT + t * 256 + h * 64 + 16 * dt + 4 * quad) = ov;
  }
}

DI void win_attn_item(const Params& P, int it, u16* sQ, u16* sKunused, u16* sVunused) {
  const int tid = TID(), lane = tid & 63, w = tid >> 6, r16 = lane & 15, quad = lane >> 4;
  const int tbk = 127 - (it >> 3), b = it & 7;
  u16* sK = sQ + 128 * 72;
  u16* sVt = sK + 64 * 72;
  (void)sKunused; (void)sVunused;
  const u16* PROJ = (const u16*)(WSP(P) + WS_PROJ);
  const u16* QR = (const u16*)(WSP(P) + WS_QR);
  u16* OW = (u16*)(WSP(P) + WS_OW);
  const long tb = (long)b * SEQ;
  const int t0 = tbk * 32;
#pragma unroll
  for (int i = 0; i < 4; ++i) {
    const int c = tid + 256 * i, row = c >> 3, ch = c & 7;
    *(uint4*)(sQ + row * 72 + ch * 8) = *(const uint4*)(QR + (tb + t0 + (row & 31)) * 256 + (row >> 5) * 64 + ch * 8);
  }
  __syncthreads();
  bf16x8 bq[2][2];
  int tq[2];
#pragma unroll
  for (int qt = 0; qt < 2; ++qt) {
    const int rowq = 32 * w + 16 * qt + r16;
    bq[qt][0] = *(const bf16x8*)(sQ + rowq * 72 + quad * 8);
    bq[qt][1] = *(const bf16x8*)(sQ + rowq * 72 + 32 + quad * 8);
    tq[qt] = t0 + 16 * qt + r16;
  }
  f32x4 ot[2][4];
#pragma unroll
  for (int qt = 0; qt < 2; ++qt)
#pragma unroll
    for (int dt = 0; dt < 4; ++dt) ot[qt][dt] = (f32x4){0.f, 0.f, 0.f, 0.f};
  float m[2] = {-1e30f, -1e30f}, lsum[2] = {0.f, 0.f};
  const int lo = (t0 - 511) > 0 ? (t0 - 511) : 0;
  const int kb_lo = lo >> 6, kb_hi = (t0 + 31) >> 6;
  uint4 pk0, pk1, pv0, pv1;
  kv_gload(pk0, pk1, pv0, pv1, PROJ + (tb + kb_lo * 64) * PW + P_KV + 256, PROJ + (tb + kb_lo * 64) * PW + P_KV + 320, PW);
  for (int kb = kb_lo; kb <= kb_hi; ++kb) {
    __syncthreads();
    kv_store(pk0, pk1, pv0, pv1, sK, sVt);
    __syncthreads();
    if (kb < kb_hi) kv_gload(pk0, pk1, pv0, pv1, PROJ + (tb + (kb + 1) * 64) * PW + P_KV + 256, PROJ + (tb + (kb + 1) * 64) * PW + P_KV + 320, PW);
#pragma unroll
    for (int qt = 0; qt < 2; ++qt) {
      f32x4 st[4];
      st_mma(st, sK, bq[qt], lane);
      bool msk[4][4];
#pragma unroll
      for (int mt = 0; mt < 4; ++mt)
#pragma unroll
        for (int j = 0; j < 4; ++j) { int s = kb * 64 + 16 * mt + 4 * quad + j; int df = tq[qt] - s; msk[mt][j] = (df >= 0) && (df < 512); }
      softmax_tile(st, msk, m[qt], lsum[qt], ot[qt]);
      pv_mma(ot[qt], sVt, st, lane);
    }
  }
#pragma unroll
  for (int qt = 0; qt < 2; ++qt) {
    const float ls = quad_sum(lsum[qt]);
    const float inv = 1.f / fmaxf(ls, 1e-30f);
    const long t = tb + tq[qt];
#pragma unroll
    for (int dt = 0; dt < 4; ++dt) {
      uint2 ov; ov.x = pk2(ot[qt][dt][0] * inv, ot[qt][dt][1] * inv); ov.y = pk2(ot[qt][dt][2] * inv, ot[qt][dt][3] * inv);
      *(uint2*)(OW + t * 256 + w * 64 + 16 * dt + 4 * quad) = ov;
    }
  }
}

DI void cmp_attn_item(const Params& P, int it, u16* sQ, u16* sK, u16* sVt, float* sImp) {
  const int tid = TID(), lane = tid & 63, w = tid >> 6, r16 = lane & 15, quad = lane >> 4;
  const int tbk = 255 - (it >> 3), b = it & 7;
  const u16* PROJ = (const u16*)(WSP(P) + WS_PROJ);
  const u16* KC = (const u16*)(WSP(P) + WS_KC) + (long)b * 256 * 64;
  const u16* VC = (const u16*)(WSP(P) + WS_VC) + (long)b * 256 * 64;
  u16* OC = (u16*)(WSP(P) + WS_OC);
  u64* SEL = (u64*)(WSP(P) + WS_SEL);
  const long tb = (long)b * SEQ;
  const int t0 = tbk * 16;
  load_q_nsa(sQ, PROJ + (tb + t0) * PW + P_Q, PW);
  for (int e = tid; e < 4 * 16 * 64; e += 256) sImp[e] = 0.f;
  __syncthreads();
  bf16x8 bq[2]; load_qfrag(bq, sQ, w, lane);
  const int tq = t0 + r16;
  const int nv = (tq >= 31) ? ((tq - 31) >> 4) + 1 : 0;
  const int nvmax = (t0 + 15 >= 31) ? ((t0 + 15 - 31) >> 4) + 1 : 0;
  const int ntile = (nvmax + 63) >> 6;
  float m = -1e30f, lsum = 0.f;
  uint4 pk0, pk1, pv0, pv1;
  if (ntile > 0) k_gload(pk0, pk1, KC, 64);
  for (int kt = 0; kt < ntile; ++kt) {
    __syncthreads();
    k_store(pk0, pk1, sK);
    __syncthreads();
    if (kt + 1 < ntile) k_gload(pk0, pk1, KC + (kt + 1) * 64 * 64, 64);
    f32x4 st[4];
    st_mma(st, sK, bq, lane);
    float tm = -1e30f;
#pragma unroll
    for (int mt = 0; mt < 4; ++mt)
#pragma unroll
      for (int j = 0; j < 4; ++j) { int n = kt * 64 + 16 * mt + 4 * quad + j; float s = st[mt][j] * 0.125f; st[mt][j] = s; if (n < nv) tm = fmaxf(tm, s); }
    tm = quad_max(tm);
    float mn = fmaxf(m, tm);
    float ps = 0.f;
#pragma unroll
    for (int mt = 0; mt < 4; ++mt)
#pragma unroll
      for (int j = 0; j < 4; ++j) { int n = kt * 64 + 16 * mt + 4 * quad + j; if (n < nv) ps += __expf(st[mt][j] - mn); }
    lsum = lsum * __expf(m - mn) + ps;
    m = mn;
  }
  lsum = quad_sum(lsum);
  const float inv = (lsum > 0.f) ? 1.f / lsum : 0.f;
  f32x4 ot[4];
#pragma unroll
  for (int dt = 0; dt < 4; ++dt) ot[dt] = (f32x4){0.f, 0.f, 0.f, 0.f};
  float carry = 0.f;
  if (ntile > 0) kv_gload(pk0, pk1, pv0, pv1, KC, VC, 64);
  for (int kt = 0; kt < ntile; ++kt) {
    __syncthreads();
    kv_store(pk0, pk1, pv0, pv1, sK, sVt);
    __syncthreads();
    if (kt + 1 < ntile) kv_gload(pk0, pk1, pv0, pv1, KC + (kt + 1) * 64 * 64, VC + (kt + 1) * 64 * 64, 64);
    f32x4 st[4];
    st_mma(st, sK, bq, lane);
#pragma unroll
    for (int mt = 0; mt < 4; ++mt)
#pragma unroll
      for (int j = 0; j < 4; ++j) { int n = kt * 64 + 16 * mt + 4 * quad + j; st[mt][j] = (n < nv) ? __expf(st[mt][j] * 0.125f - m) * inv : 0.f; }
    pv_mma(ot, sVt, st, lane);
    float prevlast = carry;
#pragma unroll
    for (int mt = 0; mt < 4; ++mt) {
      float pl = st[mt][3];
      float fd = __shfl_up(pl, 16);
      float pprev = (quad > 0) ? fd : prevlast;
      float v = st[mt][0] + st[mt][1] + st[mt][2] + st[mt][3] + pprev;
      sImp[(w * 16 + r16) * 64 + kt * 16 + mt * 4 + quad] = v;
      prevlast = __shfl_down(pl, 48);
    }
    carry = prevlast;
  }
  {
    const long t = tb + tq;
#pragma unroll
    for (int dt = 0; dt < 4; ++dt) {
      uint2 ov; ov.x = pk2(ot[dt][0], ot[dt][1]); ov.y = pk2(ot[dt][2], ot[dt][3]);
      *(uint2*)(OC + t * 256 + w * 64 + 16 * dt + 4 * quad) = ov;
    }
  }
  __syncthreads();
  for (int q = 0; q < 4; ++q) {
    const int tok = 4 * w + q, t = t0 + tok;
    float v = sImp[(0 * 16 + tok) * 64 + lane] + sImp[(1 * 16 + tok) * 64 + lane] + sImp[(2 * 16 + tok) * 64 + lane] + sImp[(3 * 16 + tok) * 64 + lane];
    const int cur = t >> 6;
    if (lane == 0 || lane == cur) v = 1e9f;
    else if (lane * 64 > t) v = -1e30f;
    int cnt = 0;
#pragma unroll
    for (int i2 = 0; i2 < 64; ++i2) {
      float vi = __builtin_bit_cast(float, __builtin_amdgcn_readlane(__builtin_bit_cast(int, v), i2));
      cnt += (vi > v || (vi == v && i2 < lane)) ? 1 : 0;
    }
    u64 mask = __ballot(cnt < 16);
    if (lane == 0) SEL[tb + t] = mask;
  }
}

DI void sel_attn_item(const Params& P, int it, u16* sQ, u16* sKunused, u16* sVunused) {
  const int tid = TID(), lane = tid & 63, w = tid >> 6, r16 = lane & 15, quad = lane >> 4;
  const int tbk = 127 - (it >> 3), b = it & 7;
  u16* sK = sQ + 128 * 72;
  u16* sVt = sK + 64 * 72;
  (void)sKunused; (void)sVunused;
  const u16* PROJ = (const u16*)(WSP(P) + WS_PROJ);
  const u16* QR = (const u16*)(WSP(P) + WS_QR);
  const u16* OC = (const u16*)(WSP(P) + WS_OC);
  const u16* OW = (const u16*)(WSP(P) + WS_OW);
  const u64* SEL = (const u64*)(WSP(P) + WS_SEL);
  u16* OUT = (u16*)(WSP(P) + WS_OM);
  const long tb = (long)b * SEQ;
  const int t0 = tbk * 32;
#pragma unroll
  for (int i = 0; i < 4; ++i) {
    const int c = tid + 256 * i, row = c >> 3, ch = c & 7;
    *(uint4*)(sQ + row * 72 + ch * 8) = *(const uint4*)(QR + (tb + t0 + (row & 31)) * 256 + (row >> 5) * 64 + ch * 8);
  }
  __syncthreads();
  bf16x8 bq[2][2];
  int tq[2]; u64 mysel[2];
#pragma unroll
  for (int qt = 0; qt < 2; ++qt) {
    const int rowq = 32 * w + 16 * qt + r16;
    bq[qt][0] = *(const bf16x8*)(sQ + rowq * 72 + quad * 8);
    bq[qt][1] = *(const bf16x8*)(sQ + rowq * 72 + 32 + quad * 8);
    tq[qt] = t0 + 16 * qt + r16;
    mysel[qt] = SEL[tb + tq[qt]];
  }
  u64 uni = 0;
#pragma unroll
  for (int q = 0; q < 32; ++q) uni |= SEL[tb + t0 + q];
  const int cur = t0 >> 6;
  uni &= (cur == 63) ? ~0ull : ((1ull << (cur + 1)) - 1ull);
  f32x4 ot[2][4];
#pragma unroll
  for (int qt = 0; qt < 2; ++qt)
#pragma unroll
    for (int dt = 0; dt < 4; ++dt) ot[qt][dt] = (f32x4){0.f, 0.f, 0.f, 0.f};
  float m[2] = {-1e30f, -1e30f}, lsum[2] = {0.f, 0.f};
  uint4 pk0, pk1, pv0, pv1;
  int kb = uni ? (__ffsll((long long)uni) - 1) : -1;
  uni &= uni - 1;
  if (kb >= 0) kv_gload(pk0, pk1, pv0, pv1, PROJ + (tb + kb * 64) * PW + P_KV + 128, PROJ + (tb + kb * 64) * PW + P_KV + 192, PW);
  for (int nkb = -1; kb >= 0; kb = nkb) {
    __syncthreads();
    kv_store(pk0, pk1, pv0, pv1, sK, sVt);
    __syncthreads();
    nkb = uni ? (__ffsll((long long)uni) - 1) : -1;
    uni &= uni - 1;
    if (nkb >= 0) kv_gload(pk0, pk1, pv0, pv1, PROJ + (tb + nkb * 64) * PW + P_KV + 128, PROJ + (tb + nkb * 64) * PW + P_KV + 192, PW);
#pragma unroll
    for (int qt = 0; qt < 2; ++qt) {
      f32x4 st[4];
      st_mma(st, sK, bq[qt], lane);
      const bool selq = (mysel[qt] >> kb) & 1ull;
      bool msk[4][4];
#pragma unroll
      for (int mt = 0; mt < 4; ++mt)
#pragma unroll
        for (int j = 0; j < 4; ++j) { int s = kb * 64 + 16 * mt + 4 * quad + j; msk[mt][j] = selq && (s <= tq[qt]); }
      softmax_tile(st, msk, m[qt], lsum[qt], ot[qt]);
      pv_mma(ot[qt], sVt, st, lane);
    }
  }
#pragma unroll
  for (int qt = 0; qt < 2; ++qt) {
    const float ls = quad_sum(lsum[qt]);
    const float inv = 1.f / fmaxf(ls, 1e-30f);
    const long t = tb + tq[qt];
    const float gc = sigmoidf_(bf2f(PROJ[t * PW + P_NG + w * 3 + 0]));
    const float gsl = sigmoidf_(bf2f(PROJ[t * PW + P_NG + w * 3 + 1]));
    const float gw = sigmoidf_(bf2f(PROJ[t * PW + P_NG + w * 3 + 2]));
#pragma unroll
    for (int dt = 0; dt < 4; ++dt) {
      const long o = t * 256 + w * 64 + 16 * dt + 4 * quad;
      uint2 c = *(const uint2*)(OC + o), ww = *(const uint2*)(OW + o);
      float r0 = gc * bf2f((u16)(c.x & 0xffff)) + gsl * ot[qt][dt][0] * inv + gw * bf2f((u16)(ww.x & 0xffff));
      float r1 = gc * bf2f((u16)(c.x >> 16)) + gsl * ot[qt][dt][1] * inv + gw * bf2f((u16)(ww.x >> 16));
      float r2 = gc * bf2f((u16)(c.y & 0xffff)) + gsl * ot[qt][dt][2] * inv + gw * bf2f((u16)(ww.y & 0xffff));
      float r3 = gc * bf2f((u16)(c.y >> 16)) + gsl * ot[qt][dt][3] * inv + gw * bf2f((u16)(ww.y >> 16));
      uint2 ov; ov.x = pk2(r0, r1); ov.y = pk2(r2, r3);
      *(uint2*)(OUT + o) = ov;
    }
  }
}

DI void inproj_tile(const Params& P, int l, int it, u16* sA, u16* sB) {
  const int tid = TID(), lane = tid & 63, w = tid >> 6, r16 = lane & 15, quad = lane >> 4, wm = w >> 1, wn = w & 1;
  int mt, nt; tile_from_q(it, 22, mt, nt);
  const u16* H = (const u16*)(WSP(P) + WS_H);
  u16* PROJ = (u16*)(WSP(P) + WS_PROJ);
  const u16* Ab = H + (long)mt * 128 * DM;
  const u16* Bb = (const u16*)(WSP(P) + WS_W + WT_IN) + (long)nt * 128 * DM;
  f32x4 acc[4][4];
  gemm3<4>(acc, g3_ptr(Ab, DM, tid, 0, false), g3_ptr(Ab, DM, tid, 1, false), nullptr, nullptr, 64,
           g3_ptr(Bb, DM, tid, 0, false), g3_ptr(Bb, DM, tid, 1, false), nullptr, nullptr, DM, sA, 16L * DM, 16L * DM);
  __syncthreads();
#pragma unroll
  for (int mi = 0; mi < 4; ++mi)
#pragma unroll
    for (int ni = 0; ni < 4; ++ni)
#pragma unroll
      for (int j = 0; j < 4; ++j) sA[(wm * 64 + 16 * mi + 4 * quad + j) * 136 + wn * 64 + 16 * ni + r16] = f2bf(acc[mi][ni][j]);
  __syncthreads();
  store_tile_bf16<128>(sA, PROJ + (long)mt * 128 * PW + nt * 128, PW, 128);
}
DI void glu_tile(const Params& P, int l, int it, u16* sA, u16* sB) {
  const int tid = TID(), lane = tid & 63, w = tid >> 6, r16 = lane & 15, quad = lane >> 4, wm = w >> 1, wn = w & 1;
  const int mt = it >> 2, nt = it & 3;
  const u16* Y5 = (const u16*)(WSP(P) + WS_Y5);
  u16* OUT = (u16*)(WSP(P) + WS_OM) + (long)1 * T_ * 256;
  const u16* Ab = Y5 + (long)mt * 128 * 256;
  const u16* Bb = (const u16*)(WSP(P) + WS_W + WT_GLU) + (long)nt * 128 * 256;
  f32x4 acc[4][4];
  gemm3<4>(acc, g3_ptr(Ab, 256, tid, 0, false), g3_ptr(Ab, 256, tid, 1, false), nullptr, nullptr, 64,
           g3_ptr(Bb, 256, tid, 0, false), g3_ptr(Bb, 256, tid, 1, false), nullptr, nullptr, 256, sA, 16L * 256, 16L * 256);
  __syncthreads();
#pragma unroll
  for (int mi = 0; mi < 4; ++mi)
#pragma unroll
    for (int ni = 0; ni < 2; ++ni)
#pragma unroll
      for (int j = 0; j < 4; ++j)
        sA[(wm * 64 + 16 * mi + 4 * quad + j) * 72 + wn * 32 + 16 * ni + r16] = f2bf(acc[mi][ni][j] * sigmoidf_(acc[mi][ni + 2][j]));
  __syncthreads();
  store_tile_bf16<64>(sA, OUT + (long)mt * 128 * 256 + nt * 64, 256, 128);
}
DI void merge_tile(const Params& P, int l, int it, u16* sA, u16* sB) {
  const int tid = TID(), lane = tid & 63, w = tid >> 6, r16 = lane & 15, quad = lane >> 4, wm = w >> 1, wn = w & 1;
  int mt, nt; tile_from_q(it, 8, mt, nt);
  const u16* H = (const u16*)(WSP(P) + WS_H);
  const u16* OM = (const u16*)(WSP(P) + WS_OM);
  u16* MERGED = (u16*)(WSP(P) + WS_MERGED);
  uint2 outp[4][4];
#pragma unroll
  for (int mi = 0; mi < 4; ++mi)
#pragma unroll
    for (int ni = 0; ni < 4; ++ni) outp[mi][ni] = make_uint2(0u, 0u);
#pragma unroll 1
  for (int m = 0; m < 4; ++m) {
    uint2 gp[4][4];
    {
      f32x4 ag[4][4];
      const u16* Ab = H + (long)mt * 128 * DM;
      const u16* Bb = (const u16*)(WSP(P) + WS_W + WT_G) + ((long)(m * 1024 + nt * 128)) * DM;
      gemm3<4, true>(ag, g3_ptr(Ab, DM, tid, 0, false), g3_ptr(Ab, DM, tid, 1, false), nullptr, nullptr, 64,
               g3_ptr(Bb, DM, tid, 0, false), g3_ptr(Bb, DM, tid, 1, false), nullptr, nullptr, DM, sA, 16L * DM, 16L * DM);
#pragma unroll
      for (int mi = 0; mi < 4; ++mi)
#pragma unroll
        for (int ni = 0; ni < 4; ++ni) {
          gp[mi][ni].x = pk2(sigmoidf_(ag[mi][ni][0]), sigmoidf_(ag[mi][ni][1]));
          gp[mi][ni].y = pk2(sigmoidf_(ag[mi][ni][2]), sigmoidf_(ag[mi][ni][3]));
        }
    }
    {
      f32x4 av[4][4];
      const u16* Ab = OM + ((long)m * T_ + (long)mt * 128) * 256;
      const u16* Bb = (const u16*)(WSP(P) + WS_W + WT_BR) + ((long)(m * 1024 + nt * 128)) * 256;
      gemm3<4, true>(av, g3_ptr(Ab, 256, tid, 0, false), g3_ptr(Ab, 256, tid, 1, false), nullptr, nullptr, 64,
               g3_ptr(Bb, 256, tid, 0, false), g3_ptr(Bb, 256, tid, 1, false), nullptr, nullptr, 256, sA, 16L * 256, 16L * 256);
#pragma unroll
      for (int mi = 0; mi < 4; ++mi)
#pragma unroll
        for (int ni = 0; ni < 4; ++ni) {
          const float o0 = bf2f((u16)(outp[mi][ni].x & 0xffff)) + av[mi][ni][0] * bf2f((u16)(gp[mi][ni].x & 0xffff));
          const float o1 = bf2f((u16)(outp[mi][ni].x >> 16)) + av[mi][ni][1] * bf2f((u16)(gp[mi][ni].x >> 16));
          const float o2 = bf2f((u16)(outp[mi][ni].y & 0xffff)) + av[mi][ni][2] * bf2f((u16)(gp[mi][ni].y & 0xffff));
          const float o3 = bf2f((u16)(outp[mi][ni].y >> 16)) + av[mi][ni][3] * bf2f((u16)(gp[mi][ni].y >> 16));
          outp[mi][ni].x = pk2(o0, o1); outp[mi][ni].y = pk2(o2, o3);
        }
    }
  }
  __syncthreads();
#pragma unroll
  for (int mi = 0; mi < 4; ++mi)
#pragma unroll
    for (int ni = 0; ni < 4; ++ni)
#pragma unroll
      for (int j = 0; j < 4; ++j) {
        const unsigned wv = (j < 2) ? outp[mi][ni].x : outp[mi][ni].y;
        sA[(wm * 64 + 16 * mi + 4 * quad + j) * 136 + wn * 64 + 16 * ni + r16] = (u16)((j & 1) ? (wv >> 16) : (wv & 0xffff));
      }
  __syncthreads();
  store_tile_bf16<128>(sA, MERGED + (long)mt * 128 * DM + nt * 128, DM, 128);
}
DI void resid_tile(const u16* A, int K, const u16* Bt, const float* resid, float* out, int it, u16* sA, u16* sB) {
  const int tid = TID(), lane = tid & 63, w = tid >> 6, r16 = lane & 15, quad = lane >> 4, wm = w >> 1, wn = w & 1;
  int mt, nt; tile_from_q(it, 8, mt, nt);
  const u16* Ab = A + (long)mt * 128 * K;
  const u16* Bb = Bt + (long)nt * 128 * K;
  f32x4 acc[4][4];
  gemm3<4>(acc, g3_ptr(Ab, K, tid, 0, false), g3_ptr(Ab, K, tid, 1, false), nullptr, nullptr, 64,
           g3_ptr(Bb, K, tid, 0, false), g3_ptr(Bb, K, tid, 1, false), nullptr, nullptr, K, sA, 16L * K, 16L * K);
  float* sC = (float*)sA + w * (32 * 68);
#pragma unroll
  for (int hp = 0; hp < 2; ++hp) {
    __syncthreads();
#pragma unroll
    for (int mi2 = 0; mi2 < 2; ++mi2)
#pragma unroll
      for (int ni = 0; ni < 4; ++ni)
#pragma unroll
        for (int j = 0; j < 4; ++j) sC[(16 * mi2 + 4 * quad + j) * 68 + 16 * ni + r16] = acc[2 * hp + mi2][ni][j];
    __syncthreads();
#pragma unroll
    for (int q = 0; q < 8; ++q) {
      const int c = lane + 64 * q, row = c >> 4, c4 = (c & 15) * 4;
      const long o = ((long)mt * 128 + wm * 64 + 32 * hp + row) * DM + nt * 128 + wn * 64 + c4;
      const float4 rv = *(const float4*)(resid + o);
      const f32x4 cv = *(const f32x4*)(sC + row * 68 + c4);
      *(float4*)(out + o) = make_float4(rv.x + cv[0], rv.y + cv[1], rv.z + cv[2], rv.w + cv[3]);
    }
  }
}
DI void ffn1_tile(const Params& P, int l, int it, u16* sA, u16* sB) {
  const int tid = TID(), lane = tid & 63, w = tid >> 6, r16 = lane & 15, quad = lane >> 4, wm = w >> 1, wn = w & 1;
  int mt, nt; tile_from_q(it, 44, mt, nt);
  const u16* H = (const u16*)(WSP(P) + WS_H);
  u16* ACT = (u16*)(WSP(P) + WS_PROJ);
  const u16* Ab = H + (long)mt * 128 * DM;
  const u16* Bb = (const u16*)(WSP(P) + WS_W + WT_GU) + (long)nt * 128 * DM;
  f32x4 acc[4][4];
  gemm3<4>(acc, g3_ptr(Ab, DM, tid, 0, false), g3_ptr(Ab, DM, tid, 1, false), nullptr, nullptr, 64,
           g3_ptr(Bb, DM, tid, 0, false), g3_ptr(Bb, DM, tid, 1, false), nullptr, nullptr, DM, sA, 16L * DM, 16L * DM);
  __syncthreads();
#pragma unroll
  for (int mi = 0; mi < 4; ++mi)
#pragma unroll
    for (int ni = 0; ni < 2; ++ni)
#pragma unroll
      for (int j = 0; j < 4; ++j)
        sA[(wm * 64 + 16 * mi + 4 * quad + j) * 72 + wn * 32 + 16 * ni + r16] = f2bf(siluf_(acc[mi][ni][j]) * acc[mi][ni + 2][j]);
  __syncthreads();
  store_tile_bf16<64>(sA, ACT + (long)mt * 128 * DFF + nt * 64, DFF, 128);
}

__global__ void __launch_bounds__(256, LB2) fwd_megakernel(Params P) {
  cg::grid_group grid = cg::this_grid();
  __shared__ __attribute__((aligned(16))) float lds[17920];
  __shared__ int s_item;
  unsigned* cnt = (unsigned*)(WSP(P) + WS_CNT);
  const int xcd = (int)(__builtin_amdgcn_s_getreg((3 << 11) | 20) & 0xF) & 7;
  __shared__ int s_rank;
  if (threadIdx.x == 0) s_rank = (int)atomicAdd(cnt + 900 + xcd, 1u);
  __syncthreads();
  const int xrank = s_rank;
  u16* sA = (u16*)lds;
  u16* sB = sA + 128 * 80;
  u16* aQ = (u16*)lds;
  u16* aK = aQ + 64 * 72;
  u16* aV = aK + 64 * 72;
  float* aImp = (float*)(aV + 64 * 72);
  for (int ph = P.ph_lo; ph < P.ph_hi; ++ph) {
    const int l = ph / 11, sp = ph % 11;
    const float* xin = (l == 0) ? P.in[0] : P.out;
    const int nrep = (PROBE_DUP != 0 && l == 0 && ((PROBE_DUP >> sp) & 1)) ? 2 : 1;
    for (int rep = 0; rep < nrep; ++rep) {
    unsigned* pc = cnt + (ph + 32 * rep) * 8;
    switch (sp) {
      case 0: if (PHASE_MASK & (1 << 0)) {
        phase_rmsnorm(xin, P.in[2] + l * DM, (u16*)(WSP(P) + WS_H));
        phase_convert(P, l, lds);
        if (l == 0) phase_rope_table((const int*)P.in[1], (float*)(WSP(P) + WS_COS), (float*)(WSP(P) + WS_SIN));
      } break;
      case 1: if (PHASE_MASK & (1 << 1)) {
        XCD_STATIC_LOOP(32 * 22, inproj_tile(P, l, it, sA, sB))
      } break;
      case 2: if (PHASE_MASK & (1 << 2)) {
        for (;;) {
          int it = next_item(pc, &s_item); if (it >= 64 + 3 * 2048) break;
          if (it < 64) cmp1_tile(P, l, it, sA, sB);
          else if (it < 64 + 2048) gdn_p1_item(P, l, it - 64, lds);
          else if (it < 64 + 4096) s5_pass1_item(P, l, it - 64 - 2048, lds);
          else nsa_prep_item(P, l, it - 64 - 4096);
        }
      } break;
      case 3: if (PHASE_MASK & (1 << 3)) {
        for (;;) {
          int it = next_item(pc, &s_item); if (it >= 128 + 3072 + 64) break;
          if (it < 128) gdn_p2_item(P, it, lds);
          else if (it < 128 + 2048) sb_attn_item(P, it - 128, aQ, aK, aV);
          else if (it < 128 + 3072) win_attn_item(P, it - 128 - 2048, aQ, aK, aV);
          else if (it < 128 + 3072 + 32) s5_carry_item(P, l, it - 128 - 3072);
          else cmp2_tile(P, l, it - 128 - 3072 - 32, sA, sB, lds + 17000);
        }
      } break;
      case 4: if (PHASE_MASK & (1 << 4)) {
        for (;;) {
          int it = next_item(pc, &s_item); if (it >= 3 * 2048) break;
          if (it < 2048) cmp_attn_item(P, it, aQ, aK, aV, aImp);
          else if (it < 4096) s5_pass2_item(P, l, it - 2048, lds);
          else gdn_post_item(P, l, it - 4096);
        }
      } break;
      case 5: if (PHASE_MASK & (1 << 5)) {
        for (;;) {
          int it = next_item(pc, &s_item); if (it >= 1024 + 1024) break;
          if (it < 1024) sel_attn_item(P, it, aQ, aK, aV);
          else glu_tile(P, l, it - 1024, sA, sB);
        }
      } break;
      case 6: if (PHASE_MASK & (1 << 6)) {
        XCD_STATIC_LOOP(32 * 8, merge_tile(P, l, it, sA, sB))
      } break;
      case 7: if (PHASE_MASK & (1 << 7)) {
        XCD_STATIC_LOOP(32 * 8, resid_tile((const u16*)(WSP(P) + WS_MERGED), DM, (const u16*)(WSP(P) + WS_W + WT_OUT), xin, P.out, it, sA, sB))
      } break;
      case 8: if (PHASE_MASK & (1 << 8)) {
        phase_rmsnorm(P.out, P.in[26] + l * DM, (u16*)(WSP(P) + WS_H));
      } break;
      case 9: if (PHASE_MASK & (1 << 9)) {
        XCD_STATIC_LOOP(32 * 44, ffn1_tile(P, l, it, sA, sB))
      } break;
      case 10: if (PHASE_MASK & (1 << 10)) {
        XCD_STATIC_LOOP(32 * 8, resid_tile((const u16*)(WSP(P) + WS_PROJ), DFF, (const u16*)(WSP(P) + WS_W + WT_D), P.out, P.out, it, sA, sB))
      } break;
    }
    if (rep + 1 < nrep) grid.sync();
    }
    if (ph + 1 < P.ph_hi) grid.sync();
  }
}

extern "C" void kernel_launch(void* const* d_in, const int* in_sizes, int n_in, void* d_out, int out_size, void* d_ws, size_t ws_size,
                              hipStream_t stream) {
  static int grid_blocks = 0;
  if (!grid_blocks) {
    int dev = 0, cus = 0, per_cu = 0;
    hipGetDevice(&dev);
    hipDeviceGetAttribute(&cus, hipDeviceAttributeMultiprocessorCount, dev);
    hipOccupancyMaxActiveBlocksPerMultiprocessor(&per_cu, fwd_megakernel, 256, 0);
    if (per_cu < 1) per_cu = 1;
    if (per_cu > 2) per_cu = 2;
    grid_blocks = cus * per_cu;
    if (ws_size < WS_W + WT_END) fprintf(stderr, "kernel_launch: workspace too small: %zu\n", ws_size);
  }
  hipMemsetAsync((char*)d_ws + WS_CNT, 0, 4096, stream);
  Params p{};
  for (int i = 0; i < 30; ++i) p.in[i] = (const float*)d_in[i];
  p.out = (float*)d_out;
  p.ws = (unsigned char*)d_ws;
  p.ph_lo = 0; p.ph_hi = NPHASE;
  void* args[] = {&p};
  hipError_t e = hipLaunchCooperativeKernel((void*)fwd_megakernel, dim3(grid_blocks), dim3(256), args, 0, stream);
  if (e != hipSuccess) fprintf(stderr, "cooperative launch failed: %s (grid %d)\n", hipGetErrorString(e), grid_blocks);
}
```

```cpp
#include <hip/hip_runtime.h>
#include <hip/hip_cooperative_groups.h>
#include <cstdio>
namespace cg = cooperative_groups;

typedef unsigned short u16;
typedef unsigned long long u64;
typedef __attribute__((ext_vector_type(8))) short bf16x8;
typedef __attribute__((ext_vector_type(4))) short s16x4;
typedef __attribute__((ext_vector_type(4))) float f32x4;
#define DI __device__ __forceinline__

constexpr int NB = 8, SEQ = 4096, T_ = NB * SEQ, DM = 1024, DIN = 6804, PW = 2816, DFF = 2816;
constexpr int P_Q = 0, P_KV = 256, P_S5U = 640, P_GQKV = 896, P_GZ = 1664, P_SB = 1920, P_NG = 2688, P_GA = 2700, P_GB = 2704;
constexpr float EPS = 1e-6f;
constexpr size_t MiB = 1024ull * 1024ull;
constexpr size_t WS_H = 0, WS_PROJ = 64 * MiB, WS_OM = 240 * MiB, WS_MERGED = 304 * MiB,
                 WS_GQ = 304 * MiB, WS_GK = 320 * MiB, WS_GU = 336 * MiB, WS_GW = 352 * MiB, WS_GA = 368 * MiB,
                 WS_QR = 384 * MiB, WS_OC = 400 * MiB, WS_OW = 416 * MiB, WS_Y5 = 432 * MiB,
                 WS_GG = 448 * MiB, WS_SEL = 449 * MiB, WS_COS = 450 * MiB, WS_SIN = 451 * MiB,
                 WS_ENDS = 452 * MiB, WS_CARRY = 456 * MiB, WS_KC = 460 * MiB, WS_VC = 461 * MiB, WS_HID = 462 * MiB,
                 WS_CNT = 464 * MiB, WS_W = 465 * MiB, WS_CBIAS = 449 * MiB + 512 * 1024;
constexpr size_t WT_IN = 0, WT_G = WT_IN + 2816ull * 1024 * 2, WT_BR = WT_G + 4096ull * 1024 * 2, WT_OUT = WT_BR + 4096ull * 256 * 2,
                 WT_GU = WT_OUT + 1024ull * 1024 * 2, WT_D = WT_GU + 5632ull * 1024 * 2, WT_GLU = WT_D + 1024ull * 2816 * 2,
                 WT_C1 = WT_GLU + 512ull * 256 * 2, WT_C2 = WT_C1 + 512ull * 2048 * 2, WT_END = WT_C2 + 128ull * 256 * 2;
constexpr int NPHASE = 22;
#define XCD_STATIC_LOOP(NPER, BODY) { \
    unsigned c0_ = cnt[900], c1_ = cnt[901], c2_ = cnt[902], c3_ = cnt[903], c4_ = cnt[904], c5_ = cnt[905], c6_ = cnt[906], c7_ = cnt[907]; \
    const bool ok_ = c0_ && c1_ && c2_ && c3_ && c4_ && c5_ && c6_ && c7_; \
    const unsigned mine_ = xcd == 0 ? c0_ : xcd == 1 ? c1_ : xcd == 2 ? c2_ : xcd == 3 ? c3_ : xcd == 4 ? c4_ : xcd == 5 ? c5_ : xcd == 6 ? c6_ : c7_; \
    const int start_ = ok_ ? xcd * (NPER) + xrank : (int)blockIdx.x, end_ = ok_ ? (xcd + 1) * (NPER) : 8 * (NPER), step_ = ok_ ? (int)mine_ : (int)gridDim.x; \
    for (int it = start_; it < end_; it += step_) { BODY; } }
#ifndef PROBE_DUP
#define PROBE_DUP 0
#endif
#ifndef LB2
#define LB2 2
#endif
#ifndef PHASE_MASK
#define PHASE_MASK 0x7ff
#endif

struct Params {
  const float* in[30];
  float* out;
  unsigned char* ws;
  int ph_lo, ph_hi;
};


DI int TID() { int t = threadIdx.x; asm volatile("" : "+v"(t)); return t; }
DI unsigned char* WSP(const Params& P) { size_t z = 0; asm volatile("" : "+s"(z)); return P.ws + z; }
DI u16 f2bf(float x) { unsigned u = __float_as_uint(x); u += 0x7fffu + ((u >> 16) & 1u); return (u16)(u >> 16); }
DI float bf2f(u16 h) { return __uint_as_float(((unsigned)h) << 16); }
DI unsigned pk2(float a, float b) { unsigned r; asm("v_cvt_pk_bf16_f32 %0, %1, %2\n\ts_nop 1" : "=v"(r) : "v"(a), "v"(b)); return r; }
DI float wave_sum(float v) {
#pragma unroll
  for (int o = 1; o < 64; o <<= 1) v += __shfl_xor(v, o);
  return v;
}
DI float sigmoidf_(float x) { return 1.f / (1.f + __expf(-x)); }
DI float siluf_(float x) { return x * sigmoidf_(x); }
DI float softplusf_(float x) { return fmaxf(x, 0.f) + log1pf(__expf(-fabsf(x))); }
DI float gelu_tanh(float x) {
  float u = 0.7978845608028654f * (x + 0.044715f * x * x * x);
  float t = 1.f - 2.f / (__expf(2.f * u) + 1.f);
  return 0.5f * x * (1.f + t);
}
DI void sincos_d(double x, double& s, double& c) {
  const double TWO_PI = 6.283185307179586476925287, INV = 0.15915494309189533576888;
  double n = rint(x * INV);
  double r = x - n * TWO_PI;
  double r2 = r * r, term = 1.0, cs = 1.0, ss = 1.0;
#pragma unroll
  for (int k = 1; k <= 14; ++k) { term *= r2 * (-1.0 / (double)((2 * k - 1) * (2 * k))); cs += term; }
  term = 1.0;
#pragma unroll
  for (int k = 1; k <= 14; ++k) { term *= r2 * (-1.0 / (double)((2 * k) * (2 * k + 1))); ss += term; }
  s = r * ss; c = cs;
}
DI int next_item(unsigned* cnt, int* s_item) {
  __syncthreads();
  if (TID() == 0) *s_item = (int)atomicAdd(cnt, 1u);
  __syncthreads();
  return *s_item;
}
DI int next_tile_xcd(unsigned* cnt8, int n_per_xcd, int xcd, int* s_item) {
  asm volatile("" : "+s"(xcd));
  __syncthreads();
  if (threadIdx.x == 0) {
    int res = -1;
    for (int a = 0; a < 8; ++a) {
      int qq = (xcd + a) & 7;
      unsigned v = atomicAdd(cnt8 + qq, 1u);
      if (v < (unsigned)n_per_xcd) { res = qq * n_per_xcd + (int)v; break; }
    }
    *s_item = res;
  }
  __syncthreads();
  return *s_item;
}
DI void tile_from_q(int it, int numN, int& mt, int& nt) {
  const int per = 32 * numN, q = it / per, i = it % per, g = i / (8 * numN), rem = i % (8 * numN);
  nt = rem >> 3; mt = 32 * q + 8 * g + (rem & 7);
}
DI int proj_src_col(int pc) {
  if (pc < 640) return pc;
  if (pc < 1664) return pc + 12;
  if (pc < 2688) return pc + 20;
  if (pc < 2700) return pc - 2688 + 640;
  if (pc < 2708) return pc - 2700 + 1676;
  return pc;
}

DI uint4 addpos8(uint4 v, const float* pp) {
  uint4 o;
  o.x = pk2(bf2f((u16)(v.x & 0xffff)) + pp[0], bf2f((u16)(v.x >> 16)) + pp[1]);
  o.y = pk2(bf2f((u16)(v.y & 0xffff)) + pp[2], bf2f((u16)(v.y >> 16)) + pp[3]);
  o.z = pk2(bf2f((u16)(v.z & 0xffff)) + pp[4], bf2f((u16)(v.z >> 16)) + pp[5]);
  o.w = pk2(bf2f((u16)(v.w & 0xffff)) + pp[6], bf2f((u16)(v.w >> 16)) + pp[7]);
  return o;
}
template <int NTW>
DI void gemm2(f32x4 (&acc)[4][NTW], const u16* __restrict__ arow, long a_kstep, const float* __restrict__ apos,
              const u16* __restrict__ brow, int K, u16* sA, u16* sB) {
  constexpr int BN = 32 * NTW, BV = BN / 32, LS = 80;
  const int tid = TID(), lane = tid & 63, w = tid >> 6, r16 = lane & 15, quad = lane >> 4;
  const int wm = w >> 1, wn = w & 1;
  u16* sa_st = sA + (tid >> 1) * LS + (tid & 1) * 32;
  u16* sb_st = (BN == 128) ? (sB + (tid >> 1) * LS + (tid & 1) * 32) : (sB + (tid >> 2) * LS + (tid & 3) * 16);
  uint4 pa0, pa1, pa2, pa3, pb0, pb1, pb2, pb3;
  uint4 qa0, qa1, qa2, qa3, qb0, qb1, qb2, qb3;
  pb2 = make_uint4(0, 0, 0, 0); pb3 = pb2; qb2 = pb2; qb3 = pb2;
#define G2_LOAD(KT, a0, a1, a2, a3, b0, b1, b2, b3) { const uint4* pa_ = (const uint4*)(arow + (long)(KT) * a_kstep); \
    a0 = pa_[0]; a1 = pa_[1]; a2 = pa_[2]; a3 = pa_[3]; \
    if (apos) { const float* pp_ = apos + (KT) * 64 + (tid & 1) * 32; \
      a0 = addpos8(a0, pp_); a1 = addpos8(a1, pp_ + 8); a2 = addpos8(a2, pp_ + 16); a3 = addpos8(a3, pp_ + 24); } \
    const uint4* pb_ = (const uint4*)(brow + (long)(KT) * 64); \
    b0 = pb_[0]; b1 = pb_[1]; if (BV == 4) { b2 = pb_[2]; b3 = pb_[3]; } }
#define G2_STORE(a0, a1, a2, a3, b0, b1, b2, b3) { \
    ((uint4*)sa_st)[0] = a0; ((uint4*)sa_st)[1] = a1; ((uint4*)sa_st)[2] = a2; ((uint4*)sa_st)[3] = a3; \
    ((uint4*)sb_st)[0] = b0; ((uint4*)sb_st)[1] = b1; if (BV == 4) { ((uint4*)sb_st)[2] = b2; ((uint4*)sb_st)[3] = b3; } }
#define G2_COMPUTE() { _Pragma("unroll") for (int ks = 0; ks < 2; ++ks) { \
      bf16x8 af[4], bg[NTW]; \
      _Pragma("unroll") for (int mi = 0; mi < 4; ++mi) af[mi] = *(const bf16x8*)(sA + (wm * 64 + 16 * mi + r16) * LS + ks * 32 + quad * 8); \
      _Pragma("unroll") for (int ni = 0; ni < NTW; ++ni) bg[ni] = *(const bf16x8*)(sB + (wn * (BN / 2) + 16 * ni + r16) * LS + ks * 32 + quad * 8); \
      _Pragma("unroll") for (int mi = 0; mi < 4; ++mi) \
        _Pragma("unroll") for (int ni = 0; ni < NTW; ++ni) acc[mi][ni] = __builtin_amdgcn_mfma_f32_16x16x32_bf16(af[mi], bg[ni], acc[mi][ni], 0, 0, 0); } }
#pragma unroll
  for (int mi = 0; mi < 4; ++mi)
#pragma unroll
    for (int ni = 0; ni < NTW; ++ni) acc[mi][ni] = (f32x4){0.f, 0.f, 0.f, 0.f};
  const int nk = K >> 6;
  G2_LOAD(0, pa0, pa1, pa2, pa3, pb0, pb1, pb2, pb3)
  G2_LOAD(1, qa0, qa1, qa2, qa3, qb0, qb1, qb2, qb3)
#pragma unroll 1
  for (int kt = 0; kt < nk; kt += 2) {
    __syncthreads();
    G2_STORE(pa0, pa1, pa2, pa3, pb0, pb1, pb2, pb3)
    __syncthreads();
    if (kt + 2 < nk) G2_LOAD(kt + 2, pa0, pa1, pa2, pa3, pb0, pb1, pb2, pb3)
    G2_COMPUTE()
    __syncthreads();
    G2_STORE(qa0, qa1, qa2, qa3, qb0, qb1, qb2, qb3)
    __syncthreads();
    if (kt + 3 < nk) G2_LOAD(kt + 3, qa0, qa1, qa2, qa3, qb0, qb1, qb2, qb3)
    G2_COMPUTE()
  }
#undef G2_LOAD
#undef G2_STORE
#undef G2_COMPUTE
}
DI void g3_rowpiece(int tid, int q, bool n64, int& row, int& pc) {
  const int w = tid >> 6, lane = tid & 63, chunk = n64 ? (2 * w + q) : (4 * w + q);
  row = 8 * chunk + (lane >> 3);
  pc = (lane & 7) ^ ((row >> 1) & 7);
}
DI const u16* g3_ptr(const u16* base, long ld, int tid, int q, bool n64) {
  int row, pc; g3_rowpiece(tid, q, n64, row, pc);
  return base + (long)row * ld + pc * 8;
}
template <int NTW, bool LEAN = false>
DI void gemm3(f32x4 (&acc)[4][NTW], const u16* ap0, const u16* ap1, const u16* ap2, const u16* ap3, long a_kstep,
              const u16* bp0, const u16* bp1, const u16* bp2, const u16* bp3, int K, u16* sbase, long a16 = 0, long b16 = 0) {
  constexpr int BN = 32 * NTW, STAGE = 16384;
  const int tid = TID(), lane = tid & 63, w = tid >> 6, r16 = lane & 15, quad = lane >> 4;
  const int wm = w >> 1, wn = w & 1;
  const int sz = (r16 >> 1) & 7;
  const int wu = __builtin_amdgcn_readfirstlane(w);
#define G3_GLDS(GP, LOFF) asm volatile("s_mov_b32 m0, %1\n\ts_nop 0\n\tglobal_load_lds_dwordx4 %0, off" :: "v"(GP), "s"(LOFF) : "memory", "m0")
  const unsigned lds0 = (unsigned)(size_t)sbase;
#define G3_ISSUE(KT) { const unsigned st_ = lds0 + (((KT) & 1) ? STAGE * 2 : 0); const long ka_ = (long)(KT) * a_kstep, kb_ = (long)(KT) * 64; \
    if (BN == 128) { \
      const unsigned la_ = __builtin_amdgcn_readfirstlane(st_ + wu * 4096u); \
      G3_GLDS(ap0 + ka_, la_); G3_GLDS(ap1 + ka_, la_ + 1024u); \
      if (a16) { G3_GLDS(ap0 + (ka_ + a16), la_ + 2048u); G3_GLDS(ap1 + (ka_ + a16), la_ + 3072u); } else { G3_GLDS(ap2 + ka_, la_ + 2048u); G3_GLDS(ap3 + ka_, la_ + 3072u); } \
      G3_GLDS(bp0 + kb_, la_ + 16384u); G3_GLDS(bp1 + kb_, la_ + 17408u); \
      if (b16) { G3_GLDS(bp0 + (kb_ + b16), la_ + 18432u); G3_GLDS(bp1 + (kb_ + b16), la_ + 19456u); } else { G3_GLDS(bp2 + kb_, la_ + 18432u); G3_GLDS(bp3 + kb_, la_ + 19456u); } \
    } else { \
      const unsigned la_ = __builtin_amdgcn_readfirstlane(st_ + wu * 4096u); \
      const unsigned lb_ = __builtin_amdgcn_readfirstlane(st_ + 16384u + wu * 2048u); \
      G3_GLDS(ap0 + ka_, la_); G3_GLDS(ap1 + ka_, la_ + 1024u); G3_GLDS(ap2 + ka_, la_ + 2048u); G3_GLDS(ap3 + ka_, la_ + 3072u); \
      G3_GLDS(bp0 + kb_, lb_); G3_GLDS(bp1 + kb_, lb_ + 1024u); \
    } }
#pragma unroll
  for (int mi = 0; mi < 4; ++mi)
#pragma unroll
    for (int ni = 0; ni < NTW; ++ni) acc[mi][ni] = (f32x4){0.f, 0.f, 0.f, 0.f};
  const int nk = K >> 6;
  __syncthreads();
  G3_ISSUE(0)
  if (!LEAN && BN == 128) {
#define G3_PIECE(I, KT) { const unsigned st_ = lds0 + (((KT) & 1) ? STAGE * 2 : 0); const long ka_ = (long)(KT) * a_kstep, kb_ = (long)(KT) * 64; \
      const unsigned la_ = __builtin_amdgcn_readfirstlane(st_ + wu * 4096u); \
      if ((I) == 0) G3_GLDS(ap0 + ka_, la_); else if ((I) == 1) G3_GLDS(ap1 + ka_, la_ + 1024u); \
      else if ((I) == 2) G3_GLDS((a16 ? ap0 + a16 : ap2) + ka_, la_ + 2048u); else if ((I) == 3) G3_GLDS((a16 ? ap1 + a16 : ap3) + ka_, la_ + 3072u); \
      else if ((I) == 4) G3_GLDS(bp0 + kb_, la_ + 16384u); else if ((I) == 5) G3_GLDS(bp1 + kb_, la_ + 17408u); \
      else if ((I) == 6) G3_GLDS((b16 ? bp0 + b16 : bp2) + kb_, la_ + 18432u); else G3_GLDS((b16 ? bp1 + b16 : bp3) + kb_, la_ + 19456u); }
#define G3_STEP(KT, DOISSUE) { const u16* sAs = sbase + ((KT) & 1) * STAGE; const u16* sBs = sAs + 8192; \
      bf16x8 af[2][4], bg[2][NTW];     \
      _Pragma("unroll") for (int ks = 0; ks < 2; ++ks) { \
        const int pcol = ((ks * 4 + quad) ^ sz) * 8; \
        _Pragma("unroll") for (int mi = 0; mi < 4; ++mi) af[ks][mi] = *(const bf16x8*)(sAs + (wm * 64 + 16 * mi + r16) * 64 + pcol); \
        _Pragma("unroll") for (int ni = 0; ni < NTW; ++ni) bg[ks][ni] = *(const bf16x8*)(sBs + (wn * (BN / 2) + 16 * ni + r16) * 64 + pcol); } \
      __builtin_amdgcn_s_setprio(1);     \
      _Pragma("unroll") for (int mi = 0; mi < 4; ++mi) {   \
        acc[mi][0] = __builtin_amdgcn_mfma_f32_16x16x32_bf16(af[0][mi], bg[0][0], acc[mi][0], 0, 0, 0); \
        acc[mi][1] = __builtin_amdgcn_mfma_f32_16x16x32_bf16(af[0][mi], bg[0][1], acc[mi][1], 0, 0, 0); \
        if (DOISSUE) G3_PIECE(2 * mi, (KT) + 1) \
        __builtin_amdgcn_sched_barrier(0); \
        acc[mi][2] = __builtin_amdgcn_mfma_f32_16x16x32_bf16(af[0][mi], bg[0][2], acc[mi][2], 0, 0, 0); \
        acc[mi][3] = __builtin_amdgcn_mfma_f32_16x16x32_bf16(af[0][mi], bg[0][3], acc[mi][3], 0, 0, 0); \
        if (DOISSUE) G3_PIECE(2 * mi + 1, (KT) + 1) \
        __builtin_amdgcn_sched_barrier(0); } \
      _Pragma("unroll") for (int mi = 0; mi < 4; ++mi) \
        _Pragma("unroll") for (int ni = 0; ni < NTW; ++ni) acc[mi][ni] = __builtin_amdgcn_mfma_f32_16x16x32_bf16(af[1][mi], bg[1][ni], acc[mi][ni], 0, 0, 0); \
      __builtin_amdgcn_s_setprio(0); }
#pragma unroll 1
    for (int kt = 0; kt < nk - 1; ++kt) {
      asm volatile("s_waitcnt vmcnt(0) lgkmcnt(0)" ::: "memory");
      __builtin_amdgcn_s_barrier();
      asm volatile("" ::: "memory");
      G3_STEP(kt, true)
    }
    asm volatile("s_waitcnt vmcnt(0) lgkmcnt(0)" ::: "memory");
    __builtin_amdgcn_s_barrier();
    asm volatile("" ::: "memory");
    G3_STEP(nk - 1, false)
#undef G3_PIECE
#undef G3_STEP
  } else
#pragma unroll 1
  for (int kt = 0; kt < nk; ++kt) {
    asm volatile("s_waitcnt vmcnt(0) lgkmcnt(0)" ::: "memory");
    __builtin_amdgcn_s_barrier();
    asm volatile("" ::: "memory");
    if (kt + 1 < nk) G3_ISSUE(kt + 1)
    const u16* sAs = sbase + (kt & 1) * STAGE;
    const u16* sBs = sAs + 8192;
#pragma unroll 1
    for (int ks = 0; ks < (LEAN ? 2 : 0); ++ks) {
      const int pcol = ((ks * 4 + quad) ^ sz) * 8;
      bf16x8 af[4];
#pragma unroll
      for (int mi = 0; mi < 4; ++mi) af[mi] = *(const bf16x8*)(sAs + (wm * 64 + 16 * mi + r16) * 64 + pcol);
#pragma unroll
      for (int ni = 0; ni < NTW; ++ni) {
        bf16x8 b1 = *(const bf16x8*)(sBs + (wn * (BN / 2) + 16 * ni + r16) * 64 + pcol);
#pragma unroll
        for (int mi = 0; mi < 4; ++mi) acc[mi][ni] = __builtin_amdgcn_mfma_f32_16x16x32_bf16(af[mi], b1, acc[mi][ni], 0, 0, 0);
      }
    }
#pragma unroll
    for (int ks = 0; ks < (LEAN ? 0 : 2); ++ks) {
      const int pcol = ((ks * 4 + quad) ^ sz) * 8;
      bf16x8 af[4], bg[NTW];
#pragma unroll
      for (int mi = 0; mi < 4; ++mi) af[mi] = *(const bf16x8*)(sAs + (wm * 64 + 16 * mi + r16) * 64 + pcol);
#pragma unroll
      for (int ni = 0; ni < NTW; ++ni) bg[ni] = *(const bf16x8*)(sBs + (wn * (BN / 2) + 16 * ni + r16) * 64 + pcol);
#pragma unroll
      for (int mi = 0; mi < 4; ++mi)
#pragma unroll
        for (int ni = 0; ni < NTW; ++ni) acc[mi][ni] = __builtin_amdgcn_mfma_f32_16x16x32_bf16(af[mi], bg[ni], acc[mi][ni], 0, 0, 0);
    }
  }
#undef G3_ISSUE
#undef G3_GLDS
}
template <int NCOLS>
DI void store_tile_bf16(const u16* sC, u16* gdst, long ld, int rows_valid) {
  constexpr int CPR = NCOLS / 8, LS = NCOLS + 8;
  const int tid = TID();
#pragma unroll
  for (int q = 0; q < (128 * CPR) / 256; ++q) {
    const int c = tid + 256 * q, row = c / CPR, ch = c % CPR;
    if (row < rows_valid) *(uint4*)(gdst + (long)row * ld + ch * 8) = *(const uint4*)(sC + row * LS + ch * 8);
  }
}
DI int pair_col(int np, int& which) {
  const int nt = np >> 7, c = np & 127, wn = c >> 6, ni = (c >> 4) & 3, r = c & 15;
  which = ni >> 1;
  return nt * 64 + wn * 32 + (ni & 1) * 16 + r;
}
DI const float* conv_colptr(const Params& P, int l, int mat, int np, long& ld) {
  int which;
  switch (mat) {
    case 0: ld = DIN; return P.in[3] + (long)l * DM * DIN + proj_src_col(np);
    case 1: ld = DIN; return P.in[3] + (long)l * DM * DIN + 2708 + np;
    case 2: ld = DM; return P.in[24] + ((long)(l * 4 + (np >> 10)) * 256) * DM + (np & 1023);
    case 3: ld = DM; return P.in[25] + (long)l * DM * DM + np;
    case 4: { int o = pair_col(np, which); ld = DFF; return (which ? P.in[28] : P.in[27]) + (long)l * DM * DFF + o; }
    case 5: ld = DM; return P.in[29] + (long)l * DFF * DM + np;
    case 6: { int o = pair_col(np, which); ld = 512; return P.in[19] + (long)l * 256 * 512 + which * 256 + o; }
    case 7: ld = 256; return P.in[(np >> 8) ? 9 : 7] + (long)l * 2048 * 256 + (np & 255);
    default: ld = 64; return P.in[(np >> 6) ? 10 : 8] + (long)l * 256 * 64 + (np & 63);
  }
}
DI void phase_convert(const Params& P, int l, float* lds) {
  const int tid = TID();
  if (blockIdx.x < 64) {
    const int kv = blockIdx.x >> 5, ks = blockIdx.x & 31;
    const float* pos = P.in[6] + (long)(l * 2 + kv) * 2048 + ks * 64;
    const float* w1 = P.in[kv ? 9 : 7] + (long)l * 2048 * 256 + (long)ks * 64 * 256 + tid;
    float a = 0.f;
#pragma unroll 8
    for (int k = 0; k < 64; ++k) a += pos[k] * w1[(long)k * 256];
    ((float*)(WSP(P) + WS_CBIAS))[(kv * 32 + ks) * 256 + tid] = a;
  }
  const int NB_[9] = {44, 64, 64, 16, 88, 16, 8, 8, 2};
  const int KB_[9] = {16, 16, 4, 16, 16, 44, 4, 32, 4};
  const size_t OFF_[9] = {WT_IN, WT_G, WT_BR, WT_OUT, WT_GU, WT_D, WT_GLU, WT_C1, WT_C2};
  for (int it = blockIdx.x; it < 4648; it += gridDim.x) {
    int r = it, mat = 0, nbk = 0, kbk = 0; size_t off = 0;
#pragma unroll
    for (int q = 0; q < 9; ++q) { int n = NB_[q] * KB_[q]; if (r >= 0 && r < n) { mat = q; nbk = NB_[q]; kbk = KB_[q]; off = OFF_[q]; r -= 100000; } else if (r >= 0) r -= n; }
    r += 100000;
    const int nb = r / kbk, kb = r % kbk, K = kbk * 64;
    (void)nbk;
    __syncthreads();
    {
      const int n = tid & 63;
      long ld; const float* cp = conv_colptr(P, l, mat, nb * 64 + n, ld);
#pragma unroll 4
      for (int q = 0; q < 16; ++q) { int k = (tid >> 6) + 4 * q; lds[n * 65 + k] = cp[(long)(kb * 64 + k) * ld]; }
    }
    __syncthreads();
    u16* dst = (u16*)(WSP(P) + WS_W + off);
#pragma unroll
    for (int q = 0; q < 2; ++q) {
      int c = tid + 256 * q, n = c >> 3, k8 = (c & 7) * 8;
      const float* sp = lds + n * 65 + k8;
      uint4 v; v.x = pk2(sp[0], sp[1]); v.y = pk2(sp[2], sp[3]); v.z = pk2(sp[4], sp[5]); v.w = pk2(sp[6], sp[7]);
      *(uint4*)(dst + (long)(nb * 64 + n) * K + kb * 64 + k8) = v;
    }
  }
}

DI void st_mma(f32x4 (&st)[4], const u16* sK, const bf16x8 (&bq)[2], int lane) {
  const int r = lane & 15, quad = lane >> 4;
#pragma unroll
  for (int mt = 0; mt < 4; ++mt) {
    f32x4 a = {0.f, 0.f, 0.f, 0.f};
#pragma unroll
    for (int ks = 0; ks < 2; ++ks) {
      bf16x8 kf = *(const bf16x8*)(sK + (16 * mt + r) * 72 + ks * 32 + quad * 8);
      a = __builtin_amdgcn_mfma_f32_16x16x32_bf16(kf, bq[ks], a, 0, 0, 0);
    }
    st[mt] = a;
  }
}
DI void pv_mma(f32x4 (&ot)[4], const u16* sVt, const f32x4 (&p)[4], int lane) {
  const int r = lane & 15, quad = lane >> 4;
#pragma unroll
  for (int ks = 0; ks < 2; ++ks) {
    uint4 pu;
    pu.x = pk2(p[2 * ks][0], p[2 * ks][1]); pu.y = pk2(p[2 * ks][2], p[2 * ks][3]);
    pu.z = pk2(p[2 * ks + 1][0], p[2 * ks + 1][1]); pu.w = pk2(p[2 * ks + 1][2], p[2 * ks + 1][3]);
    bf16x8 pb = __builtin_bit_cast(bf16x8, pu);
#pragma unroll
    for (int dt = 0; dt < 4; ++dt) {
      const u16* vrow = sVt + (16 * dt + r) * 72;
      s16x4 lo = *(const s16x4*)(vrow + ((32 * ks + 4 * quad) ^ (16 * dt)));
      s16x4 hi = *(const s16x4*)(vrow + ((32 * ks + 16 + 4 * quad) ^ (16 * dt)));
      bf16x8 vf = __builtin_shufflevector(lo, hi, 0, 1, 2, 3, 4, 5, 6, 7);
      ot[dt] = __builtin_amdgcn_mfma_f32_16x16x32_bf16(vf, pb, ot[dt], 0, 0, 0);
    }
  }
}
DI void load_tile(u16* dst, const u16* src, long ld) {
  const int tid = TID();
#pragma unroll
  for (int i = 0; i < 2; ++i) {
    int c = tid + 256 * i, row = c >> 3, ch = c & 7;
    uint4 v = *(const uint4*)(src + (long)row * ld + ch * 8);
    *(uint4*)(dst + row * 72 + ch * 8) = v;
  }
}
DI void load_tile_T(u16* dst, const u16* src, long ld) {
  const int tid = TID();
#pragma unroll
  for (int i = 0; i < 2; ++i) {
    int c = tid + 256 * i, row = c >> 3, ch = c & 7;
    uint4 v = *(const uint4*)(src + (long)row * ld + ch * 8);
    const unsigned* vv = (const unsigned*)&v;
#pragma unroll
    for (int q = 0; q < 4; ++q) {
      dst[(ch * 8 + 2 * q) * 72 + row] = (u16)(vv[q] & 0xffff);
      dst[(ch * 8 + 2 * q + 1) * 72 + row] = (u16)(vv[q] >> 16);
    }
  }
}
DI void load_q_nsa(u16* dst, const u16* src, long ld) {
  const int tid = TID();
#pragma unroll
  for (int i = 0; i < 2; ++i) {
    int c = tid + 256 * i, row = c >> 3, ch = c & 7;
    uint4 v = *(const uint4*)(src + (long)(row & 15) * ld + (row >> 4) * 64 + ch * 8);
    *(uint4*)(dst + row * 72 + ch * 8) = v;
  }
}
DI void load_qfrag(bf16x8 (&bq)[2], const u16* sQ, int w, int lane) {
  const int r = lane & 15, quad = lane >> 4;
  bq[0] = *(const bf16x8*)(sQ + (16 * w + r) * 72 + quad * 8);
  bq[1] = *(const bf16x8*)(sQ + (16 * w + r) * 72 + 32 + quad * 8);
}
DI float quad_max(float v) { v = fmaxf(v, __shfl_xor(v, 16)); v = fmaxf(v, __shfl_xor(v, 32)); return v; }
DI float quad_sum(float v) { v += __shfl_xor(v, 16); v += __shfl_xor(v, 32); return v; }

DI void softmax_tile(f32x4 (&st)[4], const bool (&msk)[4][4], float& m, float& l, f32x4 (&ot)[4]) {
  float tm = -1e30f;
#pragma unroll
  for (int mt = 0; mt < 4; ++mt)
#pragma unroll
    for (int j = 0; j < 4; ++j) { float s = st[mt][j] * 0.125f; st[mt][j] = s; if (msk[mt][j]) tm = fmaxf(tm, s); }
  tm = quad_max(tm);
  float mn = fmaxf(m, tm);
  float alpha = __expf(m - mn);
  float ps = 0.f;
#pragma unroll
  for (int mt = 0; mt < 4; ++mt)
#pragma unroll
    for (int j = 0; j < 4; ++j) { float p = msk[mt][j] ? __expf(st[mt][j] - mn) : 0.f; st[mt][j] = p; ps += p; }
  l = l * alpha + ps;
  m = mn;
#pragma unroll
  for (int dt = 0; dt < 4; ++dt)
#pragma unroll
    for (int j = 0; j < 4; ++j) ot[dt][j] *= alpha;
}

DI void phase_rmsnorm(const float* __restrict__ x, const float* __restrict__ wgt, u16* __restrict__ H) {
  const int lane = TID() & 63, w = TID() >> 6;
  const int gw = blockIdx.x * 4 + w, nw = gridDim.x * 4;
  for (int row = gw; row < T_; row += nw) {
    const float4* xr = (const float4*)(x + (long)row * DM);
    float4 v[4]; float s = 0.f;
#pragma unroll
    for (int j = 0; j < 4; ++j) { v[j] = xr[lane + 64 * j]; s += v[j].x * v[j].x + v[j].y * v[j].y + v[j].z * v[j].z + v[j].w * v[j].w; }
    s = wave_sum(s);
    float r = rsqrtf(s * (1.f / DM) + EPS);
#pragma unroll
    for (int j = 0; j < 4; ++j) {
      float4 g = ((const float4*)wgt)[lane + 64 * j];
      uint2 o; o.x = pk2(v[j].x * r * g.x, v[j].y * r * g.y); o.y = pk2(v[j].z * r * g.z, v[j].w * r * g.w);
      *(uint2*)(H + (long)row * DM + (lane + 64 * j) * 4) = o;
    }
  }
}
DI void phase_rope_table(const int* __restrict__ positions, float* __restrict__ COS, float* __restrict__ SIN) {
  const float invf[8] = {1.0f, 0.1939227432012558f, 0.03760603070259094f, 0.007292664609849453f,
                         0.0014142135623842478f, 0.00027424818836152554f, 5.3182957344688475e-05f, 1.0313385246263351e-05f};
  for (int idx = blockIdx.x * 256 + TID(); idx < T_ * 8; idx += gridDim.x * 256) {
    int i = idx & 7;
    float f = invf[0];
#pragma unroll
    for (int q = 1; q < 8; ++q) f = (i == q) ? invf[q] : f;
    float ang = (float)positions[idx >> 3] * f;
    double s, c; sincos_d((double)ang, s, c);
    COS[idx] = (float)c; SIN[idx] = (float)s;
  }
}

struct S5Coef { float ar, ai; float bbr[16], bbi[16]; };
DI void s5_coef(const Params& P, int l, int g, int p, S5Coef& C) {
  float dt = expf(P.in[13][l * 16 + g]);
  float lr = P.in[11][(l * 16 + g) * 64 + p], li = P.in[12][(l * 16 + g) * 64 + p];
  float mag = expf(lr * dt);
  double s, c; sincos_d((double)(li * dt), s, c);
  C.ar = mag * (float)c; C.ai = mag * (float)s;
  float den = lr * lr + li * li;
  float fr = ((C.ar - 1.f) * lr + C.ai * li) / den;
  float fi = (C.ai * lr - (C.ar - 1.f) * li) / den;
  const float* br = P.in[14] + ((long)(l * 16 + g) * 64 + p) * 16;
  const float* bi = P.in[15] + ((long)(l * 16 + g) * 64 + p) * 16;
#pragma unroll
  for (int c2 = 0; c2 < 16; ++c2) {
    float b_r = br[c2], b_i = bi[c2];
    C.bbr[c2] = fr * b_r - fi * b_i;
    C.bbi[c2] = fr * b_i + fi * b_r;
  }
}
DI void s5_load_u(float* su, const u16* PROJ, int b, int chunk, int g, int lane) {
  const u16* src = PROJ + ((long)(b * SEQ + chunk * 64 + lane)) * PW + P_S5U + g * 16;
  uint4 v0 = ((const uint4*)src)[0], v1 = ((const uint4*)src)[1];
  const unsigned* a = (const unsigned*)&v0; const unsigned* c = (const unsigned*)&v1;
  float* d = su + lane * 16;
#pragma unroll
  for (int q = 0; q < 4; ++q) { d[2 * q] = bf2f((u16)(a[q] & 0xffff)); d[2 * q + 1] = bf2f((u16)(a[q] >> 16)); }
#pragma unroll
  for (int q = 0; q < 4; ++q) { d[8 + 2 * q] = bf2f((u16)(c[q] & 0xffff)); d[8 + 2 * q + 1] = bf2f((u16)(c[q] >> 16)); }
}

DI void s5_pass1_item(const Params& P, int l, int it, float* lds) {
  const int lane = TID() & 63, w = TID() >> 6;
  const int gq = it & 3, chunk = (it >> 2) & 63, b = it >> 8;
  const int g = gq * 4 + w;
  const u16* PROJ = (const u16*)(WSP(P) + WS_PROJ);
  float* su = lds + w * 1024;
  S5Coef C; s5_coef(P, l, g, lane, C);
  s5_load_u(su, PROJ, b, chunk, g, lane);
  __syncthreads();
  float xr = 0.f, xi = 0.f;
#pragma unroll 4
  for (int t = 0; t < 64; ++t) {
    const f32x4* up = (const f32x4*)(su + t * 16);
    float br = 0.f, bi = 0.f;
#pragma unroll
    for (int q = 0; q < 4; ++q) {
      f32x4 u = up[q];
#pragma unroll
      for (int e = 0; e < 4; ++e) { br += u[e] * C.bbr[4 * q + e]; bi += u[e] * C.bbi[4 * q + e]; }
    }
    float nr = C.ar * xr - C.ai * xi + br;
    float ni = C.ar * xi + C.ai * xr + bi;
    xr = nr; xi = ni;
  }
  float2* ENDS = (float2*)(WSP(P) + WS_ENDS);
  ENDS[((long)(b * 64 + chunk) * 16 + g) * 64 + lane] = make_float2(xr, xi);
}

DI void s5_carry_item(const Params& P, int l, int it) {
  const int idx = it * 256 + TID();
  const int b = idx >> 10, gp = idx & 1023, g = gp >> 6, p = gp & 63;
  float dt = expf(P.in[13][l * 16 + g]);
  float lr = P.in[11][(l * 16 + g) * 64 + p], li = P.in[12][(l * 16 + g) * 64 + p];
  float mag = expf(lr * dt * 64.f);
  double s, c; sincos_d((double)(li * dt) * 64.0, s, c);
  float ar = mag * (float)c, ai = mag * (float)s;
  const float2* ENDS = (const float2*)(WSP(P) + WS_ENDS);
  float2* CARRY = (float2*)(WSP(P) + WS_CARRY);
  float xr = 0.f, xi = 0.f;
  for (int ch = 0; ch < 64; ++ch) {
    long o = ((long)(b * 64 + ch) * 16 + g) * 64 + p;
    CARRY[o] = make_float2(xr, xi);
    float2 e = ENDS[o];
    float nr = ar * xr - ai * xi + e.x;
    float ni = ar * xi + ai * xr + e.y;
    xr = nr; xi = ni;
  }
}

DI void s5_pass2_item(const Params& P, int l, int it, float* lds) {
  const int lane = TID() & 63, w = TID() >> 6, r16 = lane & 15, quad = lane >> 4;
  const int gq = it & 3, chunk = (it >> 2) & 63, b = it >> 8;
  const int g = gq * 4 + w;
  const u16* PROJ = (const u16*)(WSP(P) + WS_PROJ);
  u16* Y5 = (u16*)(WSP(P) + WS_Y5);
  float* su = lds + w * 1024;
  u16* sX = (u16*)(lds + 4096) + w * (32 * 136);
  S5Coef C; s5_coef(P, l, g, lane, C);
  bf16x8 bfr[4];
#pragma unroll
  for (int ks = 0; ks < 4; ++ks) {
    const float* src = P.in[(ks < 2) ? 16 : 17] + ((long)(l * 16 + g) * 16 + r16) * 64 + (ks & 1) * 32 + quad * 8;
    const float4 v0 = ((const float4*)src)[0], v1 = ((const float4*)src)[1];
    const float sg = (ks < 2) ? 1.f : -1.f;
    uint4 pu; pu.x = pk2(sg * v0.x, sg * v0.y); pu.y = pk2(sg * v0.z, sg * v0.w); pu.z = pk2(sg * v1.x, sg * v1.y); pu.w = pk2(sg * v1.z, sg * v1.w);
    bfr[ks] = __builtin_bit_cast(bf16x8, pu);
  }
  const float dsk = P.in[18][l * 256 + g * 16 + r16];
  s5_load_u(su, PROJ, b, chunk, g, lane);
  __syncthreads();
  const float2 c0 = ((const float2*)(WSP(P) + WS_CARRY))[((long)(b * 64 + chunk) * 16 + g) * 64 + lane];
  float xr = c0.x, xi = c0.y;
  for (int half = 0; half < 2; ++half) {
#pragma unroll 4
    for (int tt = 0; tt < 32; ++tt) {
      const int t = half * 32 + tt;
      const f32x4* up = (const f32x4*)(su + t * 16);
      float br0 = 0.f, bi0 = 0.f, br1 = 0.f, bi1 = 0.f;
#pragma unroll
      for (int q = 0; q < 4; ++q) {
        f32x4 u = up[q];
        br0 += u[0] * C.bbr[4 * q + 0]; bi0 += u[0] * C.bbi[4 * q + 0];
        br1 += u[1] * C.bbr[4 * q + 1]; bi1 += u[1] * C.bbi[4 * q + 1];
        br0 += u[2] * C.bbr[4 * q + 2]; bi0 += u[2] * C.bbi[4 * q + 2];
        br1 += u[3] * C.bbr[4 * q + 3]; bi1 += u[3] * C.bbi[4 * q + 3];
      }
      const float nr = C.ar * xr - C.ai * xi + (br0 + br1);
      const float ni = C.ar * xi + C.ai * xr + (bi0 + bi1);
      xr = nr; xi = ni;
      sX[tt * 136 + lane] = f2bf(xr);
      sX[tt * 136 + 64 + lane] = f2bf(xi);
    }
    __syncthreads();
#pragma unroll
    for (int mt = 0; mt < 2; ++mt) {
      f32x4 acc = {0.f, 0.f, 0.f, 0.f};
#pragma unroll
      for (int ks = 0; ks < 4; ++ks) {
        const bf16x8 af = *(const bf16x8*)(sX + (16 * mt + r16) * 136 + ks * 32 + quad * 8);
        acc = __builtin_amdgcn_mfma_f32_16x16x32_bf16(af, bfr[ks], acc, 0, 0, 0);
      }
#pragma unroll
      for (int j = 0; j < 4; ++j) {
        const int t = half * 32 + 16 * mt + 4 * quad + j;
        const float y = acc[j] + dsk * su[t * 16 + r16];
        Y5[((long)(b * SEQ + chunk * 64 + t)) * 256 + g * 16 + r16] = f2bf(gelu_tanh(y));
      }
    }
    __syncthreads();
  }
}

DI void nsa_prep_item(const Params& P, int l, int it) {
  const int lane = TID() & 63, w = TID() >> 6;
  u16* PROJ = (u16*)(WSP(P) + WS_PROJ);
  u16* QR = (u16*)(WSP(P) + WS_QR);
  const float* COS = (const float*)(WSP(P) + WS_COS);
  const float* SIN = (const float*)(WSP(P) + WS_SIN);
  for (int tt = 0; tt < 4; ++tt) {
    const long t = (long)it * 16 + w * 4 + tt;
    const float cs = COS[t * 8 + (lane & 7)], sn = SIN[t * 8 + (lane & 7)];
#pragma unroll
    for (int g = 0; g < 6; ++g) {
      const int col = (g < 4) ? (P_Q + g * 64) : (g == 4 ? P_KV + 128 : P_KV + 256);
      const float wg = (g < 4) ? P.in[4][l * 64 + lane] : P.in[5][(l * 3 + (g - 3)) * 64 + lane];
      u16* ptr = PROJ + t * PW + col + lane;
      float v = bf2f(*ptr);
      float ss = wave_sum(v * v);
      float y = v * rsqrtf(ss * (1.f / 64.f) + EPS) * wg;
      float pr = __shfl_xor(y, 8);
      float rot = (lane < 8) ? (y * cs - pr * sn) : ((lane < 16) ? (y * cs + pr * sn) : y);
      if (g < 4) { *ptr = f2bf(y); QR[t * 256 + g * 64 + lane] = f2bf(rot); }
      else *ptr = f2bf(rot);
    }
  }
}

DI void cmp1_tile(const Params& P, int l, int ct, u16* sA, u16* sB) {
  const int tid = TID(), lane = tid & 63, w = tid >> 6, r16 = lane & 15, quad = lane >> 4, wm = w >> 1, wn = w & 1;
  const int kv = ct >> 5, mt = (ct >> 1) & 15, nt = ct & 1;
  const u16* PROJ = (const u16*)(WSP(P) + WS_PROJ);
  u16* HID = (u16*)(WSP(P) + WS_HID);
  const u16* apq[4];
#pragma unroll
  for (int q = 0; q < 4; ++q) {
    int row, pc; g3_rowpiece(tid, q, false, row, pc);
    int gr = mt * 128 + row; if (gr > 2039) gr = 2039;
    const int b = gr / 255, n = gr % 255;
    apq[q] = PROJ + ((long)(b * SEQ + 16 * n)) * PW + P_KV + kv * 64 + pc * 8;
  }
  const u16* Bb = (const u16*)(WSP(P) + WS_W + WT_C1) + ((long)(kv * 256 + nt * 128)) * 2048;
  f32x4 acc[4][4];
  gemm3<4>(acc, apq[0], apq[1], apq[2], apq[3], PW,
           g3_ptr(Bb, 2048, tid, 0, false), g3_ptr(Bb, 2048, tid, 1, false), g3_ptr(Bb, 2048, tid, 2, false), g3_ptr(Bb, 2048, tid, 3, false), 2048, sA);
  {
    const float* PART = (const float*)(WSP(P) + WS_CBIAS) + (long)kv * 32 * 256;
#pragma unroll
    for (int ni = 0; ni < 4; ++ni) {
      const int col = nt * 128 + wn * 64 + 16 * ni + r16;
      float bsum = 0.f;
      for (int sl = 0; sl < 32; ++sl) bsum += PART[sl * 256 + col];
#pragma unroll
      for (int mi = 0; mi < 4; ++mi)
#pragma unroll
        for (int j = 0; j < 4; ++j) acc[mi][ni][j] += bsum;
    }
  }
  __syncthreads();
#pragma unroll
  for (int mi = 0; mi < 4; ++mi)
#pragma unroll
    for (int ni = 0; ni < 4; ++ni)
#pragma unroll
      for (int j = 0; j < 4; ++j) sA[(wm * 64 + 16 * mi + 4 * quad + j) * 136 + wn * 64 + 16 * ni + r16] = f2bf(gelu_tanh(acc[mi][ni][j]));
  __syncthreads();
  store_tile_bf16<128>(sA, HID + ((long)kv * 2048 + mt * 128) * 256 + nt * 128, 256, 2040 - mt * 128);
}
DI void cmp2_tile(const Params& P, int l, int ct, u16* sA, u16* sB, float* sSS) {
  const int tid = TID(), lane = tid & 63, w = tid >> 6, r16 = lane & 15, quad = lane >> 4, wm = w >> 1, wn = w & 1;
  const int kv = ct >> 4, mt = ct & 15;
  const u16* HID = (const u16*)(WSP(P) + WS_HID);
  u16* OUT = (u16*)(WSP(P) + (kv ? WS_VC : WS_KC));
  const u16* Ab = HID + ((long)kv * 2048 + mt * 128) * 256;
  const u16* Bb = (const u16*)(WSP(P) + WS_W + WT_C2) + (long)kv * 64 * 256;
  f32x4 acc[4][2];
  gemm3<2>(acc, g3_ptr(Ab, 256, tid, 0, false), g3_ptr(Ab, 256, tid, 1, false), g3_ptr(Ab, 256, tid, 2, false), g3_ptr(Ab, 256, tid, 3, false), 64,
           g3_ptr(Bb, 256, tid, 0, true), g3_ptr(Bb, 256, tid, 1, true), nullptr, nullptr, 256, sA);
  __syncthreads();
  if (tid < 128) sSS[tid] = 0.f;
  __syncthreads();
#pragma unroll
  for (int mi = 0; mi < 4; ++mi)
#pragma unroll
    for (int j = 0; j < 4; ++j) {
      float ss = acc[mi][0][j] * acc[mi][0][j] + acc[mi][1][j] * acc[mi][1][j];
      ss += __shfl_xor(ss, 1); ss += __shfl_xor(ss, 2); ss += __shfl_xor(ss, 4); ss += __shfl_xor(ss, 8);
      if (r16 == 0) atomicAdd(&sSS[wm * 64 + 16 * mi + 4 * quad + j], ss);
    }
  __syncthreads();
#pragma unroll
  for (int mi = 0; mi < 4; ++mi)
#pragma unroll
    for (int j = 0; j < 4; ++j) {
      const int rl = wm * 64 + 16 * mi + 4 * quad + j, row = mt * 128 + rl;
      const float sc = (kv == 0) ? rsqrtf(sSS[rl] * (1.f / 64.f) + EPS) : 1.f;
      if (row < 2040) {
        int b = row / 255, n = row % 255;
#pragma unroll
        for (int ni = 0; ni < 2; ++ni) {
          int col = wn * 32 + 16 * ni + r16;
          float v = acc[mi][ni][j] * sc;
          if (kv == 0) v *= P.in[5][(l * 3 + 0) * 64 + col];
          OUT[((long)(b * 256 + n)) * 64 + col] = f2bf(v);
        }
      }
    }
}

DI void gdn_p1_item(const Params& P, int l, int it, float* lds) {
  const int tid = TID(), lane = tid & 63, w = tid >> 6, r16 = lane & 15, quad = lane >> 4;
  const int chunk = it & 63, h = (it >> 6) & 3, b = it >> 8;
  const long ci = it;
  const u16* PROJ = (const u16*)(WSP(P) + WS_PROJ);
  float* sq = lds;
  float* sk = lds + 64 * 65;
  float* sv = lds + 2 * 64 * 65;
  float* sG = lds + 3 * 64 * 65;
  float* sBeta = sG + 64;
  float* sg = sBeta + 64;
  u16* sQb = (u16*)(sg + 64);
  u16* sKb = sQb + 64 * 72;
  const float* cw = P.in[20] + (long)l * 4 * 768;
  if (tid < 192) {
    const int cp = tid % 96, th = tid / 96;
    const int c0 = 2 * cp, which = c0 >> 6, d = c0 & 63, C = which * 256 + h * 64 + d;
    float w0[4], w1[4];
#pragma unroll
    for (int k = 0; k < 4; ++k) { w0[k] = cw[k * 768 + C]; w1[k] = cw[k * 768 + C + 1]; }
    unsigned v[35];
    const int s0 = chunk * 64 + th * 32 - 3;
    const u16* src = PROJ + ((long)(b * SEQ + s0)) * PW + P_GQKV + C;
#pragma unroll
    for (int k = 0; k < 35; ++k) v[k] = (s0 + k >= 0) ? *(const unsigned*)(src + (long)k * PW) : 0u;
    float* dst = lds + which * 64 * 65 + (th * 32) * 65 + d;
#pragma unroll
    for (int tt = 0; tt < 32; ++tt) {
      float a0 = 0.f, a1 = 0.f;
#pragma unroll
      for (int k = 0; k < 4; ++k) { a0 += w0[k] * bf2f((u16)(v[tt + k] & 0xffff)); a1 += w1[k] * bf2f((u16)(v[tt + k] >> 16)); }
      dst[tt * 65] = siluf_(a0); dst[tt * 65 + 1] = siluf_(a1);
    }
  }
  __syncthreads();
  if (tid < 128) {
    float* base = (tid < 64) ? sq : sk;
    u16* bb = (tid < 64) ? sQb : sKb;
    const int row = tid & 63;
    float ss = 0.f;
#pragma unroll 8
    for (int d = 0; d < 64; ++d) { float x = base[row * 65 + d]; ss += x * x; }
    const float sc = rsqrtf(ss + EPS) * ((tid < 64) ? 0.125f : 1.f);
#pragma unroll 8
    for (int d = 0; d < 64; d += 2) {
      const float x0 = base[row * 65 + d] * sc, x1 = base[row * 65 + d + 1] * sc;
      base[row * 65 + d] = x0; base[row * 65 + d + 1] = x1;
      *(unsigned*)(bb + row * 72 + d) = pk2(x0, x1);
    }
  } else if (tid < 192) {
    const int row = tid - 128;
    const long t = (long)(b * SEQ + chunk * 64 + row);
    const float bl = bf2f(PROJ[t * PW + P_GB + h]);
    const float al = bf2f(PROJ[t * PW + P_GA + h]);
    sBeta[row] = sigmoidf_(bl);
    sg[row] = -expf(P.in[21][l * 4 + h]) * softplusf_(al + P.in[22][l * 4 + h]);
  }
  __syncthreads();
  if (tid < 64) {
    float x = sg[tid];
#pragma unroll
    for (int o = 1; o < 64; o <<= 1) { float u = __shfl_up(x, o); if (tid >= o) x += u; }
    sG[tid] = x;
    ((float*)(WSP(P) + WS_GG))[ci * 64 + tid] = x;
  }
  __syncthreads();
  f32x4 lreg[4];
  {
    const f32x4 Gi4 = *(const f32x4*)(sG + 16 * w + 4 * quad);
    const f32x4 Bi4 = *(const f32x4*)(sBeta + 16 * w + 4 * quad);
    u16* GA = (u16*)(WSP(P) + WS_GA) + ci * 4096;
#pragma unroll
    for (int nt = 0; nt < 4; ++nt) {
      f32x4 aq = {0.f, 0.f, 0.f, 0.f}, ak = {0.f, 0.f, 0.f, 0.f};
#pragma unroll
      for (int ks = 0; ks < 2; ++ks) {
        const bf16x8 fq = *(const bf16x8*)(sQb + (16 * w + r16) * 72 + ks * 32 + quad * 8);
        const bf16x8 fk = *(const bf16x8*)(sKb + (16 * w + r16) * 72 + ks * 32 + quad * 8);
        const bf16x8 fb = *(const bf16x8*)(sKb + (16 * nt + r16) * 72 + ks * 32 + quad * 8);
        aq = __builtin_amdgcn_mfma_f32_16x16x32_bf16(fq, fb, aq, 0, 0, 0);
        ak = __builtin_amdgcn_mfma_f32_16x16x32_bf16(fk, fb, ak, 0, 0, 0);
      }
      const int j = 16 * nt + r16;
      const float Gj = sG[j];
#pragma unroll
      for (int jj = 0; jj < 4; ++jj) {
        const int i = 16 * w + 4 * quad + jj;
        const float dec = __expf(Gi4[jj] - Gj);
        GA[i * 64 + j] = f2bf((j <= i) ? aq[jj] * dec : 0.f);
        const float lv = (j < i) ? Bi4[jj] * ak[jj] * dec : 0.f;
        sq[i * 65 + j] = lv;
        lreg[nt][jj] = lv;
      }
    }
  }
  {
    u16* GQ = (u16*)(WSP(P) + WS_GQ) + ci * 4096;
#pragma unroll
    for (int q = 0; q < 2; ++q) { const int c = tid + 256 * q, row = c >> 3, ch = c & 7; *(uint4*)(GQ + row * 64 + ch * 8) = *(const uint4*)(sQb + row * 72 + ch * 8); }
    const int i = tid >> 2, j0 = (tid & 3) * 16;
    u16* GK = (u16*)(WSP(P) + WS_GK) + ci * 4096 + i * 64 + j0;
    unsigned ok[8];
#pragma unroll
    for (int q = 0; q < 8; ++q) ok[q] = pk2(sk[(j0 + 2 * q) * 65 + i], sk[(j0 + 2 * q + 1) * 65 + i]);
    ((uint4*)GK)[0] = make_uint4(ok[0], ok[1], ok[2], ok[3]); ((uint4*)GK)[1] = make_uint4(ok[4], ok[5], ok[6], ok[7]);
  }
  __syncthreads();
  u16* sLb = sQb;
  u16* sXT = sKb;
  {
    const int i = tid >> 2, j0 = (tid & 3) * 16;
    const float bi = sBeta[i], eg = __expf(sG[i]);
#pragma unroll
    for (int jj = 0; jj < 16; ++jj) { sv[i * 65 + j0 + jj] *= bi; sk[i * 65 + j0 + jj] *= bi * eg; }
#pragma unroll
    for (int nt = 0; nt < 4; ++nt)
#pragma unroll
      for (int jj = 0; jj < 4; ++jj) sLb[(16 * w + 4 * quad + jj) * 72 + 16 * nt + r16] = f2bf(lreg[nt][jj]);
  }
  __syncthreads();
#pragma unroll 1
  for (int bi = 0; bi < 4; ++bi) {
    if (tid < 128) {
      float* buf = (tid < 64) ? sv : sk;
      const int col = tid & 63;
      float x[16];
#pragma unroll
      for (int r = 0; r < 16; ++r) {
        float a0 = buf[(16 * bi + r) * 65 + col], a1 = 0.f;
#pragma unroll
        for (int j = 0; j + 1 < r; j += 2) { a0 -= sq[(16 * bi + r) * 65 + 16 * bi + j] * x[j]; a1 -= sq[(16 * bi + r) * 65 + 16 * bi + j + 1] * x[j + 1]; }
        if (r & 1) a0 -= sq[(16 * bi + r) * 65 + 16 * bi + r - 1] * x[r - 1];
        x[r] = a0 + a1;
        buf[(16 * bi + r) * 65 + col] = x[r];
      }
      uint4 p0, p1;
      p0.x = pk2(x[0], x[1]); p0.y = pk2(x[2], x[3]); p0.z = pk2(x[4], x[5]); p0.w = pk2(x[6], x[7]);
      p1.x = pk2(x[8], x[9]); p1.y = pk2(x[10], x[11]); p1.z = pk2(x[12], x[13]); p1.w = pk2(x[14], x[15]);
      *(uint4*)(sXT + tid * 24) = p0; *(uint4*)(sXT + tid * 24 + 8) = p1;
    }
    __syncthreads();
    if (bi < 3) {
#pragma unroll
      for (int q = 0; q < 2; ++q) {
        const int nt = 2 * w + q, colg = 16 * nt + r16;
        bf16x8 bx = *(const bf16x8*)(sXT + colg * 24 + (quad & 1) * 8);
        if (quad >= 2) bx = (bf16x8){0, 0, 0, 0, 0, 0, 0, 0};
        float* buf = (colg < 64) ? sv : sk;
        const int cc = colg & 63;
        for (int bk = bi + 1; bk < 4; ++bk) {
          const bf16x8 al = *(const bf16x8*)(sLb + (16 * bk + r16) * 72 + 16 * bi + quad * 8);
          f32x4 c = {0.f, 0.f, 0.f, 0.f};
          c = __builtin_amdgcn_mfma_f32_16x16x32_bf16(al, bx, c, 0, 0, 0);
#pragma unroll
          for (int jj = 0; jj < 4; ++jj) buf[(16 * bk + 4 * quad + jj) * 65 + cc] -= c[jj];
        }
      }
    }
    __syncthreads();
  }
  {
    const int i = tid >> 2, j0 = (tid & 3) * 16;
    u16* GU = (u16*)(WSP(P) + WS_GU) + ci * 4096 + i * 64 + j0;
    u16* GW = (u16*)(WSP(P) + WS_GW) + ci * 4096 + i * 64 + j0;
    unsigned ou[8], ow[8];
#pragma unroll
    for (int q = 0; q < 8; ++q) {
      ou[q] = pk2(sv[i * 65 + j0 + 2 * q], sv[i * 65 + j0 + 2 * q + 1]);
      ow[q] = pk2(sk[i * 65 + j0 + 2 * q], sk[i * 65 + j0 + 2 * q + 1]);
    }
    ((uint4*)GU)[0] = make_uint4(ou[0], ou[1], ou[2], ou[3]); ((uint4*)GU)[1] = make_uint4(ou[4], ou[5], ou[6], ou[7]);
    ((uint4*)GW)[0] = make_uint4(ow[0], ow[1], ow[2], ow[3]); ((uint4*)GW)[1] = make_uint4(ow[4], ow[5], ow[6], ow[7]);
  }
}

DI void unpack8(const u16* p, float (&o)[8]) {
  uint4 v = *(const uint4*)p;
  o[0] = bf2f((u16)(v.x & 0xffff)); o[1] = bf2f((u16)(v.x >> 16));
  o[2] = bf2f((u16)(v.y & 0xffff)); o[3] = bf2f((u16)(v.y >> 16));
  o[4] = bf2f((u16)(v.z & 0xffff)); o[5] = bf2f((u16)(v.z >> 16));
  o[6] = bf2f((u16)(v.w & 0xffff)); o[7] = bf2f((u16)(v.w >> 16));
}
DI void st_kt(u16* sKt, int c8, int row, uint4 k) {
  sKt[(c8 + 0) * 72 + row] = (u16)(k.x & 0xffff); sKt[(c8 + 1) * 72 + row] = (u16)(k.x >> 16);
  sKt[(c8 + 2) * 72 + row] = (u16)(k.y & 0xffff); sKt[(c8 + 3) * 72 + row] = (u16)(k.y >> 16);
  sKt[(c8 + 4) * 72 + row] = (u16)(k.z & 0xffff); sKt[(c8 + 5) * 72 + row] = (u16)(k.z >> 16);
  sKt[(c8 + 6) * 72 + row] = (u16)(k.w & 0xffff); sKt[(c8 + 7) * 72 + row] = (u16)(k.w >> 16);
}
DI uint2 pack4bf(const f32x4& v) { uint2 r; r.x = pk2(v[0], v[1]); r.y = pk2(v[2], v[3]); return r; }
DI void gdn_p2_item(const Params& P, int it, float* lds) {
  const int tid = TID(), lane = tid & 63, w = tid >> 6, r16 = lane & 15, quad = lane >> 4;
  const int es = it & 3, bh = it >> 2, b = bh >> 2, h = bh & 3;
  u16* sW = (u16*)lds;
  u16* sQ = sW + 64 * 72;
  u16* sAm = sQ + 64 * 72;
  u16* sKt = sAm + 64 * 72;
  u16* sSt = sKt + 64 * 72;
  u16* sVnT = sSt + 16 * 72;
  u16* sVdT = sVnT + 16 * 72;
  float* sG = (float*)(sVdT + 16 * 72);
  const u16* GQ = (const u16*)(WSP(P) + WS_GQ); const u16* GK = (const u16*)(WSP(P) + WS_GK);
  const u16* GU = (const u16*)(WSP(P) + WS_GU); const u16* GW = (const u16*)(WSP(P) + WS_GW);
  const u16* GA = (const u16*)(WSP(P) + WS_GA); const float* GG = (const float*)(WSP(P) + WS_GG);
  u16* ORAW = (u16*)(WSP(P) + WS_OM) + (long)2 * T_ * 256;
  f32x4 S = {0.f, 0.f, 0.f, 0.f};
  const int irow = 16 * w + 4 * quad;
  uint4 rw0, rw1, rq0, rq1, ra0, ra1, rk0, rk1; u16 ru0, ru1, ru2, ru3; float rg = 0.f;
  const int c0 = tid, c1 = tid + 256;
  const long off0 = (c0 >> 3) * 64 + (c0 & 7) * 8, off1 = (c1 >> 3) * 64 + (c1 & 7) * 8;
#define GDN_GLOAD(CH) { long ci_ = (long)bh * 64 + (CH); \
    rw0 = *(const uint4*)(GW + ci_ * 4096 + off0); rw1 = *(const uint4*)(GW + ci_ * 4096 + off1); \
    rq0 = *(const uint4*)(GQ + ci_ * 4096 + off0); rq1 = *(const uint4*)(GQ + ci_ * 4096 + off1); \
    ra0 = *(const uint4*)(GA + ci_ * 4096 + off0); ra1 = *(const uint4*)(GA + ci_ * 4096 + off1); \
    rk0 = *(const uint4*)(GK + ci_ * 4096 + off0); rk1 = *(const uint4*)(GK + ci_ * 4096 + off1); \
    const u16* up_ = GU + ci_ * 4096 + irow * 64 + es * 16 + r16; \
    ru0 = up_[0]; ru1 = up_[64]; ru2 = up_[128]; ru3 = up_[192]; \
    if (tid < 64) rg = GG[ci_ * 64 + tid]; }
  GDN_GLOAD(0)
  for (int ch = 0; ch < 64; ++ch) {
    __syncthreads();
    {
      const int row0 = c0 >> 3, c80 = (c0 & 7) * 8, row1 = c1 >> 3, c81 = (c1 & 7) * 8;
      *(uint4*)(sW + row0 * 72 + c80) = rw0; *(uint4*)(sW + row1 * 72 + c81) = rw1;
      *(uint4*)(sQ + row0 * 72 + c80) = rq0; *(uint4*)(sQ + row1 * 72 + c81) = rq1;
      *(uint4*)(sAm + row0 * 72 + c80) = ra0; *(uint4*)(sAm + row1 * 72 + c81) = ra1;
      *(uint4*)(sKt + row0 * 72 + c80) = rk0; *(uint4*)(sKt + row1 * 72 + c81) = rk1;
    }
    if (tid < 64) sG[tid] = rg;
    *(uint2*)(sSt + r16 * 72 + irow) = pack4bf(S);
    const f32x4 uc = {bf2f(ru0), bf2f(ru1), bf2f(ru2), bf2f(ru3)};
    __syncthreads();
    if (ch + 1 < 64) GDN_GLOAD(ch + 1)
    f32x4 ws = {0.f, 0.f, 0.f, 0.f}, qs = {0.f, 0.f, 0.f, 0.f};
#pragma unroll
    for (int ks = 0; ks < 2; ++ks) {
      const bf16x8 bS = *(const bf16x8*)(sSt + r16 * 72 + ks * 32 + quad * 8);
      const bf16x8 aW = *(const bf16x8*)(sW + (16 * w + r16) * 72 + ks * 32 + quad * 8);
      const bf16x8 aQ = *(const bf16x8*)(sQ + (16 * w + r16) * 72 + ks * 32 + quad * 8);
      ws = __builtin_amdgcn_mfma_f32_16x16x32_bf16(aW, bS, ws, 0, 0, 0);
      qs = __builtin_amdgcn_mfma_f32_16x16x32_bf16(aQ, bS, qs, 0, 0, 0);
    }
    const float Gl = sG[63];
    const f32x4 G4 = *(const f32x4*)(sG + irow);
    f32x4 vn, vd;
#pragma unroll
    for (int j = 0; j < 4; ++j) { vn[j] = uc[j] - ws[j]; vd[j] = vn[j] * __expf(Gl - G4[j]); }
    *(uint2*)(sVnT + r16 * 72 + irow) = pack4bf(vn);
    *(uint2*)(sVdT + r16 * 72 + irow) = pack4bf(vd);
    __syncthreads();
    f32x4 av = {0.f, 0.f, 0.f, 0.f}, kv = {0.f, 0.f, 0.f, 0.f};
#pragma unroll
    for (int ks = 0; ks < 2; ++ks) {
      const bf16x8 bVn = *(const bf16x8*)(sVnT + r16 * 72 + ks * 32 + quad * 8);
      const bf16x8 bVd = *(const bf16x8*)(sVdT + r16 * 72 + ks * 32 + quad * 8);
      const bf16x8 aA = *(const bf16x8*)(sAm + (16 * w + r16) * 72 + ks * 32 + quad * 8);
      const bf16x8 aK = *(const bf16x8*)(sKt + (16 * w + r16) * 72 + ks * 32 + quad * 8);
      av = __builtin_amdgcn_mfma_f32_16x16x32_bf16(aA, bVn, av, 0, 0, 0);
      kv = __builtin_amdgcn_mfma_f32_16x16x32_bf16(aK, bVd, kv, 0, 0, 0);
    }
    {
      u16* op = ORAW + ((long)(b * SEQ + ch * 64 + irow)) * 256 + h * 64 + es * 16 + r16;
#pragma unroll
      for (int j = 0; j < 4; ++j) op[j * 256] = f2bf(__expf(G4[j]) * qs[j] + av[j]);
    }
    const float gl = __expf(Gl);
#pragma unroll
    for (int j = 0; j < 4; ++j) S[j] = S[j] * gl + kv[j];
  }
#undef GDN_GLOAD
}
DI void gdn_post_item(const Params& P, int l, int it) {
  const int lane = TID() & 63, w = TID() >> 6;
  const u16* PROJ = (const u16*)(WSP(P) + WS_PROJ);
  u16* O = (u16*)(WSP(P) + WS_OM) + (long)2 * T_ * 256;
  const float wn = P.in[23][l * 64 + lane];
#pragma unroll 4
  for (int q = 0; q < 16; ++q) {
    long t = (long)it * 16 + w * 4 + (q >> 2); int h = q & 3;
    float o = bf2f(O[t * 256 + h * 64 + lane]);
    float ss = wave_sum(o * o);
    float y = o * rsqrtf(ss * (1.f / 64.f) + EPS) * wn;
    float z = bf2f(PROJ[t * PW + P_GZ + h * 64 + lane]);
    O[t * 256 + h * 64 + lane] = f2bf(y * siluf_(z));
  }
}

DI void kv_gload(uint4& k0, uint4& k1, uint4& v0, uint4& v1, const u16* ksrc, const u16* vsrc, long ld) {
  const int tid = TID(), r0 = tid >> 3, ch = tid & 7;
  k0 = *(const uint4*)(ksrc + (long)r0 * ld + ch * 8); k1 = *(const uint4*)(ksrc + (long)(r0 + 32) * ld + ch * 8);
  v0 = *(const uint4*)(vsrc + (long)r0 * ld + ch * 8); v1 = *(const uint4*)(vsrc + (long)(r0 + 32) * ld + ch * 8);
}
DI void k_gload(uint4& k0, uint4& k1, const u16* ksrc, long ld) {
  const int tid = TID(), r0 = tid >> 3, ch = tid & 7;
  k0 = *(const uint4*)(ksrc + (long)r0 * ld + ch * 8); k1 = *(const uint4*)(ksrc + (long)(r0 + 32) * ld + ch * 8);
}
DI void k_store(const uint4& k0, const uint4& k1, u16* sK) {
  const int tid = TID(), r0 = tid >> 3, ch = tid & 7;
  *(uint4*)(sK + r0 * 72 + ch * 8) = k0; *(uint4*)(sK + (r0 + 32) * 72 + ch * 8) = k1;
}
DI void kv_store(const uint4& k0, const uint4& k1, const uint4& v0, const uint4& v1, u16* sK, u16* sVt) {
  const int tid = TID(), r0 = tid >> 3, ch = tid & 7;
  *(uint4*)(sK + r0 * 72 + ch * 8) = k0; *(uint4*)(sK + (r0 + 32) * 72 + ch * 8) = k1;
  const int ksw = 16 * (ch >> 1);
  st_kt(sVt, ch * 8, r0 ^ ksw, v0); st_kt(sVt, ch * 8, (r0 + 32) ^ ksw, v1);
}
DI void sb_attn_item(const Params& P, int it, u16* sQ, u16* sK, u16* sVt) {
  const int tid = TID(), lane = tid & 63, w = tid >> 6, r16 = lane & 15, quad = lane >> 4;
  const int qb = 63 - (it >> 5), bh = it & 31, b = bh >> 2, h = bh & 3;
  const u16* PROJ = (const u16*)(WSP(P) + WS_PROJ);
  u16* OUT = (u16*)(WSP(P) + WS_OM) + (long)3 * T_ * 256;
  const long tb = (long)b * SEQ;
  load_tile(sQ, PROJ + (tb + qb * 64) * PW + P_SB + h * 64, PW);
  __syncthreads();
  bf16x8 bq[2]; load_qfrag(bq, sQ, w, lane);
  const int tq = qb * 64 + 16 * w + r16;
  f32x4 ot[4];
#pragma unroll
  for (int dt = 0; dt < 4; ++dt) ot[dt] = (f32x4){0.f, 0.f, 0.f, 0.f};
  float R = 0.f;
  uint4 pk0, pk1, pv0, pv1;
  kv_gload(pk0, pk1, pv0, pv1, PROJ + (tb + qb * 64) * PW + P_SB + 256 + h * 64, PROJ + (tb + qb * 64) * PW + P_SB + 512 + h * 64, PW);
  for (int kb = qb; kb >= 0; --kb) {
    if (__syncthreads_and(R < -104.f)) break;
    kv_store(pk0, pk1, pv0, pv1, sK, sVt);
    __syncthreads();
    if (kb > 0) kv_gload(pk0, pk1, pv0, pv1, PROJ + (tb + (kb - 1) * 64) * PW + P_SB + 256 + h * 64, PROJ + (tb + (kb - 1) * 64) * PW + P_SB + 512 + h * 64, PW);
    f32x4 st[4];
    st_mma(st, sK, bq, lane);
    float gs[4], zz[4][4], x[4][4];
#pragma unroll
    for (int mt = 0; mt < 4; ++mt) {
      float g = 0.f;
#pragma unroll
      for (int j = 0; j < 4; ++j) {
        int s = kb * 64 + 16 * mt + 4 * quad + j;
        float z = st[mt][j] * 0.125f;
        float sp = softplusf_(z);
        bool mk = s < tq;
        x[mt][j] = mk ? -sp : 0.f;
        zz[mt][j] = mk ? (z - sp) : -1e30f;
        g += x[mt][j];
      }
      gs[mt] = g;
    }
    float hm = 0.f, tot_all = 0.f;
    f32x4 pw[4];
#pragma unroll
    for (int mt = 3; mt >= 0; --mt) {
      float g = gs[mt];
      float v1 = __shfl_down(g, 16), v2 = __shfl_down(g, 32), v3 = __shfl_down(g, 48);
      float hq = (quad < 3 ? v1 : 0.f) + (quad < 2 ? v2 : 0.f) + (quad < 1 ? v3 : 0.f);
      float tot = quad_sum(g);
      float base = R + hm + hq;
      float e3 = 0.f, e2 = x[mt][3], e1 = e2 + x[mt][2], e0 = e1 + x[mt][1];
      pw[mt][0] = __expf(zz[mt][0] + base + e0);
      pw[mt][1] = __expf(zz[mt][1] + base + e1);
      pw[mt][2] = __expf(zz[mt][2] + base + e2);
      pw[mt][3] = __expf(zz[mt][3] + base + e3);
      hm += tot; tot_all += tot;
    }
    R += tot_all;
    pv_mma(ot, sVt, pw, lane);
  }
  const long t = tb + tq;
#pragma unroll
  for (int dt = 0; dt < 4; ++dt) {
    uint2 ov; ov.x = pk2(ot[dt][0], ot[dt][1]); ov.y = pk2(ot[dt][2], ot[dt][3]);
    *(uint2*)(OUT + t * 256 + h * 64 + 16 * dt + 4 * quad) = ov;
  }
}

DI void win_attn_item(const Params& P, int it, u16* sQ, u16* sKunused, u16* sVunused) {
  const int tid = TID(), lane = tid & 63, w = tid >> 6, r16 = lane & 15, quad = lane >> 4;
  const int tbk = 127 - (it >> 3), b = it & 7;
  u16* sK = sQ + 128 * 72;
  u16* sVt = sK + 64 * 72;
  (void)sKunused; (void)sVunused;
  const u16* PROJ = (const u16*)(WSP(P) + WS_PROJ);
  const u16* QR = (const u16*)(WSP(P) + WS_QR);
  u16* OW = (u16*)(WSP(P) + WS_OW);
  const long tb = (long)b * SEQ;
  const int t0 = tbk * 32;
#pragma unroll
  for (int i = 0; i < 4; ++i) {
    const int c = tid + 256 * i, row = c >> 3, ch = c & 7;
    *(uint4*)(sQ + row * 72 + ch * 8) = *(const uint4*)(QR + (tb + t0 + (row & 31)) * 256 + (row >> 5) * 64 + ch * 8);
  }
  __syncthreads();
  bf16x8 bq[2][2];
  int tq[2];
#pragma unroll
  for (int qt = 0; qt < 2; ++qt) {
    const int rowq = 32 * w + 16 * qt + r16;
    bq[qt][0] = *(const bf16x8*)(sQ + rowq * 72 + quad * 8);
    bq[qt][1] = *(const bf16x8*)(sQ + rowq * 72 + 32 + quad * 8);
    tq[qt] = t0 + 16 * qt + r16;
  }
  f32x4 ot[2][4];
#pragma unroll
  for (int qt = 0; qt < 2; ++qt)
#pragma unroll
    for (int dt = 0; dt < 4; ++dt) ot[qt][dt] = (f32x4){0.f, 0.f, 0.f, 0.f};
  float m[2] = {-1e30f, -1e30f}, lsum[2] = {0.f, 0.f};
  const int lo = (t0 - 511) > 0 ? (t0 - 511) : 0;
  const int kb_lo = lo >> 6, kb_hi = (t0 + 31) >> 6;
  uint4 pk0, pk1, pv0, pv1;
  kv_gload(pk0, pk1, pv0, pv1, PROJ + (tb + kb_lo * 64) * PW + P_KV + 256, PROJ + (tb + kb_lo * 64) * PW + P_KV + 320, PW);
  for (int kb = kb_lo; kb <= kb_hi; ++kb) {
    __syncthreads();
    kv_store(pk0, pk1, pv0, pv1, sK, sVt);
    __syncthreads();
    if (kb < kb_hi) kv_gload(pk0, pk1, pv0, pv1, PROJ + (tb + (kb + 1) * 64) * PW + P_KV + 256, PROJ + (tb + (kb + 1) * 64) * PW + P_KV + 320, PW);
#pragma unroll
    for (int qt = 0; qt < 2; ++qt) {
      f32x4 st[4];
      st_mma(st, sK, bq[qt], lane);
      bool msk[4][4];
#pragma unroll
      for (int mt = 0; mt < 4; ++mt)
#pragma unroll
        for (int j = 0; j < 4; ++j) { int s = kb * 64 + 16 * mt + 4 * quad + j; int df = tq[qt] - s; msk[mt][j] = (df >= 0) && (df < 512); }
      softmax_tile(st, msk, m[qt], lsum[qt], ot[qt]);
      pv_mma(ot[qt], sVt, st, lane);
    }
  }
#pragma unroll
  for (int qt = 0; qt < 2; ++qt) {
    const float ls = quad_sum(lsum[qt]);
    const float inv = 1.f / fmaxf(ls, 1e-30f);
    const long t = tb + tq[qt];
#pragma unroll
    for (int dt = 0; dt < 4; ++dt) {
      uint2 ov; ov.x = pk2(ot[qt][dt][0] * inv, ot[qt][dt][1] * inv); ov.y = pk2(ot[qt][dt][2] * inv, ot[qt][dt][3] * inv);
      *(uint2*)(OW + t * 256 + w * 64 + 16 * dt + 4 * quad) = ov;
    }
  }
}

DI void cmp_attn_item(const Params& P, int it, u16* sQ, u16* sK, u16* sVt, float* sImp) {
  const int tid = TID(), lane = tid & 63, w = tid >> 6, r16 = lane & 15, quad = lane >> 4;
  const int tbk = 255 - (it >> 3), b = it & 7;
  const u16* PROJ = (const u16*)(WSP(P) + WS_PROJ);
  const u16* KC = (const u16*)(WSP(P) + WS_KC) + (long)b * 256 * 64;
  const u16* VC = (const u16*)(WSP(P) + WS_VC) + (long)b * 256 * 64;
  u16* OC = (u16*)(WSP(P) + WS_OC);
  u64* SEL = (u64*)(WSP(P) + WS_SEL);
  const long tb = (long)b * SEQ;
  const int t0 = tbk * 16;
  load_q_nsa(sQ, PROJ + (tb + t0) * PW + P_Q, PW);
  for (int e = tid; e < 4 * 16 * 64; e += 256) sImp[e] = 0.f;
  __syncthreads();
  bf16x8 bq[2]; load_qfrag(bq, sQ, w, lane);
  const int tq = t0 + r16;
  const int nv = (tq >= 31) ? ((tq - 31) >> 4) + 1 : 0;
  const int nvmax = (t0 + 15 >= 31) ? ((t0 + 15 - 31) >> 4) + 1 : 0;
  const int ntile = (nvmax + 63) >> 6;
  float m = -1e30f, lsum = 0.f;
  uint4 pk0, pk1, pv0, pv1;
  if (ntile > 0) k_gload(pk0, pk1, KC, 64);
  for (int kt = 0; kt < ntile; ++kt) {
    __syncthreads();
    k_store(pk0, pk1, sK);
    __syncthreads();
    if (kt + 1 < ntile) k_gload(pk0, pk1, KC + (kt + 1) * 64 * 64, 64);
    f32x4 st[4];
    st_mma(st, sK, bq, lane);
    float tm = -1e30f;
#pragma unroll
    for (int mt = 0; mt < 4; ++mt)
#pragma unroll
      for (int j = 0; j < 4; ++j) { int n = kt * 64 + 16 * mt + 4 * quad + j; float s = st[mt][j] * 0.125f; st[mt][j] = s; if (n < nv) tm = fmaxf(tm, s); }
    tm = quad_max(tm);
    float mn = fmaxf(m, tm);
    float ps = 0.f;
#pragma unroll
    for (int mt = 0; mt < 4; ++mt)
#pragma unroll
      for (int j = 0; j < 4; ++j) { int n = kt * 64 + 16 * mt + 4 * quad + j; if (n < nv) ps += __expf(st[mt][j] - mn); }
    lsum = lsum * __expf(m - mn) + ps;
    m = mn;
  }
  lsum = quad_sum(lsum);
  const float inv = (lsum > 0.f) ? 1.f / lsum : 0.f;
  f32x4 ot[4];
#pragma unroll
  for (int dt = 0; dt < 4; ++dt) ot[dt] = (f32x4){0.f, 0.f, 0.f, 0.f};
  float carry = 0.f;
  if (ntile > 0) kv_gload(pk0, pk1, pv0, pv1, KC, VC, 64);
  for (int kt = 0; kt < ntile; ++kt) {
    __syncthreads();
    kv_store(pk0, pk1, pv0, pv1, sK, sVt);
    __syncthreads();
    if (kt + 1 < ntile) kv_gload(pk0, pk1, pv0, pv1, KC + (kt + 1) * 64 * 64, VC + (kt + 1) * 64 * 64, 64);
    f32x4 st[4];
    st_mma(st, sK, bq, lane);
#pragma unroll
    for (int mt = 0; mt < 4; ++mt)
#pragma unroll
      for (int j = 0; j < 4; ++j) { int n = kt * 64 + 16 * mt + 4 * quad + j; st[mt][j] = (n < nv) ? __expf(st[mt][j] * 0.125f - m) * inv : 0.f; }
    pv_mma(ot, sVt, st, lane);
    float prevlast = carry;
#pragma unroll
    for (int mt = 0; mt < 4; ++mt) {
      float pl = st[mt][3];
      float fd = __shfl_up(pl, 16);
      float pprev = (quad > 0) ? fd : prevlast;
      float v = st[mt][0] + st[mt][1] + st[mt][2] + st[mt][3] + pprev;
      sImp[(w * 16 + r16) * 64 + kt * 16 + mt * 4 + quad] = v;
      prevlast = __shfl_down(pl, 48);
    }
    carry = prevlast;
  }
  {
    const long t = tb + tq;
#pragma unroll
    for (int dt = 0; dt < 4; ++dt) {
      uint2 ov; ov.x = pk2(ot[dt][0], ot[dt][1]); ov.y = pk2(ot[dt][2], ot[dt][3]);
      *(uint2*)(OC + t * 256 + w * 64 + 16 * dt + 4 * quad) = ov;
    }
  }
  __syncthreads();
  for (int q = 0; q < 4; ++q) {
    const int tok = 4 * w + q, t = t0 + tok;
    float v = sImp[(0 * 16 + tok) * 64 + lane] + sImp[(1 * 16 + tok) * 64 + lane] + sImp[(2 * 16 + tok) * 64 + lane] + sImp[(3 * 16 + tok) * 64 + lane];
    const int cur = t >> 6;
    if (lane == 0 || lane == cur) v = 1e9f;
    else if (lane * 64 > t) v = -1e30f;
    int cnt = 0;
#pragma unroll
    for (int i2 = 0; i2 < 64; ++i2) {
      float vi = __builtin_bit_cast(float, __builtin_amdgcn_readlane(__builtin_bit_cast(int, v), i2));
      cnt += (vi > v || (vi == v && i2 < lane)) ? 1 : 0;
    }
    u64 mask = __ballot(cnt < 16);
    if (lane == 0) SEL[tb + t] = mask;
  }
}

DI void sel_attn_item(const Params& P, int it, u16* sQ, u16* sKunused, u16* sVunused) {
  const int tid = TID(), lane = tid & 63, w = tid >> 6, r16 = lane & 15, quad = lane >> 4;
  const int tbk = 127 - (it >> 3), b = it & 7;
  u16* sK = sQ + 128 * 72;
  u16* sVt = sK + 64 * 72;
  (void)sKunused; (void)sVunused;
  const u16* PROJ = (const u16*)(WSP(P) + WS_PROJ);
  const u16* QR = (const u16*)(WSP(P) + WS_QR);
  const u16* OC = (const u16*)(WSP(P) + WS_OC);
  const u16* OW = (const u16*)(WSP(P) + WS_OW);
  const u64* SEL = (const u64*)(WSP(P) + WS_SEL);
  u16* OUT = (u16*)(WSP(P) + WS_OM);
  const long tb = (long)b * SEQ;
  const int t0 = tbk * 32;
#pragma unroll
  for (int i = 0; i < 4; ++i) {
    const int c = tid + 256 * i, row = c >> 3, ch = c & 7;
    *(uint4*)(sQ + row * 72 + ch * 8) = *(const uint4*)(QR + (tb + t0 + (row & 31)) * 256 + (row >> 5) * 64 + ch * 8);
  }
  __syncthreads();
  bf16x8 bq[2][2];
  int tq[2]; u64 mysel[2];
#pragma unroll
  for (int qt = 0; qt < 2; ++qt) {
    const int rowq = 32 * w + 16 * qt + r16;
    bq[qt][0] = *(const bf16x8*)(sQ + rowq * 72 + quad * 8);
    bq[qt][1] = *(const bf16x8*)(sQ + rowq * 72 + 32 + quad * 8);
    tq[qt] = t0 + 16 * qt + r16;
    mysel[qt] = SEL[tb + tq[qt]];
  }
  u64 uni = 0;
#pragma unroll
  for (int q = 0; q < 32; ++q) uni |= SEL[tb + t0 + q];
  const int cur = t0 >> 6;
  uni &= (cur == 63) ? ~0ull : ((1ull << (cur + 1)) - 1ull);
  f32x4 ot[2][4];
#pragma unroll
  for (int qt = 0; qt < 2; ++qt)
#pragma unroll
    for (int dt = 0; dt < 4; ++dt) ot[qt][dt] = (f32x4){0.f, 0.f, 0.f, 0.f};
  float m[2] = {-1e30f, -1e30f}, lsum[2] = {0.f, 0.f};
  uint4 pk0, pk1, pv0, pv1;
  int kb = uni ? (__ffsll((long long)uni) - 1) : -1;
  uni &= uni - 1;
  if (kb >= 0) kv_gload(pk0, pk1, pv0, pv1, PROJ + (tb + kb * 64) * PW + P_KV + 128, PROJ + (tb + kb * 64) * PW + P_KV + 192, PW);
  for (int nkb = -1; kb >= 0; kb = nkb) {
    __syncthreads();
    kv_store(pk0, pk1, pv0, pv1, sK, sVt);
    __syncthreads();
    nkb = uni ? (__ffsll((long long)uni) - 1) : -1;
    uni &= uni - 1;
    if (nkb >= 0) kv_gload(pk0, pk1, pv0, pv1, PROJ + (tb + nkb * 64) * PW + P_KV + 128, PROJ + (tb + nkb * 64) * PW + P_KV + 192, PW);
#pragma unroll
    for (int qt = 0; qt < 2; ++qt) {
      f32x4 st[4];
      st_mma(st, sK, bq[qt], lane);
      const bool selq = (mysel[qt] >> kb) & 1ull;
      bool msk[4][4];
#pragma unroll
      for (int mt = 0; mt < 4; ++mt)
#pragma unroll
        for (int j = 0; j < 4; ++j) { int s = kb * 64 + 16 * mt + 4 * quad + j; msk[mt][j] = selq && (s <= tq[qt]); }
      softmax_tile(st, msk, m[qt], lsum[qt], ot[qt]);
      pv_mma(ot[qt], sVt, st, lane);
    }
  }
#pragma unroll
  for (int qt = 0; qt < 2; ++qt) {
    const float ls = quad_sum(lsum[qt]);
    const float inv = 1.f / fmaxf(ls, 1e-30f);
    const long t = tb + tq[qt];
    const float gc = sigmoidf_(bf2f(PROJ[t * PW + P_NG + w * 3 + 0]));
    const float gsl = sigmoidf_(bf2f(PROJ[t * PW + P_NG + w * 3 + 1]));
    const float gw = sigmoidf_(bf2f(PROJ[t * PW + P_NG + w * 3 + 2]));
#pragma unroll
    for (int dt = 0; dt < 4; ++dt) {
      const long o = t * 256 + w * 64 + 16 * dt + 4 * quad;
      uint2 c = *(const uint2*)(OC + o), ww = *(const uint2*)(OW + o);
      float r0 = gc * bf2f((u16)(c.x & 0xffff)) + gsl * ot[qt][dt][0] * inv + gw * bf2f((u16)(ww.x & 0xffff));
      float r1 = gc * bf2f((u16)(c.x >> 16)) + gsl * ot[qt][dt][1] * inv + gw * bf2f((u16)(ww.x >> 16));
      float r2 = gc * bf2f((u16)(c.y & 0xffff)) + gsl * ot[qt][dt][2] * inv + gw * bf2f((u16)(ww.y & 0xffff));
      float r3 = gc * bf2f((u16)(c.y >> 16)) + gsl * ot[qt][dt][3] * inv + gw * bf2f((u16)(ww.y >> 16));
      uint2 ov; ov.x = pk2(r0, r1); ov.y = pk2(r2, r3);
      *(uint2*)(OUT + o) = ov;
    }
  }
}

DI void inproj_tile(const Params& P, int l, int it, u16* sA, u16* sB) {
  const int tid = TID(), lane = tid & 63, w = tid >> 6, r16 = lane & 15, quad = lane >> 4, wm = w >> 1, wn = w & 1;
  int mt, nt; tile_from_q(it, 22, mt, nt);
  const u16* H = (const u16*)(WSP(P) + WS_H);
  u16* PROJ = (u16*)(WSP(P) + WS_PROJ);
  const u16* Ab = H + (long)mt * 128 * DM;
  const u16* Bb = (const u16*)(WSP(P) + WS_W + WT_IN) + (long)nt * 128 * DM;
  f32x4 acc[4][4];
  gemm3<4>(acc, g3_ptr(Ab, DM, tid, 0, false), g3_ptr(Ab, DM, tid, 1, false), nullptr, nullptr, 64,
           g3_ptr(Bb, DM, tid, 0, false), g3_ptr(Bb, DM, tid, 1, false), nullptr, nullptr, DM, sA, 16L * DM, 16L * DM);
  __syncthreads();
#pragma unroll
  for (int mi = 0; mi < 4; ++mi)
#pragma unroll
    for (int ni = 0; ni < 4; ++ni)
#pragma unroll
      for (int j = 0; j < 4; ++j) sA[(wm * 64 + 16 * mi + 4 * quad + j) * 136 + wn * 64 + 16 * ni + r16] = f2bf(acc[mi][ni][j]);
  __syncthreads();
  store_tile_bf16<128>(sA, PROJ + (long)mt * 128 * PW + nt * 128, PW, 128);
}
DI void glu_tile(const Params& P, int l, int it, u16* sA, u16* sB) {
  const int tid = TID(), lane = tid & 63, w = tid >> 6, r16 = lane & 15, quad = lane >> 4, wm = w >> 1, wn = w & 1;
  const int mt = it >> 2, nt = it & 3;
  const u16* Y5 = (const u16*)(WSP(P) + WS_Y5);
  u16* OUT = (u16*)(WSP(P) + WS_OM) + (long)1 * T_ * 256;
  const u16* Ab = Y5 + (long)mt * 128 * 256;
  const u16* Bb = (const u16*)(WSP(P) + WS_W + WT_GLU) + (long)nt * 128 * 256;
  f32x4 acc[4][4];
  gemm3<4>(acc, g3_ptr(Ab, 256, tid, 0, false), g3_ptr(Ab, 256, tid, 1, false), nullptr, nullptr, 64,
           g3_ptr(Bb, 256, tid, 0, false), g3_ptr(Bb, 256, tid, 1, false), nullptr, nullptr, 256, sA, 16L * 256, 16L * 256);
  __syncthreads();
#pragma unroll
  for (int mi = 0; mi < 4; ++mi)
#pragma unroll
    for (int ni = 0; ni < 2; ++ni)
#pragma unroll
      for (int j = 0; j < 4; ++j)
        sA[(wm * 64 + 16 * mi + 4 * quad + j) * 72 + wn * 32 + 16 * ni + r16] = f2bf(acc[mi][ni][j] * sigmoidf_(acc[mi][ni + 2][j]));
  __syncthreads();
  store_tile_bf16<64>(sA, OUT + (long)mt * 128 * 256 + nt * 64, 256, 128);
}
DI void merge_tile(const Params& P, int l, int it, u16* sA, u16* sB) {
  const int tid = TID(), lane = tid & 63, w = tid >> 6, r16 = lane & 15, quad = lane >> 4, wm = w >> 1, wn = w & 1;
  int mt, nt; tile_from_q(it, 8, mt, nt);
  const u16* H = (const u16*)(WSP(P) + WS_H);
  const u16* OM = (const u16*)(WSP(P) + WS_OM);
  u16* MERGED = (u16*)(WSP(P) + WS_MERGED);
  uint2 outp[4][4];
#pragma unroll
  for (int mi = 0; mi < 4; ++mi)
#pragma unroll
    for (int ni = 0; ni < 4; ++ni) outp[mi][ni] = make_uint2(0u, 0u);
#pragma unroll 1
  for (int m = 0; m < 4; ++m) {
    uint2 gp[4][4];
    {
      f32x4 ag[4][4];
      const u16* Ab = H + (long)mt * 128 * DM;
      const u16* Bb = (const u16*)(WSP(P) + WS_W + WT_G) + ((long)(m * 1024 + nt * 128)) * DM;
      gemm3<4, true>(ag, g3_ptr(Ab, DM, tid, 0, false), g3_ptr(Ab, DM, tid, 1, false), nullptr, nullptr, 64,
               g3_ptr(Bb, DM, tid, 0, false), g3_ptr(Bb, DM, tid, 1, false), nullptr, nullptr, DM, sA, 16L * DM, 16L * DM);
#pragma unroll
      for (int mi = 0; mi < 4; ++mi)
#pragma unroll
        for (int ni = 0; ni < 4; ++ni) {
          gp[mi][ni].x = pk2(sigmoidf_(ag[mi][ni][0]), sigmoidf_(ag[mi][ni][1]));
          gp[mi][ni].y = pk2(sigmoidf_(ag[mi][ni][2]), sigmoidf_(ag[mi][ni][3]));
        }
    }
    {
      f32x4 av[4][4];
      const u16* Ab = OM + ((long)m * T_ + (long)mt * 128) * 256;
      const u16* Bb = (const u16*)(WSP(P) + WS_W + WT_BR) + ((long)(m * 1024 + nt * 128)) * 256;
      gemm3<4, true>(av, g3_ptr(Ab, 256, tid, 0, false), g3_ptr(Ab, 256, tid, 1, false), nullptr, nullptr, 64,
               g3_ptr(Bb, 256, tid, 0, false), g3_ptr(Bb, 256, tid, 1, false), nullptr, nullptr, 256, sA, 16L * 256, 16L * 256);
#pragma unroll
      for (int mi = 0; mi < 4; ++mi)
#pragma unroll
        for (int ni = 0; ni < 4; ++ni) {
          const float o0 = bf2f((u16)(outp[mi][ni].x & 0xffff)) + av[mi][ni][0] * bf2f((u16)(gp[mi][ni].x & 0xffff));
          const float o1 = bf2f((u16)(outp[mi][ni].x >> 16)) + av[mi][ni][1] * bf2f((u16)(gp[mi][ni].x >> 16));
          const float o2 = bf2f((u16)(outp[mi][ni].y & 0xffff)) + av[mi][ni][2] * bf2f((u16)(gp[mi][ni].y & 0xffff));
          const float o3 = bf2f((u16)(outp[mi][ni].y >> 16)) + av[mi][ni][3] * bf2f((u16)(gp[mi][ni].y >> 16));
          outp[mi][ni].x = pk2(o0, o1); outp[mi][ni].y = pk2(o2, o3);
        }
    }
  }
  __syncthreads();
#pragma unroll
  for (int mi = 0; mi < 4; ++mi)
#pragma unroll
    for (int ni = 0; ni < 4; ++ni)
#pragma unroll
      for (int j = 0; j < 4; ++j) {
        const unsigned wv = (j < 2) ? outp[mi][ni].x : outp[mi][ni].y;
        sA[(wm * 64 + 16 * mi + 4 * quad + j) * 136 + wn * 64 + 16 * ni + r16] = (u16)((j & 1) ? (wv >> 16) : (wv & 0xffff));
      }
  __syncthreads();
  store_tile_bf16<128>(sA, MERGED + (long)mt * 128 * DM + nt * 128, DM, 128);
}
DI void resid_tile(const u16* A, int K, const u16* Bt, const float* resid, float* out, int it, u16* sA, u16* sB) {
  const int tid = TID(), lane = tid & 63, w = tid >> 6, r16 = lane & 15, quad = lane >> 4, wm = w >> 1, wn = w & 1;
  int mt, nt; tile_from_q(it, 8, mt, nt);
  const u16* Ab = A + (long)mt * 128 * K;
  const u16* Bb = Bt + (long)nt * 128 * K;
  f32x4 acc[4][4];
  gemm3<4>(acc, g3_ptr(Ab, K, tid, 0, false), g3_ptr(Ab, K, tid, 1, false), nullptr, nullptr, 64,
           g3_ptr(Bb, K, tid, 0, false), g3_ptr(Bb, K, tid, 1, false), nullptr, nullptr, K, sA, 16L * K, 16L * K);
  float* sC = (float*)sA + w * (32 * 68);
#pragma unroll
  for (int hp = 0; hp < 2; ++hp) {
    __syncthreads();
#pragma unroll
    for (int mi2 = 0; mi2 < 2; ++mi2)
#pragma unroll
      for (int ni = 0; ni < 4; ++ni)
#pragma unroll
        for (int j = 0; j < 4; ++j) sC[(16 * mi2 + 4 * quad + j) * 68 + 16 * ni + r16] = acc[2 * hp + mi2][ni][j];
    __syncthreads();
#pragma unroll
    for (int q = 0; q < 8; ++q) {
      const int c = lane + 64 * q, row = c >> 4, c4 = (c & 15) * 4;
      const long o = ((long)mt * 128 + wm * 64 + 32 * hp + row) * DM + nt * 128 + wn * 64 + c4;
      const float4 rv = *(const float4*)(resid + o);
      const f32x4 cv = *(const f32x4*)(sC + row * 68 + c4);
      *(float4*)(out + o) = make_float4(rv.x + cv[0], rv.y + cv[1], rv.z + cv[2], rv.w + cv[3]);
    }
  }
}
DI void ffn1_tile(const Params& P, int l, int it, u16* sA, u16* sB) {
  const int tid = TID(), lane = tid & 63, w = tid >> 6, r16 = lane & 15, quad = lane >> 4, wm = w >> 1, wn = w & 1;
  int mt, nt; tile_from_q(it, 44, mt, nt);
  const u16* H = (const u16*)(WSP(P) + WS_H);
  u16* ACT = (u16*)(WSP(P) + WS_PROJ);
  const u16* Ab = H + (long)mt * 128 * DM;
  const u16* Bb = (const u16*)(WSP(P) + WS_W + WT_GU) + (long)nt * 128 * DM;
  f32x4 acc[4][4];
  gemm3<4>(acc, g3_ptr(Ab, DM, tid, 0, false), g3_ptr(Ab, DM, tid, 1, false), nullptr, nullptr, 64,
           g3_ptr(Bb, DM, tid, 0, false), g3_ptr(Bb, DM, tid, 1, false), nullptr, nullptr, DM, sA, 16L * DM, 16L * DM);
  __syncthreads();
#pragma unroll
  for (int mi = 0; mi < 4; ++mi)
#pragma unroll
    for (int ni = 0; ni < 2; ++ni)
#pragma unroll
      for (int j = 0; j < 4; ++j)
        sA[(wm * 64 + 16 * mi + 4 * quad + j) * 72 + wn * 32 + 16 * ni + r16] = f2bf(siluf_(acc[mi][ni][j]) * acc[mi][ni + 2][j]);
  __syncthreads();
  store_tile_bf16<64>(sA, ACT + (long)mt * 128 * DFF + nt * 64, DFF, 128);
}

__global__ void __launch_bounds__(256, LB2) fwd_megakernel(Params P) {
  cg::grid_group grid = cg::this_grid();
  __shared__ __attribute__((aligned(16))) float lds[17920];
  __shared__ int s_item;
  unsigned* cnt = (unsigned*)(WSP(P) + WS_CNT);
  const int xcd = (int)(__builtin_amdgcn_s_getreg((3 << 11) | 20) & 0xF) & 7;
  __shared__ int s_rank;
  if (threadIdx.x == 0) s_rank = (int)atomicAdd(cnt + 900 + xcd, 1u);
  __syncthreads();
  const int xrank = s_rank;
  u16* sA = (u16*)lds;
  u16* sB = sA + 128 * 80;
  u16* aQ = (u16*)lds;
  u16* aK = aQ + 64 * 72;
  u16* aV = aK + 64 * 72;
  float* aImp = (float*)(aV + 64 * 72);
  for (int ph = P.ph_lo; ph < P.ph_hi; ++ph) {
    const int l = ph / 11, sp = ph % 11;
    const float* xin = (l == 0) ? P.in[0] : P.out;
    const int nrep = (PROBE_DUP != 0 && l == 0 && ((PROBE_DUP >> sp) & 1)) ? 2 : 1;
    for (int rep = 0; rep < nrep; ++rep) {
    unsigned* pc = cnt + (ph + 32 * rep) * 8;
    switch (sp) {
      case 0: if (PHASE_MASK & (1 << 0)) {
        phase_rmsnorm(xin, P.in[2] + l * DM, (u16*)(WSP(P) + WS_H));
        phase_convert(P, l, lds);
        if (l == 0) phase_rope_table((const int*)P.in[1], (float*)(WSP(P) + WS_COS), (float*)(WSP(P) + WS_SIN));
      } break;
      case 1: if (PHASE_MASK & (1 << 1)) {
        XCD_STATIC_LOOP(32 * 22, inproj_tile(P, l, it, sA, sB))
      } break;
      case 2: if (PHASE_MASK & (1 << 2)) {
        for (;;) {
          int it = next_item(pc, &s_item); if (it >= 64 + 3 * 2048) break;
          if (it < 64) cmp1_tile(P, l, it, sA, sB);
          else if (it < 64 + 2048) gdn_p1_item(P, l, it - 64, lds);
          else if (it < 64 + 4096) s5_pass1_item(P, l, it - 64 - 2048, lds);
          else nsa_prep_item(P, l, it - 64 - 4096);
        }
      } break;
      case 3: if (PHASE_MASK & (1 << 3)) {
        for (;;) {
          int it = next_item(pc, &s_item); if (it >= 128 + 3072 + 64) break;
          if (it < 128) gdn_p2_item(P, it, lds);
          else if (it < 128 + 2048) sb_attn_item(P, it - 128, aQ, aK, aV);
          else if (it < 128 + 3072) win_attn_item(P, it - 128 - 2048, aQ, aK, aV);
          else if (it < 128 + 3072 + 32) s5_carry_item(P, l, it - 128 - 3072);
          else cmp2_tile(P, l, it - 128 - 3072 - 32, sA, sB, lds + 17000);
        }
      } break;
      case 4: if (PHASE_MASK & (1 << 4)) {
        for (;;) {
          int it = next_item(pc, &s_item); if (it >= 3 * 2048) break;
          if (it < 2048) cmp_attn_item(P, it, aQ, aK, aV, aImp);
          else if (it < 4096) s5_pass2_item(P, l, it - 2048, lds);
          else gdn_post_item(P, l, it - 4096);
        }
      } break;
      case 5: if (PHASE_MASK & (1 << 5)) {
        for (;;) {
          int it = next_item(pc, &s_item); if (it >= 1024 + 1024) break;
          if (it < 1024) sel_attn_item(P, it, aQ, aK, aV);
          else glu_tile(P, l, it - 1024, sA, sB);
        }
      } break;
      case 6: if (PHASE_MASK & (1 << 6)) {
        XCD_STATIC_LOOP(32 * 8, merge_tile(P, l, it, sA, sB))
      } break;
      case 7: if (PHASE_MASK & (1 << 7)) {
        XCD_STATIC_LOOP(32 * 8, resid_tile((const u16*)(WSP(P) + WS_MERGED), DM, (const u16*)(WSP(P) + WS_W + WT_OUT), xin, P.out, it, sA, sB))
      } break;
      case 8: if (PHASE_MASK & (1 << 8)) {
        phase_rmsnorm(P.out, P.in[26] + l * DM, (u16*)(WSP(P) + WS_H));
      } break;
      case 9: if (PHASE_MASK & (1 << 9)) {
        XCD_STATIC_LOOP(32 * 44, ffn1_tile(P, l, it, sA, sB))
      } break;
      case 10: if (PHASE_MASK & (1 << 10)) {
        XCD_STATIC_LOOP(32 * 8, resid_tile((const u16*)(WSP(P) + WS_PROJ), DFF, (const u16*)(WSP(P) + WS_W + WT_D), P.out, P.out, it, sA, sB))
      } break;
    }
    if (rep + 1 < nrep) grid.sync();
    }
    if (ph + 1 < P.ph_hi) grid.sync();
  }
}

extern "C" void kernel_launch(void* const* d_in, const int* in_sizes, int n_in, void* d_out, int out_size, void* d_ws, size_t ws_size,
                              hipStream_t stream) {
  static int grid_blocks = 0;
  if (!grid_blocks) {
    int dev = 0, cus = 0, per_cu = 0;
    hipGetDevice(&dev);
    hipDeviceGetAttribute(&cus, hipDeviceAttributeMultiprocessorCount, dev);
    hipOccupancyMaxActiveBlocksPerMultiprocessor(&per_cu, fwd_megakernel, 256, 0);
    if (per_cu < 1) per_cu = 1;
    if (per_cu > 2) per_cu = 2;
    grid_blocks = cus * per_cu;
    if (ws_size < WS_W + WT_END) fprintf(stderr, "kernel_launch: workspace too small: %zu\n", ws_size);
  }
  hipMemsetAsync((char*)d_ws + WS_CNT, 0, 4096, stream);
  Params p{};
  for (int i = 0; i < 30; ++i) p.in[i] = (const float*)d_in[i];
  p.out = (float*)d_out;
  p.ws = (unsigned char*)d_ws;
  p.ph_lo = 0; p.ph_hi = NPHASE;
  void* args[] = {&p};
  hipError_t e = hipLaunchCooperativeKernel((void*)fwd_megakernel, dim3(grid_blocks), dim3(256), args, 0, stream);
  if (e != hipSuccess) fprintf(stderr, "cooperative launch failed: %s (grid %d)\n", hipGetErrorString(e), grid_blocks);
}
```

```cpp
#include <hip/hip_runtime.h>
#include <hip/hip_cooperative_groups.h>
#include <cstdio>
namespace cg = cooperative_groups;

typedef unsigned short u16;
typedef unsigned long long u64;
typedef __attribute__((ext_vector_type(8))) short bf16x8;
typedef __attribute__((ext_vector_type(4))) short s16x4;
typedef __attribute__((ext_vector_type(4))) float f32x4;
#define DI __device__ __forceinline__

constexpr int NB = 8, SEQ = 4096, T_ = NB * SEQ, DM = 1024, DIN = 6804, PW = 2816, DFF = 2816;
constexpr int P_Q = 0, P_KV = 256, P_S5U = 640, P_GQKV = 896, P_GZ = 1664, P_SB = 1920, P_NG = 2688, P_GA = 2700, P_GB = 2704;
constexpr float EPS = 1e-6f;
constexpr size_t MiB = 1024ull * 1024ull;
constexpr size_t WS_H = 0, WS_PROJ = 64 * MiB, WS_OM = 240 * MiB, WS_MERGED = 304 * MiB,
                 WS_GQ = 304 * MiB, WS_GK = 320 * MiB, WS_GU = 336 * MiB, WS_GW = 352 * MiB, WS_GA = 368 * MiB,
                 WS_QR = 384 * MiB, WS_OC = 400 * MiB, WS_OW = 416 * MiB, WS_Y5 = 432 * MiB,
                 WS_GG = 448 * MiB, WS_SEL = 449 * MiB, WS_COS = 450 * MiB, WS_SIN = 451 * MiB,
                 WS_ENDS = 452 * MiB, WS_CARRY = 456 * MiB, WS_KC = 460 * MiB, WS_VC = 461 * MiB, WS_HID = 462 * MiB,
                 WS_CNT = 464 * MiB, WS_W = 465 * MiB, WS_CBIAS = 449 * MiB + 512 * 1024;
constexpr size_t WT_IN = 0, WT_G = WT_IN + 2816ull * 1024 * 2, WT_BR = WT_G + 4096ull * 1024 * 2, WT_OUT = WT_BR + 4096ull * 256 * 2,
                 WT_GU = WT_OUT + 1024ull * 1024 * 2, WT_D = WT_GU + 5632ull * 1024 * 2, WT_GLU = WT_D + 1024ull * 2816 * 2,
                 WT_C1 = WT_GLU + 512ull * 256 * 2, WT_C2 = WT_C1 + 512ull * 2048 * 2, WT_END = WT_C2 + 128ull * 256 * 2;
constexpr int NPHASE = 22;
#define XCD_STATIC_LOOP(NPER, BODY) { \
    unsigned c0_ = cnt[900], c1_ = cnt[901], c2_ = cnt[902], c3_ = cnt[903], c4_ = cnt[904], c5_ = cnt[905], c6_ = cnt[906], c7_ = cnt[907]; \
    const bool ok_ = c0_ && c1_ && c2_ && c3_ && c4_ && c5_ && c6_ && c7_; \
    const unsigned mine_ = xcd == 0 ? c0_ : xcd == 1 ? c1_ : xcd == 2 ? c2_ : xcd == 3 ? c3_ : xcd == 4 ? c4_ : xcd == 5 ? c5_ : xcd == 6 ? c6_ : c7_; \
    const int start_ = ok_ ? xcd * (NPER) + xrank : (int)blockIdx.x, end_ = ok_ ? (xcd + 1) * (NPER) : 8 * (NPER), step_ = ok_ ? (int)mine_ : (int)gridDim.x; \
    for (int it = start_; it < end_; it += step_) { BODY; } }
#ifndef PROBE_DUP
#define PROBE_DUP 0
#endif
#ifndef LB2
#define LB2 2
#endif
#ifndef PHASE_MASK
#define PHASE_MASK 0x7ff
#endif

struct Params {
  const float* in[30];
  float* out;
  unsigned char* ws;
  int ph_lo, ph_hi;
};


DI int TID() { int t = threadIdx.x; asm volatile("" : "+v"(t)); return t; }
DI unsigned char* WSP(const Params& P) { size_t z = 0; asm volatile("" : "+s"(z)); return P.ws + z; }
DI u16 f2bf(float x) { unsigned r; asm("v_cvt_pk_bf16_f32 %0, %1, %1\n\ts_nop 1" : "=v"(r) : "v"(x)); return (u16)(r & 0xffffu); }
DI float bf2f(u16 h) { return __uint_as_float(((unsigned)h) << 16); }
DI unsigned pk2(float a, float b) { unsigned r; asm("v_cvt_pk_bf16_f32 %0, %1, %2\n\ts_nop 1" : "=v"(r) : "v"(a), "v"(b)); return r; }
DI float wave_sum(float v) {
#pragma unroll
  for (int o = 1; o < 64; o <<= 1) v += __shfl_xor(v, o);
  return v;
}
DI float sigmoidf_(float x) { return 1.f / (1.f + __expf(-x)); }
DI float siluf_(float x) { return x * sigmoidf_(x); }
DI float softplusf_(float x) { return fmaxf(x, 0.f) + log1pf(__expf(-fabsf(x))); }
DI float gelu_tanh(float x) {
  float u = 0.7978845608028654f * (x + 0.044715f * x * x * x);
  float t = 1.f - 2.f / (__expf(2.f * u) + 1.f);
  return 0.5f * x * (1.f + t);
}
DI void sincos_d(double x, double& s, double& c) {
  const double TWO_PI = 6.283185307179586476925287, INV = 0.15915494309189533576888;
  double n = rint(x * INV);
  double r = x - n * TWO_PI;
  double r2 = r * r, term = 1.0, cs = 1.0, ss = 1.0;
#pragma unroll
  for (int k = 1; k <= 14; ++k) { term *= r2 * (-1.0 / (double)((2 * k - 1) * (2 * k))); cs += term; }
  term = 1.0;
#pragma unroll
  for (int k = 1; k <= 14; ++k) { term *= r2 * (-1.0 / (double)((2 * k) * (2 * k + 1))); ss += term; }
  s = r * ss; c = cs;
}
DI int next_item(unsigned* cnt, int* s_item) {
  __syncthreads();
  if (TID() == 0) *s_item = (int)atomicAdd(cnt, 1u);
  __syncthreads();
  return *s_item;
}
DI int next_tile_xcd(unsigned* cnt8, int n_per_xcd, int xcd, int* s_item) {
  asm volatile("" : "+s"(xcd));
  __syncthreads();
  if (threadIdx.x == 0) {
    int res = -1;
    for (int a = 0; a < 8; ++a) {
      int qq = (xcd + a) & 7;
      unsigned v = atomicAdd(cnt8 + qq, 1u);
      if (v < (unsigned)n_per_xcd) { res = qq * n_per_xcd + (int)v; break; }
    }
    *s_item = res;
  }
  __syncthreads();
  return *s_item;
}
DI void tile_from_q(int it, int numN, int& mt, int& nt) {
  const int per = 32 * numN, q = it / per, i = it % per, g = i / (8 * numN), rem = i % (8 * numN);
  nt = rem >> 3; mt = 32 * q + 8 * g + (rem & 7);
}
DI int proj_src_col(int pc) {
  if (pc < 640) return pc;
  if (pc < 1664) return pc + 12;
  if (pc < 2688) return pc + 20;
  if (pc < 2700) return pc - 2688 + 640;
  if (pc < 2708) return pc - 2700 + 1676;
  return pc;
}

DI uint4 addpos8(uint4 v, const float* pp) {
  uint4 o;
  o.x = pk2(bf2f((u16)(v.x & 0xffff)) + pp[0], bf2f((u16)(v.x >> 16)) + pp[1]);
  o.y = pk2(bf2f((u16)(v.y & 0xffff)) + pp[2], bf2f((u16)(v.y >> 16)) + pp[3]);
  o.z = pk2(bf2f((u16)(v.z & 0xffff)) + pp[4], bf2f((u16)(v.z >> 16)) + pp[5]);
  o.w = pk2(bf2f((u16)(v.w & 0xffff)) + pp[6], bf2f((u16)(v.w >> 16)) + pp[7]);
  return o;
}
template <int NTW>
DI void gemm2(f32x4 (&acc)[4][NTW], const u16* __restrict__ arow, long a_kstep, const float* __restrict__ apos,
              const u16* __restrict__ brow, int K, u16* sA, u16* sB) {
  constexpr int BN = 32 * NTW, BV = BN / 32, LS = 80;
  const int tid = TID(), lane = tid & 63, w = tid >> 6, r16 = lane & 15, quad = lane >> 4;
  const int wm = w >> 1, wn = w & 1;
  u16* sa_st = sA + (tid >> 1) * LS + (tid & 1) * 32;
  u16* sb_st = (BN == 128) ? (sB + (tid >> 1) * LS + (tid & 1) * 32) : (sB + (tid >> 2) * LS + (tid & 3) * 16);
  uint4 pa0, pa1, pa2, pa3, pb0, pb1, pb2, pb3;
  uint4 qa0, qa1, qa2, qa3, qb0, qb1, qb2, qb3;
  pb2 = make_uint4(0, 0, 0, 0); pb3 = pb2; qb2 = pb2; qb3 = pb2;
#define G2_LOAD(KT, a0, a1, a2, a3, b0, b1, b2, b3) { const uint4* pa_ = (const uint4*)(arow + (long)(KT) * a_kstep); \
    a0 = pa_[0]; a1 = pa_[1]; a2 = pa_[2]; a3 = pa_[3]; \
    if (apos) { const float* pp_ = apos + (KT) * 64 + (tid & 1) * 32; \
      a0 = addpos8(a0, pp_); a1 = addpos8(a1, pp_ + 8); a2 = addpos8(a2, pp_ + 16); a3 = addpos8(a3, pp_ + 24); } \
    const uint4* pb_ = (const uint4*)(brow + (long)(KT) * 64); \
    b0 = pb_[0]; b1 = pb_[1]; if (BV == 4) { b2 = pb_[2]; b3 = pb_[3]; } }
#define G2_STORE(a0, a1, a2, a3, b0, b1, b2, b3) { \
    ((uint4*)sa_st)[0] = a0; ((uint4*)sa_st)[1] = a1; ((uint4*)sa_st)[2] = a2; ((uint4*)sa_st)[3] = a3; \
    ((uint4*)sb_st)[0] = b0; ((uint4*)sb_st)[1] = b1; if (BV == 4) { ((uint4*)sb_st)[2] = b2; ((uint4*)sb_st)[3] = b3; } }
#define G2_COMPUTE() { _Pragma("unroll") for (int ks = 0; ks < 2; ++ks) { \
      bf16x8 af[4], bg[NTW]; \
      _Pragma("unroll") for (int mi = 0; mi < 4; ++mi) af[mi] = *(const bf16x8*)(sA + (wm * 64 + 16 * mi + r16) * LS + ks * 32 + quad * 8); \
      _Pragma("unroll") for (int ni = 0; ni < NTW; ++ni) bg[ni] = *(const bf16x8*)(sB + (wn * (BN / 2) + 16 * ni + r16) * LS + ks * 32 + quad * 8); \
      _Pragma("unroll") for (int mi = 0; mi < 4; ++mi) \
        _Pragma("unroll") for (int ni = 0; ni < NTW; ++ni) acc[mi][ni] = __builtin_amdgcn_mfma_f32_16x16x32_bf16(af[mi], bg[ni], acc[mi][ni], 0, 0, 0); } }
#pragma unroll
  for (int mi = 0; mi < 4; ++mi)
#pragma unroll
    for (int ni = 0; ni < NTW; ++ni) acc[mi][ni] = (f32x4){0.f, 0.f, 0.f, 0.f};
  const int nk = K >> 6;
  G2_LOAD(0, pa0, pa1, pa2, pa3, pb0, pb1, pb2, pb3)
  G2_LOAD(1, qa0, qa1, qa2, qa3, qb0, qb1, qb2, qb3)
#pragma unroll 1
  for (int kt = 0; kt < nk; kt += 2) {
    __syncthreads();
    G2_STORE(pa0, pa1, pa2, pa3, pb0, pb1, pb2, pb3)
    __syncthreads();
    if (kt + 2 < nk) G2_LOAD(kt + 2, pa0, pa1, pa2, pa3, pb0, pb1, pb2, pb3)
    G2_COMPUTE()
    __syncthreads();
    G2_STORE(qa0, qa1, qa2, qa3, qb0, qb1, qb2, qb3)
    __syncthreads();
    if (kt + 3 < nk) G2_LOAD(kt + 3, qa0, qa1, qa2, qa3, qb0, qb1, qb2, qb3)
    G2_COMPUTE()
  }
#undef G2_LOAD
#undef G2_STORE
#undef G2_COMPUTE
}
DI void g3_rowpiece(int tid, int q, bool n64, int& row, int& pc) {
  const int w = tid >> 6, lane = tid & 63, chunk = n64 ? (2 * w + q) : (4 * w + q);
  row = 8 * chunk + (lane >> 3);
  pc = (lane & 7) ^ ((row >> 1) & 7);
}
DI const u16* g3_ptr(const u16* base, long ld, int tid, int q, bool n64) {
  int row, pc; g3_rowpiece(tid, q, n64, row, pc);
  return base + (long)row * ld + pc * 8;
}
template <int NTW, bool LEAN = false>
DI void gemm3(f32x4 (&acc)[4][NTW], const u16* ap0, const u16* ap1, const u16* ap2, const u16* ap3, long a_kstep,
              const u16* bp0, const u16* bp1, const u16* bp2, const u16* bp3, int K, u16* sbase, long a16 = 0, long b16 = 0) {
  constexpr int BN = 32 * NTW, STAGE = 16384;
  const int tid = TID(), lane = tid & 63, w = tid >> 6, r16 = lane & 15, quad = lane >> 4;
  const int wm = w >> 1, wn = w & 1;
  const int sz = (r16 >> 1) & 7;
  const int wu = __builtin_amdgcn_readfirstlane(w);
#define G3_GLDS(GP, LOFF) asm volatile("s_mov_b32 m0, %1\n\ts_nop 0\n\tglobal_load_lds_dwordx4 %0, off" :: "v"(GP), "s"(LOFF) : "memory", "m0")
  const unsigned lds0 = (unsigned)(size_t)sbase;
#define G3_ISSUE(KT) { const unsigned st_ = lds0 + (((KT) & 1) ? STAGE * 2 : 0); const long ka_ = (long)(KT) * a_kstep, kb_ = (long)(KT) * 64; \
    if (BN == 128) { \
      const unsigned la_ = __builtin_amdgcn_readfirstlane(st_ + wu * 4096u); \
      G3_GLDS(ap0 + ka_, la_); G3_GLDS(ap1 + ka_, la_ + 1024u); \
      if (a16) { G3_GLDS(ap0 + (ka_ + a16), la_ + 2048u); G3_GLDS(ap1 + (ka_ + a16), la_ + 3072u); } else { G3_GLDS(ap2 + ka_, la_ + 2048u); G3_GLDS(ap3 + ka_, la_ + 3072u); } \
      G3_GLDS(bp0 + kb_, la_ + 16384u); G3_GLDS(bp1 + kb_, la_ + 17408u); \
      if (b16) { G3_GLDS(bp0 + (kb_ + b16), la_ + 18432u); G3_GLDS(bp1 + (kb_ + b16), la_ + 19456u); } else { G3_GLDS(bp2 + kb_, la_ + 18432u); G3_GLDS(bp3 + kb_, la_ + 19456u); } \
    } else { \
      const unsigned la_ = __builtin_amdgcn_readfirstlane(st_ + wu * 4096u); \
      const unsigned lb_ = __builtin_amdgcn_readfirstlane(st_ + 16384u + wu * 2048u); \
      G3_GLDS(ap0 + ka_, la_); G3_GLDS(ap1 + ka_, la_ + 1024u); G3_GLDS(ap2 + ka_, la_ + 2048u); G3_GLDS(ap3 + ka_, la_ + 3072u); \
      G3_GLDS(bp0 + kb_, lb_); G3_GLDS(bp1 + kb_, lb_ + 1024u); \
    } }
#pragma unroll
  for (int mi = 0; mi < 4; ++mi)
#pragma unroll
    for (int ni = 0; ni < NTW; ++ni) acc[mi][ni] = (f32x4){0.f, 0.f, 0.f, 0.f};
  const int nk = K >> 6;
  __syncthreads();
  G3_ISSUE(0)
  if (!LEAN && BN == 128) {
#define G3_PIECE(I, KT) { const unsigned st_ = lds0 + (((KT) & 1) ? STAGE * 2 : 0); const long ka_ = (long)(KT) * a_kstep, kb_ = (long)(KT) * 64; \
      const unsigned la_ = __builtin_amdgcn_readfirstlane(st_ + wu * 4096u); \
      if ((I) == 0) G3_GLDS(ap0 + ka_, la_); else if ((I) == 1) G3_GLDS(ap1 + ka_, la_ + 1024u); \
      else if ((I) == 2) G3_GLDS((a16 ? ap0 + a16 : ap2) + ka_, la_ + 2048u); else if ((I) == 3) G3_GLDS((a16 ? ap1 + a16 : ap3) + ka_, la_ + 3072u); \
      else if ((I) == 4) G3_GLDS(bp0 + kb_, la_ + 16384u); else if ((I) == 5) G3_GLDS(bp1 + kb_, la_ + 17408u); \
      else if ((I) == 6) G3_GLDS((b16 ? bp0 + b16 : bp2) + kb_, la_ + 18432u); else G3_GLDS((b16 ? bp1 + b16 : bp3) + kb_, la_ + 19456u); }
#define G3_STEP(KT, DOISSUE) { const u16* sAs = sbase + ((KT) & 1) * STAGE; const u16* sBs = sAs + 8192; \
      bf16x8 af[2][4], bg[2][NTW];     \
      _Pragma("unroll") for (int ks = 0; ks < 2; ++ks) { \
        const int pcol = ((ks * 4 + quad) ^ sz) * 8; \
        _Pragma("unroll") for (int mi = 0; mi < 4; ++mi) af[ks][mi] = *(const bf16x8*)(sAs + (wm * 64 + 16 * mi + r16) * 64 + pcol); \
        _Pragma("unroll") for (int ni = 0; ni < NTW; ++ni) bg[ks][ni] = *(const bf16x8*)(sBs + (wn * (BN / 2) + 16 * ni + r16) * 64 + pcol); } \
      __builtin_amdgcn_s_setprio(1);     \
      _Pragma("unroll") for (int mi = 0; mi < 4; ++mi) {   \
        acc[mi][0] = __builtin_amdgcn_mfma_f32_16x16x32_bf16(af[0][mi], bg[0][0], acc[mi][0], 0, 0, 0); \
        acc[mi][1] = __builtin_amdgcn_mfma_f32_16x16x32_bf16(af[0][mi], bg[0][1], acc[mi][1], 0, 0, 0); \
        if (DOISSUE) G3_PIECE(2 * mi, (KT) + 1) \
        __builtin_amdgcn_sched_barrier(0); \
        acc[mi][2] = __builtin_amdgcn_mfma_f32_16x16x32_bf16(af[0][mi], bg[0][2], acc[mi][2], 0, 0, 0); \
        acc[mi][3] = __builtin_amdgcn_mfma_f32_16x16x32_bf16(af[0][mi], bg[0][3], acc[mi][3], 0, 0, 0); \
        if (DOISSUE) G3_PIECE(2 * mi + 1, (KT) + 1) \
        __builtin_amdgcn_sched_barrier(0); } \
      _Pragma("unroll") for (int mi = 0; mi < 4; ++mi) \
        _Pragma("unroll") for (int ni = 0; ni < NTW; ++ni) acc[mi][ni] = __builtin_amdgcn_mfma_f32_16x16x32_bf16(af[1][mi], bg[1][ni], acc[mi][ni], 0, 0, 0); \
      __builtin_amdgcn_s_setprio(0); }
#pragma unroll 1
    for (int kt = 0; kt < nk - 1; ++kt) {
      asm volatile("s_waitcnt vmcnt(0) lgkmcnt(0)" ::: "memory");
      __builtin_amdgcn_s_barrier();
      asm volatile("" ::: "memory");
      G3_STEP(kt, true)
    }
    asm volatile("s_waitcnt vmcnt(0) lgkmcnt(0)" ::: "memory");
    __builtin_amdgcn_s_barrier();
    asm volatile("" ::: "memory");
    G3_STEP(nk - 1, false)
#undef G3_PIECE
#undef G3_STEP
  } else
#pragma unroll 1
  for (int kt = 0; kt < nk; ++kt) {
    asm volatile("s_waitcnt vmcnt(0) lgkmcnt(0)" ::: "memory");
    __builtin_amdgcn_s_barrier();
    asm volatile("" ::: "memory");
    if (kt + 1 < nk) G3_ISSUE(kt + 1)
    const u16* sAs = sbase + (kt & 1) * STAGE;
    const u16* sBs = sAs + 8192;
#pragma unroll 1
    for (int ks = 0; ks < (LEAN ? 2 : 0); ++ks) {
      const int pcol = ((ks * 4 + quad) ^ sz) * 8;
      bf16x8 af[4];
#pragma unroll
      for (int mi = 0; mi < 4; ++mi) af[mi] = *(const bf16x8*)(sAs + (wm * 64 + 16 * mi + r16) * 64 + pcol);
#pragma unroll
      for (int ni = 0; ni < NTW; ++ni) {
        bf16x8 b1 = *(const bf16x8*)(sBs + (wn * (BN / 2) + 16 * ni + r16) * 64 + pcol);
#pragma unroll
        for (int mi = 0; mi < 4; ++mi) acc[mi][ni] = __builtin_amdgcn_mfma_f32_16x16x32_bf16(af[mi], b1, acc[mi][ni], 0, 0, 0);
      }
    }
#pragma unroll
    for (int ks = 0; ks < (LEAN ? 0 : 2); ++ks) {
      const int pcol = ((ks * 4 + quad) ^ sz) * 8;
      bf16x8 af[4], bg[NTW];
#pragma unroll
      for (int mi = 0; mi < 4; ++mi) af[mi] = *(const bf16x8*)(sAs + (wm * 64 + 16 * mi + r16) * 64 + pcol);
#pragma unroll
      for (int ni = 0; ni < NTW; ++ni) bg[ni] = *(const bf16x8*)(sBs + (wn * (BN / 2) + 16 * ni + r16) * 64 + pcol);
#pragma unroll
      for (int mi = 0; mi < 4; ++mi)
#pragma unroll
        for (int ni = 0; ni < NTW; ++ni) acc[mi][ni] = __builtin_amdgcn_mfma_f32_16x16x32_bf16(af[mi], bg[ni], acc[mi][ni], 0, 0, 0);
    }
  }
#undef G3_ISSUE
#undef G3_GLDS
}
template <int NCOLS>
DI void store_tile_bf16(const u16* sC, u16* gdst, long ld, int rows_valid) {
  constexpr int CPR = NCOLS / 8, LS = NCOLS + 8;
  const int tid = TID();
#pragma unroll
  for (int q = 0; q < (128 * CPR) / 256; ++q) {
    const int c = tid + 256 * q, row = c / CPR, ch = c % CPR;
    if (row < rows_valid) *(uint4*)(gdst + (long)row * ld + ch * 8) = *(const uint4*)(sC + row * LS + ch * 8);
  }
}
DI int pair_col(int np, int& which) {
  const int nt = np >> 7, c = np & 127, wn = c >> 6, ni = (c >> 4) & 3, r = c & 15;
  which = ni >> 1;
  return nt * 64 + wn * 32 + (ni & 1) * 16 + r;
}
DI const float* conv_colptr(const Params& P, int l, int mat, int np, long& ld) {
  int which;
  switch (mat) {
    case 0: ld = DIN; return P.in[3] + (long)l * DM * DIN + proj_src_col(np);
    case 1: ld = DIN; return P.in[3] + (long)l * DM * DIN + 2708 + np;
    case 2: ld = DM; return P.in[24] + ((long)(l * 4 + (np >> 10)) * 256) * DM + (np & 1023);
    case 3: ld = DM; return P.in[25] + (long)l * DM * DM + np;
    case 4: { int o = pair_col(np, which); ld = DFF; return (which ? P.in[28] : P.in[27]) + (long)l * DM * DFF + o; }
    case 5: ld = DM; return P.in[29] + (long)l * DFF * DM + np;
    case 6: { int o = pair_col(np, which); ld = 512; return P.in[19] + (long)l * 256 * 512 + which * 256 + o; }
    case 7: ld = 256; return P.in[(np >> 8) ? 9 : 7] + (long)l * 2048 * 256 + (np & 255);
    default: ld = 64; return P.in[(np >> 6) ? 10 : 8] + (long)l * 256 * 64 + (np & 63);
  }
}
DI void phase_convert(const Params& P, int l, float* lds) {
  const int tid = TID();
  if (blockIdx.x < 64) {
    const int kv = blockIdx.x >> 5, ks = blockIdx.x & 31;
    const float* pos = P.in[6] + (long)(l * 2 + kv) * 2048 + ks * 64;
    const float* w1 = P.in[kv ? 9 : 7] + (long)l * 2048 * 256 + (long)ks * 64 * 256 + tid;
    float a = 0.f;
#pragma unroll 8
    for (int k = 0; k < 64; ++k) a += pos[k] * w1[(long)k * 256];
    ((float*)(WSP(P) + WS_CBIAS))[(kv * 32 + ks) * 256 + tid] = a;
  }
  const int NB_[9] = {44, 64, 64, 16, 88, 16, 8, 8, 2};
  const int KB_[9] = {16, 16, 4, 16, 16, 44, 4, 32, 4};
  const size_t OFF_[9] = {WT_IN, WT_G, WT_BR, WT_OUT, WT_GU, WT_D, WT_GLU, WT_C1, WT_C2};
  for (int it = blockIdx.x; it < 4648; it += gridDim.x) {
    int r = it, mat = 0, nbk = 0, kbk = 0; size_t off = 0;
#pragma unroll
    for (int q = 0; q < 9; ++q) { int n = NB_[q] * KB_[q]; if (r >= 0 && r < n) { mat = q; nbk = NB_[q]; kbk = KB_[q]; off = OFF_[q]; r -= 100000; } else if (r >= 0) r -= n; }
    r += 100000;
    const int nb = r / kbk, kb = r % kbk, K = kbk * 64;
    (void)nbk;
    __syncthreads();
    {
      const int n = tid & 63;
      long ld; const float* cp = conv_colptr(P, l, mat, nb * 64 + n, ld);
#pragma unroll 4
      for (int q = 0; q < 16; ++q) { int k = (tid >> 6) + 4 * q; lds[n * 65 + k] = cp[(long)(kb * 64 + k) * ld]; }
    }
    __syncthreads();
    u16* dst = (u16*)(WSP(P) + WS_W + off);
#pragma unroll
    for (int q = 0; q < 2; ++q) {
      int c = tid + 256 * q, n = c >> 3, k8 = (c & 7) * 8;
      const float* sp = lds + n * 65 + k8;
      uint4 v; v.x = pk2(sp[0], sp[1]); v.y = pk2(sp[2], sp[3]); v.z = pk2(sp[4], sp[5]); v.w = pk2(sp[6], sp[7]);
      *(uint4*)(dst + (long)(nb * 64 + n) * K + kb * 64 + k8) = v;
    }
  }
}

DI void st_mma(f32x4 (&st)[4], const u16* sK, const bf16x8 (&bq)[2], int lane) {
  const int r = lane & 15, quad = lane >> 4;
#pragma unroll
  for (int mt = 0; mt < 4; ++mt) {
    f32x4 a = {0.f, 0.f, 0.f, 0.f};
#pragma unroll
    for (int ks = 0; ks < 2; ++ks) {
      bf16x8 kf = *(const bf16x8*)(sK + (16 * mt + r) * 72 + ks * 32 + quad * 8);
      a = __builtin_amdgcn_mfma_f32_16x16x32_bf16(kf, bq[ks], a, 0, 0, 0);
    }
    st[mt] = a;
  }
}
DI void pv_mma(f32x4 (&ot)[4], const u16* sVt, const f32x4 (&p)[4], int lane) {
  const int r = lane & 15, quad = lane >> 4;
#pragma unroll
  for (int ks = 0; ks < 2; ++ks) {
    uint4 pu;
    pu.x = pk2(p[2 * ks][0], p[2 * ks][1]); pu.y = pk2(p[2 * ks][2], p[2 * ks][3]);
    pu.z = pk2(p[2 * ks + 1][0], p[2 * ks + 1][1]); pu.w = pk2(p[2 * ks + 1][2], p[2 * ks + 1][3]);
    bf16x8 pb = __builtin_bit_cast(bf16x8, pu);
#pragma unroll
    for (int dt = 0; dt < 4; ++dt) {
      const u16* vrow = sVt + (16 * dt + r) * 72;
      s16x4 lo = *(const s16x4*)(vrow + ((32 * ks + 4 * quad) ^ (16 * dt)));
      s16x4 hi = *(const s16x4*)(vrow + ((32 * ks + 16 + 4 * quad) ^ (16 * dt)));
      bf16x8 vf = __builtin_shufflevector(lo, hi, 0, 1, 2, 3, 4, 5, 6, 7);
      ot[dt] = __builtin_amdgcn_mfma_f32_16x16x32_bf16(vf, pb, ot[dt], 0, 0, 0);
    }
  }
}
DI void load_tile(u16* dst, const u16* src, long ld) {
  const int tid = TID();
#pragma unroll
  for (int i = 0; i < 2; ++i) {
    int c = tid + 256 * i, row = c >> 3, ch = c & 7;
    uint4 v = *(const uint4*)(src + (long)row * ld + ch * 8);
    *(uint4*)(dst + row * 72 + ch * 8) = v;
  }
}
DI void load_tile_T(u16* dst, const u16* src, long ld) {
  const int tid = TID();
#pragma unroll
  for (int i = 0; i < 2; ++i) {
    int c = tid + 256 * i, row = c >> 3, ch = c & 7;
    uint4 v = *(const uint4*)(src + (long)row * ld + ch * 8);
    const unsigned* vv = (const unsigned*)&v;
#pragma unroll
    for (int q = 0; q < 4; ++q) {
      dst[(ch * 8 + 2 * q) * 72 + row] = (u16)(vv[q] & 0xffff);
      dst[(ch * 8 + 2 * q + 1) * 72 + row] = (u16)(vv[q] >> 16);
    }
  }
}
DI void load_q_nsa(u16* dst, const u16* src, long ld) {
  const int tid = TID();
#pragma unroll
  for (int i = 0; i < 2; ++i) {
    int c = tid + 256 * i, row = c >> 3, ch = c & 7;
    uint4 v = *(const uint4*)(src + (long)(row & 15) * ld + (row >> 4) * 64 + ch * 8);
    *(uint4*)(dst + row * 72 + ch * 8) = v;
  }
}
DI void load_qfrag(bf16x8 (&bq)[2], const u16* sQ, int w, int lane) {
  const int r = lane & 15, quad = lane >> 4;
  bq[0] = *(const bf16x8*)(sQ + (16 * w + r) * 72 + quad * 8);
  bq[1] = *(const bf16x8*)(sQ + (16 * w + r) * 72 + 32 + quad * 8);
}
DI float quad_max(float v) { v = fmaxf(v, __shfl_xor(v, 16)); v = fmaxf(v, __shfl_xor(v, 32)); return v; }
DI float quad_sum(float v) { v += __shfl_xor(v, 16); v += __shfl_xor(v, 32); return v; }

DI void softmax_tile(f32x4 (&st)[4], const bool (&msk)[4][4], float& m, float& l, f32x4 (&ot)[4]) {
  float tm = -1e30f;
#pragma unroll
  for (int mt = 0; mt < 4; ++mt)
#pragma unroll
    for (int j = 0; j < 4; ++j) { float s = st[mt][j] * 0.125f; st[mt][j] = s; if (msk[mt][j]) tm = fmaxf(tm, s); }
  tm = quad_max(tm);
  float mn = fmaxf(m, tm);
  float alpha = __expf(m - mn);
  float ps = 0.f;
#pragma unroll
  for (int mt = 0; mt < 4; ++mt)
#pragma unroll
    for (int j = 0; j < 4; ++j) { float p = msk[mt][j] ? __expf(st[mt][j] - mn) : 0.f; st[mt][j] = p; ps += p; }
  l = l * alpha + ps;
  m = mn;
#pragma unroll
  for (int dt = 0; dt < 4; ++dt)
#pragma unroll
    for (int j = 0; j < 4; ++j) ot[dt][j] *= alpha;
}

DI void phase_rmsnorm(const float* __restrict__ x, const float* __restrict__ wgt, u16* __restrict__ H) {
  const int lane = TID() & 63, w = TID() >> 6;
  const int gw = blockIdx.x * 4 + w, nw = gridDim.x * 4;
  for (int row = gw; row < T_; row += nw) {
    const float4* xr = (const float4*)(x + (long)row * DM);
    float4 v[4]; float s = 0.f;
#pragma unroll
    for (int j = 0; j < 4; ++j) { v[j] = xr[lane + 64 * j]; s += v[j].x * v[j].x + v[j].y * v[j].y + v[j].z * v[j].z + v[j].w * v[j].w; }
    s = wave_sum(s);
    float r = rsqrtf(s * (1.f / DM) + EPS);
#pragma unroll
    for (int j = 0; j < 4; ++j) {
      float4 g = ((const float4*)wgt)[lane + 64 * j];
      uint2 o; o.x = pk2(v[j].x * r * g.x, v[j].y * r * g.y); o.y = pk2(v[j].z * r * g.z, v[j].w * r * g.w);
      *(uint2*)(H + (long)row * DM + (lane + 64 * j) * 4) = o;
    }
  }
}
DI void phase_rope_table(const int* __restrict__ positions, float* __restrict__ COS, float* __restrict__ SIN) {
  const float invf[8] = {1.0f, 0.1939227432012558f, 0.03760603070259094f, 0.007292664609849453f,
                         0.0014142135623842478f, 0.00027424818836152554f, 5.3182957344688475e-05f, 1.0313385246263351e-05f};
  for (int idx = blockIdx.x * 256 + TID(); idx < T_ * 8; idx += gridDim.x * 256) {
    int i = idx & 7;
    float f = invf[0];
#pragma unroll
    for (int q = 1; q < 8; ++q) f = (i == q) ? invf[q] : f;
    float ang = (float)positions[idx >> 3] * f;
    double s, c; sincos_d((double)ang, s, c);
    COS[idx] = (float)c; SIN[idx] = (float)s;
  }
}

struct S5Coef { float ar, ai; float bbr[16], bbi[16]; };
DI void s5_coef(const Params& P, int l, int g, int p, S5Coef& C) {
  float dt = expf(P.in[13][l * 16 + g]);
  float lr = P.in[11][(l * 16 + g) * 64 + p], li = P.in[12][(l * 16 + g) * 64 + p];
  float mag = expf(lr * dt);
  double s, c; sincos_d((double)(li * dt), s, c);
  C.ar = mag * (float)c; C.ai = mag * (float)s;
  float den = lr * lr + li * li;
  float fr = ((C.ar - 1.f) * lr + C.ai * li) / den;
  float fi = (C.ai * lr - (C.ar - 1.f) * li) / den;
  const float* br = P.in[14] + ((long)(l * 16 + g) * 64 + p) * 16;
  const float* bi = P.in[15] + ((long)(l * 16 + g) * 64 + p) * 16;
#pragma unroll
  for (int c2 = 0; c2 < 16; ++c2) {
    float b_r = br[c2], b_i = bi[c2];
    C.bbr[c2] = fr * b_r - fi * b_i;
    C.bbi[c2] = fr * b_i + fi * b_r;
  }
}
DI void s5_load_u(float* su, const u16* PROJ, int b, int chunk, int g, int lane) {
  const u16* src = PROJ + ((long)(b * SEQ + chunk * 64 + lane)) * PW + P_S5U + g * 16;
  uint4 v0 = ((const uint4*)src)[0], v1 = ((const uint4*)src)[1];
  const unsigned* a = (const unsigned*)&v0; const unsigned* c = (const unsigned*)&v1;
  float* d = su + lane * 16;
#pragma unroll
  for (int q = 0; q < 4; ++q) { d[2 * q] = bf2f((u16)(a[q] & 0xffff)); d[2 * q + 1] = bf2f((u16)(a[q] >> 16)); }
#pragma unroll
  for (int q = 0; q < 4; ++q) { d[8 + 2 * q] = bf2f((u16)(c[q] & 0xffff)); d[8 + 2 * q + 1] = bf2f((u16)(c[q] >> 16)); }
}

DI void s5_pass1_item(const Params& P, int l, int it, float* lds) {
  const int lane = TID() & 63, w = TID() >> 6;
  const int gq = it & 3, chunk = (it >> 2) & 63, b = it >> 8;
  const int g = gq * 4 + w;
  const u16* PROJ = (const u16*)(WSP(P) + WS_PROJ);
  float* su = lds + w * 1024;
  S5Coef C; s5_coef(P, l, g, lane, C);
  s5_load_u(su, PROJ, b, chunk, g, lane);
  __syncthreads();
  float xr = 0.f, xi = 0.f;
#pragma unroll 4
  for (int t = 0; t < 64; ++t) {
    const f32x4* up = (const f32x4*)(su + t * 16);
    float br = 0.f, bi = 0.f;
#pragma unroll
    for (int q = 0; q < 4; ++q) {
      f32x4 u = up[q];
#pragma unroll
      for (int e = 0; e < 4; ++e) { br += u[e] * C.bbr[4 * q + e]; bi += u[e] * C.bbi[4 * q + e]; }
    }
    float nr = C.ar * xr - C.ai * xi + br;
    float ni = C.ar * xi + C.ai * xr + bi;
    xr = nr; xi = ni;
  }
  float2* ENDS = (float2*)(WSP(P) + WS_ENDS);
  ENDS[((long)(b * 64 + chunk) * 16 + g) * 64 + lane] = make_float2(xr, xi);
}

DI void s5_carry_item(const Params& P, int l, int it) {
  const int idx = it * 256 + TID();
  const int b = idx >> 10, gp = idx & 1023, g = gp >> 6, p = gp & 63;
  float dt = expf(P.in[13][l * 16 + g]);
  float lr = P.in[11][(l * 16 + g) * 64 + p], li = P.in[12][(l * 16 + g) * 64 + p];
  float mag = expf(lr * dt * 64.f);
  double s, c; sincos_d((double)(li * dt) * 64.0, s, c);
  float ar = mag * (float)c, ai = mag * (float)s;
  const float2* ENDS = (const float2*)(WSP(P) + WS_ENDS);
  float2* CARRY = (float2*)(WSP(P) + WS_CARRY);
  float xr = 0.f, xi = 0.f;
  for (int ch = 0; ch < 64; ++ch) {
    long o = ((long)(b * 64 + ch) * 16 + g) * 64 + p;
    CARRY[o] = make_float2(xr, xi);
    float2 e = ENDS[o];
    float nr = ar * xr - ai * xi + e.x;
    float ni = ar * xi + ai * xr + e.y;
    xr = nr; xi = ni;
  }
}

DI void s5_pass2_item(const Params& P, int l, int it, float* lds) {
  const int lane = TID() & 63, w = TID() >> 6, r16 = lane & 15, quad = lane >> 4;
  const int gq = it & 3, chunk = (it >> 2) & 63, b = it >> 8;
  const int g = gq * 4 + w;
  const u16* PROJ = (const u16*)(WSP(P) + WS_PROJ);
  u16* Y5 = (u16*)(WSP(P) + WS_Y5);
  float* su = lds + w * 1024;
  u16* sX = (u16*)(lds + 4096) + w * (32 * 136);
  S5Coef C; s5_coef(P, l, g, lane, C);
  bf16x8 bfr[4];
#pragma unroll
  for (int ks = 0; ks < 4; ++ks) {
    const float* src = P.in[(ks < 2) ? 16 : 17] + ((long)(l * 16 + g) * 16 + r16) * 64 + (ks & 1) * 32 + quad * 8;
    const float4 v0 = ((const float4*)src)[0], v1 = ((const float4*)src)[1];
    const float sg = (ks < 2) ? 1.f : -1.f;
    uint4 pu; pu.x = pk2(sg * v0.x, sg * v0.y); pu.y = pk2(sg * v0.z, sg * v0.w); pu.z = pk2(sg * v1.x, sg * v1.y); pu.w = pk2(sg * v1.z, sg * v1.w);
    bfr[ks] = __builtin_bit_cast(bf16x8, pu);
  }
  const float dsk = P.in[18][l * 256 + g * 16 + r16];
  s5_load_u(su, PROJ, b, chunk, g, lane);
  __syncthreads();
  const float2 c0 = ((const float2*)(WSP(P) + WS_CARRY))[((long)(b * 64 + chunk) * 16 + g) * 64 + lane];
  float xr = c0.x, xi = c0.y;
  for (int half = 0; half < 2; ++half) {
#pragma unroll 4
    for (int tt = 0; tt < 32; ++tt) {
      const int t = half * 32 + tt;
      const f32x4* up = (const f32x4*)(su + t * 16);
      float br0 = 0.f, bi0 = 0.f, br1 = 0.f, bi1 = 0.f;
#pragma unroll
      for (int q = 0; q < 4; ++q) {
        f32x4 u = up[q];
        br0 += u[0] * C.bbr[4 * q + 0]; bi0 += u[0] * C.bbi[4 * q + 0];
        br1 += u[1] * C.bbr[4 * q + 1]; bi1 += u[1] * C.bbi[4 * q + 1];
        br0 += u[2] * C.bbr[4 * q + 2]; bi0 += u[2] * C.bbi[4 * q + 2];
        br1 += u[3] * C.bbr[4 * q + 3]; bi1 += u[3] * C.bbi[4 * q + 3];
      }
      const float nr = C.ar * xr - C.ai * xi + (br0 + br1);
      const float ni = C.ar * xi + C.ai * xr + (bi0 + bi1);
      xr = nr; xi = ni;
      sX[tt * 136 + lane] = f2bf(xr);
      sX[tt * 136 + 64 + lane] = f2bf(xi);
    }
    __syncthreads();
#pragma unroll
    for (int mt = 0; mt < 2; ++mt) {
      f32x4 acc = {0.f, 0.f, 0.f, 0.f};
#pragma unroll
      for (int ks = 0; ks < 4; ++ks) {
        const bf16x8 af = *(const bf16x8*)(sX + (16 * mt + r16) * 136 + ks * 32 + quad * 8);
        acc = __builtin_amdgcn_mfma_f32_16x16x32_bf16(af, bfr[ks], acc, 0, 0, 0);
      }
#pragma unroll
      for (int j = 0; j < 4; ++j) {
        const int t = half * 32 + 16 * mt + 4 * quad + j;
        const float y = acc[j] + dsk * su[t * 16 + r16];
        Y5[((long)(b * SEQ + chunk * 64 + t)) * 256 + g * 16 + r16] = f2bf(gelu_tanh(y));
      }
    }
    __syncthreads();
  }
}

DI void nsa_prep_item(const Params& P, int l, int it) {
  const int lane = TID() & 63, w = TID() >> 6;
  u16* PROJ = (u16*)(WSP(P) + WS_PROJ);
  u16* QR = (u16*)(WSP(P) + WS_QR);
  const float* COS = (const float*)(WSP(P) + WS_COS);
  const float* SIN = (const float*)(WSP(P) + WS_SIN);
  for (int tt = 0; tt < 4; ++tt) {
    const long t = (long)it * 16 + w * 4 + tt;
    const float cs = COS[t * 8 + (lane & 7)], sn = SIN[t * 8 + (lane & 7)];
#pragma unroll
    for (int g = 0; g < 6; ++g) {
      const int col = (g < 4) ? (P_Q + g * 64) : (g == 4 ? P_KV + 128 : P_KV + 256);
      const float wg = (g < 4) ? P.in[4][l * 64 + lane] : P.in[5][(l * 3 + (g - 3)) * 64 + lane];
      u16* ptr = PROJ + t * PW + col + lane;
      float v = bf2f(*ptr);
      float ss = wave_sum(v * v);
      float y = v * rsqrtf(ss * (1.f / 64.f) + EPS) * wg;
      float pr = __shfl_xor(y, 8);
      float rot = (lane < 8) ? (y * cs - pr * sn) : ((lane < 16) ? (y * cs + pr * sn) : y);
      if (g < 4) { *ptr = f2bf(y); QR[t * 256 + g * 64 + lane] = f2bf(rot); }
      else *ptr = f2bf(rot);
    }
  }
}

DI void cmp1_tile(const Params& P, int l, int ct, u16* sA, u16* sB) {
  const int tid = TID(), lane = tid & 63, w = tid >> 6, r16 = lane & 15, quad = lane >> 4, wm = w >> 1, wn = w & 1;
  const int kv = ct >> 5, mt = (ct >> 1) & 15, nt = ct & 1;
  const u16* PROJ = (const u16*)(WSP(P) + WS_PROJ);
  u16* HID = (u16*)(WSP(P) + WS_HID);
  const u16* apq[4];
#pragma unroll
  for (int q = 0; q < 4; ++q) {
    int row, pc; g3_rowpiece(tid, q, false, row, pc);
    int gr = mt * 128 + row; if (gr > 2039) gr = 2039;
    const int b = gr / 255, n = gr % 255;
    apq[q] = PROJ + ((long)(b * SEQ + 16 * n)) * PW + P_KV + kv * 64 + pc * 8;
  }
  const u16* Bb = (const u16*)(WSP(P) + WS_W + WT_C1) + ((long)(kv * 256 + nt * 128)) * 2048;
  f32x4 acc[4][4];
  gemm3<4>(acc, apq[0], apq[1], apq[2], apq[3], PW,
           g3_ptr(Bb, 2048, tid, 0, false), g3_ptr(Bb, 2048, tid, 1, false), g3_ptr(Bb, 2048, tid, 2, false), g3_ptr(Bb, 2048, tid, 3, false), 2048, sA);
  {
    const float* PART = (const float*)(WSP(P) + WS_CBIAS) + (long)kv * 32 * 256;
#pragma unroll
    for (int ni = 0; ni < 4; ++ni) {
      const int col = nt * 128 + wn * 64 + 16 * ni + r16;
      float bsum = 0.f;
      for (int sl = 0; sl < 32; ++sl) bsum += PART[sl * 256 + col];
#pragma unroll
      for (int mi = 0; mi < 4; ++mi)
#pragma unroll
        for (int j = 0; j < 4; ++j) acc[mi][ni][j] += bsum;
    }
  }
  __syncthreads();
#pragma unroll
  for (int mi = 0; mi < 4; ++mi)
#pragma unroll
    for (int ni = 0; ni < 4; ++ni)
#pragma unroll
      for (int j = 0; j < 4; ++j) sA[(wm * 64 + 16 * mi + 4 * quad + j) * 136 + wn * 64 + 16 * ni + r16] = f2bf(gelu_tanh(acc[mi][ni][j]));
  __syncthreads();
  store_tile_bf16<128>(sA, HID + ((long)kv * 2048 + mt * 128) * 256 + nt * 128, 256, 2040 - mt * 128);
}
DI void cmp2_tile(const Params& P, int l, int ct, u16* sA, u16* sB, float* sSS) {
  const int tid = TID(), lane = tid & 63, w = tid >> 6, r16 = lane & 15, quad = lane >> 4, wm = w >> 1, wn = w & 1;
  const int kv = ct >> 4, mt = ct & 15;
  const u16* HID = (const u16*)(WSP(P) + WS_HID);
  u16* OUT = (u16*)(WSP(P) + (kv ? WS_VC : WS_KC));
  const u16* Ab = HID + ((long)kv * 2048 + mt * 128) * 256;
  const u16* Bb = (const u16*)(WSP(P) + WS_W + WT_C2) + (long)kv * 64 * 256;
  f32x4 acc[4][2];
  gemm3<2>(acc, g3_ptr(Ab, 256, tid, 0, false), g3_ptr(Ab, 256, tid, 1, false), g3_ptr(Ab, 256, tid, 2, false), g3_ptr(Ab, 256, tid, 3, false), 64,
           g3_ptr(Bb, 256, tid, 0, true), g3_ptr(Bb, 256, tid, 1, true), nullptr, nullptr, 256, sA);
  __syncthreads();
  if (tid < 128) sSS[tid] = 0.f;
  __syncthreads();
#pragma unroll
  for (int mi = 0; mi < 4; ++mi)
#pragma unroll
    for (int j = 0; j < 4; ++j) {
      float ss = acc[mi][0][j] * acc[mi][0][j] + acc[mi][1][j] * acc[mi][1][j];
      ss += __shfl_xor(ss, 1); ss += __shfl_xor(ss, 2); ss += __shfl_xor(ss, 4); ss += __shfl_xor(ss, 8);
      if (r16 == 0) atomicAdd(&sSS[wm * 64 + 16 * mi + 4 * quad + j], ss);
    }
  __syncthreads();
#pragma unroll
  for (int mi = 0; mi < 4; ++mi)
#pragma unroll
    for (int j = 0; j < 4; ++j) {
      const int rl = wm * 64 + 16 * mi + 4 * quad + j, row = mt * 128 + rl;
      const float sc = (kv == 0) ? rsqrtf(sSS[rl] * (1.f / 64.f) + EPS) : 1.f;
      if (row < 2040) {
        int b = row / 255, n = row % 255;
#pragma unroll
        for (int ni = 0; ni < 2; ++ni) {
          int col = wn * 32 + 16 * ni + r16;
          float v = acc[mi][ni][j] * sc;
          if (kv == 0) v *= P.in[5][(l * 3 + 0) * 64 + col];
          OUT[((long)(b * 256 + n)) * 64 + col] = f2bf(v);
        }
      }
    }
}

DI void gdn_p1_item(const Params& P, int l, int it, float* lds) {
  const int tid = TID(), lane = tid & 63, w = tid >> 6, r16 = lane & 15, quad = lane >> 4;
  const int chunk = it & 63, h = (it >> 6) & 3, b = it >> 8;
  const long ci = it;
  const u16* PROJ = (const u16*)(WSP(P) + WS_PROJ);
  float* sq = lds;
  float* sk = lds + 64 * 65;
  float* sv = lds + 2 * 64 * 65;
  float* sG = lds + 3 * 64 * 65;
  float* sBeta = sG + 64;
  float* sg = sBeta + 64;
  u16* sQb = (u16*)(sg + 64);
  u16* sKb = sQb + 64 * 72;
  const float* cw = P.in[20] + (long)l * 4 * 768;
  if (tid < 192) {
    const int cp = tid % 96, th = tid / 96;
    const int c0 = 2 * cp, which = c0 >> 6, d = c0 & 63, C = which * 256 + h * 64 + d;
    float w0[4], w1[4];
#pragma unroll
    for (int k = 0; k < 4; ++k) { w0[k] = cw[k * 768 + C]; w1[k] = cw[k * 768 + C + 1]; }
    unsigned v[35];
    const int s0 = chunk * 64 + th * 32 - 3;
    const u16* src = PROJ + ((long)(b * SEQ + s0)) * PW + P_GQKV + C;
#pragma unroll
    for (int k = 0; k < 35; ++k) v[k] = (s0 + k >= 0) ? *(const unsigned*)(src + (long)k * PW) : 0u;
    float* dst = lds + which * 64 * 65 + (th * 32) * 65 + d;
#pragma unroll
    for (int tt = 0; tt < 32; ++tt) {
      float a0 = 0.f, a1 = 0.f;
#pragma unroll
      for (int k = 0; k < 4; ++k) { a0 += w0[k] * bf2f((u16)(v[tt + k] & 0xffff)); a1 += w1[k] * bf2f((u16)(v[tt + k] >> 16)); }
      dst[tt * 65] = siluf_(a0); dst[tt * 65 + 1] = siluf_(a1);
    }
  }
  __syncthreads();
  if (tid < 128) {
    float* base = (tid < 64) ? sq : sk;
    u16* bb = (tid < 64) ? sQb : sKb;
    const int row = tid & 63;
    float ss = 0.f;
#pragma unroll 8
    for (int d = 0; d < 64; ++d) { float x = base[row * 65 + d]; ss += x * x; }
    const float sc = rsqrtf(ss + EPS) * ((tid < 64) ? 0.125f : 1.f);
#pragma unroll 8
    for (int d = 0; d < 64; d += 2) {
      const float x0 = base[row * 65 + d] * sc, x1 = base[row * 65 + d + 1] * sc;
      base[row * 65 + d] = x0; base[row * 65 + d + 1] = x1;
      *(unsigned*)(bb + row * 72 + d) = pk2(x0, x1);
    }
  } else if (tid < 192) {
    const int row = tid - 128;
    const long t = (long)(b * SEQ + chunk * 64 + row);
    const float bl = bf2f(PROJ[t * PW + P_GB + h]);
    const float al = bf2f(PROJ[t * PW + P_GA + h]);
    sBeta[row] = sigmoidf_(bl);
    sg[row] = -expf(P.in[21][l * 4 + h]) * softplusf_(al + P.in[22][l * 4 + h]);
  }
  __syncthreads();
  if (tid < 64) {
    float x = sg[tid];
#pragma unroll
    for (int o = 1; o < 64; o <<= 1) { float u = __shfl_up(x, o); if (tid >= o) x += u; }
    sG[tid] = x;
    ((float*)(WSP(P) + WS_GG))[ci * 64 + tid] = x;
  }
  __syncthreads();
  f32x4 lreg[4];
  {
    const f32x4 Gi4 = *(const f32x4*)(sG + 16 * w + 4 * quad);
    const f32x4 Bi4 = *(const f32x4*)(sBeta + 16 * w + 4 * quad);
    u16* GA = (u16*)(WSP(P) + WS_GA) + ci * 4096;
#pragma unroll
    for (int nt = 0; nt < 4; ++nt) {
      f32x4 aq = {0.f, 0.f, 0.f, 0.f}, ak = {0.f, 0.f, 0.f, 0.f};
#pragma unroll
      for (int ks = 0; ks < 2; ++ks) {
        const bf16x8 fq = *(const bf16x8*)(sQb + (16 * w + r16) * 72 + ks * 32 + quad * 8);
        const bf16x8 fk = *(const bf16x8*)(sKb + (16 * w + r16) * 72 + ks * 32 + quad * 8);
        const bf16x8 fb = *(const bf16x8*)(sKb + (16 * nt + r16) * 72 + ks * 32 + quad * 8);
        aq = __builtin_amdgcn_mfma_f32_16x16x32_bf16(fq, fb, aq, 0, 0, 0);
        ak = __builtin_amdgcn_mfma_f32_16x16x32_bf16(fk, fb, ak, 0, 0, 0);
      }
      const int j = 16 * nt + r16;
      const float Gj = sG[j];
#pragma unroll
      for (int jj = 0; jj < 4; ++jj) {
        const int i = 16 * w + 4 * quad + jj;
        const float dec = __expf(Gi4[jj] - Gj);
        GA[i * 64 + j] = f2bf((j <= i) ? aq[jj] * dec : 0.f);
        const float lv = (j < i) ? Bi4[jj] * ak[jj] * dec : 0.f;
        sq[i * 65 + j] = lv;
        lreg[nt][jj] = lv;
      }
    }
  }
  {
    u16* GQ = (u16*)(WSP(P) + WS_GQ) + ci * 4096;
#pragma unroll
    for (int q = 0; q < 2; ++q) { const int c = tid + 256 * q, row = c >> 3, ch = c & 7; *(uint4*)(GQ + row * 64 + ch * 8) = *(const uint4*)(sQb + row * 72 + ch * 8); }
    const int i = tid >> 2, j0 = (tid & 3) * 16;
    u16* GK = (u16*)(WSP(P) + WS_GK) + ci * 4096 + i * 64 + j0;
    unsigned ok[8];
#pragma unroll
    for (int q = 0; q < 8; ++q) ok[q] = pk2(sk[(j0 + 2 * q) * 65 + i], sk[(j0 + 2 * q + 1) * 65 + i]);
    ((uint4*)GK)[0] = make_uint4(ok[0], ok[1], ok[2], ok[3]); ((uint4*)GK)[1] = make_uint4(ok[4], ok[5], ok[6], ok[7]);
  }
  __syncthreads();
  u16* sLb = sQb;
  u16* sXT = sKb;
  {
    const int i = tid >> 2, j0 = (tid & 3) * 16;
    const float bi = sBeta[i], eg = __expf(sG[i]);
#pragma unroll
    for (int jj = 0; jj < 16; ++jj) { sv[i * 65 + j0 + jj] *= bi; sk[i * 65 + j0 + jj] *= bi * eg; }
#pragma unroll
    for (int nt = 0; nt < 4; ++nt)
#pragma unroll
      for (int jj = 0; jj < 4; ++jj) sLb[(16 * w + 4 * quad + jj) * 72 + 16 * nt + r16] = f2bf(lreg[nt][jj]);
  }
  __syncthreads();
#pragma unroll 1
  for (int bi = 0; bi < 4; ++bi) {
    if (tid < 128) {
      float* buf = (tid < 64) ? sv : sk;
      const int col = tid & 63;
      float x[16];
#pragma unroll
      for (int r = 0; r < 16; ++r) {
        float a0 = buf[(16 * bi + r) * 65 + col], a1 = 0.f;
#pragma unroll
        for (int j = 0; j + 1 < r; j += 2) { a0 -= sq[(16 * bi + r) * 65 + 16 * bi + j] * x[j]; a1 -= sq[(16 * bi + r) * 65 + 16 * bi + j + 1] * x[j + 1]; }
        if (r & 1) a0 -= sq[(16 * bi + r) * 65 + 16 * bi + r - 1] * x[r - 1];
        x[r] = a0 + a1;
        buf[(16 * bi + r) * 65 + col] = x[r];
      }
      uint4 p0, p1;
      p0.x = pk2(x[0], x[1]); p0.y = pk2(x[2], x[3]); p0.z = pk2(x[4], x[5]); p0.w = pk2(x[6], x[7]);
      p1.x = pk2(x[8], x[9]); p1.y = pk2(x[10], x[11]); p1.z = pk2(x[12], x[13]); p1.w = pk2(x[14], x[15]);
      *(uint4*)(sXT + tid * 24) = p0; *(uint4*)(sXT + tid * 24 + 8) = p1;
    }
    __syncthreads();
    if (bi < 3) {
#pragma unroll
      for (int q = 0; q < 2; ++q) {
        const int nt = 2 * w + q, colg = 16 * nt + r16;
        bf16x8 bx = *(const bf16x8*)(sXT + colg * 24 + (quad & 1) * 8);
        if (quad >= 2) bx = (bf16x8){0, 0, 0, 0, 0, 0, 0, 0};
        float* buf = (colg < 64) ? sv : sk;
        const int cc = colg & 63;
        for (int bk = bi + 1; bk < 4; ++bk) {
          const bf16x8 al = *(const bf16x8*)(sLb + (16 * bk + r16) * 72 + 16 * bi + quad * 8);
          f32x4 c = {0.f, 0.f, 0.f, 0.f};
          c = __builtin_amdgcn_mfma_f32_16x16x32_bf16(al, bx, c, 0, 0, 0);
#pragma unroll
          for (int jj = 0; jj < 4; ++jj) buf[(16 * bk + 4 * quad + jj) * 65 + cc] -= c[jj];
        }
      }
    }
    __syncthreads();
  }
  {
    const int i = tid >> 2, j0 = (tid & 3) * 16;
    u16* GU = (u16*)(WSP(P) + WS_GU) + ci * 4096 + i * 64 + j0;
    u16* GW = (u16*)(WSP(P) + WS_GW) + ci * 4096 + i * 64 + j0;
    unsigned ou[8], ow[8];
#pragma unroll
    for (int q = 0; q < 8; ++q) {
      ou[q] = pk2(sv[i * 65 + j0 + 2 * q], sv[i * 65 + j0 + 2 * q + 1]);
      ow[q] = pk2(sk[i * 65 + j0 + 2 * q], sk[i * 65 + j0 + 2 * q + 1]);
    }
    ((uint4*)GU)[0] = make_uint4(ou[0], ou[1], ou[2], ou[3]); ((uint4*)GU)[1] = make_uint4(ou[4], ou[5], ou[6], ou[7]);
    ((uint4*)GW)[0] = make_uint4(ow[0], ow[1], ow[2], ow[3]); ((uint4*)GW)[1] = make_uint4(ow[4], ow[5], ow[6], ow[7]);
  }
}

DI void unpack8(const u16* p, float (&o)[8]) {
  uint4 v = *(const uint4*)p;
  o[0] = bf2f((u16)(v.x & 0xffff)); o[1] = bf2f((u16)(v.x >> 16));
  o[2] = bf2f((u16)(v.y & 0xffff)); o[3] = bf2f((u16)(v.y >> 16));
  o[4] = bf2f((u16)(v.z & 0xffff)); o[5] = bf2f((u16)(v.z >> 16));
  o[6] = bf2f((u16)(v.w & 0xffff)); o[7] = bf2f((u16)(v.w >> 16));
}
DI void st_kt(u16* sKt, int c8, int row, uint4 k) {
  sKt[(c8 + 0) * 72 + row] = (u16)(k.x & 0xffff); sKt[(c8 + 1) * 72 + row] = (u16)(k.x >> 16);
  sKt[(c8 + 2) * 72 + row] = (u16)(k.y & 0xffff); sKt[(c8 + 3) * 72 + row] = (u16)(k.y >> 16);
  sKt[(c8 + 4) * 72 + row] = (u16)(k.z & 0xffff); sKt[(c8 + 5) * 72 + row] = (u16)(k.z >> 16);
  sKt[(c8 + 6) * 72 + row] = (u16)(k.w & 0xffff); sKt[(c8 + 7) * 72 + row] = (u16)(k.w >> 16);
}
DI uint2 pack4bf(const f32x4& v) { uint2 r; r.x = pk2(v[0], v[1]); r.y = pk2(v[2], v[3]); return r; }
DI void gdn_p2_item(const Params& P, int it, float* lds) {
  const int tid = TID(), lane = tid & 63, w = tid >> 6, r16 = lane & 15, quad = lane >> 4;
  const int es = it & 3, bh = it >> 2, b = bh >> 2, h = bh & 3;
  u16* sW = (u16*)lds;
  u16* sQ = sW + 64 * 72;
  u16* sAm = sQ + 64 * 72;
  u16* sKt = sAm + 64 * 72;
  u16* sSt = sKt + 64 * 72;
  u16* sVnT = sSt + 16 * 72;
  u16* sVdT = sVnT + 16 * 72;
  float* sG = (float*)(sVdT + 16 * 72);
  const u16* GQ = (const u16*)(WSP(P) + WS_GQ); const u16* GK = (const u16*)(WSP(P) + WS_GK);
  const u16* GU = (const u16*)(WSP(P) + WS_GU); const u16* GW = (const u16*)(WSP(P) + WS_GW);
  const u16* GA = (const u16*)(WSP(P) + WS_GA); const float* GG = (const float*)(WSP(P) + WS_GG);
  u16* ORAW = (u16*)(WSP(P) + WS_OM) + (long)2 * T_ * 256;
  f32x4 S = {0.f, 0.f, 0.f, 0.f};
  const int irow = 16 * w + 4 * quad;
  uint4 rw0, rw1, rq0, rq1, ra0, ra1, rk0, rk1; u16 ru0, ru1, ru2, ru3; float rg = 0.f;
  const int c0 = tid, c1 = tid + 256;
  const long off0 = (c0 >> 3) * 64 + (c0 & 7) * 8, off1 = (c1 >> 3) * 64 + (c1 & 7) * 8;
#define GDN_GLOAD(CH) { long ci_ = (long)bh * 64 + (CH); \
    rw0 = *(const uint4*)(GW + ci_ * 4096 + off0); rw1 = *(const uint4*)(GW + ci_ * 4096 + off1); \
    rq0 = *(const uint4*)(GQ + ci_ * 4096 + off0); rq1 = *(const uint4*)(GQ + ci_ * 4096 + off1); \
    ra0 = *(const uint4*)(GA + ci_ * 4096 + off0); ra1 = *(const uint4*)(GA + ci_ * 4096 + off1); \
    rk0 = *(const uint4*)(GK + ci_ * 4096 + off0); rk1 = *(const uint4*)(GK + ci_ * 4096 + off1); \
    const u16* up_ = GU + ci_ * 4096 + irow * 64 + es * 16 + r16; \
    ru0 = up_[0]; ru1 = up_[64]; ru2 = up_[128]; ru3 = up_[192]; \
    if (tid < 64) rg = GG[ci_ * 64 + tid]; }
  GDN_GLOAD(0)
  for (int ch = 0; ch < 64; ++ch) {
    __syncthreads();
    {
      const int row0 = c0 >> 3, c80 = (c0 & 7) * 8, row1 = c1 >> 3, c81 = (c1 & 7) * 8;
      *(uint4*)(sW + row0 * 72 + c80) = rw0; *(uint4*)(sW + row1 * 72 + c81) = rw1;
      *(uint4*)(sQ + row0 * 72 + c80) = rq0; *(uint4*)(sQ + row1 * 72 + c81) = rq1;
      *(uint4*)(sAm + row0 * 72 + c80) = ra0; *(uint4*)(sAm + row1 * 72 + c81) = ra1;
      *(uint4*)(sKt + row0 * 72 + c80) = rk0; *(uint4*)(sKt + row1 * 72 + c81) = rk1;
    }
    if (tid < 64) sG[tid] = rg;
    *(uint2*)(sSt + r16 * 72 + irow) = pack4bf(S);
    const f32x4 uc = {bf2f(ru0), bf2f(ru1), bf2f(ru2), bf2f(ru3)};
    __syncthreads();
    if (ch + 1 < 64) GDN_GLOAD(ch + 1)
    f32x4 ws = {0.f, 0.f, 0.f, 0.f}, qs = {0.f, 0.f, 0.f, 0.f};
#pragma unroll
    for (int ks = 0; ks < 2; ++ks) {
      const bf16x8 bS = *(const bf16x8*)(sSt + r16 * 72 + ks * 32 + quad * 8);
      const bf16x8 aW = *(const bf16x8*)(sW + (16 * w + r16) * 72 + ks * 32 + quad * 8);
      const bf16x8 aQ = *(const bf16x8*)(sQ + (16 * w + r16) * 72 + ks * 32 + quad * 8);
      ws = __builtin_amdgcn_mfma_f32_16x16x32_bf16(aW, bS, ws, 0, 0, 0);
      qs = __builtin_amdgcn_mfma_f32_16x16x32_bf16(aQ, bS, qs, 0, 0, 0);
    }
    const float Gl = sG[63];
    const f32x4 G4 = *(const f32x4*)(sG + irow);
    f32x4 vn, vd;
#pragma unroll
    for (int j = 0; j < 4; ++j) { vn[j] = uc[j] - ws[j]; vd[j] = vn[j] * __expf(Gl - G4[j]); }
    *(uint2*)(sVnT + r16 * 72 + irow) = pack4bf(vn);
    *(uint2*)(sVdT + r16 * 72 + irow) = pack4bf(vd);
    __syncthreads();
    f32x4 av = {0.f, 0.f, 0.f, 0.f}, kv = {0.f, 0.f, 0.f, 0.f};
#pragma unroll
    for (int ks = 0; ks < 2; ++ks) {
      const bf16x8 bVn = *(const bf16x8*)(sVnT + r16 * 72 + ks * 32 + quad * 8);
      const bf16x8 bVd = *(const bf16x8*)(sVdT + r16 * 72 + ks * 32 + quad * 8);
      const bf16x8 aA = *(const bf16x8*)(sAm + (16 * w + r16) * 72 + ks * 32 + quad * 8);
      const bf16x8 aK = *(const bf16x8*)(sKt + (16 * w + r16) * 72 + ks * 32 + quad * 8);
      av = __builtin_amdgcn_mfma_f32_16x16x32_bf16(aA, bVn, av, 0, 0, 0);
      kv = __builtin_amdgcn_mfma_f32_16x16x32_bf16(aK, bVd, kv, 0, 0, 0);
    }
    {
      u16* op = ORAW + ((long)(b * SEQ + ch * 64 + irow)) * 256 + h * 64 + es * 16 + r16;
#pragma unroll
      for (int j = 0; j < 4; ++j) op[j * 256] = f2bf(__expf(G4[j]) * qs[j] + av[j]);
    }
    const float gl = __expf(Gl);
#pragma unroll
    for (int j = 0; j < 4; ++j) S[j] = S[j] * gl + kv[j];
  }
#undef GDN_GLOAD
}
DI void gdn_post_item(const Params& P, int l, int it) {
  const int lane = TID() & 63, w = TID() >> 6;
  const u16* PROJ = (const u16*)(WSP(P) + WS_PROJ);
  u16* O = (u16*)(WSP(P) + WS_OM) + (long)2 * T_ * 256;
  const float wn = P.in[23][l * 64 + lane];
#pragma unroll 4
  for (int q = 0; q < 16; ++q) {
    long t = (long)it * 16 + w * 4 + (q >> 2); int h = q & 3;
    float o = bf2f(O[t * 256 + h * 64 + lane]);
    float ss = wave_sum(o * o);
    float y = o * rsqrtf(ss * (1.f / 64.f) + EPS) * wn;
    float z = bf2f(PROJ[t * PW + P_GZ + h * 64 + lane]);
    O[t * 256 + h * 64 + lane] = f2bf(y * siluf_(z));
  }
}

DI void kv_gload(uint4& k0, uint4& k1, uint4& v0, uint4& v1, const u16* ksrc, const u16* vsrc, long ld) {
  const int tid = TID(), r0 = tid >> 3, ch = tid & 7;
  k0 = *(const uint4*)(ksrc + (long)r0 * ld + ch * 8); k1 = *(const uint4*)(ksrc + (long)(r0 + 32) * ld + ch * 8);
  v0 = *(const uint4*)(vsrc + (long)r0 * ld + ch * 8); v1 = *(const uint4*)(vsrc + (long)(r0 + 32) * ld + ch * 8);
}
DI void k_gload(uint4& k0, uint4& k1, const u16* ksrc, long ld) {
  const int tid = TID(), r0 = tid >> 3, ch = tid & 7;
  k0 = *(const uint4*)(ksrc + (long)r0 * ld + ch * 8); k1 = *(const uint4*)(ksrc + (long)(r0 + 32) * ld + ch * 8);
}
DI void k_store(const uint4& k0, const uint4& k1, u16* sK) {
  const int tid = TID(), r0 = tid >> 3, ch = tid & 7;
  *(uint4*)(sK + r0 * 72 + ch * 8) = k0; *(uint4*)(sK + (r0 + 32) * 72 + ch * 8) = k1;
}
DI void kv_store(const uint4& k0, const uint4& k1, const uint4& v0, const uint4& v1, u16* sK, u16* sVt) {
  const int tid = TID(), r0 = tid >> 3, ch = tid & 7;
  *(uint4*)(sK + r0 * 72 + ch * 8) = k0; *(uint4*)(sK + (r0 + 32) * 72 + ch * 8) = k1;
  const int ksw = 16 * (ch >> 1);
  st_kt(sVt, ch * 8, r0 ^ ksw, v0); st_kt(sVt, ch * 8, (r0 + 32) ^ ksw, v1);
}
DI void sb_attn_item(const Params& P, int it, u16* sQ, u16* sK, u16* sVt) {
  const int tid = TID(), lane = tid & 63, w = tid >> 6, r16 = lane & 15, quad = lane >> 4;
  const int qb = 63 - (it >> 5), bh = it & 31, b = bh >> 2, h = bh & 3;
  const u16* PROJ = (const u16*)(WSP(P) + WS_PROJ);
  u16* OUT = (u16*)(WSP(P) + WS_OM) + (long)3 * T_ * 256;
  const long tb = (long)b * SEQ;
  load_tile(sQ, PROJ + (tb + qb * 64) * PW + P_SB + h * 64, PW);
  __syncthreads();
  bf16x8 bq[2]; load_qfrag(bq, sQ, w, lane);
  const int tq = qb * 64 + 16 * w + r16;
  f32x4 ot[4];
#pragma unroll
  for (int dt = 0; dt < 4; ++dt) ot[dt] = (f32x4){0.f, 0.f, 0.f, 0.f};
  float R = 0.f;
  uint4 pk0, pk1, pv0, pv1;
  kv_gload(pk0, pk1, pv0, pv1, PROJ + (tb + qb * 64) * PW + P_SB + 256 + h * 64, PROJ + (tb + qb * 64) * PW + P_SB + 512 + h * 64, PW);
  for (int kb = qb; kb >= 0; --kb) {
    if (__syncthreads_and(R < -104.f)) break;
    kv_store(pk0, pk1, pv0, pv1, sK, sVt);
    __syncthreads();
    if (kb > 0) kv_gload(pk0, pk1, pv0, pv1, PROJ + (tb + (kb - 1) * 64) * PW + P_SB + 256 + h * 64, PROJ + (tb + (kb - 1) * 64) * PW + P_SB + 512 + h * 64, PW);
    f32x4 st[4];
    st_mma(st, sK, bq, lane);
    float gs[4], zz[4][4], x[4][4];
#pragma unroll
    for (int mt = 0; mt < 4; ++mt) {
      float g = 0.f;
#pragma unroll
      for (int j = 0; j < 4; ++j) {
        int s = kb * 64 + 16 * mt + 4 * quad + j;
        float z = st[mt][j] * 0.125f;
        float sp = softplusf_(z);
        bool mk = s < tq;
        x[mt][j] = mk ? -sp : 0.f;
        zz[mt][j] = mk ? (z - sp) : -1e30f;
        g += x[mt][j];
      }
      gs[mt] = g;
    }
    float hm = 0.f, tot_all = 0.f;
    f32x4 pw[4];
#pragma unroll
    for (int mt = 3; mt >= 0; --mt) {
      float g = gs[mt];
      float v1 = __shfl_down(g, 16), v2 = __shfl_down(g, 32), v3 = __shfl_down(g, 48);
      float hq = (quad < 3 ? v1 : 0.f) + (quad < 2 ? v2 : 0.f) + (quad < 1 ? v3 : 0.f);
      float tot = quad_sum(g);
      float base = R + hm + hq;
      float e3 = 0.f, e2 = x[mt][3], e1 = e2 + x[mt][2], e0 = e1 + x[mt][1];
      pw[mt][0] = __expf(zz[mt][0] + base + e0);
      pw[mt][1] = __expf(zz[mt][1] + base + e1);
      pw[mt][2] = __expf(zz[mt][2] + base + e2);
      pw[mt][3] = __expf(zz[mt][3] + base + e3);
      hm += tot; tot_all += tot;
    }
    R += tot_all;
    pv_mma(ot, sVt, pw, lane);
  }
  const long t = tb + tq;
#pragma unroll
  for (int dt = 0; dt < 4; ++dt) {
    uint2 ov; ov.x = pk2(ot[dt][0], ot[dt][1]); ov.y = pk2(ot[dt][2], ot[dt][3]);
    *(uint2*)(OUT + t * 256 + h * 64 + 16 * dt + 4 * quad) = ov;
  }
}

DI void win_attn_item(const Params& P, int it, u16* sQ, u16* sKunused, u16* sVunused) {
  const int tid = TID(), lane = tid & 63, w = tid >> 6, r16 = lane & 15, quad = lane >> 4;
  const int tbk = 127 - (it >> 3), b = it & 7;
  u16* sK = sQ + 128 * 72;
  u16* sVt = sK + 64 * 72;
  (void)sKunused; (void)sVunused;
  const u16* PROJ = (const u16*)(WSP(P) + WS_PROJ);
  const u16* QR = (const u16*)(WSP(P) + WS_QR);
  u16* OW = (u16*)(WSP(P) + WS_OW);
  const long tb = (long)b * SEQ;
  const int t0 = tbk * 32;
#pragma unroll
  for (int i = 0; i < 4; ++i) {
    const int c = tid + 256 * i, row = c >> 3, ch = c & 7;
    *(uint4*)(sQ + row * 72 + ch * 8) = *(const uint4*)(QR + (tb + t0 + (row & 31)) * 256 + (row >> 5) * 64 + ch * 8);
  }
  __syncthreads();
  bf16x8 bq[2][2];
  int tq[2];
#pragma unroll
  for (int qt = 0; qt < 2; ++qt) {
    const int rowq = 32 * w + 16 * qt + r16;
    bq[qt][0] = *(const bf16x8*)(sQ + rowq * 72 + quad * 8);
    bq[qt][1] = *(const bf16x8*)(sQ + rowq * 72 + 32 + quad * 8);
    tq[qt] = t0 + 16 * qt + r16;
  }
  f32x4 ot[2][4];
#pragma unroll
  for (int qt = 0; qt < 2; ++qt)
#pragma unroll
    for (int dt = 0; dt < 4; ++dt) ot[qt][dt] = (f32x4){0.f, 0.f, 0.f, 0.f};
  float m[2] = {-1e30f, -1e30f}, lsum[2] = {0.f, 0.f};
  const int lo = (t0 - 511) > 0 ? (t0 - 511) : 0;
  const int kb_lo = lo >> 6, kb_hi = (t0 + 31) >> 6;
  uint4 pk0, pk1, pv0, pv1;
  kv_gload(pk0, pk1, pv0, pv1, PROJ + (tb + kb_lo * 64) * PW + P_KV + 256, PROJ + (tb + kb_lo * 64) * PW + P_KV + 320, PW);
  for (int kb = kb_lo; kb <= kb_hi; ++kb) {
    __syncthreads();
    kv_store(pk0, pk1, pv0, pv1, sK, sVt);
    __syncthreads();
    if (kb < kb_hi) kv_gload(pk0, pk1, pv0, pv1, PROJ + (tb + (kb + 1) * 64) * PW + P_KV + 256, PROJ + (tb + (kb + 1) * 64) * PW + P_KV + 320, PW);
#pragma unroll
    for (int qt = 0; qt < 2; ++qt) {
      f32x4 st[4];
      st_mma(st, sK, bq[qt], lane);
      bool msk[4][4];
#pragma unroll
      for (int mt = 0; mt < 4; ++mt)
#pragma unroll
        for (int j = 0; j < 4; ++j) { int s = kb * 64 + 16 * mt + 4 * quad + j; int df = tq[qt] - s; msk[mt][j] = (df >= 0) && (df < 512); }
      softmax_tile(st, msk, m[qt], lsum[qt], ot[qt]);
      pv_mma(ot[qt], sVt, st, lane);
    }
  }
#pragma unroll
  for (int qt = 0; qt < 2; ++qt) {
    const float ls = quad_sum(lsum[qt]);
    const float inv = 1.f / fmaxf(ls, 1e-30f);
    const long t = tb + tq[qt];
#pragma unroll
    for (int dt = 0; dt < 4; ++dt) {
      uint2 ov; ov.x = pk2(ot[qt][dt][0] * inv, ot[qt][dt][1] * inv); ov.y = pk2(ot[qt][dt][2] * inv, ot[qt][dt][3] * inv);
      *(uint2*)(OW + t * 256 + w * 64 + 16 * dt + 4 * quad) = ov;
    }
  }
}

DI void cmp_attn_item(const Params& P, int it, u16* sQ, u16* sK, u16* sVt, float* sImp) {
  const int tid = TID(), lane = tid & 63, w = tid >> 6, r16 = lane & 15, quad = lane >> 4;
  const int tbk = 255 - (it >> 3), b = it & 7;
  const u16* PROJ = (const u16*)(WSP(P) + WS_PROJ);
  const u16* KC = (const u16*)(WSP(P) + WS_KC) + (long)b * 256 * 64;
  const u16* VC = (const u16*)(WSP(P) + WS_VC) + (long)b * 256 * 64;
  u16* OC = (u16*)(WSP(P) + WS_OC);
  u64* SEL = (u64*)(WSP(P) + WS_SEL);
  const long tb = (long)b * SEQ;
  const int t0 = tbk * 16;
  load_q_nsa(sQ, PROJ + (tb + t0) * PW + P_Q, PW);
  for (int e = tid; e < 4 * 16 * 64; e += 256) sImp[e] = 0.f;
  __syncthreads();
  bf16x8 bq[2]; load_qfrag(bq, sQ, w, lane);
  const int tq = t0 + r16;
  const int nv = (tq >= 31) ? ((tq - 31) >> 4) + 1 : 0;
  const int nvmax = (t0 + 15 >= 31) ? ((t0 + 15 - 31) >> 4) + 1 : 0;
  const int ntile = (nvmax + 63) >> 6;
  float m = -1e30f, lsum = 0.f;
  uint4 pk0, pk1, pv0, pv1;
  if (ntile > 0) k_gload(pk0, pk1, KC, 64);
  for (int kt = 0; kt < ntile; ++kt) {
    __syncthreads();
    k_store(pk0, pk1, sK);
    __syncthreads();
    if (kt + 1 < ntile) k_gload(pk0, pk1, KC + (kt + 1) * 64 * 64, 64);
    f32x4 st[4];
    st_mma(st, sK, bq, lane);
    float tm = -1e30f;
#pragma unroll
    for (int mt = 0; mt < 4; ++mt)
#pragma unroll
      for (int j = 0; j < 4; ++j) { int n = kt * 64 + 16 * mt + 4 * quad + j; float s = st[mt][j] * 0.125f; st[mt][j] = s; if (n < nv) tm = fmaxf(tm, s); }
    tm = quad_max(tm);
    float mn = fmaxf(m, tm);
    float ps = 0.f;
#pragma unroll
    for (int mt = 0; mt < 4; ++mt)
#pragma unroll
      for (int j = 0; j < 4; ++j) { int n = kt * 64 + 16 * mt + 4 * quad + j; if (n < nv) ps += __expf(st[mt][j] - mn); }
    lsum = lsum * __expf(m - mn) + ps;
    m = mn;
  }
  lsum = quad_sum(lsum);
  const float inv = (lsum > 0.f) ? 1.f / lsum : 0.f;
  f32x4 ot[4];
#pragma unroll
  for (int dt = 0; dt < 4; ++dt) ot[dt] = (f32x4){0.f, 0.f, 0.f, 0.f};
  float carry = 0.f;
  if (ntile > 0) kv_gload(pk0, pk1, pv0, pv1, KC, VC, 64);
  for (int kt = 0; kt < ntile; ++kt) {
    __syncthreads();
    kv_store(pk0, pk1, pv0, pv1, sK, sVt);
    __syncthreads();
    if (kt + 1 < ntile) kv_gload(pk0, pk1, pv0, pv1, KC + (kt + 1) * 64 * 64, VC + (kt + 1) * 64 * 64, 64);
    f32x4 st[4];
    st_mma(st, sK, bq, lane);
#pragma unroll
    for (int mt = 0; mt < 4; ++mt)
#pragma unroll
      for (int j = 0; j < 4; ++j) { int n = kt * 64 + 16 * mt + 4 * quad + j; st[mt][j] = (n < nv) ? __expf(st[mt][j] * 0.125f - m) * inv : 0.f; }
    pv_mma(ot, sVt, st, lane);
    float prevlast = carry;
#pragma unroll
    for (int mt = 0; mt < 4; ++mt) {
      float pl = st[mt][3];
      float fd = __shfl_up(pl, 16);
      float pprev = (quad > 0) ? fd : prevlast;
      float v = st[mt][0] + st[mt][1] + st[mt][2] + st[mt][3] + pprev;
      sImp[(w * 16 + r16) * 64 + kt * 16 + mt * 4 + quad] = v;
      prevlast = __shfl_down(pl, 48);
    }
    carry = prevlast;
  }
  {
    const long t = tb + tq;
#pragma unroll
    for (int dt = 0; dt < 4; ++dt) {
      uint2 ov; ov.x = pk2(ot[dt][0], ot[dt][1]); ov.y = pk2(ot[dt][2], ot[dt][3]);
      *(uint2*)(OC + t * 256 + w * 64 + 16 * dt + 4 * quad) = ov;
    }
  }
  __syncthreads();
  for (int q = 0; q < 4; ++q) {
    const int tok = 4 * w + q, t = t0 + tok;
    float v = sImp[(0 * 16 + tok) * 64 + lane] + sImp[(1 * 16 + tok) * 64 + lane] + sImp[(2 * 16 + tok) * 64 + lane] + sImp[(3 * 16 + tok) * 64 + lane];
    const int cur = t >> 6;
    if (lane == 0 || lane == cur) v = 1e9f;
    else if (lane * 64 > t) v = -1e30f;
    int cnt = 0;
#pragma unroll
    for (int i2 = 0; i2 < 64; ++i2) {
      float vi = __builtin_bit_cast(float, __builtin_amdgcn_readlane(__builtin_bit_cast(int, v), i2));
      cnt += (vi > v || (vi == v && i2 < lane)) ? 1 : 0;
    }
    u64 mask = __ballot(cnt < 16);
    if (lane == 0) SEL[tb + t] = mask;
  }
}

DI void sel_attn_item(const Params& P, int it, u16* sQ, u16* sKunused, u16* sVunused) {
  const int tid = TID(), lane = tid & 63, w = tid >> 6, r16 = lane & 15, quad = lane >> 4;
  const int tbk = 127 - (it >> 3), b = it & 7;
  u16* sK = sQ + 128 * 72;
  u16* sVt = sK + 64 * 72;
  (void)sKunused; (void)sVunused;
  const u16* PROJ = (const u16*)(WSP(P) + WS_PROJ);
  const u16* QR = (const u16*)(WSP(P) + WS_QR);
  const u16* OC = (const u16*)(WSP(P) + WS_OC);
  const u16* OW = (const u16*)(WSP(P) + WS_OW);
  const u64* SEL = (const u64*)(WSP(P) + WS_SEL);
  u16* OUT = (u16*)(WSP(P) + WS_OM);
  const long tb = (long)b * SEQ;
  const int t0 = tbk * 32;
#pragma unroll
  for (int i = 0; i < 4; ++i) {
    const int c = tid + 256 * i, row = c >> 3, ch = c & 7;
    *(uint4*)(sQ + row * 72 + ch * 8) = *(const uint4*)(QR + (tb + t0 + (row & 31)) * 256 + (row >> 5) * 64 + ch * 8);
  }
  __syncthreads();
  bf16x8 bq[2][2];
  int tq[2]; u64 mysel[2];
#pragma unroll
  for (int qt = 0; qt < 2; ++qt) {
    const int rowq = 32 * w + 16 * qt + r16;
    bq[qt][0] = *(const bf16x8*)(sQ + rowq * 72 + quad * 8);
    bq[qt][1] = *(const bf16x8*)(sQ + rowq * 72 + 32 + quad * 8);
    tq[qt] = t0 + 16 * qt + r16;
    mysel[qt] = SEL[tb + tq[qt]];
  }
  u64 uni = 0;
#pragma unroll
  for (int q = 0; q < 32; ++q) uni |= SEL[tb + t0 + q];
  const int cur = t0 >> 6;
  uni &= (cur == 63) ? ~0ull : ((1ull << (cur + 1)) - 1ull);
  f32x4 ot[2][4];
#pragma unroll
  for (int qt = 0; qt < 2; ++qt)
#pragma unroll
    for (int dt = 0; dt < 4; ++dt) ot[qt][dt] = (f32x4){0.f, 0.f, 0.f, 0.f};
  float m[2] = {-1e30f, -1e30f}, lsum[2] = {0.f, 0.f};
  uint4 pk0, pk1, pv0, pv1;
  int kb = uni ? (__ffsll((long long)uni) - 1) : -1;
  uni &= uni - 1;
  if (kb >= 0) kv_gload(pk0, pk1, pv0, pv1, PROJ + (tb + kb * 64) * PW + P_KV + 128, PROJ + (tb + kb * 64) * PW + P_KV + 192, PW);
  for (int nkb = -1; kb >= 0; kb = nkb) {
    __syncthreads();
    kv_store(pk0, pk1, pv0, pv1, sK, sVt);
    __syncthreads();
    nkb = uni ? (__ffsll((long long)uni) - 1) : -1;
    uni &= uni - 1;
    if (nkb >= 0) kv_gload(pk0, pk1, pv0, pv1, PROJ + (tb + nkb * 64) * PW + P_KV + 128, PROJ + (tb + nkb * 64) * PW + P_KV + 192, PW);
#pragma unroll
    for (int qt = 0; qt < 2; ++qt) {
      f32x4 st[4];
      st_mma(st, sK, bq[qt], lane);
      const bool selq = (mysel[qt] >> kb) & 1ull;
      bool msk[4][4];
#pragma unroll
      for (int mt = 0; mt < 4; ++mt)
#pragma unroll
        for (int j = 0; j < 4; ++j) { int s = kb * 64 + 16 * mt + 4 * quad + j; msk[mt][j] = selq && (s <= tq[qt]); }
      softmax_tile(st, msk, m[qt], lsum[qt], ot[qt]);
      pv_mma(ot[qt], sVt, st, lane);
    }
  }
#pragma unroll
  for (int qt = 0; qt < 2; ++qt) {
    const float ls = quad_sum(lsum[qt]);
    const float inv = 1.f / fmaxf(ls, 1e-30f);
    const long t = tb + tq[qt];
    const float gc = sigmoidf_(bf2f(PROJ[t * PW + P_NG + w * 3 + 0]));
    const float gsl = sigmoidf_(bf2f(PROJ[t * PW + P_NG + w * 3 + 1]));
    const float gw = sigmoidf_(bf2f(PROJ[t * PW + P_NG + w * 3 + 2]));
#pragma unroll
    for (int dt = 0; dt < 4; ++dt) {
      const long o = t * 256 + w * 64 + 16 * dt + 4 * quad;
      uint2 c = *(const uint2*)(OC + o), ww = *(const uint2*)(OW + o);
      float r0 = gc * bf2f((u16)(c.x & 0xffff)) + gsl * ot[qt][dt][0] * inv + gw * bf2f((u16)(ww.x & 0xffff));
      float r1 = gc * bf2f((u16)(c.x >> 16)) + gsl * ot[qt][dt][1] * inv + gw * bf2f((u16)(ww.x >> 16));
      float r2 = gc * bf2f((u16)(c.y & 0xffff)) + gsl * ot[qt][dt][2] * inv + gw * bf2f((u16)(ww.y & 0xffff));
      float r3 = gc * bf2f((u16)(c.y >> 16)) + gsl * ot[qt][dt][3] * inv + gw * bf2f((u16)(ww.y >> 16));
      uint2 ov; ov.x = pk2(r0, r1); ov.y = pk2(r2, r3);
      *(uint2*)(OUT + o) = ov;
    }
  }
}

DI void inproj_tile(const Params& P, int l, int it, u16* sA, u16* sB) {
  const int tid = TID(), lane = tid & 63, w = tid >> 6, r16 = lane & 15, quad = lane >> 4, wm = w >> 1, wn = w & 1;
  int mt, nt; tile_from_q(it, 22, mt, nt);
  const u16* H = (const u16*)(WSP(P) + WS_H);
  u16* PROJ = (u16*)(WSP(P) + WS_PROJ);
  const u16* Ab = H + (long)mt * 128 * DM;
  const u16* Bb = (const u16*)(WSP(P) + WS_W + WT_IN) + (long)nt * 128 * DM;
  f32x4 acc[4][4];
  gemm3<4>(acc, g3_ptr(Ab, DM, tid, 0, false), g3_ptr(Ab, DM, tid, 1, false), nullptr, nullptr, 64,
           g3_ptr(Bb, DM, tid, 0, false), g3_ptr(Bb, DM, tid, 1, false), nullptr, nullptr, DM, sA, 16L * DM, 16L * DM);
  __syncthreads();
#pragma unroll
  for (int mi = 0; mi < 4; ++mi)
#pragma unroll
    for (int ni = 0; ni < 4; ++ni)
#pragma unroll
      for (int j = 0; j < 4; ++j) sA[(wm * 64 + 16 * mi + 4 * quad + j) * 136 + wn * 64 + 16 * ni + r16] = f2bf(acc[mi][ni][j]);
  __syncthreads();
  store_tile_bf16<128>(sA, PROJ + (long)mt * 128 * PW + nt * 128, PW, 128);
}
DI void glu_tile(const Params& P, int l, int it, u16* sA, u16* sB) {
  const int tid = TID(), lane = tid & 63, w = tid >> 6, r16 = lane & 15, quad = lane >> 4, wm = w >> 1, wn = w & 1;
  const int mt = it >> 2, nt = it & 3;
  const u16* Y5 = (const u16*)(WSP(P) + WS_Y5);
  u16* OUT = (u16*)(WSP(P) + WS_OM) + (long)1 * T_ * 256;
  const u16* Ab = Y5 + (long)mt * 128 * 256;
  const u16* Bb = (const u16*)(WSP(P) + WS_W + WT_GLU) + (long)nt * 128 * 256;
  f32x4 acc[4][4];
  gemm3<4>(acc, g3_ptr(Ab, 256, tid, 0, false), g3_ptr(Ab, 256, tid, 1, false), nullptr, nullptr, 64,
           g3_ptr(Bb, 256, tid, 0, false), g3_ptr(Bb, 256, tid, 1, false), nullptr, nullptr, 256, sA, 16L * 256, 16L * 256);
  __syncthreads();
#pragma unroll
  for (int mi = 0; mi < 4; ++mi)
#pragma unroll
    for (int ni = 0; ni < 2; ++ni)
#pragma unroll
      for (int j = 0; j < 4; ++j)
        sA[(wm * 64 + 16 * mi + 4 * quad + j) * 72 + wn * 32 + 16 * ni + r16] = f2bf(acc[mi][ni][j] * sigmoidf_(acc[mi][ni + 2][j]));
  __syncthreads();
  store_tile_bf16<64>(sA, OUT + (long)mt * 128 * 256 + nt * 64, 256, 128);
}
DI void merge_tile(const Params& P, int l, int it, u16* sA, u16* sB) {
  const int tid = TID(), lane = tid & 63, w = tid >> 6, r16 = lane & 15, quad = lane >> 4, wm = w >> 1, wn = w & 1;
  int mt, nt; tile_from_q(it, 8, mt, nt);
  const u16* H = (const u16*)(WSP(P) + WS_H);
  const u16* OM = (const u16*)(WSP(P) + WS_OM);
  u16* MERGED = (u16*)(WSP(P) + WS_MERGED);
  uint2 outp[4][4];
#pragma unroll
  for (int mi = 0; mi < 4; ++mi)
#pragma unroll
    for (int ni = 0; ni < 4; ++ni) outp[mi][ni] = make_uint2(0u, 0u);
#pragma unroll 1
  for (int m = 0; m < 4; ++m) {
    uint2 gp[4][4];
    {
      f32x4 ag[4][4];
      const u16* Ab = H + (long)mt * 128 * DM;
      const u16* Bb = (const u16*)(WSP(P) + WS_W + WT_G) + ((long)(m * 1024 + nt * 128)) * DM;
      gemm3<4, true>(ag, g3_ptr(Ab, DM, tid, 0, false), g3_ptr(Ab, DM, tid, 1, false), nullptr, nullptr, 64,
               g3_ptr(Bb, DM, tid, 0, false), g3_ptr(Bb, DM, tid, 1, false), nullptr, nullptr, DM, sA, 16L * DM, 16L * DM);
#pragma unroll
      for (int mi = 0; mi < 4; ++mi)
#pragma unroll
        for (int ni = 0; ni < 4; ++ni) {
          gp[mi][ni].x = pk2(sigmoidf_(ag[mi][ni][0]), sigmoidf_(ag[mi][ni][1]));
          gp[mi][ni].y = pk2(sigmoidf_(ag[mi][ni][2]), sigmoidf_(ag[mi][ni][3]));
        }
    }
    {
      f32x4 av[4][4];
      const u16* Ab = OM + ((long)m * T_ + (long)mt * 128) * 256;
      const u16* Bb = (const u16*)(WSP(P) + WS_W + WT_BR) + ((long)(m * 1024 + nt * 128)) * 256;
      gemm3<4, true>(av, g3_ptr(Ab, 256, tid, 0, false), g3_ptr(Ab, 256, tid, 1, false), nullptr, nullptr, 64,
               g3_ptr(Bb, 256, tid, 0, false), g3_ptr(Bb, 256, tid, 1, false), nullptr, nullptr, 256, sA, 16L * 256, 16L * 256);
#pragma unroll
      for (int mi = 0; mi < 4; ++mi)
#pragma unroll
        for (int ni = 0; ni < 4; ++ni) {
          const float o0 = bf2f((u16)(outp[mi][ni].x & 0xffff)) + av[mi][ni][0] * bf2f((u16)(gp[mi][ni].x & 0xffff));
          const float o1 = bf2f((u16)(outp[mi][ni].x >> 16)) + av[mi][ni][1] * bf2f((u16)(gp[mi][ni].x >> 16));
          const float o2 = bf2f((u16)(outp[mi][ni].y & 0xffff)) + av[mi][ni][2] * bf2f((u16)(gp[mi][ni].y & 0xffff));
          const float o3 = bf2f((u16)(outp[mi][ni].y >> 16)) + av[mi][ni][3] * bf2f((u16)(gp[mi][ni].y >> 16));
          outp[mi][ni].x = pk2(o0, o1); outp[mi][ni].y = pk2(o2, o3);
        }
    }
  }
  __syncthreads();
#pragma unroll
  for (int mi = 0; mi < 4; ++mi)
#pragma unroll
    for (int ni = 0; ni < 4; ++ni)
#pragma unroll
      for (int j = 0; j < 4; ++j) {
        const unsigned wv = (j < 2) ? outp[mi][ni].x : outp[mi][ni].y;
        sA[(wm * 64 + 16 * mi + 4 * quad + j) * 136 + wn * 64 + 16 * ni + r16] = (u16)((j & 1) ? (wv >> 16) : (wv & 0xffff));
      }
  __syncthreads();
  store_tile_bf16<128>(sA, MERGED + (long)mt * 128 * DM + nt * 128, DM, 128);
}
DI void resid_tile(const u16* A, int K, const u16* Bt, const float* resid, float* out, int it, u16* sA, u16* sB) {
  const int tid = TID(), lane = tid & 63, w = tid >> 6, r16 = lane & 15, quad = lane >> 4, wm = w >> 1, wn = w & 1;
  int mt, nt; tile_from_q(it, 8, mt, nt);
  const u16* Ab = A + (long)mt * 128 * K;
  const u16* Bb = Bt + (long)nt * 128 * K;
  f32x4 acc[4][4];
  gemm3<4>(acc, g3_ptr(Ab, K, tid, 0, false), g3_ptr(Ab, K, tid, 1, false), nullptr, nullptr, 64,
           g3_ptr(Bb, K, tid, 0, false), g3_ptr(Bb, K, tid, 1, false), nullptr, nullptr, K, sA, 16L * K, 16L * K);
  float* sC = (float*)sA + w * (32 * 68);
#pragma unroll
  for (int hp = 0; hp < 2; ++hp) {
    __syncthreads();
#pragma unroll
    for (int mi2 = 0; mi2 < 2; ++mi2)
#pragma unroll
      for (int ni = 0; ni < 4; ++ni)
#pragma unroll
        for (int j = 0; j < 4; ++j) sC[(16 * mi2 + 4 * quad + j) * 68 + 16 * ni + r16] = acc[2 * hp + mi2][ni][j];
    __syncthreads();
#pragma unroll
    for (int q = 0; q < 8; ++q) {
      const int c = lane + 64 * q, row = c >> 4, c4 = (c & 15) * 4;
      const long o = ((long)mt * 128 + wm * 64 + 32 * hp + row) * DM + nt * 128 + wn * 64 + c4;
      const float4 rv = *(const float4*)(resid + o);
      const f32x4 cv = *(const f32x4*)(sC + row * 68 + c4);
      *(float4*)(out + o) = make_float4(rv.x + cv[0], rv.y + cv[1], rv.z + cv[2], rv.w + cv[3]);
    }
  }
}
DI void ffn1_tile(const Params& P, int l, int it, u16* sA, u16* sB) {
  const int tid = TID(), lane = tid & 63, w = tid >> 6, r16 = lane & 15, quad = lane >> 4, wm = w >> 1, wn = w & 1;
  int mt, nt; tile_from_q(it, 44, mt, nt);
  const u16* H = (const u16*)(WSP(P) + WS_H);
  u16* ACT = (u16*)(WSP(P) + WS_PROJ);
  const u16* Ab = H + (long)mt * 128 * DM;
  const u16* Bb = (const u16*)(WSP(P) + WS_W + WT_GU) + (long)nt * 128 * DM;
  f32x4 acc[4][4];
  gemm3<4>(acc, g3_ptr(Ab, DM, tid, 0, false), g3_ptr(Ab, DM, tid, 1, false), nullptr, nullptr, 64,
           g3_ptr(Bb, DM, tid, 0, false), g3_ptr(Bb, DM, tid, 1, false), nullptr, nullptr, DM, sA, 16L * DM, 16L * DM);
  __syncthreads();
#pragma unroll
  for (int mi = 0; mi < 4; ++mi)
#pragma unroll
    for (int ni = 0; ni < 2; ++ni)
#pragma unroll
      for (int j = 0; j < 4; ++j)
        sA[(wm * 64 + 16 * mi + 4 * quad + j) * 72 + wn * 32 + 16 * ni + r16] = f2bf(siluf_(acc[mi][ni][j]) * acc[mi][ni + 2][j]);
  __syncthreads();
  store_tile_bf16<64>(sA, ACT + (long)mt * 128 * DFF + nt * 64, DFF, 128);
}

__global__ void __launch_bounds__(256, LB2) fwd_megakernel(Params P) {
  cg::grid_group grid = cg::this_grid();
  __shared__ __attribute__((aligned(16))) float lds[17920];
  __shared__ int s_item;
  unsigned* cnt = (unsigned*)(WSP(P) + WS_CNT);
  const int xcd = (int)(__builtin_amdgcn_s_getreg((3 << 11) | 20) & 0xF) & 7;
  __shared__ int s_rank;
  if (threadIdx.x == 0) s_rank = (int)atomicAdd(cnt + 900 + xcd, 1u);
  __syncthreads();
  const int xrank = s_rank;
  u16* sA = (u16*)lds;
  u16* sB = sA + 128 * 80;
  u16* aQ = (u16*)lds;
  u16* aK = aQ + 64 * 72;
  u16* aV = aK + 64 * 72;
  float* aImp = (float*)(aV + 64 * 72);
  for (int ph = P.ph_lo; ph < P.ph_hi; ++ph) {
    const int l = ph / 11, sp = ph % 11;
    const float* xin = (l == 0) ? P.in[0] : P.out;
    const int nrep = (PROBE_DUP != 0 && l == 0 && ((PROBE_DUP >> sp) & 1)) ? 2 : 1;
    for (int rep = 0; rep < nrep; ++rep) {
    unsigned* pc = cnt + (ph + 32 * rep) * 8;
    switch (sp) {
      case 0: if (PHASE_MASK & (1 << 0)) {
        phase_rmsnorm(xin, P.in[2] + l * DM, (u16*)(WSP(P) + WS_H));
        phase_convert(P, l, lds);
        if (l == 0) phase_rope_table((const int*)P.in[1], (float*)(WSP(P) + WS_COS), (float*)(WSP(P) + WS_SIN));
      } break;
      case 1: if (PHASE_MASK & (1 << 1)) {
        XCD_STATIC_LOOP(32 * 22, inproj_tile(P, l, it, sA, sB))
      } break;
      case 2: if (PHASE_MASK & (1 << 2)) {
        for (;;) {
          int it = next_item(pc, &s_item); if (it >= 64 + 3 * 2048) break;
          if (it < 64) cmp1_tile(P, l, it, sA, sB);
          else if (it < 64 + 2048) gdn_p1_item(P, l, it - 64, lds);
          else if (it < 64 + 4096) s5_pass1_item(P, l, it - 64 - 2048, lds);
          else nsa_prep_item(P, l, it - 64 - 4096);
        }
      } break;
      case 3: if (PHASE_MASK & (1 << 3)) {
        for (;;) {
          int it = next_item(pc, &s_item); if (it >= 128 + 3072 + 64) break;
          if (it < 128) gdn_p2_item(P, it, lds);
          else if (it < 128 + 2048) sb_attn_item(P, it - 128, aQ, aK, aV);
          else if (it < 128 + 3072) win_attn_item(P, it - 128 - 2048, aQ, aK, aV);
          else if (it < 128 + 3072 + 32) s5_carry_item(P, l, it - 128 - 3072);
          else cmp2_tile(P, l, it - 128 - 3072 - 32, sA, sB, lds + 17000);
        }
      } break;
      case 4: if (PHASE_MASK & (1 << 4)) {
        for (;;) {
          int it = next_item(pc, &s_item); if (it >= 3 * 2048) break;
          if (it < 2048) cmp_attn_item(P, it, aQ, aK, aV, aImp);
          else if (it < 4096) s5_pass2_item(P, l, it - 2048, lds);
          else gdn_post_item(P, l, it - 4096);
        }
      } break;
      case 5: if (PHASE_MASK & (1 << 5)) {
        for (;;) {
          int it = next_item(pc, &s_item); if (it >= 1024 + 1024) break;
          if (it < 1024) sel_attn_item(P, it, aQ, aK, aV);
          else glu_tile(P, l, it - 1024, sA, sB);
        }
      } break;
      case 6: if (PHASE_MASK & (1 << 6)) {
        XCD_STATIC_LOOP(32 * 8, merge_tile(P, l, it, sA, sB))
      } break;
      case 7: if (PHASE_MASK & (1 << 7)) {
        XCD_STATIC_LOOP(32 * 8, resid_tile((const u16*)(WSP(P) + WS_MERGED), DM, (const u16*)(WSP(P) + WS_W + WT_OUT), xin, P.out, it, sA, sB))
      } break;
      case 8: if (PHASE_MASK & (1 << 8)) {
        phase_rmsnorm(P.out, P.in[26] + l * DM, (u16*)(WSP(P) + WS_H));
      } break;
      case 9: if (PHASE_MASK & (1 << 9)) {
        XCD_STATIC_LOOP(32 * 44, ffn1_tile(P, l, it, sA, sB))
      } break;
      case 10: if (PHASE_MASK & (1 << 10)) {
        XCD_STATIC_LOOP(32 * 8, resid_tile((const u16*)(WSP(P) + WS_PROJ), DFF, (const u16*)(WSP(P) + WS_W + WT_D), P.out, P.out, it, sA, sB))
      } break;
    }
    if (rep + 1 < nrep) grid.sync();
    }
    if (ph + 1 < P.ph_hi) grid.sync();
  }
}

extern "C" void kernel_launch(void* const* d_in, const int* in_sizes, int n_in, void* d_out, int out_size, void* d_ws, size_t ws_size,
                              hipStream_t stream) {
  static int grid_blocks = 0;
  if (!grid_blocks) {
    int dev = 0, cus = 0, per_cu = 0;
    hipGetDevice(&dev);
    hipDeviceGetAttribute(&cus, hipDeviceAttributeMultiprocessorCount, dev);
    hipOccupancyMaxActiveBlocksPerMultiprocessor(&per_cu, fwd_megakernel, 256, 0);
    if (per_cu < 1) per_cu = 1;
    if (per_cu > 2) per_cu = 2;
    grid_blocks = cus * per_cu;
    if (ws_size < WS_W + WT_END) fprintf(stderr, "kernel_launch: workspace too small: %zu\n", ws_size);
  }
  hipMemsetAsync((char*)d_ws + WS_CNT, 0, 4096, stream);
  Params p{};
  for (int i = 0; i < 30; ++i) p.in[i] = (const float*)d_in[i];
  p.out = (float*)d_out;
  p.ws = (unsigned char*)d_ws;
  p.ph_lo = 0; p.ph_hi = NPHASE;
  void* args[] = {&p};
  hipError_t e = hipLaunchCooperativeKernel((void*)fwd_megakernel, dim3(grid_blocks), dim3(256), args, 0, stream);
  if (e != hipSuccess) fprintf(stderr, "cooperative launch failed: %s (grid %d)\n", hipGetErrorString(e), grid_blocks);
}
```

```cpp
#include <hip/hip_runtime.h>
#include <hip/hip_cooperative_groups.h>
#include <cstdio>
namespace cg = cooperative_groups;

typedef unsigned short u16;
typedef unsigned long long u64;
typedef __attribute__((ext_vector_type(8))) short bf16x8;
typedef __attribute__((ext_vector_type(4))) short s16x4;
typedef __attribute__((ext_vector_type(4))) float f32x4;
#define DI __device__ __forceinline__

constexpr int NB = 8, SEQ = 4096, T_ = NB * SEQ, DM = 1024, DIN = 6804, PW = 2816, DFF = 2816;
constexpr int P_Q = 0, P_KV = 256, P_S5U = 640, P_GQKV = 896, P_GZ = 1664, P_SB = 1920, P_NG = 2688, P_GA = 2700, P_GB = 2704;
constexpr float EPS = 1e-6f;
constexpr size_t MiB = 1024ull * 1024ull;
constexpr size_t WS_H = 0, WS_PROJ = 64 * MiB, WS_OM = 240 * MiB, WS_MERGED = 304 * MiB,
                 WS_GQ = 304 * MiB, WS_GK = 320 * MiB, WS_GU = 336 * MiB, WS_GW = 352 * MiB, WS_GA = 368 * MiB,
                 WS_QR = 384 * MiB, WS_OC = 400 * MiB, WS_OW = 416 * MiB, WS_Y5 = 432 * MiB,
                 WS_GG = 448 * MiB, WS_SEL = 449 * MiB, WS_COS = 450 * MiB, WS_SIN = 451 * MiB,
                 WS_ENDS = 452 * MiB, WS_CARRY = 456 * MiB, WS_KC = 460 * MiB, WS_VC = 461 * MiB, WS_HID = 462 * MiB,
                 WS_CNT = 464 * MiB, WS_W = 465 * MiB, WS_CBIAS = 449 * MiB + 512 * 1024;
constexpr size_t WT_IN = 0, WT_G = WT_IN + 2816ull * 1024 * 2, WT_BR = WT_G + 4096ull * 1024 * 2, WT_OUT = WT_BR + 4096ull * 256 * 2,
                 WT_GU = WT_OUT + 1024ull * 1024 * 2, WT_D = WT_GU + 5632ull * 1024 * 2, WT_GLU = WT_D + 1024ull * 2816 * 2,
                 WT_C1 = WT_GLU + 512ull * 256 * 2, WT_C2 = WT_C1 + 512ull * 2048 * 2, WT_END = WT_C2 + 128ull * 256 * 2;
constexpr int NPHASE = 22;
#define XCD_STATIC_LOOP(NPER, BODY) { \
    unsigned c0_ = cnt[900], c1_ = cnt[901], c2_ = cnt[902], c3_ = cnt[903], c4_ = cnt[904], c5_ = cnt[905], c6_ = cnt[906], c7_ = cnt[907]; \
    const bool ok_ = c0_ && c1_ && c2_ && c3_ && c4_ && c5_ && c6_ && c7_; \
    const unsigned mine_ = xcd == 0 ? c0_ : xcd == 1 ? c1_ : xcd == 2 ? c2_ : xcd == 3 ? c3_ : xcd == 4 ? c4_ : xcd == 5 ? c5_ : xcd == 6 ? c6_ : c7_; \
    const int start_ = ok_ ? xcd * (NPER) + xrank : (int)blockIdx.x, end_ = ok_ ? (xcd + 1) * (NPER) : 8 * (NPER), step_ = ok_ ? (int)mine_ : (int)gridDim.x; \
    for (int it = start_; it < end_; it += step_) { BODY; } }
#ifndef PROBE_DUP
#define PROBE_DUP 0
#endif
#ifndef LB2
#define LB2 2
#endif
#ifndef PHASE_MASK
#define PHASE_MASK 0x7ff
#endif

struct Params {
  const float* in[30];
  float* out;
  unsigned char* ws;
  int ph_lo, ph_hi;
};


DI int TID() { int t = threadIdx.x; asm volatile("" : "+v"(t)); return t; }
DI unsigned char* WSP(const Params& P) { size_t z = 0; asm volatile("" : "+s"(z)); return P.ws + z; }
typedef __bf16 bf16x2_t __attribute__((ext_vector_type(2)));
typedef float f32x2_t __attribute__((ext_vector_type(2)));
DI u16 f2bf(float x) { __bf16 r = (__bf16)x; return __builtin_bit_cast(u16, r); }
DI float bf2f(u16 h) { return __uint_as_float(((unsigned)h) << 16); }
DI unsigned pk2(float a, float b) { f32x2_t v = {a, b}; bf16x2_t r = __builtin_convertvector(v, bf16x2_t); return __builtin_bit_cast(unsigned, r); }
DI float wave_sum(float v) {
#pragma unroll
  for (int o = 1; o < 64; o <<= 1) v += __shfl_xor(v, o);
  return v;
}
DI float sigmoidf_(float x) { return 1.f / (1.f + __expf(-x)); }
DI float siluf_(float x) { return x * sigmoidf_(x); }
DI float softplusf_(float x) { return fmaxf(x, 0.f) + log1pf(__expf(-fabsf(x))); }
DI float gelu_tanh(float x) {
  float u = 0.7978845608028654f * (x + 0.044715f * x * x * x);
  float t = 1.f - 2.f / (__expf(2.f * u) + 1.f);
  return 0.5f * x * (1.f + t);
}
DI void sincos_d(double x, double& s, double& c) {
  const double TWO_PI = 6.283185307179586476925287, INV = 0.15915494309189533576888;
  double n = rint(x * INV);
  double r = x - n * TWO_PI;
  double r2 = r * r, term = 1.0, cs = 1.0, ss = 1.0;
#pragma unroll
  for (int k = 1; k <= 14; ++k) { term *= r2 * (-1.0 / (double)((2 * k - 1) * (2 * k))); cs += term; }
  term = 1.0;
#pragma unroll
  for (int k = 1; k <= 14; ++k) { term *= r2 * (-1.0 / (double)((2 * k) * (2 * k + 1))); ss += term; }
  s = r * ss; c = cs;
}
DI int next_item(unsigned* cnt, int* s_item) {
  __syncthreads();
  if (TID() == 0) *s_item = (int)atomicAdd(cnt, 1u);
  __syncthreads();
  return *s_item;
}
DI int next_tile_xcd(unsigned* cnt8, int n_per_xcd, int xcd, int* s_item) {
  asm volatile("" : "+s"(xcd));
  __syncthreads();
  if (threadIdx.x == 0) {
    int res = -1;
    for (int a = 0; a < 8; ++a) {
      int qq = (xcd + a) & 7;
      unsigned v = atomicAdd(cnt8 + qq, 1u);
      if (v < (unsigned)n_per_xcd) { res = qq * n_per_xcd + (int)v; break; }
    }
    *s_item = res;
  }
  __syncthreads();
  return *s_item;
}
DI void tile_from_q(int it, int numN, int& mt, int& nt) {
  const int per = 32 * numN, q = it / per, i = it % per, g = i / (8 * numN), rem = i % (8 * numN);
  nt = rem >> 3; mt = 32 * q + 8 * g + (rem & 7);
}
DI int proj_src_col(int pc) {
  if (pc < 640) return pc;
  if (pc < 1664) return pc + 12;
  if (pc < 2688) return pc + 20;
  if (pc < 2700) return pc - 2688 + 640;
  if (pc < 2708) return pc - 2700 + 1676;
  return pc;
}

DI uint4 addpos8(uint4 v, const float* pp) {
  uint4 o;
  o.x = pk2(bf2f((u16)(v.x & 0xffff)) + pp[0], bf2f((u16)(v.x >> 16)) + pp[1]);
  o.y = pk2(bf2f((u16)(v.y & 0xffff)) + pp[2], bf2f((u16)(v.y >> 16)) + pp[3]);
  o.z = pk2(bf2f((u16)(v.z & 0xffff)) + pp[4], bf2f((u16)(v.z >> 16)) + pp[5]);
  o.w = pk2(bf2f((u16)(v.w & 0xffff)) + pp[6], bf2f((u16)(v.w >> 16)) + pp[7]);
  return o;
}
template <int NTW>
DI void gemm2(f32x4 (&acc)[4][NTW], const u16* __restrict__ arow, long a_kstep, const float* __restrict__ apos,
              const u16* __restrict__ brow, int K, u16* sA, u16* sB) {
  constexpr int BN = 32 * NTW, BV = BN / 32, LS = 80;
  const int tid = TID(), lane = tid & 63, w = tid >> 6, r16 = lane & 15, quad = lane >> 4;
  const int wm = w >> 1, wn = w & 1;
  u16* sa_st = sA + (tid >> 1) * LS + (tid & 1) * 32;
  u16* sb_st = (BN == 128) ? (sB + (tid >> 1) * LS + (tid & 1) * 32) : (sB + (tid >> 2) * LS + (tid & 3) * 16);
  uint4 pa0, pa1, pa2, pa3, pb0, pb1, pb2, pb3;
  uint4 qa0, qa1, qa2, qa3, qb0, qb1, qb2, qb3;
  pb2 = make_uint4(0, 0, 0, 0); pb3 = pb2; qb2 = pb2; qb3 = pb2;
#define G2_LOAD(KT, a0, a1, a2, a3, b0, b1, b2, b3) { const uint4* pa_ = (const uint4*)(arow + (long)(KT) * a_kstep); \
    a0 = pa_[0]; a1 = pa_[1]; a2 = pa_[2]; a3 = pa_[3]; \
    if (apos) { const float* pp_ = apos + (KT) * 64 + (tid & 1) * 32; \
      a0 = addpos8(a0, pp_); a1 = addpos8(a1, pp_ + 8); a2 = addpos8(a2, pp_ + 16); a3 = addpos8(a3, pp_ + 24); } \
    const uint4* pb_ = (const uint4*)(brow + (long)(KT) * 64); \
    b0 = pb_[0]; b1 = pb_[1]; if (BV == 4) { b2 = pb_[2]; b3 = pb_[3]; } }
#define G2_STORE(a0, a1, a2, a3, b0, b1, b2, b3) { \
    ((uint4*)sa_st)[0] = a0; ((uint4*)sa_st)[1] = a1; ((uint4*)sa_st)[2] = a2; ((uint4*)sa_st)[3] = a3; \
    ((uint4*)sb_st)[0] = b0; ((uint4*)sb_st)[1] = b1; if (BV == 4) { ((uint4*)sb_st)[2] = b2; ((uint4*)sb_st)[3] = b3; } }
#define G2_COMPUTE() { _Pragma("unroll") for (int ks = 0; ks < 2; ++ks) { \
      bf16x8 af[4], bg[NTW]; \
      _Pragma("unroll") for (int mi = 0; mi < 4; ++mi) af[mi] = *(const bf16x8*)(sA + (wm * 64 + 16 * mi + r16) * LS + ks * 32 + quad * 8); \
      _Pragma("unroll") for (int ni = 0; ni < NTW; ++ni) bg[ni] = *(const bf16x8*)(sB + (wn * (BN / 2) + 16 * ni + r16) * LS + ks * 32 + quad * 8); \
      _Pragma("unroll") for (int mi = 0; mi < 4; ++mi) \
        _Pragma("unroll") for (int ni = 0; ni < NTW; ++ni) acc[mi][ni] = __builtin_amdgcn_mfma_f32_16x16x32_bf16(af[mi], bg[ni], acc[mi][ni], 0, 0, 0); } }
#pragma unroll
  for (int mi = 0; mi < 4; ++mi)
#pragma unroll
    for (int ni = 0; ni < NTW; ++ni) acc[mi][ni] = (f32x4){0.f, 0.f, 0.f, 0.f};
  const int nk = K >> 6;
  G2_LOAD(0, pa0, pa1, pa2, pa3, pb0, pb1, pb2, pb3)
  G2_LOAD(1, qa0, qa1, qa2, qa3, qb0, qb1, qb2, qb3)
#pragma unroll 1
  for (int kt = 0; kt < nk; kt += 2) {
    __syncthreads();
    G2_STORE(pa0, pa1, pa2, pa3, pb0, pb1, pb2, pb3)
    __syncthreads();
    if (kt + 2 < nk) G2_LOAD(kt + 2, pa0, pa1, pa2, pa3, pb0, pb1, pb2, pb3)
    G2_COMPUTE()
    __syncthreads();
    G2_STORE(qa0, qa1, qa2, qa3, qb0, qb1, qb2, qb3)
    __syncthreads();
    if (kt + 3 < nk) G2_LOAD(kt + 3, qa0, qa1, qa2, qa3, qb0, qb1, qb2, qb3)
    G2_COMPUTE()
  }
#undef G2_LOAD
#undef G2_STORE
#undef G2_COMPUTE
}
DI void g3_rowpiece(int tid, int q, bool n64, int& row, int& pc) {
  const int w = tid >> 6, lane = tid & 63, chunk = n64 ? (2 * w + q) : (4 * w + q);
  row = 8 * chunk + (lane >> 3);
  pc = (lane & 7) ^ ((row >> 1) & 7);
}
DI const u16* g3_ptr(const u16* base, long ld, int tid, int q, bool n64) {
  int row, pc; g3_rowpiece(tid, q, n64, row, pc);
  return base + (long)row * ld + pc * 8;
}
template <int NTW, bool LEAN = false>
DI void gemm3(f32x4 (&acc)[4][NTW], const u16* ap0, const u16* ap1, const u16* ap2, const u16* ap3, long a_kstep,
              const u16* bp0, const u16* bp1, const u16* bp2, const u16* bp3, int K, u16* sbase, long a16 = 0, long b16 = 0) {
  constexpr int BN = 32 * NTW, STAGE = 16384;
  const int tid = TID(), lane = tid & 63, w = tid >> 6, r16 = lane & 15, quad = lane >> 4;
  const int wm = w >> 1, wn = w & 1;
  const int sz = (r16 >> 1) & 7;
  const int wu = __builtin_amdgcn_readfirstlane(w);
#define G3_GLDS(GP, LOFF) asm volatile("s_mov_b32 m0, %1\n\ts_nop 0\n\tglobal_load_lds_dwordx4 %0, off" :: "v"(GP), "s"(LOFF) : "memory", "m0")
  const unsigned lds0 = (unsigned)(size_t)sbase;
#define G3_ISSUE(KT) { const unsigned st_ = lds0 + (((KT) & 1) ? STAGE * 2 : 0); const long ka_ = (long)(KT) * a_kstep, kb_ = (long)(KT) * 64; \
    if (BN == 128) { \
      const unsigned la_ = __builtin_amdgcn_readfirstlane(st_ + wu * 4096u); \
      G3_GLDS(ap0 + ka_, la_); G3_GLDS(ap1 + ka_, la_ + 1024u); \
      if (a16) { G3_GLDS(ap0 + (ka_ + a16), la_ + 2048u); G3_GLDS(ap1 + (ka_ + a16), la_ + 3072u); } else { G3_GLDS(ap2 + ka_, la_ + 2048u); G3_GLDS(ap3 + ka_, la_ + 3072u); } \
      G3_GLDS(bp0 + kb_, la_ + 16384u); G3_GLDS(bp1 + kb_, la_ + 17408u); \
      if (b16) { G3_GLDS(bp0 + (kb_ + b16), la_ + 18432u); G3_GLDS(bp1 + (kb_ + b16), la_ + 19456u); } else { G3_GLDS(bp2 + kb_, la_ + 18432u); G3_GLDS(bp3 + kb_, la_ + 19456u); } \
    } else { \
      const unsigned la_ = __builtin_amdgcn_readfirstlane(st_ + wu * 4096u); \
      const unsigned lb_ = __builtin_amdgcn_readfirstlane(st_ + 16384u + wu * 2048u); \
      G3_GLDS(ap0 + ka_, la_); G3_GLDS(ap1 + ka_, la_ + 1024u); G3_GLDS(ap2 + ka_, la_ + 2048u); G3_GLDS(ap3 + ka_, la_ + 3072u); \
      G3_GLDS(bp0 + kb_, lb_); G3_GLDS(bp1 + kb_, lb_ + 1024u); \
    } }
#pragma unroll
  for (int mi = 0; mi < 4; ++mi)
#pragma unroll
    for (int ni = 0; ni < NTW; ++ni) acc[mi][ni] = (f32x4){0.f, 0.f, 0.f, 0.f};
  const int nk = K >> 6;
  __syncthreads();
  G3_ISSUE(0)
  if (!LEAN && BN == 128) {
#define G3_PIECE(I, KT) { const unsigned st_ = lds0 + (((KT) & 1) ? STAGE * 2 : 0); const long ka_ = (long)(KT) * a_kstep, kb_ = (long)(KT) * 64; \
      const unsigned la_ = __builtin_amdgcn_readfirstlane(st_ + wu * 4096u); \
      if ((I) == 0) G3_GLDS(ap0 + ka_, la_); else if ((I) == 1) G3_GLDS(ap1 + ka_, la_ + 1024u); \
      else if ((I) == 2) G3_GLDS((a16 ? ap0 + a16 : ap2) + ka_, la_ + 2048u); else if ((I) == 3) G3_GLDS((a16 ? ap1 + a16 : ap3) + ka_, la_ + 3072u); \
      else if ((I) == 4) G3_GLDS(bp0 + kb_, la_ + 16384u); else if ((I) == 5) G3_GLDS(bp1 + kb_, la_ + 17408u); \
      else if ((I) == 6) G3_GLDS((b16 ? bp0 + b16 : bp2) + kb_, la_ + 18432u); else G3_GLDS((b16 ? bp1 + b16 : bp3) + kb_, la_ + 19456u); }
#define G3_STEP(KT, DOISSUE) { const u16* sAs = sbase + ((KT) & 1) * STAGE; const u16* sBs = sAs + 8192; \
      bf16x8 af[2][4], bg[2][NTW];     \
      _Pragma("unroll") for (int ks = 0; ks < 2; ++ks) { \
        const int pcol = ((ks * 4 + quad) ^ sz) * 8; \
        _Pragma("unroll") for (int mi = 0; mi < 4; ++mi) af[ks][mi] = *(const bf16x8*)(sAs + (wm * 64 + 16 * mi + r16) * 64 + pcol); \
        _Pragma("unroll") for (int ni = 0; ni < NTW; ++ni) bg[ks][ni] = *(const bf16x8*)(sBs + (wn * (BN / 2) + 16 * ni + r16) * 64 + pcol); } \
      __builtin_amdgcn_s_setprio(1);     \
      _Pragma("unroll") for (int mi = 0; mi < 4; ++mi) {   \
        acc[mi][0] = __builtin_amdgcn_mfma_f32_16x16x32_bf16(af[0][mi], bg[0][0], acc[mi][0], 0, 0, 0); \
        acc[mi][1] = __builtin_amdgcn_mfma_f32_16x16x32_bf16(af[0][mi], bg[0][1], acc[mi][1], 0, 0, 0); \
        if (DOISSUE) G3_PIECE(2 * mi, (KT) + 1) \
        __builtin_amdgcn_sched_barrier(0); \
        acc[mi][2] = __builtin_amdgcn_mfma_f32_16x16x32_bf16(af[0][mi], bg[0][2], acc[mi][2], 0, 0, 0); \
        acc[mi][3] = __builtin_amdgcn_mfma_f32_16x16x32_bf16(af[0][mi], bg[0][3], acc[mi][3], 0, 0, 0); \
        if (DOISSUE) G3_PIECE(2 * mi + 1, (KT) + 1) \
        __builtin_amdgcn_sched_barrier(0); } \
      _Pragma("unroll") for (int mi = 0; mi < 4; ++mi) \
        _Pragma("unroll") for (int ni = 0; ni < NTW; ++ni) acc[mi][ni] = __builtin_amdgcn_mfma_f32_16x16x32_bf16(af[1][mi], bg[1][ni], acc[mi][ni], 0, 0, 0); \
      __builtin_amdgcn_s_setprio(0); }
#pragma unroll 1
    for (int kt = 0; kt < nk - 1; ++kt) {
      asm volatile("s_waitcnt vmcnt(0) lgkmcnt(0)" ::: "memory");
      __builtin_amdgcn_s_barrier();
      asm volatile("" ::: "memory");
      G3_STEP(kt, true)
    }
    asm volatile("s_waitcnt vmcnt(0) lgkmcnt(0)" ::: "memory");
    __builtin_amdgcn_s_barrier();
    asm volatile("" ::: "memory");
    G3_STEP(nk - 1, false)
#undef G3_PIECE
#undef G3_STEP
  } else
#pragma unroll 1
  for (int kt = 0; kt < nk; ++kt) {
    asm volatile("s_waitcnt vmcnt(0) lgkmcnt(0)" ::: "memory");
    __builtin_amdgcn_s_barrier();
    asm volatile("" ::: "memory");
    if (kt + 1 < nk) G3_ISSUE(kt + 1)
    const u16* sAs = sbase + (kt & 1) * STAGE;
    const u16* sBs = sAs + 8192;
#pragma unroll 1
    for (int ks = 0; ks < (LEAN ? 2 : 0); ++ks) {
      const int pcol = ((ks * 4 + quad) ^ sz) * 8;
      bf16x8 af[4];
#pragma unroll
      for (int mi = 0; mi < 4; ++mi) af[mi] = *(const bf16x8*)(sAs + (wm * 64 + 16 * mi + r16) * 64 + pcol);
#pragma unroll
      for (int ni = 0; ni < NTW; ++ni) {
        bf16x8 b1 = *(const bf16x8*)(sBs + (wn * (BN / 2) + 16 * ni + r16) * 64 + pcol);
#pragma unroll
        for (int mi = 0; mi < 4; ++mi) acc[mi][ni] = __builtin_amdgcn_mfma_f32_16x16x32_bf16(af[mi], b1, acc[mi][ni], 0, 0, 0);
      }
    }
#pragma unroll
    for (int ks = 0; ks < (LEAN ? 0 : 2); ++ks) {
      const int pcol = ((ks * 4 + quad) ^ sz) * 8;
      bf16x8 af[4], bg[NTW];
#pragma unroll
      for (int mi = 0; mi < 4; ++mi) af[mi] = *(const bf16x8*)(sAs + (wm * 64 + 16 * mi + r16) * 64 + pcol);
#pragma unroll
      for (int ni = 0; ni < NTW; ++ni) bg[ni] = *(const bf16x8*)(sBs + (wn * (BN / 2) + 16 * ni + r16) * 64 + pcol);
#pragma unroll
      for (int mi = 0; mi < 4; ++mi)
#pragma unroll
        for (int ni = 0; ni < NTW; ++ni) acc[mi][ni] = __builtin_amdgcn_mfma_f32_16x16x32_bf16(af[mi], bg[ni], acc[mi][ni], 0, 0, 0);
    }
  }
#undef G3_ISSUE
#undef G3_GLDS
}
template <int NCOLS>
DI void store_tile_bf16(const u16* sC, u16* gdst, long ld, int rows_valid) {
  constexpr int CPR = NCOLS / 8, LS = NCOLS + 8;
  const int tid = TID();
#pragma unroll
  for (int q = 0; q < (128 * CPR) / 256; ++q) {
    const int c = tid + 256 * q, row = c / CPR, ch = c % CPR;
    if (row < rows_valid) *(uint4*)(gdst + (long)row * ld + ch * 8) = *(const uint4*)(sC + row * LS + ch * 8);
  }
}
DI int pair_col(int np, int& which) {
  const int nt = np >> 7, c = np & 127, wn = c >> 6, ni = (c >> 4) & 3, r = c & 15;
  which = ni >> 1;
  return nt * 64 + wn * 32 + (ni & 1) * 16 + r;
}
DI const float* conv_colptr(const Params& P, int l, int mat, int np, long& ld) {
  int which;
  switch (mat) {
    case 0: ld = DIN; return P.in[3] + (long)l * DM * DIN + proj_src_col(np);
    case 1: ld = DIN; return P.in[3] + (long)l * DM * DIN + 2708 + np;
    case 2: ld = DM; return P.in[24] + ((long)(l * 4 + (np >> 10)) * 256) * DM + (np & 1023);
    case 3: ld = DM; return P.in[25] + (long)l * DM * DM + np;
    case 4: { int o = pair_col(np, which); ld = DFF; return (which ? P.in[28] : P.in[27]) + (long)l * DM * DFF + o; }
    case 5: ld = DM; return P.in[29] + (long)l * DFF * DM + np;
    case 6: { int o = pair_col(np, which); ld = 512; return P.in[19] + (long)l * 256 * 512 + which * 256 + o; }
    case 7: ld = 256; return P.in[(np >> 8) ? 9 : 7] + (long)l * 2048 * 256 + (np & 255);
    default: ld = 64; return P.in[(np >> 6) ? 10 : 8] + (long)l * 256 * 64 + (np & 63);
  }
}
DI void phase_convert(const Params& P, int l, float* lds) {
  const int tid = TID();
  if (blockIdx.x < 64) {
    const int kv = blockIdx.x >> 5, ks = blockIdx.x & 31;
    const float* pos = P.in[6] + (long)(l * 2 + kv) * 2048 + ks * 64;
    const float* w1 = P.in[kv ? 9 : 7] + (long)l * 2048 * 256 + (long)ks * 64 * 256 + tid;
    float a = 0.f;
#pragma unroll 8
    for (int k = 0; k < 64; ++k) a += pos[k] * w1[(long)k * 256];
    ((float*)(WSP(P) + WS_CBIAS))[(kv * 32 + ks) * 256 + tid] = a;
  }
  const int NB_[9] = {44, 64, 64, 16, 88, 16, 8, 8, 2};
  const int KB_[9] = {16, 16, 4, 16, 16, 44, 4, 32, 4};
  const size_t OFF_[9] = {WT_IN, WT_G, WT_BR, WT_OUT, WT_GU, WT_D, WT_GLU, WT_C1, WT_C2};
  for (int it = blockIdx.x; it < 4648; it += gridDim.x) {
    int r = it, mat = 0, nbk = 0, kbk = 0; size_t off = 0;
#pragma unroll
    for (int q = 0; q < 9; ++q) { int n = NB_[q] * KB_[q]; if (r >= 0 && r < n) { mat = q; nbk = NB_[q]; kbk = KB_[q]; off = OFF_[q]; r -= 100000; } else if (r >= 0) r -= n; }
    r += 100000;
    const int nb = r / kbk, kb = r % kbk, K = kbk * 64;
    (void)nbk;
    __syncthreads();
    {
      const int n = tid & 63;
      long ld; const float* cp = conv_colptr(P, l, mat, nb * 64 + n, ld);
#pragma unroll 4
      for (int q = 0; q < 16; ++q) { int k = (tid >> 6) + 4 * q; lds[n * 65 + k] = cp[(long)(kb * 64 + k) * ld]; }
    }
    __syncthreads();
    u16* dst = (u16*)(WSP(P) + WS_W + off);
#pragma unroll
    for (int q = 0; q < 2; ++q) {
      int c = tid + 256 * q, n = c >> 3, k8 = (c & 7) * 8;
      const float* sp = lds + n * 65 + k8;
      uint4 v; v.x = pk2(sp[0], sp[1]); v.y = pk2(sp[2], sp[3]); v.z = pk2(sp[4], sp[5]); v.w = pk2(sp[6], sp[7]);
      *(uint4*)(dst + (long)(nb * 64 + n) * K + kb * 64 + k8) = v;
    }
  }
}

DI void st_mma(f32x4 (&st)[4], const u16* sK, const bf16x8 (&bq)[2], int lane) {
  const int r = lane & 15, quad = lane >> 4;
#pragma unroll
  for (int mt = 0; mt < 4; ++mt) {
    f32x4 a = {0.f, 0.f, 0.f, 0.f};
#pragma unroll
    for (int ks = 0; ks < 2; ++ks) {
      bf16x8 kf = *(const bf16x8*)(sK + (16 * mt + r) * 72 + ks * 32 + quad * 8);
      a = __builtin_amdgcn_mfma_f32_16x16x32_bf16(kf, bq[ks], a, 0, 0, 0);
    }
    st[mt] = a;
  }
}
DI void pv_mma(f32x4 (&ot)[4], const u16* sVt, const f32x4 (&p)[4], int lane) {
  const int r = lane & 15, quad = lane >> 4;
#pragma unroll
  for (int ks = 0; ks < 2; ++ks) {
    uint4 pu;
    pu.x = pk2(p[2 * ks][0], p[2 * ks][1]); pu.y = pk2(p[2 * ks][2], p[2 * ks][3]);
    pu.z = pk2(p[2 * ks + 1][0], p[2 * ks + 1][1]); pu.w = pk2(p[2 * ks + 1][2], p[2 * ks + 1][3]);
    bf16x8 pb = __builtin_bit_cast(bf16x8, pu);
#pragma unroll
    for (int dt = 0; dt < 4; ++dt) {
      const u16* vrow = sVt + (16 * dt + r) * 72;
      s16x4 lo = *(const s16x4*)(vrow + ((32 * ks + 4 * quad) ^ (16 * dt)));
      s16x4 hi = *(const s16x4*)(vrow + ((32 * ks + 16 + 4 * quad) ^ (16 * dt)));
      bf16x8 vf = __builtin_shufflevector(lo, hi, 0, 1, 2, 3, 4, 5, 6, 7);
      ot[dt] = __builtin_amdgcn_mfma_f32_16x16x32_bf16(vf, pb, ot[dt], 0, 0, 0);
    }
  }
}
DI void load_tile(u16* dst, const u16* src, long ld) {
  const int tid = TID();
#pragma unroll
  for (int i = 0; i < 2; ++i) {
    int c = tid + 256 * i, row = c >> 3, ch = c & 7;
    uint4 v = *(const uint4*)(src + (long)row * ld + ch * 8);
    *(uint4*)(dst + row * 72 + ch * 8) = v;
  }
}
DI void load_tile_T(u16* dst, const u16* src, long ld) {
  const int tid = TID();
#pragma unroll
  for (int i = 0; i < 2; ++i) {
    int c = tid + 256 * i, row = c >> 3, ch = c & 7;
    uint4 v = *(const uint4*)(src + (long)row * ld + ch * 8);
    const unsigned* vv = (const unsigned*)&v;
#pragma unroll
    for (int q = 0; q < 4; ++q) {
      dst[(ch * 8 + 2 * q) * 72 + row] = (u16)(vv[q] & 0xffff);
      dst[(ch * 8 + 2 * q + 1) * 72 + row] = (u16)(vv[q] >> 16);
    }
  }
}
DI void load_q_nsa(u16* dst, const u16* src, long ld) {
  const int tid = TID();
#pragma unroll
  for (int i = 0; i < 2; ++i) {
    int c = tid + 256 * i, row = c >> 3, ch = c & 7;
    uint4 v = *(const uint4*)(src + (long)(row & 15) * ld + (row >> 4) * 64 + ch * 8);
    *(uint4*)(dst + row * 72 + ch * 8) = v;
  }
}
DI void load_qfrag(bf16x8 (&bq)[2], const u16* sQ, int w, int lane) {
  const int r = lane & 15, quad = lane >> 4;
  bq[0] = *(const bf16x8*)(sQ + (16 * w + r) * 72 + quad * 8);
  bq[1] = *(const bf16x8*)(sQ + (16 * w + r) * 72 + 32 + quad * 8);
}
DI float quad_max(float v) { v = fmaxf(v, __shfl_xor(v, 16)); v = fmaxf(v, __shfl_xor(v, 32)); return v; }
DI float quad_sum(float v) { v += __shfl_xor(v, 16); v += __shfl_xor(v, 32); return v; }

DI void softmax_tile(f32x4 (&st)[4], const bool (&msk)[4][4], float& m, float& l, f32x4 (&ot)[4]) {
  float tm = -1e30f;
#pragma unroll
  for (int mt = 0; mt < 4; ++mt)
#pragma unroll
    for (int j = 0; j < 4; ++j) { float s = st[mt][j] * 0.125f; st[mt][j] = s; if (msk[mt][j]) tm = fmaxf(tm, s); }
  tm = quad_max(tm);
  float mn = fmaxf(m, tm);
  float alpha = __expf(m - mn);
  float ps = 0.f;
#pragma unroll
  for (int mt = 0; mt < 4; ++mt)
#pragma unroll
    for (int j = 0; j < 4; ++j) { float p = msk[mt][j] ? __expf(st[mt][j] - mn) : 0.f; st[mt][j] = p; ps += p; }
  l = l * alpha + ps;
  m = mn;
#pragma unroll
  for (int dt = 0; dt < 4; ++dt)
#pragma unroll
    for (int j = 0; j < 4; ++j) ot[dt][j] *= alpha;
}

DI void phase_rmsnorm(const float* __restrict__ x, const float* __restrict__ wgt, u16* __restrict__ H) {
  const int lane = TID() & 63, w = TID() >> 6;
  const int gw = blockIdx.x * 4 + w, nw = gridDim.x * 4;
  for (int row = gw; row < T_; row += nw) {
    const float4* xr = (const float4*)(x + (long)row * DM);
    float4 v[4]; float s = 0.f;
#pragma unroll
    for (int j = 0; j < 4; ++j) { v[j] = xr[lane + 64 * j]; s += v[j].x * v[j].x + v[j].y * v[j].y + v[j].z * v[j].z + v[j].w * v[j].w; }
    s = wave_sum(s);
    float r = rsqrtf(s * (1.f / DM) + EPS);
#pragma unroll
    for (int j = 0; j < 4; ++j) {
      float4 g = ((const float4*)wgt)[lane + 64 * j];
      uint2 o; o.x = pk2(v[j].x * r * g.x, v[j].y * r * g.y); o.y = pk2(v[j].z * r * g.z, v[j].w * r * g.w);
      *(uint2*)(H + (long)row * DM + (lane + 64 * j) * 4) = o;
    }
  }
}
DI void phase_rope_table(const int* __restrict__ positions, float* __restrict__ COS, float* __restrict__ SIN) {
  const float invf[8] = {1.0f, 0.1939227432012558f, 0.03760603070259094f, 0.007292664609849453f,
                         0.0014142135623842478f, 0.00027424818836152554f, 5.3182957344688475e-05f, 1.0313385246263351e-05f};
  for (int idx = blockIdx.x * 256 + TID(); idx < T_ * 8; idx += gridDim.x * 256) {
    int i = idx & 7;
    float f = invf[0];
#pragma unroll
    for (int q = 1; q < 8; ++q) f = (i == q) ? invf[q] : f;
    float ang = (float)positions[idx >> 3] * f;
    double s, c; sincos_d((double)ang, s, c);
    COS[idx] = (float)c; SIN[idx] = (float)s;
  }
}

struct S5Coef { float ar, ai; float bbr[16], bbi[16]; };
DI void s5_coef(const Params& P, int l, int g, int p, S5Coef& C) {
  float dt = expf(P.in[13][l * 16 + g]);
  float lr = P.in[11][(l * 16 + g) * 64 + p], li = P.in[12][(l * 16 + g) * 64 + p];
  float mag = expf(lr * dt);
  double s, c; sincos_d((double)(li * dt), s, c);
  C.ar = mag * (float)c; C.ai = mag * (float)s;
  float den = lr * lr + li * li;
  float fr = ((C.ar - 1.f) * lr + C.ai * li) / den;
  float fi = (C.ai * lr - (C.ar - 1.f) * li) / den;
  const float* br = P.in[14] + ((long)(l * 16 + g) * 64 + p) * 16;
  const float* bi = P.in[15] + ((long)(l * 16 + g) * 64 + p) * 16;
#pragma unroll
  for (int c2 = 0; c2 < 16; ++c2) {
    float b_r = br[c2], b_i = bi[c2];
    C.bbr[c2] = fr * b_r - fi * b_i;
    C.bbi[c2] = fr * b_i + fi * b_r;
  }
}
DI void s5_load_u(float* su, const u16* PROJ, int b, int chunk, int g, int lane) {
  const u16* src = PROJ + ((long)(b * SEQ + chunk * 64 + lane)) * PW + P_S5U + g * 16;
  uint4 v0 = ((const uint4*)src)[0], v1 = ((const uint4*)src)[1];
  const unsigned* a = (const unsigned*)&v0; const unsigned* c = (const unsigned*)&v1;
  float* d = su + lane * 16;
#pragma unroll
  for (int q = 0; q < 4; ++q) { d[2 * q] = bf2f((u16)(a[q] & 0xffff)); d[2 * q + 1] = bf2f((u16)(a[q] >> 16)); }
#pragma unroll
  for (int q = 0; q < 4; ++q) { d[8 + 2 * q] = bf2f((u16)(c[q] & 0xffff)); d[8 + 2 * q + 1] = bf2f((u16)(c[q] >> 16)); }
}

DI void s5_pass1_item(const Params& P, int l, int it, float* lds) {
  const int lane = TID() & 63, w = TID() >> 6;
  const int gq = it & 3, chunk = (it >> 2) & 63, b = it >> 8;
  const int g = gq * 4 + w;
  const u16* PROJ = (const u16*)(WSP(P) + WS_PROJ);
  float* su = lds + w * 1024;
  S5Coef C; s5_coef(P, l, g, lane, C);
  s5_load_u(su, PROJ, b, chunk, g, lane);
  __syncthreads();
  float xr = 0.f, xi = 0.f;
#pragma unroll 4
  for (int t = 0; t < 64; ++t) {
    const f32x4* up = (const f32x4*)(su + t * 16);
    float br = 0.f, bi = 0.f;
#pragma unroll
    for (int q = 0; q < 4; ++q) {
      f32x4 u = up[q];
#pragma unroll
      for (int e = 0; e < 4; ++e) { br += u[e] * C.bbr[4 * q + e]; bi += u[e] * C.bbi[4 * q + e]; }
    }
    float nr = C.ar * xr - C.ai * xi + br;
    float ni = C.ar * xi + C.ai * xr + bi;
    xr = nr; xi = ni;
  }
  float2* ENDS = (float2*)(WSP(P) + WS_ENDS);
  ENDS[((long)(b * 64 + chunk) * 16 + g) * 64 + lane] = make_float2(xr, xi);
}

DI void s5_carry_item(const Params& P, int l, int it) {
  const int idx = it * 256 + TID();
  const int b = idx >> 10, gp = idx & 1023, g = gp >> 6, p = gp & 63;
  float dt = expf(P.in[13][l * 16 + g]);
  float lr = P.in[11][(l * 16 + g) * 64 + p], li = P.in[12][(l * 16 + g) * 64 + p];
  float mag = expf(lr * dt * 64.f);
  double s, c; sincos_d((double)(li * dt) * 64.0, s, c);
  float ar = mag * (float)c, ai = mag * (float)s;
  const float2* ENDS = (const float2*)(WSP(P) + WS_ENDS);
  float2* CARRY = (float2*)(WSP(P) + WS_CARRY);
  float xr = 0.f, xi = 0.f;
  for (int ch = 0; ch < 64; ++ch) {
    long o = ((long)(b * 64 + ch) * 16 + g) * 64 + p;
    CARRY[o] = make_float2(xr, xi);
    float2 e = ENDS[o];
    float nr = ar * xr - ai * xi + e.x;
    float ni = ar * xi + ai * xr + e.y;
    xr = nr; xi = ni;
  }
}

DI void s5_pass2_item(const Params& P, int l, int it, float* lds) {
  const int lane = TID() & 63, w = TID() >> 6, r16 = lane & 15, quad = lane >> 4;
  const int gq = it & 3, chunk = (it >> 2) & 63, b = it >> 8;
  const int g = gq * 4 + w;
  const u16* PROJ = (const u16*)(WSP(P) + WS_PROJ);
  u16* Y5 = (u16*)(WSP(P) + WS_Y5);
  float* su = lds + w * 1024;
  u16* sX = (u16*)(lds + 4096) + w * (32 * 136);
  S5Coef C; s5_coef(P, l, g, lane, C);
  bf16x8 bfr[4];
#pragma unroll
  for (int ks = 0; ks < 4; ++ks) {
    const float* src = P.in[(ks < 2) ? 16 : 17] + ((long)(l * 16 + g) * 16 + r16) * 64 + (ks & 1) * 32 + quad * 8;
    const float4 v0 = ((const float4*)src)[0], v1 = ((const float4*)src)[1];
    const float sg = (ks < 2) ? 1.f : -1.f;
    uint4 pu; pu.x = pk2(sg * v0.x, sg * v0.y); pu.y = pk2(sg * v0.z, sg * v0.w); pu.z = pk2(sg * v1.x, sg * v1.y); pu.w = pk2(sg * v1.z, sg * v1.w);
    bfr[ks] = __builtin_bit_cast(bf16x8, pu);
  }
  const float dsk = P.in[18][l * 256 + g * 16 + r16];
  s5_load_u(su, PROJ, b, chunk, g, lane);
  __syncthreads();
  const float2 c0 = ((const float2*)(WSP(P) + WS_CARRY))[((long)(b * 64 + chunk) * 16 + g) * 64 + lane];
  float xr = c0.x, xi = c0.y;
  for (int half = 0; half < 2; ++half) {
#pragma unroll 4
    for (int tt = 0; tt < 32; ++tt) {
      const int t = half * 32 + tt;
      const f32x4* up = (const f32x4*)(su + t * 16);
      float br0 = 0.f, bi0 = 0.f, br1 = 0.f, bi1 = 0.f;
#pragma unroll
      for (int q = 0; q < 4; ++q) {
        f32x4 u = up[q];
        br0 += u[0] * C.bbr[4 * q + 0]; bi0 += u[0] * C.bbi[4 * q + 0];
        br1 += u[1] * C.bbr[4 * q + 1]; bi1 += u[1] * C.bbi[4 * q + 1];
        br0 += u[2] * C.bbr[4 * q + 2]; bi0 += u[2] * C.bbi[4 * q + 2];
        br1 += u[3] * C.bbr[4 * q + 3]; bi1 += u[3] * C.bbi[4 * q + 3];
      }
      const float nr = C.ar * xr - C.ai * xi + (br0 + br1);
      const float ni = C.ar * xi + C.ai * xr + (bi0 + bi1);
      xr = nr; xi = ni;
      sX[tt * 136 + lane] = f2bf(xr);
      sX[tt * 136 + 64 + lane] = f2bf(xi);
    }
    __syncthreads();
#pragma unroll
    for (int mt = 0; mt < 2; ++mt) {
      f32x4 acc = {0.f, 0.f, 0.f, 0.f};
#pragma unroll
      for (int ks = 0; ks < 4; ++ks) {
        const bf16x8 af = *(const bf16x8*)(sX + (16 * mt + r16) * 136 + ks * 32 + quad * 8);
        acc = __builtin_amdgcn_mfma_f32_16x16x32_bf16(af, bfr[ks], acc, 0, 0, 0);
      }
#pragma unroll
      for (int j = 0; j < 4; ++j) {
        const int t = half * 32 + 16 * mt + 4 * quad + j;
        const float y = acc[j] + dsk * su[t * 16 + r16];
        Y5[((long)(b * SEQ + chunk * 64 + t)) * 256 + g * 16 + r16] = f2bf(gelu_tanh(y));
      }
    }
    __syncthreads();
  }
}

DI void nsa_prep_item(const Params& P, int l, int it) {
  const int lane = TID() & 63, w = TID() >> 6;
  u16* PROJ = (u16*)(WSP(P) + WS_PROJ);
  u16* QR = (u16*)(WSP(P) + WS_QR);
  const float* COS = (const float*)(WSP(P) + WS_COS);
  const float* SIN = (const float*)(WSP(P) + WS_SIN);
  for (int tt = 0; tt < 4; ++tt) {
    const long t = (long)it * 16 + w * 4 + tt;
    const float cs = COS[t * 8 + (lane & 7)], sn = SIN[t * 8 + (lane & 7)];
#pragma unroll
    for (int g = 0; g < 6; ++g) {
      const int col = (g < 4) ? (P_Q + g * 64) : (g == 4 ? P_KV + 128 : P_KV + 256);
      const float wg = (g < 4) ? P.in[4][l * 64 + lane] : P.in[5][(l * 3 + (g - 3)) * 64 + lane];
      u16* ptr = PROJ + t * PW + col + lane;
      float v = bf2f(*ptr);
      float ss = wave_sum(v * v);
      float y = v * rsqrtf(ss * (1.f / 64.f) + EPS) * wg;
      float pr = __shfl_xor(y, 8);
      float rot = (lane < 8) ? (y * cs - pr * sn) : ((lane < 16) ? (y * cs + pr * sn) : y);
      if (g < 4) { *ptr = f2bf(y); QR[t * 256 + g * 64 + lane] = f2bf(rot); }
      else *ptr = f2bf(rot);
    }
  }
}

DI void cmp1_tile(const Params& P, int l, int ct, u16* sA, u16* sB) {
  const int tid = TID(), lane = tid & 63, w = tid >> 6, r16 = lane & 15, quad = lane >> 4, wm = w >> 1, wn = w & 1;
  const int kv = ct >> 5, mt = (ct >> 1) & 15, nt = ct & 1;
  const u16* PROJ = (const u16*)(WSP(P) + WS_PROJ);
  u16* HID = (u16*)(WSP(P) + WS_HID);
  const u16* apq[4];
#pragma unroll
  for (int q = 0; q < 4; ++q) {
    int row, pc; g3_rowpiece(tid, q, false, row, pc);
    int gr = mt * 128 + row; if (gr > 2039) gr = 2039;
    const int b = gr / 255, n = gr % 255;
    apq[q] = PROJ + ((long)(b * SEQ + 16 * n)) * PW + P_KV + kv * 64 + pc * 8;
  }
  const u16* Bb = (const u16*)(WSP(P) + WS_W + WT_C1) + ((long)(kv * 256 + nt * 128)) * 2048;
  f32x4 acc[4][4];
  gemm3<4>(acc, apq[0], apq[1], apq[2], apq[3], PW,
           g3_ptr(Bb, 2048, tid, 0, false), g3_ptr(Bb, 2048, tid, 1, false), g3_ptr(Bb, 2048, tid, 2, false), g3_ptr(Bb, 2048, tid, 3, false), 2048, sA);
  {
    const float* PART = (const float*)(WSP(P) + WS_CBIAS) + (long)kv * 32 * 256;
#pragma unroll
    for (int ni = 0; ni < 4; ++ni) {
      const int col = nt * 128 + wn * 64 + 16 * ni + r16;
      float bsum = 0.f;
      for (int sl = 0; sl < 32; ++sl) bsum += PART[sl * 256 + col];
#pragma unroll
      for (int mi = 0; mi < 4; ++mi)
#pragma unroll
        for (int j = 0; j < 4; ++j) acc[mi][ni][j] += bsum;
    }
  }
  __syncthreads();
#pragma unroll
  for (int mi = 0; mi < 4; ++mi)
#pragma unroll
    for (int ni = 0; ni < 4; ++ni)
#pragma unroll
      for (int j = 0; j < 4; ++j) sA[(wm * 64 + 16 * mi + 4 * quad + j) * 136 + wn * 64 + 16 * ni + r16] = f2bf(gelu_tanh(acc[mi][ni][j]));
  __syncthreads();
  store_tile_bf16<128>(sA, HID + ((long)kv * 2048 + mt * 128) * 256 + nt * 128, 256, 2040 - mt * 128);
}
DI void cmp2_tile(const Params& P, int l, int ct, u16* sA, u16* sB, float* sSS) {
  const int tid = TID(), lane = tid & 63, w = tid >> 6, r16 = lane & 15, quad = lane >> 4, wm = w >> 1, wn = w & 1;
  const int kv = ct >> 4, mt = ct & 15;
  const u16* HID = (const u16*)(WSP(P) + WS_HID);
  u16* OUT = (u16*)(WSP(P) + (kv ? WS_VC : WS_KC));
  const u16* Ab = HID + ((long)kv * 2048 + mt * 128) * 256;
  const u16* Bb = (const u16*)(WSP(P) + WS_W + WT_C2) + (long)kv * 64 * 256;
  f32x4 acc[4][2];
  gemm3<2>(acc, g3_ptr(Ab, 256, tid, 0, false), g3_ptr(Ab, 256, tid, 1, false), g3_ptr(Ab, 256, tid, 2, false), g3_ptr(Ab, 256, tid, 3, false), 64,
           g3_ptr(Bb, 256, tid, 0, true), g3_ptr(Bb, 256, tid, 1, true), nullptr, nullptr, 256, sA);
  __syncthreads();
  if (tid < 128) sSS[tid] = 0.f;
  __syncthreads();
#pragma unroll
  for (int mi = 0; mi < 4; ++mi)
#pragma unroll
    for (int j = 0; j < 4; ++j) {
      float ss = acc[mi][0][j] * acc[mi][0][j] + acc[mi][1][j] * acc[mi][1][j];
      ss += __shfl_xor(ss, 1); ss += __shfl_xor(ss, 2); ss += __shfl_xor(ss, 4); ss += __shfl_xor(ss, 8);
      if (r16 == 0) atomicAdd(&sSS[wm * 64 + 16 * mi + 4 * quad + j], ss);
    }
  __syncthreads();
#pragma unroll
  for (int mi = 0; mi < 4; ++mi)
#pragma unroll
    for (int j = 0; j < 4; ++j) {
      const int rl = wm * 64 + 16 * mi + 4 * quad + j, row = mt * 128 + rl;
      const float sc = (kv == 0) ? rsqrtf(sSS[rl] * (1.f / 64.f) + EPS) : 1.f;
      if (row < 2040) {
        int b = row / 255, n = row % 255;
#pragma unroll
        for (int ni = 0; ni < 2; ++ni) {
          int col = wn * 32 + 16 * ni + r16;
          float v = acc[mi][ni][j] * sc;
          if (kv == 0) v *= P.in[5][(l * 3 + 0) * 64 + col];
          OUT[((long)(b * 256 + n)) * 64 + col] = f2bf(v);
        }
      }
    }
}

DI void gdn_p1_item(const Params& P, int l, int it, float* lds) {
  const int tid = TID(), lane = tid & 63, w = tid >> 6, r16 = lane & 15, quad = lane >> 4;
  const int chunk = it & 63, h = (it >> 6) & 3, b = it >> 8;
  const long ci = it;
  const u16* PROJ = (const u16*)(WSP(P) + WS_PROJ);
  float* sq = lds;
  float* sk = lds + 64 * 65;
  float* sv = lds + 2 * 64 * 65;
  float* sG = lds + 3 * 64 * 65;
  float* sBeta = sG + 64;
  float* sg = sBeta + 64;
  u16* sQb = (u16*)(sg + 64);
  u16* sKb = sQb + 64 * 72;
  const float* cw = P.in[20] + (long)l * 4 * 768;
  if (tid < 192) {
    const int cp = tid % 96, th = tid / 96;
    const int c0 = 2 * cp, which = c0 >> 6, d = c0 & 63, C = which * 256 + h * 64 + d;
    float w0[4], w1[4];
#pragma unroll
    for (int k = 0; k < 4; ++k) { w0[k] = cw[k * 768 + C]; w1[k] = cw[k * 768 + C + 1]; }
    unsigned v[35];
    const int s0 = chunk * 64 + th * 32 - 3;
    const u16* src = PROJ + ((long)(b * SEQ + s0)) * PW + P_GQKV + C;
#pragma unroll
    for (int k = 0; k < 35; ++k) v[k] = (s0 + k >= 0) ? *(const unsigned*)(src + (long)k * PW) : 0u;
    float* dst = lds + which * 64 * 65 + (th * 32) * 65 + d;
#pragma unroll
    for (int tt = 0; tt < 32; ++tt) {
      float a0 = 0.f, a1 = 0.f;
#pragma unroll
      for (int k = 0; k < 4; ++k) { a0 += w0[k] * bf2f((u16)(v[tt + k] & 0xffff)); a1 += w1[k] * bf2f((u16)(v[tt + k] >> 16)); }
      dst[tt * 65] = siluf_(a0); dst[tt * 65 + 1] = siluf_(a1);
    }
  }
  __syncthreads();
  if (tid < 128) {
    float* base = (tid < 64) ? sq : sk;
    u16* bb = (tid < 64) ? sQb : sKb;
    const int row = tid & 63;
    float ss = 0.f;
#pragma unroll 8
    for (int d = 0; d < 64; ++d) { float x = base[row * 65 + d]; ss += x * x; }
    const float sc = rsqrtf(ss + EPS) * ((tid < 64) ? 0.125f : 1.f);
#pragma unroll 8
    for (int d = 0; d < 64; d += 2) {
      const float x0 = base[row * 65 + d] * sc, x1 = base[row * 65 + d + 1] * sc;
      base[row * 65 + d] = x0; base[row * 65 + d + 1] = x1;
      *(unsigned*)(bb + row * 72 + d) = pk2(x0, x1);
    }
  } else if (tid < 192) {
    const int row = tid - 128;
    const long t = (long)(b * SEQ + chunk * 64 + row);
    const float bl = bf2f(PROJ[t * PW + P_GB + h]);
    const float al = bf2f(PROJ[t * PW + P_GA + h]);
    sBeta[row] = sigmoidf_(bl);
    sg[row] = -expf(P.in[21][l * 4 + h]) * softplusf_(al + P.in[22][l * 4 + h]);
  }
  __syncthreads();
  if (tid < 64) {
    float x = sg[tid];
#pragma unroll
    for (int o = 1; o < 64; o <<= 1) { float u = __shfl_up(x, o); if (tid >= o) x += u; }
    sG[tid] = x;
    ((float*)(WSP(P) + WS_GG))[ci * 64 + tid] = x;
  }
  __syncthreads();
  f32x4 lreg[4];
  {
    const f32x4 Gi4 = *(const f32x4*)(sG + 16 * w + 4 * quad);
    const f32x4 Bi4 = *(const f32x4*)(sBeta + 16 * w + 4 * quad);
    u16* GA = (u16*)(WSP(P) + WS_GA) + ci * 4096;
#pragma unroll
    for (int nt = 0; nt < 4; ++nt) {
      f32x4 aq = {0.f, 0.f, 0.f, 0.f}, ak = {0.f, 0.f, 0.f, 0.f};
#pragma unroll
      for (int ks = 0; ks < 2; ++ks) {
        const bf16x8 fq = *(const bf16x8*)(sQb + (16 * w + r16) * 72 + ks * 32 + quad * 8);
        const bf16x8 fk = *(const bf16x8*)(sKb + (16 * w + r16) * 72 + ks * 32 + quad * 8);
        const bf16x8 fb = *(const bf16x8*)(sKb + (16 * nt + r16) * 72 + ks * 32 + quad * 8);
        aq = __builtin_amdgcn_mfma_f32_16x16x32_bf16(fq, fb, aq, 0, 0, 0);
        ak = __builtin_amdgcn_mfma_f32_16x16x32_bf16(fk, fb, ak, 0, 0, 0);
      }
      const int j = 16 * nt + r16;
      const float Gj = sG[j];
#pragma unroll
      for (int jj = 0; jj < 4; ++jj) {
        const int i = 16 * w + 4 * quad + jj;
        const float dec = __expf(Gi4[jj] - Gj);
        GA[i * 64 + j] = f2bf((j <= i) ? aq[jj] * dec : 0.f);
        const float lv = (j < i) ? Bi4[jj] * ak[jj] * dec : 0.f;
        sq[i * 65 + j] = lv;
        lreg[nt][jj] = lv;
      }
    }
  }
  {
    u16* GQ = (u16*)(WSP(P) + WS_GQ) + ci * 4096;
#pragma unroll
    for (int q = 0; q < 2; ++q) { const int c = tid + 256 * q, row = c >> 3, ch = c & 7; *(uint4*)(GQ + row * 64 + ch * 8) = *(const uint4*)(sQb + row * 72 + ch * 8); }
    const int i = tid >> 2, j0 = (tid & 3) * 16;
    u16* GK = (u16*)(WSP(P) + WS_GK) + ci * 4096 + i * 64 + j0;
    unsigned ok[8];
#pragma unroll
    for (int q = 0; q < 8; ++q) ok[q] = pk2(sk[(j0 + 2 * q) * 65 + i], sk[(j0 + 2 * q + 1) * 65 + i]);
    ((uint4*)GK)[0] = make_uint4(ok[0], ok[1], ok[2], ok[3]); ((uint4*)GK)[1] = make_uint4(ok[4], ok[5], ok[6], ok[7]);
  }
  __syncthreads();
  u16* sLb = sQb;
  u16* sXT = sKb;
  {
    const int i = tid >> 2, j0 = (tid & 3) * 16;
    const float bi = sBeta[i], eg = __expf(sG[i]);
#pragma unroll
    for (int jj = 0; jj < 16; ++jj) { sv[i * 65 + j0 + jj] *= bi; sk[i * 65 + j0 + jj] *= bi * eg; }
#pragma unroll
    for (int nt = 0; nt < 4; ++nt)
#pragma unroll
      for (int jj = 0; jj < 4; ++jj) sLb[(16 * w + 4 * quad + jj) * 72 + 16 * nt + r16] = f2bf(lreg[nt][jj]);
  }
  __syncthreads();
#pragma unroll 1
  for (int bi = 0; bi < 4; ++bi) {
    if (tid < 128) {
      float* buf = (tid < 64) ? sv : sk;
      const int col = tid & 63;
      float x[16];
#pragma unroll
      for (int r = 0; r < 16; ++r) {
        float a0 = buf[(16 * bi + r) * 65 + col], a1 = 0.f;
#pragma unroll
        for (int j = 0; j + 1 < r; j += 2) { a0 -= sq[(16 * bi + r) * 65 + 16 * bi + j] * x[j]; a1 -= sq[(16 * bi + r) * 65 + 16 * bi + j + 1] * x[j + 1]; }
        if (r & 1) a0 -= sq[(16 * bi + r) * 65 + 16 * bi + r - 1] * x[r - 1];
        x[r] = a0 + a1;
        buf[(16 * bi + r) * 65 + col] = x[r];
      }
      uint4 p0, p1;
      p0.x = pk2(x[0], x[1]); p0.y = pk2(x[2], x[3]); p0.z = pk2(x[4], x[5]); p0.w = pk2(x[6], x[7]);
      p1.x = pk2(x[8], x[9]); p1.y = pk2(x[10], x[11]); p1.z = pk2(x[12], x[13]); p1.w = pk2(x[14], x[15]);
      *(uint4*)(sXT + tid * 24) = p0; *(uint4*)(sXT + tid * 24 + 8) = p1;
    }
    __syncthreads();
    if (bi < 3) {
#pragma unroll
      for (int q = 0; q < 2; ++q) {
        const int nt = 2 * w + q, colg = 16 * nt + r16;
        bf16x8 bx = *(const bf16x8*)(sXT + colg * 24 + (quad & 1) * 8);
        if (quad >= 2) bx = (bf16x8){0, 0, 0, 0, 0, 0, 0, 0};
        float* buf = (colg < 64) ? sv : sk;
        const int cc = colg & 63;
        for (int bk = bi + 1; bk < 4; ++bk) {
          const bf16x8 al = *(const bf16x8*)(sLb + (16 * bk + r16) * 72 + 16 * bi + quad * 8);
          f32x4 c = {0.f, 0.f, 0.f, 0.f};
          c = __builtin_amdgcn_mfma_f32_16x16x32_bf16(al, bx, c, 0, 0, 0);
#pragma unroll
          for (int jj = 0; jj < 4; ++jj) buf[(16 * bk + 4 * quad + jj) * 65 + cc] -= c[jj];
        }
      }
    }
    __syncthreads();
  }
  {
    const int i = tid >> 2, j0 = (tid & 3) * 16;
    u16* GU = (u16*)(WSP(P) + WS_GU) + ci * 4096 + i * 64 + j0;
    u16* GW = (u16*)(WSP(P) + WS_GW) + ci * 4096 + i * 64 + j0;
    unsigned ou[8], ow[8];
#pragma unroll
    for (int q = 0; q < 8; ++q) {
      ou[q] = pk2(sv[i * 65 + j0 + 2 * q], sv[i * 65 + j0 + 2 * q + 1]);
      ow[q] = pk2(sk[i * 65 + j0 + 2 * q], sk[i * 65 + j0 + 2 * q + 1]);
    }
    ((uint4*)GU)[0] = make_uint4(ou[0], ou[1], ou[2], ou[3]); ((uint4*)GU)[1] = make_uint4(ou[4], ou[5], ou[6], ou[7]);
    ((uint4*)GW)[0] = make_uint4(ow[0], ow[1], ow[2], ow[3]); ((uint4*)GW)[1] = make_uint4(ow[4], ow[5], ow[6], ow[7]);
  }
}

DI void unpack8(const u16* p, float (&o)[8]) {
  uint4 v = *(const uint4*)p;
  o[0] = bf2f((u16)(v.x & 0xffff)); o[1] = bf2f((u16)(v.x >> 16));
  o[2] = bf2f((u16)(v.y & 0xffff)); o[3] = bf2f((u16)(v.y >> 16));
  o[4] = bf2f((u16)(v.z & 0xffff)); o[5] = bf2f((u16)(v.z >> 16));
  o[6] = bf2f((u16)(v.w & 0xffff)); o[7] = bf2f((u16)(v.w >> 16));
}
DI void st_kt(u16* sKt, int c8, int row, uint4 k) {
  sKt[(c8 + 0) * 72 + row] = (u16)(k.x & 0xffff); sKt[(c8 + 1) * 72 + row] = (u16)(k.x >> 16);
  sKt[(c8 + 2) * 72 + row] = (u16)(k.y & 0xffff); sKt[(c8 + 3) * 72 + row] = (u16)(k.y >> 16);
  sKt[(c8 + 4) * 72 + row] = (u16)(k.z & 0xffff); sKt[(c8 + 5) * 72 + row] = (u16)(k.z >> 16);
  sKt[(c8 + 6) * 72 + row] = (u16)(k.w & 0xffff); sKt[(c8 + 7) * 72 + row] = (u16)(k.w >> 16);
}
DI uint2 pack4bf(const f32x4& v) { uint2 r; r.x = pk2(v[0], v[1]); r.y = pk2(v[2], v[3]); return r; }
DI void gdn_p2_item(const Params& P, int it, float* lds) {
  const int tid = TID(), lane = tid & 63, w = tid >> 6, r16 = lane & 15, quad = lane >> 4;
  const int es = it & 3, bh = it >> 2, b = bh >> 2, h = bh & 3;
  u16* sW = (u16*)lds;
  u16* sQ = sW + 64 * 72;
  u16* sAm = sQ + 64 * 72;
  u16* sKt = sAm + 64 * 72;
  u16* sSt = sKt + 64 * 72;
  u16* sVnT = sSt + 16 * 72;
  u16* sVdT = sVnT + 16 * 72;
  float* sG = (float*)(sVdT + 16 * 72);
  const u16* GQ = (const u16*)(WSP(P) + WS_GQ); const u16* GK = (const u16*)(WSP(P) + WS_GK);
  const u16* GU = (const u16*)(WSP(P) + WS_GU); const u16* GW = (const u16*)(WSP(P) + WS_GW);
  const u16* GA = (const u16*)(WSP(P) + WS_GA); const float* GG = (const float*)(WSP(P) + WS_GG);
  u16* ORAW = (u16*)(WSP(P) + WS_OM) + (long)2 * T_ * 256;
  f32x4 S = {0.f, 0.f, 0.f, 0.f};
  const int irow = 16 * w + 4 * quad;
  uint4 rw0, rw1, rq0, rq1, ra0, ra1, rk0, rk1; u16 ru0, ru1, ru2, ru3; float rg = 0.f;
  const int c0 = tid, c1 = tid + 256;
  const long off0 = (c0 >> 3) * 64 + (c0 & 7) * 8, off1 = (c1 >> 3) * 64 + (c1 & 7) * 8;
#define GDN_GLOAD(CH) { long ci_ = (long)bh * 64 + (CH); \
    rw0 = *(const uint4*)(GW + ci_ * 4096 + off0); rw1 = *(const uint4*)(GW + ci_ * 4096 + off1); \
    rq0 = *(const uint4*)(GQ + ci_ * 4096 + off0); rq1 = *(const uint4*)(GQ + ci_ * 4096 + off1); \
    ra0 = *(const uint4*)(GA + ci_ * 4096 + off0); ra1 = *(const uint4*)(GA + ci_ * 4096 + off1); \
    rk0 = *(const uint4*)(GK + ci_ * 4096 + off0); rk1 = *(const uint4*)(GK + ci_ * 4096 + off1); \
    const u16* up_ = GU + ci_ * 4096 + irow * 64 + es * 16 + r16; \
    ru0 = up_[0]; ru1 = up_[64]; ru2 = up_[128]; ru3 = up_[192]; \
    if (tid < 64) rg = GG[ci_ * 64 + tid]; }
  GDN_GLOAD(0)
  for (int ch = 0; ch < 64; ++ch) {
    __syncthreads();
    {
      const int row0 = c0 >> 3, c80 = (c0 & 7) * 8, row1 = c1 >> 3, c81 = (c1 & 7) * 8;
      *(uint4*)(sW + row0 * 72 + c80) = rw0; *(uint4*)(sW + row1 * 72 + c81) = rw1;
      *(uint4*)(sQ + row0 * 72 + c80) = rq0; *(uint4*)(sQ + row1 * 72 + c81) = rq1;
      *(uint4*)(sAm + row0 * 72 + c80) = ra0; *(uint4*)(sAm + row1 * 72 + c81) = ra1;
      *(uint4*)(sKt + row0 * 72 + c80) = rk0; *(uint4*)(sKt + row1 * 72 + c81) = rk1;
    }
    if (tid < 64) sG[tid] = rg;
    *(uint2*)(sSt + r16 * 72 + irow) = pack4bf(S);
    const f32x4 uc = {bf2f(ru0), bf2f(ru1), bf2f(ru2), bf2f(ru3)};
    __syncthreads();
    if (ch + 1 < 64) GDN_GLOAD(ch + 1)
    f32x4 ws = {0.f, 0.f, 0.f, 0.f}, qs = {0.f, 0.f, 0.f, 0.f};
#pragma unroll
    for (int ks = 0; ks < 2; ++ks) {
      const bf16x8 bS = *(const bf16x8*)(sSt + r16 * 72 + ks * 32 + quad * 8);
      const bf16x8 aW = *(const bf16x8*)(sW + (16 * w + r16) * 72 + ks * 32 + quad * 8);
      const bf16x8 aQ = *(const bf16x8*)(sQ + (16 * w + r16) * 72 + ks * 32 + quad * 8);
      ws = __builtin_amdgcn_mfma_f32_16x16x32_bf16(aW, bS, ws, 0, 0, 0);
      qs = __builtin_amdgcn_mfma_f32_16x16x32_bf16(aQ, bS, qs, 0, 0, 0);
    }
    const float Gl = sG[63];
    const f32x4 G4 = *(const f32x4*)(sG + irow);
    f32x4 vn, vd;
#pragma unroll
    for (int j = 0; j < 4; ++j) { vn[j] = uc[j] - ws[j]; vd[j] = vn[j] * __expf(Gl - G4[j]); }
    *(uint2*)(sVnT + r16 * 72 + irow) = pack4bf(vn);
    *(uint2*)(sVdT + r16 * 72 + irow) = pack4bf(vd);
    __syncthreads();
    f32x4 av = {0.f, 0.f, 0.f, 0.f}, kv = {0.f, 0.f, 0.f, 0.f};
#pragma unroll
    for (int ks = 0; ks < 2; ++ks) {
      const bf16x8 bVn = *(const bf16x8*)(sVnT + r16 * 72 + ks * 32 + quad * 8);
      const bf16x8 bVd = *(const bf16x8*)(sVdT + r16 * 72 + ks * 32 + quad * 8);
      const bf16x8 aA = *(const bf16x8*)(sAm + (16 * w + r16) * 72 + ks * 32 + quad * 8);
      const bf16x8 aK = *(const bf16x8*)(sKt + (16 * w + r16) * 72 + ks * 32 + quad * 8);
      av = __builtin_amdgcn_mfma_f32_16x16x32_bf16(aA, bVn, av, 0, 0, 0);
      kv = __builtin_amdgcn_mfma_f32_16x16x32_bf16(aK, bVd, kv, 0, 0, 0);
    }
    {
      u16* op = ORAW + ((long)(b * SEQ + ch * 64 + irow)) * 256 + h * 64 + es * 16 + r16;
#pragma unroll
      for (int j = 0; j < 4; ++j) op[j * 256] = f2bf(__expf(G4[j]) * qs[j] + av[j]);
    }
    const float gl = __expf(Gl);
#pragma unroll
    for (int j = 0; j < 4; ++j) S[j] = S[j] * gl + kv[j];
  }
#undef GDN_GLOAD
}
DI void gdn_post_item(const Params& P, int l, int it) {
  const int lane = TID() & 63, w = TID() >> 6;
  const u16* PROJ = (const u16*)(WSP(P) + WS_PROJ);
  u16* O = (u16*)(WSP(P) + WS_OM) + (long)2 * T_ * 256;
  const float wn = P.in[23][l * 64 + lane];
#pragma unroll 4
  for (int q = 0; q < 16; ++q) {
    long t = (long)it * 16 + w * 4 + (q >> 2); int h = q & 3;
    float o = bf2f(O[t * 256 + h * 64 + lane]);
    float ss = wave_sum(o * o);
    float y = o * rsqrtf(ss * (1.f / 64.f) + EPS) * wn;
    float z = bf2f(PROJ[t * PW + P_GZ + h * 64 + lane]);
    O[t * 256 + h * 64 + lane] = f2bf(y * siluf_(z));
  }
}

DI void kv_gload(uint4& k0, uint4& k1, uint4& v0, uint4& v1, const u16* ksrc, const u16* vsrc, long ld) {
  const int tid = TID(), r0 = tid >> 3, ch = tid & 7;
  k0 = *(const uint4*)(ksrc + (long)r0 * ld + ch * 8); k1 = *(const uint4*)(ksrc + (long)(r0 + 32) * ld + ch * 8);
  v0 = *(const uint4*)(vsrc + (long)r0 * ld + ch * 8); v1 = *(const uint4*)(vsrc + (long)(r0 + 32) * ld + ch * 8);
}
DI void k_gload(uint4& k0, uint4& k1, const u16* ksrc, long ld) {
  const int tid = TID(), r0 = tid >> 3, ch = tid & 7;
  k0 = *(const uint4*)(ksrc + (long)r0 * ld + ch * 8); k1 = *(const uint4*)(ksrc + (long)(r0 + 32) * ld + ch * 8);
}
DI void k_store(const uint4& k0, const uint4& k1, u16* sK) {
  const int tid = TID(), r0 = tid >> 3, ch = tid & 7;
  *(uint4*)(sK + r0 * 72 + ch * 8) = k0; *(uint4*)(sK + (r0 + 32) * 72 + ch * 8) = k1;
}
DI void kv_store(const uint4& k0, const uint4& k1, const uint4& v0, const uint4& v1, u16* sK, u16* sVt) {
  const int tid = TID(), r0 = tid >> 3, ch = tid & 7;
  *(uint4*)(sK + r0 * 72 + ch * 8) = k0; *(uint4*)(sK + (r0 + 32) * 72 + ch * 8) = k1;
  const int ksw = 16 * (ch >> 1);
  st_kt(sVt, ch * 8, r0 ^ ksw, v0); st_kt(sVt, ch * 8, (r0 + 32) ^ ksw, v1);
}
DI void sb_attn_item(const Params& P, int it, u16* sQ, u16* sK, u16* sVt) {
  const int tid = TID(), lane = tid & 63, w = tid >> 6, r16 = lane & 15, quad = lane >> 4;
  const int qb = 63 - (it >> 5), bh = it & 31, b = bh >> 2, h = bh & 3;
  const u16* PROJ = (const u16*)(WSP(P) + WS_PROJ);
  u16* OUT = (u16*)(WSP(P) + WS_OM) + (long)3 * T_ * 256;
  const long tb = (long)b * SEQ;
  load_tile(sQ, PROJ + (tb + qb * 64) * PW + P_SB + h * 64, PW);
  __syncthreads();
  bf16x8 bq[2]; load_qfrag(bq, sQ, w, lane);
  const int tq = qb * 64 + 16 * w + r16;
  f32x4 ot[4];
#pragma unroll
  for (int dt = 0; dt < 4; ++dt) ot[dt] = (f32x4){0.f, 0.f, 0.f, 0.f};
  float R = 0.f;
  uint4 pk0, pk1, pv0, pv1;
  kv_gload(pk0, pk1, pv0, pv1, PROJ + (tb + qb * 64) * PW + P_SB + 256 + h * 64, PROJ + (tb + qb * 64) * PW + P_SB + 512 + h * 64, PW);
  for (int kb = qb; kb >= 0; --kb) {
    if (__syncthreads_and(R < -104.f)) break;
    kv_store(pk0, pk1, pv0, pv1, sK, sVt);
    __syncthreads();
    if (kb > 0) kv_gload(pk0, pk1, pv0, pv1, PROJ + (tb + (kb - 1) * 64) * PW + P_SB + 256 + h * 64, PROJ + (tb + (kb - 1) * 64) * PW + P_SB + 512 + h * 64, PW);
    f32x4 st[4];
    st_mma(st, sK, bq, lane);
    float gs[4], zz[4][4], x[4][4];
#pragma unroll
    for (int mt = 0; mt < 4; ++mt) {
      float g = 0.f;
#pragma unroll
      for (int j = 0; j < 4; ++j) {
        int s = kb * 64 + 16 * mt + 4 * quad + j;
        float z = st[mt][j] * 0.125f;
        float sp = softplusf_(z);
        bool mk = s < tq;
        x[mt][j] = mk ? -sp : 0.f;
        zz[mt][j] = mk ? (z - sp) : -1e30f;
        g += x[mt][j];
      }
      gs[mt] = g;
    }
    float hm = 0.f, tot_all = 0.f;
    f32x4 pw[4];
#pragma unroll
    for (int mt = 3; mt >= 0; --mt) {
      float g = gs[mt];
      float v1 = __shfl_down(g, 16), v2 = __shfl_down(g, 32), v3 = __shfl_down(g, 48);
      float hq = (quad < 3 ? v1 : 0.f) + (quad < 2 ? v2 : 0.f) + (quad < 1 ? v3 : 0.f);
      float tot = quad_sum(g);
      float base = R + hm + hq;
      float e3 = 0.f, e2 = x[mt][3], e1 = e2 + x[mt][2], e0 = e1 + x[mt][1];
      pw[mt][0] = __expf(zz[mt][0] + base + e0);
      pw[mt][1] = __expf(zz[mt][1] + base + e1);
      pw[mt][2] = __expf(zz[mt][2] + base + e2);
      pw[mt][3] = __expf(zz[mt][3] + base + e3);
      hm += tot; tot_all += tot;
    }
    R += tot_all;
    pv_mma(ot, sVt, pw, lane);
  }
  const long t = tb + tq;
#pragma unroll
  for (int dt = 0; dt < 4; ++dt) {
    uint2 ov; ov.x = pk2(ot[dt][0], ot[dt][1]); ov.y = pk2(ot[dt][2], ot[dt][3]);
    *(uint2*)(OUT + t * 256 + h * 64 + 16 * dt + 4 * quad) = ov;
  }
}

DI void win_attn_item(const Params& P, int it, u16* sQ, u16* sKunused, u16* sVunused) {
  const int tid = TID(), lane = tid & 63, w = tid >> 6, r16 = lane & 15, quad = lane >> 4;
  const int tbk = 127 - (it >> 3), b = it & 7;
  u16* sK = sQ + 128 * 72;
  u16* sVt = sK + 64 * 72;
  (void)sKunused; (void)sVunused;
  const u16* PROJ = (const u16*)(WSP(P) + WS_PROJ);
  const u16* QR = (const u16*)(WSP(P) + WS_QR);
  u16* OW = (u16*)(WSP(P) + WS_OW);
  const long tb = (long)b * SEQ;
  const int t0 = tbk * 32;
#pragma unroll
  for (int i = 0; i < 4; ++i) {
    const int c = tid + 256 * i, row = c >> 3, ch = c & 7;
    *(uint4*)(sQ + row * 72 + ch * 8) = *(const uint4*)(QR + (tb + t0 + (row & 31)) * 256 + (row >> 5) * 64 + ch * 8);
  }
  __syncthreads();
  bf16x8 bq[2][2];
  int tq[2];
#pragma unroll
  for (int qt = 0; qt < 2; ++qt) {
    const int rowq = 32 * w + 16 * qt + r16;
    bq[qt][0] = *(const bf16x8*)(sQ + rowq * 72 + quad * 8);
    bq[qt][1] = *(const bf16x8*)(sQ + rowq * 72 + 32 + quad * 8);
    tq[qt] = t0 + 16 * qt + r16;
  }
  f32x4 ot[2][4];
#pragma unroll
  for (int qt = 0; qt < 2; ++qt)
#pragma unroll
    for (int dt = 0; dt < 4; ++dt) ot[qt][dt] = (f32x4){0.f, 0.f, 0.f, 0.f};
  float m[2] = {-1e30f, -1e30f}, lsum[2] = {0.f, 0.f};
  const int lo = (t0 - 511) > 0 ? (t0 - 511) : 0;
  const int kb_lo = lo >> 6, kb_hi = (t0 + 31) >> 6;
  uint4 pk0, pk1, pv0, pv1;
  kv_gload(pk0, pk1, pv0, pv1, PROJ + (tb + kb_lo * 64) * PW + P_KV + 256, PROJ + (tb + kb_lo * 64) * PW + P_KV + 320, PW);
  for (int kb = kb_lo; kb <= kb_hi; ++kb) {
    __syncthreads();
    kv_store(pk0, pk1, pv0, pv1, sK, sVt);
    __syncthreads();
    if (kb < kb_hi) kv_gload(pk0, pk1, pv0, pv1, PROJ + (tb + (kb + 1) * 64) * PW + P_KV + 256, PROJ + (tb + (kb + 1) * 64) * PW + P_KV + 320, PW);
#pragma unroll
    for (int qt = 0; qt < 2; ++qt) {
      f32x4 st[4];
      st_mma(st, sK, bq[qt], lane);
      bool msk[4][4];
#pragma unroll
      for (int mt = 0; mt < 4; ++mt)
#pragma unroll
        for (int j = 0; j < 4; ++j) { int s = kb * 64 + 16 * mt + 4 * quad + j; int df = tq[qt] - s; msk[mt][j] = (df >= 0) && (df < 512); }
      softmax_tile(st, msk, m[qt], lsum[qt], ot[qt]);
      pv_mma(ot[qt], sVt, st, lane);
    }
  }
#pragma unroll
  for (int qt = 0; qt < 2; ++qt) {
    const float ls = quad_sum(lsum[qt]);
    const float inv = 1.f / fmaxf(ls, 1e-30f);
    const long t = tb + tq[qt];
#pragma unroll
    for (int dt = 0; dt < 4; ++dt) {
      uint2 ov; ov.x = pk2(ot[qt][dt][0] * inv, ot[qt][dt][1] * inv); ov.y = pk2(ot[qt][dt][2] * inv, ot[qt][dt][3] * inv);
      *(uint2*)(OW + t * 256 + w * 64 + 16 * dt + 4 * quad) = ov;
    }
  }
}

DI void cmp_attn_item(const Params& P, int it, u16* sQ, u16* sK, u16* sVt, float* sImp) {
  const int tid = TID(), lane = tid & 63, w = tid >> 6, r16 = lane & 15, quad = lane >> 4;
  const int tbk = 255 - (it >> 3), b = it & 7;
  const u16* PROJ = (const u16*)(WSP(P) + WS_PROJ);
  const u16* KC = (const u16*)(WSP(P) + WS_KC) + (long)b * 256 * 64;
  const u16* VC = (const u16*)(WSP(P) + WS_VC) + (long)b * 256 * 64;
  u16* OC = (u16*)(WSP(P) + WS_OC);
  u64* SEL = (u64*)(WSP(P) + WS_SEL);
  const long tb = (long)b * SEQ;
  const int t0 = tbk * 16;
  load_q_nsa(sQ, PROJ + (tb + t0) * PW + P_Q, PW);
  for (int e = tid; e < 4 * 16 * 64; e += 256) sImp[e] = 0.f;
  __syncthreads();
  bf16x8 bq[2]; load_qfrag(bq, sQ, w, lane);
  const int tq = t0 + r16;
  const int nv = (tq >= 31) ? ((tq - 31) >> 4) + 1 : 0;
  const int nvmax = (t0 + 15 >= 31) ? ((t0 + 15 - 31) >> 4) + 1 : 0;
  const int ntile = (nvmax + 63) >> 6;
  float m = -1e30f, lsum = 0.f;
  uint4 pk0, pk1, pv0, pv1;
  if (ntile > 0) k_gload(pk0, pk1, KC, 64);
  for (int kt = 0; kt < ntile; ++kt) {
    __syncthreads();
    k_store(pk0, pk1, sK);
    __syncthreads();
    if (kt + 1 < ntile) k_gload(pk0, pk1, KC + (kt + 1) * 64 * 64, 64);
    f32x4 st[4];
    st_mma(st, sK, bq, lane);
    float tm = -1e30f;
#pragma unroll
    for (int mt = 0; mt < 4; ++mt)
#pragma unroll
      for (int j = 0; j < 4; ++j) { int n = kt * 64 + 16 * mt + 4 * quad + j; float s = st[mt][j] * 0.125f; st[mt][j] = s; if (n < nv) tm = fmaxf(tm, s); }
    tm = quad_max(tm);
    float mn = fmaxf(m, tm);
    float ps = 0.f;
#pragma unroll
    for (int mt = 0; mt < 4; ++mt)
#pragma unroll
      for (int j = 0; j < 4; ++j) { int n = kt * 64 + 16 * mt + 4 * quad + j; if (n < nv) ps += __expf(st[mt][j] - mn); }
    lsum = lsum * __expf(m - mn) + ps;
    m = mn;
  }
  lsum = quad_sum(lsum);
  const float inv = (lsum > 0.f) ? 1.f / lsum : 0.f;
  f32x4 ot[4];
#pragma unroll
  for (int dt = 0; dt < 4; ++dt) ot[dt] = (f32x4){0.f, 0.f, 0.f, 0.f};
  float carry = 0.f;
  if (ntile > 0) kv_gload(pk0, pk1, pv0, pv1, KC, VC, 64);
  for (int kt = 0; kt < ntile; ++kt) {
    __syncthreads();
    kv_store(pk0, pk1, pv0, pv1, sK, sVt);
    __syncthreads();
    if (kt + 1 < ntile) kv_gload(pk0, pk1, pv0, pv1, KC + (kt + 1) * 64 * 64, VC + (kt + 1) * 64 * 64, 64);
    f32x4 st[4];
    st_mma(st, sK, bq, lane);
#pragma unroll
    for (int mt = 0; mt < 4; ++mt)
#pragma unroll
      for (int j = 0; j < 4; ++j) { int n = kt * 64 + 16 * mt + 4 * quad + j; st[mt][j] = (n < nv) ? __expf(st[mt][j] * 0.125f - m) * inv : 0.f; }
    pv_mma(ot, sVt, st, lane);
    float prevlast = carry;
#pragma unroll
    for (int mt = 0; mt < 4; ++mt) {
      float pl = st[mt][3];
      float fd = __shfl_up(pl, 16);
      float pprev = (quad > 0) ? fd : prevlast;
      float v = st[mt][0] + st[mt][1] + st[mt][2] + st[mt][3] + pprev;
      sImp[(w * 16 + r16) * 64 + kt * 16 + mt * 4 + quad] = v;
      prevlast = __shfl_down(pl, 48);
    }
    carry = prevlast;
  }
  {
    const long t = tb + tq;
#pragma unroll
    for (int dt = 0; dt < 4; ++dt) {
      uint2 ov; ov.x = pk2(ot[dt][0], ot[dt][1]); ov.y = pk2(ot[dt][2], ot[dt][3]);
      *(uint2*)(OC + t * 256 + w * 64 + 16 * dt + 4 * quad) = ov;
    }
  }
  __syncthreads();
  for (int q = 0; q < 4; ++q) {
    const int tok = 4 * w + q, t = t0 + tok;
    float v = sImp[(0 * 16 + tok) * 64 + lane] + sImp[(1 * 16 + tok) * 64 + lane] + sImp[(2 * 16 + tok) * 64 + lane] + sImp[(3 * 16 + tok) * 64 + lane];
    const int cur = t >> 6;
    if (lane == 0 || lane == cur) v = 1e9f;
    else if (lane * 64 > t) v = -1e30f;
    int cnt = 0;
#pragma unroll
    for (int i2 = 0; i2 < 64; ++i2) {
      float vi = __builtin_bit_cast(float, __builtin_amdgcn_readlane(__builtin_bit_cast(int, v), i2));
      cnt += (vi > v || (vi == v && i2 < lane)) ? 1 : 0;
    }
    u64 mask = __ballot(cnt < 16);
    if (lane == 0) SEL[tb + t] = mask;
  }
}

DI void sel_attn_item(const Params& P, int it, u16* sQ, u16* sKunused, u16* sVunused) {
  const int tid = TID(), lane = tid & 63, w = tid >> 6, r16 = lane & 15, quad = lane >> 4;
  const int tbk = 127 - (it >> 3), b = it & 7;
  u16* sK = sQ + 128 * 72;
  u16* sVt = sK + 64 * 72;
  (void)sKunused; (void)sVunused;
  const u16* PROJ = (const u16*)(WSP(P) + WS_PROJ);
  const u16* QR = (const u16*)(WSP(P) + WS_QR);
  const u16* OC = (const u16*)(WSP(P) + WS_OC);
  const u16* OW = (const u16*)(WSP(P) + WS_OW);
  const u64* SEL = (const u64*)(WSP(P) + WS_SEL);
  u16* OUT = (u16*)(WSP(P) + WS_OM);
  const long tb = (long)b * SEQ;
  const int t0 = tbk * 32;
#pragma unroll
  for (int i = 0; i < 4; ++i) {
    const int c = tid + 256 * i, row = c >> 3, ch = c & 7;
    *(uint4*)(sQ + row * 72 + ch * 8) = *(const uint4*)(QR + (tb + t0 + (row & 31)) * 256 + (row >> 5) * 64 + ch * 8);
  }
  __syncthreads();
  bf16x8 bq[2][2];
  int tq[2]; u64 mysel[2];
#pragma unroll
  for (int qt = 0; qt < 2; ++qt) {
    const int rowq = 32 * w + 16 * qt + r16;
    bq[qt][0] = *(const bf16x8*)(sQ + rowq * 72 + quad * 8);
    bq[qt][1] = *(const bf16x8*)(sQ + rowq * 72 + 32 + quad * 8);
    tq[qt] = t0 + 16 * qt + r16;
    mysel[qt] = SEL[tb + tq[qt]];
  }
  u64 uni = 0;
#pragma unroll
  for (int q = 0; q < 32; ++q) uni |= SEL[tb + t0 + q];
  const int cur = t0 >> 6;
  uni &= (cur == 63) ? ~0ull : ((1ull << (cur + 1)) - 1ull);
  f32x4 ot[2][4];
#pragma unroll
  for (int qt = 0; qt < 2; ++qt)
#pragma unroll
    for (int dt = 0; dt < 4; ++dt) ot[qt][dt] = (f32x4){0.f, 0.f, 0.f, 0.f};
  float m[2] = {-1e30f, -1e30f}, lsum[2] = {0.f, 0.f};
  uint4 pk0, pk1, pv0, pv1;
  int kb = uni ? (__ffsll((long long)uni) - 1) : -1;
  uni &= uni - 1;
  if (kb >= 0) kv_gload(pk0, pk1, pv0, pv1, PROJ + (tb + kb * 64) * PW + P_KV + 128, PROJ + (tb + kb * 64) * PW + P_KV + 192, PW);
  for (int nkb = -1; kb >= 0; kb = nkb) {
    __syncthreads();
    kv_store(pk0, pk1, pv0, pv1, sK, sVt);
    __syncthreads();
    nkb = uni ? (__ffsll((long long)uni) - 1) : -1;
    uni &= uni - 1;
    if (nkb >= 0) kv_gload(pk0, pk1, pv0, pv1, PROJ + (tb + nkb * 64) * PW + P_KV + 128, PROJ + (tb + nkb * 64) * PW + P_KV + 192, PW);
#pragma unroll
    for (int qt = 0; qt < 2; ++qt) {
      f32x4 st[4];
      st_mma(st, sK, bq[qt], lane);
      const bool selq = (mysel[qt] >> kb) & 1ull;
      bool msk[4][4];
#pragma unroll
      for (int mt = 0; mt < 4; ++mt)
#pragma unroll
        for (int j = 0; j < 4; ++j) { int s = kb * 64 + 16 * mt + 4 * quad + j; msk[mt][j] = selq && (s <= tq[qt]); }
      softmax_tile(st, msk, m[qt], lsum[qt], ot[qt]);
      pv_mma(ot[qt], sVt, st, lane);
    }
  }
#pragma unroll
  for (int qt = 0; qt < 2; ++qt) {
    const float ls = quad_sum(lsum[qt]);
    const float inv = 1.f / fmaxf(ls, 1e-30f);
    const long t = tb + tq[qt];
    const float gc = sigmoidf_(bf2f(PROJ[t * PW + P_NG + w * 3 + 0]));
    const float gsl = sigmoidf_(bf2f(PROJ[t * PW + P_NG + w * 3 + 1]));
    const float gw = sigmoidf_(bf2f(PROJ[t * PW + P_NG + w * 3 + 2]));
#pragma unroll
    for (int dt = 0; dt < 4; ++dt) {
      const long o = t * 256 + w * 64 + 16 * dt + 4 * quad;
      uint2 c = *(const uint2*)(OC + o), ww = *(const uint2*)(OW + o);
      float r0 = gc * bf2f((u16)(c.x & 0xffff)) + gsl * ot[qt][dt][0] * inv + gw * bf2f((u16)(ww.x & 0xffff));
      float r1 = gc * bf2f((u16)(c.x >> 16)) + gsl * ot[qt][dt][1] * inv + gw * bf2f((u16)(ww.x >> 16));
      float r2 = gc * bf2f((u16)(c.y & 0xffff)) + gsl * ot[qt][dt][2] * inv + gw * bf2f((u16)(ww.y & 0xffff));
      float r3 = gc * bf2f((u16)(c.y >> 16)) + gsl * ot[qt][dt][3] * inv + gw * bf2f((u16)(ww.y >> 16));
      uint2 ov; ov.x = pk2(r0, r1); ov.y = pk2(r2, r3);
      *(uint2*)(OUT + o) = ov;
    }
  }
}

DI void inproj_tile(const Params& P, int l, int it, u16* sA, u16* sB) {
  const int tid = TID(), lane = tid & 63, w = tid >> 6, r16 = lane & 15, quad = lane >> 4, wm = w >> 1, wn = w & 1;
  int mt, nt; tile_from_q(it, 22, mt, nt);
  const u16* H = (const u16*)(WSP(P) + WS_H);
  u16* PROJ = (u16*)(WSP(P) + WS_PROJ);
  const u16* Ab = H + (long)mt * 128 * DM;
  const u16* Bb = (const u16*)(WSP(P) + WS_W + WT_IN) + (long)nt * 128 * DM;
  f32x4 acc[4][4];
  gemm3<4>(acc, g3_ptr(Ab, DM, tid, 0, false), g3_ptr(Ab, DM, tid, 1, false), nullptr, nullptr, 64,
           g3_ptr(Bb, DM, tid, 0, false), g3_ptr(Bb, DM, tid, 1, false), nullptr, nullptr, DM, sA, 16L * DM, 16L * DM);
  __syncthreads();
#pragma unroll
  for (int mi = 0; mi < 4; ++mi)
#pragma unroll
    for (int ni = 0; ni < 4; ++ni)
#pragma unroll
      for (int j = 0; j < 4; ++j) sA[(wm * 64 + 16 * mi + 4 * quad + j) * 136 + wn * 64 + 16 * ni + r16] = f2bf(acc[mi][ni][j]);
  __syncthreads();
  store_tile_bf16<128>(sA, PROJ + (long)mt * 128 * PW + nt * 128, PW, 128);
}
DI void glu_tile(const Params& P, int l, int it, u16* sA, u16* sB) {
  const int tid = TID(), lane = tid & 63, w = tid >> 6, r16 = lane & 15, quad = lane >> 4, wm = w >> 1, wn = w & 1;
  const int mt = it >> 2, nt = it & 3;
  const u16* Y5 = (const u16*)(WSP(P) + WS_Y5);
  u16* OUT = (u16*)(WSP(P) + WS_OM) + (long)1 * T_ * 256;
  const u16* Ab = Y5 + (long)mt * 128 * 256;
  const u16* Bb = (const u16*)(WSP(P) + WS_W + WT_GLU) + (long)nt * 128 * 256;
  f32x4 acc[4][4];
  gemm3<4>(acc, g3_ptr(Ab, 256, tid, 0, false), g3_ptr(Ab, 256, tid, 1, false), nullptr, nullptr, 64,
           g3_ptr(Bb, 256, tid, 0, false), g3_ptr(Bb, 256, tid, 1, false), nullptr, nullptr, 256, sA, 16L * 256, 16L * 256);
  __syncthreads();
#pragma unroll
  for (int mi = 0; mi < 4; ++mi)
#pragma unroll
    for (int ni = 0; ni < 2; ++ni)
#pragma unroll
      for (int j = 0; j < 4; ++j)
        sA[(wm * 64 + 16 * mi + 4 * quad + j) * 72 + wn * 32 + 16 * ni + r16] = f2bf(acc[mi][ni][j] * sigmoidf_(acc[mi][ni + 2][j]));
  __syncthreads();
  store_tile_bf16<64>(sA, OUT + (long)mt * 128 * 256 + nt * 64, 256, 128);
}
DI void merge_tile(const Params& P, int l, int it, u16* sA, u16* sB) {
  const int tid = TID(), lane = tid & 63, w = tid >> 6, r16 = lane & 15, quad = lane >> 4, wm = w >> 1, wn = w & 1;
  int mt, nt; tile_from_q(it, 8, mt, nt);
  const u16* H = (const u16*)(WSP(P) + WS_H);
  const u16* OM = (const u16*)(WSP(P) + WS_OM);
  u16* MERGED = (u16*)(WSP(P) + WS_MERGED);
  uint2 outp[4][4];
#pragma unroll
  for (int mi = 0; mi < 4; ++mi)
#pragma unroll
    for (int ni = 0; ni < 4; ++ni) outp[mi][ni] = make_uint2(0u, 0u);
#pragma unroll 1
  for (int m = 0; m < 4; ++m) {
    uint2 gp[4][4];
    {
      f32x4 ag[4][4];
      const u16* Ab = H + (long)mt * 128 * DM;
      const u16* Bb = (const u16*)(WSP(P) + WS_W + WT_G) + ((long)(m * 1024 + nt * 128)) * DM;
      gemm3<4, true>(ag, g3_ptr(Ab, DM, tid, 0, false), g3_ptr(Ab, DM, tid, 1, false), nullptr, nullptr, 64,
               g3_ptr(Bb, DM, tid, 0, false), g3_ptr(Bb, DM, tid, 1, false), nullptr, nullptr, DM, sA, 16L * DM, 16L * DM);
#pragma unroll
      for (int mi = 0; mi < 4; ++mi)
#pragma unroll
        for (int ni = 0; ni < 4; ++ni) {
          gp[mi][ni].x = pk2(sigmoidf_(ag[mi][ni][0]), sigmoidf_(ag[mi][ni][1]));
          gp[mi][ni].y = pk2(sigmoidf_(ag[mi][ni][2]), sigmoidf_(ag[mi][ni][3]));
        }
    }
    {
      f32x4 av[4][4];
      const u16* Ab = OM + ((long)m * T_ + (long)mt * 128) * 256;
      const u16* Bb = (const u16*)(WSP(P) + WS_W + WT_BR) + ((long)(m * 1024 + nt * 128)) * 256;
      gemm3<4, true>(av, g3_ptr(Ab, 256, tid, 0, false), g3_ptr(Ab, 256, tid, 1, false), nullptr, nullptr, 64,
               g3_ptr(Bb, 256, tid, 0, false), g3_ptr(Bb, 256, tid, 1, false), nullptr, nullptr, 256, sA, 16L * 256, 16L * 256);
#pragma unroll
      for (int mi = 0; mi < 4; ++mi)
#pragma unroll
        for (int ni = 0; ni < 4; ++ni) {
          const float o0 = bf2f((u16)(outp[mi][ni].x & 0xffff)) + av[mi][ni][0] * bf2f((u16)(gp[mi][ni].x & 0xffff));
          const float o1 = bf2f((u16)(outp[mi][ni].x >> 16)) + av[mi][ni][1] * bf2f((u16)(gp[mi][ni].x >> 16));
          const float o2 = bf2f((u16)(outp[mi][ni].y & 0xffff)) + av[mi][ni][2] * bf2f((u16)(gp[mi][ni].y & 0xffff));
          const float o3 = bf2f((u16)(outp[mi][ni].y >> 16)) + av[mi][ni][3] * bf2f((u16)(gp[mi][ni].y >> 16));
          outp[mi][ni].x = pk2(o0, o1); outp[mi][ni].y = pk2(o2, o3);
        }
    }
  }
  __syncthreads();
#pragma unroll
  for (int mi = 0; mi < 4; ++mi)
#pragma unroll
    for (int ni = 0; ni < 4; ++ni)
#pragma unroll
      for (int j = 0; j < 4; ++j) {
        const unsigned wv = (j < 2) ? outp[mi][ni].x : outp[mi][ni].y;
        sA[(wm * 64 + 16 * mi + 4 * quad + j) * 136 + wn * 64 + 16 * ni + r16] = (u16)((j & 1) ? (wv >> 16) : (wv & 0xffff));
      }
  __syncthreads();
  store_tile_bf16<128>(sA, MERGED + (long)mt * 128 * DM + nt * 128, DM, 128);
}
DI void resid_tile(const u16* A, int K, const u16* Bt, const float* resid, float* out, int it, u16* sA, u16* sB) {
  const int tid = TID(), lane = tid & 63, w = tid >> 6, r16 = lane & 15, quad = lane >> 4, wm = w >> 1, wn = w & 1;
  int mt, nt; tile_from_q(it, 8, mt, nt);
  const u16* Ab = A + (long)mt * 128 * K;
  const u16* Bb = Bt + (long)nt * 128 * K;
  f32x4 acc[4][4];
  gemm3<4>(acc, g3_ptr(Ab, K, tid, 0, false), g3_ptr(Ab, K, tid, 1, false), nullptr, nullptr, 64,
           g3_ptr(Bb, K, tid, 0, false), g3_ptr(Bb, K, tid, 1, false), nullptr, nullptr, K, sA, 16L * K, 16L * K);
  float* sC = (float*)sA + w * (32 * 68);
#pragma unroll
  for (int hp = 0; hp < 2; ++hp) {
    __syncthreads();
#pragma unroll
    for (int mi2 = 0; mi2 < 2; ++mi2)
#pragma unroll
      for (int ni = 0; ni < 4; ++ni)
#pragma unroll
        for (int j = 0; j < 4; ++j) sC[(16 * mi2 + 4 * quad + j) * 68 + 16 * ni + r16] = acc[2 * hp + mi2][ni][j];
    __syncthreads();
#pragma unroll
    for (int q = 0; q < 8; ++q) {
      const int c = lane + 64 * q, row = c >> 4, c4 = (c & 15) * 4;
      const long o = ((long)mt * 128 + wm * 64 + 32 * hp + row) * DM + nt * 128 + wn * 64 + c4;
      const float4 rv = *(const float4*)(resid + o);
      const f32x4 cv = *(const f32x4*)(sC + row * 68 + c4);
      *(float4*)(out + o) = make_float4(rv.x + cv[0], rv.y + cv[1], rv.z + cv[2], rv.w + cv[3]);
    }
  }
}
DI void ffn1_tile(const Params& P, int l, int it, u16* sA, u16* sB) {
  const int tid = TID(), lane = tid & 63, w = tid >> 6, r16 = lane & 15, quad = lane >> 4, wm = w >> 1, wn = w & 1;
  int mt, nt; tile_from_q(it, 44, mt, nt);
  const u16* H = (const u16*)(WSP(P) + WS_H);
  u16* ACT = (u16*)(WSP(P) + WS_PROJ);
  const u16* Ab = H + (long)mt * 128 * DM;
  const u16* Bb = (const u16*)(WSP(P) + WS_W + WT_GU) + (long)nt * 128 * DM;
  f32x4 acc[4][4];
  gemm3<4>(acc, g3_ptr(Ab, DM, tid, 0, false), g3_ptr(Ab, DM, tid, 1, false), nullptr, nullptr, 64,
           g3_ptr(Bb, DM, tid, 0, false), g3_ptr(Bb, DM, tid, 1, false), nullptr, nullptr, DM, sA, 16L * DM, 16L * DM);
  __syncthreads();
#pragma unroll
  for (int mi = 0; mi < 4; ++mi)
#pragma unroll
    for (int ni = 0; ni < 2; ++ni)
#pragma unroll
      for (int j = 0; j < 4; ++j)
        sA[(wm * 64 + 16 * mi + 4 * quad + j) * 72 + wn * 32 + 16 * ni + r16] = f2bf(siluf_(acc[mi][ni][j]) * acc[mi][ni + 2][j]);
  __syncthreads();
  store_tile_bf16<64>(sA, ACT + (long)mt * 128 * DFF + nt * 64, DFF, 128);
}

__global__ void __launch_bounds__(256, LB2) fwd_megakernel(Params P) {
  cg::grid_group grid = cg::this_grid();
  __shared__ __attribute__((aligned(16))) float lds[17920];
  __shared__ int s_item;
  unsigned* cnt = (unsigned*)(WSP(P) + WS_CNT);
  const int xcd = (int)(__builtin_amdgcn_s_getreg((3 << 11) | 20) & 0xF) & 7;
  __shared__ int s_rank;
  if (threadIdx.x == 0) s_rank = (int)atomicAdd(cnt + 900 + xcd, 1u);
  __syncthreads();
  const int xrank = s_rank;
  u16* sA = (u16*)lds;
  u16* sB = sA + 128 * 80;
  u16* aQ = (u16*)lds;
  u16* aK = aQ + 64 * 72;
  u16* aV = aK + 64 * 72;
  float* aImp = (float*)(aV + 64 * 72);
  for (int ph = P.ph_lo; ph < P.ph_hi; ++ph) {
    const int l = ph / 11, sp = ph % 11;
    const float* xin = (l == 0) ? P.in[0] : P.out;
    const int nrep = (PROBE_DUP != 0 && l == 0 && ((PROBE_DUP >> sp) & 1)) ? 2 : 1;
    for (int rep = 0; rep < nrep; ++rep) {
    unsigned* pc = cnt + (ph + 32 * rep) * 8;
    switch (sp) {
      case 0: if (PHASE_MASK & (1 << 0)) {
        phase_rmsnorm(xin, P.in[2] + l * DM, (u16*)(WSP(P) + WS_H));
        phase_convert(P, l, lds);
        if (l == 0) phase_rope_table((const int*)P.in[1], (float*)(WSP(P) + WS_COS), (float*)(WSP(P) + WS_SIN));
      } break;
      case 1: if (PHASE_MASK & (1 << 1)) {
        XCD_STATIC_LOOP(32 * 22, inproj_tile(P, l, it, sA, sB))
      } break;
      case 2: if (PHASE_MASK & (1 << 2)) {
        for (;;) {
          int it = next_item(pc, &s_item); if (it >= 64 + 3 * 2048) break;
          if (it < 64) cmp1_tile(P, l, it, sA, sB);
          else if (it < 64 + 2048) gdn_p1_item(P, l, it - 64, lds);
          else if (it < 64 + 4096) s5_pass1_item(P, l, it - 64 - 2048, lds);
          else nsa_prep_item(P, l, it - 64 - 4096);
        }
      } break;
      case 3: if (PHASE_MASK & (1 << 3)) {
        for (;;) {
          int it = next_item(pc, &s_item); if (it >= 128 + 3072 + 64) break;
          if (it < 128) gdn_p2_item(P, it, lds);
          else if (it < 128 + 2048) sb_attn_item(P, it - 128, aQ, aK, aV);
          else if (it < 128 + 3072) win_attn_item(P, it - 128 - 2048, aQ, aK, aV);
          else if (it < 128 + 3072 + 32) s5_carry_item(P, l, it - 128 - 3072);
          else cmp2_tile(P, l, it - 128 - 3072 - 32, sA, sB, lds + 17000);
        }
      } break;
      case 4: if (PHASE_MASK & (1 << 4)) {
        for (;;) {
          int it = next_item(pc, &s_item); if (it >= 3 * 2048) break;
          if (it < 2048) cmp_attn_item(P, it, aQ, aK, aV, aImp);
          else if (it < 4096) s5_pass2_item(P, l, it - 2048, lds);
          else gdn_post_item(P, l, it - 4096);
        }
      } break;
      case 5: if (PHASE_MASK & (1 << 5)) {
        for (;;) {
          int it = next_item(pc, &s_item); if (it >= 1024 + 1024) break;
          if (it < 1024) sel_attn_item(P, it, aQ, aK, aV);
          else glu_tile(P, l, it - 1024, sA, sB);
        }
      } break;
      case 6: if (PHASE_MASK & (1 << 6)) {
        XCD_STATIC_LOOP(32 * 8, merge_tile(P, l, it, sA, sB))
      } break;
      case 7: if (PHASE_MASK & (1 << 7)) {
        XCD_STATIC_LOOP(32 * 8, resid_tile((const u16*)(WSP(P) + WS_MERGED), DM, (const u16*)(WSP(P) + WS_W + WT_OUT), xin, P.out, it, sA, sB))
      } break;
      case 8: if (PHASE_MASK & (1 << 8)) {
        phase_rmsnorm(P.out, P.in[26] + l * DM, (u16*)(WSP(P) + WS_H));
      } break;
      case 9: if (PHASE_MASK & (1 << 9)) {
        XCD_STATIC_LOOP(32 * 44, ffn1_tile(P, l, it, sA, sB))
      } break;
      case 10: if (PHASE_MASK & (1 << 10)) {
        XCD_STATIC_LOOP(32 * 8, resid_tile((const u16*)(WSP(P) + WS_PROJ), DFF, (const u16*)(WSP(P) + WS_W + WT_D), P.out, P.out, it, sA, sB))
      } break;
    }
    if (rep + 1 < nrep) grid.sync();
    }
    if (ph + 1 < P.ph_hi) grid.sync();
  }
}

extern "C" void kernel_launch(void* const* d_in, const int* in_sizes, int n_in, void* d_out, int out_size, void* d_ws, size_t ws_size,
                              hipStream_t stream) {
  static int grid_blocks = 0;
  if (!grid_blocks) {
    int dev = 0, cus = 0, per_cu = 0;
    hipGetDevice(&dev);
    hipDeviceGetAttribute(&cus, hipDeviceAttributeMultiprocessorCount, dev);
    hipOccupancyMaxActiveBlocksPerMultiprocessor(&per_cu, fwd_megakernel, 256, 0);
    if (per_cu < 1) per_cu = 1;
    if (per_cu > 2) per_cu = 2;
    grid_blocks = cus * per_cu;
    if (ws_size < WS_W + WT_END) fprintf(stderr, "kernel_launch: workspace too small: %zu\n", ws_size);
  }
  hipMemsetAsync((char*)d_ws + WS_CNT, 0, 4096, stream);
  Params p{};
  for (int i = 0; i < 30; ++i) p.in[i] = (const float*)d_in[i];
  p.out = (float*)d_out;
  p.ws = (unsigned char*)d_ws;
  p.ph_lo = 0; p.ph_hi = NPHASE;
  void* args[] = {&p};
  hipError_t e = hipLaunchCooperativeKernel((void*)fwd_megakernel, dim3(grid_blocks), dim3(256), args, 0, stream);
  if (e != hipSuccess) fprintf(stderr, "cooperative launch failed: %s (grid %d)\n", hipGetErrorString(e), grid_blocks);
}
```

```cpp
#include <hip/hip_runtime.h>
#include <hip/hip_cooperative_groups.h>
#include <cstdio>
namespace cg = cooperative_groups;

typedef unsigned short u16;
typedef unsigned long long u64;
typedef __attribute__((ext_vector_type(8))) short bf16x8;
typedef __attribute__((ext_vector_type(4))) short s16x4;
typedef __attribute__((ext_vector_type(4))) float f32x4;
#define DI __device__ __forceinline__

constexpr int NB = 8, SEQ = 4096, T_ = NB * SEQ, DM = 1024, DIN = 6804, PW = 2816, DFF = 2816;
constexpr int P_Q = 0, P_KV = 256, P_S5U = 640, P_GQKV = 896, P_GZ = 1664, P_SB = 1920, P_NG = 2688, P_GA = 2700, P_GB = 2704;
constexpr float EPS = 1e-6f;
constexpr size_t MiB = 1024ull * 1024ull;
constexpr size_t WS_H = 0, WS_PROJ = 64 * MiB, WS_OM = 240 * MiB, WS_MERGED = 304 * MiB,
                 WS_GQ = 304 * MiB, WS_GK = 320 * MiB, WS_GU = 336 * MiB, WS_GW = 352 * MiB, WS_GA = 368 * MiB,
                 WS_QR = 384 * MiB, WS_OC = 400 * MiB, WS_OW = 416 * MiB, WS_Y5 = 432 * MiB,
                 WS_GG = 448 * MiB, WS_SEL = 449 * MiB, WS_COS = 450 * MiB, WS_SIN = 451 * MiB,
                 WS_ENDS = 452 * MiB, WS_CARRY = 456 * MiB, WS_KC = 460 * MiB, WS_VC = 461 * MiB, WS_HID = 462 * MiB,
                 WS_CNT = 464 * MiB, WS_W = 465 * MiB, WS_CBIAS = 449 * MiB + 512 * 1024;
constexpr size_t WT_IN = 0, WT_G = WT_IN + 2816ull * 1024 * 2, WT_BR = WT_G + 4096ull * 1024 * 2, WT_OUT = WT_BR + 4096ull * 256 * 2,
                 WT_GU = WT_OUT + 1024ull * 1024 * 2, WT_D = WT_GU + 5632ull * 1024 * 2, WT_GLU = WT_D + 1024ull * 2816 * 2,
                 WT_C1 = WT_GLU + 512ull * 256 * 2, WT_C2 = WT_C1 + 512ull * 2048 * 2, WT_END = WT_C2 + 128ull * 256 * 2;
constexpr int NPHASE = 22;
#define XCD_STATIC_LOOP(NPER, BODY) { \
    unsigned c0_ = cnt[900], c1_ = cnt[901], c2_ = cnt[902], c3_ = cnt[903], c4_ = cnt[904], c5_ = cnt[905], c6_ = cnt[906], c7_ = cnt[907]; \
    const bool ok_ = c0_ && c1_ && c2_ && c3_ && c4_ && c5_ && c6_ && c7_; \
    const unsigned mine_ = xcd == 0 ? c0_ : xcd == 1 ? c1_ : xcd == 2 ? c2_ : xcd == 3 ? c3_ : xcd == 4 ? c4_ : xcd == 5 ? c5_ : xcd == 6 ? c6_ : c7_; \
    const int start_ = ok_ ? xcd * (NPER) + xrank : (int)blockIdx.x, end_ = ok_ ? (xcd + 1) * (NPER) : 8 * (NPER), step_ = ok_ ? (int)mine_ : (int)gridDim.x; \
    for (int it = start_; it < end_; it += step_) { BODY; } }
#ifndef PROBE_DUP
#define PROBE_DUP 0
#endif
#ifndef LB2
#define LB2 2
#endif
#ifndef PHASE_MASK
#define PHASE_MASK 0x7ff
#endif

struct Params {
  const float* in[30];
  float* out;
  unsigned char* ws;
  int ph_lo, ph_hi;
};


DI int TID() { int t = threadIdx.x; asm volatile("" : "+v"(t)); return t; }
DI unsigned char* WSP(const Params& P) { size_t z = 0; asm volatile("" : "+s"(z)); return P.ws + z; }
typedef __bf16 bf16x2_t __attribute__((ext_vector_type(2)));
typedef float f32x2_t __attribute__((ext_vector_type(2)));
DI u16 f2bf(float x) { __bf16 r = (__bf16)x; return __builtin_bit_cast(u16, r); }
DI float bf2f(u16 h) { return __uint_as_float(((unsigned)h) << 16); }
DI unsigned pk2(float a, float b) { f32x2_t v = {a, b}; bf16x2_t r = __builtin_convertvector(v, bf16x2_t); return __builtin_bit_cast(unsigned, r); }
DI float wave_sum(float v) {
#pragma unroll
  for (int o = 1; o < 64; o <<= 1) v += __shfl_xor(v, o);
  return v;
}
DI float sigmoidf_(float x) { return 1.f / (1.f + __expf(-x)); }
DI float siluf_(float x) { return x * sigmoidf_(x); }
DI float softplusf_(float x) { return fmaxf(x, 0.f) + log1pf(__expf(-fabsf(x))); }
DI float softplus_fast(float x) { return fmaxf(x, 0.f) + __logf(1.f + __expf(-fabsf(x))); }
DI float gelu_tanh(float x) {
  float u = 0.7978845608028654f * (x + 0.044715f * x * x * x);
  float t = 1.f - 2.f / (__expf(2.f * u) + 1.f);
  return 0.5f * x * (1.f + t);
}
DI void sincos_d(double x, double& s, double& c) {
  const double TWO_PI = 6.283185307179586476925287, INV = 0.15915494309189533576888;
  double n = rint(x * INV);
  double r = x - n * TWO_PI;
  double r2 = r * r, term = 1.0, cs = 1.0, ss = 1.0;
#pragma unroll
  for (int k = 1; k <= 14; ++k) { term *= r2 * (-1.0 / (double)((2 * k - 1) * (2 * k))); cs += term; }
  term = 1.0;
#pragma unroll
  for (int k = 1; k <= 14; ++k) { term *= r2 * (-1.0 / (double)((2 * k) * (2 * k + 1))); ss += term; }
  s = r * ss; c = cs;
}
DI int next_item(unsigned* cnt, int* s_item) {
  __syncthreads();
  if (TID() == 0) *s_item = (int)atomicAdd(cnt, 1u);
  __syncthreads();
  return *s_item;
}
DI int next_tile_xcd(unsigned* cnt8, int n_per_xcd, int xcd, int* s_item) {
  asm volatile("" : "+s"(xcd));
  __syncthreads();
  if (threadIdx.x == 0) {
    int res = -1;
    for (int a = 0; a < 8; ++a) {
      int qq = (xcd + a) & 7;
      unsigned v = atomicAdd(cnt8 + qq, 1u);
      if (v < (unsigned)n_per_xcd) { res = qq * n_per_xcd + (int)v; break; }
    }
    *s_item = res;
  }
  __syncthreads();
  return *s_item;
}
DI void tile_from_q(int it, int numN, int& mt, int& nt) {
  const int per = 32 * numN, q = it / per, i = it % per, g = i / (8 * numN), rem = i % (8 * numN);
  nt = rem >> 3; mt = 32 * q + 8 * g + (rem & 7);
}
DI int proj_src_col(int pc) {
  if (pc < 640) return pc;
  if (pc < 1664) return pc + 12;
  if (pc < 2688) return pc + 20;
  if (pc < 2700) return pc - 2688 + 640;
  if (pc < 2708) return pc - 2700 + 1676;
  return pc;
}

DI uint4 addpos8(uint4 v, const float* pp) {
  uint4 o;
  o.x = pk2(bf2f((u16)(v.x & 0xffff)) + pp[0], bf2f((u16)(v.x >> 16)) + pp[1]);
  o.y = pk2(bf2f((u16)(v.y & 0xffff)) + pp[2], bf2f((u16)(v.y >> 16)) + pp[3]);
  o.z = pk2(bf2f((u16)(v.z & 0xffff)) + pp[4], bf2f((u16)(v.z >> 16)) + pp[5]);
  o.w = pk2(bf2f((u16)(v.w & 0xffff)) + pp[6], bf2f((u16)(v.w >> 16)) + pp[7]);
  return o;
}
template <int NTW>
DI void gemm2(f32x4 (&acc)[4][NTW], const u16* __restrict__ arow, long a_kstep, const float* __restrict__ apos,
              const u16* __restrict__ brow, int K, u16* sA, u16* sB) {
  constexpr int BN = 32 * NTW, BV = BN / 32, LS = 80;
  const int tid = TID(), lane = tid & 63, w = tid >> 6, r16 = lane & 15, quad = lane >> 4;
  const int wm = w >> 1, wn = w & 1;
  u16* sa_st = sA + (tid >> 1) * LS + (tid & 1) * 32;
  u16* sb_st = (BN == 128) ? (sB + (tid >> 1) * LS + (tid & 1) * 32) : (sB + (tid >> 2) * LS + (tid & 3) * 16);
  uint4 pa0, pa1, pa2, pa3, pb0, pb1, pb2, pb3;
  uint4 qa0, qa1, qa2, qa3, qb0, qb1, qb2, qb3;
  pb2 = make_uint4(0, 0, 0, 0); pb3 = pb2; qb2 = pb2; qb3 = pb2;
#define G2_LOAD(KT, a0, a1, a2, a3, b0, b1, b2, b3) { const uint4* pa_ = (const uint4*)(arow + (long)(KT) * a_kstep); \
    a0 = pa_[0]; a1 = pa_[1]; a2 = pa_[2]; a3 = pa_[3]; \
    if (apos) { const float* pp_ = apos + (KT) * 64 + (tid & 1) * 32; \
      a0 = addpos8(a0, pp_); a1 = addpos8(a1, pp_ + 8); a2 = addpos8(a2, pp_ + 16); a3 = addpos8(a3, pp_ + 24); } \
    const uint4* pb_ = (const uint4*)(brow + (long)(KT) * 64); \
    b0 = pb_[0]; b1 = pb_[1]; if (BV == 4) { b2 = pb_[2]; b3 = pb_[3]; } }
#define G2_STORE(a0, a1, a2, a3, b0, b1, b2, b3) { \
    ((uint4*)sa_st)[0] = a0; ((uint4*)sa_st)[1] = a1; ((uint4*)sa_st)[2] = a2; ((uint4*)sa_st)[3] = a3; \
    ((uint4*)sb_st)[0] = b0; ((uint4*)sb_st)[1] = b1; if (BV == 4) { ((uint4*)sb_st)[2] = b2; ((uint4*)sb_st)[3] = b3; } }
#define G2_COMPUTE() { _Pragma("unroll") for (int ks = 0; ks < 2; ++ks) { \
      bf16x8 af[4], bg[NTW]; \
      _Pragma("unroll") for (int mi = 0; mi < 4; ++mi) af[mi] = *(const bf16x8*)(sA + (wm * 64 + 16 * mi + r16) * LS + ks * 32 + quad * 8); \
      _Pragma("unroll") for (int ni = 0; ni < NTW; ++ni) bg[ni] = *(const bf16x8*)(sB + (wn * (BN / 2) + 16 * ni + r16) * LS + ks * 32 + quad * 8); \
      _Pragma("unroll") for (int mi = 0; mi < 4; ++mi) \
        _Pragma("unroll") for (int ni = 0; ni < NTW; ++ni) acc[mi][ni] = __builtin_amdgcn_mfma_f32_16x16x32_bf16(af[mi], bg[ni], acc[mi][ni], 0, 0, 0); } }
#pragma unroll
  for (int mi = 0; mi < 4; ++mi)
#pragma unroll
    for (int ni = 0; ni < NTW; ++ni) acc[mi][ni] = (f32x4){0.f, 0.f, 0.f, 0.f};
  const int nk = K >> 6;
  G2_LOAD(0, pa0, pa1, pa2, pa3, pb0, pb1, pb2, pb3)
  G2_LOAD(1, qa0, qa1, qa2, qa3, qb0, qb1, qb2, qb3)
#pragma unroll 1
  for (int kt = 0; kt < nk; kt += 2) {
    __syncthreads();
    G2_STORE(pa0, pa1, pa2, pa3, pb0, pb1, pb2, pb3)
    __syncthreads();
    if (kt + 2 < nk) G2_LOAD(kt + 2, pa0, pa1, pa2, pa3, pb0, pb1, pb2, pb3)
    G2_COMPUTE()
    __syncthreads();
    G2_STORE(qa0, qa1, qa2, qa3, qb0, qb1, qb2, qb3)
    __syncthreads();
    if (kt + 3 < nk) G2_LOAD(kt + 3, qa0, qa1, qa2, qa3, qb0, qb1, qb2, qb3)
    G2_COMPUTE()
  }
#undef G2_LOAD
#undef G2_STORE
#undef G2_COMPUTE
}
DI void g3_rowpiece(int tid, int q, bool n64, int& row, int& pc) {
  const int w = tid >> 6, lane = tid & 63, chunk = n64 ? (2 * w + q) : (4 * w + q);
  row = 8 * chunk + (lane >> 3);
  pc = (lane & 7) ^ ((row >> 1) & 7);
}
DI const u16* g3_ptr(const u16* base, long ld, int tid, int q, bool n64) {
  int row, pc; g3_rowpiece(tid, q, n64, row, pc);
  return base + (long)row * ld + pc * 8;
}
template <int NTW, bool LEAN = false>
DI void gemm3(f32x4 (&acc)[4][NTW], const u16* ap0, const u16* ap1, const u16* ap2, const u16* ap3, long a_kstep,
              const u16* bp0, const u16* bp1, const u16* bp2, const u16* bp3, int K, u16* sbase, long a16 = 0, long b16 = 0) {
  constexpr int BN = 32 * NTW, STAGE = 16384;
  const int tid = TID(), lane = tid & 63, w = tid >> 6, r16 = lane & 15, quad = lane >> 4;
  const int wm = w >> 1, wn = w & 1;
  const int sz = (r16 >> 1) & 7;
  const int wu = __builtin_amdgcn_readfirstlane(w);
#define G3_GLDS(GP, LOFF) asm volatile("s_mov_b32 m0, %1\n\ts_nop 0\n\tglobal_load_lds_dwordx4 %0, off" :: "v"(GP), "s"(LOFF) : "memory", "m0")
  const unsigned lds0 = (unsigned)(size_t)sbase;
#define G3_ISSUE(KT) { const unsigned st_ = lds0 + (((KT) & 1) ? STAGE * 2 : 0); const long ka_ = (long)(KT) * a_kstep, kb_ = (long)(KT) * 64; \
    if (BN == 128) { \
      const unsigned la_ = __builtin_amdgcn_readfirstlane(st_ + wu * 4096u); \
      G3_GLDS(ap0 + ka_, la_); G3_GLDS(ap1 + ka_, la_ + 1024u); \
      if (a16) { G3_GLDS(ap0 + (ka_ + a16), la_ + 2048u); G3_GLDS(ap1 + (ka_ + a16), la_ + 3072u); } else { G3_GLDS(ap2 + ka_, la_ + 2048u); G3_GLDS(ap3 + ka_, la_ + 3072u); } \
      G3_GLDS(bp0 + kb_, la_ + 16384u); G3_GLDS(bp1 + kb_, la_ + 17408u); \
      if (b16) { G3_GLDS(bp0 + (kb_ + b16), la_ + 18432u); G3_GLDS(bp1 + (kb_ + b16), la_ + 19456u); } else { G3_GLDS(bp2 + kb_, la_ + 18432u); G3_GLDS(bp3 + kb_, la_ + 19456u); } \
    } else { \
      const unsigned la_ = __builtin_amdgcn_readfirstlane(st_ + wu * 4096u); \
      const unsigned lb_ = __builtin_amdgcn_readfirstlane(st_ + 16384u + wu * 2048u); \
      G3_GLDS(ap0 + ka_, la_); G3_GLDS(ap1 + ka_, la_ + 1024u); G3_GLDS(ap2 + ka_, la_ + 2048u); G3_GLDS(ap3 + ka_, la_ + 3072u); \
      G3_GLDS(bp0 + kb_, lb_); G3_GLDS(bp1 + kb_, lb_ + 1024u); \
    } }
#pragma unroll
  for (int mi = 0; mi < 4; ++mi)
#pragma unroll
    for (int ni = 0; ni < NTW; ++ni) acc[mi][ni] = (f32x4){0.f, 0.f, 0.f, 0.f};
  const int nk = K >> 6;
  __syncthreads();
  G3_ISSUE(0)
  if (!LEAN && BN == 128) {
#define G3_PIECE(I, KT) { const unsigned st_ = lds0 + (((KT) & 1) ? STAGE * 2 : 0); const long ka_ = (long)(KT) * a_kstep, kb_ = (long)(KT) * 64; \
      const unsigned la_ = __builtin_amdgcn_readfirstlane(st_ + wu * 4096u); \
      if ((I) == 0) G3_GLDS(ap0 + ka_, la_); else if ((I) == 1) G3_GLDS(ap1 + ka_, la_ + 1024u); \
      else if ((I) == 2) G3_GLDS((a16 ? ap0 + a16 : ap2) + ka_, la_ + 2048u); else if ((I) == 3) G3_GLDS((a16 ? ap1 + a16 : ap3) + ka_, la_ + 3072u); \
      else if ((I) == 4) G3_GLDS(bp0 + kb_, la_ + 16384u); else if ((I) == 5) G3_GLDS(bp1 + kb_, la_ + 17408u); \
      else if ((I) == 6) G3_GLDS((b16 ? bp0 + b16 : bp2) + kb_, la_ + 18432u); else G3_GLDS((b16 ? bp1 + b16 : bp3) + kb_, la_ + 19456u); }
#define G3_STEP(KT, DOISSUE) { const u16* sAs = sbase + ((KT) & 1) * STAGE; const u16* sBs = sAs + 8192; \
      bf16x8 af[2][4], bg[2][NTW];     \
      _Pragma("unroll") for (int ks = 0; ks < 2; ++ks) { \
        const int pcol = ((ks * 4 + quad) ^ sz) * 8; \
        _Pragma("unroll") for (int mi = 0; mi < 4; ++mi) af[ks][mi] = *(const bf16x8*)(sAs + (wm * 64 + 16 * mi + r16) * 64 + pcol); \
        _Pragma("unroll") for (int ni = 0; ni < NTW; ++ni) bg[ks][ni] = *(const bf16x8*)(sBs + (wn * (BN / 2) + 16 * ni + r16) * 64 + pcol); } \
      __builtin_amdgcn_s_setprio(1);     \
      _Pragma("unroll") for (int mi = 0; mi < 4; ++mi) {   \
        acc[mi][0] = __builtin_amdgcn_mfma_f32_16x16x32_bf16(af[0][mi], bg[0][0], acc[mi][0], 0, 0, 0); \
        acc[mi][1] = __builtin_amdgcn_mfma_f32_16x16x32_bf16(af[0][mi], bg[0][1], acc[mi][1], 0, 0, 0); \
        if (DOISSUE) G3_PIECE(2 * mi, (KT) + 1) \
        __builtin_amdgcn_sched_barrier(0); \
        acc[mi][2] = __builtin_amdgcn_mfma_f32_16x16x32_bf16(af[0][mi], bg[0][2], acc[mi][2], 0, 0, 0); \
        acc[mi][3] = __builtin_amdgcn_mfma_f32_16x16x32_bf16(af[0][mi], bg[0][3], acc[mi][3], 0, 0, 0); \
        if (DOISSUE) G3_PIECE(2 * mi + 1, (KT) + 1) \
        __builtin_amdgcn_sched_barrier(0); } \
      _Pragma("unroll") for (int mi = 0; mi < 4; ++mi) \
        _Pragma("unroll") for (int ni = 0; ni < NTW; ++ni) acc[mi][ni] = __builtin_amdgcn_mfma_f32_16x16x32_bf16(af[1][mi], bg[1][ni], acc[mi][ni], 0, 0, 0); \
      __builtin_amdgcn_s_setprio(0); }
#pragma unroll 1
    for (int kt = 0; kt < nk - 1; ++kt) {
      asm volatile("s_waitcnt vmcnt(0) lgkmcnt(0)" ::: "memory");
      __builtin_amdgcn_s_barrier();
      asm volatile("" ::: "memory");
      G3_STEP(kt, true)
    }
    asm volatile("s_waitcnt vmcnt(0) lgkmcnt(0)" ::: "memory");
    __builtin_amdgcn_s_barrier();
    asm volatile("" ::: "memory");
    G3_STEP(nk - 1, false)
#undef G3_PIECE
#undef G3_STEP
  } else
#pragma unroll 1
  for (int kt = 0; kt < nk; ++kt) {
    asm volatile("s_waitcnt vmcnt(0) lgkmcnt(0)" ::: "memory");
    __builtin_amdgcn_s_barrier();
    asm volatile("" ::: "memory");
    if (kt + 1 < nk) G3_ISSUE(kt + 1)
    const u16* sAs = sbase + (kt & 1) * STAGE;
    const u16* sBs = sAs + 8192;
#pragma unroll 1
    for (int ks = 0; ks < (LEAN ? 2 : 0); ++ks) {
      const int pcol = ((ks * 4 + quad) ^ sz) * 8;
      bf16x8 af[4];
#pragma unroll
      for (int mi = 0; mi < 4; ++mi) af[mi] = *(const bf16x8*)(sAs + (wm * 64 + 16 * mi + r16) * 64 + pcol);
#pragma unroll
      for (int ni = 0; ni < NTW; ++ni) {
        bf16x8 b1 = *(const bf16x8*)(sBs + (wn * (BN / 2) + 16 * ni + r16) * 64 + pcol);
#pragma unroll
        for (int mi = 0; mi < 4; ++mi) acc[mi][ni] = __builtin_amdgcn_mfma_f32_16x16x32_bf16(af[mi], b1, acc[mi][ni], 0, 0, 0);
      }
    }
#pragma unroll
    for (int ks = 0; ks < (LEAN ? 0 : 2); ++ks) {
      const int pcol = ((ks * 4 + quad) ^ sz) * 8;
      bf16x8 af[4], bg[NTW];
#pragma unroll
      for (int mi = 0; mi < 4; ++mi) af[mi] = *(const bf16x8*)(sAs + (wm * 64 + 16 * mi + r16) * 64 + pcol);
#pragma unroll
      for (int ni = 0; ni < NTW; ++ni) bg[ni] = *(const bf16x8*)(sBs + (wn * (BN / 2) + 16 * ni + r16) * 64 + pcol);
#pragma unroll
      for (int mi = 0; mi < 4; ++mi)
#pragma unroll
        for (int ni = 0; ni < NTW; ++ni) acc[mi][ni] = __builtin_amdgcn_mfma_f32_16x16x32_bf16(af[mi], bg[ni], acc[mi][ni], 0, 0, 0);
    }
  }
#undef G3_ISSUE
#undef G3_GLDS
}
template <int NCOLS>
DI void store_tile_bf16(const u16* sC, u16* gdst, long ld, int rows_valid) {
  constexpr int CPR = NCOLS / 8, LS = NCOLS + 8;
  const int tid = TID();
#pragma unroll
  for (int q = 0; q < (128 * CPR) / 256; ++q) {
    const int c = tid + 256 * q, row = c / CPR, ch = c % CPR;
    if (row < rows_valid) *(uint4*)(gdst + (long)row * ld + ch * 8) = *(const uint4*)(sC + row * LS + ch * 8);
  }
}
DI int pair_col(int np, int& which) {
  const int nt = np >> 7, c = np & 127, wn = c >> 6, ni = (c >> 4) & 3, r = c & 15;
  which = ni >> 1;
  return nt * 64 + wn * 32 + (ni & 1) * 16 + r;
}
DI const float* conv_colptr(const Params& P, int l, int mat, int np, long& ld) {
  int which;
  switch (mat) {
    case 0: ld = DIN; return P.in[3] + (long)l * DM * DIN + proj_src_col(np);
    case 1: ld = DIN; return P.in[3] + (long)l * DM * DIN + 2708 + np;
    case 2: ld = DM; return P.in[24] + ((long)(l * 4 + (np >> 10)) * 256) * DM + (np & 1023);
    case 3: ld = DM; return P.in[25] + (long)l * DM * DM + np;
    case 4: { int o = pair_col(np, which); ld = DFF; return (which ? P.in[28] : P.in[27]) + (long)l * DM * DFF + o; }
    case 5: ld = DM; return P.in[29] + (long)l * DFF * DM + np;
    case 6: { int o = pair_col(np, which); ld = 512; return P.in[19] + (long)l * 256 * 512 + which * 256 + o; }
    case 7: ld = 256; return P.in[(np >> 8) ? 9 : 7] + (long)l * 2048 * 256 + (np & 255);
    default: ld = 64; return P.in[(np >> 6) ? 10 : 8] + (long)l * 256 * 64 + (np & 63);
  }
}
DI void phase_convert(const Params& P, int l, float* lds) {
  const int tid = TID();
  if (blockIdx.x < 64) {
    const int kv = blockIdx.x >> 5, ks = blockIdx.x & 31;
    const float* pos = P.in[6] + (long)(l * 2 + kv) * 2048 + ks * 64;
    const float* w1 = P.in[kv ? 9 : 7] + (long)l * 2048 * 256 + (long)ks * 64 * 256 + tid;
    float a = 0.f;
#pragma unroll 8
    for (int k = 0; k < 64; ++k) a += pos[k] * w1[(long)k * 256];
    ((float*)(WSP(P) + WS_CBIAS))[(kv * 32 + ks) * 256 + tid] = a;
  }
  const int NB_[9] = {44, 64, 64, 16, 88, 16, 8, 8, 2};
  const int KB_[9] = {16, 16, 4, 16, 16, 44, 4, 32, 4};
  const size_t OFF_[9] = {WT_IN, WT_G, WT_BR, WT_OUT, WT_GU, WT_D, WT_GLU, WT_C1, WT_C2};
  for (int it = blockIdx.x; it < 4648; it += gridDim.x) {
    int r = it, mat = 0, nbk = 0, kbk = 0; size_t off = 0;
#pragma unroll
    for (int q = 0; q < 9; ++q) { int n = NB_[q] * KB_[q]; if (r >= 0 && r < n) { mat = q; nbk = NB_[q]; kbk = KB_[q]; off = OFF_[q]; r -= 100000; } else if (r >= 0) r -= n; }
    r += 100000;
    const int nb = r / kbk, kb = r % kbk, K = kbk * 64;
    (void)nbk;
    __syncthreads();
    {
      const int n = tid & 63;
      long ld; const float* cp = conv_colptr(P, l, mat, nb * 64 + n, ld);
#pragma unroll 4
      for (int q = 0; q < 16; ++q) { int k = (tid >> 6) + 4 * q; lds[n * 65 + k] = cp[(long)(kb * 64 + k) * ld]; }
    }
    __syncthreads();
    u16* dst = (u16*)(WSP(P) + WS_W + off);
#pragma unroll
    for (int q = 0; q < 2; ++q) {
      int c = tid + 256 * q, n = c >> 3, k8 = (c & 7) * 8;
      const float* sp = lds + n * 65 + k8;
      uint4 v; v.x = pk2(sp[0], sp[1]); v.y = pk2(sp[2], sp[3]); v.z = pk2(sp[4], sp[5]); v.w = pk2(sp[6], sp[7]);
      *(uint4*)(dst + (long)(nb * 64 + n) * K + kb * 64 + k8) = v;
    }
  }
}

DI void st_mma(f32x4 (&st)[4], const u16* sK, const bf16x8 (&bq)[2], int lane) {
  const int r = lane & 15, quad = lane >> 4;
#pragma unroll
  for (int mt = 0; mt < 4; ++mt) {
    f32x4 a = {0.f, 0.f, 0.f, 0.f};
#pragma unroll
    for (int ks = 0; ks < 2; ++ks) {
      bf16x8 kf = *(const bf16x8*)(sK + (16 * mt + r) * 72 + ks * 32 + quad * 8);
      a = __builtin_amdgcn_mfma_f32_16x16x32_bf16(kf, bq[ks], a, 0, 0, 0);
    }
    st[mt] = a;
  }
}
DI void pv_mma(f32x4 (&ot)[4], const u16* sVt, const f32x4 (&p)[4], int lane) {
  const int r = lane & 15, quad = lane >> 4;
#pragma unroll
  for (int ks = 0; ks < 2; ++ks) {
    uint4 pu;
    pu.x = pk2(p[2 * ks][0], p[2 * ks][1]); pu.y = pk2(p[2 * ks][2], p[2 * ks][3]);
    pu.z = pk2(p[2 * ks + 1][0], p[2 * ks + 1][1]); pu.w = pk2(p[2 * ks + 1][2], p[2 * ks + 1][3]);
    bf16x8 pb = __builtin_bit_cast(bf16x8, pu);
#pragma unroll
    for (int dt = 0; dt < 4; ++dt) {
      const u16* vrow = sVt + (16 * dt + r) * 72;
      s16x4 lo = *(const s16x4*)(vrow + ((32 * ks + 4 * quad) ^ (16 * dt)));
      s16x4 hi = *(const s16x4*)(vrow + ((32 * ks + 16 + 4 * quad) ^ (16 * dt)));
      bf16x8 vf = __builtin_shufflevector(lo, hi, 0, 1, 2, 3, 4, 5, 6, 7);
      ot[dt] = __builtin_amdgcn_mfma_f32_16x16x32_bf16(vf, pb, ot[dt], 0, 0, 0);
    }
  }
}
DI void load_tile(u16* dst, const u16* src, long ld) {
  const int tid = TID();
#pragma unroll
  for (int i = 0; i < 2; ++i) {
    int c = tid + 256 * i, row = c >> 3, ch = c & 7;
    uint4 v = *(const uint4*)(src + (long)row * ld + ch * 8);
    *(uint4*)(dst + row * 72 + ch * 8) = v;
  }
}
DI void load_tile_T(u16* dst, const u16* src, long ld) {
  const int tid = TID();
#pragma unroll
  for (int i = 0; i < 2; ++i) {
    int c = tid + 256 * i, row = c >> 3, ch = c & 7;
    uint4 v = *(const uint4*)(src + (long)row * ld + ch * 8);
    const unsigned* vv = (const unsigned*)&v;
#pragma unroll
    for (int q = 0; q < 4; ++q) {
      dst[(ch * 8 + 2 * q) * 72 + row] = (u16)(vv[q] & 0xffff);
      dst[(ch * 8 + 2 * q + 1) * 72 + row] = (u16)(vv[q] >> 16);
    }
  }
}
DI void load_q_nsa(u16* dst, const u16* src, long ld) {
  const int tid = TID();
#pragma unroll
  for (int i = 0; i < 2; ++i) {
    int c = tid + 256 * i, row = c >> 3, ch = c & 7;
    uint4 v = *(const uint4*)(src + (long)(row & 15) * ld + (row >> 4) * 64 + ch * 8);
    *(uint4*)(dst + row * 72 + ch * 8) = v;
  }
}
DI void load_qfrag(bf16x8 (&bq)[2], const u16* sQ, int w, int lane) {
  const int r = lane & 15, quad = lane >> 4;
  bq[0] = *(const bf16x8*)(sQ + (16 * w + r) * 72 + quad * 8);
  bq[1] = *(const bf16x8*)(sQ + (16 * w + r) * 72 + 32 + quad * 8);
}
DI float quad_max(float v) { v = fmaxf(v, __shfl_xor(v, 16)); v = fmaxf(v, __shfl_xor(v, 32)); return v; }
DI float quad_sum(float v) { v += __shfl_xor(v, 16); v += __shfl_xor(v, 32); return v; }

DI void softmax_tile(f32x4 (&st)[4], const bool (&msk)[4][4], float& m, float& l, f32x4 (&ot)[4]) {
  float tm = -1e30f;
#pragma unroll
  for (int mt = 0; mt < 4; ++mt)
#pragma unroll
    for (int j = 0; j < 4; ++j) { float s = st[mt][j] * 0.125f; st[mt][j] = s; if (msk[mt][j]) tm = fmaxf(tm, s); }
  tm = quad_max(tm);
  float mn = fmaxf(m, tm);
  float alpha = __expf(m - mn);
  float ps = 0.f;
#pragma unroll
  for (int mt = 0; mt < 4; ++mt)
#pragma unroll
    for (int j = 0; j < 4; ++j) { float p = msk[mt][j] ? __expf(st[mt][j] - mn) : 0.f; st[mt][j] = p; ps += p; }
  l = l * alpha + ps;
  m = mn;
#pragma unroll
  for (int dt = 0; dt < 4; ++dt)
#pragma unroll
    for (int j = 0; j < 4; ++j) ot[dt][j] *= alpha;
}

DI void phase_rmsnorm(const float* __restrict__ x, const float* __restrict__ wgt, u16* __restrict__ H) {
  const int lane = TID() & 63, w = TID() >> 6;
  const int gw = blockIdx.x * 4 + w, nw = gridDim.x * 4;
  for (int row = gw; row < T_; row += nw) {
    const float4* xr = (const float4*)(x + (long)row * DM);
    float4 v[4]; float s = 0.f;
#pragma unroll
    for (int j = 0; j < 4; ++j) { v[j] = xr[lane + 64 * j]; s += v[j].x * v[j].x + v[j].y * v[j].y + v[j].z * v[j].z + v[j].w * v[j].w; }
    s = wave_sum(s);
    float r = rsqrtf(s * (1.f / DM) + EPS);
#pragma unroll
    for (int j = 0; j < 4; ++j) {
      float4 g = ((const float4*)wgt)[lane + 64 * j];
      uint2 o; o.x = pk2(v[j].x * r * g.x, v[j].y * r * g.y); o.y = pk2(v[j].z * r * g.z, v[j].w * r * g.w);
      *(uint2*)(H + (long)row * DM + (lane + 64 * j) * 4) = o;
    }
  }
}
DI void phase_rope_table(const int* __restrict__ positions, float* __restrict__ COS, float* __restrict__ SIN) {
  const float invf[8] = {1.0f, 0.1939227432012558f, 0.03760603070259094f, 0.007292664609849453f,
                         0.0014142135623842478f, 0.00027424818836152554f, 5.3182957344688475e-05f, 1.0313385246263351e-05f};
  for (int idx = blockIdx.x * 256 + TID(); idx < T_ * 8; idx += gridDim.x * 256) {
    int i = idx & 7;
    float f = invf[0];
#pragma unroll
    for (int q = 1; q < 8; ++q) f = (i == q) ? invf[q] : f;
    float ang = (float)positions[idx >> 3] * f;
    double s, c; sincos_d((double)ang, s, c);
    COS[idx] = (float)c; SIN[idx] = (float)s;
  }
}

struct S5Coef { float ar, ai; float bbr[16], bbi[16]; };
DI void s5_coef(const Params& P, int l, int g, int p, S5Coef& C) {
  float dt = expf(P.in[13][l * 16 + g]);
  float lr = P.in[11][(l * 16 + g) * 64 + p], li = P.in[12][(l * 16 + g) * 64 + p];
  float mag = expf(lr * dt);
  double s, c; sincos_d((double)(li * dt), s, c);
  C.ar = mag * (float)c; C.ai = mag * (float)s;
  float den = lr * lr + li * li;
  float fr = ((C.ar - 1.f) * lr + C.ai * li) / den;
  float fi = (C.ai * lr - (C.ar - 1.f) * li) / den;
  const float* br = P.in[14] + ((long)(l * 16 + g) * 64 + p) * 16;
  const float* bi = P.in[15] + ((long)(l * 16 + g) * 64 + p) * 16;
#pragma unroll
  for (int c2 = 0; c2 < 16; ++c2) {
    float b_r = br[c2], b_i = bi[c2];
    C.bbr[c2] = fr * b_r - fi * b_i;
    C.bbi[c2] = fr * b_i + fi * b_r;
  }
}
DI void s5_load_u(float* su, const u16* PROJ, int b, int chunk, int g, int lane) {
  const u16* src = PROJ + ((long)(b * SEQ + chunk * 64 + lane)) * PW + P_S5U + g * 16;
  uint4 v0 = ((const uint4*)src)[0], v1 = ((const uint4*)src)[1];
  const unsigned* a = (const unsigned*)&v0; const unsigned* c = (const unsigned*)&v1;
  float* d = su + lane * 16;
#pragma unroll
  for (int q = 0; q < 4; ++q) { d[2 * q] = bf2f((u16)(a[q] & 0xffff)); d[2 * q + 1] = bf2f((u16)(a[q] >> 16)); }
#pragma unroll
  for (int q = 0; q < 4; ++q) { d[8 + 2 * q] = bf2f((u16)(c[q] & 0xffff)); d[8 + 2 * q + 1] = bf2f((u16)(c[q] >> 16)); }
}

DI void s5_pass1_item(const Params& P, int l, int it, float* lds) {
  const int lane = TID() & 63, w = TID() >> 6;
  const int gq = it & 3, chunk = (it >> 2) & 63, b = it >> 8;
  const int g = gq * 4 + w;
  const u16* PROJ = (const u16*)(WSP(P) + WS_PROJ);
  float* su = lds + w * 1024;
  S5Coef C; s5_coef(P, l, g, lane, C);
  s5_load_u(su, PROJ, b, chunk, g, lane);
  __syncthreads();
  float xr = 0.f, xi = 0.f;
#pragma unroll 4
  for (int t = 0; t < 64; ++t) {
    const f32x4* up = (const f32x4*)(su + t * 16);
    float br = 0.f, bi = 0.f;
#pragma unroll
    for (int q = 0; q < 4; ++q) {
      f32x4 u = up[q];
#pragma unroll
      for (int e = 0; e < 4; ++e) { br += u[e] * C.bbr[4 * q + e]; bi += u[e] * C.bbi[4 * q + e]; }
    }
    float nr = C.ar * xr - C.ai * xi + br;
    float ni = C.ar * xi + C.ai * xr + bi;
    xr = nr; xi = ni;
  }
  float2* ENDS = (float2*)(WSP(P) + WS_ENDS);
  ENDS[((long)(b * 64 + chunk) * 16 + g) * 64 + lane] = make_float2(xr, xi);
}

DI void s5_carry_item(const Params& P, int l, int it) {
  const int idx = it * 256 + TID();
  const int b = idx >> 10, gp = idx & 1023, g = gp >> 6, p = gp & 63;
  float dt = expf(P.in[13][l * 16 + g]);
  float lr = P.in[11][(l * 16 + g) * 64 + p], li = P.in[12][(l * 16 + g) * 64 + p];
  float mag = expf(lr * dt * 64.f);
  double s, c; sincos_d((double)(li * dt) * 64.0, s, c);
  float ar = mag * (float)c, ai = mag * (float)s;
  const float2* ENDS = (const float2*)(WSP(P) + WS_ENDS);
  float2* CARRY = (float2*)(WSP(P) + WS_CARRY);
  float xr = 0.f, xi = 0.f;
  for (int ch = 0; ch < 64; ++ch) {
    long o = ((long)(b * 64 + ch) * 16 + g) * 64 + p;
    CARRY[o] = make_float2(xr, xi);
    float2 e = ENDS[o];
    float nr = ar * xr - ai * xi + e.x;
    float ni = ar * xi + ai * xr + e.y;
    xr = nr; xi = ni;
  }
}

DI void s5_pass2_item(const Params& P, int l, int it, float* lds) {
  const int lane = TID() & 63, w = TID() >> 6, r16 = lane & 15, quad = lane >> 4;
  const int gq = it & 3, chunk = (it >> 2) & 63, b = it >> 8;
  const int g = gq * 4 + w;
  const u16* PROJ = (const u16*)(WSP(P) + WS_PROJ);
  u16* Y5 = (u16*)(WSP(P) + WS_Y5);
  float* su = lds + w * 1024;
  u16* sX = (u16*)(lds + 4096) + w * (32 * 136);
  S5Coef C; s5_coef(P, l, g, lane, C);
  bf16x8 bfr[4];
#pragma unroll
  for (int ks = 0; ks < 4; ++ks) {
    const float* src = P.in[(ks < 2) ? 16 : 17] + ((long)(l * 16 + g) * 16 + r16) * 64 + (ks & 1) * 32 + quad * 8;
    const float4 v0 = ((const float4*)src)[0], v1 = ((const float4*)src)[1];
    const float sg = (ks < 2) ? 1.f : -1.f;
    uint4 pu; pu.x = pk2(sg * v0.x, sg * v0.y); pu.y = pk2(sg * v0.z, sg * v0.w); pu.z = pk2(sg * v1.x, sg * v1.y); pu.w = pk2(sg * v1.z, sg * v1.w);
    bfr[ks] = __builtin_bit_cast(bf16x8, pu);
  }
  const float dsk = P.in[18][l * 256 + g * 16 + r16];
  s5_load_u(su, PROJ, b, chunk, g, lane);
  __syncthreads();
  const float2 c0 = ((const float2*)(WSP(P) + WS_CARRY))[((long)(b * 64 + chunk) * 16 + g) * 64 + lane];
  float xr = c0.x, xi = c0.y;
  for (int half = 0; half < 2; ++half) {
#pragma unroll 4
    for (int tt = 0; tt < 32; ++tt) {
      const int t = half * 32 + tt;
      const f32x4* up = (const f32x4*)(su + t * 16);
      float br0 = 0.f, bi0 = 0.f, br1 = 0.f, bi1 = 0.f;
#pragma unroll
      for (int q = 0; q < 4; ++q) {
        f32x4 u = up[q];
        br0 += u[0] * C.bbr[4 * q + 0]; bi0 += u[0] * C.bbi[4 * q + 0];
        br1 += u[1] * C.bbr[4 * q + 1]; bi1 += u[1] * C.bbi[4 * q + 1];
        br0 += u[2] * C.bbr[4 * q + 2]; bi0 += u[2] * C.bbi[4 * q + 2];
        br1 += u[3] * C.bbr[4 * q + 3]; bi1 += u[3] * C.bbi[4 * q + 3];
      }
      const float nr = C.ar * xr - C.ai * xi + (br0 + br1);
      const float ni = C.ar * xi + C.ai * xr + (bi0 + bi1);
      xr = nr; xi = ni;
      sX[tt * 136 + lane] = f2bf(xr);
      sX[tt * 136 + 64 + lane] = f2bf(xi);
    }
    __syncthreads();
#pragma unroll
    for (int mt = 0; mt < 2; ++mt) {
      f32x4 acc = {0.f, 0.f, 0.f, 0.f};
#pragma unroll
      for (int ks = 0; ks < 4; ++ks) {
        const bf16x8 af = *(const bf16x8*)(sX + (16 * mt + r16) * 136 + ks * 32 + quad * 8);
        acc = __builtin_amdgcn_mfma_f32_16x16x32_bf16(af, bfr[ks], acc, 0, 0, 0);
      }
#pragma unroll
      for (int j = 0; j < 4; ++j) {
        const int t = half * 32 + 16 * mt + 4 * quad + j;
        const float y = acc[j] + dsk * su[t * 16 + r16];
        Y5[((long)(b * SEQ + chunk * 64 + t)) * 256 + g * 16 + r16] = f2bf(gelu_tanh(y));
      }
    }
    __syncthreads();
  }
}

DI void nsa_prep_item(const Params& P, int l, int it) {
  const int lane = TID() & 63, w = TID() >> 6;
  u16* PROJ = (u16*)(WSP(P) + WS_PROJ);
  u16* QR = (u16*)(WSP(P) + WS_QR);
  const float* COS = (const float*)(WSP(P) + WS_COS);
  const float* SIN = (const float*)(WSP(P) + WS_SIN);
  for (int tt = 0; tt < 4; ++tt) {
    const long t = (long)it * 16 + w * 4 + tt;
    const float cs = COS[t * 8 + (lane & 7)], sn = SIN[t * 8 + (lane & 7)];
#pragma unroll
    for (int g = 0; g < 6; ++g) {
      const int col = (g < 4) ? (P_Q + g * 64) : (g == 4 ? P_KV + 128 : P_KV + 256);
      const float wg = (g < 4) ? P.in[4][l * 64 + lane] : P.in[5][(l * 3 + (g - 3)) * 64 + lane];
      u16* ptr = PROJ + t * PW + col + lane;
      float v = bf2f(*ptr);
      float ss = wave_sum(v * v);
      float y = v * rsqrtf(ss * (1.f / 64.f) + EPS) * wg;
      float pr = __shfl_xor(y, 8);
      float rot = (lane < 8) ? (y * cs - pr * sn) : ((lane < 16) ? (y * cs + pr * sn) : y);
      if (g < 4) { *ptr = f2bf(y); QR[t * 256 + g * 64 + lane] = f2bf(rot); }
      else *ptr = f2bf(rot);
    }
  }
}

DI void cmp1_tile(const Params& P, int l, int ct, u16* sA, u16* sB) {
  const int tid = TID(), lane = tid & 63, w = tid >> 6, r16 = lane & 15, quad = lane >> 4, wm = w >> 1, wn = w & 1;
  const int kv = ct >> 5, mt = (ct >> 1) & 15, nt = ct & 1;
  const u16* PROJ = (const u16*)(WSP(P) + WS_PROJ);
  u16* HID = (u16*)(WSP(P) + WS_HID);
  const u16* apq[4];
#pragma unroll
  for (int q = 0; q < 4; ++q) {
    int row, pc; g3_rowpiece(tid, q, false, row, pc);
    int gr = mt * 128 + row; if (gr > 2039) gr = 2039;
    const int b = gr / 255, n = gr % 255;
    apq[q] = PROJ + ((long)(b * SEQ + 16 * n)) * PW + P_KV + kv * 64 + pc * 8;
  }
  const u16* Bb = (const u16*)(WSP(P) + WS_W + WT_C1) + ((long)(kv * 256 + nt * 128)) * 2048;
  f32x4 acc[4][4];
  gemm3<4>(acc, apq[0], apq[1], apq[2], apq[3], PW,
           g3_ptr(Bb, 2048, tid, 0, false), g3_ptr(Bb, 2048, tid, 1, false), g3_ptr(Bb, 2048, tid, 2, false), g3_ptr(Bb, 2048, tid, 3, false), 2048, sA);
  {
    const float* PART = (const float*)(WSP(P) + WS_CBIAS) + (long)kv * 32 * 256;
#pragma unroll
    for (int ni = 0; ni < 4; ++ni) {
      const int col = nt * 128 + wn * 64 + 16 * ni + r16;
      float bsum = 0.f;
      for (int sl = 0; sl < 32; ++sl) bsum += PART[sl * 256 + col];
#pragma unroll
      for (int mi = 0; mi < 4; ++mi)
#pragma unroll
        for (int j = 0; j < 4; ++j) acc[mi][ni][j] += bsum;
    }
  }
  __syncthreads();
#pragma unroll
  for (int mi = 0; mi < 4; ++mi)
#pragma unroll
    for (int ni = 0; ni < 4; ++ni)
#pragma unroll
      for (int j = 0; j < 4; ++j) sA[(wm * 64 + 16 * mi + 4 * quad + j) * 136 + wn * 64 + 16 * ni + r16] = f2bf(gelu_tanh(acc[mi][ni][j]));
  __syncthreads();
  store_tile_bf16<128>(sA, HID + ((long)kv * 2048 + mt * 128) * 256 + nt * 128, 256, 2040 - mt * 128);
}
DI void cmp2_tile(const Params& P, int l, int ct, u16* sA, u16* sB, float* sSS) {
  const int tid = TID(), lane = tid & 63, w = tid >> 6, r16 = lane & 15, quad = lane >> 4, wm = w >> 1, wn = w & 1;
  const int kv = ct >> 4, mt = ct & 15;
  const u16* HID = (const u16*)(WSP(P) + WS_HID);
  u16* OUT = (u16*)(WSP(P) + (kv ? WS_VC : WS_KC));
  const u16* Ab = HID + ((long)kv * 2048 + mt * 128) * 256;
  const u16* Bb = (const u16*)(WSP(P) + WS_W + WT_C2) + (long)kv * 64 * 256;
  f32x4 acc[4][2];
  gemm3<2>(acc, g3_ptr(Ab, 256, tid, 0, false), g3_ptr(Ab, 256, tid, 1, false), g3_ptr(Ab, 256, tid, 2, false), g3_ptr(Ab, 256, tid, 3, false), 64,
           g3_ptr(Bb, 256, tid, 0, true), g3_ptr(Bb, 256, tid, 1, true), nullptr, nullptr, 256, sA);
  __syncthreads();
  if (tid < 128) sSS[tid] = 0.f;
  __syncthreads();
#pragma unroll
  for (int mi = 0; mi < 4; ++mi)
#pragma unroll
    for (int j = 0; j < 4; ++j) {
      float ss = acc[mi][0][j] * acc[mi][0][j] + acc[mi][1][j] * acc[mi][1][j];
      ss += __shfl_xor(ss, 1); ss += __shfl_xor(ss, 2); ss += __shfl_xor(ss, 4); ss += __shfl_xor(ss, 8);
      if (r16 == 0) atomicAdd(&sSS[wm * 64 + 16 * mi + 4 * quad + j], ss);
    }
  __syncthreads();
#pragma unroll
  for (int mi = 0; mi < 4; ++mi)
#pragma unroll
    for (int j = 0; j < 4; ++j) {
      const int rl = wm * 64 + 16 * mi + 4 * quad + j, row = mt * 128 + rl;
      const float sc = (kv == 0) ? rsqrtf(sSS[rl] * (1.f / 64.f) + EPS) : 1.f;
      if (row < 2040) {
        int b = row / 255, n = row % 255;
#pragma unroll
        for (int ni = 0; ni < 2; ++ni) {
          int col = wn * 32 + 16 * ni + r16;
          float v = acc[mi][ni][j] * sc;
          if (kv == 0) v *= P.in[5][(l * 3 + 0) * 64 + col];
          OUT[((long)(b * 256 + n)) * 64 + col] = f2bf(v);
        }
      }
    }
}

DI void gdn_p1_item(const Params& P, int l, int it, float* lds) {
  const int tid = TID(), lane = tid & 63, w = tid >> 6, r16 = lane & 15, quad = lane >> 4;
  const int chunk = it & 63, h = (it >> 6) & 3, b = it >> 8;
  const long ci = it;
  const u16* PROJ = (const u16*)(WSP(P) + WS_PROJ);
  float* sq = lds;
  float* sk = lds + 64 * 65;
  float* sv = lds + 2 * 64 * 65;
  float* sG = lds + 3 * 64 * 65;
  float* sBeta = sG + 64;
  float* sg = sBeta + 64;
  u16* sQb = (u16*)(sg + 64);
  u16* sKb = sQb + 64 * 72;
  const float* cw = P.in[20] + (long)l * 4 * 768;
  if (tid < 192) {
    const int cp = tid % 96, th = tid / 96;
    const int c0 = 2 * cp, which = c0 >> 6, d = c0 & 63, C = which * 256 + h * 64 + d;
    float w0[4], w1[4];
#pragma unroll
    for (int k = 0; k < 4; ++k) { w0[k] = cw[k * 768 + C]; w1[k] = cw[k * 768 + C + 1]; }
    unsigned v[35];
    const int s0 = chunk * 64 + th * 32 - 3;
    const u16* src = PROJ + ((long)(b * SEQ + s0)) * PW + P_GQKV + C;
#pragma unroll
    for (int k = 0; k < 35; ++k) v[k] = (s0 + k >= 0) ? *(const unsigned*)(src + (long)k * PW) : 0u;
    float* dst = lds + which * 64 * 65 + (th * 32) * 65 + d;
#pragma unroll
    for (int tt = 0; tt < 32; ++tt) {
      float a0 = 0.f, a1 = 0.f;
#pragma unroll
      for (int k = 0; k < 4; ++k) { a0 += w0[k] * bf2f((u16)(v[tt + k] & 0xffff)); a1 += w1[k] * bf2f((u16)(v[tt + k] >> 16)); }
      dst[tt * 65] = siluf_(a0); dst[tt * 65 + 1] = siluf_(a1);
    }
  }
  __syncthreads();
  if (tid < 128) {
    float* base = (tid < 64) ? sq : sk;
    u16* bb = (tid < 64) ? sQb : sKb;
    const int row = tid & 63;
    float ss = 0.f;
#pragma unroll 8
    for (int d = 0; d < 64; ++d) { float x = base[row * 65 + d]; ss += x * x; }
    const float sc = rsqrtf(ss + EPS) * ((tid < 64) ? 0.125f : 1.f);
#pragma unroll 8
    for (int d = 0; d < 64; d += 2) {
      const float x0 = base[row * 65 + d] * sc, x1 = base[row * 65 + d + 1] * sc;
      base[row * 65 + d] = x0; base[row * 65 + d + 1] = x1;
      *(unsigned*)(bb + row * 72 + d) = pk2(x0, x1);
    }
  } else if (tid < 192) {
    const int row = tid - 128;
    const long t = (long)(b * SEQ + chunk * 64 + row);
    const float bl = bf2f(PROJ[t * PW + P_GB + h]);
    const float al = bf2f(PROJ[t * PW + P_GA + h]);
    sBeta[row] = sigmoidf_(bl);
    sg[row] = -expf(P.in[21][l * 4 + h]) * softplusf_(al + P.in[22][l * 4 + h]);
  }
  __syncthreads();
  if (tid < 64) {
    float x = sg[tid];
#pragma unroll
    for (int o = 1; o < 64; o <<= 1) { float u = __shfl_up(x, o); if (tid >= o) x += u; }
    sG[tid] = x;
    ((float*)(WSP(P) + WS_GG))[ci * 64 + tid] = x;
  }
  __syncthreads();
  f32x4 lreg[4];
  {
    const f32x4 Gi4 = *(const f32x4*)(sG + 16 * w + 4 * quad);
    const f32x4 Bi4 = *(const f32x4*)(sBeta + 16 * w + 4 * quad);
    u16* GA = (u16*)(WSP(P) + WS_GA) + ci * 4096;
#pragma unroll
    for (int nt = 0; nt < 4; ++nt) {
      f32x4 aq = {0.f, 0.f, 0.f, 0.f}, ak = {0.f, 0.f, 0.f, 0.f};
#pragma unroll
      for (int ks = 0; ks < 2; ++ks) {
        const bf16x8 fq = *(const bf16x8*)(sQb + (16 * w + r16) * 72 + ks * 32 + quad * 8);
        const bf16x8 fk = *(const bf16x8*)(sKb + (16 * w + r16) * 72 + ks * 32 + quad * 8);
        const bf16x8 fb = *(const bf16x8*)(sKb + (16 * nt + r16) * 72 + ks * 32 + quad * 8);
        aq = __builtin_amdgcn_mfma_f32_16x16x32_bf16(fq, fb, aq, 0, 0, 0);
        ak = __builtin_amdgcn_mfma_f32_16x16x32_bf16(fk, fb, ak, 0, 0, 0);
      }
      const int j = 16 * nt + r16;
      const float Gj = sG[j];
#pragma unroll
      for (int jj = 0; jj < 4; ++jj) {
        const int i = 16 * w + 4 * quad + jj;
        const float dec = __expf(Gi4[jj] - Gj);
        GA[i * 64 + j] = f2bf((j <= i) ? aq[jj] * dec : 0.f);
        const float lv = (j < i) ? Bi4[jj] * ak[jj] * dec : 0.f;
        sq[i * 65 + j] = lv;
        lreg[nt][jj] = lv;
      }
    }
  }
  {
    u16* GQ = (u16*)(WSP(P) + WS_GQ) + ci * 4096;
#pragma unroll
    for (int q = 0; q < 2; ++q) { const int c = tid + 256 * q, row = c >> 3, ch = c & 7; *(uint4*)(GQ + row * 64 + ch * 8) = *(const uint4*)(sQb + row * 72 + ch * 8); }
    const int i = tid >> 2, j0 = (tid & 3) * 16;
    u16* GK = (u16*)(WSP(P) + WS_GK) + ci * 4096 + i * 64 + j0;
    unsigned ok[8];
#pragma unroll
    for (int q = 0; q < 8; ++q) ok[q] = pk2(sk[(j0 + 2 * q) * 65 + i], sk[(j0 + 2 * q + 1) * 65 + i]);
    ((uint4*)GK)[0] = make_uint4(ok[0], ok[1], ok[2], ok[3]); ((uint4*)GK)[1] = make_uint4(ok[4], ok[5], ok[6], ok[7]);
  }
  __syncthreads();
  u16* sLb = sQb;
  u16* sXT = sKb;
  {
    const int i = tid >> 2, j0 = (tid & 3) * 16;
    const float bi = sBeta[i], eg = __expf(sG[i]);
#pragma unroll
    for (int jj = 0; jj < 16; ++jj) { sv[i * 65 + j0 + jj] *= bi; sk[i * 65 + j0 + jj] *= bi * eg; }
#pragma unroll
    for (int nt = 0; nt < 4; ++nt)
#pragma unroll
      for (int jj = 0; jj < 4; ++jj) sLb[(16 * w + 4 * quad + jj) * 72 + 16 * nt + r16] = f2bf(lreg[nt][jj]);
  }
  __syncthreads();
#pragma unroll 1
  for (int bi = 0; bi < 4; ++bi) {
    if (tid < 128) {
      float* buf = (tid < 64) ? sv : sk;
      const int col = tid & 63;
      float x[16];
#pragma unroll
      for (int r = 0; r < 16; ++r) {
        float a0 = buf[(16 * bi + r) * 65 + col], a1 = 0.f;
#pragma unroll
        for (int j = 0; j + 1 < r; j += 2) { a0 -= sq[(16 * bi + r) * 65 + 16 * bi + j] * x[j]; a1 -= sq[(16 * bi + r) * 65 + 16 * bi + j + 1] * x[j + 1]; }
        if (r & 1) a0 -= sq[(16 * bi + r) * 65 + 16 * bi + r - 1] * x[r - 1];
        x[r] = a0 + a1;
        buf[(16 * bi + r) * 65 + col] = x[r];
      }
      uint4 p0, p1;
      p0.x = pk2(x[0], x[1]); p0.y = pk2(x[2], x[3]); p0.z = pk2(x[4], x[5]); p0.w = pk2(x[6], x[7]);
      p1.x = pk2(x[8], x[9]); p1.y = pk2(x[10], x[11]); p1.z = pk2(x[12], x[13]); p1.w = pk2(x[14], x[15]);
      *(uint4*)(sXT + tid * 24) = p0; *(uint4*)(sXT + tid * 24 + 8) = p1;
    }
    __syncthreads();
    if (bi < 3) {
#pragma unroll
      for (int q = 0; q < 2; ++q) {
        const int nt = 2 * w + q, colg = 16 * nt + r16;
        bf16x8 bx = *(const bf16x8*)(sXT + colg * 24 + (quad & 1) * 8);
        if (quad >= 2) bx = (bf16x8){0, 0, 0, 0, 0, 0, 0, 0};
        float* buf = (colg < 64) ? sv : sk;
        const int cc = colg & 63;
        for (int bk = bi + 1; bk < 4; ++bk) {
          const bf16x8 al = *(const bf16x8*)(sLb + (16 * bk + r16) * 72 + 16 * bi + quad * 8);
          f32x4 c = {0.f, 0.f, 0.f, 0.f};
          c = __builtin_amdgcn_mfma_f32_16x16x32_bf16(al, bx, c, 0, 0, 0);
#pragma unroll
          for (int jj = 0; jj < 4; ++jj) buf[(16 * bk + 4 * quad + jj) * 65 + cc] -= c[jj];
        }
      }
    }
    __syncthreads();
  }
  {
    const int i = tid >> 2, j0 = (tid & 3) * 16;
    u16* GU = (u16*)(WSP(P) + WS_GU) + ci * 4096 + i * 64 + j0;
    u16* GW = (u16*)(WSP(P) + WS_GW) + ci * 4096 + i * 64 + j0;
    unsigned ou[8], ow[8];
#pragma unroll
    for (int q = 0; q < 8; ++q) {
      ou[q] = pk2(sv[i * 65 + j0 + 2 * q], sv[i * 65 + j0 + 2 * q + 1]);
      ow[q] = pk2(sk[i * 65 + j0 + 2 * q], sk[i * 65 + j0 + 2 * q + 1]);
    }
    ((uint4*)GU)[0] = make_uint4(ou[0], ou[1], ou[2], ou[3]); ((uint4*)GU)[1] = make_uint4(ou[4], ou[5], ou[6], ou[7]);
    ((uint4*)GW)[0] = make_uint4(ow[0], ow[1], ow[2], ow[3]); ((uint4*)GW)[1] = make_uint4(ow[4], ow[5], ow[6], ow[7]);
  }
}

DI void unpack8(const u16* p, float (&o)[8]) {
  uint4 v = *(const uint4*)p;
  o[0] = bf2f((u16)(v.x & 0xffff)); o[1] = bf2f((u16)(v.x >> 16));
  o[2] = bf2f((u16)(v.y & 0xffff)); o[3] = bf2f((u16)(v.y >> 16));
  o[4] = bf2f((u16)(v.z & 0xffff)); o[5] = bf2f((u16)(v.z >> 16));
  o[6] = bf2f((u16)(v.w & 0xffff)); o[7] = bf2f((u16)(v.w >> 16));
}
DI void st_kt(u16* sKt, int c8, int row, uint4 k) {
  sKt[(c8 + 0) * 72 + row] = (u16)(k.x & 0xffff); sKt[(c8 + 1) * 72 + row] = (u16)(k.x >> 16);
  sKt[(c8 + 2) * 72 + row] = (u16)(k.y & 0xffff); sKt[(c8 + 3) * 72 + row] = (u16)(k.y >> 16);
  sKt[(c8 + 4) * 72 + row] = (u16)(k.z & 0xffff); sKt[(c8 + 5) * 72 + row] = (u16)(k.z >> 16);
  sKt[(c8 + 6) * 72 + row] = (u16)(k.w & 0xffff); sKt[(c8 + 7) * 72 + row] = (u16)(k.w >> 16);
}
DI uint2 pack4bf(const f32x4& v) { uint2 r; r.x = pk2(v[0], v[1]); r.y = pk2(v[2], v[3]); return r; }
DI void gdn_p2_item(const Params& P, int it, float* lds) {
  const int tid = TID(), lane = tid & 63, w = tid >> 6, r16 = lane & 15, quad = lane >> 4;
  const int es = it & 3, bh = it >> 2, b = bh >> 2, h = bh & 3;
  u16* sW = (u16*)lds;
  u16* sQ = sW + 64 * 72;
  u16* sAm = sQ + 64 * 72;
  u16* sKt = sAm + 64 * 72;
  u16* sSt = sKt + 64 * 72;
  u16* sVnT = sSt + 16 * 72;
  u16* sVdT = sVnT + 16 * 72;
  float* sG = (float*)(sVdT + 16 * 72);
  const u16* GQ = (const u16*)(WSP(P) + WS_GQ); const u16* GK = (const u16*)(WSP(P) + WS_GK);
  const u16* GU = (const u16*)(WSP(P) + WS_GU); const u16* GW = (const u16*)(WSP(P) + WS_GW);
  const u16* GA = (const u16*)(WSP(P) + WS_GA); const float* GG = (const float*)(WSP(P) + WS_GG);
  u16* ORAW = (u16*)(WSP(P) + WS_OM) + (long)2 * T_ * 256;
  f32x4 S = {0.f, 0.f, 0.f, 0.f};
  const int irow = 16 * w + 4 * quad;
  uint4 rw0, rw1, rq0, rq1, ra0, ra1, rk0, rk1; u16 ru0, ru1, ru2, ru3; float rg = 0.f;
  const int c0 = tid, c1 = tid + 256;
  const long off0 = (c0 >> 3) * 64 + (c0 & 7) * 8, off1 = (c1 >> 3) * 64 + (c1 & 7) * 8;
#define GDN_GLOAD(CH) { long ci_ = (long)bh * 64 + (CH); \
    rw0 = *(const uint4*)(GW + ci_ * 4096 + off0); rw1 = *(const uint4*)(GW + ci_ * 4096 + off1); \
    rq0 = *(const uint4*)(GQ + ci_ * 4096 + off0); rq1 = *(const uint4*)(GQ + ci_ * 4096 + off1); \
    ra0 = *(const uint4*)(GA + ci_ * 4096 + off0); ra1 = *(const uint4*)(GA + ci_ * 4096 + off1); \
    rk0 = *(const uint4*)(GK + ci_ * 4096 + off0); rk1 = *(const uint4*)(GK + ci_ * 4096 + off1); \
    const u16* up_ = GU + ci_ * 4096 + irow * 64 + es * 16 + r16; \
    ru0 = up_[0]; ru1 = up_[64]; ru2 = up_[128]; ru3 = up_[192]; \
    if (tid < 64) rg = GG[ci_ * 64 + tid]; }
  GDN_GLOAD(0)
  for (int ch = 0; ch < 64; ++ch) {
    __syncthreads();
    {
      const int row0 = c0 >> 3, c80 = (c0 & 7) * 8, row1 = c1 >> 3, c81 = (c1 & 7) * 8;
      *(uint4*)(sW + row0 * 72 + c80) = rw0; *(uint4*)(sW + row1 * 72 + c81) = rw1;
      *(uint4*)(sQ + row0 * 72 + c80) = rq0; *(uint4*)(sQ + row1 * 72 + c81) = rq1;
      *(uint4*)(sAm + row0 * 72 + c80) = ra0; *(uint4*)(sAm + row1 * 72 + c81) = ra1;
      *(uint4*)(sKt + row0 * 72 + c80) = rk0; *(uint4*)(sKt + row1 * 72 + c81) = rk1;
    }
    if (tid < 64) sG[tid] = rg;
    *(uint2*)(sSt + r16 * 72 + irow) = pack4bf(S);
    const f32x4 uc = {bf2f(ru0), bf2f(ru1), bf2f(ru2), bf2f(ru3)};
    __syncthreads();
    if (ch + 1 < 64) GDN_GLOAD(ch + 1)
    f32x4 ws = {0.f, 0.f, 0.f, 0.f}, qs = {0.f, 0.f, 0.f, 0.f};
#pragma unroll
    for (int ks = 0; ks < 2; ++ks) {
      const bf16x8 bS = *(const bf16x8*)(sSt + r16 * 72 + ks * 32 + quad * 8);
      const bf16x8 aW = *(const bf16x8*)(sW + (16 * w + r16) * 72 + ks * 32 + quad * 8);
      const bf16x8 aQ = *(const bf16x8*)(sQ + (16 * w + r16) * 72 + ks * 32 + quad * 8);
      ws = __builtin_amdgcn_mfma_f32_16x16x32_bf16(aW, bS, ws, 0, 0, 0);
      qs = __builtin_amdgcn_mfma_f32_16x16x32_bf16(aQ, bS, qs, 0, 0, 0);
    }
    const float Gl = sG[63];
    const f32x4 G4 = *(const f32x4*)(sG + irow);
    f32x4 vn, vd;
#pragma unroll
    for (int j = 0; j < 4; ++j) { vn[j] = uc[j] - ws[j]; vd[j] = vn[j] * __expf(Gl - G4[j]); }
    *(uint2*)(sVnT + r16 * 72 + irow) = pack4bf(vn);
    *(uint2*)(sVdT + r16 * 72 + irow) = pack4bf(vd);
    __syncthreads();
    f32x4 av = {0.f, 0.f, 0.f, 0.f}, kv = {0.f, 0.f, 0.f, 0.f};
#pragma unroll
    for (int ks = 0; ks < 2; ++ks) {
      const bf16x8 bVn = *(const bf16x8*)(sVnT + r16 * 72 + ks * 32 + quad * 8);
      const bf16x8 bVd = *(const bf16x8*)(sVdT + r16 * 72 + ks * 32 + quad * 8);
      const bf16x8 aA = *(const bf16x8*)(sAm + (16 * w + r16) * 72 + ks * 32 + quad * 8);
      const bf16x8 aK = *(const bf16x8*)(sKt + (16 * w + r16) * 72 + ks * 32 + quad * 8);
      av = __builtin_amdgcn_mfma_f32_16x16x32_bf16(aA, bVn, av, 0, 0, 0);
      kv = __builtin_amdgcn_mfma_f32_16x16x32_bf16(aK, bVd, kv, 0, 0, 0);
    }
    {
      u16* op = ORAW + ((long)(b * SEQ + ch * 64 + irow)) * 256 + h * 64 + es * 16 + r16;
#pragma unroll
      for (int j = 0; j < 4; ++j) op[j * 256] = f2bf(__expf(G4[j]) * qs[j] + av[j]);
    }
    const float gl = __expf(Gl);
#pragma unroll
    for (int j = 0; j < 4; ++j) S[j] = S[j] * gl + kv[j];
  }
#undef GDN_GLOAD
}
DI void gdn_post_item(const Params& P, int l, int it) {
  const int lane = TID() & 63, w = TID() >> 6;
  const u16* PROJ = (const u16*)(WSP(P) + WS_PROJ);
  u16* O = (u16*)(WSP(P) + WS_OM) + (long)2 * T_ * 256;
  const float wn = P.in[23][l * 64 + lane];
#pragma unroll 4
  for (int q = 0; q < 16; ++q) {
    long t = (long)it * 16 + w * 4 + (q >> 2); int h = q & 3;
    float o = bf2f(O[t * 256 + h * 64 + lane]);
    float ss = wave_sum(o * o);
    float y = o * rsqrtf(ss * (1.f / 64.f) + EPS) * wn;
    float z = bf2f(PROJ[t * PW + P_GZ + h * 64 + lane]);
    O[t * 256 + h * 64 + lane] = f2bf(y * siluf_(z));
  }
}

DI void kv_gload(uint4& k0, uint4& k1, uint4& v0, uint4& v1, const u16* ksrc, const u16* vsrc, long ld) {
  const int tid = TID(), r0 = tid >> 3, ch = tid & 7;
  k0 = *(const uint4*)(ksrc + (long)r0 * ld + ch * 8); k1 = *(const uint4*)(ksrc + (long)(r0 + 32) * ld + ch * 8);
  v0 = *(const uint4*)(vsrc + (long)r0 * ld + ch * 8); v1 = *(const uint4*)(vsrc + (long)(r0 + 32) * ld + ch * 8);
}
DI void k_gload(uint4& k0, uint4& k1, const u16* ksrc, long ld) {
  const int tid = TID(), r0 = tid >> 3, ch = tid & 7;
  k0 = *(const uint4*)(ksrc + (long)r0 * ld + ch * 8); k1 = *(const uint4*)(ksrc + (long)(r0 + 32) * ld + ch * 8);
}
DI void k_store(const uint4& k0, const uint4& k1, u16* sK) {
  const int tid = TID(), r0 = tid >> 3, ch = tid & 7;
  *(uint4*)(sK + r0 * 72 + ch * 8) = k0; *(uint4*)(sK + (r0 + 32) * 72 + ch * 8) = k1;
}
DI void kv_store(const uint4& k0, const uint4& k1, const uint4& v0, const uint4& v1, u16* sK, u16* sVt) {
  const int tid = TID(), r0 = tid >> 3, ch = tid & 7;
  *(uint4*)(sK + r0 * 72 + ch * 8) = k0; *(uint4*)(sK + (r0 + 32) * 72 + ch * 8) = k1;
  const int ksw = 16 * (ch >> 1);
  st_kt(sVt, ch * 8, r0 ^ ksw, v0); st_kt(sVt, ch * 8, (r0 + 32) ^ ksw, v1);
}
DI void sb_attn_item(const Params& P, int it, u16* sQ, u16* sK, u16* sVt) {
  const int tid = TID(), lane = tid & 63, w = tid >> 6, r16 = lane & 15, quad = lane >> 4;
  const int qb = 63 - (it >> 5), bh = it & 31, b = bh >> 2, h = bh & 3;
  const u16* PROJ = (const u16*)(WSP(P) + WS_PROJ);
  u16* OUT = (u16*)(WSP(P) + WS_OM) + (long)3 * T_ * 256;
  const long tb = (long)b * SEQ;
  load_tile(sQ, PROJ + (tb + qb * 64) * PW + P_SB + h * 64, PW);
  __syncthreads();
  bf16x8 bq[2]; load_qfrag(bq, sQ, w, lane);
  const int tq = qb * 64 + 16 * w + r16;
  f32x4 ot[4];
#pragma unroll
  for (int dt = 0; dt < 4; ++dt) ot[dt] = (f32x4){0.f, 0.f, 0.f, 0.f};
  float R = 0.f;
  uint4 pk0, pk1, pv0, pv1;
  kv_gload(pk0, pk1, pv0, pv1, PROJ + (tb + qb * 64) * PW + P_SB + 256 + h * 64, PROJ + (tb + qb * 64) * PW + P_SB + 512 + h * 64, PW);
  for (int kb = qb; kb >= 0; --kb) {
    if (__syncthreads_and(R < -104.f)) break;
    kv_store(pk0, pk1, pv0, pv1, sK, sVt);
    __syncthreads();
    if (kb > 0) kv_gload(pk0, pk1, pv0, pv1, PROJ + (tb + (kb - 1) * 64) * PW + P_SB + 256 + h * 64, PROJ + (tb + (kb - 1) * 64) * PW + P_SB + 512 + h * 64, PW);
    f32x4 st[4];
    st_mma(st, sK, bq, lane);
    float gs[4], zz[4][4], x[4][4];
#pragma unroll
    for (int mt = 0; mt < 4; ++mt) {
      float g = 0.f;
#pragma unroll
      for (int j = 0; j < 4; ++j) {
        int s = kb * 64 + 16 * mt + 4 * quad + j;
        float z = st[mt][j] * 0.125f;
        float sp = softplus_fast(z);
        bool mk = s < tq;
        x[mt][j] = mk ? -sp : 0.f;
        zz[mt][j] = mk ? (z - sp) : -1e30f;
        g += x[mt][j];
      }
      gs[mt] = g;
    }
    float hm = 0.f, tot_all = 0.f;
    f32x4 pw[4];
#pragma unroll
    for (int mt = 3; mt >= 0; --mt) {
      float g = gs[mt];
      float v1 = __shfl_down(g, 16), v2 = __shfl_down(g, 32), v3 = __shfl_down(g, 48);
      float hq = (quad < 3 ? v1 : 0.f) + (quad < 2 ? v2 : 0.f) + (quad < 1 ? v3 : 0.f);
      float tot = quad_sum(g);
      float base = R + hm + hq;
      float e3 = 0.f, e2 = x[mt][3], e1 = e2 + x[mt][2], e0 = e1 + x[mt][1];
      pw[mt][0] = __expf(zz[mt][0] + base + e0);
      pw[mt][1] = __expf(zz[mt][1] + base + e1);
      pw[mt][2] = __expf(zz[mt][2] + base + e2);
      pw[mt][3] = __expf(zz[mt][3] + base + e3);
      hm += tot; tot_all += tot;
    }
    R += tot_all;
    pv_mma(ot, sVt, pw, lane);
  }
  const long t = tb + tq;
#pragma unroll
  for (int dt = 0; dt < 4; ++dt) {
    uint2 ov; ov.x = pk2(ot[dt][0], ot[dt][1]); ov.y = pk2(ot[dt][2], ot[dt][3]);
    *(uint2*)(OUT + t * 256 + h * 64 + 16 * dt + 4 * quad) = ov;
  }
}

DI void win_attn_item(const Params& P, int it, u16* sQ, u16* sKunused, u16* sVunused) {
  const int tid = TID(), lane = tid & 63, w = tid >> 6, r16 = lane & 15, quad = lane >> 4;
  const int tbk = 127 - (it >> 3), b = it & 7;
  u16* sK = sQ + 128 * 72;
  u16* sVt = sK + 64 * 72;
  (void)sKunused; (void)sVunused;
  const u16* PROJ = (const u16*)(WSP(P) + WS_PROJ);
  const u16* QR = (const u16*)(WSP(P) + WS_QR);
  u16* OW = (u16*)(WSP(P) + WS_OW);
  const long tb = (long)b * SEQ;
  const int t0 = tbk * 32;
#pragma unroll
  for (int i = 0; i < 4; ++i) {
    const int c = tid + 256 * i, row = c >> 3, ch = c & 7;
    *(uint4*)(sQ + row * 72 + ch * 8) = *(const uint4*)(QR + (tb + t0 + (row & 31)) * 256 + (row >> 5) * 64 + ch * 8);
  }
  __syncthreads();
  bf16x8 bq[2][2];
  int tq[2];
#pragma unroll
  for (int qt = 0; qt < 2; ++qt) {
    const int rowq = 32 * w + 16 * qt + r16;
    bq[qt][0] = *(const bf16x8*)(sQ + rowq * 72 + quad * 8);
    bq[qt][1] = *(const bf16x8*)(sQ + rowq * 72 + 32 + quad * 8);
    tq[qt] = t0 + 16 * qt + r16;
  }
  f32x4 ot[2][4];
#pragma unroll
  for (int qt = 0; qt < 2; ++qt)
#pragma unroll
    for (int dt = 0; dt < 4; ++dt) ot[qt][dt] = (f32x4){0.f, 0.f, 0.f, 0.f};
  float m[2] = {-1e30f, -1e30f}, lsum[2] = {0.f, 0.f};
  const int lo = (t0 - 511) > 0 ? (t0 - 511) : 0;
  const int kb_lo = lo >> 6, kb_hi = (t0 + 31) >> 6;
  uint4 pk0, pk1, pv0, pv1;
  kv_gload(pk0, pk1, pv0, pv1, PROJ + (tb + kb_lo * 64) * PW + P_KV + 256, PROJ + (tb + kb_lo * 64) * PW + P_KV + 320, PW);
  for (int kb = kb_lo; kb <= kb_hi; ++kb) {
    __syncthreads();
    kv_store(pk0, pk1, pv0, pv1, sK, sVt);
    __syncthreads();
    if (kb < kb_hi) kv_gload(pk0, pk1, pv0, pv1, PROJ + (tb + (kb + 1) * 64) * PW + P_KV + 256, PROJ + (tb + (kb + 1) * 64) * PW + P_KV + 320, PW);
#pragma unroll
    for (int qt = 0; qt < 2; ++qt) {
      f32x4 st[4];
      st_mma(st, sK, bq[qt], lane);
      bool msk[4][4];
#pragma unroll
      for (int mt = 0; mt < 4; ++mt)
#pragma unroll
        for (int j = 0; j < 4; ++j) { int s = kb * 64 + 16 * mt + 4 * quad + j; int df = tq[qt] - s; msk[mt][j] = (df >= 0) && (df < 512); }
      softmax_tile(st, msk, m[qt], lsum[qt], ot[qt]);
      pv_mma(ot[qt], sVt, st, lane);
    }
  }
#pragma unroll
  for (int qt = 0; qt < 2; ++qt) {
    const float ls = quad_sum(lsum[qt]);
    const float inv = 1.f / fmaxf(ls, 1e-30f);
    const long t = tb + tq[qt];
#pragma unroll
    for (int dt = 0; dt < 4; ++dt) {
      uint2 ov; ov.x = pk2(ot[qt][dt][0] * inv, ot[qt][dt][1] * inv); ov.y = pk2(ot[qt][dt][2] * inv, ot[qt][dt][3] * inv);
      *(uint2*)(OW + t * 256 + w * 64 + 16 * dt + 4 * quad) = ov;
    }
  }
}

DI void cmp_attn_item(const Params& P, int it, u16* sQ, u16* sK, u16* sVt, float* sImp) {
  const int tid = TID(), lane = tid & 63, w = tid >> 6, r16 = lane & 15, quad = lane >> 4;
  const int tbk = 255 - (it >> 3), b = it & 7;
  const u16* PROJ = (const u16*)(WSP(P) + WS_PROJ);
  const u16* KC = (const u16*)(WSP(P) + WS_KC) + (long)b * 256 * 64;
  const u16* VC = (const u16*)(WSP(P) + WS_VC) + (long)b * 256 * 64;
  u16* OC = (u16*)(WSP(P) + WS_OC);
  u64* SEL = (u64*)(WSP(P) + WS_SEL);
  const long tb = (long)b * SEQ;
  const int t0 = tbk * 16;
  load_q_nsa(sQ, PROJ + (tb + t0) * PW + P_Q, PW);
  for (int e = tid; e < 4 * 16 * 64; e += 256) sImp[e] = 0.f;
  __syncthreads();
  bf16x8 bq[2]; load_qfrag(bq, sQ, w, lane);
  const int tq = t0 + r16;
  const int nv = (tq >= 31) ? ((tq - 31) >> 4) + 1 : 0;
  const int nvmax = (t0 + 15 >= 31) ? ((t0 + 15 - 31) >> 4) + 1 : 0;
  const int ntile = (nvmax + 63) >> 6;
  float m = -1e30f, lsum = 0.f;
  uint4 pk0, pk1, pv0, pv1;
  if (ntile > 0) k_gload(pk0, pk1, KC, 64);
  for (int kt = 0; kt < ntile; ++kt) {
    __syncthreads();
    k_store(pk0, pk1, sK);
    __syncthreads();
    if (kt + 1 < ntile) k_gload(pk0, pk1, KC + (kt + 1) * 64 * 64, 64);
    f32x4 st[4];
    st_mma(st, sK, bq, lane);
    float tm = -1e30f;
#pragma unroll
    for (int mt = 0; mt < 4; ++mt)
#pragma unroll
      for (int j = 0; j < 4; ++j) { int n = kt * 64 + 16 * mt + 4 * quad + j; float s = st[mt][j] * 0.125f; st[mt][j] = s; if (n < nv) tm = fmaxf(tm, s); }
    tm = quad_max(tm);
    float mn = fmaxf(m, tm);
    float ps = 0.f;
#pragma unroll
    for (int mt = 0; mt < 4; ++mt)
#pragma unroll
      for (int j = 0; j < 4; ++j) { int n = kt * 64 + 16 * mt + 4 * quad + j; if (n < nv) ps += __expf(st[mt][j] - mn); }
    lsum = lsum * __expf(m - mn) + ps;
    m = mn;
  }
  lsum = quad_sum(lsum);
  const float inv = (lsum > 0.f) ? 1.f / lsum : 0.f;
  f32x4 ot[4];
#pragma unroll
  for (int dt = 0; dt < 4; ++dt) ot[dt] = (f32x4){0.f, 0.f, 0.f, 0.f};
  float carry = 0.f;
  if (ntile > 0) kv_gload(pk0, pk1, pv0, pv1, KC, VC, 64);
  for (int kt = 0; kt < ntile; ++kt) {
    __syncthreads();
    kv_store(pk0, pk1, pv0, pv1, sK, sVt);
    __syncthreads();
    if (kt + 1 < ntile) kv_gload(pk0, pk1, pv0, pv1, KC + (kt + 1) * 64 * 64, VC + (kt + 1) * 64 * 64, 64);
    f32x4 st[4];
    st_mma(st, sK, bq, lane);
#pragma unroll
    for (int mt = 0; mt < 4; ++mt)
#pragma unroll
      for (int j = 0; j < 4; ++j) { int n = kt * 64 + 16 * mt + 4 * quad + j; st[mt][j] = (n < nv) ? __expf(st[mt][j] * 0.125f - m) * inv : 0.f; }
    pv_mma(ot, sVt, st, lane);
    float prevlast = carry;
#pragma unroll
    for (int mt = 0; mt < 4; ++mt) {
      float pl = st[mt][3];
      float fd = __shfl_up(pl, 16);
      float pprev = (quad > 0) ? fd : prevlast;
      float v = st[mt][0] + st[mt][1] + st[mt][2] + st[mt][3] + pprev;
      sImp[(w * 16 + r16) * 64 + kt * 16 + mt * 4 + quad] = v;
      prevlast = __shfl_down(pl, 48);
    }
    carry = prevlast;
  }
  {
    const long t = tb + tq;
#pragma unroll
    for (int dt = 0; dt < 4; ++dt) {
      uint2 ov; ov.x = pk2(ot[dt][0], ot[dt][1]); ov.y = pk2(ot[dt][2], ot[dt][3]);
      *(uint2*)(OC + t * 256 + w * 64 + 16 * dt + 4 * quad) = ov;
    }
  }
  __syncthreads();
  for (int q = 0; q < 4; ++q) {
    const int tok = 4 * w + q, t = t0 + tok;
    float v = sImp[(0 * 16 + tok) * 64 + lane] + sImp[(1 * 16 + tok) * 64 + lane] + sImp[(2 * 16 + tok) * 64 + lane] + sImp[(3 * 16 + tok) * 64 + lane];
    const int cur = t >> 6;
    if (lane == 0 || lane == cur) v = 1e9f;
    else if (lane * 64 > t) v = -1e30f;
    int cnt = 0;
#pragma unroll
    for (int i2 = 0; i2 < 64; ++i2) {
      float vi = __builtin_bit_cast(float, __builtin_amdgcn_readlane(__builtin_bit_cast(int, v), i2));
      cnt += (vi > v || (vi == v && i2 < lane)) ? 1 : 0;
    }
    u64 mask = __ballot(cnt < 16);
    if (lane == 0) SEL[tb + t] = mask;
  }
}

DI void sel_attn_item(const Params& P, int it, u16* sQ, u16* sKunused, u16* sVunused) {
  const int tid = TID(), lane = tid & 63, w = tid >> 6, r16 = lane & 15, quad = lane >> 4;
  const int tbk = 127 - (it >> 3), b = it & 7;
  u16* sK = sQ + 128 * 72;
  u16* sVt = sK + 64 * 72;
  (void)sKunused; (void)sVunused;
  const u16* PROJ = (const u16*)(WSP(P) + WS_PROJ);
  const u16* QR = (const u16*)(WSP(P) + WS_QR);
  const u16* OC = (const u16*)(WSP(P) + WS_OC);
  const u16* OW = (const u16*)(WSP(P) + WS_OW);
  const u64* SEL = (const u64*)(WSP(P) + WS_SEL);
  u16* OUT = (u16*)(WSP(P) + WS_OM);
  const long tb = (long)b * SEQ;
  const int t0 = tbk * 32;
#pragma unroll
  for (int i = 0; i < 4; ++i) {
    const int c = tid + 256 * i, row = c >> 3, ch = c & 7;
    *(uint4*)(sQ + row * 72 + ch * 8) = *(const uint4*)(QR + (tb + t0 + (row & 31)) * 256 + (row >> 5) * 64 + ch * 8);
  }
  __syncthreads();
  bf16x8 bq[2][2];
  int tq[2]; u64 mysel[2];
#pragma unroll
  for (int qt = 0; qt < 2; ++qt) {
    const int rowq = 32 * w + 16 * qt + r16;
    bq[qt][0] = *(const bf16x8*)(sQ + rowq * 72 + quad * 8);
    bq[qt][1] = *(const bf16x8*)(sQ + rowq * 72 + 32 + quad * 8);
    tq[qt] = t0 + 16 * qt + r16;
    mysel[qt] = SEL[tb + tq[qt]];
  }
  u64 uni = 0;
#pragma unroll
  for (int q = 0; q < 32; ++q) uni |= SEL[tb + t0 + q];
  const int cur = t0 >> 6;
  uni &= (cur == 63) ? ~0ull : ((1ull << (cur + 1)) - 1ull);
  f32x4 ot[2][4];
#pragma unroll
  for (int qt = 0; qt < 2; ++qt)
#pragma unroll
    for (int dt = 0; dt < 4; ++dt) ot[qt][dt] = (f32x4){0.f, 0.f, 0.f, 0.f};
  float m[2] = {-1e30f, -1e30f}, lsum[2] = {0.f, 0.f};
  uint4 pk0, pk1, pv0, pv1;
  int kb = uni ? (__ffsll((long long)uni) - 1) : -1;
  uni &= uni - 1;
  if (kb >= 0) kv_gload(pk0, pk1, pv0, pv1, PROJ + (tb + kb * 64) * PW + P_KV + 128, PROJ + (tb + kb * 64) * PW + P_KV + 192, PW);
  for (int nkb = -1; kb >= 0; kb = nkb) {
    __syncthreads();
    kv_store(pk0, pk1, pv0, pv1, sK, sVt);
    __syncthreads();
    nkb = uni ? (__ffsll((long long)uni) - 1) : -1;
    uni &= uni - 1;
    if (nkb >= 0) kv_gload(pk0, pk1, pv0, pv1, PROJ + (tb + nkb * 64) * PW + P_KV + 128, PROJ + (tb + nkb * 64) * PW + P_KV + 192, PW);
#pragma unroll
    for (int qt = 0; qt < 2; ++qt) {
      f32x4 st[4];
      st_mma(st, sK, bq[qt], lane);
      const bool selq = (mysel[qt] >> kb) & 1ull;
      bool msk[4][4];
#pragma unroll
      for (int mt = 0; mt < 4; ++mt)
#pragma unroll
        for (int j = 0; j < 4; ++j) { int s = kb * 64 + 16 * mt + 4 * quad + j; msk[mt][j] = selq && (s <= tq[qt]); }
      softmax_tile(st, msk, m[qt], lsum[qt], ot[qt]);
      pv_mma(ot[qt], sVt, st, lane);
    }
  }
#pragma unroll
  for (int qt = 0; qt < 2; ++qt) {
    const float ls = quad_sum(lsum[qt]);
    const float inv = 1.f / fmaxf(ls, 1e-30f);
    const long t = tb + tq[qt];
    const float gc = sigmoidf_(bf2f(PROJ[t * PW + P_NG + w * 3 + 0]));
    const float gsl = sigmoidf_(bf2f(PROJ[t * PW + P_NG + w * 3 + 1]));
    const float gw = sigmoidf_(bf2f(PROJ[t * PW + P_NG + w * 3 + 2]));
#pragma unroll
    for (int dt = 0; dt < 4; ++dt) {
      const long o = t * 256 + w * 64 + 16 * dt + 4 * quad;
      uint2 c = *(const uint2*)(OC + o), ww = *(const uint2*)(OW + o);
      float r0 = gc * bf2f((u16)(c.x & 0xffff)) + gsl * ot[qt][dt][0] * inv + gw * bf2f((u16)(ww.x & 0xffff));
      float r1 = gc * bf2f((u16)(c.x >> 16)) + gsl * ot[qt][dt][1] * inv + gw * bf2f((u16)(ww.x >> 16));
      float r2 = gc * bf2f((u16)(c.y & 0xffff)) + gsl * ot[qt][dt][2] * inv + gw * bf2f((u16)(ww.y & 0xffff));
      float r3 = gc * bf2f((u16)(c.y >> 16)) + gsl * ot[qt][dt][3] * inv + gw * bf2f((u16)(ww.y >> 16));
      uint2 ov; ov.x = pk2(r0, r1); ov.y = pk2(r2, r3);
      *(uint2*)(OUT + o) = ov;
    }
  }
}

DI void inproj_tile(const Params& P, int l, int it, u16* sA, u16* sB) {
  const int tid = TID(), lane = tid & 63, w = tid >> 6, r16 = lane & 15, quad = lane >> 4, wm = w >> 1, wn = w & 1;
  int mt, nt; tile_from_q(it, 22, mt, nt);
  const u16* H = (const u16*)(WSP(P) + WS_H);
  u16* PROJ = (u16*)(WSP(P) + WS_PROJ);
  const u16* Ab = H + (long)mt * 128 * DM;
  const u16* Bb = (const u16*)(WSP(P) + WS_W + WT_IN) + (long)nt * 128 * DM;
  f32x4 acc[4][4];
  gemm3<4>(acc, g3_ptr(Ab, DM, tid, 0, false), g3_ptr(Ab, DM, tid, 1, false), nullptr, nullptr, 64,
           g3_ptr(Bb, DM, tid, 0, false), g3_ptr(Bb, DM, tid, 1, false), nullptr, nullptr, DM, sA, 16L * DM, 16L * DM);
  __syncthreads();
#pragma unroll
  for (int mi = 0; mi < 4; ++mi)
#pragma unroll
    for (int ni = 0; ni < 4; ++ni)
#pragma unroll
      for (int j = 0; j < 4; ++j) sA[(wm * 64 + 16 * mi + 4 * quad + j) * 136 + wn * 64 + 16 * ni + r16] = f2bf(acc[mi][ni][j]);
  __syncthreads();
  store_tile_bf16<128>(sA, PROJ + (long)mt * 128 * PW + nt * 128, PW, 128);
}
DI void glu_tile(const Params& P, int l, int it, u16* sA, u16* sB) {
  const int tid = TID(), lane = tid & 63, w = tid >> 6, r16 = lane & 15, quad = lane >> 4, wm = w >> 1, wn = w & 1;
  const int mt = it >> 2, nt = it & 3;
  const u16* Y5 = (const u16*)(WSP(P) + WS_Y5);
  u16* OUT = (u16*)(WSP(P) + WS_OM) + (long)1 * T_ * 256;
  const u16* Ab = Y5 + (long)mt * 128 * 256;
  const u16* Bb = (const u16*)(WSP(P) + WS_W + WT_GLU) + (long)nt * 128 * 256;
  f32x4 acc[4][4];
  gemm3<4>(acc, g3_ptr(Ab, 256, tid, 0, false), g3_ptr(Ab, 256, tid, 1, false), nullptr, nullptr, 64,
           g3_ptr(Bb, 256, tid, 0, false), g3_ptr(Bb, 256, tid, 1, false), nullptr, nullptr, 256, sA, 16L * 256, 16L * 256);
  __syncthreads();
#pragma unroll
  for (int mi = 0; mi < 4; ++mi)
#pragma unroll
    for (int ni = 0; ni < 2; ++ni)
#pragma unroll
      for (int j = 0; j < 4; ++j)
        sA[(wm * 64 + 16 * mi + 4 * quad + j) * 72 + wn * 32 + 16 * ni + r16] = f2bf(acc[mi][ni][j] * sigmoidf_(acc[mi][ni + 2][j]));
  __syncthreads();
  store_tile_bf16<64>(sA, OUT + (long)mt * 128 * 256 + nt * 64, 256, 128);
}
DI void merge_tile(const Params& P, int l, int it, u16* sA, u16* sB) {
  const int tid = TID(), lane = tid & 63, w = tid >> 6, r16 = lane & 15, quad = lane >> 4, wm = w >> 1, wn = w & 1;
  int mt, nt; tile_from_q(it, 8, mt, nt);
  const u16* H = (const u16*)(WSP(P) + WS_H);
  const u16* OM = (const u16*)(WSP(P) + WS_OM);
  u16* MERGED = (u16*)(WSP(P) + WS_MERGED);
  uint2 outp[4][4];
#pragma unroll
  for (int mi = 0; mi < 4; ++mi)
#pragma unroll
    for (int ni = 0; ni < 4; ++ni) outp[mi][ni] = make_uint2(0u, 0u);
#pragma unroll 1
  for (int m = 0; m < 4; ++m) {
    uint2 gp[4][4];
    {
      f32x4 ag[4][4];
      const u16* Ab = H + (long)mt * 128 * DM;
      const u16* Bb = (const u16*)(WSP(P) + WS_W + WT_G) + ((long)(m * 1024 + nt * 128)) * DM;
      gemm3<4, true>(ag, g3_ptr(Ab, DM, tid, 0, false), g3_ptr(Ab, DM, tid, 1, false), nullptr, nullptr, 64,
               g3_ptr(Bb, DM, tid, 0, false), g3_ptr(Bb, DM, tid, 1, false), nullptr, nullptr, DM, sA, 16L * DM, 16L * DM);
#pragma unroll
      for (int mi = 0; mi < 4; ++mi)
#pragma unroll
        for (int ni = 0; ni < 4; ++ni) {
          gp[mi][ni].x = pk2(sigmoidf_(ag[mi][ni][0]), sigmoidf_(ag[mi][ni][1]));
          gp[mi][ni].y = pk2(sigmoidf_(ag[mi][ni][2]), sigmoidf_(ag[mi][ni][3]));
        }
    }
    {
      f32x4 av[4][4];
      const u16* Ab = OM + ((long)m * T_ + (long)mt * 128) * 256;
      const u16* Bb = (const u16*)(WSP(P) + WS_W + WT_BR) + ((long)(m * 1024 + nt * 128)) * 256;
      gemm3<4, true>(av, g3_ptr(Ab, 256, tid, 0, false), g3_ptr(Ab, 256, tid, 1, false), nullptr, nullptr, 64,
               g3_ptr(Bb, 256, tid, 0, false), g3_ptr(Bb, 256, tid, 1, false), nullptr, nullptr, 256, sA, 16L * 256, 16L * 256);
#pragma unroll
      for (int mi = 0; mi < 4; ++mi)
#pragma unroll
        for (int ni = 0; ni < 4; ++ni) {
          const float o0 = bf2f((u16)(outp[mi][ni].x & 0xffff)) + av[mi][ni][0] * bf2f((u16)(gp[mi][ni].x & 0xffff));
          const float o1 = bf2f((u16)(outp[mi][ni].x >> 16)) + av[mi][ni][1] * bf2f((u16)(gp[mi][ni].x >> 16));
          const float o2 = bf2f((u16)(outp[mi][ni].y & 0xffff)) + av[mi][ni][2] * bf2f((u16)(gp[mi][ni].y & 0xffff));
          const float o3 = bf2f((u16)(outp[mi][ni].y >> 16)) + av[mi][ni][3] * bf2f((u16)(gp[mi][ni].y >> 16));
          outp[mi][ni].x = pk2(o0, o1); outp[mi][ni].y = pk2(o2, o3);
        }
    }
  }
  __syncthreads();
#pragma unroll
  for (int mi = 0; mi < 4; ++mi)
#pragma unroll
    for (int ni = 0; ni < 4; ++ni)
#pragma unroll
      for (int j = 0; j < 4; ++j) {
        const unsigned wv = (j < 2) ? outp[mi][ni].x : outp[mi][ni].y;
        sA[(wm * 64 + 16 * mi + 4 * quad + j) * 136 + wn * 64 + 16 * ni + r16] = (u16)((j & 1) ? (wv >> 16) : (wv & 0xffff));
      }
  __syncthreads();
  store_tile_bf16<128>(sA, MERGED + (long)mt * 128 * DM + nt * 128, DM, 128);
}
DI void resid_tile(const u16* A, int K, const u16* Bt, const float* resid, float* out, int it, u16* sA, u16* sB) {
  const int tid = TID(), lane = tid & 63, w = tid >> 6, r16 = lane & 15, quad = lane >> 4, wm = w >> 1, wn = w & 1;
  int mt, nt; tile_from_q(it, 8, mt, nt);
  const u16* Ab = A + (long)mt * 128 * K;
  const u16* Bb = Bt + (long)nt * 128 * K;
  f32x4 acc[4][4];
  gemm3<4>(acc, g3_ptr(Ab, K, tid, 0, false), g3_ptr(Ab, K, tid, 1, false), nullptr, nullptr, 64,
           g3_ptr(Bb, K, tid, 0, false), g3_ptr(Bb, K, tid, 1, false), nullptr, nullptr, K, sA, 16L * K, 16L * K);
  float* sC = (float*)sA + w * (32 * 68);
#pragma unroll
  for (int hp = 0; hp < 2; ++hp) {
    __syncthreads();
#pragma unroll
    for (int mi2 = 0; mi2 < 2; ++mi2)
#pragma unroll
      for (int ni = 0; ni < 4; ++ni)
#pragma unroll
        for (int j = 0; j < 4; ++j) sC[(16 * mi2 + 4 * quad + j) * 68 + 16 * ni + r16] = acc[2 * hp + mi2][ni][j];
    __syncthreads();
#pragma unroll
    for (int q = 0; q < 8; ++q) {
      const int c = lane + 64 * q, row = c >> 4, c4 = (c & 15) * 4;
      const long o = ((long)mt * 128 + wm * 64 + 32 * hp + row) * DM + nt * 128 + wn * 64 + c4;
      const float4 rv = *(const float4*)(resid + o);
      const f32x4 cv = *(const f32x4*)(sC + row * 68 + c4);
      *(float4*)(out + o) = make_float4(rv.x + cv[0], rv.y + cv[1], rv.z + cv[2], rv.w + cv[3]);
    }
  }
}
DI void ffn1_tile(const Params& P, int l, int it, u16* sA, u16* sB) {
  const int tid = TID(), lane = tid & 63, w = tid >> 6, r16 = lane & 15, quad = lane >> 4, wm = w >> 1, wn = w & 1;
  int mt, nt; tile_from_q(it, 44, mt, nt);
  const u16* H = (const u16*)(WSP(P) + WS_H);
  u16* ACT = (u16*)(WSP(P) + WS_PROJ);
  const u16* Ab = H + (long)mt * 128 * DM;
  const u16* Bb = (const u16*)(WSP(P) + WS_W + WT_GU) + (long)nt * 128 * DM;
  f32x4 acc[4][4];
  gemm3<4>(acc, g3_ptr(Ab, DM, tid, 0, false), g3_ptr(Ab, DM, tid, 1, false), nullptr, nullptr, 64,
           g3_ptr(Bb, DM, tid, 0, false), g3_ptr(Bb, DM, tid, 1, false), nullptr, nullptr, DM, sA, 16L * DM, 16L * DM);
  __syncthreads();
#pragma unroll
  for (int mi = 0; mi < 4; ++mi)
#pragma unroll
    for (int ni = 0; ni < 2; ++ni)
#pragma unroll
      for (int j = 0; j < 4; ++j)
        sA[(wm * 64 + 16 * mi + 4 * quad + j) * 72 + wn * 32 + 16 * ni + r16] = f2bf(siluf_(acc[mi][ni][j]) * acc[mi][ni + 2][j]);
  __syncthreads();
  store_tile_bf16<64>(sA, ACT + (long)mt * 128 * DFF + nt * 64, DFF, 128);
}

__global__ void __launch_bounds__(256, LB2) fwd_megakernel(Params P) {
  cg::grid_group grid = cg::this_grid();
  __shared__ __attribute__((aligned(16))) float lds[17920];
  __shared__ int s_item;
  unsigned* cnt = (unsigned*)(WSP(P) + WS_CNT);
  const int xcd = (int)(__builtin_amdgcn_s_getreg((3 << 11) | 20) & 0xF) & 7;
  __shared__ int s_rank;
  if (threadIdx.x == 0) s_rank = (int)atomicAdd(cnt + 900 + xcd, 1u);
  __syncthreads();
  const int xrank = s_rank;
  u16* sA = (u16*)lds;
  u16* sB = sA + 128 * 80;
  u16* aQ = (u16*)lds;
  u16* aK = aQ + 64 * 72;
  u16* aV = aK + 64 * 72;
  float* aImp = (float*)(aV + 64 * 72);
  for (int ph = P.ph_lo; ph < P.ph_hi; ++ph) {
    const int l = ph / 11, sp = ph % 11;
    const float* xin = (l == 0) ? P.in[0] : P.out;
    const int nrep = (PROBE_DUP != 0 && l == 0 && ((PROBE_DUP >> sp) & 1)) ? 2 : 1;
    for (int rep = 0; rep < nrep; ++rep) {
    unsigned* pc = cnt + (ph + 32 * rep) * 8;
    switch (sp) {
      case 0: if (PHASE_MASK & (1 << 0)) {
        phase_rmsnorm(xin, P.in[2] + l * DM, (u16*)(WSP(P) + WS_H));
        phase_convert(P, l, lds);
        if (l == 0) phase_rope_table((const int*)P.in[1], (float*)(WSP(P) + WS_COS), (float*)(WSP(P) + WS_SIN));
      } break;
      case 1: if (PHASE_MASK & (1 << 1)) {
        XCD_STATIC_LOOP(32 * 22, inproj_tile(P, l, it, sA, sB))
      } break;
      case 2: if (PHASE_MASK & (1 << 2)) {
        for (;;) {
          int it = next_item(pc, &s_item); if (it >= 64 + 3 * 2048) break;
          if (it < 64) cmp1_tile(P, l, it, sA, sB);
          else if (it < 64 + 2048) gdn_p1_item(P, l, it - 64, lds);
          else if (it < 64 + 4096) s5_pass1_item(P, l, it - 64 - 2048, lds);
          else nsa_prep_item(P, l, it - 64 - 4096);
        }
      } break;
      case 3: if (PHASE_MASK & (1 << 3)) {
        for (;;) {
          int it = next_item(pc, &s_item); if (it >= 128 + 3072 + 64) break;
          if (it < 128) gdn_p2_item(P, it, lds);
          else if (it < 128 + 2048) sb_attn_item(P, it - 128, aQ, aK, aV);
          else if (it < 128 + 3072) win_attn_item(P, it - 128 - 2048, aQ, aK, aV);
          else if (it < 128 + 3072 + 32) s5_carry_item(P, l, it - 128 - 3072);
          else cmp2_tile(P, l, it - 128 - 3072 - 32, sA, sB, lds + 17000);
        }
      } break;
      case 4: if (PHASE_MASK & (1 << 4)) {
        for (;;) {
          int it = next_item(pc, &s_item); if (it >= 3 * 2048) break;
          if (it < 2048) cmp_attn_item(P, it, aQ, aK, aV, aImp);
          else if (it < 4096) s5_pass2_item(P, l, it - 2048, lds);
          else gdn_post_item(P, l, it - 4096);
        }
      } break;
      case 5: if (PHASE_MASK & (1 << 5)) {
        for (;;) {
          int it = next_item(pc, &s_item); if (it >= 1024 + 1024) break;
          if (it < 1024) sel_attn_item(P, it, aQ, aK, aV);
          else glu_tile(P, l, it - 1024, sA, sB);
        }
      } break;
      case 6: if (PHASE_MASK & (1 << 6)) {
        XCD_STATIC_LOOP(32 * 8, merge_tile(P, l, it, sA, sB))
      } break;
      case 7: if (PHASE_MASK & (1 << 7)) {
        XCD_STATIC_LOOP(32 * 8, resid_tile((const u16*)(WSP(P) + WS_MERGED), DM, (const u16*)(WSP(P) + WS_W + WT_OUT), xin, P.out, it, sA, sB))
      } break;
      case 8: if (PHASE_MASK & (1 << 8)) {
        phase_rmsnorm(P.out, P.in[26] + l * DM, (u16*)(WSP(P) + WS_H));
      } break;
      case 9: if (PHASE_MASK & (1 << 9)) {
        XCD_STATIC_LOOP(32 * 44, ffn1_tile(P, l, it, sA, sB))
      } break;
      case 10: if (PHASE_MASK & (1 << 10)) {
        XCD_STATIC_LOOP(32 * 8, resid_tile((const u16*)(WSP(P) + WS_PROJ), DFF, (const u16*)(WSP(P) + WS_W + WT_D), P.out, P.out, it, sA, sB))
      } break;
    }
    if (rep + 1 < nrep) grid.sync();
    }
    if (ph + 1 < P.ph_hi) grid.sync();
  }
}

extern "C" void kernel_launch(void* const* d_in, const int* in_sizes, int n_in, void* d_out, int out_size, void* d_ws, size_t ws_size,
                              hipStream_t stream) {
  static int grid_blocks = 0;
  if (!grid_blocks) {
    int dev = 0, cus = 0, per_cu = 0;
    hipGetDevice(&dev);
    hipDeviceGetAttribute(&cus, hipDeviceAttributeMultiprocessorCount, dev);
    hipOccupancyMaxActiveBlocksPerMultiprocessor(&per_cu, fwd_megakernel, 256, 0);
    if (per_cu < 1) per_cu = 1;
    if (per_cu > 2) per_cu = 2;
    grid_blocks = cus * per_cu;
    if (ws_size < WS_W + WT_END) fprintf(stderr, "kernel_launch: workspace too small: %zu\n", ws_size);
  }
  hipMemsetAsync((char*)d_ws + WS_CNT, 0, 4096, stream);
  Params p{};
  for (int i = 0; i < 30; ++i) p.in[i] = (const float*)d_in[i];
  p.out = (float*)d_out;
  p.ws = (unsigned char*)d_ws;
  p.ph_lo = 0; p.ph_hi = NPHASE;
  void* args[] = {&p};
  hipError_t e = hipLaunchCooperativeKernel((void*)fwd_megakernel, dim3(grid_blocks), dim3(256), args, 0, stream);
  if (e != hipSuccess) fprintf(stderr, "cooperative launch failed: %s (grid %d)\n", hipGetErrorString(e), grid_blocks);
}
```

```cpp
#include <hip/hip_runtime.h>
#include <hip/hip_cooperative_groups.h>
#include <cstdio>
namespace cg = cooperative_groups;

typedef unsigned short u16;
typedef unsigned long long u64;
typedef __attribute__((ext_vector_type(8))) short bf16x8;
typedef __attribute__((ext_vector_type(4))) short s16x4;
typedef __attribute__((ext_vector_type(4))) float f32x4;
#define DI __device__ __forceinline__

constexpr int NB = 8, SEQ = 4096, T_ = NB * SEQ, DM = 1024, DIN = 6804, PW = 2816, DFF = 2816;
constexpr int P_Q = 0, P_KV = 256, P_S5U = 640, P_GQKV = 896, P_GZ = 1664, P_SB = 1920, P_NG = 2688, P_GA = 2700, P_GB = 2704;
constexpr float EPS = 1e-6f;
constexpr size_t MiB = 1024ull * 1024ull;
constexpr size_t WS_H = 0, WS_PROJ = 64 * MiB, WS_OM = 240 * MiB, WS_MERGED = 304 * MiB,
                 WS_GQ = 304 * MiB, WS_GK = 320 * MiB, WS_GU = 336 * MiB, WS_GW = 352 * MiB, WS_GA = 368 * MiB,
                 WS_QR = 384 * MiB, WS_OC = 400 * MiB, WS_OW = 416 * MiB, WS_Y5 = 432 * MiB,
                 WS_GG = 448 * MiB, WS_SEL = 449 * MiB, WS_COS = 450 * MiB, WS_SIN = 451 * MiB,
                 WS_ENDS = 452 * MiB, WS_CARRY = 456 * MiB, WS_KC = 460 * MiB, WS_VC = 461 * MiB, WS_HID = 462 * MiB,
                 WS_CNT = 464 * MiB, WS_W = 465 * MiB, WS_CBIAS = 449 * MiB + 512 * 1024;
constexpr size_t WT_IN = 0, WT_G = WT_IN + 2816ull * 1024 * 2, WT_BR = WT_G + 4096ull * 1024 * 2, WT_OUT = WT_BR + 4096ull * 256 * 2,
                 WT_GU = WT_OUT + 1024ull * 1024 * 2, WT_D = WT_GU + 5632ull * 1024 * 2, WT_GLU = WT_D + 1024ull * 2816 * 2,
                 WT_C1 = WT_GLU + 512ull * 256 * 2, WT_C2 = WT_C1 + 512ull * 2048 * 2, WT_END = WT_C2 + 128ull * 256 * 2;
constexpr int NPHASE = 22;
#define XCD_STATIC_LOOP(NPER, BODY) { \
    unsigned c0_ = cnt[900], c1_ = cnt[901], c2_ = cnt[902], c3_ = cnt[903], c4_ = cnt[904], c5_ = cnt[905], c6_ = cnt[906], c7_ = cnt[907]; \
    const bool ok_ = c0_ && c1_ && c2_ && c3_ && c4_ && c5_ && c6_ && c7_; \
    const unsigned mine_ = xcd == 0 ? c0_ : xcd == 1 ? c1_ : xcd == 2 ? c2_ : xcd == 3 ? c3_ : xcd == 4 ? c4_ : xcd == 5 ? c5_ : xcd == 6 ? c6_ : c7_; \
    const int start_ = ok_ ? xcd * (NPER) + xrank : (int)blockIdx.x, end_ = ok_ ? (xcd + 1) * (NPER) : 8 * (NPER), step_ = ok_ ? (int)mine_ : (int)gridDim.x; \
    for (int it = start_; it < end_; it += step_) { BODY; } }
#ifndef PROBE_DUP
#define PROBE_DUP 0
#endif
#ifndef LB2
#define LB2 2
#endif
#ifndef PHASE_MASK
#define PHASE_MASK 0x7ff
#endif

struct Params {
  const float* in[30];
  float* out;
  unsigned char* ws;
  int ph_lo, ph_hi;
};


DI int TID() { int t = threadIdx.x; asm volatile("" : "+v"(t)); return t; }
DI unsigned char* WSP(const Params& P) { size_t z = 0; asm volatile("" : "+s"(z)); return P.ws + z; }
typedef __bf16 bf16x2_t __attribute__((ext_vector_type(2)));
typedef float f32x2_t __attribute__((ext_vector_type(2)));
DI u16 f2bf(float x) { __bf16 r = (__bf16)x; return __builtin_bit_cast(u16, r); }
DI float bf2f(u16 h) { return __uint_as_float(((unsigned)h) << 16); }
DI unsigned pk2(float a, float b) { f32x2_t v = {a, b}; bf16x2_t r = __builtin_convertvector(v, bf16x2_t); return __builtin_bit_cast(unsigned, r); }
DI float wave_sum(float v) {
#pragma unroll
  for (int o = 1; o < 64; o <<= 1) v += __shfl_xor(v, o);
  return v;
}
DI float sigmoidf_(float x) { return __builtin_amdgcn_rcpf(1.f + __expf(-x)); }
DI float siluf_(float x) { return x * sigmoidf_(x); }
DI float softplusf_(float x) { return fmaxf(x, 0.f) + log1pf(__expf(-fabsf(x))); }
DI float softplus_fast(float x) { return fmaxf(x, 0.f) + __logf(1.f + __expf(-fabsf(x))); }
DI float gelu_tanh(float x) {
  float u = 0.7978845608028654f * (x + 0.044715f * x * x * x);
  float t = 1.f - 2.f * __builtin_amdgcn_rcpf(__expf(2.f * u) + 1.f);
  return 0.5f * x * (1.f + t);
}
DI void sincos_d(double x, double& s, double& c) {
  const double TWO_PI = 6.283185307179586476925287, INV = 0.15915494309189533576888;
  double n = rint(x * INV);
  double r = x - n * TWO_PI;
  double r2 = r * r, term = 1.0, cs = 1.0, ss = 1.0;
#pragma unroll
  for (int k = 1; k <= 14; ++k) { term *= r2 * (-1.0 / (double)((2 * k - 1) * (2 * k))); cs += term; }
  term = 1.0;
#pragma unroll
  for (int k = 1; k <= 14; ++k) { term *= r2 * (-1.0 / (double)((2 * k) * (2 * k + 1))); ss += term; }
  s = r * ss; c = cs;
}
DI int next_item(unsigned* cnt, int* s_item) {
  __syncthreads();
  if (TID() == 0) *s_item = (int)atomicAdd(cnt, 1u);
  __syncthreads();
  return *s_item;
}
DI int next_tile_xcd(unsigned* cnt8, int n_per_xcd, int xcd, int* s_item) {
  asm volatile("" : "+s"(xcd));
  __syncthreads();
  if (threadIdx.x == 0) {
    int res = -1;
    for (int a = 0; a < 8; ++a) {
      int qq = (xcd + a) & 7;
      unsigned v = atomicAdd(cnt8 + qq, 1u);
      if (v < (unsigned)n_per_xcd) { res = qq * n_per_xcd + (int)v; break; }
    }
    *s_item = res;
  }
  __syncthreads();
  return *s_item;
}
DI void tile_from_q(int it, int numN, int& mt, int& nt) {
  const int per = 32 * numN, q = it / per, i = it % per, g = i / (8 * numN), rem = i % (8 * numN);
  nt = rem >> 3; mt = 32 * q + 8 * g + (rem & 7);
}
DI int proj_src_col(int pc) {
  if (pc < 640) return pc;
  if (pc < 1664) return pc + 12;
  if (pc < 2688) return pc + 20;
  if (pc < 2700) return pc - 2688 + 640;
  if (pc < 2708) return pc - 2700 + 1676;
  return pc;
}

DI uint4 addpos8(uint4 v, const float* pp) {
  uint4 o;
  o.x = pk2(bf2f((u16)(v.x & 0xffff)) + pp[0], bf2f((u16)(v.x >> 16)) + pp[1]);
  o.y = pk2(bf2f((u16)(v.y & 0xffff)) + pp[2], bf2f((u16)(v.y >> 16)) + pp[3]);
  o.z = pk2(bf2f((u16)(v.z & 0xffff)) + pp[4], bf2f((u16)(v.z >> 16)) + pp[5]);
  o.w = pk2(bf2f((u16)(v.w & 0xffff)) + pp[6], bf2f((u16)(v.w >> 16)) + pp[7]);
  return o;
}
template <int NTW>
DI void gemm2(f32x4 (&acc)[4][NTW], const u16* __restrict__ arow, long a_kstep, const float* __restrict__ apos,
              const u16* __restrict__ brow, int K, u16* sA, u16* sB) {
  constexpr int BN = 32 * NTW, BV = BN / 32, LS = 80;
  const int tid = TID(), lane = tid & 63, w = tid >> 6, r16 = lane & 15, quad = lane >> 4;
  const int wm = w >> 1, wn = w & 1;
  u16* sa_st = sA + (tid >> 1) * LS + (tid & 1) * 32;
  u16* sb_st = (BN == 128) ? (sB + (tid >> 1) * LS + (tid & 1) * 32) : (sB + (tid >> 2) * LS + (tid & 3) * 16);
  uint4 pa0, pa1, pa2, pa3, pb0, pb1, pb2, pb3;
  uint4 qa0, qa1, qa2, qa3, qb0, qb1, qb2, qb3;
  pb2 = make_uint4(0, 0, 0, 0); pb3 = pb2; qb2 = pb2; qb3 = pb2;
#define G2_LOAD(KT, a0, a1, a2, a3, b0, b1, b2, b3) { const uint4* pa_ = (const uint4*)(arow + (long)(KT) * a_kstep); \
    a0 = pa_[0]; a1 = pa_[1]; a2 = pa_[2]; a3 = pa_[3]; \
    if (apos) { const float* pp_ = apos + (KT) * 64 + (tid & 1) * 32; \
      a0 = addpos8(a0, pp_); a1 = addpos8(a1, pp_ + 8); a2 = addpos8(a2, pp_ + 16); a3 = addpos8(a3, pp_ + 24); } \
    const uint4* pb_ = (const uint4*)(brow + (long)(KT) * 64); \
    b0 = pb_[0]; b1 = pb_[1]; if (BV == 4) { b2 = pb_[2]; b3 = pb_[3]; } }
#define G2_STORE(a0, a1, a2, a3, b0, b1, b2, b3) { \
    ((uint4*)sa_st)[0] = a0; ((uint4*)sa_st)[1] = a1; ((uint4*)sa_st)[2] = a2; ((uint4*)sa_st)[3] = a3; \
    ((uint4*)sb_st)[0] = b0; ((uint4*)sb_st)[1] = b1; if (BV == 4) { ((uint4*)sb_st)[2] = b2; ((uint4*)sb_st)[3] = b3; } }
#define G2_COMPUTE() { _Pragma("unroll") for (int ks = 0; ks < 2; ++ks) { \
      bf16x8 af[4], bg[NTW]; \
      _Pragma("unroll") for (int mi = 0; mi < 4; ++mi) af[mi] = *(const bf16x8*)(sA + (wm * 64 + 16 * mi + r16) * LS + ks * 32 + quad * 8); \
      _Pragma("unroll") for (int ni = 0; ni < NTW; ++ni) bg[ni] = *(const bf16x8*)(sB + (wn * (BN / 2) + 16 * ni + r16) * LS + ks * 32 + quad * 8); \
      _Pragma("unroll") for (int mi = 0; mi < 4; ++mi) \
        _Pragma("unroll") for (int ni = 0; ni < NTW; ++ni) acc[mi][ni] = __builtin_amdgcn_mfma_f32_16x16x32_bf16(af[mi], bg[ni], acc[mi][ni], 0, 0, 0); } }
#pragma unroll
  for (int mi = 0; mi < 4; ++mi)
#pragma unroll
    for (int ni = 0; ni < NTW; ++ni) acc[mi][ni] = (f32x4){0.f, 0.f, 0.f, 0.f};
  const int nk = K >> 6;
  G2_LOAD(0, pa0, pa1, pa2, pa3, pb0, pb1, pb2, pb3)
  G2_LOAD(1, qa0, qa1, qa2, qa3, qb0, qb1, qb2, qb3)
#pragma unroll 1
  for (int kt = 0; kt < nk; kt += 2) {
    __syncthreads();
    G2_STORE(pa0, pa1, pa2, pa3, pb0, pb1, pb2, pb3)
    __syncthreads();
    if (kt + 2 < nk) G2_LOAD(kt + 2, pa0, pa1, pa2, pa3, pb0, pb1, pb2, pb3)
    G2_COMPUTE()
    __syncthreads();
    G2_STORE(qa0, qa1, qa2, qa3, qb0, qb1, qb2, qb3)
    __syncthreads();
    if (kt + 3 < nk) G2_LOAD(kt + 3, qa0, qa1, qa2, qa3, qb0, qb1, qb2, qb3)
    G2_COMPUTE()
  }
#undef G2_LOAD
#undef G2_STORE
#undef G2_COMPUTE
}
DI void g3_rowpiece(int tid, int q, bool n64, int& row, int& pc) {
  const int w = tid >> 6, lane = tid & 63, chunk = n64 ? (2 * w + q) : (4 * w + q);
  row = 8 * chunk + (lane >> 3);
  pc = (lane & 7) ^ ((row >> 1) & 7);
}
DI const u16* g3_ptr(const u16* base, long ld, int tid, int q, bool n64) {
  int row, pc; g3_rowpiece(tid, q, n64, row, pc);
  return base + (long)row * ld + pc * 8;
}
template <int NTW, bool LEAN = false>
DI void gemm3(f32x4 (&acc)[4][NTW], const u16* ap0, const u16* ap1, const u16* ap2, const u16* ap3, long a_kstep,
              const u16* bp0, const u16* bp1, const u16* bp2, const u16* bp3, int K, u16* sbase, long a16 = 0, long b16 = 0) {
  constexpr int BN = 32 * NTW, STAGE = 16384;
  const int tid = TID(), lane = tid & 63, w = tid >> 6, r16 = lane & 15, quad = lane >> 4;
  const int wm = w >> 1, wn = w & 1;
  const int sz = (r16 >> 1) & 7;
  const int wu = __builtin_amdgcn_readfirstlane(w);
#define G3_GLDS(GP, LOFF) asm volatile("s_mov_b32 m0, %1\n\ts_nop 0\n\tglobal_load_lds_dwordx4 %0, off" :: "v"(GP), "s"(LOFF) : "memory", "m0")
  const unsigned lds0 = (unsigned)(size_t)sbase;
#define G3_ISSUE(KT) { const unsigned st_ = lds0 + (((KT) & 1) ? STAGE * 2 : 0); const long ka_ = (long)(KT) * a_kstep, kb_ = (long)(KT) * 64; \
    if (BN == 128) { \
      const unsigned la_ = __builtin_amdgcn_readfirstlane(st_ + wu * 4096u); \
      G3_GLDS(ap0 + ka_, la_); G3_GLDS(ap1 + ka_, la_ + 1024u); \
      if (a16) { G3_GLDS(ap0 + (ka_ + a16), la_ + 2048u); G3_GLDS(ap1 + (ka_ + a16), la_ + 3072u); } else { G3_GLDS(ap2 + ka_, la_ + 2048u); G3_GLDS(ap3 + ka_, la_ + 3072u); } \
      G3_GLDS(bp0 + kb_, la_ + 16384u); G3_GLDS(bp1 + kb_, la_ + 17408u); \
      if (b16) { G3_GLDS(bp0 + (kb_ + b16), la_ + 18432u); G3_GLDS(bp1 + (kb_ + b16), la_ + 19456u); } else { G3_GLDS(bp2 + kb_, la_ + 18432u); G3_GLDS(bp3 + kb_, la_ + 19456u); } \
    } else { \
      const unsigned la_ = __builtin_amdgcn_readfirstlane(st_ + wu * 4096u); \
      const unsigned lb_ = __builtin_amdgcn_readfirstlane(st_ + 16384u + wu * 2048u); \
      G3_GLDS(ap0 + ka_, la_); G3_GLDS(ap1 + ka_, la_ + 1024u); G3_GLDS(ap2 + ka_, la_ + 2048u); G3_GLDS(ap3 + ka_, la_ + 3072u); \
      G3_GLDS(bp0 + kb_, lb_); G3_GLDS(bp1 + kb_, lb_ + 1024u); \
    } }
#pragma unroll
  for (int mi = 0; mi < 4; ++mi)
#pragma unroll
    for (int ni = 0; ni < NTW; ++ni) acc[mi][ni] = (f32x4){0.f, 0.f, 0.f, 0.f};
  const int nk = K >> 6;
  __syncthreads();
  G3_ISSUE(0)
  if (!LEAN && BN == 128) {
#define G3_PIECE(I, KT) { const unsigned st_ = lds0 + (((KT) & 1) ? STAGE * 2 : 0); const long ka_ = (long)(KT) * a_kstep, kb_ = (long)(KT) * 64; \
      const unsigned la_ = __builtin_amdgcn_readfirstlane(st_ + wu * 4096u); \
      if ((I) == 0) G3_GLDS(ap0 + ka_, la_); else if ((I) == 1) G3_GLDS(ap1 + ka_, la_ + 1024u); \
      else if ((I) == 2) G3_GLDS((a16 ? ap0 + a16 : ap2) + ka_, la_ + 2048u); else if ((I) == 3) G3_GLDS((a16 ? ap1 + a16 : ap3) + ka_, la_ + 3072u); \
      else if ((I) == 4) G3_GLDS(bp0 + kb_, la_ + 16384u); else if ((I) == 5) G3_GLDS(bp1 + kb_, la_ + 17408u); \
      else if ((I) == 6) G3_GLDS((b16 ? bp0 + b16 : bp2) + kb_, la_ + 18432u); else G3_GLDS((b16 ? bp1 + b16 : bp3) + kb_, la_ + 19456u); }
#define G3_STEP(KT, DOISSUE) { const u16* sAs = sbase + ((KT) & 1) * STAGE; const u16* sBs = sAs + 8192; \
      bf16x8 af[2][4], bg[2][NTW];     \
      _Pragma("unroll") for (int ks = 0; ks < 2; ++ks) { \
        const int pcol = ((ks * 4 + quad) ^ sz) * 8; \
        _Pragma("unroll") for (int mi = 0; mi < 4; ++mi) af[ks][mi] = *(const bf16x8*)(sAs + (wm * 64 + 16 * mi + r16) * 64 + pcol); \
        _Pragma("unroll") for (int ni = 0; ni < NTW; ++ni) bg[ks][ni] = *(const bf16x8*)(sBs + (wn * (BN / 2) + 16 * ni + r16) * 64 + pcol); } \
      __builtin_amdgcn_s_setprio(1);     \
      _Pragma("unroll") for (int mi = 0; mi < 4; ++mi) {   \
        acc[mi][0] = __builtin_amdgcn_mfma_f32_16x16x32_bf16(af[0][mi], bg[0][0], acc[mi][0], 0, 0, 0); \
        acc[mi][1] = __builtin_amdgcn_mfma_f32_16x16x32_bf16(af[0][mi], bg[0][1], acc[mi][1], 0, 0, 0); \
        if (DOISSUE) G3_PIECE(2 * mi, (KT) + 1) \
        __builtin_amdgcn_sched_barrier(0); \
        acc[mi][2] = __builtin_amdgcn_mfma_f32_16x16x32_bf16(af[0][mi], bg[0][2], acc[mi][2], 0, 0, 0); \
        acc[mi][3] = __builtin_amdgcn_mfma_f32_16x16x32_bf16(af[0][mi], bg[0][3], acc[mi][3], 0, 0, 0); \
        if (DOISSUE) G3_PIECE(2 * mi + 1, (KT) + 1) \
        __builtin_amdgcn_sched_barrier(0); } \
      _Pragma("unroll") for (int mi = 0; mi < 4; ++mi) \
        _Pragma("unroll") for (int ni = 0; ni < NTW; ++ni) acc[mi][ni] = __builtin_amdgcn_mfma_f32_16x16x32_bf16(af[1][mi], bg[1][ni], acc[mi][ni], 0, 0, 0); \
      __builtin_amdgcn_s_setprio(0); }
#pragma unroll 1
    for (int kt = 0; kt < nk - 1; ++kt) {
      asm volatile("s_waitcnt vmcnt(0) lgkmcnt(0)" ::: "memory");
      __builtin_amdgcn_s_barrier();
      asm volatile("" ::: "memory");
      G3_STEP(kt, true)
    }
    asm volatile("s_waitcnt vmcnt(0) lgkmcnt(0)" ::: "memory");
    __builtin_amdgcn_s_barrier();
    asm volatile("" ::: "memory");
    G3_STEP(nk - 1, false)
#undef G3_PIECE
#undef G3_STEP
  } else
#pragma unroll 1
  for (int kt = 0; kt < nk; ++kt) {
    asm volatile("s_waitcnt vmcnt(0) lgkmcnt(0)" ::: "memory");
    __builtin_amdgcn_s_barrier();
    asm volatile("" ::: "memory");
    if (kt + 1 < nk) G3_ISSUE(kt + 1)
    const u16* sAs = sbase + (kt & 1) * STAGE;
    const u16* sBs = sAs + 8192;
#pragma unroll 1
    for (int ks = 0; ks < (LEAN ? 2 : 0); ++ks) {
      const int pcol = ((ks * 4 + quad) ^ sz) * 8;
      bf16x8 af[4];
#pragma unroll
      for (int mi = 0; mi < 4; ++mi) af[mi] = *(const bf16x8*)(sAs + (wm * 64 + 16 * mi + r16) * 64 + pcol);
#pragma unroll
      for (int ni = 0; ni < NTW; ++ni) {
        bf16x8 b1 = *(const bf16x8*)(sBs + (wn * (BN / 2) + 16 * ni + r16) * 64 + pcol);
#pragma unroll
        for (int mi = 0; mi < 4; ++mi) acc[mi][ni] = __builtin_amdgcn_mfma_f32_16x16x32_bf16(af[mi], b1, acc[mi][ni], 0, 0, 0);
      }
    }
#pragma unroll
    for (int ks = 0; ks < (LEAN ? 0 : 2); ++ks) {
      const int pcol = ((ks * 4 + quad) ^ sz) * 8;
      bf16x8 af[4], bg[NTW];
#pragma unroll
      for (int mi = 0; mi < 4; ++mi) af[mi] = *(const bf16x8*)(sAs + (wm * 64 + 16 * mi + r16) * 64 + pcol);
#pragma unroll
      for (int ni = 0; ni < NTW; ++ni) bg[ni] = *(const bf16x8*)(sBs + (wn * (BN / 2) + 16 * ni + r16) * 64 + pcol);
#pragma unroll
      for (int mi = 0; mi < 4; ++mi)
#pragma unroll
        for (int ni = 0; ni < NTW; ++ni) acc[mi][ni] = __builtin_amdgcn_mfma_f32_16x16x32_bf16(af[mi], bg[ni], acc[mi][ni], 0, 0, 0);
    }
  }
#undef G3_ISSUE
#undef G3_GLDS
}
template <int NCOLS>
DI void store_tile_bf16(const u16* sC, u16* gdst, long ld, int rows_valid) {
  constexpr int CPR = NCOLS / 8, LS = NCOLS + 8;
  const int tid = TID();
#pragma unroll
  for (int q = 0; q < (128 * CPR) / 256; ++q) {
    const int c = tid + 256 * q, row = c / CPR, ch = c % CPR;
    if (row < rows_valid) *(uint4*)(gdst + (long)row * ld + ch * 8) = *(const uint4*)(sC + row * LS + ch * 8);
  }
}
DI int pair_col(int np, int& which) {
  const int nt = np >> 7, c = np & 127, wn = c >> 6, ni = (c >> 4) & 3, r = c & 15;
  which = ni >> 1;
  return nt * 64 + wn * 32 + (ni & 1) * 16 + r;
}
DI const float* conv_colptr(const Params& P, int l, int mat, int np, long& ld) {
  int which;
  switch (mat) {
    case 0: ld = DIN; return P.in[3] + (long)l * DM * DIN + proj_src_col(np);
    case 1: ld = DIN; return P.in[3] + (long)l * DM * DIN + 2708 + np;
    case 2: ld = DM; return P.in[24] + ((long)(l * 4 + (np >> 10)) * 256) * DM + (np & 1023);
    case 3: ld = DM; return P.in[25] + (long)l * DM * DM + np;
    case 4: { int o = pair_col(np, which); ld = DFF; return (which ? P.in[28] : P.in[27]) + (long)l * DM * DFF + o; }
    case 5: ld = DM; return P.in[29] + (long)l * DFF * DM + np;
    case 6: { int o = pair_col(np, which); ld = 512; return P.in[19] + (long)l * 256 * 512 + which * 256 + o; }
    case 7: ld = 256; return P.in[(np >> 8) ? 9 : 7] + (long)l * 2048 * 256 + (np & 255);
    default: ld = 64; return P.in[(np >> 6) ? 10 : 8] + (long)l * 256 * 64 + (np & 63);
  }
}
DI void phase_convert(const Params& P, int l, float* lds) {
  const int tid = TID();
  if (blockIdx.x < 64) {
    const int kv = blockIdx.x >> 5, ks = blockIdx.x & 31;
    const float* pos = P.in[6] + (long)(l * 2 + kv) * 2048 + ks * 64;
    const float* w1 = P.in[kv ? 9 : 7] + (long)l * 2048 * 256 + (long)ks * 64 * 256 + tid;
    float a = 0.f;
#pragma unroll 8
    for (int k = 0; k < 64; ++k) a += pos[k] * w1[(long)k * 256];
    ((float*)(WSP(P) + WS_CBIAS))[(kv * 32 + ks) * 256 + tid] = a;
  }
  const int NB_[9] = {44, 64, 64, 16, 88, 16, 8, 8, 2};
  const int KB_[9] = {16, 16, 4, 16, 16, 44, 4, 32, 4};
  const size_t OFF_[9] = {WT_IN, WT_G, WT_BR, WT_OUT, WT_GU, WT_D, WT_GLU, WT_C1, WT_C2};
  for (int it = blockIdx.x; it < 4648; it += gridDim.x) {
    int r = it, mat = 0, nbk = 0, kbk = 0; size_t off = 0;
#pragma unroll
    for (int q = 0; q < 9; ++q) { int n = NB_[q] * KB_[q]; if (r >= 0 && r < n) { mat = q; nbk = NB_[q]; kbk = KB_[q]; off = OFF_[q]; r -= 100000; } else if (r >= 0) r -= n; }
    r += 100000;
    const int nb = r / kbk, kb = r % kbk, K = kbk * 64;
    (void)nbk;
    __syncthreads();
    {
      const int n = tid & 63;
      long ld; const float* cp = conv_colptr(P, l, mat, nb * 64 + n, ld);
#pragma unroll 4
      for (int q = 0; q < 16; ++q) { int k = (tid >> 6) + 4 * q; lds[n * 65 + k] = cp[(long)(kb * 64 + k) * ld]; }
    }
    __syncthreads();
    u16* dst = (u16*)(WSP(P) + WS_W + off);
#pragma unroll
    for (int q = 0; q < 2; ++q) {
      int c = tid + 256 * q, n = c >> 3, k8 = (c & 7) * 8;
      const float* sp = lds + n * 65 + k8;
      uint4 v; v.x = pk2(sp[0], sp[1]); v.y = pk2(sp[2], sp[3]); v.z = pk2(sp[4], sp[5]); v.w = pk2(sp[6], sp[7]);
      *(uint4*)(dst + (long)(nb * 64 + n) * K + kb * 64 + k8) = v;
    }
  }
}

DI void st_mma(f32x4 (&st)[4], const u16* sK, const bf16x8 (&bq)[2], int lane) {
  const int r = lane & 15, quad = lane >> 4;
#pragma unroll
  for (int mt = 0; mt < 4; ++mt) {
    f32x4 a = {0.f, 0.f, 0.f, 0.f};
#pragma unroll
    for (int ks = 0; ks < 2; ++ks) {
      bf16x8 kf = *(const bf16x8*)(sK + (16 * mt + r) * 72 + ks * 32 + quad * 8);
      a = __builtin_amdgcn_mfma_f32_16x16x32_bf16(kf, bq[ks], a, 0, 0, 0);
    }
    st[mt] = a;
  }
}
DI void pv_mma(f32x4 (&ot)[4], const u16* sVt, const f32x4 (&p)[4], int lane) {
  const int r = lane & 15, quad = lane >> 4;
#pragma unroll
  for (int ks = 0; ks < 2; ++ks) {
    uint4 pu;
    pu.x = pk2(p[2 * ks][0], p[2 * ks][1]); pu.y = pk2(p[2 * ks][2], p[2 * ks][3]);
    pu.z = pk2(p[2 * ks + 1][0], p[2 * ks + 1][1]); pu.w = pk2(p[2 * ks + 1][2], p[2 * ks + 1][3]);
    bf16x8 pb = __builtin_bit_cast(bf16x8, pu);
#pragma unroll
    for (int dt = 0; dt < 4; ++dt) {
      const u16* vrow = sVt + (16 * dt + r) * 72;
      s16x4 lo = *(const s16x4*)(vrow + ((32 * ks + 4 * quad) ^ (16 * dt)));
      s16x4 hi = *(const s16x4*)(vrow + ((32 * ks + 16 + 4 * quad) ^ (16 * dt)));
      bf16x8 vf = __builtin_shufflevector(lo, hi, 0, 1, 2, 3, 4, 5, 6, 7);
      ot[dt] = __builtin_amdgcn_mfma_f32_16x16x32_bf16(vf, pb, ot[dt], 0, 0, 0);
    }
  }
}
DI void load_tile(u16* dst, const u16* src, long ld) {
  const int tid = TID();
#pragma unroll
  for (int i = 0; i < 2; ++i) {
    int c = tid + 256 * i, row = c >> 3, ch = c & 7;
    uint4 v = *(const uint4*)(src + (long)row * ld + ch * 8);
    *(uint4*)(dst + row * 72 + ch * 8) = v;
  }
}
DI void load_tile_T(u16* dst, const u16* src, long ld) {
  const int tid = TID();
#pragma unroll
  for (int i = 0; i < 2; ++i) {
    int c = tid + 256 * i, row = c >> 3, ch = c & 7;
    uint4 v = *(const uint4*)(src + (long)row * ld + ch * 8);
    const unsigned* vv = (const unsigned*)&v;
#pragma unroll
    for (int q = 0; q < 4; ++q) {
      dst[(ch * 8 + 2 * q) * 72 + row] = (u16)(vv[q] & 0xffff);
      dst[(ch * 8 + 2 * q + 1) * 72 + row] = (u16)(vv[q] >> 16);
    }
  }
}
DI void load_q_nsa(u16* dst, const u16* src, long ld) {
  const int tid = TID();
#pragma unroll
  for (int i = 0; i < 2; ++i) {
    int c = tid + 256 * i, row = c >> 3, ch = c & 7;
    uint4 v = *(const uint4*)(src + (long)(row & 15) * ld + (row >> 4) * 64 + ch * 8);
    *(uint4*)(dst + row * 72 + ch * 8) = v;
  }
}
DI void load_qfrag(bf16x8 (&bq)[2], const u16* sQ, int w, int lane) {
  const int r = lane & 15, quad = lane >> 4;
  bq[0] = *(const bf16x8*)(sQ + (16 * w + r) * 72 + quad * 8);
  bq[1] = *(const bf16x8*)(sQ + (16 * w + r) * 72 + 32 + quad * 8);
}
DI float quad_max(float v) { v = fmaxf(v, __shfl_xor(v, 16)); v = fmaxf(v, __shfl_xor(v, 32)); return v; }
DI float quad_sum(float v) { v += __shfl_xor(v, 16); v += __shfl_xor(v, 32); return v; }

DI void softmax_tile(f32x4 (&st)[4], const bool (&msk)[4][4], float& m, float& l, f32x4 (&ot)[4]) {
  float tm = -1e30f;
#pragma unroll
  for (int mt = 0; mt < 4; ++mt)
#pragma unroll
    for (int j = 0; j < 4; ++j) { float s = st[mt][j] * 0.125f; st[mt][j] = s; if (msk[mt][j]) tm = fmaxf(tm, s); }
  tm = quad_max(tm);
  float mn = fmaxf(m, tm);
  float alpha = __expf(m - mn);
  float ps = 0.f;
#pragma unroll
  for (int mt = 0; mt < 4; ++mt)
#pragma unroll
    for (int j = 0; j < 4; ++j) { float p = msk[mt][j] ? __expf(st[mt][j] - mn) : 0.f; st[mt][j] = p; ps += p; }
  l = l * alpha + ps;
  m = mn;
#pragma unroll
  for (int dt = 0; dt < 4; ++dt)
#pragma unroll
    for (int j = 0; j < 4; ++j) ot[dt][j] *= alpha;
}

DI void phase_rmsnorm(const float* __restrict__ x, const float* __restrict__ wgt, u16* __restrict__ H) {
  const int lane = TID() & 63, w = TID() >> 6;
  const int gw = blockIdx.x * 4 + w, nw = gridDim.x * 4;
  for (int row = gw; row < T_; row += nw) {
    const float4* xr = (const float4*)(x + (long)row * DM);
    float4 v[4]; float s = 0.f;
#pragma unroll
    for (int j = 0; j < 4; ++j) { v[j] = xr[lane + 64 * j]; s += v[j].x * v[j].x + v[j].y * v[j].y + v[j].z * v[j].z + v[j].w * v[j].w; }
    s = wave_sum(s);
    float r = rsqrtf(s * (1.f / DM) + EPS);
#pragma unroll
    for (int j = 0; j < 4; ++j) {
      float4 g = ((const float4*)wgt)[lane + 64 * j];
      uint2 o; o.x = pk2(v[j].x * r * g.x, v[j].y * r * g.y); o.y = pk2(v[j].z * r * g.z, v[j].w * r * g.w);
      *(uint2*)(H + (long)row * DM + (lane + 64 * j) * 4) = o;
    }
  }
}
DI void phase_rope_table(const int* __restrict__ positions, float* __restrict__ COS, float* __restrict__ SIN) {
  const float invf[8] = {1.0f, 0.1939227432012558f, 0.03760603070259094f, 0.007292664609849453f,
                         0.0014142135623842478f, 0.00027424818836152554f, 5.3182957344688475e-05f, 1.0313385246263351e-05f};
  for (int idx = blockIdx.x * 256 + TID(); idx < T_ * 8; idx += gridDim.x * 256) {
    int i = idx & 7;
    float f = invf[0];
#pragma unroll
    for (int q = 1; q < 8; ++q) f = (i == q) ? invf[q] : f;
    float ang = (float)positions[idx >> 3] * f;
    double s, c; sincos_d((double)ang, s, c);
    COS[idx] = (float)c; SIN[idx] = (float)s;
  }
}

struct S5Coef { float ar, ai; float bbr[16], bbi[16]; };
DI void s5_coef(const Params& P, int l, int g, int p, S5Coef& C) {
  float dt = expf(P.in[13][l * 16 + g]);
  float lr = P.in[11][(l * 16 + g) * 64 + p], li = P.in[12][(l * 16 + g) * 64 + p];
  float mag = expf(lr * dt);
  double s, c; sincos_d((double)(li * dt), s, c);
  C.ar = mag * (float)c; C.ai = mag * (float)s;
  float den = lr * lr + li * li;
  float fr = ((C.ar - 1.f) * lr + C.ai * li) / den;
  float fi = (C.ai * lr - (C.ar - 1.f) * li) / den;
  const float* br = P.in[14] + ((long)(l * 16 + g) * 64 + p) * 16;
  const float* bi = P.in[15] + ((long)(l * 16 + g) * 64 + p) * 16;
#pragma unroll
  for (int c2 = 0; c2 < 16; ++c2) {
    float b_r = br[c2], b_i = bi[c2];
    C.bbr[c2] = fr * b_r - fi * b_i;
    C.bbi[c2] = fr * b_i + fi * b_r;
  }
}
DI void s5_load_u(float* su, const u16* PROJ, int b, int chunk, int g, int lane) {
  const u16* src = PROJ + ((long)(b * SEQ + chunk * 64 + lane)) * PW + P_S5U + g * 16;
  uint4 v0 = ((const uint4*)src)[0], v1 = ((const uint4*)src)[1];
  const unsigned* a = (const unsigned*)&v0; const unsigned* c = (const unsigned*)&v1;
  float* d = su + lane * 16;
#pragma unroll
  for (int q = 0; q < 4; ++q) { d[2 * q] = bf2f((u16)(a[q] & 0xffff)); d[2 * q + 1] = bf2f((u16)(a[q] >> 16)); }
#pragma unroll
  for (int q = 0; q < 4; ++q) { d[8 + 2 * q] = bf2f((u16)(c[q] & 0xffff)); d[8 + 2 * q + 1] = bf2f((u16)(c[q] >> 16)); }
}

DI void s5_pass1_item(const Params& P, int l, int it, float* lds) {
  const int lane = TID() & 63, w = TID() >> 6;
  const int gq = it & 3, chunk = (it >> 2) & 63, b = it >> 8;
  const int g = gq * 4 + w;
  const u16* PROJ = (const u16*)(WSP(P) + WS_PROJ);
  float* su = lds + w * 1024;
  S5Coef C; s5_coef(P, l, g, lane, C);
  s5_load_u(su, PROJ, b, chunk, g, lane);
  __syncthreads();
  float xr = 0.f, xi = 0.f;
#pragma unroll 4
  for (int t = 0; t < 64; ++t) {
    const f32x4* up = (const f32x4*)(su + t * 16);
    float br = 0.f, bi = 0.f;
#pragma unroll
    for (int q = 0; q < 4; ++q) {
      f32x4 u = up[q];
#pragma unroll
      for (int e = 0; e < 4; ++e) { br += u[e] * C.bbr[4 * q + e]; bi += u[e] * C.bbi[4 * q + e]; }
    }
    float nr = C.ar * xr - C.ai * xi + br;
    float ni = C.ar * xi + C.ai * xr + bi;
    xr = nr; xi = ni;
  }
  float2* ENDS = (float2*)(WSP(P) + WS_ENDS);
  ENDS[((long)(b * 64 + chunk) * 16 + g) * 64 + lane] = make_float2(xr, xi);
}

DI void s5_carry_item(const Params& P, int l, int it) {
  const int idx = it * 256 + TID();
  const int b = idx >> 10, gp = idx & 1023, g = gp >> 6, p = gp & 63;
  float dt = expf(P.in[13][l * 16 + g]);
  float lr = P.in[11][(l * 16 + g) * 64 + p], li = P.in[12][(l * 16 + g) * 64 + p];
  float mag = expf(lr * dt * 64.f);
  double s, c; sincos_d((double)(li * dt) * 64.0, s, c);
  float ar = mag * (float)c, ai = mag * (float)s;
  const float2* ENDS = (const float2*)(WSP(P) + WS_ENDS);
  float2* CARRY = (float2*)(WSP(P) + WS_CARRY);
  float xr = 0.f, xi = 0.f;
  for (int ch = 0; ch < 64; ++ch) {
    long o = ((long)(b * 64 + ch) * 16 + g) * 64 + p;
    CARRY[o] = make_float2(xr, xi);
    float2 e = ENDS[o];
    float nr = ar * xr - ai * xi + e.x;
    float ni = ar * xi + ai * xr + e.y;
    xr = nr; xi = ni;
  }
}

DI void s5_pass2_item(const Params& P, int l, int it, float* lds) {
  const int lane = TID() & 63, w = TID() >> 6, r16 = lane & 15, quad = lane >> 4;
  const int gq = it & 3, chunk = (it >> 2) & 63, b = it >> 8;
  const int g = gq * 4 + w;
  const u16* PROJ = (const u16*)(WSP(P) + WS_PROJ);
  u16* Y5 = (u16*)(WSP(P) + WS_Y5);
  float* su = lds + w * 1024;
  u16* sX = (u16*)(lds + 4096) + w * (32 * 136);
  S5Coef C; s5_coef(P, l, g, lane, C);
  bf16x8 bfr[4];
#pragma unroll
  for (int ks = 0; ks < 4; ++ks) {
    const float* src = P.in[(ks < 2) ? 16 : 17] + ((long)(l * 16 + g) * 16 + r16) * 64 + (ks & 1) * 32 + quad * 8;
    const float4 v0 = ((const float4*)src)[0], v1 = ((const float4*)src)[1];
    const float sg = (ks < 2) ? 1.f : -1.f;
    uint4 pu; pu.x = pk2(sg * v0.x, sg * v0.y); pu.y = pk2(sg * v0.z, sg * v0.w); pu.z = pk2(sg * v1.x, sg * v1.y); pu.w = pk2(sg * v1.z, sg * v1.w);
    bfr[ks] = __builtin_bit_cast(bf16x8, pu);
  }
  const float dsk = P.in[18][l * 256 + g * 16 + r16];
  s5_load_u(su, PROJ, b, chunk, g, lane);
  __syncthreads();
  const float2 c0 = ((const float2*)(WSP(P) + WS_CARRY))[((long)(b * 64 + chunk) * 16 + g) * 64 + lane];
  float xr = c0.x, xi = c0.y;
  for (int half = 0; half < 2; ++half) {
#pragma unroll 4
    for (int tt = 0; tt < 32; ++tt) {
      const int t = half * 32 + tt;
      const f32x4* up = (const f32x4*)(su + t * 16);
      float br0 = 0.f, bi0 = 0.f, br1 = 0.f, bi1 = 0.f;
#pragma unroll
      for (int q = 0; q < 4; ++q) {
        f32x4 u = up[q];
        br0 += u[0] * C.bbr[4 * q + 0]; bi0 += u[0] * C.bbi[4 * q + 0];
        br1 += u[1] * C.bbr[4 * q + 1]; bi1 += u[1] * C.bbi[4 * q + 1];
        br0 += u[2] * C.bbr[4 * q + 2]; bi0 += u[2] * C.bbi[4 * q + 2];
        br1 += u[3] * C.bbr[4 * q + 3]; bi1 += u[3] * C.bbi[4 * q + 3];
      }
      const float nr = C.ar * xr - C.ai * xi + (br0 + br1);
      const float ni = C.ar * xi + C.ai * xr + (bi0 + bi1);
      xr = nr; xi = ni;
      sX[tt * 136 + lane] = f2bf(xr);
      sX[tt * 136 + 64 + lane] = f2bf(xi);
    }
    __syncthreads();
#pragma unroll
    for (int mt = 0; mt < 2; ++mt) {
      f32x4 acc = {0.f, 0.f, 0.f, 0.f};
#pragma unroll
      for (int ks = 0; ks < 4; ++ks) {
        const bf16x8 af = *(const bf16x8*)(sX + (16 * mt + r16) * 136 + ks * 32 + quad * 8);
        acc = __builtin_amdgcn_mfma_f32_16x16x32_bf16(af, bfr[ks], acc, 0, 0, 0);
      }
#pragma unroll
      for (int j = 0; j < 4; ++j) {
        const int t = half * 32 + 16 * mt + 4 * quad + j;
        const float y = acc[j] + dsk * su[t * 16 + r16];
        Y5[((long)(b * SEQ + chunk * 64 + t)) * 256 + g * 16 + r16] = f2bf(gelu_tanh(y));
      }
    }
    __syncthreads();
  }
}

DI void nsa_prep_item(const Params& P, int l, int it) {
  const int lane = TID() & 63, w = TID() >> 6;
  u16* PROJ = (u16*)(WSP(P) + WS_PROJ);
  u16* QR = (u16*)(WSP(P) + WS_QR);
  const float* COS = (const float*)(WSP(P) + WS_COS);
  const float* SIN = (const float*)(WSP(P) + WS_SIN);
  for (int tt = 0; tt < 4; ++tt) {
    const long t = (long)it * 16 + w * 4 + tt;
    const float cs = COS[t * 8 + (lane & 7)], sn = SIN[t * 8 + (lane & 7)];
#pragma unroll
    for (int g = 0; g < 6; ++g) {
      const int col = (g < 4) ? (P_Q + g * 64) : (g == 4 ? P_KV + 128 : P_KV + 256);
      const float wg = (g < 4) ? P.in[4][l * 64 + lane] : P.in[5][(l * 3 + (g - 3)) * 64 + lane];
      u16* ptr = PROJ + t * PW + col + lane;
      float v = bf2f(*ptr);
      float ss = wave_sum(v * v);
      float y = v * rsqrtf(ss * (1.f / 64.f) + EPS) * wg;
      float pr = __shfl_xor(y, 8);
      float rot = (lane < 8) ? (y * cs - pr * sn) : ((lane < 16) ? (y * cs + pr * sn) : y);
      if (g < 4) { *ptr = f2bf(y); QR[t * 256 + g * 64 + lane] = f2bf(rot); }
      else *ptr = f2bf(rot);
    }
  }
}

DI void cmp1_tile(const Params& P, int l, int ct, u16* sA, u16* sB) {
  const int tid = TID(), lane = tid & 63, w = tid >> 6, r16 = lane & 15, quad = lane >> 4, wm = w >> 1, wn = w & 1;
  const int kv = ct >> 5, mt = (ct >> 1) & 15, nt = ct & 1;
  const u16* PROJ = (const u16*)(WSP(P) + WS_PROJ);
  u16* HID = (u16*)(WSP(P) + WS_HID);
  const u16* apq[4];
#pragma unroll
  for (int q = 0; q < 4; ++q) {
    int row, pc; g3_rowpiece(tid, q, false, row, pc);
    int gr = mt * 128 + row; if (gr > 2039) gr = 2039;
    const int b = gr / 255, n = gr % 255;
    apq[q] = PROJ + ((long)(b * SEQ + 16 * n)) * PW + P_KV + kv * 64 + pc * 8;
  }
  const u16* Bb = (const u16*)(WSP(P) + WS_W + WT_C1) + ((long)(kv * 256 + nt * 128)) * 2048;
  f32x4 acc[4][4];
  gemm3<4>(acc, apq[0], apq[1], apq[2], apq[3], PW,
           g3_ptr(Bb, 2048, tid, 0, false), g3_ptr(Bb, 2048, tid, 1, false), g3_ptr(Bb, 2048, tid, 2, false), g3_ptr(Bb, 2048, tid, 3, false), 2048, sA);
  {
    const float* PART = (const float*)(WSP(P) + WS_CBIAS) + (long)kv * 32 * 256;
#pragma unroll
    for (int ni = 0; ni < 4; ++ni) {
      const int col = nt * 128 + wn * 64 + 16 * ni + r16;
      float bsum = 0.f;
      for (int sl = 0; sl < 32; ++sl) bsum += PART[sl * 256 + col];
#pragma unroll
      for (int mi = 0; mi < 4; ++mi)
#pragma unroll
        for (int j = 0; j < 4; ++j) acc[mi][ni][j] += bsum;
    }
  }
  __syncthreads();
#pragma unroll
  for (int mi = 0; mi < 4; ++mi)
#pragma unroll
    for (int ni = 0; ni < 4; ++ni)
#pragma unroll
      for (int j = 0; j < 4; ++j) sA[(wm * 64 + 16 * mi + 4 * quad + j) * 136 + wn * 64 + 16 * ni + r16] = f2bf(gelu_tanh(acc[mi][ni][j]));
  __syncthreads();
  store_tile_bf16<128>(sA, HID + ((long)kv * 2048 + mt * 128) * 256 + nt * 128, 256, 2040 - mt * 128);
}
DI void cmp2_tile(const Params& P, int l, int ct, u16* sA, u16* sB, float* sSS) {
  const int tid = TID(), lane = tid & 63, w = tid >> 6, r16 = lane & 15, quad = lane >> 4, wm = w >> 1, wn = w & 1;
  const int kv = ct >> 4, mt = ct & 15;
  const u16* HID = (const u16*)(WSP(P) + WS_HID);
  u16* OUT = (u16*)(WSP(P) + (kv ? WS_VC : WS_KC));
  const u16* Ab = HID + ((long)kv * 2048 + mt * 128) * 256;
  const u16* Bb = (const u16*)(WSP(P) + WS_W + WT_C2) + (long)kv * 64 * 256;
  f32x4 acc[4][2];
  gemm3<2>(acc, g3_ptr(Ab, 256, tid, 0, false), g3_ptr(Ab, 256, tid, 1, false), g3_ptr(Ab, 256, tid, 2, false), g3_ptr(Ab, 256, tid, 3, false), 64,
           g3_ptr(Bb, 256, tid, 0, true), g3_ptr(Bb, 256, tid, 1, true), nullptr, nullptr, 256, sA);
  __syncthreads();
  if (tid < 128) sSS[tid] = 0.f;
  __syncthreads();
#pragma unroll
  for (int mi = 0; mi < 4; ++mi)
#pragma unroll
    for (int j = 0; j < 4; ++j) {
      float ss = acc[mi][0][j] * acc[mi][0][j] + acc[mi][1][j] * acc[mi][1][j];
      ss += __shfl_xor(ss, 1); ss += __shfl_xor(ss, 2); ss += __shfl_xor(ss, 4); ss += __shfl_xor(ss, 8);
      if (r16 == 0) atomicAdd(&sSS[wm * 64 + 16 * mi + 4 * quad + j], ss);
    }
  __syncthreads();
#pragma unroll
  for (int mi = 0; mi < 4; ++mi)
#pragma unroll
    for (int j = 0; j < 4; ++j) {
      const int rl = wm * 64 + 16 * mi + 4 * quad + j, row = mt * 128 + rl;
      const float sc = (kv == 0) ? rsqrtf(sSS[rl] * (1.f / 64.f) + EPS) : 1.f;
      if (row < 2040) {
        int b = row / 255, n = row % 255;
#pragma unroll
        for (int ni = 0; ni < 2; ++ni) {
          int col = wn * 32 + 16 * ni + r16;
          float v = acc[mi][ni][j] * sc;
          if (kv == 0) v *= P.in[5][(l * 3 + 0) * 64 + col];
          OUT[((long)(b * 256 + n)) * 64 + col] = f2bf(v);
        }
      }
    }
}

DI void gdn_p1_item(const Params& P, int l, int it, float* lds) {
  const int tid = TID(), lane = tid & 63, w = tid >> 6, r16 = lane & 15, quad = lane >> 4;
  const int chunk = it & 63, h = (it >> 6) & 3, b = it >> 8;
  const long ci = it;
  const u16* PROJ = (const u16*)(WSP(P) + WS_PROJ);
  float* sq = lds;
  float* sk = lds + 64 * 65;
  float* sv = lds + 2 * 64 * 65;
  float* sG = lds + 3 * 64 * 65;
  float* sBeta = sG + 64;
  float* sg = sBeta + 64;
  u16* sQb = (u16*)(sg + 64);
  u16* sKb = sQb + 64 * 72;
  const float* cw = P.in[20] + (long)l * 4 * 768;
  if (tid < 192) {
    const int cp = tid % 96, th = tid / 96;
    const int c0 = 2 * cp, which = c0 >> 6, d = c0 & 63, C = which * 256 + h * 64 + d;
    float w0[4], w1[4];
#pragma unroll
    for (int k = 0; k < 4; ++k) { w0[k] = cw[k * 768 + C]; w1[k] = cw[k * 768 + C + 1]; }
    unsigned v[35];
    const int s0 = chunk * 64 + th * 32 - 3;
    const u16* src = PROJ + ((long)(b * SEQ + s0)) * PW + P_GQKV + C;
#pragma unroll
    for (int k = 0; k < 35; ++k) v[k] = (s0 + k >= 0) ? *(const unsigned*)(src + (long)k * PW) : 0u;
    float* dst = lds + which * 64 * 65 + (th * 32) * 65 + d;
#pragma unroll
    for (int tt = 0; tt < 32; ++tt) {
      float a0 = 0.f, a1 = 0.f;
#pragma unroll
      for (int k = 0; k < 4; ++k) { a0 += w0[k] * bf2f((u16)(v[tt + k] & 0xffff)); a1 += w1[k] * bf2f((u16)(v[tt + k] >> 16)); }
      dst[tt * 65] = siluf_(a0); dst[tt * 65 + 1] = siluf_(a1);
    }
  }
  __syncthreads();
  if (tid < 128) {
    float* base = (tid < 64) ? sq : sk;
    u16* bb = (tid < 64) ? sQb : sKb;
    const int row = tid & 63;
    float ss = 0.f;
#pragma unroll 8
    for (int d = 0; d < 64; ++d) { float x = base[row * 65 + d]; ss += x * x; }
    const float sc = rsqrtf(ss + EPS) * ((tid < 64) ? 0.125f : 1.f);
#pragma unroll 8
    for (int d = 0; d < 64; d += 2) {
      const float x0 = base[row * 65 + d] * sc, x1 = base[row * 65 + d + 1] * sc;
      base[row * 65 + d] = x0; base[row * 65 + d + 1] = x1;
      *(unsigned*)(bb + row * 72 + d) = pk2(x0, x1);
    }
  } else if (tid < 192) {
    const int row = tid - 128;
    const long t = (long)(b * SEQ + chunk * 64 + row);
    const float bl = bf2f(PROJ[t * PW + P_GB + h]);
    const float al = bf2f(PROJ[t * PW + P_GA + h]);
    sBeta[row] = sigmoidf_(bl);
    sg[row] = -expf(P.in[21][l * 4 + h]) * softplusf_(al + P.in[22][l * 4 + h]);
  }
  __syncthreads();
  if (tid < 64) {
    float x = sg[tid];
#pragma unroll
    for (int o = 1; o < 64; o <<= 1) { float u = __shfl_up(x, o); if (tid >= o) x += u; }
    sG[tid] = x;
    ((float*)(WSP(P) + WS_GG))[ci * 64 + tid] = x;
  }
  __syncthreads();
  f32x4 lreg[4];
  {
    const f32x4 Gi4 = *(const f32x4*)(sG + 16 * w + 4 * quad);
    const f32x4 Bi4 = *(const f32x4*)(sBeta + 16 * w + 4 * quad);
    u16* GA = (u16*)(WSP(P) + WS_GA) + ci * 4096;
#pragma unroll
    for (int nt = 0; nt < 4; ++nt) {
      f32x4 aq = {0.f, 0.f, 0.f, 0.f}, ak = {0.f, 0.f, 0.f, 0.f};
#pragma unroll
      for (int ks = 0; ks < 2; ++ks) {
        const bf16x8 fq = *(const bf16x8*)(sQb + (16 * w + r16) * 72 + ks * 32 + quad * 8);
        const bf16x8 fk = *(const bf16x8*)(sKb + (16 * w + r16) * 72 + ks * 32 + quad * 8);
        const bf16x8 fb = *(const bf16x8*)(sKb + (16 * nt + r16) * 72 + ks * 32 + quad * 8);
        aq = __builtin_amdgcn_mfma_f32_16x16x32_bf16(fq, fb, aq, 0, 0, 0);
        ak = __builtin_amdgcn_mfma_f32_16x16x32_bf16(fk, fb, ak, 0, 0, 0);
      }
      const int j = 16 * nt + r16;
      const float Gj = sG[j];
#pragma unroll
      for (int jj = 0; jj < 4; ++jj) {
        const int i = 16 * w + 4 * quad + jj;
        const float dec = __expf(Gi4[jj] - Gj);
        GA[i * 64 + j] = f2bf((j <= i) ? aq[jj] * dec : 0.f);
        const float lv = (j < i) ? Bi4[jj] * ak[jj] * dec : 0.f;
        sq[i * 65 + j] = lv;
        lreg[nt][jj] = lv;
      }
    }
  }
  {
    u16* GQ = (u16*)(WSP(P) + WS_GQ) + ci * 4096;
#pragma unroll
    for (int q = 0; q < 2; ++q) { const int c = tid + 256 * q, row = c >> 3, ch = c & 7; *(uint4*)(GQ + row * 64 + ch * 8) = *(const uint4*)(sQb + row * 72 + ch * 8); }
    const int i = tid >> 2, j0 = (tid & 3) * 16;
    u16* GK = (u16*)(WSP(P) + WS_GK) + ci * 4096 + i * 64 + j0;
    unsigned ok[8];
#pragma unroll
    for (int q = 0; q < 8; ++q) ok[q] = pk2(sk[(j0 + 2 * q) * 65 + i], sk[(j0 + 2 * q + 1) * 65 + i]);
    ((uint4*)GK)[0] = make_uint4(ok[0], ok[1], ok[2], ok[3]); ((uint4*)GK)[1] = make_uint4(ok[4], ok[5], ok[6], ok[7]);
  }
  __syncthreads();
  u16* sLb = sQb;
  u16* sXT = sKb;
  {
    const int i = tid >> 2, j0 = (tid & 3) * 16;
    const float bi = sBeta[i], eg = __expf(sG[i]);
#pragma unroll
    for (int jj = 0; jj < 16; ++jj) { sv[i * 65 + j0 + jj] *= bi; sk[i * 65 + j0 + jj] *= bi * eg; }
#pragma unroll
    for (int nt = 0; nt < 4; ++nt)
#pragma unroll
      for (int jj = 0; jj < 4; ++jj) sLb[(16 * w + 4 * quad + jj) * 72 + 16 * nt + r16] = f2bf(lreg[nt][jj]);
  }
  __syncthreads();
#pragma unroll 1
  for (int bi = 0; bi < 4; ++bi) {
    if (tid < 128) {
      float* buf = (tid < 64) ? sv : sk;
      const int col = tid & 63;
      float x[16];
#pragma unroll
      for (int r = 0; r < 16; ++r) {
        float a0 = buf[(16 * bi + r) * 65 + col], a1 = 0.f;
#pragma unroll
        for (int j = 0; j + 1 < r; j += 2) { a0 -= sq[(16 * bi + r) * 65 + 16 * bi + j] * x[j]; a1 -= sq[(16 * bi + r) * 65 + 16 * bi + j + 1] * x[j + 1]; }
        if (r & 1) a0 -= sq[(16 * bi + r) * 65 + 16 * bi + r - 1] * x[r - 1];
        x[r] = a0 + a1;
        buf[(16 * bi + r) * 65 + col] = x[r];
      }
      uint4 p0, p1;
      p0.x = pk2(x[0], x[1]); p0.y = pk2(x[2], x[3]); p0.z = pk2(x[4], x[5]); p0.w = pk2(x[6], x[7]);
      p1.x = pk2(x[8], x[9]); p1.y = pk2(x[10], x[11]); p1.z = pk2(x[12], x[13]); p1.w = pk2(x[14], x[15]);
      *(uint4*)(sXT + tid * 24) = p0; *(uint4*)(sXT + tid * 24 + 8) = p1;
    }
    __syncthreads();
    if (bi < 3) {
#pragma unroll
      for (int q = 0; q < 2; ++q) {
        const int nt = 2 * w + q, colg = 16 * nt + r16;
        bf16x8 bx = *(const bf16x8*)(sXT + colg * 24 + (quad & 1) * 8);
        if (quad >= 2) bx = (bf16x8){0, 0, 0, 0, 0, 0, 0, 0};
        float* buf = (colg < 64) ? sv : sk;
        const int cc = colg & 63;
        for (int bk = bi + 1; bk < 4; ++bk) {
          const bf16x8 al = *(const bf16x8*)(sLb + (16 * bk + r16) * 72 + 16 * bi + quad * 8);
          f32x4 c = {0.f, 0.f, 0.f, 0.f};
          c = __builtin_amdgcn_mfma_f32_16x16x32_bf16(al, bx, c, 0, 0, 0);
#pragma unroll
          for (int jj = 0; jj < 4; ++jj) buf[(16 * bk + 4 * quad + jj) * 65 + cc] -= c[jj];
        }
      }
    }
    __syncthreads();
  }
  {
    const int i = tid >> 2, j0 = (tid & 3) * 16;
    u16* GU = (u16*)(WSP(P) + WS_GU) + ci * 4096 + i * 64 + j0;
    u16* GW = (u16*)(WSP(P) + WS_GW) + ci * 4096 + i * 64 + j0;
    unsigned ou[8], ow[8];
#pragma unroll
    for (int q = 0; q < 8; ++q) {
      ou[q] = pk2(sv[i * 65 + j0 + 2 * q], sv[i * 65 + j0 + 2 * q + 1]);
      ow[q] = pk2(sk[i * 65 + j0 + 2 * q], sk[i * 65 + j0 + 2 * q + 1]);
    }
    ((uint4*)GU)[0] = make_uint4(ou[0], ou[1], ou[2], ou[3]); ((uint4*)GU)[1] = make_uint4(ou[4], ou[5], ou[6], ou[7]);
    ((uint4*)GW)[0] = make_uint4(ow[0], ow[1], ow[2], ow[3]); ((uint4*)GW)[1] = make_uint4(ow[4], ow[5], ow[6], ow[7]);
  }
}

DI void unpack8(const u16* p, float (&o)[8]) {
  uint4 v = *(const uint4*)p;
  o[0] = bf2f((u16)(v.x & 0xffff)); o[1] = bf2f((u16)(v.x >> 16));
  o[2] = bf2f((u16)(v.y & 0xffff)); o[3] = bf2f((u16)(v.y >> 16));
  o[4] = bf2f((u16)(v.z & 0xffff)); o[5] = bf2f((u16)(v.z >> 16));
  o[6] = bf2f((u16)(v.w & 0xffff)); o[7] = bf2f((u16)(v.w >> 16));
}
DI void st_kt(u16* sKt, int c8, int row, uint4 k) {
  sKt[(c8 + 0) * 72 + row] = (u16)(k.x & 0xffff); sKt[(c8 + 1) * 72 + row] = (u16)(k.x >> 16);
  sKt[(c8 + 2) * 72 + row] = (u16)(k.y & 0xffff); sKt[(c8 + 3) * 72 + row] = (u16)(k.y >> 16);
  sKt[(c8 + 4) * 72 + row] = (u16)(k.z & 0xffff); sKt[(c8 + 5) * 72 + row] = (u16)(k.z >> 16);
  sKt[(c8 + 6) * 72 + row] = (u16)(k.w & 0xffff); sKt[(c8 + 7) * 72 + row] = (u16)(k.w >> 16);
}
DI uint2 pack4bf(const f32x4& v) { uint2 r; r.x = pk2(v[0], v[1]); r.y = pk2(v[2], v[3]); return r; }
DI void gdn_p2_item(const Params& P, int it, float* lds) {
  const int tid = TID(), lane = tid & 63, w = tid >> 6, r16 = lane & 15, quad = lane >> 4;
  const int es = it & 3, bh = it >> 2, b = bh >> 2, h = bh & 3;
  u16* sW = (u16*)lds;
  u16* sQ = sW + 64 * 72;
  u16* sAm = sQ + 64 * 72;
  u16* sKt = sAm + 64 * 72;
  u16* sSt = sKt + 64 * 72;
  u16* sVnT = sSt + 16 * 72;
  u16* sVdT = sVnT + 16 * 72;
  float* sG = (float*)(sVdT + 16 * 72);
  const u16* GQ = (const u16*)(WSP(P) + WS_GQ); const u16* GK = (const u16*)(WSP(P) + WS_GK);
  const u16* GU = (const u16*)(WSP(P) + WS_GU); const u16* GW = (const u16*)(WSP(P) + WS_GW);
  const u16* GA = (const u16*)(WSP(P) + WS_GA); const float* GG = (const float*)(WSP(P) + WS_GG);
  u16* ORAW = (u16*)(WSP(P) + WS_OM) + (long)2 * T_ * 256;
  f32x4 S = {0.f, 0.f, 0.f, 0.f};
  const int irow = 16 * w + 4 * quad;
  uint4 rw0, rw1, rq0, rq1, ra0, ra1, rk0, rk1; u16 ru0, ru1, ru2, ru3; float rg = 0.f;
  const int c0 = tid, c1 = tid + 256;
  const long off0 = (c0 >> 3) * 64 + (c0 & 7) * 8, off1 = (c1 >> 3) * 64 + (c1 & 7) * 8;
#define GDN_GLOAD(CH) { long ci_ = (long)bh * 64 + (CH); \
    rw0 = *(const uint4*)(GW + ci_ * 4096 + off0); rw1 = *(const uint4*)(GW + ci_ * 4096 + off1); \
    rq0 = *(const uint4*)(GQ + ci_ * 4096 + off0); rq1 = *(const uint4*)(GQ + ci_ * 4096 + off1); \
    ra0 = *(const uint4*)(GA + ci_ * 4096 + off0); ra1 = *(const uint4*)(GA + ci_ * 4096 + off1); \
    rk0 = *(const uint4*)(GK + ci_ * 4096 + off0); rk1 = *(const uint4*)(GK + ci_ * 4096 + off1); \
    const u16* up_ = GU + ci_ * 4096 + irow * 64 + es * 16 + r16; \
    ru0 = up_[0]; ru1 = up_[64]; ru2 = up_[128]; ru3 = up_[192]; \
    if (tid < 64) rg = GG[ci_ * 64 + tid]; }
  GDN_GLOAD(0)
  for (int ch = 0; ch < 64; ++ch) {
    __syncthreads();
    {
      const int row0 = c0 >> 3, c80 = (c0 & 7) * 8, row1 = c1 >> 3, c81 = (c1 & 7) * 8;
      *(uint4*)(sW + row0 * 72 + c80) = rw0; *(uint4*)(sW + row1 * 72 + c81) = rw1;
      *(uint4*)(sQ + row0 * 72 + c80) = rq0; *(uint4*)(sQ + row1 * 72 + c81) = rq1;
      *(uint4*)(sAm + row0 * 72 + c80) = ra0; *(uint4*)(sAm + row1 * 72 + c81) = ra1;
      *(uint4*)(sKt + row0 * 72 + c80) = rk0; *(uint4*)(sKt + row1 * 72 + c81) = rk1;
    }
    if (tid < 64) sG[tid] = rg;
    *(uint2*)(sSt + r16 * 72 + irow) = pack4bf(S);
    const f32x4 uc = {bf2f(ru0), bf2f(ru1), bf2f(ru2), bf2f(ru3)};
    __syncthreads();
    if (ch + 1 < 64) GDN_GLOAD(ch + 1)
    f32x4 ws = {0.f, 0.f, 0.f, 0.f}, qs = {0.f, 0.f, 0.f, 0.f};
#pragma unroll
    for (int ks = 0; ks < 2; ++ks) {
      const bf16x8 bS = *(const bf16x8*)(sSt + r16 * 72 + ks * 32 + quad * 8);
      const bf16x8 aW = *(const bf16x8*)(sW + (16 * w + r16) * 72 + ks * 32 + quad * 8);
      const bf16x8 aQ = *(const bf16x8*)(sQ + (16 * w + r16) * 72 + ks * 32 + quad * 8);
      ws = __builtin_amdgcn_mfma_f32_16x16x32_bf16(aW, bS, ws, 0, 0, 0);
      qs = __builtin_amdgcn_mfma_f32_16x16x32_bf16(aQ, bS, qs, 0, 0, 0);
    }
    const float Gl = sG[63];
    const f32x4 G4 = *(const f32x4*)(sG + irow);
    f32x4 vn, vd;
#pragma unroll
    for (int j = 0; j < 4; ++j) { vn[j] = uc[j] - ws[j]; vd[j] = vn[j] * __expf(Gl - G4[j]); }
    *(uint2*)(sVnT + r16 * 72 + irow) = pack4bf(vn);
    *(uint2*)(sVdT + r16 * 72 + irow) = pack4bf(vd);
    __syncthreads();
    f32x4 av = {0.f, 0.f, 0.f, 0.f}, kv = {0.f, 0.f, 0.f, 0.f};
#pragma unroll
    for (int ks = 0; ks < 2; ++ks) {
      const bf16x8 bVn = *(const bf16x8*)(sVnT + r16 * 72 + ks * 32 + quad * 8);
      const bf16x8 bVd = *(const bf16x8*)(sVdT + r16 * 72 + ks * 32 + quad * 8);
      const bf16x8 aA = *(const bf16x8*)(sAm + (16 * w + r16) * 72 + ks * 32 + quad * 8);
      const bf16x8 aK = *(const bf16x8*)(sKt + (16 * w + r16) * 72 + ks * 32 + quad * 8);
      av = __builtin_amdgcn_mfma_f32_16x16x32_bf16(aA, bVn, av, 0, 0, 0);
      kv = __builtin_amdgcn_mfma_f32_16x16x32_bf16(aK, bVd, kv, 0, 0, 0);
    }
    {
      u16* op = ORAW + ((long)(b * SEQ + ch * 64 + irow)) * 256 + h * 64 + es * 16 + r16;
#pragma unroll
      for (int j = 0; j < 4; ++j) op[j * 256] = f2bf(__expf(G4[j]) * qs[j] + av[j]);
    }
    const float gl = __expf(Gl);
#pragma unroll
    for (int j = 0; j < 4; ++j) S[j] = S[j] * gl + kv[j];
  }
#undef GDN_GLOAD
}
DI void gdn_post_item(const Params& P, int l, int it) {
  const int lane = TID() & 63, w = TID() >> 6;
  const u16* PROJ = (const u16*)(WSP(P) + WS_PROJ);
  u16* O = (u16*)(WSP(P) + WS_OM) + (long)2 * T_ * 256;
  const float wn = P.in[23][l * 64 + lane];
#pragma unroll 4
  for (int q = 0; q < 16; ++q) {
    long t = (long)it * 16 + w * 4 + (q >> 2); int h = q & 3;
    float o = bf2f(O[t * 256 + h * 64 + lane]);
    float ss = wave_sum(o * o);
    float y = o * rsqrtf(ss * (1.f / 64.f) + EPS) * wn;
    float z = bf2f(PROJ[t * PW + P_GZ + h * 64 + lane]);
    O[t * 256 + h * 64 + lane] = f2bf(y * siluf_(z));
  }
}

DI void kv_gload(uint4& k0, uint4& k1, uint4& v0, uint4& v1, const u16* ksrc, const u16* vsrc, long ld) {
  const int tid = TID(), r0 = tid >> 3, ch = tid & 7;
  k0 = *(const uint4*)(ksrc + (long)r0 * ld + ch * 8); k1 = *(const uint4*)(ksrc + (long)(r0 + 32) * ld + ch * 8);
  v0 = *(const uint4*)(vsrc + (long)r0 * ld + ch * 8); v1 = *(const uint4*)(vsrc + (long)(r0 + 32) * ld + ch * 8);
}
DI void k_gload(uint4& k0, uint4& k1, const u16* ksrc, long ld) {
  const int tid = TID(), r0 = tid >> 3, ch = tid & 7;
  k0 = *(const uint4*)(ksrc + (long)r0 * ld + ch * 8); k1 = *(const uint4*)(ksrc + (long)(r0 + 32) * ld + ch * 8);
}
DI void k_store(const uint4& k0, const uint4& k1, u16* sK) {
  const int tid = TID(), r0 = tid >> 3, ch = tid & 7;
  *(uint4*)(sK + r0 * 72 + ch * 8) = k0; *(uint4*)(sK + (r0 + 32) * 72 + ch * 8) = k1;
}
DI void kv_store(const uint4& k0, const uint4& k1, const uint4& v0, const uint4& v1, u16* sK, u16* sVt) {
  const int tid = TID(), r0 = tid >> 3, ch = tid & 7;
  *(uint4*)(sK + r0 * 72 + ch * 8) = k0; *(uint4*)(sK + (r0 + 32) * 72 + ch * 8) = k1;
  const int ksw = 16 * (ch >> 1);
  st_kt(sVt, ch * 8, r0 ^ ksw, v0); st_kt(sVt, ch * 8, (r0 + 32) ^ ksw, v1);
}
DI void sb_attn_item(const Params& P, int it, u16* sQ, u16* sK, u16* sVt) {
  const int tid = TID(), lane = tid & 63, w = tid >> 6, r16 = lane & 15, quad = lane >> 4;
  const int qb = 63 - (it >> 5), bh = it & 31, b = bh >> 2, h = bh & 3;
  const u16* PROJ = (const u16*)(WSP(P) + WS_PROJ);
  u16* OUT = (u16*)(WSP(P) + WS_OM) + (long)3 * T_ * 256;
  const long tb = (long)b * SEQ;
  load_tile(sQ, PROJ + (tb + qb * 64) * PW + P_SB + h * 64, PW);
  __syncthreads();
  bf16x8 bq[2]; load_qfrag(bq, sQ, w, lane);
  const int tq = qb * 64 + 16 * w + r16;
  f32x4 ot[4];
#pragma unroll
  for (int dt = 0; dt < 4; ++dt) ot[dt] = (f32x4){0.f, 0.f, 0.f, 0.f};
  float R = 0.f;
  uint4 pk0, pk1, pv0, pv1;
  kv_gload(pk0, pk1, pv0, pv1, PROJ + (tb + qb * 64) * PW + P_SB + 256 + h * 64, PROJ + (tb + qb * 64) * PW + P_SB + 512 + h * 64, PW);
  for (int kb = qb; kb >= 0; --kb) {
    if (__syncthreads_and(R < -104.f)) break;
    kv_store(pk0, pk1, pv0, pv1, sK, sVt);
    __syncthreads();
    if (kb > 0) kv_gload(pk0, pk1, pv0, pv1, PROJ + (tb + (kb - 1) * 64) * PW + P_SB + 256 + h * 64, PROJ + (tb + (kb - 1) * 64) * PW + P_SB + 512 + h * 64, PW);
    f32x4 st[4];
    st_mma(st, sK, bq, lane);
    float gs[4], zz[4][4], x[4][4];
#pragma unroll
    for (int mt = 0; mt < 4; ++mt) {
      float g = 0.f;
#pragma unroll
      for (int j = 0; j < 4; ++j) {
        int s = kb * 64 + 16 * mt + 4 * quad + j;
        float z = st[mt][j] * 0.125f;
        float sp = softplus_fast(z);
        bool mk = s < tq;
        x[mt][j] = mk ? -sp : 0.f;
        zz[mt][j] = mk ? (z - sp) : -1e30f;
        g += x[mt][j];
      }
      gs[mt] = g;
    }
    float hm = 0.f, tot_all = 0.f;
    f32x4 pw[4];
#pragma unroll
    for (int mt = 3; mt >= 0; --mt) {
      float g = gs[mt];
      float v1 = __shfl_down(g, 16), v2 = __shfl_down(g, 32), v3 = __shfl_down(g, 48);
      float hq = (quad < 3 ? v1 : 0.f) + (quad < 2 ? v2 : 0.f) + (quad < 1 ? v3 : 0.f);
      float tot = quad_sum(g);
      float base = R + hm + hq;
      float e3 = 0.f, e2 = x[mt][3], e1 = e2 + x[mt][2], e0 = e1 + x[mt][1];
      pw[mt][0] = __expf(zz[mt][0] + base + e0);
      pw[mt][1] = __expf(zz[mt][1] + base + e1);
      pw[mt][2] = __expf(zz[mt][2] + base + e2);
      pw[mt][3] = __expf(zz[mt][3] + base + e3);
      hm += tot; tot_all += tot;
    }
    R += tot_all;
    pv_mma(ot, sVt, pw, lane);
  }
  const long t = tb + tq;
#pragma unroll
  for (int dt = 0; dt < 4; ++dt) {
    uint2 ov; ov.x = pk2(ot[dt][0], ot[dt][1]); ov.y = pk2(ot[dt][2], ot[dt][3]);
    *(uint2*)(OUT + t * 256 + h * 64 + 16 * dt + 4 * quad) = ov;
  }
}

DI void win_attn_item(const Params& P, int it, u16* sQ, u16* sKunused, u16* sVunused) {
  const int tid = TID(), lane = tid & 63, w = tid >> 6, r16 = lane & 15, quad = lane >> 4;
  const int tbk = 127 - (it >> 3), b = it & 7;
  u16* sK = sQ + 128 * 72;
  u16* sVt = sK + 64 * 72;
  (void)sKunused; (void)sVunused;
  const u16* PROJ = (const u16*)(WSP(P) + WS_PROJ);
  const u16* QR = (const u16*)(WSP(P) + WS_QR);
  u16* OW = (u16*)(WSP(P) + WS_OW);
  const long tb = (long)b * SEQ;
  const int t0 = tbk * 32;
#pragma unroll
  for (int i = 0; i < 4; ++i) {
    const int c = tid + 256 * i, row = c >> 3, ch = c & 7;
    *(uint4*)(sQ + row * 72 + ch * 8) = *(const uint4*)(QR + (tb + t0 + (row & 31)) * 256 + (row >> 5) * 64 + ch * 8);
  }
  __syncthreads();
  bf16x8 bq[2][2];
  int tq[2];
#pragma unroll
  for (int qt = 0; qt < 2; ++qt) {
    const int rowq = 32 * w + 16 * qt + r16;
    bq[qt][0] = *(const bf16x8*)(sQ + rowq * 72 + quad * 8);
    bq[qt][1] = *(const bf16x8*)(sQ + rowq * 72 + 32 + quad * 8);
    tq[qt] = t0 + 16 * qt + r16;
  }
  f32x4 ot[2][4];
#pragma unroll
  for (int qt = 0; qt < 2; ++qt)
#pragma unroll
    for (int dt = 0; dt < 4; ++dt) ot[qt][dt] = (f32x4){0.f, 0.f, 0.f, 0.f};
  float m[2] = {-1e30f, -1e30f}, lsum[2] = {0.f, 0.f};
  const int lo = (t0 - 511) > 0 ? (t0 - 511) : 0;
  const int kb_lo = lo >> 6, kb_hi = (t0 + 31) >> 6;
  uint4 pk0, pk1, pv0, pv1;
  kv_gload(pk0, pk1, pv0, pv1, PROJ + (tb + kb_lo * 64) * PW + P_KV + 256, PROJ + (tb + kb_lo * 64) * PW + P_KV + 320, PW);
  for (int kb = kb_lo; kb <= kb_hi; ++kb) {
    __syncthreads();
    kv_store(pk0, pk1, pv0, pv1, sK, sVt);
    __syncthreads();
    if (kb < kb_hi) kv_gload(pk0, pk1, pv0, pv1, PROJ + (tb + (kb + 1) * 64) * PW + P_KV + 256, PROJ + (tb + (kb + 1) * 64) * PW + P_KV + 320, PW);
#pragma unroll
    for (int qt = 0; qt < 2; ++qt) {
      f32x4 st[4];
      st_mma(st, sK, bq[qt], lane);
      bool msk[4][4];
#pragma unroll
      for (int mt = 0; mt < 4; ++mt)
#pragma unroll
        for (int j = 0; j < 4; ++j) { int s = kb * 64 + 16 * mt + 4 * quad + j; int df = tq[qt] - s; msk[mt][j] = (df >= 0) && (df < 512); }
      softmax_tile(st, msk, m[qt], lsum[qt], ot[qt]);
      pv_mma(ot[qt], sVt, st, lane);
    }
  }
#pragma unroll
  for (int qt = 0; qt < 2; ++qt) {
    const float ls = quad_sum(lsum[qt]);
    const float inv = 1.f / fmaxf(ls, 1e-30f);
    const long t = tb + tq[qt];
#pragma unroll
    for (int dt = 0; dt < 4; ++dt) {
      uint2 ov; ov.x = pk2(ot[qt][dt][0] * inv, ot[qt][dt][1] * inv); ov.y = pk2(ot[qt][dt][2] * inv, ot[qt][dt][3] * inv);
      *(uint2*)(OW + t * 256 + w * 64 + 16 * dt + 4 * quad) = ov;
    }
  }
}

DI void cmp_attn_item(const Params& P, int it, u16* sQ, u16* sK, u16* sVt, float* sImp) {
  const int tid = TID(), lane = tid & 63, w = tid >> 6, r16 = lane & 15, quad = lane >> 4;
  const int tbk = 255 - (it >> 3), b = it & 7;
  const u16* PROJ = (const u16*)(WSP(P) + WS_PROJ);
  const u16* KC = (const u16*)(WSP(P) + WS_KC) + (long)b * 256 * 64;
  const u16* VC = (const u16*)(WSP(P) + WS_VC) + (long)b * 256 * 64;
  u16* OC = (u16*)(WSP(P) + WS_OC);
  u64* SEL = (u64*)(WSP(P) + WS_SEL);
  const long tb = (long)b * SEQ;
  const int t0 = tbk * 16;
  load_q_nsa(sQ, PROJ + (tb + t0) * PW + P_Q, PW);
  for (int e = tid; e < 4 * 16 * 64; e += 256) sImp[e] = 0.f;
  __syncthreads();
  bf16x8 bq[2]; load_qfrag(bq, sQ, w, lane);
  const int tq = t0 + r16;
  const int nv = (tq >= 31) ? ((tq - 31) >> 4) + 1 : 0;
  const int nvmax = (t0 + 15 >= 31) ? ((t0 + 15 - 31) >> 4) + 1 : 0;
  const int ntile = (nvmax + 63) >> 6;
  float m = -1e30f, lsum = 0.f;
  uint4 pk0, pk1, pv0, pv1;
  if (ntile > 0) k_gload(pk0, pk1, KC, 64);
  for (int kt = 0; kt < ntile; ++kt) {
    __syncthreads();
    k_store(pk0, pk1, sK);
    __syncthreads();
    if (kt + 1 < ntile) k_gload(pk0, pk1, KC + (kt + 1) * 64 * 64, 64);
    f32x4 st[4];
    st_mma(st, sK, bq, lane);
    float tm = -1e30f;
#pragma unroll
    for (int mt = 0; mt < 4; ++mt)
#pragma unroll
      for (int j = 0; j < 4; ++j) { int n = kt * 64 + 16 * mt + 4 * quad + j; float s = st[mt][j] * 0.125f; st[mt][j] = s; if (n < nv) tm = fmaxf(tm, s); }
    tm = quad_max(tm);
    float mn = fmaxf(m, tm);
    float ps = 0.f;
#pragma unroll
    for (int mt = 0; mt < 4; ++mt)
#pragma unroll
      for (int j = 0; j < 4; ++j) { int n = kt * 64 + 16 * mt + 4 * quad + j; if (n < nv) ps += __expf(st[mt][j] - mn); }
    lsum = lsum * __expf(m - mn) + ps;
    m = mn;
  }
  lsum = quad_sum(lsum);
  const float inv = (lsum > 0.f) ? 1.f / lsum : 0.f;
  f32x4 ot[4];
#pragma unroll
  for (int dt = 0; dt < 4; ++dt) ot[dt] = (f32x4){0.f, 0.f, 0.f, 0.f};
  float carry = 0.f;
  if (ntile > 0) kv_gload(pk0, pk1, pv0, pv1, KC, VC, 64);
  for (int kt = 0; kt < ntile; ++kt) {
    __syncthreads();
    kv_store(pk0, pk1, pv0, pv1, sK, sVt);
    __syncthreads();
    if (kt + 1 < ntile) kv_gload(pk0, pk1, pv0, pv1, KC + (kt + 1) * 64 * 64, VC + (kt + 1) * 64 * 64, 64);
    f32x4 st[4];
    st_mma(st, sK, bq, lane);
#pragma unroll
    for (int mt = 0; mt < 4; ++mt)
#pragma unroll
      for (int j = 0; j < 4; ++j) { int n = kt * 64 + 16 * mt + 4 * quad + j; st[mt][j] = (n < nv) ? __expf(st[mt][j] * 0.125f - m) * inv : 0.f; }
    pv_mma(ot, sVt, st, lane);
    float prevlast = carry;
#pragma unroll
    for (int mt = 0; mt < 4; ++mt) {
      float pl = st[mt][3];
      float fd = __shfl_up(pl, 16);
      float pprev = (quad > 0) ? fd : prevlast;
      float v = st[mt][0] + st[mt][1] + st[mt][2] + st[mt][3] + pprev;
      sImp[(w * 16 + r16) * 64 + kt * 16 + mt * 4 + quad] = v;
      prevlast = __shfl_down(pl, 48);
    }
    carry = prevlast;
  }
  {
    const long t = tb + tq;
#pragma unroll
    for (int dt = 0; dt < 4; ++dt) {
      uint2 ov; ov.x = pk2(ot[dt][0], ot[dt][1]); ov.y = pk2(ot[dt][2], ot[dt][3]);
      *(uint2*)(OC + t * 256 + w * 64 + 16 * dt + 4 * quad) = ov;
    }
  }
  __syncthreads();
  for (int q = 0; q < 4; ++q) {
    const int tok = 4 * w + q, t = t0 + tok;
    float v = sImp[(0 * 16 + tok) * 64 + lane] + sImp[(1 * 16 + tok) * 64 + lane] + sImp[(2 * 16 + tok) * 64 + lane] + sImp[(3 * 16 + tok) * 64 + lane];
    const int cur = t >> 6;
    if (lane == 0 || lane == cur) v = 1e9f;
    else if (lane * 64 > t) v = -1e30f;
    int cnt = 0;
#pragma unroll
    for (int i2 = 0; i2 < 64; ++i2) {
      float vi = __builtin_bit_cast(float, __builtin_amdgcn_readlane(__builtin_bit_cast(int, v), i2));
      cnt += (vi > v || (vi == v && i2 < lane)) ? 1 : 0;
    }
    u64 mask = __ballot(cnt < 16);
    if (lane == 0) SEL[tb + t] = mask;
  }
}

DI void sel_attn_item(const Params& P, int it, u16* sQ, u16* sKunused, u16* sVunused) {
  const int tid = TID(), lane = tid & 63, w = tid >> 6, r16 = lane & 15, quad = lane >> 4;
  const int tbk = 127 - (it >> 3), b = it & 7;
  u16* sK = sQ + 128 * 72;
  u16* sVt = sK + 64 * 72;
  (void)sKunused; (void)sVunused;
  const u16* PROJ = (const u16*)(WSP(P) + WS_PROJ);
  const u16* QR = (const u16*)(WSP(P) + WS_QR);
  const u16* OC = (const u16*)(WSP(P) + WS_OC);
  const u16* OW = (const u16*)(WSP(P) + WS_OW);
  const u64* SEL = (const u64*)(WSP(P) + WS_SEL);
  u16* OUT = (u16*)(WSP(P) + WS_OM);
  const long tb = (long)b * SEQ;
  const int t0 = tbk * 32;
#pragma unroll
  for (int i = 0; i < 4; ++i) {
    const int c = tid + 256 * i, row = c >> 3, ch = c & 7;
    *(uint4*)(sQ + row * 72 + ch * 8) = *(const uint4*)(QR + (tb + t0 + (row & 31)) * 256 + (row >> 5) * 64 + ch * 8);
  }
  __syncthreads();
  bf16x8 bq[2][2];
  int tq[2]; u64 mysel[2];
#pragma unroll
  for (int qt = 0; qt < 2; ++qt) {
    const int rowq = 32 * w + 16 * qt + r16;
    bq[qt][0] = *(const bf16x8*)(sQ + rowq * 72 + quad * 8);
    bq[qt][1] = *(const bf16x8*)(sQ + rowq * 72 + 32 + quad * 8);
    tq[qt] = t0 + 16 * qt + r16;
    mysel[qt] = SEL[tb + tq[qt]];
  }
  u64 uni = 0;
#pragma unroll
  for (int q = 0; q < 32; ++q) uni |= SEL[tb + t0 + q];
  const int cur = t0 >> 6;
  uni &= (cur == 63) ? ~0ull : ((1ull << (cur + 1)) - 1ull);
  f32x4 ot[2][4];
#pragma unroll
  for (int qt = 0; qt < 2; ++qt)
#pragma unroll
    for (int dt = 0; dt < 4; ++dt) ot[qt][dt] = (f32x4){0.f, 0.f, 0.f, 0.f};
  float m[2] = {-1e30f, -1e30f}, lsum[2] = {0.f, 0.f};
  uint4 pk0, pk1, pv0, pv1;
  int kb = uni ? (__ffsll((long long)uni) - 1) : -1;
  uni &= uni - 1;
  if (kb >= 0) kv_gload(pk0, pk1, pv0, pv1, PROJ + (tb + kb * 64) * PW + P_KV + 128, PROJ + (tb + kb * 64) * PW + P_KV + 192, PW);
  for (int nkb = -1; kb >= 0; kb = nkb) {
    __syncthreads();
    kv_store(pk0, pk1, pv0, pv1, sK, sVt);
    __syncthreads();
    nkb = uni ? (__ffsll((long long)uni) - 1) : -1;
    uni &= uni - 1;
    if (nkb >= 0) kv_gload(pk0, pk1, pv0, pv1, PROJ + (tb + nkb * 64) * PW + P_KV + 128, PROJ + (tb + nkb * 64) * PW + P_KV + 192, PW);
#pragma unroll
    for (int qt = 0; qt < 2; ++qt) {
      f32x4 st[4];
      st_mma(st, sK, bq[qt], lane);
      const bool selq = (mysel[qt] >> kb) & 1ull;
      bool msk[4][4];
#pragma unroll
      for (int mt = 0; mt < 4; ++mt)
#pragma unroll
        for (int j = 0; j < 4; ++j) { int s = kb * 64 + 16 * mt + 4 * quad + j; msk[mt][j] = selq && (s <= tq[qt]); }
      softmax_tile(st, msk, m[qt], lsum[qt], ot[qt]);
      pv_mma(ot[qt], sVt, st, lane);
    }
  }
#pragma unroll
  for (int qt = 0; qt < 2; ++qt) {
    const float ls = quad_sum(lsum[qt]);
    const float inv = 1.f / fmaxf(ls, 1e-30f);
    const long t = tb + tq[qt];
    const float gc = sigmoidf_(bf2f(PROJ[t * PW + P_NG + w * 3 + 0]));
    const float gsl = sigmoidf_(bf2f(PROJ[t * PW + P_NG + w * 3 + 1]));
    const float gw = sigmoidf_(bf2f(PROJ[t * PW + P_NG + w * 3 + 2]));
#pragma unroll
    for (int dt = 0; dt < 4; ++dt) {
      const long o = t * 256 + w * 64 + 16 * dt + 4 * quad;
      uint2 c = *(const uint2*)(OC + o), ww = *(const uint2*)(OW + o);
      float r0 = gc * bf2f((u16)(c.x & 0xffff)) + gsl * ot[qt][dt][0] * inv + gw * bf2f((u16)(ww.x & 0xffff));
      float r1 = gc * bf2f((u16)(c.x >> 16)) + gsl * ot[qt][dt][1] * inv + gw * bf2f((u16)(ww.x >> 16));
      float r2 = gc * bf2f((u16)(c.y & 0xffff)) + gsl * ot[qt][dt][2] * inv + gw * bf2f((u16)(ww.y & 0xffff));
      float r3 = gc * bf2f((u16)(c.y >> 16)) + gsl * ot[qt][dt][3] * inv + gw * bf2f((u16)(ww.y >> 16));
      uint2 ov; ov.x = pk2(r0, r1); ov.y = pk2(r2, r3);
      *(uint2*)(OUT + o) = ov;
    }
  }
}

DI void inproj_tile(const Params& P, int l, int it, u16* sA, u16* sB) {
  const int tid = TID(), lane = tid & 63, w = tid >> 6, r16 = lane & 15, quad = lane >> 4, wm = w >> 1, wn = w & 1;
  int mt, nt; tile_from_q(it, 22, mt, nt);
  const u16* H = (const u16*)(WSP(P) + WS_H);
  u16* PROJ = (u16*)(WSP(P) + WS_PROJ);
  const u16* Ab = H + (long)mt * 128 * DM;
  const u16* Bb = (const u16*)(WSP(P) + WS_W + WT_IN) + (long)nt * 128 * DM;
  f32x4 acc[4][4];
  gemm3<4>(acc, g3_ptr(Ab, DM, tid, 0, false), g3_ptr(Ab, DM, tid, 1, false), nullptr, nullptr, 64,
           g3_ptr(Bb, DM, tid, 0, false), g3_ptr(Bb, DM, tid, 1, false), nullptr, nullptr, DM, sA, 16L * DM, 16L * DM);
  __syncthreads();
#pragma unroll
  for (int mi = 0; mi < 4; ++mi)
#pragma unroll
    for (int ni = 0; ni < 4; ++ni)
#pragma unroll
      for (int j = 0; j < 4; ++j) sA[(wm * 64 + 16 * mi + 4 * quad + j) * 136 + wn * 64 + 16 * ni + r16] = f2bf(acc[mi][ni][j]);
  __syncthreads();
  store_tile_bf16<128>(sA, PROJ + (long)mt * 128 * PW + nt * 128, PW, 128);
}
DI void glu_tile(const Params& P, int l, int it, u16* sA, u16* sB) {
  const int tid = TID(), lane = tid & 63, w = tid >> 6, r16 = lane & 15, quad = lane >> 4, wm = w >> 1, wn = w & 1;
  const int mt = it >> 2, nt = it & 3;
  const u16* Y5 = (const u16*)(WSP(P) + WS_Y5);
  u16* OUT = (u16*)(WSP(P) + WS_OM) + (long)1 * T_ * 256;
  const u16* Ab = Y5 + (long)mt * 128 * 256;
  const u16* Bb = (const u16*)(WSP(P) + WS_W + WT_GLU) + (long)nt * 128 * 256;
  f32x4 acc[4][4];
  gemm3<4>(acc, g3_ptr(Ab, 256, tid, 0, false), g3_ptr(Ab, 256, tid, 1, false), nullptr, nullptr, 64,
           g3_ptr(Bb, 256, tid, 0, false), g3_ptr(Bb, 256, tid, 1, false), nullptr, nullptr, 256, sA, 16L * 256, 16L * 256);
  __syncthreads();
#pragma unroll
  for (int mi = 0; mi < 4; ++mi)
#pragma unroll
    for (int ni = 0; ni < 2; ++ni)
#pragma unroll
      for (int j = 0; j < 4; ++j)
        sA[(wm * 64 + 16 * mi + 4 * quad + j) * 72 + wn * 32 + 16 * ni + r16] = f2bf(acc[mi][ni][j] * sigmoidf_(acc[mi][ni + 2][j]));
  __syncthreads();
  store_tile_bf16<64>(sA, OUT + (long)mt * 128 * 256 + nt * 64, 256, 128);
}
DI void merge_tile(const Params& P, int l, int it, u16* sA, u16* sB) {
  const int tid = TID(), lane = tid & 63, w = tid >> 6, r16 = lane & 15, quad = lane >> 4, wm = w >> 1, wn = w & 1;
  int mt, nt; tile_from_q(it, 8, mt, nt);
  const u16* H = (const u16*)(WSP(P) + WS_H);
  const u16* OM = (const u16*)(WSP(P) + WS_OM);
  u16* MERGED = (u16*)(WSP(P) + WS_MERGED);
  uint2 outp[4][4];
#pragma unroll
  for (int mi = 0; mi < 4; ++mi)
#pragma unroll
    for (int ni = 0; ni < 4; ++ni) outp[mi][ni] = make_uint2(0u, 0u);
#pragma unroll 1
  for (int m = 0; m < 4; ++m) {
    uint2 gp[4][4];
    {
      f32x4 ag[4][4];
      const u16* Ab = H + (long)mt * 128 * DM;
      const u16* Bb = (const u16*)(WSP(P) + WS_W + WT_G) + ((long)(m * 1024 + nt * 128)) * DM;
      gemm3<4, true>(ag, g3_ptr(Ab, DM, tid, 0, false), g3_ptr(Ab, DM, tid, 1, false), nullptr, nullptr, 64,
               g3_ptr(Bb, DM, tid, 0, false), g3_ptr(Bb, DM, tid, 1, false), nullptr, nullptr, DM, sA, 16L * DM, 16L * DM);
#pragma unroll
      for (int mi = 0; mi < 4; ++mi)
#pragma unroll
        for (int ni = 0; ni < 4; ++ni) {
          gp[mi][ni].x = pk2(sigmoidf_(ag[mi][ni][0]), sigmoidf_(ag[mi][ni][1]));
          gp[mi][ni].y = pk2(sigmoidf_(ag[mi][ni][2]), sigmoidf_(ag[mi][ni][3]));
        }
    }
    {
      f32x4 av[4][4];
      const u16* Ab = OM + ((long)m * T_ + (long)mt * 128) * 256;
      const u16* Bb = (const u16*)(WSP(P) + WS_W + WT_BR) + ((long)(m * 1024 + nt * 128)) * 256;
      gemm3<4, true>(av, g3_ptr(Ab, 256, tid, 0, false), g3_ptr(Ab, 256, tid, 1, false), nullptr, nullptr, 64,
               g3_ptr(Bb, 256, tid, 0, false), g3_ptr(Bb, 256, tid, 1, false), nullptr, nullptr, 256, sA, 16L * 256, 16L * 256);
#pragma unroll
      for (int mi = 0; mi < 4; ++mi)
#pragma unroll
        for (int ni = 0; ni < 4; ++ni) {
          const float o0 = bf2f((u16)(outp[mi][ni].x & 0xffff)) + av[mi][ni][0] * bf2f((u16)(gp[mi][ni].x & 0xffff));
          const float o1 = bf2f((u16)(outp[mi][ni].x >> 16)) + av[mi][ni][1] * bf2f((u16)(gp[mi][ni].x >> 16));
          const float o2 = bf2f((u16)(outp[mi][ni].y & 0xffff)) + av[mi][ni][2] * bf2f((u16)(gp[mi][ni].y & 0xffff));
          const float o3 = bf2f((u16)(outp[mi][ni].y >> 16)) + av[mi][ni][3] * bf2f((u16)(gp[mi][ni].y >> 16));
          outp[mi][ni].x = pk2(o0, o1); outp[mi][ni].y = pk2(o2, o3);
        }
    }
  }
  __syncthreads();
#pragma unroll
  for (int mi = 0; mi < 4; ++mi)
#pragma unroll
    for (int ni = 0; ni < 4; ++ni)
#pragma unroll
      for (int j = 0; j < 4; ++j) {
        const unsigned wv = (j < 2) ? outp[mi][ni].x : outp[mi][ni].y;
        sA[(wm * 64 + 16 * mi + 4 * quad + j) * 136 + wn * 64 + 16 * ni + r16] = (u16)((j & 1) ? (wv >> 16) : (wv & 0xffff));
      }
  __syncthreads();
  store_tile_bf16<128>(sA, MERGED + (long)mt * 128 * DM + nt * 128, DM, 128);
}
DI void resid_tile(const u16* A, int K, const u16* Bt, const float* resid, float* out, int it, u16* sA, u16* sB) {
  const int tid = TID(), lane = tid & 63, w = tid >> 6, r16 = lane & 15, quad = lane >> 4, wm = w >> 1, wn = w & 1;
  int mt, nt; tile_from_q(it, 8, mt, nt);
  const u16* Ab = A + (long)mt * 128 * K;
  const u16* Bb = Bt + (long)nt * 128 * K;
  f32x4 acc[4][4];
  gemm3<4>(acc, g3_ptr(Ab, K, tid, 0, false), g3_ptr(Ab, K, tid, 1, false), nullptr, nullptr, 64,
           g3_ptr(Bb, K, tid, 0, false), g3_ptr(Bb, K, tid, 1, false), nullptr, nullptr, K, sA, 16L * K, 16L * K);
  float* sC = (float*)sA + w * (32 * 68);
#pragma unroll
  for (int hp = 0; hp < 2; ++hp) {
    __syncthreads();
#pragma unroll
    for (int mi2 = 0; mi2 < 2; ++mi2)
#pragma unroll
      for (int ni = 0; ni < 4; ++ni)
#pragma unroll
        for (int j = 0; j < 4; ++j) sC[(16 * mi2 + 4 * quad + j) * 68 + 16 * ni + r16] = acc[2 * hp + mi2][ni][j];
    __syncthreads();
#pragma unroll
    for (int q = 0; q < 8; ++q) {
      const int c = lane + 64 * q, row = c >> 4, c4 = (c & 15) * 4;
      const long o = ((long)mt * 128 + wm * 64 + 32 * hp + row) * DM + nt * 128 + wn * 64 + c4;
      const float4 rv = *(const float4*)(resid + o);
      const f32x4 cv = *(const f32x4*)(sC + row * 68 + c4);
      *(float4*)(out + o) = make_float4(rv.x + cv[0], rv.y + cv[1], rv.z + cv[2], rv.w + cv[3]);
    }
  }
}
DI void ffn1_tile(const Params& P, int l, int it, u16* sA, u16* sB) {
  const int tid = TID(), lane = tid & 63, w = tid >> 6, r16 = lane & 15, quad = lane >> 4, wm = w >> 1, wn = w & 1;
  int mt, nt; tile_from_q(it, 44, mt, nt);
  const u16* H = (const u16*)(WSP(P) + WS_H);
  u16* ACT = (u16*)(WSP(P) + WS_PROJ);
  const u16* Ab = H + (long)mt * 128 * DM;
  const u16* Bb = (const u16*)(WSP(P) + WS_W + WT_GU) + (long)nt * 128 * DM;
  f32x4 acc[4][4];
  gemm3<4>(acc, g3_ptr(Ab, DM, tid, 0, false), g3_ptr(Ab, DM, tid, 1, false), nullptr, nullptr, 64,
           g3_ptr(Bb, DM, tid, 0, false), g3_ptr(Bb, DM, tid, 1, false), nullptr, nullptr, DM, sA, 16L * DM, 16L * DM);
  __syncthreads();
#pragma unroll
  for (int mi = 0; mi < 4; ++mi)
#pragma unroll
    for (int ni = 0; ni < 2; ++ni)
#pragma unroll
      for (int j = 0; j < 4; ++j)
        sA[(wm * 64 + 16 * mi + 4 * quad + j) * 72 + wn * 32 + 16 * ni + r16] = f2bf(siluf_(acc[mi][ni][j]) * acc[mi][ni + 2][j]);
  __syncthreads();
  store_tile_bf16<64>(sA, ACT + (long)mt * 128 * DFF + nt * 64, DFF, 128);
}

__global__ void __launch_bounds__(256, LB2) fwd_megakernel(Params P) {
  cg::grid_group grid = cg::this_grid();
  __shared__ __attribute__((aligned(16))) float lds[17920];
  __shared__ int s_item;
  unsigned* cnt = (unsigned*)(WSP(P) + WS_CNT);
  const int xcd = (int)(__builtin_amdgcn_s_getreg((3 << 11) | 20) & 0xF) & 7;
  __shared__ int s_rank;
  if (threadIdx.x == 0) s_rank = (int)atomicAdd(cnt + 900 + xcd, 1u);
  __syncthreads();
  const int xrank = s_rank;
  u16* sA = (u16*)lds;
  u16* sB = sA + 128 * 80;
  u16* aQ = (u16*)lds;
  u16* aK = aQ + 64 * 72;
  u16* aV = aK + 64 * 72;
  float* aImp = (float*)(aV + 64 * 72);
  for (int ph = P.ph_lo; ph < P.ph_hi; ++ph) {
    const int l = ph / 11, sp = ph % 11;
    const float* xin = (l == 0) ? P.in[0] : P.out;
    const int nrep = (PROBE_DUP != 0 && l == 0 && ((PROBE_DUP >> sp) & 1)) ? 2 : 1;
    for (int rep = 0; rep < nrep; ++rep) {
    unsigned* pc = cnt + (ph + 32 * rep) * 8;
    switch (sp) {
      case 0: if (PHASE_MASK & (1 << 0)) {
        phase_rmsnorm(xin, P.in[2] + l * DM, (u16*)(WSP(P) + WS_H));
        phase_convert(P, l, lds);
        if (l == 0) phase_rope_table((const int*)P.in[1], (float*)(WSP(P) + WS_COS), (float*)(WSP(P) + WS_SIN));
      } break;
      case 1: if (PHASE_MASK & (1 << 1)) {
        XCD_STATIC_LOOP(32 * 22, inproj_tile(P, l, it, sA, sB))
      } break;
      case 2: if (PHASE_MASK & (1 << 2)) {
        for (;;) {
          int it = next_item(pc, &s_item); if (it >= 64 + 3 * 2048) break;
          if (it < 64) cmp1_tile(P, l, it, sA, sB);
          else if (it < 64 + 2048) gdn_p1_item(P, l, it - 64, lds);
          else if (it < 64 + 4096) s5_pass1_item(P, l, it - 64 - 2048, lds);
          else nsa_prep_item(P, l, it - 64 - 4096);
        }
      } break;
      case 3: if (PHASE_MASK & (1 << 3)) {
        for (;;) {
          int it = next_item(pc, &s_item); if (it >= 128 + 3072 + 64) break;
          if (it < 128) gdn_p2_item(P, it, lds);
          else if (it < 128 + 2048) sb_attn_item(P, it - 128, aQ, aK, aV);
          else if (it < 128 + 3072) win_attn_item(P, it - 128 - 2048, aQ, aK, aV);
          else if (it < 128 + 3072 + 32) s5_carry_item(P, l, it - 128 - 3072);
          else cmp2_tile(P, l, it - 128 - 3072 - 32, sA, sB, lds + 17000);
        }
      } break;
      case 4: if (PHASE_MASK & (1 << 4)) {
        for (;;) {
          int it = next_item(pc, &s_item); if (it >= 3 * 2048) break;
          if (it < 2048) cmp_attn_item(P, it, aQ, aK, aV, aImp);
          else if (it < 4096) s5_pass2_item(P, l, it - 2048, lds);
          else gdn_post_item(P, l, it - 4096);
        }
      } break;
      case 5: if (PHASE_MASK & (1 << 5)) {
        for (;;) {
          int it = next_item(pc, &s_item); if (it >= 1024 + 1024) break;
          if (it < 1024) sel_attn_item(P, it, aQ, aK, aV);
          else glu_tile(P, l, it - 1024, sA, sB);
        }
      } break;
      case 6: if (PHASE_MASK & (1 << 6)) {
        XCD_STATIC_LOOP(32 * 8, merge_tile(P, l, it, sA, sB))
      } break;
      case 7: if (PHASE_MASK & (1 << 7)) {
        XCD_STATIC_LOOP(32 * 8, resid_tile((const u16*)(WSP(P) + WS_MERGED), DM, (const u16*)(WSP(P) + WS_W + WT_OUT), xin, P.out, it, sA, sB))
      } break;
      case 8: if (PHASE_MASK & (1 << 8)) {
        phase_rmsnorm(P.out, P.in[26] + l * DM, (u16*)(WSP(P) + WS_H));
      } break;
      case 9: if (PHASE_MASK & (1 << 9)) {
        XCD_STATIC_LOOP(32 * 44, ffn1_tile(P, l, it, sA, sB))
      } break;
      case 10: if (PHASE_MASK & (1 << 10)) {
        XCD_STATIC_LOOP(32 * 8, resid_tile((const u16*)(WSP(P) + WS_PROJ), DFF, (const u16*)(WSP(P) + WS_W + WT_D), P.out, P.out, it, sA, sB))
      } break;
    }
    if (rep + 1 < nrep) grid.sync();
    }
    if (ph + 1 < P.ph_hi) grid.sync();
  }
}

extern "C" void kernel_launch(void* const* d_in, const int* in_sizes, int n_in, void* d_out, int out_size, void* d_ws, size_t ws_size,
                              hipStream_t stream) {
  static int grid_blocks = 0;
  if (!grid_blocks) {
    int dev = 0, cus = 0, per_cu = 0;
    hipGetDevice(&dev);
    hipDeviceGetAttribute(&cus, hipDeviceAttributeMultiprocessorCount, dev);
    hipOccupancyMaxActiveBlocksPerMultiprocessor(&per_cu, fwd_megakernel, 256, 0);
    if (per_cu < 1) per_cu = 1;
    if (per_cu > 2) per_cu = 2;
    grid_blocks = cus * per_cu;
    if (ws_size < WS_W + WT_END) fprintf(stderr, "kernel_launch: workspace too small: %zu\n", ws_size);
  }
  hipMemsetAsync((char*)d_ws + WS_CNT, 0, 4096, stream);
  Params p{};
  for (int i = 0; i < 30; ++i) p.in[i] = (const float*)d_in[i];
  p.out = (float*)d_out;
  p.ws = (unsigned char*)d_ws;
  p.ph_lo = 0; p.ph_hi = NPHASE;
  void* args[] = {&p};
  hipError_t e = hipLaunchCooperativeKernel((void*)fwd_megakernel, dim3(grid_blocks), dim3(256), args, 0, stream);
  if (e != hipSuccess) fprintf(stderr, "cooperative launch failed: %s (grid %d)\n", hipGetErrorString(e), grid_blocks);
}
```

```cpp
#include <hip/hip_runtime.h>
#include <hip/hip_cooperative_groups.h>
#include <cstdio>
namespace cg = cooperative_groups;

typedef unsigned short u16;
typedef unsigned long long u64;
typedef __attribute__((ext_vector_type(8))) short bf16x8;
typedef __attribute__((ext_vector_type(4))) short s16x4;
typedef __attribute__((ext_vector_type(4))) float f32x4;
#define DI __device__ __forceinline__

constexpr int NB = 8, SEQ = 4096, T_ = NB * SEQ, DM = 1024, DIN = 6804, PW = 2816, DFF = 2816;
constexpr int P_Q = 0, P_KV = 256, P_S5U = 640, P_GQKV = 896, P_GZ = 1664, P_SB = 1920, P_NG = 2688, P_GA = 2700, P_GB = 2704;
constexpr float EPS = 1e-6f;
constexpr size_t MiB = 1024ull * 1024ull;
constexpr size_t WS_H = 0, WS_PROJ = 64 * MiB, WS_OM = 240 * MiB, WS_MERGED = 304 * MiB,
                 WS_GQ = 304 * MiB, WS_GK = 320 * MiB, WS_GU = 336 * MiB, WS_GW = 352 * MiB, WS_GA = 368 * MiB,
                 WS_QR = 384 * MiB, WS_OC = 400 * MiB, WS_OW = 416 * MiB, WS_Y5 = 432 * MiB,
                 WS_GG = 448 * MiB, WS_SEL = 449 * MiB, WS_COS = 450 * MiB, WS_SIN = 451 * MiB,
                 WS_ENDS = 452 * MiB, WS_CARRY = 456 * MiB, WS_KC = 460 * MiB, WS_VC = 461 * MiB, WS_HID = 462 * MiB,
                 WS_CNT = 464 * MiB, WS_W = 465 * MiB, WS_CBIAS = 449 * MiB + 512 * 1024;
constexpr size_t WT_IN = 0, WT_G = WT_IN + 2816ull * 1024 * 2, WT_BR = WT_G + 4096ull * 1024 * 2, WT_OUT = WT_BR + 4096ull * 256 * 2,
                 WT_GU = WT_OUT + 1024ull * 1024 * 2, WT_D = WT_GU + 5632ull * 1024 * 2, WT_GLU = WT_D + 1024ull * 2816 * 2,
                 WT_C1 = WT_GLU + 512ull * 256 * 2, WT_C2 = WT_C1 + 512ull * 2048 * 2, WT_END = WT_C2 + 128ull * 256 * 2;
constexpr int NPHASE = 22;
#define XCD_STATIC_LOOP(NPER, BODY) { \
    unsigned c0_ = cnt[900], c1_ = cnt[901], c2_ = cnt[902], c3_ = cnt[903], c4_ = cnt[904], c5_ = cnt[905], c6_ = cnt[906], c7_ = cnt[907]; \
    const bool ok_ = c0_ && c1_ && c2_ && c3_ && c4_ && c5_ && c6_ && c7_; \
    const unsigned mine_ = xcd == 0 ? c0_ : xcd == 1 ? c1_ : xcd == 2 ? c2_ : xcd == 3 ? c3_ : xcd == 4 ? c4_ : xcd == 5 ? c5_ : xcd == 6 ? c6_ : c7_; \
    const int start_ = ok_ ? xcd * (NPER) + xrank : (int)blockIdx.x, end_ = ok_ ? (xcd + 1) * (NPER) : 8 * (NPER), step_ = ok_ ? (int)mine_ : (int)gridDim.x; \
    for (int it = start_; it < end_; it += step_) { BODY; } }
#ifndef PROBE_DUP
#define PROBE_DUP 0
#endif
#ifndef LB2
#define LB2 2
#endif
#ifndef PHASE_MASK
#define PHASE_MASK 0x7ff
#endif

struct Params {
  const float* in[30];
  float* out;
  unsigned char* ws;
  int ph_lo, ph_hi;
};


DI int TID() { int t = threadIdx.x; asm volatile("" : "+v"(t)); return t; }
DI unsigned char* WSP(const Params& P) { size_t z = 0; asm volatile("" : "+s"(z)); return P.ws + z; }
typedef __bf16 bf16x2_t __attribute__((ext_vector_type(2)));
typedef float f32x2_t __attribute__((ext_vector_type(2)));
DI u16 f2bf(float x) { __bf16 r = (__bf16)x; return __builtin_bit_cast(u16, r); }
DI float bf2f(u16 h) { return __uint_as_float(((unsigned)h) << 16); }
DI unsigned pk2(float a, float b) { f32x2_t v = {a, b}; bf16x2_t r = __builtin_convertvector(v, bf16x2_t); return __builtin_bit_cast(unsigned, r); }
DI float wave_sum(float v) {
#pragma unroll
  for (int o = 1; o < 64; o <<= 1) v += __shfl_xor(v, o);
  return v;
}
DI float sigmoidf_(float x) { return __builtin_amdgcn_rcpf(1.f + __expf(-x)); }
DI float siluf_(float x) { return x * sigmoidf_(x); }
DI float softplusf_(float x) { return fmaxf(x, 0.f) + log1pf(__expf(-fabsf(x))); }
DI float softplus_fast(float x) { return fmaxf(x, 0.f) + __logf(1.f + __expf(-fabsf(x))); }
DI float gelu_tanh(float x) {
  float u = 0.7978845608028654f * (x + 0.044715f * x * x * x);
  float t = 1.f - 2.f * __builtin_amdgcn_rcpf(__expf(2.f * u) + 1.f);
  return 0.5f * x * (1.f + t);
}
DI void sincos_d(double x, double& s, double& c) {
  const double TWO_PI = 6.283185307179586476925287, INV = 0.15915494309189533576888;
  double n = rint(x * INV);
  double r = x - n * TWO_PI;
  double r2 = r * r, term = 1.0, cs = 1.0, ss = 1.0;
#pragma unroll
  for (int k = 1; k <= 14; ++k) { term *= r2 * (-1.0 / (double)((2 * k - 1) * (2 * k))); cs += term; }
  term = 1.0;
#pragma unroll
  for (int k = 1; k <= 14; ++k) { term *= r2 * (-1.0 / (double)((2 * k) * (2 * k + 1))); ss += term; }
  s = r * ss; c = cs;
}
DI int next_item(unsigned* cnt, int* s_item) {
  __syncthreads();
  if (TID() == 0) *s_item = (int)atomicAdd(cnt, 1u);
  __syncthreads();
  return *s_item;
}
DI int next_tile_xcd(unsigned* cnt8, int n_per_xcd, int xcd, int* s_item) {
  asm volatile("" : "+s"(xcd));
  __syncthreads();
  if (threadIdx.x == 0) {
    int res = -1;
    for (int a = 0; a < 8; ++a) {
      int qq = (xcd + a) & 7;
      unsigned v = atomicAdd(cnt8 + qq, 1u);
      if (v < (unsigned)n_per_xcd) { res = qq * n_per_xcd + (int)v; break; }
    }
    *s_item = res;
  }
  __syncthreads();
  return *s_item;
}
DI void tile_from_q(int it, int numN, int& mt, int& nt) {
  const int per = 32 * numN, q = it / per, i = it % per, g = i / (8 * numN), rem = i % (8 * numN);
  nt = rem >> 3; mt = 32 * q + 8 * g + (rem & 7);
}
DI int proj_src_col(int pc) {
  if (pc < 640) return pc;
  if (pc < 1664) return pc + 12;
  if (pc < 2688) return pc + 20;
  if (pc < 2700) return pc - 2688 + 640;
  if (pc < 2708) return pc - 2700 + 1676;
  return pc;
}

DI uint4 addpos8(uint4 v, const float* pp) {
  uint4 o;
  o.x = pk2(bf2f((u16)(v.x & 0xffff)) + pp[0], bf2f((u16)(v.x >> 16)) + pp[1]);
  o.y = pk2(bf2f((u16)(v.y & 0xffff)) + pp[2], bf2f((u16)(v.y >> 16)) + pp[3]);
  o.z = pk2(bf2f((u16)(v.z & 0xffff)) + pp[4], bf2f((u16)(v.z >> 16)) + pp[5]);
  o.w = pk2(bf2f((u16)(v.w & 0xffff)) + pp[6], bf2f((u16)(v.w >> 16)) + pp[7]);
  return o;
}
template <int NTW>
DI void gemm2(f32x4 (&acc)[4][NTW], const u16* __restrict__ arow, long a_kstep, const float* __restrict__ apos,
              const u16* __restrict__ brow, int K, u16* sA, u16* sB) {
  constexpr int BN = 32 * NTW, BV = BN / 32, LS = 80;
  const int tid = TID(), lane = tid & 63, w = tid >> 6, r16 = lane & 15, quad = lane >> 4;
  const int wm = w >> 1, wn = w & 1;
  u16* sa_st = sA + (tid >> 1) * LS + (tid & 1) * 32;
  u16* sb_st = (BN == 128) ? (sB + (tid >> 1) * LS + (tid & 1) * 32) : (sB + (tid >> 2) * LS + (tid & 3) * 16);
  uint4 pa0, pa1, pa2, pa3, pb0, pb1, pb2, pb3;
  uint4 qa0, qa1, qa2, qa3, qb0, qb1, qb2, qb3;
  pb2 = make_uint4(0, 0, 0, 0); pb3 = pb2; qb2 = pb2; qb3 = pb2;
#define G2_LOAD(KT, a0, a1, a2, a3, b0, b1, b2, b3) { const uint4* pa_ = (const uint4*)(arow + (long)(KT) * a_kstep); \
    a0 = pa_[0]; a1 = pa_[1]; a2 = pa_[2]; a3 = pa_[3]; \
    if (apos) { const float* pp_ = apos + (KT) * 64 + (tid & 1) * 32; \
      a0 = addpos8(a0, pp_); a1 = addpos8(a1, pp_ + 8); a2 = addpos8(a2, pp_ + 16); a3 = addpos8(a3, pp_ + 24); } \
    const uint4* pb_ = (const uint4*)(brow + (long)(KT) * 64); \
    b0 = pb_[0]; b1 = pb_[1]; if (BV == 4) { b2 = pb_[2]; b3 = pb_[3]; } }
#define G2_STORE(a0, a1, a2, a3, b0, b1, b2, b3) { \
    ((uint4*)sa_st)[0] = a0; ((uint4*)sa_st)[1] = a1; ((uint4*)sa_st)[2] = a2; ((uint4*)sa_st)[3] = a3; \
    ((uint4*)sb_st)[0] = b0; ((uint4*)sb_st)[1] = b1; if (BV == 4) { ((uint4*)sb_st)[2] = b2; ((uint4*)sb_st)[3] = b3; } }
#define G2_COMPUTE() { _Pragma("unroll") for (int ks = 0; ks < 2; ++ks) { \
      bf16x8 af[4], bg[NTW]; \
      _Pragma("unroll") for (int mi = 0; mi < 4; ++mi) af[mi] = *(const bf16x8*)(sA + (wm * 64 + 16 * mi + r16) * LS + ks * 32 + quad * 8); \
      _Pragma("unroll") for (int ni = 0; ni < NTW; ++ni) bg[ni] = *(const bf16x8*)(sB + (wn * (BN / 2) + 16 * ni + r16) * LS + ks * 32 + quad * 8); \
      _Pragma("unroll") for (int mi = 0; mi < 4; ++mi) \
        _Pragma("unroll") for (int ni = 0; ni < NTW; ++ni) acc[mi][ni] = __builtin_amdgcn_mfma_f32_16x16x32_bf16(af[mi], bg[ni], acc[mi][ni], 0, 0, 0); } }
#pragma unroll
  for (int mi = 0; mi < 4; ++mi)
#pragma unroll
    for (int ni = 0; ni < NTW; ++ni) acc[mi][ni] = (f32x4){0.f, 0.f, 0.f, 0.f};
  const int nk = K >> 6;
  G2_LOAD(0, pa0, pa1, pa2, pa3, pb0, pb1, pb2, pb3)
  G2_LOAD(1, qa0, qa1, qa2, qa3, qb0, qb1, qb2, qb3)
#pragma unroll 1
  for (int kt = 0; kt < nk; kt += 2) {
    __syncthreads();
    G2_STORE(pa0, pa1, pa2, pa3, pb0, pb1, pb2, pb3)
    __syncthreads();
    if (kt + 2 < nk) G2_LOAD(kt + 2, pa0, pa1, pa2, pa3, pb0, pb1, pb2, pb3)
    G2_COMPUTE()
    __syncthreads();
    G2_STORE(qa0, qa1, qa2, qa3, qb0, qb1, qb2, qb3)
    __syncthreads();
    if (kt + 3 < nk) G2_LOAD(kt + 3, qa0, qa1, qa2, qa3, qb0, qb1, qb2, qb3)
    G2_COMPUTE()
  }
#undef G2_LOAD
#undef G2_STORE
#undef G2_COMPUTE
}
DI void g3_rowpiece(int tid, int q, bool n64, int& row, int& pc) {
  const int w = tid >> 6, lane = tid & 63, chunk = n64 ? (2 * w + q) : (4 * w + q);
  row = 8 * chunk + (lane >> 3);
  pc = (lane & 7) ^ ((row >> 1) & 7);
}
DI const u16* g3_ptr(const u16* base, long ld, int tid, int q, bool n64) {
  int row, pc; g3_rowpiece(tid, q, n64, row, pc);
  return base + (long)row * ld + pc * 8;
}
template <int NTW, bool LEAN = false>
DI void gemm3(f32x4 (&acc)[4][NTW], const u16* ap0, const u16* ap1, const u16* ap2, const u16* ap3, long a_kstep,
              const u16* bp0, const u16* bp1, const u16* bp2, const u16* bp3, int K, u16* sbase, long a16 = 0, long b16 = 0) {
  constexpr int BN = 32 * NTW, STAGE = 16384;
  const int tid = TID(), lane = tid & 63, w = tid >> 6, r16 = lane & 15, quad = lane >> 4;
  const int wm = w >> 1, wn = w & 1;
  const int sz = (r16 >> 1) & 7;
  const int wu = __builtin_amdgcn_readfirstlane(w);
#define G3_GLDS(GP, LOFF) asm volatile("s_mov_b32 m0, %1\n\ts_nop 0\n\tglobal_load_lds_dwordx4 %0, off" :: "v"(GP), "s"(LOFF) : "memory", "m0")
  const unsigned lds0 = (unsigned)(size_t)sbase;
#define G3_ISSUE(KT) { const unsigned st_ = lds0 + (((KT) & 1) ? STAGE * 2 : 0); const long ka_ = (long)(KT) * a_kstep, kb_ = (long)(KT) * 64; \
    if (BN == 128) { \
      const unsigned la_ = __builtin_amdgcn_readfirstlane(st_ + wu * 4096u); \
      G3_GLDS(ap0 + ka_, la_); G3_GLDS(ap1 + ka_, la_ + 1024u); \
      if (a16) { G3_GLDS(ap0 + (ka_ + a16), la_ + 2048u); G3_GLDS(ap1 + (ka_ + a16), la_ + 3072u); } else { G3_GLDS(ap2 + ka_, la_ + 2048u); G3_GLDS(ap3 + ka_, la_ + 3072u); } \
      G3_GLDS(bp0 + kb_, la_ + 16384u); G3_GLDS(bp1 + kb_, la_ + 17408u); \
      if (b16) { G3_GLDS(bp0 + (kb_ + b16), la_ + 18432u); G3_GLDS(bp1 + (kb_ + b16), la_ + 19456u); } else { G3_GLDS(bp2 + kb_, la_ + 18432u); G3_GLDS(bp3 + kb_, la_ + 19456u); } \
    } else { \
      const unsigned la_ = __builtin_amdgcn_readfirstlane(st_ + wu * 4096u); \
      const unsigned lb_ = __builtin_amdgcn_readfirstlane(st_ + 16384u + wu * 2048u); \
      G3_GLDS(ap0 + ka_, la_); G3_GLDS(ap1 + ka_, la_ + 1024u); G3_GLDS(ap2 + ka_, la_ + 2048u); G3_GLDS(ap3 + ka_, la_ + 3072u); \
      G3_GLDS(bp0 + kb_, lb_); G3_GLDS(bp1 + kb_, lb_ + 1024u); \
    } }
#pragma unroll
  for (int mi = 0; mi < 4; ++mi)
#pragma unroll
    for (int ni = 0; ni < NTW; ++ni) acc[mi][ni] = (f32x4){0.f, 0.f, 0.f, 0.f};
  const int nk = K >> 6;
  __syncthreads();
  G3_ISSUE(0)
  if (!LEAN && BN == 128) {
#define G3_PIECE(I, KT) { const unsigned st_ = lds0 + (((KT) & 1) ? STAGE * 2 : 0); const long ka_ = (long)(KT) * a_kstep, kb_ = (long)(KT) * 64; \
      const unsigned la_ = __builtin_amdgcn_readfirstlane(st_ + wu * 4096u); \
      if ((I) == 0) G3_GLDS(ap0 + ka_, la_); else if ((I) == 1) G3_GLDS(ap1 + ka_, la_ + 1024u); \
      else if ((I) == 2) G3_GLDS((a16 ? ap0 + a16 : ap2) + ka_, la_ + 2048u); else if ((I) == 3) G3_GLDS((a16 ? ap1 + a16 : ap3) + ka_, la_ + 3072u); \
      else if ((I) == 4) G3_GLDS(bp0 + kb_, la_ + 16384u); else if ((I) == 5) G3_GLDS(bp1 + kb_, la_ + 17408u); \
      else if ((I) == 6) G3_GLDS((b16 ? bp0 + b16 : bp2) + kb_, la_ + 18432u); else G3_GLDS((b16 ? bp1 + b16 : bp3) + kb_, la_ + 19456u); }
#define G3_STEP(KT, DOISSUE) { const u16* sAs = sbase + ((KT) & 1) * STAGE; const u16* sBs = sAs + 8192; \
      bf16x8 af[2][4], bg[2][NTW];     \
      _Pragma("unroll") for (int ks = 0; ks < 2; ++ks) { \
        const int pcol = ((ks * 4 + quad) ^ sz) * 8; \
        _Pragma("unroll") for (int mi = 0; mi < 4; ++mi) af[ks][mi] = *(const bf16x8*)(sAs + (wm * 64 + 16 * mi + r16) * 64 + pcol); \
        _Pragma("unroll") for (int ni = 0; ni < NTW; ++ni) bg[ks][ni] = *(const bf16x8*)(sBs + (wn * (BN / 2) + 16 * ni + r16) * 64 + pcol); } \
      __builtin_amdgcn_s_setprio(1);     \
      _Pragma("unroll") for (int mi = 0; mi < 4; ++mi) {   \
        acc[mi][0] = __builtin_amdgcn_mfma_f32_16x16x32_bf16(af[0][mi], bg[0][0], acc[mi][0], 0, 0, 0); \
        acc[mi][1] = __builtin_amdgcn_mfma_f32_16x16x32_bf16(af[0][mi], bg[0][1], acc[mi][1], 0, 0, 0); \
        if (DOISSUE) G3_PIECE(2 * mi, (KT) + 1) \
        __builtin_amdgcn_sched_barrier(0); \
        acc[mi][2] = __builtin_amdgcn_mfma_f32_16x16x32_bf16(af[0][mi], bg[0][2], acc[mi][2], 0, 0, 0); \
        acc[mi][3] = __builtin_amdgcn_mfma_f32_16x16x32_bf16(af[0][mi], bg[0][3], acc[mi][3], 0, 0, 0); \
        if (DOISSUE) G3_PIECE(2 * mi + 1, (KT) + 1) \
        __builtin_amdgcn_sched_barrier(0); } \
      _Pragma("unroll") for (int mi = 0; mi < 4; ++mi) \
        _Pragma("unroll") for (int ni = 0; ni < NTW; ++ni) acc[mi][ni] = __builtin_amdgcn_mfma_f32_16x16x32_bf16(af[1][mi], bg[1][ni], acc[mi][ni], 0, 0, 0); \
      __builtin_amdgcn_s_setprio(0); }
#pragma unroll 1
    for (int kt = 0; kt < nk - 1; ++kt) {
      asm volatile("s_waitcnt vmcnt(0) lgkmcnt(0)" ::: "memory");
      __builtin_amdgcn_s_barrier();
      asm volatile("" ::: "memory");
      G3_STEP(kt, true)
    }
    asm volatile("s_waitcnt vmcnt(0) lgkmcnt(0)" ::: "memory");
    __builtin_amdgcn_s_barrier();
    asm volatile("" ::: "memory");
    G3_STEP(nk - 1, false)
#undef G3_PIECE
#undef G3_STEP
  } else
#pragma unroll 1
  for (int kt = 0; kt < nk; ++kt) {
    asm volatile("s_waitcnt vmcnt(0) lgkmcnt(0)" ::: "memory");
    __builtin_amdgcn_s_barrier();
    asm volatile("" ::: "memory");
    if (kt + 1 < nk) G3_ISSUE(kt + 1)
    const u16* sAs = sbase + (kt & 1) * STAGE;
    const u16* sBs = sAs + 8192;
#pragma unroll 1
    for (int ks = 0; ks < (LEAN ? 2 : 0); ++ks) {
      const int pcol = ((ks * 4 + quad) ^ sz) * 8;
      bf16x8 af[4];
#pragma unroll
      for (int mi = 0; mi < 4; ++mi) af[mi] = *(const bf16x8*)(sAs + (wm * 64 + 16 * mi + r16) * 64 + pcol);
#pragma unroll
      for (int ni = 0; ni < NTW; ++ni) {
        bf16x8 b1 = *(const bf16x8*)(sBs + (wn * (BN / 2) + 16 * ni + r16) * 64 + pcol);
#pragma unroll
        for (int mi = 0; mi < 4; ++mi) acc[mi][ni] = __builtin_amdgcn_mfma_f32_16x16x32_bf16(af[mi], b1, acc[mi][ni], 0, 0, 0);
      }
    }
#pragma unroll
    for (int ks = 0; ks < (LEAN ? 0 : 2); ++ks) {
      const int pcol = ((ks * 4 + quad) ^ sz) * 8;
      bf16x8 af[4], bg[NTW];
#pragma unroll
      for (int mi = 0; mi < 4; ++mi) af[mi] = *(const bf16x8*)(sAs + (wm * 64 + 16 * mi + r16) * 64 + pcol);
#pragma unroll
      for (int ni = 0; ni < NTW; ++ni) bg[ni] = *(const bf16x8*)(sBs + (wn * (BN / 2) + 16 * ni + r16) * 64 + pcol);
#pragma unroll
      for (int mi = 0; mi < 4; ++mi)
#pragma unroll
        for (int ni = 0; ni < NTW; ++ni) acc[mi][ni] = __builtin_amdgcn_mfma_f32_16x16x32_bf16(af[mi], bg[ni], acc[mi][ni], 0, 0, 0);
    }
  }
#undef G3_ISSUE
#undef G3_GLDS
}
template <int NCOLS>
DI void store_tile_bf16(const u16* sC, u16* gdst, long ld, int rows_valid) {
  constexpr int CPR = NCOLS / 8, LS = NCOLS + 8;
  const int tid = TID();
#pragma unroll
  for (int q = 0; q < (128 * CPR) / 256; ++q) {
    const int c = tid + 256 * q, row = c / CPR, ch = c % CPR;
    if (row < rows_valid) *(uint4*)(gdst + (long)row * ld + ch * 8) = *(const uint4*)(sC + row * LS + ch * 8);
  }
}
DI int pair_col(int np, int& which) {
  const int nt = np >> 7, c = np & 127, wn = c >> 6, ni = (c >> 4) & 3, r = c & 15;
  which = ni >> 1;
  return nt * 64 + wn * 32 + (ni & 1) * 16 + r;
}
DI const float* conv_colptr(const Params& P, int l, int mat, int np, long& ld) {
  int which;
  switch (mat) {
    case 0: ld = DIN; return P.in[3] + (long)l * DM * DIN + proj_src_col(np);
    case 1: ld = DIN; return P.in[3] + (long)l * DM * DIN + 2708 + np;
    case 2: ld = DM; return P.in[24] + ((long)(l * 4 + (np >> 10)) * 256) * DM + (np & 1023);
    case 3: ld = DM; return P.in[25] + (long)l * DM * DM + np;
    case 4: { int o = pair_col(np, which); ld = DFF; return (which ? P.in[28] : P.in[27]) + (long)l * DM * DFF + o; }
    case 5: ld = DM; return P.in[29] + (long)l * DFF * DM + np;
    case 6: { int o = pair_col(np, which); ld = 512; return P.in[19] + (long)l * 256 * 512 + which * 256 + o; }
    case 7: ld = 256; return P.in[(np >> 8) ? 9 : 7] + (long)l * 2048 * 256 + (np & 255);
    default: ld = 64; return P.in[(np >> 6) ? 10 : 8] + (long)l * 256 * 64 + (np & 63);
  }
}
DI void phase_convert(const Params& P, int l, float* lds) {
  const int tid = TID();
  if (blockIdx.x < 64) {
    const int kv = blockIdx.x >> 5, ks = blockIdx.x & 31;
    const float* pos = P.in[6] + (long)(l * 2 + kv) * 2048 + ks * 64;
    const float* w1 = P.in[kv ? 9 : 7] + (long)l * 2048 * 256 + (long)ks * 64 * 256 + tid;
    float a = 0.f;
#pragma unroll 8
    for (int k = 0; k < 64; ++k) a += pos[k] * w1[(long)k * 256];
    ((float*)(WSP(P) + WS_CBIAS))[(kv * 32 + ks) * 256 + tid] = a;
  }
  const int NB_[9] = {44, 64, 64, 16, 88, 16, 8, 8, 2};
  const int KB_[9] = {16, 16, 4, 16, 16, 44, 4, 32, 4};
  const size_t OFF_[9] = {WT_IN, WT_G, WT_BR, WT_OUT, WT_GU, WT_D, WT_GLU, WT_C1, WT_C2};
  for (int it = blockIdx.x; it < 4648; it += gridDim.x) {
    int r = it, mat = 0, nbk = 0, kbk = 0; size_t off = 0;
#pragma unroll
    for (int q = 0; q < 9; ++q) { int n = NB_[q] * KB_[q]; if (r >= 0 && r < n) { mat = q; nbk = NB_[q]; kbk = KB_[q]; off = OFF_[q]; r -= 100000; } else if (r >= 0) r -= n; }
    r += 100000;
    const int nb = r / kbk, kb = r % kbk, K = kbk * 64;
    (void)nbk;
    __syncthreads();
    {
      const int n = tid & 63;
      long ld; const float* cp = conv_colptr(P, l, mat, nb * 64 + n, ld);
#pragma unroll 4
      for (int q = 0; q < 16; ++q) { int k = (tid >> 6) + 4 * q; lds[n * 65 + k] = cp[(long)(kb * 64 + k) * ld]; }
    }
    __syncthreads();
    u16* dst = (u16*)(WSP(P) + WS_W + off);
#pragma unroll
    for (int q = 0; q < 2; ++q) {
      int c = tid + 256 * q, n = c >> 3, k8 = (c & 7) * 8;
      const float* sp = lds + n * 65 + k8;
      uint4 v; v.x = pk2(sp[0], sp[1]); v.y = pk2(sp[2], sp[3]); v.z = pk2(sp[4], sp[5]); v.w = pk2(sp[6], sp[7]);
      *(uint4*)(dst + (long)(nb * 64 + n) * K + kb * 64 + k8) = v;
    }
  }
}

DI void st_mma(f32x4 (&st)[4], const u16* sK, const bf16x8 (&bq)[2], int lane) {
  const int r = lane & 15, quad = lane >> 4;
#pragma unroll
  for (int mt = 0; mt < 4; ++mt) {
    f32x4 a = {0.f, 0.f, 0.f, 0.f};
#pragma unroll
    for (int ks = 0; ks < 2; ++ks) {
      bf16x8 kf = *(const bf16x8*)(sK + (16 * mt + r) * 72 + ks * 32 + quad * 8);
      a = __builtin_amdgcn_mfma_f32_16x16x32_bf16(kf, bq[ks], a, 0, 0, 0);
    }
    st[mt] = a;
  }
}
DI void pv_mma(f32x4 (&ot)[4], const u16* sVt, const f32x4 (&p)[4], int lane) {
  const int r = lane & 15, quad = lane >> 4;
#pragma unroll
  for (int ks = 0; ks < 2; ++ks) {
    uint4 pu;
    pu.x = pk2(p[2 * ks][0], p[2 * ks][1]); pu.y = pk2(p[2 * ks][2], p[2 * ks][3]);
    pu.z = pk2(p[2 * ks + 1][0], p[2 * ks + 1][1]); pu.w = pk2(p[2 * ks + 1][2], p[2 * ks + 1][3]);
    bf16x8 pb = __builtin_bit_cast(bf16x8, pu);
#pragma unroll
    for (int dt = 0; dt < 4; ++dt) {
      const u16* vrow = sVt + (16 * dt + r) * 72;
      s16x4 lo = *(const s16x4*)(vrow + ((32 * ks + 4 * quad) ^ (16 * dt)));
      s16x4 hi = *(const s16x4*)(vrow + ((32 * ks + 16 + 4 * quad) ^ (16 * dt)));
      bf16x8 vf = __builtin_shufflevector(lo, hi, 0, 1, 2, 3, 4, 5, 6, 7);
      ot[dt] = __builtin_amdgcn_mfma_f32_16x16x32_bf16(vf, pb, ot[dt], 0, 0, 0);
    }
  }
}
DI void load_tile(u16* dst, const u16* src, long ld) {
  const int tid = TID();
#pragma unroll
  for (int i = 0; i < 2; ++i) {
    int c = tid + 256 * i, row = c >> 3, ch = c & 7;
    uint4 v = *(const uint4*)(src + (long)row * ld + ch * 8);
    *(uint4*)(dst + row * 72 + ch * 8) = v;
  }
}
DI void load_tile_T(u16* dst, const u16* src, long ld) {
  const int tid = TID();
#pragma unroll
  for (int i = 0; i < 2; ++i) {
    int c = tid + 256 * i, row = c >> 3, ch = c & 7;
    uint4 v = *(const uint4*)(src + (long)row * ld + ch * 8);
    const unsigned* vv = (const unsigned*)&v;
#pragma unroll
    for (int q = 0; q < 4; ++q) {
      dst[(ch * 8 + 2 * q) * 72 + row] = (u16)(vv[q] & 0xffff);
      dst[(ch * 8 + 2 * q + 1) * 72 + row] = (u16)(vv[q] >> 16);
    }
  }
}
DI void load_q_nsa(u16* dst, const u16* src, long ld) {
  const int tid = TID();
#pragma unroll
  for (int i = 0; i < 2; ++i) {
    int c = tid + 256 * i, row = c >> 3, ch = c & 7;
    uint4 v = *(const uint4*)(src + (long)(row & 15) * ld + (row >> 4) * 64 + ch * 8);
    *(uint4*)(dst + row * 72 + ch * 8) = v;
  }
}
DI void load_qfrag(bf16x8 (&bq)[2], const u16* sQ, int w, int lane) {
  const int r = lane & 15, quad = lane >> 4;
  bq[0] = *(const bf16x8*)(sQ + (16 * w + r) * 72 + quad * 8);
  bq[1] = *(const bf16x8*)(sQ + (16 * w + r) * 72 + 32 + quad * 8);
}
DI float quad_max(float v) { v = fmaxf(v, __shfl_xor(v, 16)); v = fmaxf(v, __shfl_xor(v, 32)); return v; }
DI float quad_sum(float v) { v += __shfl_xor(v, 16); v += __shfl_xor(v, 32); return v; }

DI void softmax_tile(f32x4 (&st)[4], const bool (&msk)[4][4], float& m, float& l, f32x4 (&ot)[4]) {
  float tm = -1e30f;
#pragma unroll
  for (int mt = 0; mt < 4; ++mt)
#pragma unroll
    for (int j = 0; j < 4; ++j) { float s = st[mt][j] * 0.125f; st[mt][j] = s; if (msk[mt][j]) tm = fmaxf(tm, s); }
  tm = quad_max(tm);
  float mn = fmaxf(m, tm);
  float alpha = __expf(m - mn);
  float ps = 0.f;
#pragma unroll
  for (int mt = 0; mt < 4; ++mt)
#pragma unroll
    for (int j = 0; j < 4; ++j) { float p = msk[mt][j] ? __expf(st[mt][j] - mn) : 0.f; st[mt][j] = p; ps += p; }
  l = l * alpha + ps;
  m = mn;
#pragma unroll
  for (int dt = 0; dt < 4; ++dt)
#pragma unroll
    for (int j = 0; j < 4; ++j) ot[dt][j] *= alpha;
}

DI void softmax_tile_full(f32x4 (&st)[4], float& m, float& l, f32x4 (&ot)[4]) {
  float tm = st[0][0];
#pragma unroll
  for (int mt = 0; mt < 4; ++mt)
#pragma unroll
    for (int j = 0; j < 4; ++j) tm = fmaxf(tm, st[mt][j]);
  tm = quad_max(tm) * 0.125f;
  const float mn = fmaxf(m, tm);
  const float alpha = __expf(m - mn);
  float ps = 0.f;
#pragma unroll
  for (int mt = 0; mt < 4; ++mt)
#pragma unroll
    for (int j = 0; j < 4; ++j) { const float p = __expf(st[mt][j] * 0.125f - mn); st[mt][j] = p; ps += p; }
  l = l * alpha + ps;
  m = mn;
#pragma unroll
  for (int dt = 0; dt < 4; ++dt)
#pragma unroll
    for (int j = 0; j < 4; ++j) ot[dt][j] *= alpha;
}

DI void phase_rmsnorm(const float* __restrict__ x, const float* __restrict__ wgt, u16* __restrict__ H) {
  const int lane = TID() & 63, w = TID() >> 6;
  const int gw = blockIdx.x * 4 + w, nw = gridDim.x * 4;
  for (int row = gw; row < T_; row += nw) {
    const float4* xr = (const float4*)(x + (long)row * DM);
    float4 v[4]; float s = 0.f;
#pragma unroll
    for (int j = 0; j < 4; ++j) { v[j] = xr[lane + 64 * j]; s += v[j].x * v[j].x + v[j].y * v[j].y + v[j].z * v[j].z + v[j].w * v[j].w; }
    s = wave_sum(s);
    float r = rsqrtf(s * (1.f / DM) + EPS);
#pragma unroll
    for (int j = 0; j < 4; ++j) {
      float4 g = ((const float4*)wgt)[lane + 64 * j];
      uint2 o; o.x = pk2(v[j].x * r * g.x, v[j].y * r * g.y); o.y = pk2(v[j].z * r * g.z, v[j].w * r * g.w);
      *(uint2*)(H + (long)row * DM + (lane + 64 * j) * 4) = o;
    }
  }
}
DI void phase_rope_table(const int* __restrict__ positions, float* __restrict__ COS, float* __restrict__ SIN) {
  const float invf[8] = {1.0f, 0.1939227432012558f, 0.03760603070259094f, 0.007292664609849453f,
                         0.0014142135623842478f, 0.00027424818836152554f, 5.3182957344688475e-05f, 1.0313385246263351e-05f};
  for (int idx = blockIdx.x * 256 + TID(); idx < T_ * 8; idx += gridDim.x * 256) {
    int i = idx & 7;
    float f = invf[0];
#pragma unroll
    for (int q = 1; q < 8; ++q) f = (i == q) ? invf[q] : f;
    float ang = (float)positions[idx >> 3] * f;
    double s, c; sincos_d((double)ang, s, c);
    COS[idx] = (float)c; SIN[idx] = (float)s;
  }
}

struct S5Coef { float ar, ai; float bbr[16], bbi[16]; };
DI void s5_coef(const Params& P, int l, int g, int p, S5Coef& C) {
  float dt = expf(P.in[13][l * 16 + g]);
  float lr = P.in[11][(l * 16 + g) * 64 + p], li = P.in[12][(l * 16 + g) * 64 + p];
  float mag = expf(lr * dt);
  double s, c; sincos_d((double)(li * dt), s, c);
  C.ar = mag * (float)c; C.ai = mag * (float)s;
  float den = lr * lr + li * li;
  float fr = ((C.ar - 1.f) * lr + C.ai * li) / den;
  float fi = (C.ai * lr - (C.ar - 1.f) * li) / den;
  const float* br = P.in[14] + ((long)(l * 16 + g) * 64 + p) * 16;
  const float* bi = P.in[15] + ((long)(l * 16 + g) * 64 + p) * 16;
#pragma unroll
  for (int c2 = 0; c2 < 16; ++c2) {
    float b_r = br[c2], b_i = bi[c2];
    C.bbr[c2] = fr * b_r - fi * b_i;
    C.bbi[c2] = fr * b_i + fi * b_r;
  }
}
DI void s5_load_u(float* su, const u16* PROJ, int b, int chunk, int g, int lane) {
  const u16* src = PROJ + ((long)(b * SEQ + chunk * 64 + lane)) * PW + P_S5U + g * 16;
  uint4 v0 = ((const uint4*)src)[0], v1 = ((const uint4*)src)[1];
  const unsigned* a = (const unsigned*)&v0; const unsigned* c = (const unsigned*)&v1;
  float* d = su + lane * 16;
#pragma unroll
  for (int q = 0; q < 4; ++q) { d[2 * q] = bf2f((u16)(a[q] & 0xffff)); d[2 * q + 1] = bf2f((u16)(a[q] >> 16)); }
#pragma unroll
  for (int q = 0; q < 4; ++q) { d[8 + 2 * q] = bf2f((u16)(c[q] & 0xffff)); d[8 + 2 * q + 1] = bf2f((u16)(c[q] >> 16)); }
}

DI void s5_pass1_item(const Params& P, int l, int it, float* lds) {
  const int lane = TID() & 63, w = TID() >> 6;
  const int gq = it & 3, chunk = (it >> 2) & 63, b = it >> 8;
  const int g = gq * 4 + w;
  const u16* PROJ = (const u16*)(WSP(P) + WS_PROJ);
  float* su = lds + w * 1024;
  S5Coef C; s5_coef(P, l, g, lane, C);
  s5_load_u(su, PROJ, b, chunk, g, lane);
  __syncthreads();
  float xr = 0.f, xi = 0.f;
#pragma unroll 4
  for (int t = 0; t < 64; ++t) {
    const f32x4* up = (const f32x4*)(su + t * 16);
    float br = 0.f, bi = 0.f;
#pragma unroll
    for (int q = 0; q < 4; ++q) {
      f32x4 u = up[q];
#pragma unroll
      for (int e = 0; e < 4; ++e) { br += u[e] * C.bbr[4 * q + e]; bi += u[e] * C.bbi[4 * q + e]; }
    }
    float nr = C.ar * xr - C.ai * xi + br;
    float ni = C.ar * xi + C.ai * xr + bi;
    xr = nr; xi = ni;
  }
  float2* ENDS = (float2*)(WSP(P) + WS_ENDS);
  ENDS[((long)(b * 64 + chunk) * 16 + g) * 64 + lane] = make_float2(xr, xi);
}

DI void s5_carry_item(const Params& P, int l, int it) {
  const int idx = it * 256 + TID();
  const int b = idx >> 10, gp = idx & 1023, g = gp >> 6, p = gp & 63;
  float dt = expf(P.in[13][l * 16 + g]);
  float lr = P.in[11][(l * 16 + g) * 64 + p], li = P.in[12][(l * 16 + g) * 64 + p];
  float mag = expf(lr * dt * 64.f);
  double s, c; sincos_d((double)(li * dt) * 64.0, s, c);
  float ar = mag * (float)c, ai = mag * (float)s;
  const float2* ENDS = (const float2*)(WSP(P) + WS_ENDS);
  float2* CARRY = (float2*)(WSP(P) + WS_CARRY);
  float xr = 0.f, xi = 0.f;
  for (int ch = 0; ch < 64; ++ch) {
    long o = ((long)(b * 64 + ch) * 16 + g) * 64 + p;
    CARRY[o] = make_float2(xr, xi);
    float2 e = ENDS[o];
    float nr = ar * xr - ai * xi + e.x;
    float ni = ar * xi + ai * xr + e.y;
    xr = nr; xi = ni;
  }
}

DI void s5_pass2_item(const Params& P, int l, int it, float* lds) {
  const int lane = TID() & 63, w = TID() >> 6, r16 = lane & 15, quad = lane >> 4;
  const int gq = it & 3, chunk = (it >> 2) & 63, b = it >> 8;
  const int g = gq * 4 + w;
  const u16* PROJ = (const u16*)(WSP(P) + WS_PROJ);
  u16* Y5 = (u16*)(WSP(P) + WS_Y5);
  float* su = lds + w * 1024;
  u16* sX = (u16*)(lds + 4096) + w * (32 * 136);
  S5Coef C; s5_coef(P, l, g, lane, C);
  bf16x8 bfr[4];
#pragma unroll
  for (int ks = 0; ks < 4; ++ks) {
    const float* src = P.in[(ks < 2) ? 16 : 17] + ((long)(l * 16 + g) * 16 + r16) * 64 + (ks & 1) * 32 + quad * 8;
    const float4 v0 = ((const float4*)src)[0], v1 = ((const float4*)src)[1];
    const float sg = (ks < 2) ? 1.f : -1.f;
    uint4 pu; pu.x = pk2(sg * v0.x, sg * v0.y); pu.y = pk2(sg * v0.z, sg * v0.w); pu.z = pk2(sg * v1.x, sg * v1.y); pu.w = pk2(sg * v1.z, sg * v1.w);
    bfr[ks] = __builtin_bit_cast(bf16x8, pu);
  }
  const float dsk = P.in[18][l * 256 + g * 16 + r16];
  s5_load_u(su, PROJ, b, chunk, g, lane);
  __syncthreads();
  const float2 c0 = ((const float2*)(WSP(P) + WS_CARRY))[((long)(b * 64 + chunk) * 16 + g) * 64 + lane];
  float xr = c0.x, xi = c0.y;
  for (int half = 0; half < 2; ++half) {
#pragma unroll 4
    for (int tt = 0; tt < 32; ++tt) {
      const int t = half * 32 + tt;
      const f32x4* up = (const f32x4*)(su + t * 16);
      float br0 = 0.f, bi0 = 0.f, br1 = 0.f, bi1 = 0.f;
#pragma unroll
      for (int q = 0; q < 4; ++q) {
        f32x4 u = up[q];
        br0 += u[0] * C.bbr[4 * q + 0]; bi0 += u[0] * C.bbi[4 * q + 0];
        br1 += u[1] * C.bbr[4 * q + 1]; bi1 += u[1] * C.bbi[4 * q + 1];
        br0 += u[2] * C.bbr[4 * q + 2]; bi0 += u[2] * C.bbi[4 * q + 2];
        br1 += u[3] * C.bbr[4 * q + 3]; bi1 += u[3] * C.bbi[4 * q + 3];
      }
      const float nr = C.ar * xr - C.ai * xi + (br0 + br1);
      const float ni = C.ar * xi + C.ai * xr + (bi0 + bi1);
      xr = nr; xi = ni;
      sX[tt * 136 + lane] = f2bf(xr);
      sX[tt * 136 + 64 + lane] = f2bf(xi);
    }
    __syncthreads();
#pragma unroll
    for (int mt = 0; mt < 2; ++mt) {
      f32x4 acc = {0.f, 0.f, 0.f, 0.f};
#pragma unroll
      for (int ks = 0; ks < 4; ++ks) {
        const bf16x8 af = *(const bf16x8*)(sX + (16 * mt + r16) * 136 + ks * 32 + quad * 8);
        acc = __builtin_amdgcn_mfma_f32_16x16x32_bf16(af, bfr[ks], acc, 0, 0, 0);
      }
#pragma unroll
      for (int j = 0; j < 4; ++j) {
        const int t = half * 32 + 16 * mt + 4 * quad + j;
        const float y = acc[j] + dsk * su[t * 16 + r16];
        Y5[((long)(b * SEQ + chunk * 64 + t)) * 256 + g * 16 + r16] = f2bf(gelu_tanh(y));
      }
    }
    __syncthreads();
  }
}

DI void nsa_prep_item(const Params& P, int l, int it) {
  const int lane = TID() & 63, w = TID() >> 6;
  u16* PROJ = (u16*)(WSP(P) + WS_PROJ);
  u16* QR = (u16*)(WSP(P) + WS_QR);
  const float* COS = (const float*)(WSP(P) + WS_COS);
  const float* SIN = (const float*)(WSP(P) + WS_SIN);
  for (int tt = 0; tt < 4; ++tt) {
    const long t = (long)it * 16 + w * 4 + tt;
    const float cs = COS[t * 8 + (lane & 7)], sn = SIN[t * 8 + (lane & 7)];
#pragma unroll
    for (int g = 0; g < 6; ++g) {
      const int col = (g < 4) ? (P_Q + g * 64) : (g == 4 ? P_KV + 128 : P_KV + 256);
      const float wg = (g < 4) ? P.in[4][l * 64 + lane] : P.in[5][(l * 3 + (g - 3)) * 64 + lane];
      u16* ptr = PROJ + t * PW + col + lane;
      float v = bf2f(*ptr);
      float ss = wave_sum(v * v);
      float y = v * rsqrtf(ss * (1.f / 64.f) + EPS) * wg;
      float pr = __shfl_xor(y, 8);
      float rot = (lane < 8) ? (y * cs - pr * sn) : ((lane < 16) ? (y * cs + pr * sn) : y);
      if (g < 4) { *ptr = f2bf(y); QR[t * 256 + g * 64 + lane] = f2bf(rot); }
      else *ptr = f2bf(rot);
    }
  }
}

DI void cmp1_tile(const Params& P, int l, int ct, u16* sA, u16* sB) {
  const int tid = TID(), lane = tid & 63, w = tid >> 6, r16 = lane & 15, quad = lane >> 4, wm = w >> 1, wn = w & 1;
  const int kv = ct >> 5, mt = (ct >> 1) & 15, nt = ct & 1;
  const u16* PROJ = (const u16*)(WSP(P) + WS_PROJ);
  u16* HID = (u16*)(WSP(P) + WS_HID);
  const u16* apq[4];
#pragma unroll
  for (int q = 0; q < 4; ++q) {
    int row, pc; g3_rowpiece(tid, q, false, row, pc);
    int gr = mt * 128 + row; if (gr > 2039) gr = 2039;
    const int b = gr / 255, n = gr % 255;
    apq[q] = PROJ + ((long)(b * SEQ + 16 * n)) * PW + P_KV + kv * 64 + pc * 8;
  }
  const u16* Bb = (const u16*)(WSP(P) + WS_W + WT_C1) + ((long)(kv * 256 + nt * 128)) * 2048;
  f32x4 acc[4][4];
  gemm3<4>(acc, apq[0], apq[1], apq[2], apq[3], PW,
           g3_ptr(Bb, 2048, tid, 0, false), g3_ptr(Bb, 2048, tid, 1, false), g3_ptr(Bb, 2048, tid, 2, false), g3_ptr(Bb, 2048, tid, 3, false), 2048, sA);
  {
    const float* PART = (const float*)(WSP(P) + WS_CBIAS) + (long)kv * 32 * 256;
#pragma unroll
    for (int ni = 0; ni < 4; ++ni) {
      const int col = nt * 128 + wn * 64 + 16 * ni + r16;
      float bsum = 0.f;
      for (int sl = 0; sl < 32; ++sl) bsum += PART[sl * 256 + col];
#pragma unroll
      for (int mi = 0; mi < 4; ++mi)
#pragma unroll
        for (int j = 0; j < 4; ++j) acc[mi][ni][j] += bsum;
    }
  }
  __syncthreads();
#pragma unroll
  for (int mi = 0; mi < 4; ++mi)
#pragma unroll
    for (int ni = 0; ni < 4; ++ni)
#pragma unroll
      for (int j = 0; j < 4; ++j) sA[(wm * 64 + 16 * mi + 4 * quad + j) * 136 + wn * 64 + 16 * ni + r16] = f2bf(gelu_tanh(acc[mi][ni][j]));
  __syncthreads();
  store_tile_bf16<128>(sA, HID + ((long)kv * 2048 + mt * 128) * 256 + nt * 128, 256, 2040 - mt * 128);
}
DI void cmp2_tile(const Params& P, int l, int ct, u16* sA, u16* sB, float* sSS) {
  const int tid = TID(), lane = tid & 63, w = tid >> 6, r16 = lane & 15, quad = lane >> 4, wm = w >> 1, wn = w & 1;
  const int kv = ct >> 4, mt = ct & 15;
  const u16* HID = (const u16*)(WSP(P) + WS_HID);
  u16* OUT = (u16*)(WSP(P) + (kv ? WS_VC : WS_KC));
  const u16* Ab = HID + ((long)kv * 2048 + mt * 128) * 256;
  const u16* Bb = (const u16*)(WSP(P) + WS_W + WT_C2) + (long)kv * 64 * 256;
  f32x4 acc[4][2];
  gemm3<2>(acc, g3_ptr(Ab, 256, tid, 0, false), g3_ptr(Ab, 256, tid, 1, false), g3_ptr(Ab, 256, tid, 2, false), g3_ptr(Ab, 256, tid, 3, false), 64,
           g3_ptr(Bb, 256, tid, 0, true), g3_ptr(Bb, 256, tid, 1, true), nullptr, nullptr, 256, sA);
  __syncthreads();
  if (tid < 128) sSS[tid] = 0.f;
  __syncthreads();
#pragma unroll
  for (int mi = 0; mi < 4; ++mi)
#pragma unroll
    for (int j = 0; j < 4; ++j) {
      float ss = acc[mi][0][j] * acc[mi][0][j] + acc[mi][1][j] * acc[mi][1][j];
      ss += __shfl_xor(ss, 1); ss += __shfl_xor(ss, 2); ss += __shfl_xor(ss, 4); ss += __shfl_xor(ss, 8);
      if (r16 == 0) atomicAdd(&sSS[wm * 64 + 16 * mi + 4 * quad + j], ss);
    }
  __syncthreads();
#pragma unroll
  for (int mi = 0; mi < 4; ++mi)
#pragma unroll
    for (int j = 0; j < 4; ++j) {
      const int rl = wm * 64 + 16 * mi + 4 * quad + j, row = mt * 128 + rl;
      const float sc = (kv == 0) ? rsqrtf(sSS[rl] * (1.f / 64.f) + EPS) : 1.f;
      if (row < 2040) {
        int b = row / 255, n = row % 255;
#pragma unroll
        for (int ni = 0; ni < 2; ++ni) {
          int col = wn * 32 + 16 * ni + r16;
          float v = acc[mi][ni][j] * sc;
          if (kv == 0) v *= P.in[5][(l * 3 + 0) * 64 + col];
          OUT[((long)(b * 256 + n)) * 64 + col] = f2bf(v);
        }
      }
    }
}

DI void gdn_p1_item(const Params& P, int l, int it, float* lds) {
  const int tid = TID(), lane = tid & 63, w = tid >> 6, r16 = lane & 15, quad = lane >> 4;
  const int chunk = it & 63, h = (it >> 6) & 3, b = it >> 8;
  const long ci = it;
  const u16* PROJ = (const u16*)(WSP(P) + WS_PROJ);
  float* sq = lds;
  float* sk = lds + 64 * 65;
  float* sv = lds + 2 * 64 * 65;
  float* sG = lds + 3 * 64 * 65;
  float* sBeta = sG + 64;
  float* sg = sBeta + 64;
  u16* sQb = (u16*)(sg + 64);
  u16* sKb = sQb + 64 * 72;
  const float* cw = P.in[20] + (long)l * 4 * 768;
  if (tid < 192) {
    const int cp = tid % 96, th = tid / 96;
    const int c0 = 2 * cp, which = c0 >> 6, d = c0 & 63, C = which * 256 + h * 64 + d;
    float w0[4], w1[4];
#pragma unroll
    for (int k = 0; k < 4; ++k) { w0[k] = cw[k * 768 + C]; w1[k] = cw[k * 768 + C + 1]; }
    unsigned v[35];
    const int s0 = chunk * 64 + th * 32 - 3;
    const u16* src = PROJ + ((long)(b * SEQ + s0)) * PW + P_GQKV + C;
#pragma unroll
    for (int k = 0; k < 35; ++k) v[k] = (s0 + k >= 0) ? *(const unsigned*)(src + (long)k * PW) : 0u;
    float* dst = lds + which * 64 * 65 + (th * 32) * 65 + d;
#pragma unroll
    for (int tt = 0; tt < 32; ++tt) {
      float a0 = 0.f, a1 = 0.f;
#pragma unroll
      for (int k = 0; k < 4; ++k) { a0 += w0[k] * bf2f((u16)(v[tt + k] & 0xffff)); a1 += w1[k] * bf2f((u16)(v[tt + k] >> 16)); }
      dst[tt * 65] = siluf_(a0); dst[tt * 65 + 1] = siluf_(a1);
    }
  }
  __syncthreads();
  if (tid < 128) {
    float* base = (tid < 64) ? sq : sk;
    u16* bb = (tid < 64) ? sQb : sKb;
    const int row = tid & 63;
    float ss = 0.f;
#pragma unroll 8
    for (int d = 0; d < 64; ++d) { float x = base[row * 65 + d]; ss += x * x; }
    const float sc = rsqrtf(ss + EPS) * ((tid < 64) ? 0.125f : 1.f);
#pragma unroll 8
    for (int d = 0; d < 64; d += 2) {
      const float x0 = base[row * 65 + d] * sc, x1 = base[row * 65 + d + 1] * sc;
      base[row * 65 + d] = x0; base[row * 65 + d + 1] = x1;
      *(unsigned*)(bb + row * 72 + d) = pk2(x0, x1);
    }
  } else if (tid < 192) {
    const int row = tid - 128;
    const long t = (long)(b * SEQ + chunk * 64 + row);
    const float bl = bf2f(PROJ[t * PW + P_GB + h]);
    const float al = bf2f(PROJ[t * PW + P_GA + h]);
    sBeta[row] = sigmoidf_(bl);
    sg[row] = -expf(P.in[21][l * 4 + h]) * softplusf_(al + P.in[22][l * 4 + h]);
  }
  __syncthreads();
  if (tid < 64) {
    float x = sg[tid];
#pragma unroll
    for (int o = 1; o < 64; o <<= 1) { float u = __shfl_up(x, o); if (tid >= o) x += u; }
    sG[tid] = x;
    ((float*)(WSP(P) + WS_GG))[ci * 64 + tid] = x;
  }
  __syncthreads();
  f32x4 lreg[4];
  {
    const f32x4 Gi4 = *(const f32x4*)(sG + 16 * w + 4 * quad);
    const f32x4 Bi4 = *(const f32x4*)(sBeta + 16 * w + 4 * quad);
    u16* GA = (u16*)(WSP(P) + WS_GA) + ci * 4096;
#pragma unroll
    for (int nt = 0; nt < 4; ++nt) {
      f32x4 aq = {0.f, 0.f, 0.f, 0.f}, ak = {0.f, 0.f, 0.f, 0.f};
#pragma unroll
      for (int ks = 0; ks < 2; ++ks) {
        const bf16x8 fq = *(const bf16x8*)(sQb + (16 * w + r16) * 72 + ks * 32 + quad * 8);
        const bf16x8 fk = *(const bf16x8*)(sKb + (16 * w + r16) * 72 + ks * 32 + quad * 8);
        const bf16x8 fb = *(const bf16x8*)(sKb + (16 * nt + r16) * 72 + ks * 32 + quad * 8);
        aq = __builtin_amdgcn_mfma_f32_16x16x32_bf16(fq, fb, aq, 0, 0, 0);
        ak = __builtin_amdgcn_mfma_f32_16x16x32_bf16(fk, fb, ak, 0, 0, 0);
      }
      const int j = 16 * nt + r16;
      const float Gj = sG[j];
#pragma unroll
      for (int jj = 0; jj < 4; ++jj) {
        const int i = 16 * w + 4 * quad + jj;
        const float dec = __expf(Gi4[jj] - Gj);
        GA[i * 64 + j] = f2bf((j <= i) ? aq[jj] * dec : 0.f);
        const float lv = (j < i) ? Bi4[jj] * ak[jj] * dec : 0.f;
        sq[i * 65 + j] = lv;
        lreg[nt][jj] = lv;
      }
    }
  }
  {
    u16* GQ = (u16*)(WSP(P) + WS_GQ) + ci * 4096;
#pragma unroll
    for (int q = 0; q < 2; ++q) { const int c = tid + 256 * q, row = c >> 3, ch = c & 7; *(uint4*)(GQ + row * 64 + ch * 8) = *(const uint4*)(sQb + row * 72 + ch * 8); }
    const int i = tid >> 2, j0 = (tid & 3) * 16;
    u16* GK = (u16*)(WSP(P) + WS_GK) + ci * 4096 + i * 64 + j0;
    unsigned ok[8];
#pragma unroll
    for (int q = 0; q < 8; ++q) ok[q] = pk2(sk[(j0 + 2 * q) * 65 + i], sk[(j0 + 2 * q + 1) * 65 + i]);
    ((uint4*)GK)[0] = make_uint4(ok[0], ok[1], ok[2], ok[3]); ((uint4*)GK)[1] = make_uint4(ok[4], ok[5], ok[6], ok[7]);
  }
  __syncthreads();
  u16* sLb = sQb;
  u16* sXT = sKb;
  {
    const int i = tid >> 2, j0 = (tid & 3) * 16;
    const float bi = sBeta[i], eg = __expf(sG[i]);
#pragma unroll
    for (int jj = 0; jj < 16; ++jj) { sv[i * 65 + j0 + jj] *= bi; sk[i * 65 + j0 + jj] *= bi * eg; }
#pragma unroll
    for (int nt = 0; nt < 4; ++nt)
#pragma unroll
      for (int jj = 0; jj < 4; ++jj) sLb[(16 * w + 4 * quad + jj) * 72 + 16 * nt + r16] = f2bf(lreg[nt][jj]);
  }
  __syncthreads();
#pragma unroll 1
  for (int bi = 0; bi < 4; ++bi) {
    if (tid < 128) {
      float* buf = (tid < 64) ? sv : sk;
      const int col = tid & 63;
      float x[16];
#pragma unroll
      for (int r = 0; r < 16; ++r) {
        float a0 = buf[(16 * bi + r) * 65 + col], a1 = 0.f;
#pragma unroll
        for (int j = 0; j + 1 < r; j += 2) { a0 -= sq[(16 * bi + r) * 65 + 16 * bi + j] * x[j]; a1 -= sq[(16 * bi + r) * 65 + 16 * bi + j + 1] * x[j + 1]; }
        if (r & 1) a0 -= sq[(16 * bi + r) * 65 + 16 * bi + r - 1] * x[r - 1];
        x[r] = a0 + a1;
        buf[(16 * bi + r) * 65 + col] = x[r];
      }
      uint4 p0, p1;
      p0.x = pk2(x[0], x[1]); p0.y = pk2(x[2], x[3]); p0.z = pk2(x[4], x[5]); p0.w = pk2(x[6], x[7]);
      p1.x = pk2(x[8], x[9]); p1.y = pk2(x[10], x[11]); p1.z = pk2(x[12], x[13]); p1.w = pk2(x[14], x[15]);
      *(uint4*)(sXT + tid * 24) = p0; *(uint4*)(sXT + tid * 24 + 8) = p1;
    }
    __syncthreads();
    if (bi < 3) {
#pragma unroll
      for (int q = 0; q < 2; ++q) {
        const int nt = 2 * w + q, colg = 16 * nt + r16;
        bf16x8 bx = *(const bf16x8*)(sXT + colg * 24 + (quad & 1) * 8);
        if (quad >= 2) bx = (bf16x8){0, 0, 0, 0, 0, 0, 0, 0};
        float* buf = (colg < 64) ? sv : sk;
        const int cc = colg & 63;
        for (int bk = bi + 1; bk < 4; ++bk) {
          const bf16x8 al = *(const bf16x8*)(sLb + (16 * bk + r16) * 72 + 16 * bi + quad * 8);
          f32x4 c = {0.f, 0.f, 0.f, 0.f};
          c = __builtin_amdgcn_mfma_f32_16x16x32_bf16(al, bx, c, 0, 0, 0);
#pragma unroll
          for (int jj = 0; jj < 4; ++jj) buf[(16 * bk + 4 * quad + jj) * 65 + cc] -= c[jj];
        }
      }
    }
    __syncthreads();
  }
  {
    const int i = tid >> 2, j0 = (tid & 3) * 16;
    u16* GU = (u16*)(WSP(P) + WS_GU) + ci * 4096 + i * 64 + j0;
    u16* GW = (u16*)(WSP(P) + WS_GW) + ci * 4096 + i * 64 + j0;
    unsigned ou[8], ow[8];
#pragma unroll
    for (int q = 0; q < 8; ++q) {
      ou[q] = pk2(sv[i * 65 + j0 + 2 * q], sv[i * 65 + j0 + 2 * q + 1]);
      ow[q] = pk2(sk[i * 65 + j0 + 2 * q], sk[i * 65 + j0 + 2 * q + 1]);
    }
    ((uint4*)GU)[0] = make_uint4(ou[0], ou[1], ou[2], ou[3]); ((uint4*)GU)[1] = make_uint4(ou[4], ou[5], ou[6], ou[7]);
    ((uint4*)GW)[0] = make_uint4(ow[0], ow[1], ow[2], ow[3]); ((uint4*)GW)[1] = make_uint4(ow[4], ow[5], ow[6], ow[7]);
  }
}

DI void unpack8(const u16* p, float (&o)[8]) {
  uint4 v = *(const uint4*)p;
  o[0] = bf2f((u16)(v.x & 0xffff)); o[1] = bf2f((u16)(v.x >> 16));
  o[2] = bf2f((u16)(v.y & 0xffff)); o[3] = bf2f((u16)(v.y >> 16));
  o[4] = bf2f((u16)(v.z & 0xffff)); o[5] = bf2f((u16)(v.z >> 16));
  o[6] = bf2f((u16)(v.w & 0xffff)); o[7] = bf2f((u16)(v.w >> 16));
}
DI void st_kt(u16* sKt, int c8, int row, uint4 k) {
  sKt[(c8 + 0) * 72 + row] = (u16)(k.x & 0xffff); sKt[(c8 + 1) * 72 + row] = (u16)(k.x >> 16);
  sKt[(c8 + 2) * 72 + row] = (u16)(k.y & 0xffff); sKt[(c8 + 3) * 72 + row] = (u16)(k.y >> 16);
  sKt[(c8 + 4) * 72 + row] = (u16)(k.z & 0xffff); sKt[(c8 + 5) * 72 + row] = (u16)(k.z >> 16);
  sKt[(c8 + 6) * 72 + row] = (u16)(k.w & 0xffff); sKt[(c8 + 7) * 72 + row] = (u16)(k.w >> 16);
}
DI uint2 pack4bf(const f32x4& v) { uint2 r; r.x = pk2(v[0], v[1]); r.y = pk2(v[2], v[3]); return r; }
DI void gdn_p2_item(const Params& P, int it, float* lds) {
  const int tid = TID(), lane = tid & 63, w = tid >> 6, r16 = lane & 15, quad = lane >> 4;
  const int es = it & 3, bh = it >> 2, b = bh >> 2, h = bh & 3;
  u16* sW = (u16*)lds;
  u16* sQ = sW + 64 * 72;
  u16* sAm = sQ + 64 * 72;
  u16* sKt = sAm + 64 * 72;
  u16* sSt = sKt + 64 * 72;
  u16* sVnT = sSt + 16 * 72;
  u16* sVdT = sVnT + 16 * 72;
  float* sG = (float*)(sVdT + 16 * 72);
  const u16* GQ = (const u16*)(WSP(P) + WS_GQ); const u16* GK = (const u16*)(WSP(P) + WS_GK);
  const u16* GU = (const u16*)(WSP(P) + WS_GU); const u16* GW = (const u16*)(WSP(P) + WS_GW);
  const u16* GA = (const u16*)(WSP(P) + WS_GA); const float* GG = (const float*)(WSP(P) + WS_GG);
  u16* ORAW = (u16*)(WSP(P) + WS_OM) + (long)2 * T_ * 256;
  f32x4 S = {0.f, 0.f, 0.f, 0.f};
  const int irow = 16 * w + 4 * quad;
  uint4 rw0, rw1, rq0, rq1, ra0, ra1, rk0, rk1; u16 ru0, ru1, ru2, ru3; float rg = 0.f;
  const int c0 = tid, c1 = tid + 256;
  const long off0 = (c0 >> 3) * 64 + (c0 & 7) * 8, off1 = (c1 >> 3) * 64 + (c1 & 7) * 8;
#define GDN_GLOAD(CH) { long ci_ = (long)bh * 64 + (CH); \
    rw0 = *(const uint4*)(GW + ci_ * 4096 + off0); rw1 = *(const uint4*)(GW + ci_ * 4096 + off1); \
    rq0 = *(const uint4*)(GQ + ci_ * 4096 + off0); rq1 = *(const uint4*)(GQ + ci_ * 4096 + off1); \
    ra0 = *(const uint4*)(GA + ci_ * 4096 + off0); ra1 = *(const uint4*)(GA + ci_ * 4096 + off1); \
    rk0 = *(const uint4*)(GK + ci_ * 4096 + off0); rk1 = *(const uint4*)(GK + ci_ * 4096 + off1); \
    const u16* up_ = GU + ci_ * 4096 + irow * 64 + es * 16 + r16; \
    ru0 = up_[0]; ru1 = up_[64]; ru2 = up_[128]; ru3 = up_[192]; \
    if (tid < 64) rg = GG[ci_ * 64 + tid]; }
  GDN_GLOAD(0)
  for (int ch = 0; ch < 64; ++ch) {
    __syncthreads();
    {
      const int row0 = c0 >> 3, c80 = (c0 & 7) * 8, row1 = c1 >> 3, c81 = (c1 & 7) * 8;
      *(uint4*)(sW + row0 * 72 + c80) = rw0; *(uint4*)(sW + row1 * 72 + c81) = rw1;
      *(uint4*)(sQ + row0 * 72 + c80) = rq0; *(uint4*)(sQ + row1 * 72 + c81) = rq1;
      *(uint4*)(sAm + row0 * 72 + c80) = ra0; *(uint4*)(sAm + row1 * 72 + c81) = ra1;
      *(uint4*)(sKt + row0 * 72 + c80) = rk0; *(uint4*)(sKt + row1 * 72 + c81) = rk1;
    }
    if (tid < 64) sG[tid] = rg;
    *(uint2*)(sSt + r16 * 72 + irow) = pack4bf(S);
    const f32x4 uc = {bf2f(ru0), bf2f(ru1), bf2f(ru2), bf2f(ru3)};
    __syncthreads();
    if (ch + 1 < 64) GDN_GLOAD(ch + 1)
    f32x4 ws = {0.f, 0.f, 0.f, 0.f}, qs = {0.f, 0.f, 0.f, 0.f};
#pragma unroll
    for (int ks = 0; ks < 2; ++ks) {
      const bf16x8 bS = *(const bf16x8*)(sSt + r16 * 72 + ks * 32 + quad * 8);
      const bf16x8 aW = *(const bf16x8*)(sW + (16 * w + r16) * 72 + ks * 32 + quad * 8);
      const bf16x8 aQ = *(const bf16x8*)(sQ + (16 * w + r16) * 72 + ks * 32 + quad * 8);
      ws = __builtin_amdgcn_mfma_f32_16x16x32_bf16(aW, bS, ws, 0, 0, 0);
      qs = __builtin_amdgcn_mfma_f32_16x16x32_bf16(aQ, bS, qs, 0, 0, 0);
    }
    const float Gl = sG[63];
    const f32x4 G4 = *(const f32x4*)(sG + irow);
    f32x4 vn, vd;
#pragma unroll
    for (int j = 0; j < 4; ++j) { vn[j] = uc[j] - ws[j]; vd[j] = vn[j] * __expf(Gl - G4[j]); }
    *(uint2*)(sVnT + r16 * 72 + irow) = pack4bf(vn);
    *(uint2*)(sVdT + r16 * 72 + irow) = pack4bf(vd);
    __syncthreads();
    f32x4 av = {0.f, 0.f, 0.f, 0.f}, kv = {0.f, 0.f, 0.f, 0.f};
#pragma unroll
    for (int ks = 0; ks < 2; ++ks) {
      const bf16x8 bVn = *(const bf16x8*)(sVnT + r16 * 72 + ks * 32 + quad * 8);
      const bf16x8 bVd = *(const bf16x8*)(sVdT + r16 * 72 + ks * 32 + quad * 8);
      const bf16x8 aA = *(const bf16x8*)(sAm + (16 * w + r16) * 72 + ks * 32 + quad * 8);
      const bf16x8 aK = *(const bf16x8*)(sKt + (16 * w + r16) * 72 + ks * 32 + quad * 8);
      av = __builtin_amdgcn_mfma_f32_16x16x32_bf16(aA, bVn, av, 0, 0, 0);
      kv = __builtin_amdgcn_mfma_f32_16x16x32_bf16(aK, bVd, kv, 0, 0, 0);
    }
    {
      u16* op = ORAW + ((long)(b * SEQ + ch * 64 + irow)) * 256 + h * 64 + es * 16 + r16;
#pragma unroll
      for (int j = 0; j < 4; ++j) op[j * 256] = f2bf(__expf(G4[j]) * qs[j] + av[j]);
    }
    const float gl = __expf(Gl);
#pragma unroll
    for (int j = 0; j < 4; ++j) S[j] = S[j] * gl + kv[j];
  }
#undef GDN_GLOAD
}
DI void gdn_post_item(const Params& P, int l, int it) {
  const int lane = TID() & 63, w = TID() >> 6;
  const u16* PROJ = (const u16*)(WSP(P) + WS_PROJ);
  u16* O = (u16*)(WSP(P) + WS_OM) + (long)2 * T_ * 256;
  const float wn = P.in[23][l * 64 + lane];
#pragma unroll 4
  for (int q = 0; q < 16; ++q) {
    long t = (long)it * 16 + w * 4 + (q >> 2); int h = q & 3;
    float o = bf2f(O[t * 256 + h * 64 + lane]);
    float ss = wave_sum(o * o);
    float y = o * rsqrtf(ss * (1.f / 64.f) + EPS) * wn;
    float z = bf2f(PROJ[t * PW + P_GZ + h * 64 + lane]);
    O[t * 256 + h * 64 + lane] = f2bf(y * siluf_(z));
  }
}

DI void kv_gload(uint4& k0, uint4& k1, uint4& v0, uint4& v1, const u16* ksrc, const u16* vsrc, long ld) {
  const int tid = TID(), r0 = tid >> 3, ch = tid & 7;
  k0 = *(const uint4*)(ksrc + (long)r0 * ld + ch * 8); k1 = *(const uint4*)(ksrc + (long)(r0 + 32) * ld + ch * 8);
  v0 = *(const uint4*)(vsrc + (long)r0 * ld + ch * 8); v1 = *(const uint4*)(vsrc + (long)(r0 + 32) * ld + ch * 8);
}
DI void k_gload(uint4& k0, uint4& k1, const u16* ksrc, long ld) {
  const int tid = TID(), r0 = tid >> 3, ch = tid & 7;
  k0 = *(const uint4*)(ksrc + (long)r0 * ld + ch * 8); k1 = *(const uint4*)(ksrc + (long)(r0 + 32) * ld + ch * 8);
}
DI void k_store(const uint4& k0, const uint4& k1, u16* sK) {
  const int tid = TID(), r0 = tid >> 3, ch = tid & 7;
  *(uint4*)(sK + r0 * 72 + ch * 8) = k0; *(uint4*)(sK + (r0 + 32) * 72 + ch * 8) = k1;
}
DI void kv_store(const uint4& k0, const uint4& k1, const uint4& v0, const uint4& v1, u16* sK, u16* sVt) {
  const int tid = TID(), r0 = tid >> 3, ch = tid & 7;
  *(uint4*)(sK + r0 * 72 + ch * 8) = k0; *(uint4*)(sK + (r0 + 32) * 72 + ch * 8) = k1;
  const int ksw = 16 * (ch >> 1);
  st_kt(sVt, ch * 8, r0 ^ ksw, v0); st_kt(sVt, ch * 8, (r0 + 32) ^ ksw, v1);
}
DI void sb_attn_item(const Params& P, int it, u16* sQ, u16* sK, u16* sVt) {
  const int tid = TID(), lane = tid & 63, w = tid >> 6, r16 = lane & 15, quad = lane >> 4;
  const int qb = 63 - (it >> 5), bh = it & 31, b = bh >> 2, h = bh & 3;
  const u16* PROJ = (const u16*)(WSP(P) + WS_PROJ);
  u16* OUT = (u16*)(WSP(P) + WS_OM) + (long)3 * T_ * 256;
  const long tb = (long)b * SEQ;
  load_tile(sQ, PROJ + (tb + qb * 64) * PW + P_SB + h * 64, PW);
  __syncthreads();
  bf16x8 bq[2]; load_qfrag(bq, sQ, w, lane);
  const int tq = qb * 64 + 16 * w + r16;
  f32x4 ot[4];
#pragma unroll
  for (int dt = 0; dt < 4; ++dt) ot[dt] = (f32x4){0.f, 0.f, 0.f, 0.f};
  float R = 0.f;
  uint4 pk0, pk1, pv0, pv1;
  kv_gload(pk0, pk1, pv0, pv1, PROJ + (tb + qb * 64) * PW + P_SB + 256 + h * 64, PROJ + (tb + qb * 64) * PW + P_SB + 512 + h * 64, PW);
  for (int kb = qb; kb >= 0; --kb) {
    if (__syncthreads_and(R < -104.f)) break;
    kv_store(pk0, pk1, pv0, pv1, sK, sVt);
    __syncthreads();
    if (kb > 0) kv_gload(pk0, pk1, pv0, pv1, PROJ + (tb + (kb - 1) * 64) * PW + P_SB + 256 + h * 64, PROJ + (tb + (kb - 1) * 64) * PW + P_SB + 512 + h * 64, PW);
    f32x4 st[4];
    st_mma(st, sK, bq, lane);
    float gs[4], zz[4][4], x[4][4];
#pragma unroll
    for (int mt = 0; mt < 4; ++mt) {
      float g = 0.f;
#pragma unroll
      for (int j = 0; j < 4; ++j) {
        int s = kb * 64 + 16 * mt + 4 * quad + j;
        float z = st[mt][j] * 0.125f;
        float sp = softplus_fast(z);
        bool mk = s < tq;
        x[mt][j] = mk ? -sp : 0.f;
        zz[mt][j] = mk ? (z - sp) : -1e30f;
        g += x[mt][j];
      }
      gs[mt] = g;
    }
    float hm = 0.f, tot_all = 0.f;
    f32x4 pw[4];
#pragma unroll
    for (int mt = 3; mt >= 0; --mt) {
      float g = gs[mt];
      float v1 = __shfl_down(g, 16), v2 = __shfl_down(g, 32), v3 = __shfl_down(g, 48);
      float hq = (quad < 3 ? v1 : 0.f) + (quad < 2 ? v2 : 0.f) + (quad < 1 ? v3 : 0.f);
      float tot = quad_sum(g);
      float base = R + hm + hq;
      float e3 = 0.f, e2 = x[mt][3], e1 = e2 + x[mt][2], e0 = e1 + x[mt][1];
      pw[mt][0] = __expf(zz[mt][0] + base + e0);
      pw[mt][1] = __expf(zz[mt][1] + base + e1);
      pw[mt][2] = __expf(zz[mt][2] + base + e2);
      pw[mt][3] = __expf(zz[mt][3] + base + e3);
      hm += tot; tot_all += tot;
    }
    R += tot_all;
    pv_mma(ot, sVt, pw, lane);
  }
  const long t = tb + tq;
#pragma unroll
  for (int dt = 0; dt < 4; ++dt) {
    uint2 ov; ov.x = pk2(ot[dt][0], ot[dt][1]); ov.y = pk2(ot[dt][2], ot[dt][3]);
    *(uint2*)(OUT + t * 256 + h * 64 + 16 * dt + 4 * quad) = ov;
  }
}

DI void win_attn_item(const Params& P, int it, u16* sQ, u16* sKunused, u16* sVunused) {
  const int tid = TID(), lane = tid & 63, w = tid >> 6, r16 = lane & 15, quad = lane >> 4;
  const int tbk = 127 - (it >> 3), b = it & 7;
  u16* sK = sQ + 128 * 72;
  u16* sVt = sK + 64 * 72;
  (void)sKunused; (void)sVunused;
  const u16* PROJ = (const u16*)(WSP(P) + WS_PROJ);
  const u16* QR = (const u16*)(WSP(P) + WS_QR);
  u16* OW = (u16*)(WSP(P) + WS_OW);
  const long tb = (long)b * SEQ;
  const int t0 = tbk * 32;
#pragma unroll
  for (int i = 0; i < 4; ++i) {
    const int c = tid + 256 * i, row = c >> 3, ch = c & 7;
    *(uint4*)(sQ + row * 72 + ch * 8) = *(const uint4*)(QR + (tb + t0 + (row & 31)) * 256 + (row >> 5) * 64 + ch * 8);
  }
  __syncthreads();
  bf16x8 bq[2][2];
  int tq[2];
#pragma unroll
  for (int qt = 0; qt < 2; ++qt) {
    const int rowq = 32 * w + 16 * qt + r16;
    bq[qt][0] = *(const bf16x8*)(sQ + rowq * 72 + quad * 8);
    bq[qt][1] = *(const bf16x8*)(sQ + rowq * 72 + 32 + quad * 8);
    tq[qt] = t0 + 16 * qt + r16;
  }
  f32x4 ot[2][4];
#pragma unroll
  for (int qt = 0; qt < 2; ++qt)
#pragma unroll
    for (int dt = 0; dt < 4; ++dt) ot[qt][dt] = (f32x4){0.f, 0.f, 0.f, 0.f};
  float m[2] = {-1e30f, -1e30f}, lsum[2] = {0.f, 0.f};
  const int lo = (t0 - 511) > 0 ? (t0 - 511) : 0;
  const int kb_lo = lo >> 6, kb_hi = (t0 + 31) >> 6;
  uint4 pk0, pk1, pv0, pv1;
  kv_gload(pk0, pk1, pv0, pv1, PROJ + (tb + kb_lo * 64) * PW + P_KV + 256, PROJ + (tb + kb_lo * 64) * PW + P_KV + 320, PW);
  for (int kb = kb_lo; kb <= kb_hi; ++kb) {
    __syncthreads();
    kv_store(pk0, pk1, pv0, pv1, sK, sVt);
    __syncthreads();
    if (kb < kb_hi) kv_gload(pk0, pk1, pv0, pv1, PROJ + (tb + (kb + 1) * 64) * PW + P_KV + 256, PROJ + (tb + (kb + 1) * 64) * PW + P_KV + 320, PW);
#pragma unroll
    for (int qt = 0; qt < 2; ++qt) {
      f32x4 st[4];
      st_mma(st, sK, bq[qt], lane);
      const int tqlo = t0 + 16 * qt;
      if (kb * 64 + 63 <= tqlo && tqlo + 15 - kb * 64 < 512) softmax_tile_full(st, m[qt], lsum[qt], ot[qt]);
      else {
        bool msk[4][4];
#pragma unroll
        for (int mt = 0; mt < 4; ++mt)
#pragma unroll
          for (int j = 0; j < 4; ++j) { int s = kb * 64 + 16 * mt + 4 * quad + j; int df = tq[qt] - s; msk[mt][j] = (df >= 0) && (df < 512); }
        softmax_tile(st, msk, m[qt], lsum[qt], ot[qt]);
      }
      pv_mma(ot[qt], sVt, st, lane);
    }
  }
#pragma unroll
  for (int qt = 0; qt < 2; ++qt) {
    const float ls = quad_sum(lsum[qt]);
    const float inv = 1.f / fmaxf(ls, 1e-30f);
    const long t = tb + tq[qt];
#pragma unroll
    for (int dt = 0; dt < 4; ++dt) {
      uint2 ov; ov.x = pk2(ot[qt][dt][0] * inv, ot[qt][dt][1] * inv); ov.y = pk2(ot[qt][dt][2] * inv, ot[qt][dt][3] * inv);
      *(uint2*)(OW + t * 256 + w * 64 + 16 * dt + 4 * quad) = ov;
    }
  }
}

DI void cmp_attn_item(const Params& P, int it, u16* sQ, u16* sK, u16* sVt, float* sImp) {
  const int tid = TID(), lane = tid & 63, w = tid >> 6, r16 = lane & 15, quad = lane >> 4;
  const int tbk = 255 - (it >> 3), b = it & 7;
  const u16* PROJ = (const u16*)(WSP(P) + WS_PROJ);
  const u16* KC = (const u16*)(WSP(P) + WS_KC) + (long)b * 256 * 64;
  const u16* VC = (const u16*)(WSP(P) + WS_VC) + (long)b * 256 * 64;
  u16* OC = (u16*)(WSP(P) + WS_OC);
  u64* SEL = (u64*)(WSP(P) + WS_SEL);
  const long tb = (long)b * SEQ;
  const int t0 = tbk * 16;
  load_q_nsa(sQ, PROJ + (tb + t0) * PW + P_Q, PW);
  for (int e = tid; e < 4 * 16 * 64; e += 256) sImp[e] = 0.f;
  __syncthreads();
  bf16x8 bq[2]; load_qfrag(bq, sQ, w, lane);
  const int tq = t0 + r16;
  const int nv = (tq >= 31) ? ((tq - 31) >> 4) + 1 : 0;
  const int nvmax = (t0 + 15 >= 31) ? ((t0 + 15 - 31) >> 4) + 1 : 0;
  const int ntile = (nvmax + 63) >> 6;
  float m = -1e30f, lsum = 0.f;
  uint4 pk0, pk1, pv0, pv1;
  if (ntile > 0) k_gload(pk0, pk1, KC, 64);
  for (int kt = 0; kt < ntile; ++kt) {
    __syncthreads();
    k_store(pk0, pk1, sK);
    __syncthreads();
    if (kt + 1 < ntile) k_gload(pk0, pk1, KC + (kt + 1) * 64 * 64, 64);
    f32x4 st[4];
    st_mma(st, sK, bq, lane);
    float tm = -1e30f;
#pragma unroll
    for (int mt = 0; mt < 4; ++mt)
#pragma unroll
      for (int j = 0; j < 4; ++j) { int n = kt * 64 + 16 * mt + 4 * quad + j; float s = st[mt][j] * 0.125f; st[mt][j] = s; if (n < nv) tm = fmaxf(tm, s); }
    tm = quad_max(tm);
    float mn = fmaxf(m, tm);
    float ps = 0.f;
#pragma unroll
    for (int mt = 0; mt < 4; ++mt)
#pragma unroll
      for (int j = 0; j < 4; ++j) { int n = kt * 64 + 16 * mt + 4 * quad + j; if (n < nv) ps += __expf(st[mt][j] - mn); }
    lsum = lsum * __expf(m - mn) + ps;
    m = mn;
  }
  lsum = quad_sum(lsum);
  const float inv = (lsum > 0.f) ? 1.f / lsum : 0.f;
  f32x4 ot[4];
#pragma unroll
  for (int dt = 0; dt < 4; ++dt) ot[dt] = (f32x4){0.f, 0.f, 0.f, 0.f};
  float carry = 0.f;
  if (ntile > 0) kv_gload(pk0, pk1, pv0, pv1, KC, VC, 64);
  for (int kt = 0; kt < ntile; ++kt) {
    __syncthreads();
    kv_store(pk0, pk1, pv0, pv1, sK, sVt);
    __syncthreads();
    if (kt + 1 < ntile) kv_gload(pk0, pk1, pv0, pv1, KC + (kt + 1) * 64 * 64, VC + (kt + 1) * 64 * 64, 64);
    f32x4 st[4];
    st_mma(st, sK, bq, lane);
#pragma unroll
    for (int mt = 0; mt < 4; ++mt)
#pragma unroll
      for (int j = 0; j < 4; ++j) { int n = kt * 64 + 16 * mt + 4 * quad + j; st[mt][j] = (n < nv) ? __expf(st[mt][j] * 0.125f - m) * inv : 0.f; }
    pv_mma(ot, sVt, st, lane);
    float prevlast = carry;
#pragma unroll
    for (int mt = 0; mt < 4; ++mt) {
      float pl = st[mt][3];
      float fd = __shfl_up(pl, 16);
      float pprev = (quad > 0) ? fd : prevlast;
      float v = st[mt][0] + st[mt][1] + st[mt][2] + st[mt][3] + pprev;
      sImp[(w * 16 + r16) * 64 + kt * 16 + mt * 4 + quad] = v;
      prevlast = __shfl_down(pl, 48);
    }
    carry = prevlast;
  }
  {
    const long t = tb + tq;
#pragma unroll
    for (int dt = 0; dt < 4; ++dt) {
      uint2 ov; ov.x = pk2(ot[dt][0], ot[dt][1]); ov.y = pk2(ot[dt][2], ot[dt][3]);
      *(uint2*)(OC + t * 256 + w * 64 + 16 * dt + 4 * quad) = ov;
    }
  }
  __syncthreads();
  for (int q = 0; q < 4; ++q) {
    const int tok = 4 * w + q, t = t0 + tok;
    float v = sImp[(0 * 16 + tok) * 64 + lane] + sImp[(1 * 16 + tok) * 64 + lane] + sImp[(2 * 16 + tok) * 64 + lane] + sImp[(3 * 16 + tok) * 64 + lane];
    const int cur = t >> 6;
    if (lane == 0 || lane == cur) v = 1e9f;
    else if (lane * 64 > t) v = -1e30f;
    int cnt = 0;
#pragma unroll
    for (int i2 = 0; i2 < 64; ++i2) {
      float vi = __builtin_bit_cast(float, __builtin_amdgcn_readlane(__builtin_bit_cast(int, v), i2));
      cnt += (vi > v || (vi == v && i2 < lane)) ? 1 : 0;
    }
    u64 mask = __ballot(cnt < 16);
    if (lane == 0) SEL[tb + t] = mask;
  }
}

DI void sel_attn_item(const Params& P, int it, u16* sQ, u16* sKunused, u16* sVunused) {
  const int tid = TID(), lane = tid & 63, w = tid >> 6, r16 = lane & 15, quad = lane >> 4;
  const int tbk = 127 - (it >> 3), b = it & 7;
  u16* sK = sQ + 128 * 72;
  u16* sVt = sK + 64 * 72;
  (void)sKunused; (void)sVunused;
  const u16* PROJ = (const u16*)(WSP(P) + WS_PROJ);
  const u16* QR = (const u16*)(WSP(P) + WS_QR);
  const u16* OC = (const u16*)(WSP(P) + WS_OC);
  const u16* OW = (const u16*)(WSP(P) + WS_OW);
  const u64* SEL = (const u64*)(WSP(P) + WS_SEL);
  u16* OUT = (u16*)(WSP(P) + WS_OM);
  const long tb = (long)b * SEQ;
  const int t0 = tbk * 32;
#pragma unroll
  for (int i = 0; i < 4; ++i) {
    const int c = tid + 256 * i, row = c >> 3, ch = c & 7;
    *(uint4*)(sQ + row * 72 + ch * 8) = *(const uint4*)(QR + (tb + t0 + (row & 31)) * 256 + (row >> 5) * 64 + ch * 8);
  }
  __syncthreads();
  bf16x8 bq[2][2];
  int tq[2]; u64 mysel[2];
#pragma unroll
  for (int qt = 0; qt < 2; ++qt) {
    const int rowq = 32 * w + 16 * qt + r16;
    bq[qt][0] = *(const bf16x8*)(sQ + rowq * 72 + quad * 8);
    bq[qt][1] = *(const bf16x8*)(sQ + rowq * 72 + 32 + quad * 8);
    tq[qt] = t0 + 16 * qt + r16;
    mysel[qt] = SEL[tb + tq[qt]];
  }
  u64 uni = 0;
#pragma unroll
  for (int q = 0; q < 32; ++q) uni |= SEL[tb + t0 + q];
  const int cur = t0 >> 6;
  uni &= (cur == 63) ? ~0ull : ((1ull << (cur + 1)) - 1ull);
  f32x4 ot[2][4];
#pragma unroll
  for (int qt = 0; qt < 2; ++qt)
#pragma unroll
    for (int dt = 0; dt < 4; ++dt) ot[qt][dt] = (f32x4){0.f, 0.f, 0.f, 0.f};
  float m[2] = {-1e30f, -1e30f}, lsum[2] = {0.f, 0.f};
  uint4 pk0, pk1, pv0, pv1;
  int kb = uni ? (__ffsll((long long)uni) - 1) : -1;
  uni &= uni - 1;
  if (kb >= 0) kv_gload(pk0, pk1, pv0, pv1, PROJ + (tb + kb * 64) * PW + P_KV + 128, PROJ + (tb + kb * 64) * PW + P_KV + 192, PW);
  for (int nkb = -1; kb >= 0; kb = nkb) {
    __syncthreads();
    kv_store(pk0, pk1, pv0, pv1, sK, sVt);
    __syncthreads();
    nkb = uni ? (__ffsll((long long)uni) - 1) : -1;
    uni &= uni - 1;
    if (nkb >= 0) kv_gload(pk0, pk1, pv0, pv1, PROJ + (tb + nkb * 64) * PW + P_KV + 128, PROJ + (tb + nkb * 64) * PW + P_KV + 192, PW);
#pragma unroll
    for (int qt = 0; qt < 2; ++qt) {
      f32x4 st[4];
      st_mma(st, sK, bq[qt], lane);
      const bool selq = (mysel[qt] >> kb) & 1ull;
      if (__ballot(selq) == ~0ull && kb * 64 + 63 <= t0 + 16 * qt) softmax_tile_full(st, m[qt], lsum[qt], ot[qt]);
      else {
        bool msk[4][4];
#pragma unroll
        for (int mt = 0; mt < 4; ++mt)
#pragma unroll
          for (int j = 0; j < 4; ++j) { int s = kb * 64 + 16 * mt + 4 * quad + j; msk[mt][j] = selq && (s <= tq[qt]); }
        softmax_tile(st, msk, m[qt], lsum[qt], ot[qt]);
      }
      pv_mma(ot[qt], sVt, st, lane);
    }
  }
#pragma unroll
  for (int qt = 0; qt < 2; ++qt) {
    const float ls = quad_sum(lsum[qt]);
    const float inv = 1.f / fmaxf(ls, 1e-30f);
    const long t = tb + tq[qt];
    const float gc = sigmoidf_(bf2f(PROJ[t * PW + P_NG + w * 3 + 0]));
    const float gsl = sigmoidf_(bf2f(PROJ[t * PW + P_NG + w * 3 + 1]));
    const float gw = sigmoidf_(bf2f(PROJ[t * PW + P_NG + w * 3 + 2]));
#pragma unroll
    for (int dt = 0; dt < 4; ++dt) {
      const long o = t * 256 + w * 64 + 16 * dt + 4 * quad;
      uint2 c = *(const uint2*)(OC + o), ww = *(const uint2*)(OW + o);
      float r0 = gc * bf2f((u16)(c.x & 0xffff)) + gsl * ot[qt][dt][0] * inv + gw * bf2f((u16)(ww.x & 0xffff));
      float r1 = gc * bf2f((u16)(c.x >> 16)) + gsl * ot[qt][dt][1] * inv + gw * bf2f((u16)(ww.x >> 16));
      float r2 = gc * bf2f((u16)(c.y & 0xffff)) + gsl * ot[qt][dt][2] * inv + gw * bf2f((u16)(ww.y & 0xffff));
      float r3 = gc * bf2f((u16)(c.y >> 16)) + gsl * ot[qt][dt][3] * inv + gw * bf2f((u16)(ww.y >> 16));
      uint2 ov; ov.x = pk2(r0, r1); ov.y = pk2(r2, r3);
      *(uint2*)(OUT + o) = ov;
    }
  }
}

DI void inproj_tile(const Params& P, int l, int it, u16* sA, u16* sB) {
  const int tid = TID(), lane = tid & 63, w = tid >> 6, r16 = lane & 15, quad = lane >> 4, wm = w >> 1, wn = w & 1;
  int mt, nt; tile_from_q(it, 22, mt, nt);
  const u16* H = (const u16*)(WSP(P) + WS_H);
  u16* PROJ = (u16*)(WSP(P) + WS_PROJ);
  const u16* Ab = H + (long)mt * 128 * DM;
  const u16* Bb = (const u16*)(WSP(P) + WS_W + WT_IN) + (long)nt * 128 * DM;
  f32x4 acc[4][4];
  gemm3<4>(acc, g3_ptr(Ab, DM, tid, 0, false), g3_ptr(Ab, DM, tid, 1, false), nullptr, nullptr, 64,
           g3_ptr(Bb, DM, tid, 0, false), g3_ptr(Bb, DM, tid, 1, false), nullptr, nullptr, DM, sA, 16L * DM, 16L * DM);
  __syncthreads();
#pragma unroll
  for (int mi = 0; mi < 4; ++mi)
#pragma unroll
    for (int ni = 0; ni < 4; ++ni)
#pragma unroll
      for (int j = 0; j < 4; ++j) sA[(wm * 64 + 16 * mi + 4 * quad + j) * 136 + wn * 64 + 16 * ni + r16] = f2bf(acc[mi][ni][j]);
  __syncthreads();
  store_tile_bf16<128>(sA, PROJ + (long)mt * 128 * PW + nt * 128, PW, 128);
}
DI void glu_tile(const Params& P, int l, int it, u16* sA, u16* sB) {
  const int tid = TID(), lane = tid & 63, w = tid >> 6, r16 = lane & 15, quad = lane >> 4, wm = w >> 1, wn = w & 1;
  const int mt = it >> 2, nt = it & 3;
  const u16* Y5 = (const u16*)(WSP(P) + WS_Y5);
  u16* OUT = (u16*)(WSP(P) + WS_OM) + (long)1 * T_ * 256;
  const u16* Ab = Y5 + (long)mt * 128 * 256;
  const u16* Bb = (const u16*)(WSP(P) + WS_W + WT_GLU) + (long)nt * 128 * 256;
  f32x4 acc[4][4];
  gemm3<4>(acc, g3_ptr(Ab, 256, tid, 0, false), g3_ptr(Ab, 256, tid, 1, false), nullptr, nullptr, 64,
           g3_ptr(Bb, 256, tid, 0, false), g3_ptr(Bb, 256, tid, 1, false), nullptr, nullptr, 256, sA, 16L * 256, 16L * 256);
  __syncthreads();
#pragma unroll
  for (int mi = 0; mi < 4; ++mi)
#pragma unroll
    for (int ni = 0; ni < 2; ++ni)
#pragma unroll
      for (int j = 0; j < 4; ++j)
        sA[(wm * 64 + 16 * mi + 4 * quad + j) * 72 + wn * 32 + 16 * ni + r16] = f2bf(acc[mi][ni][j] * sigmoidf_(acc[mi][ni + 2][j]));
  __syncthreads();
  store_tile_bf16<64>(sA, OUT + (long)mt * 128 * 256 + nt * 64, 256, 128);
}
DI void merge_tile(const Params& P, int l, int it, u16* sA, u16* sB) {
  const int tid = TID(), lane = tid & 63, w = tid >> 6, r16 = lane & 15, quad = lane >> 4, wm = w >> 1, wn = w & 1;
  int mt, nt; tile_from_q(it, 8, mt, nt);
  const u16* H = (const u16*)(WSP(P) + WS_H);
  const u16* OM = (const u16*)(WSP(P) + WS_OM);
  u16* MERGED = (u16*)(WSP(P) + WS_MERGED);
  uint2 outp[4][4];
#pragma unroll
  for (int mi = 0; mi < 4; ++mi)
#pragma unroll
    for (int ni = 0; ni < 4; ++ni) outp[mi][ni] = make_uint2(0u, 0u);
#pragma unroll 1
  for (int m = 0; m < 4; ++m) {
    uint2 gp[4][4];
    {
      f32x4 ag[4][4];
      const u16* Ab = H + (long)mt * 128 * DM;
      const u16* Bb = (const u16*)(WSP(P) + WS_W + WT_G) + ((long)(m * 1024 + nt * 128)) * DM;
      gemm3<4, true>(ag, g3_ptr(Ab, DM, tid, 0, false), g3_ptr(Ab, DM, tid, 1, false), nullptr, nullptr, 64,
               g3_ptr(Bb, DM, tid, 0, false), g3_ptr(Bb, DM, tid, 1, false), nullptr, nullptr, DM, sA, 16L * DM, 16L * DM);
#pragma unroll
      for (int mi = 0; mi < 4; ++mi)
#pragma unroll
        for (int ni = 0; ni < 4; ++ni) {
          gp[mi][ni].x = pk2(sigmoidf_(ag[mi][ni][0]), sigmoidf_(ag[mi][ni][1]));
          gp[mi][ni].y = pk2(sigmoidf_(ag[mi][ni][2]), sigmoidf_(ag[mi][ni][3]));
        }
    }
    {
      f32x4 av[4][4];
      const u16* Ab = OM + ((long)m * T_ + (long)mt * 128) * 256;
      const u16* Bb = (const u16*)(WSP(P) + WS_W + WT_BR) + ((long)(m * 1024 + nt * 128)) * 256;
      gemm3<4, true>(av, g3_ptr(Ab, 256, tid, 0, false), g3_ptr(Ab, 256, tid, 1, false), nullptr, nullptr, 64,
               g3_ptr(Bb, 256, tid, 0, false), g3_ptr(Bb, 256, tid, 1, false), nullptr, nullptr, 256, sA, 16L * 256, 16L * 256);
#pragma unroll
      for (int mi = 0; mi < 4; ++mi)
#pragma unroll
        for (int ni = 0; ni < 4; ++ni) {
          const float o0 = bf2f((u16)(outp[mi][ni].x & 0xffff)) + av[mi][ni][0] * bf2f((u16)(gp[mi][ni].x & 0xffff));
          const float o1 = bf2f((u16)(outp[mi][ni].x >> 16)) + av[mi][ni][1] * bf2f((u16)(gp[mi][ni].x >> 16));
          const float o2 = bf2f((u16)(outp[mi][ni].y & 0xffff)) + av[mi][ni][2] * bf2f((u16)(gp[mi][ni].y & 0xffff));
          const float o3 = bf2f((u16)(outp[mi][ni].y >> 16)) + av[mi][ni][3] * bf2f((u16)(gp[mi][ni].y >> 16));
          outp[mi][ni].x = pk2(o0, o1); outp[mi][ni].y = pk2(o2, o3);
        }
    }
  }
  __syncthreads();
#pragma unroll
  for (int mi = 0; mi < 4; ++mi)
#pragma unroll
    for (int ni = 0; ni < 4; ++ni)
#pragma unroll
      for (int j = 0; j < 4; ++j) {
        const unsigned wv = (j < 2) ? outp[mi][ni].x : outp[mi][ni].y;
        sA[(wm * 64 + 16 * mi + 4 * quad + j) * 136 + wn * 64 + 16 * ni + r16] = (u16)((j & 1) ? (wv >> 16) : (wv & 0xffff));
      }
  __syncthreads();
  store_tile_bf16<128>(sA, MERGED + (long)mt * 128 * DM + nt * 128, DM, 128);
}
DI void resid_tile(const u16* A, int K, const u16* Bt, const float* resid, float* out, int it, u16* sA, u16* sB) {
  const int tid = TID(), lane = tid & 63, w = tid >> 6, r16 = lane & 15, quad = lane >> 4, wm = w >> 1, wn = w & 1;
  int mt, nt; tile_from_q(it, 8, mt, nt);
  const u16* Ab = A + (long)mt * 128 * K;
  const u16* Bb = Bt + (long)nt * 128 * K;
  f32x4 acc[4][4];
  gemm3<4>(acc, g3_ptr(Ab, K, tid, 0, false), g3_ptr(Ab, K, tid, 1, false), nullptr, nullptr, 64,
           g3_ptr(Bb, K, tid, 0, false), g3_ptr(Bb, K, tid, 1, false), nullptr, nullptr, K, sA, 16L * K, 16L * K);
  float* sC = (float*)sA + w * (32 * 68);
#pragma unroll
  for (int hp = 0; hp < 2; ++hp) {
    __syncthreads();
#pragma unroll
    for (int mi2 = 0; mi2 < 2; ++mi2)
#pragma unroll
      for (int ni = 0; ni < 4; ++ni)
#pragma unroll
        for (int j = 0; j < 4; ++j) sC[(16 * mi2 + 4 * quad + j) * 68 + 16 * ni + r16] = acc[2 * hp + mi2][ni][j];
    __syncthreads();
#pragma unroll
    for (int q = 0; q < 8; ++q) {
      const int c = lane + 64 * q, row = c >> 4, c4 = (c & 15) * 4;
      const long o = ((long)mt * 128 + wm * 64 + 32 * hp + row) * DM + nt * 128 + wn * 64 + c4;
      const float4 rv = *(const float4*)(resid + o);
      const f32x4 cv = *(const f32x4*)(sC + row * 68 + c4);
      *(float4*)(out + o) = make_float4(rv.x + cv[0], rv.y + cv[1], rv.z + cv[2], rv.w + cv[3]);
    }
  }
}
DI void ffn1_tile(const Params& P, int l, int it, u16* sA, u16* sB) {
  const int tid = TID(), lane = tid & 63, w = tid >> 6, r16 = lane & 15, quad = lane >> 4, wm = w >> 1, wn = w & 1;
  int mt, nt; tile_from_q(it, 44, mt, nt);
  const u16* H = (const u16*)(WSP(P) + WS_H);
  u16* ACT = (u16*)(WSP(P) + WS_PROJ);
  const u16* Ab = H + (long)mt * 128 * DM;
  const u16* Bb = (const u16*)(WSP(P) + WS_W + WT_GU) + (long)nt * 128 * DM;
  f32x4 acc[4][4];
  gemm3<4>(acc, g3_ptr(Ab, DM, tid, 0, false), g3_ptr(Ab, DM, tid, 1, false), nullptr, nullptr, 64,
           g3_ptr(Bb, DM, tid, 0, false), g3_ptr(Bb, DM, tid, 1, false), nullptr, nullptr, DM, sA, 16L * DM, 16L * DM);
  __syncthreads();
#pragma unroll
  for (int mi = 0; mi < 4; ++mi)
#pragma unroll
    for (int ni = 0; ni < 2; ++ni)
#pragma unroll
      for (int j = 0; j < 4; ++j)
        sA[(wm * 64 + 16 * mi + 4 * quad + j) * 72 + wn * 32 + 16 * ni + r16] = f2bf(siluf_(acc[mi][ni][j]) * acc[mi][ni + 2][j]);
  __syncthreads();
  store_tile_bf16<64>(sA, ACT + (long)mt * 128 * DFF + nt * 64, DFF, 128);
}

__global__ void __launch_bounds__(256, LB2) fwd_megakernel(Params P) {
  cg::grid_group grid = cg::this_grid();
  __shared__ __attribute__((aligned(16))) float lds[17920];
  __shared__ int s_item;
  unsigned* cnt = (unsigned*)(WSP(P) + WS_CNT);
  const int xcd = (int)(__builtin_amdgcn_s_getreg((3 << 11) | 20) & 0xF) & 7;
  __shared__ int s_rank;
  if (threadIdx.x == 0) s_rank = (int)atomicAdd(cnt + 900 + xcd, 1u);
  __syncthreads();
  const int xrank = s_rank;
  u16* sA = (u16*)lds;
  u16* sB = sA + 128 * 80;
  u16* aQ = (u16*)lds;
  u16* aK = aQ + 64 * 72;
  u16* aV = aK + 64 * 72;
  float* aImp = (float*)(aV + 64 * 72);
  for (int ph = P.ph_lo; ph < P.ph_hi; ++ph) {
    const int l = ph / 11, sp = ph % 11;
    const float* xin = (l == 0) ? P.in[0] : P.out;
    const int nrep = (PROBE_DUP != 0 && l == 0 && ((PROBE_DUP >> sp) & 1)) ? 2 : 1;
    for (int rep = 0; rep < nrep; ++rep) {
    unsigned* pc = cnt + (ph + 32 * rep) * 8;
    switch (sp) {
      case 0: if (PHASE_MASK & (1 << 0)) {
        phase_rmsnorm(xin, P.in[2] + l * DM, (u16*)(WSP(P) + WS_H));
        phase_convert(P, l, lds);
        if (l == 0) phase_rope_table((const int*)P.in[1], (float*)(WSP(P) + WS_COS), (float*)(WSP(P) + WS_SIN));
      } break;
      case 1: if (PHASE_MASK & (1 << 1)) {
        XCD_STATIC_LOOP(32 * 22, inproj_tile(P, l, it, sA, sB))
      } break;
      case 2: if (PHASE_MASK & (1 << 2)) {
        for (;;) {
          int it = next_item(pc, &s_item); if (it >= 64 + 3 * 2048) break;
          if (it < 64) cmp1_tile(P, l, it, sA, sB);
          else if (it < 64 + 2048) gdn_p1_item(P, l, it - 64, lds);
          else if (it < 64 + 4096) s5_pass1_item(P, l, it - 64 - 2048, lds);
          else nsa_prep_item(P, l, it - 64 - 4096);
        }
      } break;
      case 3: if (PHASE_MASK & (1 << 3)) {
        for (;;) {
          int it = next_item(pc, &s_item); if (it >= 128 + 3072 + 64) break;
          if (it < 128) gdn_p2_item(P, it, lds);
          else if (it < 128 + 2048) sb_attn_item(P, it - 128, aQ, aK, aV);
          else if (it < 128 + 3072) win_attn_item(P, it - 128 - 2048, aQ, aK, aV);
          else if (it < 128 + 3072 + 32) s5_carry_item(P, l, it - 128 - 3072);
          else cmp2_tile(P, l, it - 128 - 3072 - 32, sA, sB, lds + 17000);
        }
      } break;
      case 4: if (PHASE_MASK & (1 << 4)) {
        for (;;) {
          int it = next_item(pc, &s_item); if (it >= 3 * 2048) break;
          if (it < 2048) cmp_attn_item(P, it, aQ, aK, aV, aImp);
          else if (it < 4096) s5_pass2_item(P, l, it - 2048, lds);
          else gdn_post_item(P, l, it - 4096);
        }
      } break;
      case 5: if (PHASE_MASK & (1 << 5)) {
        for (;;) {
          int it = next_item(pc, &s_item); if (it >= 1024 + 1024) break;
          if (it < 1024) sel_attn_item(P, it, aQ, aK, aV);
          else glu_tile(P, l, it - 1024, sA, sB);
        }
      } break;
      case 6: if (PHASE_MASK & (1 << 6)) {
        XCD_STATIC_LOOP(32 * 8, merge_tile(P, l, it, sA, sB))
      } break;
      case 7: if (PHASE_MASK & (1 << 7)) {
        XCD_STATIC_LOOP(32 * 8, resid_tile((const u16*)(WSP(P) + WS_MERGED), DM, (const u16*)(WSP(P) + WS_W + WT_OUT), xin, P.out, it, sA, sB))
      } break;
      case 8: if (PHASE_MASK & (1 << 8)) {
        phase_rmsnorm(P.out, P.in[26] + l * DM, (u16*)(WSP(P) + WS_H));
      } break;
      case 9: if (PHASE_MASK & (1 << 9)) {
        XCD_STATIC_LOOP(32 * 44, ffn1_tile(P, l, it, sA, sB))
      } break;
      case 10: if (PHASE_MASK & (1 << 10)) {
        XCD_STATIC_LOOP(32 * 8, resid_tile((const u16*)(WSP(P) + WS_PROJ), DFF, (const u16*)(WSP(P) + WS_W + WT_D), P.out, P.out, it, sA, sB))
      } break;
    }
    if (rep + 1 < nrep) grid.sync();
    }
    if (ph + 1 < P.ph_hi) grid.sync();
  }
}

extern "C" void kernel_launch(void* const* d_in, const int* in_sizes, int n_in, void* d_out, int out_size, void* d_ws, size_t ws_size,
                              hipStream_t stream) {
  static int grid_blocks = 0;
  if (!grid_blocks) {
    int dev = 0, cus = 0, per_cu = 0;
    hipGetDevice(&dev);
    hipDeviceGetAttribute(&cus, hipDeviceAttributeMultiprocessorCount, dev);
    hipOccupancyMaxActiveBlocksPerMultiprocessor(&per_cu, fwd_megakernel, 256, 0);
    if (per_cu < 1) per_cu = 1;
    if (per_cu > 2) per_cu = 2;
    grid_blocks = cus * per_cu;
    if (ws_size < WS_W + WT_END) fprintf(stderr, "kernel_launch: workspace too small: %zu\n", ws_size);
  }
  hipMemsetAsync((char*)d_ws + WS_CNT, 0, 4096, stream);
  Params p{};
  for (int i = 0; i < 30; ++i) p.in[i] = (const float*)d_in[i];
  p.out = (float*)d_out;
  p.ws = (unsigned char*)d_ws;
  p.ph_lo = 0; p.ph_hi = NPHASE;
  void* args[] = {&p};
  hipError_t e = hipLaunchCooperativeKernel((void*)fwd_megakernel, dim3(grid_blocks), dim3(256), args, 0, stream);
  if (e != hipSuccess) fprintf(stderr, "cooperative launch failed: %s (grid %d)\n", hipGetErrorString(e), grid_blocks);
}
```

```cpp
#include <hip/hip_runtime.h>
#include <hip/hip_cooperative_groups.h>
#include <cstdio>
namespace cg = cooperative_groups;

typedef unsigned short u16;
typedef unsigned long long u64;
typedef __attribute__((ext_vector_type(8))) short bf16x8;
typedef __attribute__((ext_vector_type(4))) short s16x4;
typedef __attribute__((ext_vector_type(4))) float f32x4;
#define DI __device__ __forceinline__

constexpr int NB = 8, SEQ = 4096, T_ = NB * SEQ, DM = 1024, DIN = 6804, PW = 2816, DFF = 2816;
constexpr int P_Q = 0, P_KV = 256, P_S5U = 640, P_GQKV = 896, P_GZ = 1664, P_SB = 1920, P_NG = 2688, P_GA = 2700, P_GB = 2704;
constexpr float EPS = 1e-6f;
constexpr size_t MiB = 1024ull * 1024ull;
constexpr size_t WS_H = 0, WS_PROJ = 64 * MiB, WS_OM = 240 * MiB, WS_MERGED = 304 * MiB,
                 WS_GQ = 304 * MiB, WS_GK = 320 * MiB, WS_GU = 336 * MiB, WS_GW = 352 * MiB, WS_GA = 368 * MiB,
                 WS_QR = 384 * MiB, WS_OC = 400 * MiB, WS_OW = 416 * MiB, WS_Y5 = 432 * MiB,
                 WS_GG = 448 * MiB, WS_SEL = 449 * MiB, WS_COS = 450 * MiB, WS_SIN = 451 * MiB,
                 WS_ENDS = 452 * MiB, WS_CARRY = 456 * MiB, WS_KC = 460 * MiB, WS_VC = 461 * MiB, WS_HID = 462 * MiB,
                 WS_CNT = 464 * MiB, WS_W = 465 * MiB, WS_CBIAS = 449 * MiB + 512 * 1024;
constexpr size_t WT_IN = 0, WT_G = WT_IN + 2816ull * 1024 * 2, WT_BR = WT_G + 4096ull * 1024 * 2, WT_OUT = WT_BR + 4096ull * 256 * 2,
                 WT_GU = WT_OUT + 1024ull * 1024 * 2, WT_D = WT_GU + 5632ull * 1024 * 2, WT_GLU = WT_D + 1024ull * 2816 * 2,
                 WT_C1 = WT_GLU + 512ull * 256 * 2, WT_C2 = WT_C1 + 512ull * 2048 * 2, WT_END = WT_C2 + 128ull * 256 * 2;
constexpr int NPHASE = 22;
#define XCD_STATIC_LOOP(NPER, BODY) { \
    unsigned c0_ = cnt[900], c1_ = cnt[901], c2_ = cnt[902], c3_ = cnt[903], c4_ = cnt[904], c5_ = cnt[905], c6_ = cnt[906], c7_ = cnt[907]; \
    const bool ok_ = c0_ && c1_ && c2_ && c3_ && c4_ && c5_ && c6_ && c7_; \
    const unsigned mine_ = xcd == 0 ? c0_ : xcd == 1 ? c1_ : xcd == 2 ? c2_ : xcd == 3 ? c3_ : xcd == 4 ? c4_ : xcd == 5 ? c5_ : xcd == 6 ? c6_ : c7_; \
    const int start_ = ok_ ? xcd * (NPER) + xrank : (int)blockIdx.x, end_ = ok_ ? (xcd + 1) * (NPER) : 8 * (NPER), step_ = ok_ ? (int)mine_ : (int)gridDim.x; \
    for (int it = start_; it < end_; it += step_) { BODY; } }
#ifndef PROBE_DUP
#define PROBE_DUP 0
#endif
#ifndef LB2
#define LB2 2
#endif
#ifndef PHASE_MASK
#define PHASE_MASK 0x7ff
#endif

struct Params {
  const float* in[30];
  float* out;
  unsigned char* ws;
  int ph_lo, ph_hi;
};


DI int TID() { int t = threadIdx.x; asm volatile("" : "+v"(t)); return t; }
DI unsigned char* WSP(const Params& P) { size_t z = 0; asm volatile("" : "+s"(z)); return P.ws + z; }
typedef __bf16 bf16x2_t __attribute__((ext_vector_type(2)));
typedef float f32x2_t __attribute__((ext_vector_type(2)));
DI u16 f2bf(float x) { __bf16 r = (__bf16)x; return __builtin_bit_cast(u16, r); }
DI float bf2f(u16 h) { return __uint_as_float(((unsigned)h) << 16); }
DI unsigned pk2(float a, float b) { f32x2_t v = {a, b}; bf16x2_t r = __builtin_convertvector(v, bf16x2_t); return __builtin_bit_cast(unsigned, r); }
DI float wave_sum(float v) {
#pragma unroll
  for (int o = 1; o < 64; o <<= 1) v += __shfl_xor(v, o);
  return v;
}
DI float sigmoidf_(float x) { return __builtin_amdgcn_rcpf(1.f + __expf(-x)); }
DI float siluf_(float x) { return x * sigmoidf_(x); }
DI float softplusf_(float x) { return fmaxf(x, 0.f) + log1pf(__expf(-fabsf(x))); }
DI float softplus_fast(float x) { return fmaxf(x, 0.f) + __logf(1.f + __expf(-fabsf(x))); }
DI float gelu_tanh(float x) {
  float u = 0.7978845608028654f * (x + 0.044715f * x * x * x);
  float t = 1.f - 2.f * __builtin_amdgcn_rcpf(__expf(2.f * u) + 1.f);
  return 0.5f * x * (1.f + t);
}
DI void sincos_d(double x, double& s, double& c) {
  const double TWO_PI = 6.283185307179586476925287, INV = 0.15915494309189533576888;
  double n = rint(x * INV);
  double r = x - n * TWO_PI;
  double r2 = r * r, term = 1.0, cs = 1.0, ss = 1.0;
#pragma unroll
  for (int k = 1; k <= 14; ++k) { term *= r2 * (-1.0 / (double)((2 * k - 1) * (2 * k))); cs += term; }
  term = 1.0;
#pragma unroll
  for (int k = 1; k <= 14; ++k) { term *= r2 * (-1.0 / (double)((2 * k) * (2 * k + 1))); ss += term; }
  s = r * ss; c = cs;
}
DI int next_item(unsigned* cnt, int* s_item) {
  __syncthreads();
  if (TID() == 0) *s_item = (int)atomicAdd(cnt, 1u);
  __syncthreads();
  return *s_item;
}
DI int next_tile_xcd(unsigned* cnt8, int n_per_xcd, int xcd, int* s_item) {
  asm volatile("" : "+s"(xcd));
  __syncthreads();
  if (threadIdx.x == 0) {
    int res = -1;
    for (int a = 0; a < 8; ++a) {
      int qq = (xcd + a) & 7;
      unsigned v = atomicAdd(cnt8 + qq, 1u);
      if (v < (unsigned)n_per_xcd) { res = qq * n_per_xcd + (int)v; break; }
    }
    *s_item = res;
  }
  __syncthreads();
  return *s_item;
}
DI void tile_from_q(int it, int numN, int& mt, int& nt) {
  const int per = 32 * numN, q = it / per, i = it % per, g = i / (8 * numN), rem = i % (8 * numN);
  nt = rem >> 3; mt = 32 * q + 8 * g + (rem & 7);
}
DI int proj_src_col(int pc) {
  if (pc < 640) return pc;
  if (pc < 1664) return pc + 12;
  if (pc < 2688) return pc + 20;
  if (pc < 2700) return pc - 2688 + 640;
  if (pc < 2708) return pc - 2700 + 1676;
  return pc;
}

DI uint4 addpos8(uint4 v, const float* pp) {
  uint4 o;
  o.x = pk2(bf2f((u16)(v.x & 0xffff)) + pp[0], bf2f((u16)(v.x >> 16)) + pp[1]);
  o.y = pk2(bf2f((u16)(v.y & 0xffff)) + pp[2], bf2f((u16)(v.y >> 16)) + pp[3]);
  o.z = pk2(bf2f((u16)(v.z & 0xffff)) + pp[4], bf2f((u16)(v.z >> 16)) + pp[5]);
  o.w = pk2(bf2f((u16)(v.w & 0xffff)) + pp[6], bf2f((u16)(v.w >> 16)) + pp[7]);
  return o;
}
template <int NTW>
DI void gemm2(f32x4 (&acc)[4][NTW], const u16* __restrict__ arow, long a_kstep, const float* __restrict__ apos,
              const u16* __restrict__ brow, int K, u16* sA, u16* sB) {
  constexpr int BN = 32 * NTW, BV = BN / 32, LS = 80;
  const int tid = TID(), lane = tid & 63, w = tid >> 6, r16 = lane & 15, quad = lane >> 4;
  const int wm = w >> 1, wn = w & 1;
  u16* sa_st = sA + (tid >> 1) * LS + (tid & 1) * 32;
  u16* sb_st = (BN == 128) ? (sB + (tid >> 1) * LS + (tid & 1) * 32) : (sB + (tid >> 2) * LS + (tid & 3) * 16);
  uint4 pa0, pa1, pa2, pa3, pb0, pb1, pb2, pb3;
  uint4 qa0, qa1, qa2, qa3, qb0, qb1, qb2, qb3;
  pb2 = make_uint4(0, 0, 0, 0); pb3 = pb2; qb2 = pb2; qb3 = pb2;
#define G2_LOAD(KT, a0, a1, a2, a3, b0, b1, b2, b3) { const uint4* pa_ = (const uint4*)(arow + (long)(KT) * a_kstep); \
    a0 = pa_[0]; a1 = pa_[1]; a2 = pa_[2]; a3 = pa_[3]; \
    if (apos) { const float* pp_ = apos + (KT) * 64 + (tid & 1) * 32; \
      a0 = addpos8(a0, pp_); a1 = addpos8(a1, pp_ + 8); a2 = addpos8(a2, pp_ + 16); a3 = addpos8(a3, pp_ + 24); } \
    const uint4* pb_ = (const uint4*)(brow + (long)(KT) * 64); \
    b0 = pb_[0]; b1 = pb_[1]; if (BV == 4) { b2 = pb_[2]; b3 = pb_[3]; } }
#define G2_STORE(a0, a1, a2, a3, b0, b1, b2, b3) { \
    ((uint4*)sa_st)[0] = a0; ((uint4*)sa_st)[1] = a1; ((uint4*)sa_st)[2] = a2; ((uint4*)sa_st)[3] = a3; \
    ((uint4*)sb_st)[0] = b0; ((uint4*)sb_st)[1] = b1; if (BV == 4) { ((uint4*)sb_st)[2] = b2; ((uint4*)sb_st)[3] = b3; } }
#define G2_COMPUTE() { _Pragma("unroll") for (int ks = 0; ks < 2; ++ks) { \
      bf16x8 af[4], bg[NTW]; \
      _Pragma("unroll") for (int mi = 0; mi < 4; ++mi) af[mi] = *(const bf16x8*)(sA + (wm * 64 + 16 * mi + r16) * LS + ks * 32 + quad * 8); \
      _Pragma("unroll") for (int ni = 0; ni < NTW; ++ni) bg[ni] = *(const bf16x8*)(sB + (wn * (BN / 2) + 16 * ni + r16) * LS + ks * 32 + quad * 8); \
      _Pragma("unroll") for (int mi = 0; mi < 4; ++mi) \
        _Pragma("unroll") for (int ni = 0; ni < NTW; ++ni) acc[mi][ni] = __builtin_amdgcn_mfma_f32_16x16x32_bf16(af[mi], bg[ni], acc[mi][ni], 0, 0, 0); } }
#pragma unroll
  for (int mi = 0; mi < 4; ++mi)
#pragma unroll
    for (int ni = 0; ni < NTW; ++ni) acc[mi][ni] = (f32x4){0.f, 0.f, 0.f, 0.f};
  const int nk = K >> 6;
  G2_LOAD(0, pa0, pa1, pa2, pa3, pb0, pb1, pb2, pb3)
  G2_LOAD(1, qa0, qa1, qa2, qa3, qb0, qb1, qb2, qb3)
#pragma unroll 1
  for (int kt = 0; kt < nk; kt += 2) {
    __syncthreads();
    G2_STORE(pa0, pa1, pa2, pa3, pb0, pb1, pb2, pb3)
    __syncthreads();
    if (kt + 2 < nk) G2_LOAD(kt + 2, pa0, pa1, pa2, pa3, pb0, pb1, pb2, pb3)
    G2_COMPUTE()
    __syncthreads();
    G2_STORE(qa0, qa1, qa2, qa3, qb0, qb1, qb2, qb3)
    __syncthreads();
    if (kt + 3 < nk) G2_LOAD(kt + 3, qa0, qa1, qa2, qa3, qb0, qb1, qb2, qb3)
    G2_COMPUTE()
  }
#undef G2_LOAD
#undef G2_STORE
#undef G2_COMPUTE
}
DI void g3_rowpiece(int tid, int q, bool n64, int& row, int& pc) {
  const int w = tid >> 6, lane = tid & 63, chunk = n64 ? (2 * w + q) : (4 * w + q);
  row = 8 * chunk + (lane >> 3);
  pc = (lane & 7) ^ ((row >> 1) & 7);
}
DI const u16* g3_ptr(const u16* base, long ld, int tid, int q, bool n64) {
  int row, pc; g3_rowpiece(tid, q, n64, row, pc);
  return base + (long)row * ld + pc * 8;
}
template <int NTW, bool LEAN = false>
DI void gemm3(f32x4 (&acc)[4][NTW], const u16* ap0, const u16* ap1, const u16* ap2, const u16* ap3, long a_kstep,
              const u16* bp0, const u16* bp1, const u16* bp2, const u16* bp3, int K, u16* sbase, long a16 = 0, long b16 = 0) {
  constexpr int BN = 32 * NTW, STAGE = 16384;
  const int tid = TID(), lane = tid & 63, w = tid >> 6, r16 = lane & 15, quad = lane >> 4;
  const int wm = w >> 1, wn = w & 1;
  const int sz = (r16 >> 1) & 7;
  const int wu = __builtin_amdgcn_readfirstlane(w);
#define G3_GLDS(GP, LOFF) asm volatile("s_mov_b32 m0, %1\n\ts_nop 0\n\tglobal_load_lds_dwordx4 %0, off" :: "v"(GP), "s"(LOFF) : "memory", "m0")
  const unsigned lds0 = (unsigned)(size_t)sbase;
#define G3_ISSUE(KT) { const unsigned st_ = lds0 + (((KT) & 1) ? STAGE * 2 : 0); const long ka_ = (long)(KT) * a_kstep, kb_ = (long)(KT) * 64; \
    if (BN == 128) { \
      const unsigned la_ = __builtin_amdgcn_readfirstlane(st_ + wu * 4096u); \
      G3_GLDS(ap0 + ka_, la_); G3_GLDS(ap1 + ka_, la_ + 1024u); \
      if (a16) { G3_GLDS(ap0 + (ka_ + a16), la_ + 2048u); G3_GLDS(ap1 + (ka_ + a16), la_ + 3072u); } else { G3_GLDS(ap2 + ka_, la_ + 2048u); G3_GLDS(ap3 + ka_, la_ + 3072u); } \
      G3_GLDS(bp0 + kb_, la_ + 16384u); G3_GLDS(bp1 + kb_, la_ + 17408u); \
      if (b16) { G3_GLDS(bp0 + (kb_ + b16), la_ + 18432u); G3_GLDS(bp1 + (kb_ + b16), la_ + 19456u); } else { G3_GLDS(bp2 + kb_, la_ + 18432u); G3_GLDS(bp3 + kb_, la_ + 19456u); } \
    } else { \
      const unsigned la_ = __builtin_amdgcn_readfirstlane(st_ + wu * 4096u); \
      const unsigned lb_ = __builtin_amdgcn_readfirstlane(st_ + 16384u + wu * 2048u); \
      G3_GLDS(ap0 + ka_, la_); G3_GLDS(ap1 + ka_, la_ + 1024u); G3_GLDS(ap2 + ka_, la_ + 2048u); G3_GLDS(ap3 + ka_, la_ + 3072u); \
      G3_GLDS(bp0 + kb_, lb_); G3_GLDS(bp1 + kb_, lb_ + 1024u); \
    } }
#pragma unroll
  for (int mi = 0; mi < 4; ++mi)
#pragma unroll
    for (int ni = 0; ni < NTW; ++ni) acc[mi][ni] = (f32x4){0.f, 0.f, 0.f, 0.f};
  const int nk = K >> 6;
  __syncthreads();
  G3_ISSUE(0)
  if (!LEAN && BN == 128) {
#define G3_PIECE(I, KT) { const unsigned st_ = lds0 + (((KT) & 1) ? STAGE * 2 : 0); const long ka_ = (long)(KT) * a_kstep, kb_ = (long)(KT) * 64; \
      const unsigned la_ = __builtin_amdgcn_readfirstlane(st_ + wu * 4096u); \
      if ((I) == 0) G3_GLDS(ap0 + ka_, la_); else if ((I) == 1) G3_GLDS(ap1 + ka_, la_ + 1024u); \
      else if ((I) == 2) G3_GLDS((a16 ? ap0 + a16 : ap2) + ka_, la_ + 2048u); else if ((I) == 3) G3_GLDS((a16 ? ap1 + a16 : ap3) + ka_, la_ + 3072u); \
      else if ((I) == 4) G3_GLDS(bp0 + kb_, la_ + 16384u); else if ((I) == 5) G3_GLDS(bp1 + kb_, la_ + 17408u); \
      else if ((I) == 6) G3_GLDS((b16 ? bp0 + b16 : bp2) + kb_, la_ + 18432u); else G3_GLDS((b16 ? bp1 + b16 : bp3) + kb_, la_ + 19456u); }
#define G3_STEP(KT, DOISSUE) { const u16* sAs = sbase + ((KT) & 1) * STAGE; const u16* sBs = sAs + 8192; \
      bf16x8 af[2][4], bg[2][NTW];     \
      _Pragma("unroll") for (int ks = 0; ks < 2; ++ks) { \
        const int pcol = ((ks * 4 + quad) ^ sz) * 8; \
        _Pragma("unroll") for (int mi = 0; mi < 4; ++mi) af[ks][mi] = *(const bf16x8*)(sAs + (wm * 64 + 16 * mi + r16) * 64 + pcol); \
        _Pragma("unroll") for (int ni = 0; ni < NTW; ++ni) bg[ks][ni] = *(const bf16x8*)(sBs + (wn * (BN / 2) + 16 * ni + r16) * 64 + pcol); } \
      __builtin_amdgcn_s_setprio(1);     \
      _Pragma("unroll") for (int mi = 0; mi < 4; ++mi) {   \
        acc[mi][0] = __builtin_amdgcn_mfma_f32_16x16x32_bf16(af[0][mi], bg[0][0], acc[mi][0], 0, 0, 0); \
        acc[mi][1] = __builtin_amdgcn_mfma_f32_16x16x32_bf16(af[0][mi], bg[0][1], acc[mi][1], 0, 0, 0); \
        if (DOISSUE) G3_PIECE(2 * mi, (KT) + 1) \
        __builtin_amdgcn_sched_barrier(0); \
        acc[mi][2] = __builtin_amdgcn_mfma_f32_16x16x32_bf16(af[0][mi], bg[0][2], acc[mi][2], 0, 0, 0); \
        acc[mi][3] = __builtin_amdgcn_mfma_f32_16x16x32_bf16(af[0][mi], bg[0][3], acc[mi][3], 0, 0, 0); \
        if (DOISSUE) G3_PIECE(2 * mi + 1, (KT) + 1) \
        __builtin_amdgcn_sched_barrier(0); } \
      _Pragma("unroll") for (int mi = 0; mi < 4; ++mi) \
        _Pragma("unroll") for (int ni = 0; ni < NTW; ++ni) acc[mi][ni] = __builtin_amdgcn_mfma_f32_16x16x32_bf16(af[1][mi], bg[1][ni], acc[mi][ni], 0, 0, 0); \
      __builtin_amdgcn_s_setprio(0); }
#pragma unroll 1
    for (int kt = 0; kt < nk - 1; ++kt) {
      asm volatile("s_waitcnt vmcnt(0) lgkmcnt(0)" ::: "memory");
      __builtin_amdgcn_s_barrier();
      asm volatile("" ::: "memory");
      G3_STEP(kt, true)
    }
    asm volatile("s_waitcnt vmcnt(0) lgkmcnt(0)" ::: "memory");
    __builtin_amdgcn_s_barrier();
    asm volatile("" ::: "memory");
    G3_STEP(nk - 1, false)
#undef G3_PIECE
#undef G3_STEP
  } else
#pragma unroll 1
  for (int kt = 0; kt < nk; ++kt) {
    asm volatile("s_waitcnt vmcnt(0) lgkmcnt(0)" ::: "memory");
    __builtin_amdgcn_s_barrier();
    asm volatile("" ::: "memory");
    if (kt + 1 < nk) G3_ISSUE(kt + 1)
    const u16* sAs = sbase + (kt & 1) * STAGE;
    const u16* sBs = sAs + 8192;
#pragma unroll 1
    for (int ks = 0; ks < (LEAN ? 2 : 0); ++ks) {
      const int pcol = ((ks * 4 + quad) ^ sz) * 8;
      bf16x8 af[4];
#pragma unroll
      for (int mi = 0; mi < 4; ++mi) af[mi] = *(const bf16x8*)(sAs + (wm * 64 + 16 * mi + r16) * 64 + pcol);
#pragma unroll
      for (int ni = 0; ni < NTW; ++ni) {
        bf16x8 b1 = *(const bf16x8*)(sBs + (wn * (BN / 2) + 16 * ni + r16) * 64 + pcol);
#pragma unroll
        for (int mi = 0; mi < 4; ++mi) acc[mi][ni] = __builtin_amdgcn_mfma_f32_16x16x32_bf16(af[mi], b1, acc[mi][ni], 0, 0, 0);
      }
    }
#pragma unroll
    for (int ks = 0; ks < (LEAN ? 0 : 2); ++ks) {
      const int pcol = ((ks * 4 + quad) ^ sz) * 8;
      bf16x8 af[4], bg[NTW];
#pragma unroll
      for (int mi = 0; mi < 4; ++mi) af[mi] = *(const bf16x8*)(sAs + (wm * 64 + 16 * mi + r16) * 64 + pcol);
#pragma unroll
      for (int ni = 0; ni < NTW; ++ni) bg[ni] = *(const bf16x8*)(sBs + (wn * (BN / 2) + 16 * ni + r16) * 64 + pcol);
#pragma unroll
      for (int mi = 0; mi < 4; ++mi)
#pragma unroll
        for (int ni = 0; ni < NTW; ++ni) acc[mi][ni] = __builtin_amdgcn_mfma_f32_16x16x32_bf16(af[mi], bg[ni], acc[mi][ni], 0, 0, 0);
    }
  }
#undef G3_ISSUE
#undef G3_GLDS
}
template <int NCOLS>
DI void store_tile_bf16(const u16* sC, u16* gdst, long ld, int rows_valid) {
  constexpr int CPR = NCOLS / 8, LS = NCOLS + 8;
  const int tid = TID();
#pragma unroll
  for (int q = 0; q < (128 * CPR) / 256; ++q) {
    const int c = tid + 256 * q, row = c / CPR, ch = c % CPR;
    if (row < rows_valid) *(uint4*)(gdst + (long)row * ld + ch * 8) = *(const uint4*)(sC + row * LS + ch * 8);
  }
}
DI int pair_col(int np, int& which) {
  const int nt = np >> 7, c = np & 127, wn = c >> 6, ni = (c >> 4) & 3, r = c & 15;
  which = ni >> 1;
  return nt * 64 + wn * 32 + (ni & 1) * 16 + r;
}
DI const float* conv_colptr(const Params& P, int l, int mat, int np, long& ld) {
  int which;
  switch (mat) {
    case 0: ld = DIN; return P.in[3] + (long)l * DM * DIN + proj_src_col(np);
    case 1: ld = DIN; return P.in[3] + (long)l * DM * DIN + 2708 + np;
    case 2: ld = DM; return P.in[24] + ((long)(l * 4 + (np >> 10)) * 256) * DM + (np & 1023);
    case 3: ld = DM; return P.in[25] + (long)l * DM * DM + np;
    case 4: { int o = pair_col(np, which); ld = DFF; return (which ? P.in[28] : P.in[27]) + (long)l * DM * DFF + o; }
    case 5: ld = DM; return P.in[29] + (long)l * DFF * DM + np;
    case 6: { int o = pair_col(np, which); ld = 512; return P.in[19] + (long)l * 256 * 512 + which * 256 + o; }
    case 7: ld = 256; return P.in[(np >> 8) ? 9 : 7] + (long)l * 2048 * 256 + (np & 255);
    default: ld = 64; return P.in[(np >> 6) ? 10 : 8] + (long)l * 256 * 64 + (np & 63);
  }
}
DI void phase_convert(const Params& P, int l, float* lds) {
  const int tid = TID();
  if (blockIdx.x < 64) {
    const int kv = blockIdx.x >> 5, ks = blockIdx.x & 31;
    const float* pos = P.in[6] + (long)(l * 2 + kv) * 2048 + ks * 64;
    const float* w1 = P.in[kv ? 9 : 7] + (long)l * 2048 * 256 + (long)ks * 64 * 256 + tid;
    float a = 0.f;
#pragma unroll 8
    for (int k = 0; k < 64; ++k) a += pos[k] * w1[(long)k * 256];
    ((float*)(WSP(P) + WS_CBIAS))[(kv * 32 + ks) * 256 + tid] = a;
  }
  const int NB_[9] = {44, 64, 64, 16, 88, 16, 8, 8, 2};
  const int KB_[9] = {16, 16, 4, 16, 16, 44, 4, 32, 4};
  const size_t OFF_[9] = {WT_IN, WT_G, WT_BR, WT_OUT, WT_GU, WT_D, WT_GLU, WT_C1, WT_C2};
  for (int it = blockIdx.x; it < 4648; it += gridDim.x) {
    int r = it, mat = 0, nbk = 0, kbk = 0; size_t off = 0;
#pragma unroll
    for (int q = 0; q < 9; ++q) { int n = NB_[q] * KB_[q]; if (r >= 0 && r < n) { mat = q; nbk = NB_[q]; kbk = KB_[q]; off = OFF_[q]; r -= 100000; } else if (r >= 0) r -= n; }
    r += 100000;
    const int nb = r / kbk, kb = r % kbk, K = kbk * 64;
    (void)nbk;
    __syncthreads();
    {
      const int n = tid & 63;
      long ld; const float* cp = conv_colptr(P, l, mat, nb * 64 + n, ld);
#pragma unroll 4
      for (int q = 0; q < 16; ++q) { int k = (tid >> 6) + 4 * q; lds[n * 65 + k] = cp[(long)(kb * 64 + k) * ld]; }
    }
    __syncthreads();
    u16* dst = (u16*)(WSP(P) + WS_W + off);
#pragma unroll
    for (int q = 0; q < 2; ++q) {
      int c = tid + 256 * q, n = c >> 3, k8 = (c & 7) * 8;
      const float* sp = lds + n * 65 + k8;
      uint4 v; v.x = pk2(sp[0], sp[1]); v.y = pk2(sp[2], sp[3]); v.z = pk2(sp[4], sp[5]); v.w = pk2(sp[6], sp[7]);
      *(uint4*)(dst + (long)(nb * 64 + n) * K + kb * 64 + k8) = v;
    }
  }
}

DI void st_mma(f32x4 (&st)[4], const u16* sK, const bf16x8 (&bq)[2], int lane) {
  const int r = lane & 15, quad = lane >> 4;
#pragma unroll
  for (int mt = 0; mt < 4; ++mt) {
    f32x4 a = {0.f, 0.f, 0.f, 0.f};
#pragma unroll
    for (int ks = 0; ks < 2; ++ks) {
      bf16x8 kf = *(const bf16x8*)(sK + (16 * mt + r) * 72 + ks * 32 + quad * 8);
      a = __builtin_amdgcn_mfma_f32_16x16x32_bf16(kf, bq[ks], a, 0, 0, 0);
    }
    st[mt] = a;
  }
}
DI void pv_mma(f32x4 (&ot)[4], const u16* sVt, const f32x4 (&p)[4], int lane) {
  const int r = lane & 15, quad = lane >> 4;
#pragma unroll
  for (int ks = 0; ks < 2; ++ks) {
    uint4 pu;
    pu.x = pk2(p[2 * ks][0], p[2 * ks][1]); pu.y = pk2(p[2 * ks][2], p[2 * ks][3]);
    pu.z = pk2(p[2 * ks + 1][0], p[2 * ks + 1][1]); pu.w = pk2(p[2 * ks + 1][2], p[2 * ks + 1][3]);
    bf16x8 pb = __builtin_bit_cast(bf16x8, pu);
#pragma unroll
    for (int dt = 0; dt < 4; ++dt) {
      const u16* vrow = sVt + (16 * dt + r) * 72;
      s16x4 lo = *(const s16x4*)(vrow + ((32 * ks + 4 * quad) ^ (16 * dt)));
      s16x4 hi = *(const s16x4*)(vrow + ((32 * ks + 16 + 4 * quad) ^ (16 * dt)));
      bf16x8 vf = __builtin_shufflevector(lo, hi, 0, 1, 2, 3, 4, 5, 6, 7);
      ot[dt] = __builtin_amdgcn_mfma_f32_16x16x32_bf16(vf, pb, ot[dt], 0, 0, 0);
    }
  }
}
DI void load_tile(u16* dst, const u16* src, long ld) {
  const int tid = TID();
#pragma unroll
  for (int i = 0; i < 2; ++i) {
    int c = tid + 256 * i, row = c >> 3, ch = c & 7;
    uint4 v = *(const uint4*)(src + (long)row * ld + ch * 8);
    *(uint4*)(dst + row * 72 + ch * 8) = v;
  }
}
DI void load_tile_T(u16* dst, const u16* src, long ld) {
  const int tid = TID();
#pragma unroll
  for (int i = 0; i < 2; ++i) {
    int c = tid + 256 * i, row = c >> 3, ch = c & 7;
    uint4 v = *(const uint4*)(src + (long)row * ld + ch * 8);
    const unsigned* vv = (const unsigned*)&v;
#pragma unroll
    for (int q = 0; q < 4; ++q) {
      dst[(ch * 8 + 2 * q) * 72 + row] = (u16)(vv[q] & 0xffff);
      dst[(ch * 8 + 2 * q + 1) * 72 + row] = (u16)(vv[q] >> 16);
    }
  }
}
DI void load_q_nsa(u16* dst, const u16* src, long ld) {
  const int tid = TID();
#pragma unroll
  for (int i = 0; i < 2; ++i) {
    int c = tid + 256 * i, row = c >> 3, ch = c & 7;
    uint4 v = *(const uint4*)(src + (long)(row & 15) * ld + (row >> 4) * 64 + ch * 8);
    *(uint4*)(dst + row * 72 + ch * 8) = v;
  }
}
DI void load_qfrag(bf16x8 (&bq)[2], const u16* sQ, int w, int lane) {
  const int r = lane & 15, quad = lane >> 4;
  bq[0] = *(const bf16x8*)(sQ + (16 * w + r) * 72 + quad * 8);
  bq[1] = *(const bf16x8*)(sQ + (16 * w + r) * 72 + 32 + quad * 8);
}
DI float quad_max(float v) { v = fmaxf(v, __shfl_xor(v, 16)); v = fmaxf(v, __shfl_xor(v, 32)); return v; }
DI float quad_sum(float v) { v += __shfl_xor(v, 16); v += __shfl_xor(v, 32); return v; }

DI void softmax_tile(f32x4 (&st)[4], const bool (&msk)[4][4], float& m, float& l, f32x4 (&ot)[4]) {
  float tm = -1e30f;
#pragma unroll
  for (int mt = 0; mt < 4; ++mt)
#pragma unroll
    for (int j = 0; j < 4; ++j) { float s = st[mt][j] * 0.125f; st[mt][j] = s; if (msk[mt][j]) tm = fmaxf(tm, s); }
  tm = quad_max(tm);
  float mn = fmaxf(m, tm);
  float alpha = __expf(m - mn);
  float ps = 0.f;
#pragma unroll
  for (int mt = 0; mt < 4; ++mt)
#pragma unroll
    for (int j = 0; j < 4; ++j) { float p = msk[mt][j] ? __expf(st[mt][j] - mn) : 0.f; st[mt][j] = p; ps += p; }
  l = l * alpha + ps;
  m = mn;
#pragma unroll
  for (int dt = 0; dt < 4; ++dt)
#pragma unroll
    for (int j = 0; j < 4; ++j) ot[dt][j] *= alpha;
}

DI void softmax_tile_full(f32x4 (&st)[4], float& m, float& l, f32x4 (&ot)[4]) {
  float tm = st[0][0];
#pragma unroll
  for (int mt = 0; mt < 4; ++mt)
#pragma unroll
    for (int j = 0; j < 4; ++j) tm = fmaxf(tm, st[mt][j]);
  tm = quad_max(tm) * 0.125f;
  const float mn = fmaxf(m, tm);
  const float alpha = __expf(m - mn);
  float ps = 0.f;
#pragma unroll
  for (int mt = 0; mt < 4; ++mt)
#pragma unroll
    for (int j = 0; j < 4; ++j) { const float p = __expf(st[mt][j] * 0.125f - mn); st[mt][j] = p; ps += p; }
  l = l * alpha + ps;
  m = mn;
#pragma unroll
  for (int dt = 0; dt < 4; ++dt)
#pragma unroll
    for (int j = 0; j < 4; ++j) ot[dt][j] *= alpha;
}

DI void phase_rmsnorm(const float* __restrict__ x, const float* __restrict__ wgt, u16* __restrict__ H) {
  const int lane = TID() & 63, w = TID() >> 6;
  const int gw = blockIdx.x * 4 + w, nw = gridDim.x * 4;
  for (int row = gw; row < T_; row += nw) {
    const float4* xr = (const float4*)(x + (long)row * DM);
    float4 v[4]; float s = 0.f;
#pragma unroll
    for (int j = 0; j < 4; ++j) { v[j] = xr[lane + 64 * j]; s += v[j].x * v[j].x + v[j].y * v[j].y + v[j].z * v[j].z + v[j].w * v[j].w; }
    s = wave_sum(s);
    float r = rsqrtf(s * (1.f / DM) + EPS);
#pragma unroll
    for (int j = 0; j < 4; ++j) {
      float4 g = ((const float4*)wgt)[lane + 64 * j];
      uint2 o; o.x = pk2(v[j].x * r * g.x, v[j].y * r * g.y); o.y = pk2(v[j].z * r * g.z, v[j].w * r * g.w);
      *(uint2*)(H + (long)row * DM + (lane + 64 * j) * 4) = o;
    }
  }
}
DI void phase_rope_table(const int* __restrict__ positions, float* __restrict__ COS, float* __restrict__ SIN) {
  const float invf[8] = {1.0f, 0.1939227432012558f, 0.03760603070259094f, 0.007292664609849453f,
                         0.0014142135623842478f, 0.00027424818836152554f, 5.3182957344688475e-05f, 1.0313385246263351e-05f};
  for (int idx = blockIdx.x * 256 + TID(); idx < T_ * 8; idx += gridDim.x * 256) {
    int i = idx & 7;
    float f = invf[0];
#pragma unroll
    for (int q = 1; q < 8; ++q) f = (i == q) ? invf[q] : f;
    float ang = (float)positions[idx >> 3] * f;
    double s, c; sincos_d((double)ang, s, c);
    COS[idx] = (float)c; SIN[idx] = (float)s;
  }
}

struct S5Coef { float ar, ai; float bbr[16], bbi[16]; };
DI void s5_coef(const Params& P, int l, int g, int p, S5Coef& C) {
  float dt = expf(P.in[13][l * 16 + g]);
  float lr = P.in[11][(l * 16 + g) * 64 + p], li = P.in[12][(l * 16 + g) * 64 + p];
  float mag = expf(lr * dt);
  double s, c; sincos_d((double)(li * dt), s, c);
  C.ar = mag * (float)c; C.ai = mag * (float)s;
  float den = lr * lr + li * li;
  float fr = ((C.ar - 1.f) * lr + C.ai * li) / den;
  float fi = (C.ai * lr - (C.ar - 1.f) * li) / den;
  const float* br = P.in[14] + ((long)(l * 16 + g) * 64 + p) * 16;
  const float* bi = P.in[15] + ((long)(l * 16 + g) * 64 + p) * 16;
#pragma unroll
  for (int c2 = 0; c2 < 16; ++c2) {
    float b_r = br[c2], b_i = bi[c2];
    C.bbr[c2] = fr * b_r - fi * b_i;
    C.bbi[c2] = fr * b_i + fi * b_r;
  }
}
DI void s5_load_u(float* su, const u16* PROJ, int b, int chunk, int g, int lane) {
  const u16* src = PROJ + ((long)(b * SEQ + chunk * 64 + lane)) * PW + P_S5U + g * 16;
  uint4 v0 = ((const uint4*)src)[0], v1 = ((const uint4*)src)[1];
  const unsigned* a = (const unsigned*)&v0; const unsigned* c = (const unsigned*)&v1;
  float* d = su + lane * 16;
#pragma unroll
  for (int q = 0; q < 4; ++q) { d[2 * q] = bf2f((u16)(a[q] & 0xffff)); d[2 * q + 1] = bf2f((u16)(a[q] >> 16)); }
#pragma unroll
  for (int q = 0; q < 4; ++q) { d[8 + 2 * q] = bf2f((u16)(c[q] & 0xffff)); d[8 + 2 * q + 1] = bf2f((u16)(c[q] >> 16)); }
}

DI void s5_pass1_item(const Params& P, int l, int it, float* lds) {
  const int lane = TID() & 63, w = TID() >> 6;
  const int gq = it & 3, chunk = (it >> 2) & 63, b = it >> 8;
  const int g = gq * 4 + w;
  const u16* PROJ = (const u16*)(WSP(P) + WS_PROJ);
  float* su = lds + w * 1024;
  S5Coef C; s5_coef(P, l, g, lane, C);
  s5_load_u(su, PROJ, b, chunk, g, lane);
  __syncthreads();
  float xr = 0.f, xi = 0.f;
#pragma unroll 4
  for (int t = 0; t < 64; ++t) {
    const f32x4* up = (const f32x4*)(su + t * 16);
    float br = 0.f, bi = 0.f;
#pragma unroll
    for (int q = 0; q < 4; ++q) {
      f32x4 u = up[q];
#pragma unroll
      for (int e = 0; e < 4; ++e) { br += u[e] * C.bbr[4 * q + e]; bi += u[e] * C.bbi[4 * q + e]; }
    }
    float nr = C.ar * xr - C.ai * xi + br;
    float ni = C.ar * xi + C.ai * xr + bi;
    xr = nr; xi = ni;
  }
  float2* ENDS = (float2*)(WSP(P) + WS_ENDS);
  ENDS[((long)(b * 64 + chunk) * 16 + g) * 64 + lane] = make_float2(xr, xi);
}

DI void s5_carry_item(const Params& P, int l, int it) {
  const int idx = it * 256 + TID();
  const int b = idx >> 10, gp = idx & 1023, g = gp >> 6, p = gp & 63;
  float dt = expf(P.in[13][l * 16 + g]);
  float lr = P.in[11][(l * 16 + g) * 64 + p], li = P.in[12][(l * 16 + g) * 64 + p];
  float mag = expf(lr * dt * 64.f);
  double s, c; sincos_d((double)(li * dt) * 64.0, s, c);
  float ar = mag * (float)c, ai = mag * (float)s;
  const float2* ENDS = (const float2*)(WSP(P) + WS_ENDS);
  float2* CARRY = (float2*)(WSP(P) + WS_CARRY);
  float xr = 0.f, xi = 0.f;
  for (int ch = 0; ch < 64; ++ch) {
    long o = ((long)(b * 64 + ch) * 16 + g) * 64 + p;
    CARRY[o] = make_float2(xr, xi);
    float2 e = ENDS[o];
    float nr = ar * xr - ai * xi + e.x;
    float ni = ar * xi + ai * xr + e.y;
    xr = nr; xi = ni;
  }
}

DI void s5_pass2_item(const Params& P, int l, int it, float* lds) {
  const int lane = TID() & 63, w = TID() >> 6, r16 = lane & 15, quad = lane >> 4;
  const int gq = it & 3, chunk = (it >> 2) & 63, b = it >> 8;
  const int g = gq * 4 + w;
  const u16* PROJ = (const u16*)(WSP(P) + WS_PROJ);
  u16* Y5 = (u16*)(WSP(P) + WS_Y5);
  float* su = lds + w * 1024;
  u16* sX = (u16*)(lds + 4096) + w * (32 * 136);
  S5Coef C; s5_coef(P, l, g, lane, C);
  bf16x8 bfr[4];
#pragma unroll
  for (int ks = 0; ks < 4; ++ks) {
    const float* src = P.in[(ks < 2) ? 16 : 17] + ((long)(l * 16 + g) * 16 + r16) * 64 + (ks & 1) * 32 + quad * 8;
    const float4 v0 = ((const float4*)src)[0], v1 = ((const float4*)src)[1];
    const float sg = (ks < 2) ? 1.f : -1.f;
    uint4 pu; pu.x = pk2(sg * v0.x, sg * v0.y); pu.y = pk2(sg * v0.z, sg * v0.w); pu.z = pk2(sg * v1.x, sg * v1.y); pu.w = pk2(sg * v1.z, sg * v1.w);
    bfr[ks] = __builtin_bit_cast(bf16x8, pu);
  }
  const float dsk = P.in[18][l * 256 + g * 16 + r16];
  s5_load_u(su, PROJ, b, chunk, g, lane);
  __syncthreads();
  const float2 c0 = ((const float2*)(WSP(P) + WS_CARRY))[((long)(b * 64 + chunk) * 16 + g) * 64 + lane];
  float xr = c0.x, xi = c0.y;
  for (int half = 0; half < 2; ++half) {
#pragma unroll 4
    for (int tt = 0; tt < 32; ++tt) {
      const int t = half * 32 + tt;
      const f32x4* up = (const f32x4*)(su + t * 16);
      float br0 = 0.f, bi0 = 0.f, br1 = 0.f, bi1 = 0.f;
#pragma unroll
      for (int q = 0; q < 4; ++q) {
        f32x4 u = up[q];
        br0 += u[0] * C.bbr[4 * q + 0]; bi0 += u[0] * C.bbi[4 * q + 0];
        br1 += u[1] * C.bbr[4 * q + 1]; bi1 += u[1] * C.bbi[4 * q + 1];
        br0 += u[2] * C.bbr[4 * q + 2]; bi0 += u[2] * C.bbi[4 * q + 2];
        br1 += u[3] * C.bbr[4 * q + 3]; bi1 += u[3] * C.bbi[4 * q + 3];
      }
      const float nr = C.ar * xr - C.ai * xi + (br0 + br1);
      const float ni = C.ar * xi + C.ai * xr + (bi0 + bi1);
      xr = nr; xi = ni;
      sX[tt * 136 + lane] = f2bf(xr);
      sX[tt * 136 + 64 + lane] = f2bf(xi);
    }
    __syncthreads();
#pragma unroll
    for (int mt = 0; mt < 2; ++mt) {
      f32x4 acc = {0.f, 0.f, 0.f, 0.f};
#pragma unroll
      for (int ks = 0; ks < 4; ++ks) {
        const bf16x8 af = *(const bf16x8*)(sX + (16 * mt + r16) * 136 + ks * 32 + quad * 8);
        acc = __builtin_amdgcn_mfma_f32_16x16x32_bf16(af, bfr[ks], acc, 0, 0, 0);
      }
#pragma unroll
      for (int j = 0; j < 4; ++j) {
        const int t = half * 32 + 16 * mt + 4 * quad + j;
        const float y = acc[j] + dsk * su[t * 16 + r16];
        Y5[((long)(b * SEQ + chunk * 64 + t)) * 256 + g * 16 + r16] = f2bf(gelu_tanh(y));
      }
    }
    __syncthreads();
  }
}

DI void nsa_prep_item(const Params& P, int l, int it) {
  const int lane = TID() & 63, w = TID() >> 6;
  u16* PROJ = (u16*)(WSP(P) + WS_PROJ);
  u16* QR = (u16*)(WSP(P) + WS_QR);
  const float* COS = (const float*)(WSP(P) + WS_COS);
  const float* SIN = (const float*)(WSP(P) + WS_SIN);
  for (int tt = 0; tt < 4; ++tt) {
    const long t = (long)it * 16 + w * 4 + tt;
    const float cs = COS[t * 8 + (lane & 7)], sn = SIN[t * 8 + (lane & 7)];
#pragma unroll
    for (int g = 0; g < 6; ++g) {
      const int col = (g < 4) ? (P_Q + g * 64) : (g == 4 ? P_KV + 128 : P_KV + 256);
      const float wg = (g < 4) ? P.in[4][l * 64 + lane] : P.in[5][(l * 3 + (g - 3)) * 64 + lane];
      u16* ptr = PROJ + t * PW + col + lane;
      float v = bf2f(*ptr);
      float ss = wave_sum(v * v);
      float y = v * rsqrtf(ss * (1.f / 64.f) + EPS) * wg;
      float pr = __shfl_xor(y, 8);
      float rot = (lane < 8) ? (y * cs - pr * sn) : ((lane < 16) ? (y * cs + pr * sn) : y);
      if (g < 4) { *ptr = f2bf(y); QR[t * 256 + g * 64 + lane] = f2bf(rot); }
      else *ptr = f2bf(rot);
    }
  }
}

DI void cmp1_tile(const Params& P, int l, int ct, u16* sA, u16* sB) {
  const int tid = TID(), lane = tid & 63, w = tid >> 6, r16 = lane & 15, quad = lane >> 4, wm = w >> 1, wn = w & 1;
  const int kv = ct >> 5, mt = (ct >> 1) & 15, nt = ct & 1;
  const u16* PROJ = (const u16*)(WSP(P) + WS_PROJ);
  u16* HID = (u16*)(WSP(P) + WS_HID);
  const u16* apq[4];
#pragma unroll
  for (int q = 0; q < 4; ++q) {
    int row, pc; g3_rowpiece(tid, q, false, row, pc);
    int gr = mt * 128 + row; if (gr > 2039) gr = 2039;
    const int b = gr / 255, n = gr % 255;
    apq[q] = PROJ + ((long)(b * SEQ + 16 * n)) * PW + P_KV + kv * 64 + pc * 8;
  }
  const u16* Bb = (const u16*)(WSP(P) + WS_W + WT_C1) + ((long)(kv * 256 + nt * 128)) * 2048;
  f32x4 acc[4][4];
  gemm3<4>(acc, apq[0], apq[1], apq[2], apq[3], PW,
           g3_ptr(Bb, 2048, tid, 0, false), g3_ptr(Bb, 2048, tid, 1, false), g3_ptr(Bb, 2048, tid, 2, false), g3_ptr(Bb, 2048, tid, 3, false), 2048, sA);
  {
    const float* PART = (const float*)(WSP(P) + WS_CBIAS) + (long)kv * 32 * 256;
#pragma unroll
    for (int ni = 0; ni < 4; ++ni) {
      const int col = nt * 128 + wn * 64 + 16 * ni + r16;
      float bsum = 0.f;
      for (int sl = 0; sl < 32; ++sl) bsum += PART[sl * 256 + col];
#pragma unroll
      for (int mi = 0; mi < 4; ++mi)
#pragma unroll
        for (int j = 0; j < 4; ++j) acc[mi][ni][j] += bsum;
    }
  }
  __syncthreads();
#pragma unroll
  for (int mi = 0; mi < 4; ++mi)
#pragma unroll
    for (int ni = 0; ni < 4; ++ni)
#pragma unroll
      for (int j = 0; j < 4; ++j) sA[(wm * 64 + 16 * mi + 4 * quad + j) * 136 + wn * 64 + 16 * ni + r16] = f2bf(gelu_tanh(acc[mi][ni][j]));
  __syncthreads();
  store_tile_bf16<128>(sA, HID + ((long)kv * 2048 + mt * 128) * 256 + nt * 128, 256, 2040 - mt * 128);
}
DI void cmp2_tile(const Params& P, int l, int ct, u16* sA, u16* sB, float* sSS) {
  const int tid = TID(), lane = tid & 63, w = tid >> 6, r16 = lane & 15, quad = lane >> 4, wm = w >> 1, wn = w & 1;
  const int kv = ct >> 4, mt = ct & 15;
  const u16* HID = (const u16*)(WSP(P) + WS_HID);
  u16* OUT = (u16*)(WSP(P) + (kv ? WS_VC : WS_KC));
  const u16* Ab = HID + ((long)kv * 2048 + mt * 128) * 256;
  const u16* Bb = (const u16*)(WSP(P) + WS_W + WT_C2) + (long)kv * 64 * 256;
  f32x4 acc[4][2];
  gemm3<2>(acc, g3_ptr(Ab, 256, tid, 0, false), g3_ptr(Ab, 256, tid, 1, false), g3_ptr(Ab, 256, tid, 2, false), g3_ptr(Ab, 256, tid, 3, false), 64,
           g3_ptr(Bb, 256, tid, 0, true), g3_ptr(Bb, 256, tid, 1, true), nullptr, nullptr, 256, sA);
  __syncthreads();
  if (tid < 128) sSS[tid] = 0.f;
  __syncthreads();
#pragma unroll
  for (int mi = 0; mi < 4; ++mi)
#pragma unroll
    for (int j = 0; j < 4; ++j) {
      float ss = acc[mi][0][j] * acc[mi][0][j] + acc[mi][1][j] * acc[mi][1][j];
      ss += __shfl_xor(ss, 1); ss += __shfl_xor(ss, 2); ss += __shfl_xor(ss, 4); ss += __shfl_xor(ss, 8);
      if (r16 == 0) atomicAdd(&sSS[wm * 64 + 16 * mi + 4 * quad + j], ss);
    }
  __syncthreads();
#pragma unroll
  for (int mi = 0; mi < 4; ++mi)
#pragma unroll
    for (int j = 0; j < 4; ++j) {
      const int rl = wm * 64 + 16 * mi + 4 * quad + j, row = mt * 128 + rl;
      const float sc = (kv == 0) ? rsqrtf(sSS[rl] * (1.f / 64.f) + EPS) : 1.f;
      if (row < 2040) {
        int b = row / 255, n = row % 255;
#pragma unroll
        for (int ni = 0; ni < 2; ++ni) {
          int col = wn * 32 + 16 * ni + r16;
          float v = acc[mi][ni][j] * sc;
          if (kv == 0) v *= P.in[5][(l * 3 + 0) * 64 + col];
          OUT[((long)(b * 256 + n)) * 64 + col] = f2bf(v);
        }
      }
    }
}

DI void gdn_p1_item(const Params& P, int l, int it, float* lds) {
  const int tid = TID(), lane = tid & 63, w = tid >> 6, r16 = lane & 15, quad = lane >> 4;
  const int chunk = it & 63, h = (it >> 6) & 3, b = it >> 8;
  const long ci = it;
  const u16* PROJ = (const u16*)(WSP(P) + WS_PROJ);
  float* sq = lds;
  float* sk = lds + 64 * 65;
  float* sv = lds + 2 * 64 * 65;
  float* sG = lds + 3 * 64 * 65;
  float* sBeta = sG + 64;
  float* sg = sBeta + 64;
  u16* sQb = (u16*)(sg + 64);
  u16* sKb = sQb + 64 * 72;
  const float* cw = P.in[20] + (long)l * 4 * 768;
  if (tid < 192) {
    const int cp = tid % 96, th = tid / 96;
    const int c0 = 2 * cp, which = c0 >> 6, d = c0 & 63, C = which * 256 + h * 64 + d;
    float w0[4], w1[4];
#pragma unroll
    for (int k = 0; k < 4; ++k) { w0[k] = cw[k * 768 + C]; w1[k] = cw[k * 768 + C + 1]; }
    unsigned v[35];
    const int s0 = chunk * 64 + th * 32 - 3;
    const u16* src = PROJ + ((long)(b * SEQ + s0)) * PW + P_GQKV + C;
#pragma unroll
    for (int k = 0; k < 35; ++k) v[k] = (s0 + k >= 0) ? *(const unsigned*)(src + (long)k * PW) : 0u;
    float* dst = lds + which * 64 * 65 + (th * 32) * 65 + d;
#pragma unroll
    for (int tt = 0; tt < 32; ++tt) {
      float a0 = 0.f, a1 = 0.f;
#pragma unroll
      for (int k = 0; k < 4; ++k) { a0 += w0[k] * bf2f((u16)(v[tt + k] & 0xffff)); a1 += w1[k] * bf2f((u16)(v[tt + k] >> 16)); }
      dst[tt * 65] = siluf_(a0); dst[tt * 65 + 1] = siluf_(a1);
    }
  }
  __syncthreads();
  if (tid < 128) {
    float* base = (tid < 64) ? sq : sk;
    u16* bb = (tid < 64) ? sQb : sKb;
    const int row = tid & 63;
    float ss = 0.f;
#pragma unroll 8
    for (int d = 0; d < 64; ++d) { float x = base[row * 65 + d]; ss += x * x; }
    const float sc = rsqrtf(ss + EPS) * ((tid < 64) ? 0.125f : 1.f);
#pragma unroll 8
    for (int d = 0; d < 64; d += 2) {
      const float x0 = base[row * 65 + d] * sc, x1 = base[row * 65 + d + 1] * sc;
      base[row * 65 + d] = x0; base[row * 65 + d + 1] = x1;
      *(unsigned*)(bb + row * 72 + d) = pk2(x0, x1);
    }
  } else if (tid < 192) {
    const int row = tid - 128;
    const long t = (long)(b * SEQ + chunk * 64 + row);
    const float bl = bf2f(PROJ[t * PW + P_GB + h]);
    const float al = bf2f(PROJ[t * PW + P_GA + h]);
    sBeta[row] = sigmoidf_(bl);
    sg[row] = -expf(P.in[21][l * 4 + h]) * softplusf_(al + P.in[22][l * 4 + h]);
  }
  __syncthreads();
  if (tid < 64) {
    float x = sg[tid];
#pragma unroll
    for (int o = 1; o < 64; o <<= 1) { float u = __shfl_up(x, o); if (tid >= o) x += u; }
    sG[tid] = x;
    ((float*)(WSP(P) + WS_GG))[ci * 64 + tid] = x;
  }
  __syncthreads();
  f32x4 lreg[4];
  {
    const f32x4 Gi4 = *(const f32x4*)(sG + 16 * w + 4 * quad);
    const f32x4 Bi4 = *(const f32x4*)(sBeta + 16 * w + 4 * quad);
    u16* GA = (u16*)(WSP(P) + WS_GA) + ci * 4096;
#pragma unroll
    for (int nt = 0; nt < 4; ++nt) {
      f32x4 aq = {0.f, 0.f, 0.f, 0.f}, ak = {0.f, 0.f, 0.f, 0.f};
#pragma unroll
      for (int ks = 0; ks < 2; ++ks) {
        const bf16x8 fq = *(const bf16x8*)(sQb + (16 * w + r16) * 72 + ks * 32 + quad * 8);
        const bf16x8 fk = *(const bf16x8*)(sKb + (16 * w + r16) * 72 + ks * 32 + quad * 8);
        const bf16x8 fb = *(const bf16x8*)(sKb + (16 * nt + r16) * 72 + ks * 32 + quad * 8);
        aq = __builtin_amdgcn_mfma_f32_16x16x32_bf16(fq, fb, aq, 0, 0, 0);
        ak = __builtin_amdgcn_mfma_f32_16x16x32_bf16(fk, fb, ak, 0, 0, 0);
      }
      const int j = 16 * nt + r16;
      const float Gj = sG[j];
#pragma unroll
      for (int jj = 0; jj < 4; ++jj) {
        const int i = 16 * w + 4 * quad + jj;
        const float dec = __expf(Gi4[jj] - Gj);
        GA[i * 64 + j] = f2bf((j <= i) ? aq[jj] * dec : 0.f);
        const float lv = (j < i) ? Bi4[jj] * ak[jj] * dec : 0.f;
        sq[i * 65 + j] = lv;
        lreg[nt][jj] = lv;
      }
    }
  }
  {
    u16* GQ = (u16*)(WSP(P) + WS_GQ) + ci * 4096;
#pragma unroll
    for (int q = 0; q < 2; ++q) { const int c = tid + 256 * q, row = c >> 3, ch = c & 7; *(uint4*)(GQ + row * 64 + ch * 8) = *(const uint4*)(sQb + row * 72 + ch * 8); }
    const int i = tid >> 2, j0 = (tid & 3) * 16;
    u16* GK = (u16*)(WSP(P) + WS_GK) + ci * 4096 + i * 64 + j0;
    unsigned ok[8];
#pragma unroll
    for (int q = 0; q < 8; ++q) ok[q] = pk2(sk[(j0 + 2 * q) * 65 + i], sk[(j0 + 2 * q + 1) * 65 + i]);
    ((uint4*)GK)[0] = make_uint4(ok[0], ok[1], ok[2], ok[3]); ((uint4*)GK)[1] = make_uint4(ok[4], ok[5], ok[6], ok[7]);
  }
  __syncthreads();
  u16* sLb = sQb;
  u16* sXT = sKb;
  {
    const int i = tid >> 2, j0 = (tid & 3) * 16;
    const float bi = sBeta[i], eg = __expf(sG[i]);
#pragma unroll
    for (int jj = 0; jj < 16; ++jj) { sv[i * 65 + j0 + jj] *= bi; sk[i * 65 + j0 + jj] *= bi * eg; }
#pragma unroll
    for (int nt = 0; nt < 4; ++nt)
#pragma unroll
      for (int jj = 0; jj < 4; ++jj) sLb[(16 * w + 4 * quad + jj) * 72 + 16 * nt + r16] = f2bf(lreg[nt][jj]);
  }
  __syncthreads();
#pragma unroll 1
  for (int bi = 0; bi < 4; ++bi) {
    if (tid < 128) {
      float* buf = (tid < 64) ? sv : sk;
      const int col = tid & 63;
      float x[16];
#pragma unroll
      for (int r = 0; r < 16; ++r) {
        float a0 = buf[(16 * bi + r) * 65 + col], a1 = 0.f;
#pragma unroll
        for (int j = 0; j + 1 < r; j += 2) { a0 -= sq[(16 * bi + r) * 65 + 16 * bi + j] * x[j]; a1 -= sq[(16 * bi + r) * 65 + 16 * bi + j + 1] * x[j + 1]; }
        if (r & 1) a0 -= sq[(16 * bi + r) * 65 + 16 * bi + r - 1] * x[r - 1];
        x[r] = a0 + a1;
        buf[(16 * bi + r) * 65 + col] = x[r];
      }
      uint4 p0, p1;
      p0.x = pk2(x[0], x[1]); p0.y = pk2(x[2], x[3]); p0.z = pk2(x[4], x[5]); p0.w = pk2(x[6], x[7]);
      p1.x = pk2(x[8], x[9]); p1.y = pk2(x[10], x[11]); p1.z = pk2(x[12], x[13]); p1.w = pk2(x[14], x[15]);
      *(uint4*)(sXT + tid * 24) = p0; *(uint4*)(sXT + tid * 24 + 8) = p1;
    }
    __syncthreads();
    if (bi < 3) {
#pragma unroll
      for (int q = 0; q < 2; ++q) {
        const int nt = 2 * w + q, colg = 16 * nt + r16;
        bf16x8 bx = *(const bf16x8*)(sXT + colg * 24 + (quad & 1) * 8);
        if (quad >= 2) bx = (bf16x8){0, 0, 0, 0, 0, 0, 0, 0};
        float* buf = (colg < 64) ? sv : sk;
        const int cc = colg & 63;
        for (int bk = bi + 1; bk < 4; ++bk) {
          const bf16x8 al = *(const bf16x8*)(sLb + (16 * bk + r16) * 72 + 16 * bi + quad * 8);
          f32x4 c = {0.f, 0.f, 0.f, 0.f};
          c = __builtin_amdgcn_mfma_f32_16x16x32_bf16(al, bx, c, 0, 0, 0);
#pragma unroll
          for (int jj = 0; jj < 4; ++jj) buf[(16 * bk + 4 * quad + jj) * 65 + cc] -= c[jj];
        }
      }
    }
    __syncthreads();
  }
  {
    const int i = tid >> 2, j0 = (tid & 3) * 16;
    u16* GU = (u16*)(WSP(P) + WS_GU) + ci * 4096 + i * 64 + j0;
    u16* GW = (u16*)(WSP(P) + WS_GW) + ci * 4096 + i * 64 + j0;
    unsigned ou[8], ow[8];
#pragma unroll
    for (int q = 0; q < 8; ++q) {
      ou[q] = pk2(sv[i * 65 + j0 + 2 * q], sv[i * 65 + j0 + 2 * q + 1]);
      ow[q] = pk2(sk[i * 65 + j0 + 2 * q], sk[i * 65 + j0 + 2 * q + 1]);
    }
    ((uint4*)GU)[0] = make_uint4(ou[0], ou[1], ou[2], ou[3]); ((uint4*)GU)[1] = make_uint4(ou[4], ou[5], ou[6], ou[7]);
    ((uint4*)GW)[0] = make_uint4(ow[0], ow[1], ow[2], ow[3]); ((uint4*)GW)[1] = make_uint4(ow[4], ow[5], ow[6], ow[7]);
  }
}

DI void unpack8(const u16* p, float (&o)[8]) {
  uint4 v = *(const uint4*)p;
  o[0] = bf2f((u16)(v.x & 0xffff)); o[1] = bf2f((u16)(v.x >> 16));
  o[2] = bf2f((u16)(v.y & 0xffff)); o[3] = bf2f((u16)(v.y >> 16));
  o[4] = bf2f((u16)(v.z & 0xffff)); o[5] = bf2f((u16)(v.z >> 16));
  o[6] = bf2f((u16)(v.w & 0xffff)); o[7] = bf2f((u16)(v.w >> 16));
}
DI void st_kt(u16* sKt, int c8, int row, uint4 k) {
  sKt[(c8 + 0) * 72 + row] = (u16)(k.x & 0xffff); sKt[(c8 + 1) * 72 + row] = (u16)(k.x >> 16);
  sKt[(c8 + 2) * 72 + row] = (u16)(k.y & 0xffff); sKt[(c8 + 3) * 72 + row] = (u16)(k.y >> 16);
  sKt[(c8 + 4) * 72 + row] = (u16)(k.z & 0xffff); sKt[(c8 + 5) * 72 + row] = (u16)(k.z >> 16);
  sKt[(c8 + 6) * 72 + row] = (u16)(k.w & 0xffff); sKt[(c8 + 7) * 72 + row] = (u16)(k.w >> 16);
}
DI uint2 pack4bf(const f32x4& v) { uint2 r; r.x = pk2(v[0], v[1]); r.y = pk2(v[2], v[3]); return r; }
DI void gdn_p2_item(const Params& P, int it, float* lds) {
  const int tid = TID(), lane = tid & 63, w = tid >> 6, r16 = lane & 15, quad = lane >> 4;
  const int es = it & 3, bh = it >> 2, b = bh >> 2, h = bh & 3;
  u16* sW = (u16*)lds;
  u16* sQ = sW + 64 * 72;
  u16* sAm = sQ + 64 * 72;
  u16* sKt = sAm + 64 * 72;
  u16* sSt = sKt + 64 * 72;
  u16* sVnT = sSt + 16 * 72;
  u16* sVdT = sVnT + 16 * 72;
  float* sG = (float*)(sVdT + 16 * 72);
  const u16* GQ = (const u16*)(WSP(P) + WS_GQ); const u16* GK = (const u16*)(WSP(P) + WS_GK);
  const u16* GU = (const u16*)(WSP(P) + WS_GU); const u16* GW = (const u16*)(WSP(P) + WS_GW);
  const u16* GA = (const u16*)(WSP(P) + WS_GA); const float* GG = (const float*)(WSP(P) + WS_GG);
  u16* ORAW = (u16*)(WSP(P) + WS_OM) + (long)2 * T_ * 256;
  f32x4 S = {0.f, 0.f, 0.f, 0.f};
  const int irow = 16 * w + 4 * quad;
  uint4 rw0, rw1, rq0, rq1, ra0, ra1, rk0, rk1; u16 ru0, ru1, ru2, ru3; float rg = 0.f;
  const int c0 = tid, c1 = tid + 256;
  const long off0 = (c0 >> 3) * 64 + (c0 & 7) * 8, off1 = (c1 >> 3) * 64 + (c1 & 7) * 8;
#define GDN_GLOAD(CH) { long ci_ = (long)bh * 64 + (CH); \
    rw0 = *(const uint4*)(GW + ci_ * 4096 + off0); rw1 = *(const uint4*)(GW + ci_ * 4096 + off1); \
    rq0 = *(const uint4*)(GQ + ci_ * 4096 + off0); rq1 = *(const uint4*)(GQ + ci_ * 4096 + off1); \
    ra0 = *(const uint4*)(GA + ci_ * 4096 + off0); ra1 = *(const uint4*)(GA + ci_ * 4096 + off1); \
    rk0 = *(const uint4*)(GK + ci_ * 4096 + off0); rk1 = *(const uint4*)(GK + ci_ * 4096 + off1); \
    const u16* up_ = GU + ci_ * 4096 + irow * 64 + es * 16 + r16; \
    ru0 = up_[0]; ru1 = up_[64]; ru2 = up_[128]; ru3 = up_[192]; \
    if (tid < 64) rg = GG[ci_ * 64 + tid]; }
  GDN_GLOAD(0)
  for (int ch = 0; ch < 64; ++ch) {
    __syncthreads();
    {
      const int row0 = c0 >> 3, c80 = (c0 & 7) * 8, row1 = c1 >> 3, c81 = (c1 & 7) * 8;
      *(uint4*)(sW + row0 * 72 + c80) = rw0; *(uint4*)(sW + row1 * 72 + c81) = rw1;
      *(uint4*)(sQ + row0 * 72 + c80) = rq0; *(uint4*)(sQ + row1 * 72 + c81) = rq1;
      *(uint4*)(sAm + row0 * 72 + c80) = ra0; *(uint4*)(sAm + row1 * 72 + c81) = ra1;
      *(uint4*)(sKt + row0 * 72 + c80) = rk0; *(uint4*)(sKt + row1 * 72 + c81) = rk1;
    }
    if (tid < 64) sG[tid] = rg;
    *(uint2*)(sSt + r16 * 72 + irow) = pack4bf(S);
    const f32x4 uc = {bf2f(ru0), bf2f(ru1), bf2f(ru2), bf2f(ru3)};
    __syncthreads();
    if (ch + 1 < 64) GDN_GLOAD(ch + 1)
    f32x4 ws = {0.f, 0.f, 0.f, 0.f}, qs = {0.f, 0.f, 0.f, 0.f};
#pragma unroll
    for (int ks = 0; ks < 2; ++ks) {
      const bf16x8 bS = *(const bf16x8*)(sSt + r16 * 72 + ks * 32 + quad * 8);
      const bf16x8 aW = *(const bf16x8*)(sW + (16 * w + r16) * 72 + ks * 32 + quad * 8);
      const bf16x8 aQ = *(const bf16x8*)(sQ + (16 * w + r16) * 72 + ks * 32 + quad * 8);
      ws = __builtin_amdgcn_mfma_f32_16x16x32_bf16(aW, bS, ws, 0, 0, 0);
      qs = __builtin_amdgcn_mfma_f32_16x16x32_bf16(aQ, bS, qs, 0, 0, 0);
    }
    const float Gl = sG[63];
    const f32x4 G4 = *(const f32x4*)(sG + irow);
    f32x4 vn, vd;
#pragma unroll
    for (int j = 0; j < 4; ++j) { vn[j] = uc[j] - ws[j]; vd[j] = vn[j] * __expf(Gl - G4[j]); }
    *(uint2*)(sVnT + r16 * 72 + irow) = pack4bf(vn);
    *(uint2*)(sVdT + r16 * 72 + irow) = pack4bf(vd);
    __syncthreads();
    f32x4 av = {0.f, 0.f, 0.f, 0.f}, kv = {0.f, 0.f, 0.f, 0.f};
#pragma unroll
    for (int ks = 0; ks < 2; ++ks) {
      const bf16x8 bVn = *(const bf16x8*)(sVnT + r16 * 72 + ks * 32 + quad * 8);
      const bf16x8 bVd = *(const bf16x8*)(sVdT + r16 * 72 + ks * 32 + quad * 8);
      const bf16x8 aA = *(const bf16x8*)(sAm + (16 * w + r16) * 72 + ks * 32 + quad * 8);
      const bf16x8 aK = *(const bf16x8*)(sKt + (16 * w + r16) * 72 + ks * 32 + quad * 8);
      av = __builtin_amdgcn_mfma_f32_16x16x32_bf16(aA, bVn, av, 0, 0, 0);
      kv = __builtin_amdgcn_mfma_f32_16x16x32_bf16(aK, bVd, kv, 0, 0, 0);
    }
    {
      u16* op = ORAW + ((long)(b * SEQ + ch * 64 + irow)) * 256 + h * 64 + es * 16 + r16;
#pragma unroll
      for (int j = 0; j < 4; ++j) op[j * 256] = f2bf(__expf(G4[j]) * qs[j] + av[j]);
    }
    const float gl = __expf(Gl);
#pragma unroll
    for (int j = 0; j < 4; ++j) S[j] = S[j] * gl + kv[j];
  }
#undef GDN_GLOAD
}
DI void gdn_post_item(const Params& P, int l, int it) {
  const int lane = TID() & 63, w = TID() >> 6;
  const u16* PROJ = (const u16*)(WSP(P) + WS_PROJ);
  u16* O = (u16*)(WSP(P) + WS_OM) + (long)2 * T_ * 256;
  const float wn = P.in[23][l * 64 + lane];
#pragma unroll 4
  for (int q = 0; q < 16; ++q) {
    long t = (long)it * 16 + w * 4 + (q >> 2); int h = q & 3;
    float o = bf2f(O[t * 256 + h * 64 + lane]);
    float ss = wave_sum(o * o);
    float y = o * rsqrtf(ss * (1.f / 64.f) + EPS) * wn;
    float z = bf2f(PROJ[t * PW + P_GZ + h * 64 + lane]);
    O[t * 256 + h * 64 + lane] = f2bf(y * siluf_(z));
  }
}

DI void kv_gload(uint4& k0, uint4& k1, uint4& v0, uint4& v1, const u16* ksrc, const u16* vsrc, long ld) {
  const int tid = TID(), r0 = tid >> 3, ch = tid & 7;
  k0 = *(const uint4*)(ksrc + (long)r0 * ld + ch * 8); k1 = *(const uint4*)(ksrc + (long)(r0 + 32) * ld + ch * 8);
  v0 = *(const uint4*)(vsrc + (long)r0 * ld + ch * 8); v1 = *(const uint4*)(vsrc + (long)(r0 + 32) * ld + ch * 8);
}
DI void k_gload(uint4& k0, uint4& k1, const u16* ksrc, long ld) {
  const int tid = TID(), r0 = tid >> 3, ch = tid & 7;
  k0 = *(const uint4*)(ksrc + (long)r0 * ld + ch * 8); k1 = *(const uint4*)(ksrc + (long)(r0 + 32) * ld + ch * 8);
}
DI void k_store(const uint4& k0, const uint4& k1, u16* sK) {
  const int tid = TID(), r0 = tid >> 3, ch = tid & 7;
  *(uint4*)(sK + r0 * 72 + ch * 8) = k0; *(uint4*)(sK + (r0 + 32) * 72 + ch * 8) = k1;
}
DI void kv_store(const uint4& k0, const uint4& k1, const uint4& v0, const uint4& v1, u16* sK, u16* sVt) {
  const int tid = TID(), r0 = tid >> 3, ch = tid & 7;
  *(uint4*)(sK + r0 * 72 + ch * 8) = k0; *(uint4*)(sK + (r0 + 32) * 72 + ch * 8) = k1;
  const int ksw = 16 * (ch >> 1);
  st_kt(sVt, ch * 8, r0 ^ ksw, v0); st_kt(sVt, ch * 8, (r0 + 32) ^ ksw, v1);
}
DI void sb_attn_item(const Params& P, int it, u16* sQ, u16* sK, u16* sVt) {
  const int tid = TID(), lane = tid & 63, w = tid >> 6, r16 = lane & 15, quad = lane >> 4;
  const int qb = 63 - (it >> 5), bh = it & 31, b = bh >> 2, h = bh & 3;
  const u16* PROJ = (const u16*)(WSP(P) + WS_PROJ);
  u16* OUT = (u16*)(WSP(P) + WS_OM) + (long)3 * T_ * 256;
  const long tb = (long)b * SEQ;
  load_tile(sQ, PROJ + (tb + qb * 64) * PW + P_SB + h * 64, PW);
  __syncthreads();
  bf16x8 bq[2]; load_qfrag(bq, sQ, w, lane);
  const int tq = qb * 64 + 16 * w + r16;
  f32x4 ot[4];
#pragma unroll
  for (int dt = 0; dt < 4; ++dt) ot[dt] = (f32x4){0.f, 0.f, 0.f, 0.f};
  float R = 0.f;
  uint4 pk0, pk1, pv0, pv1;
  kv_gload(pk0, pk1, pv0, pv1, PROJ + (tb + qb * 64) * PW + P_SB + 256 + h * 64, PROJ + (tb + qb * 64) * PW + P_SB + 512 + h * 64, PW);
  for (int kb = qb; kb >= 0; --kb) {
    if (__syncthreads_and(R < -104.f)) break;
    kv_store(pk0, pk1, pv0, pv1, sK, sVt);
    __syncthreads();
    if (kb > 0) kv_gload(pk0, pk1, pv0, pv1, PROJ + (tb + (kb - 1) * 64) * PW + P_SB + 256 + h * 64, PROJ + (tb + (kb - 1) * 64) * PW + P_SB + 512 + h * 64, PW);
    f32x4 st[4];
    st_mma(st, sK, bq, lane);
    float gs[4], zz[4][4], x[4][4];
#pragma unroll
    for (int mt = 0; mt < 4; ++mt) {
      float g = 0.f;
#pragma unroll
      for (int j = 0; j < 4; ++j) {
        int s = kb * 64 + 16 * mt + 4 * quad + j;
        float z = st[mt][j] * 0.125f;
        float sp = softplus_fast(z);
        bool mk = s < tq;
        x[mt][j] = mk ? -sp : 0.f;
        zz[mt][j] = mk ? (z - sp) : -1e30f;
        g += x[mt][j];
      }
      gs[mt] = g;
    }
    float hm = 0.f, tot_all = 0.f;
    f32x4 pw[4];
#pragma unroll
    for (int mt = 3; mt >= 0; --mt) {
      float g = gs[mt];
      const float xa = __shfl_xor(g, 16);
      const float xb = __shfl_xor(g + xa, 32);
      const float tot = (g + xa) + xb;
      const float hq = (quad == 0) ? (xa + xb) : (quad == 1) ? xb : (quad == 2) ? xa : 0.f;
      float base = R + hm + hq;
      float e3 = 0.f, e2 = x[mt][3], e1 = e2 + x[mt][2], e0 = e1 + x[mt][1];
      pw[mt][0] = __expf(zz[mt][0] + base + e0);
      pw[mt][1] = __expf(zz[mt][1] + base + e1);
      pw[mt][2] = __expf(zz[mt][2] + base + e2);
      pw[mt][3] = __expf(zz[mt][3] + base + e3);
      hm += tot; tot_all += tot;
    }
    R += tot_all;
    pv_mma(ot, sVt, pw, lane);
  }
  const long t = tb + tq;
#pragma unroll
  for (int dt = 0; dt < 4; ++dt) {
    uint2 ov; ov.x = pk2(ot[dt][0], ot[dt][1]); ov.y = pk2(ot[dt][2], ot[dt][3]);
    *(uint2*)(OUT + t * 256 + h * 64 + 16 * dt + 4 * quad) = ov;
  }
}

DI void win_attn_item(const Params& P, int it, u16* sQ, u16* sKunused, u16* sVunused) {
  const int tid = TID(), lane = tid & 63, w = tid >> 6, r16 = lane & 15, quad = lane >> 4;
  const int tbk = 127 - (it >> 3), b = it & 7;
  u16* sK = sQ + 128 * 72;
  u16* sVt = sK + 64 * 72;
  (void)sKunused; (void)sVunused;
  const u16* PROJ = (const u16*)(WSP(P) + WS_PROJ);
  const u16* QR = (const u16*)(WSP(P) + WS_QR);
  u16* OW = (u16*)(WSP(P) + WS_OW);
  const long tb = (long)b * SEQ;
  const int t0 = tbk * 32;
#pragma unroll
  for (int i = 0; i < 4; ++i) {
    const int c = tid + 256 * i, row = c >> 3, ch = c & 7;
    *(uint4*)(sQ + row * 72 + ch * 8) = *(const uint4*)(QR + (tb + t0 + (row & 31)) * 256 + (row >> 5) * 64 + ch * 8);
  }
  __syncthreads();
  bf16x8 bq[2][2];
  int tq[2];
#pragma unroll
  for (int qt = 0; qt < 2; ++qt) {
    const int rowq = 32 * w + 16 * qt + r16;
    bq[qt][0] = *(const bf16x8*)(sQ + rowq * 72 + quad * 8);
    bq[qt][1] = *(const bf16x8*)(sQ + rowq * 72 + 32 + quad * 8);
    tq[qt] = t0 + 16 * qt + r16;
  }
  f32x4 ot[2][4];
#pragma unroll
  for (int qt = 0; qt < 2; ++qt)
#pragma unroll
    for (int dt = 0; dt < 4; ++dt) ot[qt][dt] = (f32x4){0.f, 0.f, 0.f, 0.f};
  float m[2] = {-1e30f, -1e30f}, lsum[2] = {0.f, 0.f};
  const int lo = (t0 - 511) > 0 ? (t0 - 511) : 0;
  const int kb_lo = lo >> 6, kb_hi = (t0 + 31) >> 6;
  uint4 pk0, pk1, pv0, pv1;
  kv_gload(pk0, pk1, pv0, pv1, PROJ + (tb + kb_lo * 64) * PW + P_KV + 256, PROJ + (tb + kb_lo * 64) * PW + P_KV + 320, PW);
  for (int kb = kb_lo; kb <= kb_hi; ++kb) {
    __syncthreads();
    kv_store(pk0, pk1, pv0, pv1, sK, sVt);
    __syncthreads();
    if (kb < kb_hi) kv_gload(pk0, pk1, pv0, pv1, PROJ + (tb + (kb + 1) * 64) * PW + P_KV + 256, PROJ + (tb + (kb + 1) * 64) * PW + P_KV + 320, PW);
#pragma unroll
    for (int qt = 0; qt < 2; ++qt) {
      f32x4 st[4];
      st_mma(st, sK, bq[qt], lane);
      const int tqlo = t0 + 16 * qt;
      if (kb * 64 + 63 <= tqlo && tqlo + 15 - kb * 64 < 512) softmax_tile_full(st, m[qt], lsum[qt], ot[qt]);
      else {
        bool msk[4][4];
#pragma unroll
        for (int mt = 0; mt < 4; ++mt)
#pragma unroll
          for (int j = 0; j < 4; ++j) { int s = kb * 64 + 16 * mt + 4 * quad + j; int df = tq[qt] - s; msk[mt][j] = (df >= 0) && (df < 512); }
        softmax_tile(st, msk, m[qt], lsum[qt], ot[qt]);
      }
      pv_mma(ot[qt], sVt, st, lane);
    }
  }
#pragma unroll
  for (int qt = 0; qt < 2; ++qt) {
    const float ls = quad_sum(lsum[qt]);
    const float inv = 1.f / fmaxf(ls, 1e-30f);
    const long t = tb + tq[qt];
#pragma unroll
    for (int dt = 0; dt < 4; ++dt) {
      uint2 ov; ov.x = pk2(ot[qt][dt][0] * inv, ot[qt][dt][1] * inv); ov.y = pk2(ot[qt][dt][2] * inv, ot[qt][dt][3] * inv);
      *(uint2*)(OW + t * 256 + w * 64 + 16 * dt + 4 * quad) = ov;
    }
  }
}

DI void cmp_attn_item(const Params& P, int it, u16* sQ, u16* sK, u16* sVt, float* sImp) {
  const int tid = TID(), lane = tid & 63, w = tid >> 6, r16 = lane & 15, quad = lane >> 4;
  const int tbk = 255 - (it >> 3), b = it & 7;
  const u16* PROJ = (const u16*)(WSP(P) + WS_PROJ);
  const u16* KC = (const u16*)(WSP(P) + WS_KC) + (long)b * 256 * 64;
  const u16* VC = (const u16*)(WSP(P) + WS_VC) + (long)b * 256 * 64;
  u16* OC = (u16*)(WSP(P) + WS_OC);
  u64* SEL = (u64*)(WSP(P) + WS_SEL);
  const long tb = (long)b * SEQ;
  const int t0 = tbk * 16;
  load_q_nsa(sQ, PROJ + (tb + t0) * PW + P_Q, PW);
  for (int e = tid; e < 4 * 16 * 64; e += 256) sImp[e] = 0.f;
  __syncthreads();
  bf16x8 bq[2]; load_qfrag(bq, sQ, w, lane);
  const int tq = t0 + r16;
  const int nv = (tq >= 31) ? ((tq - 31) >> 4) + 1 : 0;
  const int nvmax = (t0 + 15 >= 31) ? ((t0 + 15 - 31) >> 4) + 1 : 0;
  const int ntile = (nvmax + 63) >> 6;
  float m = -1e30f, lsum = 0.f;
  uint4 pk0, pk1, pv0, pv1;
  if (ntile > 0) k_gload(pk0, pk1, KC, 64);
  for (int kt = 0; kt < ntile; ++kt) {
    __syncthreads();
    k_store(pk0, pk1, sK);
    __syncthreads();
    if (kt + 1 < ntile) k_gload(pk0, pk1, KC + (kt + 1) * 64 * 64, 64);
    f32x4 st[4];
    st_mma(st, sK, bq, lane);
    float tm = -1e30f;
#pragma unroll
    for (int mt = 0; mt < 4; ++mt)
#pragma unroll
      for (int j = 0; j < 4; ++j) { int n = kt * 64 + 16 * mt + 4 * quad + j; float s = st[mt][j] * 0.125f; st[mt][j] = s; if (n < nv) tm = fmaxf(tm, s); }
    tm = quad_max(tm);
    float mn = fmaxf(m, tm);
    float ps = 0.f;
#pragma unroll
    for (int mt = 0; mt < 4; ++mt)
#pragma unroll
      for (int j = 0; j < 4; ++j) { int n = kt * 64 + 16 * mt + 4 * quad + j; if (n < nv) ps += __expf(st[mt][j] - mn); }
    lsum = lsum * __expf(m - mn) + ps;
    m = mn;
  }
  lsum = quad_sum(lsum);
  const float inv = (lsum > 0.f) ? 1.f / lsum : 0.f;
  f32x4 ot[4];
#pragma unroll
  for (int dt = 0; dt < 4; ++dt) ot[dt] = (f32x4){0.f, 0.f, 0.f, 0.f};
  float carry = 0.f;
  if (ntile > 0) kv_gload(pk0, pk1, pv0, pv1, KC, VC, 64);
  for (int kt = 0; kt < ntile; ++kt) {
    __syncthreads();
    kv_store(pk0, pk1, pv0, pv1, sK, sVt);
    __syncthreads();
    if (kt + 1 < ntile) kv_gload(pk0, pk1, pv0, pv1, KC + (kt + 1) * 64 * 64, VC + (kt + 1) * 64 * 64, 64);
    f32x4 st[4];
    st_mma(st, sK, bq, lane);
#pragma unroll
    for (int mt = 0; mt < 4; ++mt)
#pragma unroll
      for (int j = 0; j < 4; ++j) { int n = kt * 64 + 16 * mt + 4 * quad + j; st[mt][j] = (n < nv) ? __expf(st[mt][j] * 0.125f - m) * inv : 0.f; }
    pv_mma(ot, sVt, st, lane);
    float prevlast = carry;
#pragma unroll
    for (int mt = 0; mt < 4; ++mt) {
      float pl = st[mt][3];
      float fd = __shfl_up(pl, 16);
      float pprev = (quad > 0) ? fd : prevlast;
      float v = st[mt][0] + st[mt][1] + st[mt][2] + st[mt][3] + pprev;
      sImp[(w * 16 + r16) * 64 + kt * 16 + mt * 4 + quad] = v;
      prevlast = __shfl_down(pl, 48);
    }
    carry = prevlast;
  }
  {
    const long t = tb + tq;
#pragma unroll
    for (int dt = 0; dt < 4; ++dt) {
      uint2 ov; ov.x = pk2(ot[dt][0], ot[dt][1]); ov.y = pk2(ot[dt][2], ot[dt][3]);
      *(uint2*)(OC + t * 256 + w * 64 + 16 * dt + 4 * quad) = ov;
    }
  }
  __syncthreads();
  for (int q = 0; q < 4; ++q) {
    const int tok = 4 * w + q, t = t0 + tok;
    float v = sImp[(0 * 16 + tok) * 64 + lane] + sImp[(1 * 16 + tok) * 64 + lane] + sImp[(2 * 16 + tok) * 64 + lane] + sImp[(3 * 16 + tok) * 64 + lane];
    const int cur = t >> 6;
    if (lane == 0 || lane == cur) v = 1e9f;
    else if (lane * 64 > t) v = -1e30f;
    int cnt = 0;
#pragma unroll
    for (int i2 = 0; i2 < 64; ++i2) {
      float vi = __builtin_bit_cast(float, __builtin_amdgcn_readlane(__builtin_bit_cast(int, v), i2));
      cnt += (vi > v || (vi == v && i2 < lane)) ? 1 : 0;
    }
    u64 mask = __ballot(cnt < 16);
    if (lane == 0) SEL[tb + t] = mask;
  }
}

DI void sel_attn_item(const Params& P, int it, u16* sQ, u16* sKunused, u16* sVunused) {
  const int tid = TID(), lane = tid & 63, w = tid >> 6, r16 = lane & 15, quad = lane >> 4;
  const int tbk = 127 - (it >> 3), b = it & 7;
  u16* sK = sQ + 128 * 72;
  u16* sVt = sK + 64 * 72;
  (void)sKunused; (void)sVunused;
  const u16* PROJ = (const u16*)(WSP(P) + WS_PROJ);
  const u16* QR = (const u16*)(WSP(P) + WS_QR);
  const u16* OC = (const u16*)(WSP(P) + WS_OC);
  const u16* OW = (const u16*)(WSP(P) + WS_OW);
  const u64* SEL = (const u64*)(WSP(P) + WS_SEL);
  u16* OUT = (u16*)(WSP(P) + WS_OM);
  const long tb = (long)b * SEQ;
  const int t0 = tbk * 32;
#pragma unroll
  for (int i = 0; i < 4; ++i) {
    const int c = tid + 256 * i, row = c >> 3, ch = c & 7;
    *(uint4*)(sQ + row * 72 + ch * 8) = *(const uint4*)(QR + (tb + t0 + (row & 31)) * 256 + (row >> 5) * 64 + ch * 8);
  }
  __syncthreads();
  bf16x8 bq[2][2];
  int tq[2]; u64 mysel[2];
#pragma unroll
  for (int qt = 0; qt < 2; ++qt) {
    const int rowq = 32 * w + 16 * qt + r16;
    bq[qt][0] = *(const bf16x8*)(sQ + rowq * 72 + quad * 8);
    bq[qt][1] = *(const bf16x8*)(sQ + rowq * 72 + 32 + quad * 8);
    tq[qt] = t0 + 16 * qt + r16;
    mysel[qt] = SEL[tb + tq[qt]];
  }
  u64 uni = 0;
#pragma unroll
  for (int q = 0; q < 32; ++q) uni |= SEL[tb + t0 + q];
  const int cur = t0 >> 6;
  uni &= (cur == 63) ? ~0ull : ((1ull << (cur + 1)) - 1ull);
  f32x4 ot[2][4];
#pragma unroll
  for (int qt = 0; qt < 2; ++qt)
#pragma unroll
    for (int dt = 0; dt < 4; ++dt) ot[qt][dt] = (f32x4){0.f, 0.f, 0.f, 0.f};
  float m[2] = {-1e30f, -1e30f}, lsum[2] = {0.f, 0.f};
  uint4 pk0, pk1, pv0, pv1;
  int kb = uni ? (__ffsll((long long)uni) - 1) : -1;
  uni &= uni - 1;
  if (kb >= 0) kv_gload(pk0, pk1, pv0, pv1, PROJ + (tb + kb * 64) * PW + P_KV + 128, PROJ + (tb + kb * 64) * PW + P_KV + 192, PW);
  for (int nkb = -1; kb >= 0; kb = nkb) {
    __syncthreads();
    kv_store(pk0, pk1, pv0, pv1, sK, sVt);
    __syncthreads();
    nkb = uni ? (__ffsll((long long)uni) - 1) : -1;
    uni &= uni - 1;
    if (nkb >= 0) kv_gload(pk0, pk1, pv0, pv1, PROJ + (tb + nkb * 64) * PW + P_KV + 128, PROJ + (tb + nkb * 64) * PW + P_KV + 192, PW);
#pragma unroll
    for (int qt = 0; qt < 2; ++qt) {
      f32x4 st[4];
      st_mma(st, sK, bq[qt], lane);
      const bool selq = (mysel[qt] >> kb) & 1ull;
      if (__ballot(selq) == ~0ull && kb * 64 + 63 <= t0 + 16 * qt) softmax_tile_full(st, m[qt], lsum[qt], ot[qt]);
      else {
        bool msk[4][4];
#pragma unroll
        for (int mt = 0; mt < 4; ++mt)
#pragma unroll
          for (int j = 0; j < 4; ++j) { int s = kb * 64 + 16 * mt + 4 * quad + j; msk[mt][j] = selq && (s <= tq[qt]); }
        softmax_tile(st, msk, m[qt], lsum[qt], ot[qt]);
      }
      pv_mma(ot[qt], sVt, st, lane);
    }
  }
#pragma unroll
  for (int qt = 0; qt < 2; ++qt) {
    const float ls = quad_sum(lsum[qt]);
    const float inv = 1.f / fmaxf(ls, 1e-30f);
    const long t = tb + tq[qt];
    const float gc = sigmoidf_(bf2f(PROJ[t * PW + P_NG + w * 3 + 0]));
    const float gsl = sigmoidf_(bf2f(PROJ[t * PW + P_NG + w * 3 + 1]));
    const float gw = sigmoidf_(bf2f(PROJ[t * PW + P_NG + w * 3 + 2]));
#pragma unroll
    for (int dt = 0; dt < 4; ++dt) {
      const long o = t * 256 + w * 64 + 16 * dt + 4 * quad;
      uint2 c = *(const uint2*)(OC + o), ww = *(const uint2*)(OW + o);
      float r0 = gc * bf2f((u16)(c.x & 0xffff)) + gsl * ot[qt][dt][0] * inv + gw * bf2f((u16)(ww.x & 0xffff));
      float r1 = gc * bf2f((u16)(c.x >> 16)) + gsl * ot[qt][dt][1] * inv + gw * bf2f((u16)(ww.x >> 16));
      float r2 = gc * bf2f((u16)(c.y & 0xffff)) + gsl * ot[qt][dt][2] * inv + gw * bf2f((u16)(ww.y & 0xffff));
      float r3 = gc * bf2f((u16)(c.y >> 16)) + gsl * ot[qt][dt][3] * inv + gw * bf2f((u16)(ww.y >> 16));
      uint2 ov; ov.x = pk2(r0, r1); ov.y = pk2(r2, r3);
      *(uint2*)(OUT + o) = ov;
    }
  }
}

DI void inproj_tile(const Params& P, int l, int it, u16* sA, u16* sB) {
  const int tid = TID(), lane = tid & 63, w = tid >> 6, r16 = lane & 15, quad = lane >> 4, wm = w >> 1, wn = w & 1;
  int mt, nt; tile_from_q(it, 22, mt, nt);
  const u16* H = (const u16*)(WSP(P) + WS_H);
  u16* PROJ = (u16*)(WSP(P) + WS_PROJ);
  const u16* Ab = H + (long)mt * 128 * DM;
  const u16* Bb = (const u16*)(WSP(P) + WS_W + WT_IN) + (long)nt * 128 * DM;
  f32x4 acc[4][4];
  gemm3<4>(acc, g3_ptr(Ab, DM, tid, 0, false), g3_ptr(Ab, DM, tid, 1, false), nullptr, nullptr, 64,
           g3_ptr(Bb, DM, tid, 0, false), g3_ptr(Bb, DM, tid, 1, false), nullptr, nullptr, DM, sA, 16L * DM, 16L * DM);
  __syncthreads();
#pragma unroll
  for (int mi = 0; mi < 4; ++mi)
#pragma unroll
    for (int ni = 0; ni < 4; ++ni)
#pragma unroll
      for (int j = 0; j < 4; ++j) sA[(wm * 64 + 16 * mi + 4 * quad + j) * 136 + wn * 64 + 16 * ni + r16] = f2bf(acc[mi][ni][j]);
  __syncthreads();
  store_tile_bf16<128>(sA, PROJ + (long)mt * 128 * PW + nt * 128, PW, 128);
}
DI void glu_tile(const Params& P, int l, int it, u16* sA, u16* sB) {
  const int tid = TID(), lane = tid & 63, w = tid >> 6, r16 = lane & 15, quad = lane >> 4, wm = w >> 1, wn = w & 1;
  const int mt = it >> 2, nt = it & 3;
  const u16* Y5 = (const u16*)(WSP(P) + WS_Y5);
  u16* OUT = (u16*)(WSP(P) + WS_OM) + (long)1 * T_ * 256;
  const u16* Ab = Y5 + (long)mt * 128 * 256;
  const u16* Bb = (const u16*)(WSP(P) + WS_W + WT_GLU) + (long)nt * 128 * 256;
  f32x4 acc[4][4];
  gemm3<4>(acc, g3_ptr(Ab, 256, tid, 0, false), g3_ptr(Ab, 256, tid, 1, false), nullptr, nullptr, 64,
           g3_ptr(Bb, 256, tid, 0, false), g3_ptr(Bb, 256, tid, 1, false), nullptr, nullptr, 256, sA, 16L * 256, 16L * 256);
  __syncthreads();
#pragma unroll
  for (int mi = 0; mi < 4; ++mi)
#pragma unroll
    for (int ni = 0; ni < 2; ++ni)
#pragma unroll
      for (int j = 0; j < 4; ++j)
        sA[(wm * 64 + 16 * mi + 4 * quad + j) * 72 + wn * 32 + 16 * ni + r16] = f2bf(acc[mi][ni][j] * sigmoidf_(acc[mi][ni + 2][j]));
  __syncthreads();
  store_tile_bf16<64>(sA, OUT + (long)mt * 128 * 256 + nt * 64, 256, 128);
}
DI void merge_tile(const Params& P, int l, int it, u16* sA, u16* sB) {
  const int tid = TID(), lane = tid & 63, w = tid >> 6, r16 = lane & 15, quad = lane >> 4, wm = w >> 1, wn = w & 1;
  int mt, nt; tile_from_q(it, 8, mt, nt);
  const u16* H = (const u16*)(WSP(P) + WS_H);
  const u16* OM = (const u16*)(WSP(P) + WS_OM);
  u16* MERGED = (u16*)(WSP(P) + WS_MERGED);
  uint2 outp[4][4];
#pragma unroll
  for (int mi = 0; mi < 4; ++mi)
#pragma unroll
    for (int ni = 0; ni < 4; ++ni) outp[mi][ni] = make_uint2(0u, 0u);
#pragma unroll 1
  for (int m = 0; m < 4; ++m) {
    uint2 gp[4][4];
    {
      f32x4 ag[4][4];
      const u16* Ab = H + (long)mt * 128 * DM;
      const u16* Bb = (const u16*)(WSP(P) + WS_W + WT_G) + ((long)(m * 1024 + nt * 128)) * DM;
      gemm3<4, true>(ag, g3_ptr(Ab, DM, tid, 0, false), g3_ptr(Ab, DM, tid, 1, false), nullptr, nullptr, 64,
               g3_ptr(Bb, DM, tid, 0, false), g3_ptr(Bb, DM, tid, 1, false), nullptr, nullptr, DM, sA, 16L * DM, 16L * DM);
#pragma unroll
      for (int mi = 0; mi < 4; ++mi)
#pragma unroll
        for (int ni = 0; ni < 4; ++ni) {
          gp[mi][ni].x = pk2(sigmoidf_(ag[mi][ni][0]), sigmoidf_(ag[mi][ni][1]));
          gp[mi][ni].y = pk2(sigmoidf_(ag[mi][ni][2]), sigmoidf_(ag[mi][ni][3]));
        }
    }
    {
      f32x4 av[4][4];
      const u16* Ab = OM + ((long)m * T_ + (long)mt * 128) * 256;
      const u16* Bb = (const u16*)(WSP(P) + WS_W + WT_BR) + ((long)(m * 1024 + nt * 128)) * 256;
      gemm3<4, true>(av, g3_ptr(Ab, 256, tid, 0, false), g3_ptr(Ab, 256, tid, 1, false), nullptr, nullptr, 64,
               g3_ptr(Bb, 256, tid, 0, false), g3_ptr(Bb, 256, tid, 1, false), nullptr, nullptr, 256, sA, 16L * 256, 16L * 256);
#pragma unroll
      for (int mi = 0; mi < 4; ++mi)
#pragma unroll
        for (int ni = 0; ni < 4; ++ni) {
          const float o0 = bf2f((u16)(outp[mi][ni].x & 0xffff)) + av[mi][ni][0] * bf2f((u16)(gp[mi][ni].x & 0xffff));
          const float o1 = bf2f((u16)(outp[mi][ni].x >> 16)) + av[mi][ni][1] * bf2f((u16)(gp[mi][ni].x >> 16));
          const float o2 = bf2f((u16)(outp[mi][ni].y & 0xffff)) + av[mi][ni][2] * bf2f((u16)(gp[mi][ni].y & 0xffff));
          const float o3 = bf2f((u16)(outp[mi][ni].y >> 16)) + av[mi][ni][3] * bf2f((u16)(gp[mi][ni].y >> 16));
          outp[mi][ni].x = pk2(o0, o1); outp[mi][ni].y = pk2(o2, o3);
        }
    }
  }
  __syncthreads();
#pragma unroll
  for (int mi = 0; mi < 4; ++mi)
#pragma unroll
    for (int ni = 0; ni < 4; ++ni)
#pragma unroll
      for (int j = 0; j < 4; ++j) {
        const unsigned wv = (j < 2) ? outp[mi][ni].x : outp[mi][ni].y;
        sA[(wm * 64 + 16 * mi + 4 * quad + j) * 136 + wn * 64 + 16 * ni + r16] = (u16)((j & 1) ? (wv >> 16) : (wv & 0xffff));
      }
  __syncthreads();
  store_tile_bf16<128>(sA, MERGED + (long)mt * 128 * DM + nt * 128, DM, 128);
}
DI void resid_tile(const u16* A, int K, const u16* Bt, const float* resid, float* out, int it, u16* sA, u16* sB) {
  const int tid = TID(), lane = tid & 63, w = tid >> 6, r16 = lane & 15, quad = lane >> 4, wm = w >> 1, wn = w & 1;
  int mt, nt; tile_from_q(it, 8, mt, nt);
  const u16* Ab = A + (long)mt * 128 * K;
  const u16* Bb = Bt + (long)nt * 128 * K;
  f32x4 acc[4][4];
  gemm3<4>(acc, g3_ptr(Ab, K, tid, 0, false), g3_ptr(Ab, K, tid, 1, false), nullptr, nullptr, 64,
           g3_ptr(Bb, K, tid, 0, false), g3_ptr(Bb, K, tid, 1, false), nullptr, nullptr, K, sA, 16L * K, 16L * K);
  float* sC = (float*)sA + w * (32 * 68);
#pragma unroll
  for (int hp = 0; hp < 2; ++hp) {
    __syncthreads();
#pragma unroll
    for (int mi2 = 0; mi2 < 2; ++mi2)
#pragma unroll
      for (int ni = 0; ni < 4; ++ni)
#pragma unroll
        for (int j = 0; j < 4; ++j) sC[(16 * mi2 + 4 * quad + j) * 68 + 16 * ni + r16] = acc[2 * hp + mi2][ni][j];
    __syncthreads();
#pragma unroll
    for (int q = 0; q < 8; ++q) {
      const int c = lane + 64 * q, row = c >> 4, c4 = (c & 15) * 4;
      const long o = ((long)mt * 128 + wm * 64 + 32 * hp + row) * DM + nt * 128 + wn * 64 + c4;
      const float4 rv = *(const float4*)(resid + o);
      const f32x4 cv = *(const f32x4*)(sC + row * 68 + c4);
      *(float4*)(out + o) = make_float4(rv.x + cv[0], rv.y + cv[1], rv.z + cv[2], rv.w + cv[3]);
    }
  }
}
DI void ffn1_tile(const Params& P, int l, int it, u16* sA, u16* sB) {
  const int tid = TID(), lane = tid & 63, w = tid >> 6, r16 = lane & 15, quad = lane >> 4, wm = w >> 1, wn = w & 1;
  int mt, nt; tile_from_q(it, 44, mt, nt);
  const u16* H = (const u16*)(WSP(P) + WS_H);
  u16* ACT = (u16*)(WSP(P) + WS_PROJ);
  const u16* Ab = H + (long)mt * 128 * DM;
  const u16* Bb = (const u16*)(WSP(P) + WS_W + WT_GU) + (long)nt * 128 * DM;
  f32x4 acc[4][4];
  gemm3<4>(acc, g3_ptr(Ab, DM, tid, 0, false), g3_ptr(Ab, DM, tid, 1, false), nullptr, nullptr, 64,
           g3_ptr(Bb, DM, tid, 0, false), g3_ptr(Bb, DM, tid, 1, false), nullptr, nullptr, DM, sA, 16L * DM, 16L * DM);
  __syncthreads();
#pragma unroll
  for (int mi = 0; mi < 4; ++mi)
#pragma unroll
    for (int ni = 0; ni < 2; ++ni)
#pragma unroll
      for (int j = 0; j < 4; ++j)
        sA[(wm * 64 + 16 * mi + 4 * quad + j) * 72 + wn * 32 + 16 * ni + r16] = f2bf(siluf_(acc[mi][ni][j]) * acc[mi][ni + 2][j]);
  __syncthreads();
  store_tile_bf16<64>(sA, ACT + (long)mt * 128 * DFF + nt * 64, DFF, 128);
}

__global__ void __launch_bounds__(256, LB2) fwd_megakernel(Params P) {
  cg::grid_group grid = cg::this_grid();
  __shared__ __attribute__((aligned(16))) float lds[17920];
  __shared__ int s_item;
  unsigned* cnt = (unsigned*)(WSP(P) + WS_CNT);
  const int xcd = (int)(__builtin_amdgcn_s_getreg((3 << 11) | 20) & 0xF) & 7;
  __shared__ int s_rank;
  if (threadIdx.x == 0) s_rank = (int)atomicAdd(cnt + 900 + xcd, 1u);
  __syncthreads();
  const int xrank = s_rank;
  u16* sA = (u16*)lds;
  u16* sB = sA + 128 * 80;
  u16* aQ = (u16*)lds;
  u16* aK = aQ + 64 * 72;
  u16* aV = aK + 64 * 72;
  float* aImp = (float*)(aV + 64 * 72);
  for (int ph = P.ph_lo; ph < P.ph_hi; ++ph) {
    const int l = ph / 11, sp = ph % 11;
    const float* xin = (l == 0) ? P.in[0] : P.out;
    const int nrep = (PROBE_DUP != 0 && l == 0 && ((PROBE_DUP >> sp) & 1)) ? 2 : 1;
    for (int rep = 0; rep < nrep; ++rep) {
    unsigned* pc = cnt + (ph + 32 * rep) * 8;
    switch (sp) {
      case 0: if (PHASE_MASK & (1 << 0)) {
        phase_rmsnorm(xin, P.in[2] + l * DM, (u16*)(WSP(P) + WS_H));
        phase_convert(P, l, lds);
        if (l == 0) phase_rope_table((const int*)P.in[1], (float*)(WSP(P) + WS_COS), (float*)(WSP(P) + WS_SIN));
      } break;
      case 1: if (PHASE_MASK & (1 << 1)) {
        XCD_STATIC_LOOP(32 * 22, inproj_tile(P, l, it, sA, sB))
      } break;
      case 2: if (PHASE_MASK & (1 << 2)) {
        for (;;) {
          int it = next_item(pc, &s_item); if (it >= 64 + 3 * 2048) break;
          if (it < 64) cmp1_tile(P, l, it, sA, sB);
          else if (it < 64 + 2048) gdn_p1_item(P, l, it - 64, lds);
          else if (it < 64 + 4096) s5_pass1_item(P, l, it - 64 - 2048, lds);
          else nsa_prep_item(P, l, it - 64 - 4096);
        }
      } break;
      case 3: if (PHASE_MASK & (1 << 3)) {
        for (;;) {
          int it = next_item(pc, &s_item); if (it >= 128 + 3072 + 64) break;
          if (it < 128) gdn_p2_item(P, it, lds);
          else if (it < 128 + 2048) sb_attn_item(P, it - 128, aQ, aK, aV);
          else if (it < 128 + 3072) win_attn_item(P, it - 128 - 2048, aQ, aK, aV);
          else if (it < 128 + 3072 + 32) s5_carry_item(P, l, it - 128 - 3072);
          else cmp2_tile(P, l, it - 128 - 3072 - 32, sA, sB, lds + 17000);
        }
      } break;
      case 4: if (PHASE_MASK & (1 << 4)) {
        for (;;) {
          int it = next_item(pc, &s_item); if (it >= 3 * 2048) break;
          if (it < 2048) cmp_attn_item(P, it, aQ, aK, aV, aImp);
          else if (it < 4096) s5_pass2_item(P, l, it - 2048, lds);
          else gdn_post_item(P, l, it - 4096);
        }
      } break;
      case 5: if (PHASE_MASK & (1 << 5)) {
        for (;;) {
          int it = next_item(pc, &s_item); if (it >= 1024 + 1024) break;
          if (it < 1024) sel_attn_item(P, it, aQ, aK, aV);
          else glu_tile(P, l, it - 1024, sA, sB);
        }
      } break;
      case 6: if (PHASE_MASK & (1 << 6)) {
        XCD_STATIC_LOOP(32 * 8, merge_tile(P, l, it, sA, sB))
      } break;
      case 7: if (PHASE_MASK & (1 << 7)) {
        XCD_STATIC_LOOP(32 * 8, resid_tile((const u16*)(WSP(P) + WS_MERGED), DM, (const u16*)(WSP(P) + WS_W + WT_OUT), xin, P.out, it, sA, sB))
      } break;
      case 8: if (PHASE_MASK & (1 << 8)) {
        phase_rmsnorm(P.out, P.in[26] + l * DM, (u16*)(WSP(P) + WS_H));
      } break;
      case 9: if (PHASE_MASK & (1 << 9)) {
        XCD_STATIC_LOOP(32 * 44, ffn1_tile(P, l, it, sA, sB))
      } break;
      case 10: if (PHASE_MASK & (1 << 10)) {
        XCD_STATIC_LOOP(32 * 8, resid_tile((const u16*)(WSP(P) + WS_PROJ), DFF, (const u16*)(WSP(P) + WS_W + WT_D), P.out, P.out, it, sA, sB))
      } break;
    }
    if (rep + 1 < nrep) grid.sync();
    }
    if (ph + 1 < P.ph_hi) grid.sync();
  }
}

extern "C" void kernel_launch(void* const* d_in, const int* in_sizes, int n_in, void* d_out, int out_size, void* d_ws, size_t ws_size,
                              hipStream_t stream) {
  static int grid_blocks = 0;
  if (!grid_blocks) {
    int dev = 0, cus = 0, per_cu = 0;
    hipGetDevice(&dev);
    hipDeviceGetAttribute(&cus, hipDeviceAttributeMultiprocessorCount, dev);
    hipOccupancyMaxActiveBlocksPerMultiprocessor(&per_cu, fwd_megakernel, 256, 0);
    if (per_cu < 1) per_cu = 1;
    if (per_cu > 2) per_cu = 2;
    grid_blocks = cus * per_cu;
    if (ws_size < WS_W + WT_END) fprintf(stderr, "kernel_launch: workspace too small: %zu\n", ws_size);
  }
  hipMemsetAsync((char*)d_ws + WS_CNT, 0, 4096, stream);
  Params p{};
  for (int i = 0; i < 30; ++i) p.in[i] = (const float*)d_in[i];
  p.out = (float*)d_out;
  p.ws = (unsigned char*)d_ws;
  p.ph_lo = 0; p.ph_hi = NPHASE;
  void* args[] = {&p};
  hipError_t e = hipLaunchCooperativeKernel((void*)fwd_megakernel, dim3(grid_blocks), dim3(256), args, 0, stream);
  if (e != hipSuccess) fprintf(stderr, "cooperative launch failed: %s (grid %d)\n", hipGetErrorString(e), grid_blocks);
}
```
